# Optimizing an MI355X kernel written in HIP

```python
import math
import jax, jax.numpy as jnp
from jax import lax
import numpy as np

D_MODEL = 2048
BATCH = 2
SEQ = 4096
DEPTH = 4
DEC_BATCH = 8
DEC_SEQ = 2048
PAST_LEN = 128

N_META = 16
S5_WIDTH = 512
S5_GROUP = 16
S5_GROUPS = S5_WIDTH // S5_GROUP
S5_STATE = 64
GLA_HEADS = 4
GLA_DK = 64
GLA_DV = 128
GLA_KEY = GLA_HEADS * GLA_DK
GLA_WIDTH = GLA_HEADS * GLA_DV
GLA_RANK = 16
GLA_GATE_NORM = 16.0
GLA_CHUNK = 64
LRU_WIDTH = 1024
LRU_BLOCKS = 8
LRU_BLOCK = LRU_WIDTH // LRU_BLOCKS
CONV_WIDTH = 4
LRU_C = 8.0
N_BRANCH = 3
EPS = 1e-6
N_IN = 2 * S5_WIDTH + 2 * GLA_KEY + 2 * GLA_WIDTH + 2 * GLA_RANK + 2 * LRU_WIDTH + N_BRANCH * D_MODEL

kernel_name = 'hybrid_s5_gla_rglru_parallel_encoder'

F32 = jnp.float32


def rmsnorm(x, g):
    xf = x.astype(F32)
    return xf * lax.rsqrt(jnp.mean(xf * xf, axis=-1, keepdims=True) + EPS) * g.astype(F32)


def linear_scan(a, b, axis, reverse=False):
    if reverse:
        a = jnp.flip(a, axis)
        b = jnp.flip(b, axis)
    def combine(l, r):
        return r[0] * l[0], r[0] * l[1] + r[1]
    _, h = lax.associative_scan(combine, (a, b), axis=axis)
    if reverse:
        h = jnp.flip(h, axis)
    return h


def complex_linear_scan(a_re, a_im, b_re, b_im, axis, reverse=False):
    elems = (a_re, a_im, b_re, b_im)
    if reverse:
        elems = tuple(jnp.flip(e, axis) for e in elems)
    def combine(l, r):
        alr, ali, blr, bli = l
        arr, ari, brr, bri = r
        return (arr * alr - ari * ali, arr * ali + ari * alr,
                arr * blr - ari * bli + brr, arr * bli + ari * blr + bri)
    _, _, h_re, h_im = lax.associative_scan(combine, elems, axis=axis)
    if reverse:
        h_re = jnp.flip(h_re, axis)
        h_im = jnp.flip(h_im, axis)
    return h_re, h_im


def split_cols(c):
    sizes = (S5_WIDTH, S5_WIDTH, GLA_KEY, GLA_KEY, GLA_WIDTH, GLA_WIDTH, 2 * GLA_RANK,
             LRU_WIDTH, LRU_WIDTH, N_BRANCH * D_MODEL)
    outs = []
    start = 0
    for s in sizes:
        outs.append(c[..., start:start + s])
        start += s
    return outs


def s5_mixer(u, lam_re, lam_im, log_step, b_re, b_im, c_re, c_im, d_skip, w_glu, b_glu):
    bsz, length, _ = u.shape
    ug = u.reshape(bsz, length, S5_GROUPS, S5_GROUP)
    b_re = b_re.astype(F32)
    b_im = b_im.astype(F32)
    y = d_skip.astype(F32) * u
    for d in range(2):
        lr = lam_re[d].astype(F32)
        li = lam_im[d].astype(F32)
        dt = jnp.exp(log_step[d].astype(F32))[:, None]
        mag = jnp.exp(lr * dt)
        abr = mag * jnp.cos(li * dt)
        abi = mag * jnp.sin(li * dt)
        den = lr * lr + li * li
        fr = ((abr - 1.0) * lr + abi * li) / den
        fi = (abi * lr - (abr - 1.0) * li) / den
        bbr = fr[..., None] * b_re - fi[..., None] * b_im
        bbi = fr[..., None] * b_im + fi[..., None] * b_re
        bur = jnp.einsum('gnc,blgc->blgn', bbr, ug)
        bui = jnp.einsum('gnc,blgc->blgn', bbi, ug)
        s_re, s_im = complex_linear_scan(jnp.broadcast_to(abr, bur.shape), jnp.broadcast_to(abi, bur.shape),
                                         bur, bui, axis=1, reverse=(d == 1))
        yg = (jnp.einsum('gcn,blgn->blgc', c_re[d].astype(F32), s_re)
              - jnp.einsum('gcn,blgn->blgc', c_im[d].astype(F32), s_im))
        y = y + yg.reshape(bsz, length, S5_WIDTH)
    z = jax.nn.gelu(y)
    return z * jax.nn.sigmoid(z @ w_glu + b_glu)


def gla_chunked(q, k, v, g):
    bsz, t_len, heads, dk = q.shape
    dv = v.shape[-1]
    n_chunks = t_len // GLA_CHUNK
    rs = lambda t: t.reshape(bsz, n_chunks, GLA_CHUNK, heads, t.shape[-1]).astype(F32)
    q, k, v, g = rs(q), rs(k), rs(v), rs(g)
    b = jnp.cumsum(g, axis=2)
    qe = q * jnp.exp(b)
    ke = k * jnp.exp(-b)
    mask = jnp.tril(jnp.ones((GLA_CHUNK, GLA_CHUNK), dtype=bool))
    att = jnp.where(mask, jnp.einsum('bnihk,bnjhk->bnhij', qe, ke), 0.0)
    o = jnp.einsum('bnhij,bnjhv->bnihv', att, v)
    b_last = b[:, :, -1:]
    ds = jnp.einsum('bnjhk,bnjhv->bnhkv', k * jnp.exp(b_last - b), v)
    decay = jnp.broadcast_to(jnp.exp(b_last[:, :, 0])[..., None], ds.shape)
    s = linear_scan(decay, ds, axis=1)
    s_prev = jnp.concatenate([jnp.zeros_like(s[:, :1]), s[:, :-1]], axis=1)
    o = o + jnp.einsum('bnihk,bnhkv->bnihv', qe, s_prev)
    return o.reshape(bsz, t_len, heads, dv)


def gla_mixer(q, k, v, glr, w_gate_up, b_gate, norm_g):
    bsz, length, _ = q.shape
    q = q.reshape(bsz, length, GLA_HEADS, GLA_DK) * (GLA_DK ** -0.5)
    k = k.reshape(bsz, length, GLA_HEADS, GLA_DK)
    v = v.reshape(bsz, length, GLA_HEADS, GLA_DV)
    pad = (-N_META) % GLA_CHUNK
    padt = lambda t: jnp.pad(t, ((0, 0), (pad, 0), (0, 0), (0, 0)))
    o = 0.0
    for d in range(2):
        g = jax.nn.log_sigmoid(glr[..., d * GLA_RANK:(d + 1) * GLA_RANK] @ w_gate_up[d] + b_gate[d]) / GLA_GATE_NORM
        g = g.reshape(bsz, length, GLA_HEADS, GLA_DK)
        qp, kp, vp, gp = padt(q), padt(k), padt(v), padt(g)
        if d == 1:
            qp, kp, vp, gp = (jnp.flip(t, 1) for t in (qp, kp, vp, gp))
        od = gla_chunked(qp, kp, vp, gp)
        if d == 1:
            od = jnp.flip(od, 1)
        o = o + od[:, pad:]
    o = o * lax.rsqrt(jnp.mean(o * o, axis=-1, keepdims=True) + EPS)
    o = o * norm_g.astype(F32).reshape(GLA_HEADS, GLA_DV)
    return o.reshape(bsz, length, GLA_WIDTH)


def rglru_mixer(x, conv_w, conv_b, w_a, b_a, w_x, b_x, lam):
    bsz, length, _ = x.shape
    left = CONV_WIDTH // 2
    xp = jnp.pad(x, ((0, 0), (left, CONV_WIDTH - 1 - left), (0, 0)))
    xc = conv_b.astype(F32)
    for j in range(CONV_WIDTH):
        xc = xc + xp[:, j:j + length] * conv_w[j]
    xb = xc.reshape(bsz, length, LRU_BLOCKS, LRU_BLOCK)
    h = 0.0
    for d in range(2):
        r = jax.nn.sigmoid(jnp.einsum('blnc,ncd->blnd', xb, w_a[d]).reshape(bsz, length, LRU_WIDTH) + b_a[d])
        i = jax.nn.sigmoid(jnp.einsum('blnc,ncd->blnd', xb, w_x[d]).reshape(bsz, length, LRU_WIDTH) + b_x[d])
        log_a = -LRU_C * r * jax.nn.softplus(-lam[d].astype(F32))
        a = jnp.exp(log_a)
        bt = jnp.sqrt(-jnp.expm1(2.0 * log_a)) * (i * xc)
        h = h + linear_scan(a, bt, axis=1, reverse=(d == 1))
    return h


def mixer_layer(z, norm_g, w_in, s5_lam_re, s5_lam_im, s5_log_step, s5_b_re, s5_b_im, s5_c_re, s5_c_im,
                s5_d, s5_w_glu, s5_b_glu, gla_w_gate_up, gla_b_gate, gla_norm_g, conv_w, conv_b,
                lru_w_a, lru_b_a, lru_w_x, lru_b_x, lru_lam, w_out_a, w_out_b, w_out_c, w_o):
    bsz, length, _ = z.shape
    h = rmsnorm(z, norm_g)
    cols = h @ w_in
    u_a, gate_a, q_b, k_b, v_b, gate_b, glr_b, x_c, gate_c, merge = split_cols(cols)
    y_a = s5_mixer(u_a, s5_lam_re, s5_lam_im, s5_log_step, s5_b_re, s5_b_im, s5_c_re, s5_c_im,
                   s5_d, s5_w_glu, s5_b_glu) * jax.nn.silu(gate_a)
    y_b = gla_mixer(q_b, k_b, v_b, glr_b, gla_w_gate_up, gla_b_gate, gla_norm_g) * jax.nn.silu(gate_b)
    y_c = rglru_mixer(x_c, conv_w, conv_b, lru_w_a, lru_b_a, lru_w_x, lru_b_x, lru_lam) * jax.nn.silu(gate_c)
    gates = jax.nn.sigmoid(merge).reshape(bsz, length, N_BRANCH, D_MODEL)
    m = (gates[:, :, 0] * (y_a @ w_out_a) + gates[:, :, 1] * (y_b @ w_out_b)
         + gates[:, :, 2] * (y_c @ w_out_c))
    return z + m @ w_o


def encoder(x, meta_tokens, layer_params, final_norm_g):
    bsz = x.shape[0]
    meta = jnp.broadcast_to(meta_tokens.astype(F32)[None], (bsz, N_META, D_MODEL))
    z = jnp.concatenate([meta, x.astype(F32)], axis=1)
    for l in range(DEPTH):
        z = mixer_layer(z, *[p[l] for p in layer_params])
    return rmsnorm(z, final_norm_g)[:, N_META:].astype(x.dtype)


def setup_inputs(seed: int = 0) -> dict:
    key = jax.random.key(seed)
    ks = jax.random.split(key, 40)
    nrm = lambda k, shape, scale: jax.random.normal(k, shape, F32) * scale
    lam_im_base = math.pi * jnp.arange(S5_STATE, dtype=F32)
    u_lru = jax.random.uniform(ks[24], (DEPTH, 2, LRU_WIDTH), F32, minval=0.9, maxval=0.999)
    a_base = u_lru ** (1.0 / LRU_C)
    return {
        'x_prompt': nrm(ks[0], (BATCH, SEQ, D_MODEL), 1.0),
        'x_sample': nrm(ks[1], (DEC_BATCH, DEC_SEQ, D_MODEL), 1.0),
        'meta_tokens': nrm(ks[2], (N_META, D_MODEL), 1.0),
        'norm_g': 1.0 + nrm(ks[3], (DEPTH, D_MODEL), 0.01),
        'w_in': nrm(ks[4], (DEPTH, D_MODEL, N_IN), D_MODEL ** -0.5),
        's5_lam_re': -0.5 + nrm(ks[5], (DEPTH, 2, S5_GROUPS, S5_STATE), 0.01),
        's5_lam_im': lam_im_base + nrm(ks[6], (DEPTH, 2, S5_GROUPS, S5_STATE), 0.01),
        's5_log_step': jax.random.uniform(ks[7], (DEPTH, 2, S5_GROUPS), F32,
                                          minval=math.log(1e-3), maxval=math.log(1e-1)),
        's5_b_re': nrm(ks[8], (DEPTH, S5_GROUPS, S5_STATE, S5_GROUP), (2 * S5_GROUP) ** -0.5),
        's5_b_im': nrm(ks[9], (DEPTH, S5_GROUPS, S5_STATE, S5_GROUP), (2 * S5_GROUP) ** -0.5),
        's5_c_re': nrm(ks[10], (DEPTH, 2, S5_GROUPS, S5_GROUP, S5_STATE), (2 * S5_STATE) ** -0.5),
        's5_c_im': nrm(ks[11], (DEPTH, 2, S5_GROUPS, S5_GROUP, S5_STATE), (2 * S5_STATE) ** -0.5),
        's5_d': nrm(ks[12], (DEPTH, S5_WIDTH), 1.0),
        's5_w_glu': nrm(ks[13], (DEPTH, S5_WIDTH, S5_WIDTH), S5_WIDTH ** -0.5),
        's5_b_glu': nrm(ks[14], (DEPTH, S5_WIDTH), 0.01),
        'gla_w_gate_up': nrm(ks[15], (DEPTH, 2, GLA_RANK, GLA_KEY), GLA_RANK ** -0.5),
        'gla_b_gate': nrm(ks[16], (DEPTH, 2, GLA_KEY), 0.01),
        'gla_norm_g': 1.0 + nrm(ks[17], (DEPTH, GLA_WIDTH), 0.01),
        'conv_w': nrm(ks[18], (DEPTH, CONV_WIDTH, LRU_WIDTH), CONV_WIDTH ** -0.5),
        'conv_b': nrm(ks[19], (DEPTH, LRU_WIDTH), 0.01),
        'lru_w_a': nrm(ks[20], (DEPTH, 2, LRU_BLOCKS, LRU_BLOCK, LRU_BLOCK), LRU_BLOCK ** -0.5),
        'lru_b_a': nrm(ks[21], (DEPTH, 2, LRU_WIDTH), 0.01),
        'lru_w_x': nrm(ks[22], (DEPTH, 2, LRU_BLOCKS, LRU_BLOCK, LRU_BLOCK), LRU_BLOCK ** -0.5),
        'lru_b_x': nrm(ks[23], (DEPTH, 2, LRU_WIDTH), 0.01),
        'lru_lam': jnp.log(a_base) - jnp.log1p(-a_base),
        'w_out_a': nrm(ks[25], (DEPTH, S5_WIDTH, D_MODEL), S5_WIDTH ** -0.5),
        'w_out_b': nrm(ks[26], (DEPTH, GLA_WIDTH, D_MODEL), GLA_WIDTH ** -0.5),
        'w_out_c': nrm(ks[27], (DEPTH, LRU_WIDTH, D_MODEL), LRU_WIDTH ** -0.5),
        'w_o': nrm(ks[28], (DEPTH, D_MODEL, D_MODEL), D_MODEL ** -0.5),
        'final_norm_g': 1.0 + nrm(ks[29], (D_MODEL,), 0.01),
    }


def reference(x_prompt, x_sample, meta_tokens, norm_g, w_in, s5_lam_re, s5_lam_im, s5_log_step,
              s5_b_re, s5_b_im, s5_c_re, s5_c_im, s5_d, s5_w_glu, s5_b_glu, gla_w_gate_up, gla_b_gate,
              gla_norm_g, conv_w, conv_b, lru_w_a, lru_b_a, lru_w_x, lru_b_x, lru_lam,
              w_out_a, w_out_b, w_out_c, w_o, final_norm_g):
    layer_params = (norm_g, w_in, s5_lam_re, s5_lam_im, s5_log_step, s5_b_re, s5_b_im, s5_c_re, s5_c_im,
                    s5_d, s5_w_glu, s5_b_glu, gla_w_gate_up, gla_b_gate, gla_norm_g, conv_w, conv_b,
                    lru_w_a, lru_b_a, lru_w_x, lru_b_x, lru_lam, w_out_a, w_out_b, w_out_c, w_o)
    y_prompt = encoder(x_prompt, meta_tokens, layer_params, final_norm_g)
    y_sample = encoder(x_sample, meta_tokens, layer_params, final_norm_g)
    return (y_prompt, y_sample)
```

```cpp
#include <hip/hip_runtime.h>
#include <hip/hip_cooperative_groups.h>
#include <cstdio>
namespace cg = cooperative_groups;
#define LAS __attribute__((address_space(3)))
typedef unsigned short bf16_t;
typedef short bf16x8 __attribute__((ext_vector_type(8)));
typedef float f32x4 __attribute__((ext_vector_type(4)));
typedef float f32x2 __attribute__((ext_vector_type(2)));
typedef unsigned u32x2 __attribute__((ext_vector_type(2)));
typedef unsigned u32x4 __attribute__((ext_vector_type(4)));

constexpr int D = 2048, NTOK = 24736, MP = 24832, NINP = 11008, NIN = 10784;
constexpr int NCH16 = 1546, CHP = 1792, NCK = 394;
constexpr int C_GA = 512, C_Q = 1024, C_K = 1280, C_V = 1536, C_GB = 2048, C_XC = 2560, C_GC = 3584, C_MG = 4608, C_GLR = 10752;
constexpr int LDS_BYTES = 150528 + 16;
#ifndef SYNCREP
#define SYNCREP 1
#endif
#ifndef DUP
#define DUP -1
#endif
#ifndef SUBM
#define SUBM 7
#endif
#ifndef PHM
#define PHM 255
#endif

constexpr size_t al256(size_t x) { return (x + 255) & ~(size_t)255; }
constexpr size_t WS_Z = 0;
constexpr size_t WS_H = WS_Z + al256((size_t)MP * D * 4);
constexpr size_t WS_COLS = WS_H + al256((size_t)MP * D * 2);
constexpr size_t WS_YALL = WS_COLS + al256((size_t)MP * NINP * 2);
constexpr size_t WS_ZS5 = WS_YALL + al256((size_t)MP * D * 2);
constexpr size_t WS_UBUF = WS_ZS5 + al256((size_t)MP * 512 * 2);
constexpr size_t WS_ST = WS_UBUF + al256((size_t)32 * CHP * 512 * 2);
constexpr size_t WS_DS = WS_ST + al256((size_t)32 * CHP * 256 * 4);
constexpr size_t WS_M32 = WS_UBUF;
constexpr size_t WS_DECAY = WS_DS + al256((size_t)NCK * 4 * 2 * 8192 * 4);
constexpr size_t WS_LRUA = WS_DECAY + al256((size_t)NCK * 4 * 2 * 64 * 4);
constexpr size_t WS_LRUH = WS_LRUA + al256((size_t)NCK * 2 * 1024 * 4);
constexpr size_t WS_LRUC = WS_LRUH + al256((size_t)NCK * 2 * 1024 * 4);
constexpr size_t WS_PW = WS_LRUC + al256((size_t)NCK * 2 * 1024 * 4);
constexpr size_t WS_BBAR = WS_PW + al256((size_t)4 * 32 * 2 * 17 * 64 * 8);
constexpr size_t WS_WMAT = WS_BBAR + al256((size_t)4 * 32 * 2 * 64 * 16 * 8);
constexpr size_t WS_PMAT = WS_WMAT + al256((size_t)32 * 256 * 512 * 2);
constexpr size_t WS_BTIN = WS_PMAT + al256((size_t)32 * 256 * 256 * 2);
constexpr size_t WS_BTOUT = WS_BTIN + al256((size_t)NINP * D * 2);
constexpr size_t WS_BTO = WS_BTOUT + al256((size_t)D * D * 2);
constexpr size_t WS_BTGLU = WS_BTO + al256((size_t)D * D * 2);
constexpr size_t WS_BTLRU = WS_BTGLU + al256((size_t)512 * 512 * 2);
constexpr size_t WS_KMAT = WS_BTLRU + al256((size_t)32 * 128 * 128 * 2);
constexpr size_t WS_BAR = WS_KMAT + al256((size_t)32 * 2 * 16 * 256 * 4);
constexpr size_t WS_END = WS_BAR + al256((size_t)3456 * 4);
constexpr size_t PWL = (size_t)32 * 2 * 17 * 64, BBL = (size_t)32 * 2 * 64 * 16;
static_assert(WS_END <= (size_t)1413480448, "workspace too large");
static_assert((size_t)MP * D * 4 <= WS_DECAY - WS_UBUF, "m32 alias too small");

struct Params { const float* in[30]; float* out; unsigned char* ws; int ph_lo, ph_hi, use_sync, pad; };

#define LBAR() do { asm volatile("s_waitcnt lgkmcnt(0)" ::: "memory"); __builtin_amdgcn_s_barrier(); asm volatile("" ::: "memory"); } while (0)
__device__ __forceinline__ unsigned cvt_pk_bf16(float lo, float hi) { unsigned r; asm volatile("v_cvt_pk_bf16_f32 %0, %1, %2" : "=v"(r) : "v"(lo), "v"(hi)); return r; }
__device__ __forceinline__ bf16_t f2bf(float f) { return (bf16_t)(cvt_pk_bf16(f, 0.f) & 0xffffu); }
__device__ __forceinline__ float bf2f(bf16_t b) { return __uint_as_float(((unsigned)b) << 16); }
__device__ __forceinline__ float bflo(unsigned w) { return __uint_as_float(w << 16); }
__device__ __forceinline__ float bfhi(unsigned w) { return __uint_as_float(w & 0xffff0000u); }
__device__ __forceinline__ float sigm(float x) { return __builtin_amdgcn_rcpf(1.0f + __expf(-x)); }
__device__ __forceinline__ float silu(float x) { return x * sigm(x); }
__device__ __forceinline__ float gelu_t(float x) { const float u = 0.7978845608028654f * (x + 0.044715f * x * x * x); return x * sigm(2.0f * u); }
__device__ __forceinline__ float logsig(float x) { return -(fmaxf(-x, 0.f) + __logf(1.0f + __expf(-fabsf(x)))); }

__device__ __forceinline__ int seq_start(int s) { return s < 2 ? s * 4112 : 8224 + (s - 2) * 2064; }
__device__ __forceinline__ int seq_len(int s) { return s < 2 ? 4112 : 2064; }
__device__ __forceinline__ void chunk_info(int ci, int& seq, int& c) { if (ci < 130) { seq = ci / 65; c = ci - seq * 65; } else { const int t = ci - 130; const int q = t / 33; seq = 2 + q; c = t - q * 33; } }

constexpr int BM = 256, BK = 64, HALF = 128, HTB = HALF * BK * 2, STAGE_BYTES = 8 * HTB, NXCD = 8, WGM = 8;
__device__ __forceinline__ int lds_byte(int r, int c) { const int st = (r >> 4) * 2 + (c >> 5), rr = r & 15, cc = c & 31, ob = rr * 64 + cc * 2; return st * 1024 + (ob ^ (((ob >> 9) & 1) << 5)); }
__device__ __forceinline__ void stage_rc(int b, int& R, int& C) { const int st = b / 1024, sb = b % 1024, swz = sb ^ (((sb >> 9) & 1) << 5); R = (st >> 1) * 16 + swz / 64; C = (st & 1) * 32 + (swz % 64) / 2; }

struct Unit { int pm, pn, sub, nt; const char* a; const char* b; };

struct TileOrder {
    int nM, nN, nwg, G, c, mult, nt0; const char* A; const char* B; size_t tA, tB;
    __device__ __forceinline__ bool next(int i, Unit& u) const {
        const int ti = i / mult, sub = i - ti * mult;
        const long L = (long)ti * G + c; if (L >= nwg) return false;
        int wgid = (int)L; { const int q = nwg / NXCD, r = nwg % NXCD, xcd = wgid % NXCD, off = wgid / NXCD; wgid = (xcd < r ? xcd * (q + 1) : r * (q + 1) + (xcd - r) * q) + off; }
        const int nig = WGM * nN, gid = wgid / nig, fm = gid * WGM, gsz = (nM - fm) < WGM ? (nM - fm) : WGM;
        u.pm = fm + ((wgid % nig) % gsz); u.pn = (wgid % nig) / gsz; u.sub = sub;
        const int koff = (mult == 3) ? sub * 512 : 0; u.nt = (mult == 3) ? (sub == 2 ? 16 : 8) : nt0;
        u.a = A + (size_t)u.pm * tA + (size_t)koff * 2; u.b = B + (size_t)u.pn * tB + (size_t)koff * 2; return true;
    }
};
struct GroupOrder {
    int G, c, nt0; const char* A; const char* B; size_t gsA, gsB, tA;
    __device__ __forceinline__ bool next(int i, Unit& u) const {
        const int L = i * G + c; if (L >= 224) return false;
        const int g = L / 7, pm = L - g * 7; u.pm = pm; u.pn = 0; u.sub = g; u.nt = nt0;
        u.a = A + (size_t)g * gsA + (size_t)pm * tA; u.b = B + (size_t)g * gsB; return true;
    }
};

__device__ __forceinline__ int perm32(int rho) { const int n = rho >> 4, i = rho & 15; return 8 * (i >> 2) + 4 * n + (i & 3); }
template <class Epi, class Sched>
__device__ __forceinline__ void gemm_phase(const int TID, LAS unsigned char* lds, const int lda, const int ldb, const Sched& S, const Epi& E) {
    const int tid = TID, wid = __builtin_amdgcn_readfirstlane(tid >> 6), lane = tid & 63, wr = wid >> 2, wc = wid & 3, fr = lane & 15, fq = lane >> 4;
    unsigned voffA[2], voffB[2];
#pragma unroll
    for (int i = 0; i < 2; ++i) { int R, C; stage_rc(tid * 16 + i * 8192, R, C); const int Rb = Epi::PERM ? ((R & ~31) + perm32(R & 31)) : R; voffA[i] = (unsigned)(R * lda + C) * 2u; voffB[i] = (unsigned)(Rb * ldb + C) * 2u; }
    const size_t kstep = (size_t)(BK * 2);
    const size_t hA = (size_t)HALF * lda * 2, hB = (size_t)HALF * ldb * 2;
    const unsigned ldsw = (unsigned)wid * 1024u;
    const int aoff = lds_byte(wr * 64 + fr, fq * 8), boff = lds_byte(wc * 32 + fr, fq * 8);
#define PG8_SA(b, h) (((b) * 2 + (h)) * HTB)
#define PG8_SB(b, h) ((4 + (b) * 2 + (h)) * HTB)
#define PG8_STAGE(bufoff, gbase, voff) do { _Pragma("unroll") for (int _i = 0; _i < 2; ++_i) \
        __builtin_amdgcn_global_load_lds((const unsigned*)((const char*)(gbase) + (voff)[_i]), (LAS unsigned*)(lds + (bufoff) + ldsw + _i * 8192), 16, 0, 0); } while (0)
#define PG8_LDA(dst, b, h) do { _Pragma("unroll") for (int m = 0; m < 4; ++m) _Pragma("unroll") for (int k = 0; k < 2; ++k) dst[m][k] = *(const LAS bf16x8*)(lds + PG8_SA(b, h) + aoff + m * 2048 + k * 1024); } while (0)
#define PG8_LDB(dst, b, h) do { _Pragma("unroll") for (int n = 0; n < 2; ++n) _Pragma("unroll") for (int k = 0; k < 2; ++k) dst[n][k] = *(const LAS bf16x8*)(lds + PG8_SB(b, h) + boff + n * 2048 + k * 1024); } while (0)
#define PG8_MMA(ai, bj, At, Bt) do { __builtin_amdgcn_s_setprio(1); _Pragma("unroll") for (int m = 0; m < 4; ++m) _Pragma("unroll") for (int n = 0; n < 2; ++n) _Pragma("unroll") for (int k = 0; k < 2; ++k) \
        acc[ai][bj][m][n] = __builtin_amdgcn_mfma_f32_16x16x32_bf16(Bt[n][k], At[m][k], acc[ai][bj][m][n], 0, 0, 0); __builtin_amdgcn_s_setprio(0); } while (0)
#define PG8_WAIT_V(n) asm volatile("s_waitcnt vmcnt(" #n ")" ::: "memory")
#define PG8_WAIT_L(n) asm volatile("s_waitcnt lgkmcnt(" #n ")" ::: "memory")
#define PG8_BAR __builtin_amdgcn_s_barrier()
#define PG8_SCHED __builtin_amdgcn_sched_barrier(0)
    Unit cur, nxt; int ui = 0;
    if (!S.next(0, cur)) return;
    f32x4 acc[2][2][4][2];
#pragma unroll
    for (int a = 0; a < 2; ++a)
#pragma unroll
        for (int b = 0; b < 2; ++b)
#pragma unroll
            for (int m = 0; m < 4; ++m)
#pragma unroll
                for (int n = 0; n < 2; ++n) acc[a][b][m][n] = (f32x4){0.f, 0.f, 0.f, 0.f};
    bf16x8 At[4][2], B0[2][2], B1[2][2];
    const char* cA = cur.a; const char* cB = cur.b;
    PG8_STAGE(PG8_SB(0, 0), cB, voffB); PG8_STAGE(PG8_SA(0, 0), cA, voffA); PG8_STAGE(PG8_SB(0, 1), cB + hB, voffB); PG8_STAGE(PG8_SA(0, 1), cA + hA, voffA);
    if (wr == 1) PG8_BAR;
    PG8_WAIT_V(4); PG8_BAR;
    PG8_STAGE(PG8_SB(1, 0), cB + kstep, voffB); PG8_STAGE(PG8_SA(1, 0), cA + kstep, voffA); PG8_STAGE(PG8_SB(1, 1), cB + hB + kstep, voffB);
    PG8_WAIT_V(6); PG8_BAR;
    for (;;) {
        const bool has_next = S.next(ui + 1, nxt);
        const char* nA = has_next ? nxt.a : cA; const char* nB = has_next ? nxt.b : cB;
        const int nt = cur.nt;
        for (int t = 0; t < nt; t += 2) {
            const bool last = (t == nt - 2);
            const char* a1 = cA + (size_t)(t + 1) * kstep;
            const char* a2 = last ? nA : cA + (size_t)(t + 2) * kstep; const char* b2 = last ? nB : cB + (size_t)(t + 2) * kstep;
            const char* a3 = a2 + kstep; const char* b3 = b2 + kstep;
            PG8_LDB(B0, 0, 0); PG8_SCHED; PG8_LDA(At, 0, 0); PG8_STAGE(PG8_SA(1, 1), a1 + hA, voffA);
            PG8_WAIT_L(8); PG8_BAR; PG8_WAIT_L(0); PG8_MMA(0, 0, At, B0); PG8_BAR; PG8_SCHED;
            PG8_LDB(B1, 0, 1); PG8_STAGE(PG8_SB(0, 0), b2, voffB);
            PG8_BAR; PG8_WAIT_L(0); PG8_MMA(0, 1, At, B1); PG8_BAR;
            PG8_LDA(At, 0, 1); PG8_STAGE(PG8_SA(0, 0), a2, voffA);
            PG8_BAR; PG8_WAIT_L(0); PG8_MMA(1, 0, At, B0); PG8_BAR; PG8_SCHED;
            PG8_STAGE(PG8_SB(0, 1), b2 + hB, voffB);
            PG8_WAIT_V(6); PG8_BAR; PG8_MMA(1, 1, At, B1); PG8_BAR;
            PG8_LDB(B0, 1, 0); PG8_SCHED; PG8_LDA(At, 1, 0); PG8_STAGE(PG8_SA(0, 1), a2 + hA, voffA);
            PG8_WAIT_L(8); PG8_BAR; PG8_WAIT_L(0); PG8_MMA(0, 0, At, B0); PG8_BAR; PG8_SCHED;
            PG8_LDB(B1, 1, 1); PG8_STAGE(PG8_SB(1, 0), b3, voffB);
            PG8_BAR; PG8_WAIT_L(0); PG8_MMA(0, 1, At, B1); PG8_BAR;
            PG8_LDA(At, 1, 1); PG8_STAGE(PG8_SA(1, 0), a3, voffA);
            PG8_BAR; PG8_WAIT_L(0); PG8_MMA(1, 0, At, B0); PG8_BAR; PG8_SCHED;
            PG8_STAGE(PG8_SB(1, 1), b3 + hB, voffB);
            PG8_WAIT_V(6); PG8_BAR; PG8_MMA(1, 1, At, B1); PG8_BAR;
        }
        E(acc, cur, wr, wc, fr, fq);
        if (!has_next) break;
#pragma unroll
        for (int a = 0; a < 2; ++a)
#pragma unroll
            for (int b = 0; b < 2; ++b)
#pragma unroll
                for (int m = 0; m < 4; ++m)
#pragma unroll
                    for (int n = 0; n < 2; ++n) acc[a][b][m][n] = (f32x4){0.f, 0.f, 0.f, 0.f};
        cur = nxt; cA = nA; cB = nB; ++ui;
    }
    PG8_WAIT_V(0);
    if (wr == 0) PG8_BAR;
    PG8_BAR;
#undef PG8_SA
#undef PG8_SB
#undef PG8_STAGE
#undef PG8_LDA
#undef PG8_LDB
#undef PG8_MMA
#undef PG8_WAIT_V
#undef PG8_WAIT_L
#undef PG8_BAR
#undef PG8_SCHED
}

#define EPI_LOOP(...) \
    const int row0 = u.pm * BM + wr * 64 + fr, col0 = u.pn * BM + wc * 32 + 4 * fq; \
    _Pragma("unroll") for (int ai = 0; ai < 2; ++ai) _Pragma("unroll") for (int m = 0; m < 4; ++m) { const int r = row0 + ai * HALF + m * 16; \
        _Pragma("unroll") for (int bj = 0; bj < 2; ++bj) _Pragma("unroll") for (int n = 0; n < 2; ++n) { const int c = col0 + bj * HALF + n * 16; const f32x4 v = acc[ai][bj][m][n]; __VA_ARGS__ } }

#define EPI_PROWS(...) \
    const int row0 = u.pm * BM + wr * 64 + fr, col0 = u.pn * BM + wc * 32 + 8 * fq; \
    _Pragma("unroll") for (int ai = 0; ai < 2; ++ai) _Pragma("unroll") for (int m = 0; m < 4; ++m) { const int r = row0 + ai * HALF + m * 16; __VA_ARGS__ }
__device__ __forceinline__ u32x4 pack8(const f32x4 a, const f32x4 b) { u32x4 w; w[0] = cvt_pk_bf16(a[0], a[1]); w[1] = cvt_pk_bf16(a[2], a[3]); w[2] = cvt_pk_bf16(b[0], b[1]); w[3] = cvt_pk_bf16(b[2], b[3]); return w; }
__device__ __forceinline__ unsigned q8(float x) { return (unsigned)__float2uint_rn(sigm(x) * 255.0f); }
__device__ __forceinline__ unsigned q8x4(const f32x4 v) { return q8(v[0]) | (q8(v[1]) << 8) | (q8(v[2]) << 16) | (q8(v[3]) << 24); }
struct EpiIn { static constexpr bool PERM = true; bf16_t* cols; bf16_t* ubuf;
    __device__ __forceinline__ void operator()(const f32x4 (&acc)[2][2][4][2], const Unit& u, int wr, int wc, int fr, int fq) const {
        if (u.pn >= 18 && u.pn < 42) {
            EPI_PROWS({ u32x4 w; w[0] = q8x4(acc[ai][0][m][0]); w[1] = q8x4(acc[ai][0][m][1]); w[2] = q8x4(acc[ai][1][m][0]); w[3] = q8x4(acc[ai][1][m][1]);
                *(u32x4*)((unsigned char*)(cols + (size_t)r * NINP + C_MG) + (u.pn - 18) * 256 + (wc * 4 + fq) * 16) = w; })
        } else {
            EPI_PROWS({ _Pragma("unroll") for (int bj = 0; bj < 2; ++bj) { const int c = col0 + bj * HALF;
                bf16_t* dst = (u.pn < 2) ? ubuf + ((size_t)((c >> 4) * CHP + (r >> 4)) * 512 + (r & 15) * 16 + (c & 15)) : cols + (size_t)r * NINP + c;
                *(u32x4*)dst = pack8(acc[ai][bj][m][0], acc[ai][bj][m][1]); } })
        }
    } };
struct EpiS5State { static constexpr bool PERM = false; float* st;
    __device__ __forceinline__ void operator()(const f32x4 (&acc)[2][2][4][2], const Unit& u, int wr, int wc, int fr, int fq) const {
        EPI_LOOP({ *(f32x4*)(st + ((size_t)(u.sub * CHP + r)) * 256 + c) = v; })
    } };
struct EpiS5Out { static constexpr bool PERM = true; bf16_t* zs5;
    __device__ __forceinline__ void operator()(const f32x4 (&acc)[2][2][4][2], const Unit& u, int wr, int wc, int fr, int fq) const {
        EPI_PROWS({ if (r < NCH16) { _Pragma("unroll") for (int bj = 0; bj < 2; ++bj) { const int c = col0 + bj * HALF; f32x4 a = acc[ai][bj][m][0], b2 = acc[ai][bj][m][1];
            _Pragma("unroll") for (int e = 0; e < 4; ++e) { a[e] = gelu_t(a[e]); b2[e] = gelu_t(b2[e]); }
            *(u32x4*)(zs5 + (size_t)(r * 16 + (c >> 4)) * 512 + u.sub * 16 + (c & 15)) = pack8(a, b2); } } })
    } };
#define EPI_ROWS(...) \
    const int row0 = u.pm * BM + wr * 64 + fr, col0 = u.pn * BM + wc * 32 + 4 * fq; \
    _Pragma("unroll") for (int ai = 0; ai < 2; ++ai) _Pragma("unroll") for (int m = 0; m < 4; ++m) { const int r = row0 + ai * HALF + m * 16; __VA_ARGS__ }
#define QOFF(q) (((q) >> 1) * HALF + ((q) & 1) * 16)
#define EPI_PIPE(LOADF, COMPF) \
    const int row0 = u.pm * BM + wr * 64 + fr, col0 = u.pn * BM + wc * 32 + 8 * fq; \
    LOADF(0, 0); \
    _Pragma("unroll") for (int gi = 0; gi < 8; ++gi) { if (gi + 1 < 8) { if ((gi & 1) == 0) { LOADF(gi + 1, 1); } else { LOADF(gi + 1, 0); } } if ((gi & 1) == 0) { COMPF(gi, 0); } else { COMPF(gi, 1); } }
#define GROW(gi) (row0 + ((gi) >> 2) * HALF + ((gi) & 3) * 16)
struct EpiGlu { static constexpr bool PERM = true; const bf16_t* zs5; const bf16_t* cols; const float* bglu; bf16_t* yall;
    __device__ __forceinline__ void operator()(const f32x4 (&acc)[2][2][4][2], const Unit& u, int wr, int wc, int fr, int fq) const {
        u32x4 zz[2][2], gg[2][2]; f32x4 bb[2][2];
        { const int c0 = u.pn * BM + wc * 32 + 8 * fq; _Pragma("unroll") for (int bj = 0; bj < 2; ++bj) { bb[bj][0] = *(const f32x4*)(bglu + c0 + bj * HALF); bb[bj][1] = *(const f32x4*)(bglu + c0 + bj * HALF + 4); } }
#define GLU_LOAD(gi, bf) do { const int r_ = GROW(gi); _Pragma("unroll") for (int bj = 0; bj < 2; ++bj) { const int c = col0 + bj * HALF; zz[bf][bj] = *(const u32x4*)(zs5 + (size_t)r_ * 512 + c); gg[bf][bj] = *(const u32x4*)(cols + (size_t)r_ * NINP + C_GA + c); } } while (0)
#define GLU_COMP(gi, bf) do { const int r_ = GROW(gi); _Pragma("unroll") for (int bj = 0; bj < 2; ++bj) { const int c = col0 + bj * HALF; f32x4 o[2]; \
            _Pragma("unroll") for (int hf = 0; hf < 2; ++hf) { const f32x4 v = acc[(gi) >> 2][bj][(gi) & 3][hf]; \
                o[hf][0] = bflo(zz[bf][bj][2 * hf]) * sigm(v[0] + bb[bj][hf][0]) * silu(bflo(gg[bf][bj][2 * hf])); o[hf][1] = bfhi(zz[bf][bj][2 * hf]) * sigm(v[1] + bb[bj][hf][1]) * silu(bfhi(gg[bf][bj][2 * hf])); \
                o[hf][2] = bflo(zz[bf][bj][2 * hf + 1]) * sigm(v[2] + bb[bj][hf][2]) * silu(bflo(gg[bf][bj][2 * hf + 1])); o[hf][3] = bfhi(zz[bf][bj][2 * hf + 1]) * sigm(v[3] + bb[bj][hf][3]) * silu(bfhi(gg[bf][bj][2 * hf + 1])); } \
            *(u32x4*)(yall + (size_t)r_ * D + c) = pack8(o[0], o[1]); } } while (0)
        EPI_PIPE(GLU_LOAD, GLU_COMP)
#undef GLU_LOAD
#undef GLU_COMP
    } };
__device__ __forceinline__ float ub(unsigned w, int k) { return (float)((w >> (8 * k)) & 255u) * (1.0f / 255.0f); }
struct EpiOut { static constexpr bool PERM = true; const bf16_t* cols; bf16_t* mbf;
    __device__ __forceinline__ void operator()(const f32x4 (&acc)[2][2][4][2], const Unit& u, int wr, int wc, int fr, int fq) const {
        u32x4 gg[2], mm[2][2];
#define OUT_LOAD(gi, bf) do { const int r_ = GROW(gi); const bf16_t* mp = mbf + (size_t)r_ * D + col0; \
            gg[bf] = *(const u32x4*)((const unsigned char*)(cols + (size_t)r_ * NINP + C_MG) + (u.sub * 8 + u.pn) * 256 + (wc * 4 + fq) * 16); \
            _Pragma("unroll") for (int bj = 0; bj < 2; ++bj) { mm[bf][bj] = (u32x4){0u, 0u, 0u, 0u}; if (u.sub != 0) mm[bf][bj] = *(const u32x4*)(mp + bj * HALF); } } while (0)
#define OUT_COMP(gi, bf) do { const int r_ = GROW(gi); bf16_t* mp = mbf + (size_t)r_ * D + col0; _Pragma("unroll") for (int bj = 0; bj < 2; ++bj) { f32x4 o[2]; \
            _Pragma("unroll") for (int hf = 0; hf < 2; ++hf) { const f32x4 v = acc[(gi) >> 2][bj][(gi) & 3][hf]; const unsigned gw = gg[bf][bj * 2 + hf]; \
                o[hf][0] = bflo(mm[bf][bj][2 * hf]) + ub(gw, 0) * v[0]; o[hf][1] = bfhi(mm[bf][bj][2 * hf]) + ub(gw, 1) * v[1]; \
                o[hf][2] = bflo(mm[bf][bj][2 * hf + 1]) + ub(gw, 2) * v[2]; o[hf][3] = bfhi(mm[bf][bj][2 * hf + 1]) + ub(gw, 3) * v[3]; } \
            *(u32x4*)(mp + bj * HALF) = pack8(o[0], o[1]); } } while (0)
        EPI_PIPE(OUT_LOAD, OUT_COMP)
#undef OUT_LOAD
#undef OUT_COMP
    } };
struct EpiWo { static constexpr bool PERM = false; float* z;
    __device__ __forceinline__ void operator()(const f32x4 (&acc)[2][2][4][2], const Unit& u, int wr, int wc, int fr, int fq) const {
        EPI_ROWS({ if (r < NTOK) { float* zp = z + (size_t)r * D + col0; f32x4 pv[4];
            _Pragma("unroll") for (int q = 0; q < 4; ++q) pv[q] = *(const f32x4*)(zp + QOFF(q));
            _Pragma("unroll") for (int q = 0; q < 4; ++q) *(f32x4*)(zp + QOFF(q)) = pv[q] + acc[ai][q >> 1][m][q & 1]; } })
    } };

__device__ __forceinline__ const float* src_row(const Params& p, int r) {
    int s, pos; if (r < 8224) { s = r / 4112; pos = r - s * 4112; } else { const int t = r - 8224; const int q = t / 2064; s = 2 + q; pos = t - q * 2064; }
    if (pos < 16) return p.in[2] + (size_t)pos * D;
    return s < 2 ? p.in[0] + ((size_t)s * 4096 + (pos - 16)) * D : p.in[1] + ((size_t)(s - 2) * 2048 + (pos - 16)) * D;
}
__device__ __forceinline__ void rmsnorm_phase(const int TID, const int BID, const Params& p, int l) {
    float* z = (float*)(p.ws + WS_Z); bf16_t* h = (bf16_t*)(p.ws + WS_H); const float* g = p.in[3] + (size_t)l * D;
    const int lane = TID & 63, gw = BID * 8 + (TID >> 6), nw = gridDim.x * 8;
    f32x4 gg[8];
#pragma unroll
    for (int i = 0; i < 8; ++i) gg[i] = *(const f32x4*)(g + (i * 64 + lane) * 4);
    f32x4 xn[8];
    { const int r0 = gw < NTOK ? gw : NTOK - 1; const float* src = (l == 0) ? src_row(p, r0) : z + (size_t)r0 * D;
#pragma unroll
      for (int i = 0; i < 8; ++i) xn[i] = *(const f32x4*)(src + (i * 64 + lane) * 4); }
    for (int r = gw; r < MP; r += nw) {
        bf16_t* hr = h + (size_t)r * D;
        f32x4 x[8];
#pragma unroll
        for (int i = 0; i < 8; ++i) x[i] = xn[i];
        { const int rn = (r + nw < NTOK) ? r + nw : NTOK - 1; const float* src = (l == 0) ? src_row(p, rn) : z + (size_t)rn * D;
#pragma unroll
          for (int i = 0; i < 8; ++i) xn[i] = *(const f32x4*)(src + (i * 64 + lane) * 4); }
        if (r >= NTOK) { for (int i = 0; i < 4; ++i) *(u32x4*)(hr + (i * 64 + lane) * 8) = (u32x4){0u, 0u, 0u, 0u}; continue; }
        float ss = 0.f;
#pragma unroll
        for (int i = 0; i < 8; ++i) ss += x[i][0] * x[i][0] + x[i][1] * x[i][1] + x[i][2] * x[i][2] + x[i][3] * x[i][3];
#pragma unroll
        for (int o = 32; o >= 1; o >>= 1) ss += __shfl_xor(ss, o);
        const float rs = rsqrtf(ss * (1.0f / D) + 1e-6f);
#pragma unroll
        for (int i = 0; i < 8; ++i) { const int c = (i * 64 + lane) * 4;
            if (l == 0) *(f32x4*)(z + (size_t)r * D + c) = x[i];
            u32x2 w; w.x = cvt_pk_bf16(x[i][0] * rs * gg[i][0], x[i][1] * rs * gg[i][1]); w.y = cvt_pk_bf16(x[i][2] * rs * gg[i][2], x[i][3] * rs * gg[i][3]); *(u32x2*)(hr + c) = w; }
    }
}
__device__ __forceinline__ void final_norm_phase(const int TID, const int BID, const Params& p) {
    const float* z = (const float*)(p.ws + WS_Z); const float* g = p.in[29];
    const int lane = TID & 63, gw = BID * 8 + (TID >> 6), nw = gridDim.x * 8;
    for (int r = gw; r < NTOK; r += nw) {
        int s, pos; if (r < 8224) { s = r / 4112; pos = r - s * 4112; } else { const int t = r - 8224; const int q = t / 2064; s = 2 + q; pos = t - q * 2064; }
        if (pos < 16) continue;
        float* dst = s < 2 ? p.out + ((size_t)s * 4096 + (pos - 16)) * D : p.out + (size_t)2 * 4096 * D + ((size_t)(s - 2) * 2048 + (pos - 16)) * D;
        const float* src = z + (size_t)r * D;
        f32x4 x[8]; float ss = 0.f;
#pragma unroll
        for (int i = 0; i < 8; ++i) { x[i] = *(const f32x4*)(src + (i * 64 + lane) * 4); ss += x[i][0] * x[i][0] + x[i][1] * x[i][1] + x[i][2] * x[i][2] + x[i][3] * x[i][3]; }
#pragma unroll
        for (int o = 32; o >= 1; o >>= 1) ss += __shfl_xor(ss, o);
        const float rs = rsqrtf(ss * (1.0f / D) + 1e-6f);
#pragma unroll
        for (int i = 0; i < 8; ++i) { const int c = (i * 64 + lane) * 4; const f32x4 gg = *(const f32x4*)(g + c); f32x4 o; o[0] = x[i][0] * rs * gg[0]; o[1] = x[i][1] * rs * gg[1]; o[2] = x[i][2] * rs * gg[2]; o[3] = x[i][3] * rs * gg[3]; *(f32x4*)(dst + c) = o; }
    }
}
__device__ __forceinline__ void conv_tile(const int TID, const float* src, int ldn, int k0, int n0, int nvalid, bf16_t* dst, int ldd, int kofs, bool mapin, LAS float* tile) {
    const int tx = TID & 63, ty = TID >> 6;
    const int ncl = (n0 + tx < nvalid) ? n0 + tx : nvalid - 1;
#pragma unroll
    for (int i = 0; i < 8; ++i) { const int k = ty + 8 * i; tile[k * 65 + tx] = src[(size_t)(k0 + k) * ldn + ncl]; }
    __syncthreads();
#pragma unroll
    for (int i = 0; i < 8; ++i) { const int nn = ty + 8 * i; int n = n0 + nn;
        if (n < nvalid) { if (mapin) n = (n < 2560) ? n : (n < 2592 ? n + (C_GLR - 2560) : n - 32); dst[(size_t)n * ldd + kofs + k0 + tx] = f2bf(tile[tx * 65 + nn]); } }
    __syncthreads();
}
__device__ __forceinline__ void convert_weights(const int TID, const int BID, const Params& p, int l, LAS float* tile) {
    const int G = gridDim.x, b = BID;
    bf16_t* btin = (bf16_t*)(p.ws + WS_BTIN); bf16_t* btout = (bf16_t*)(p.ws + WS_BTOUT); bf16_t* bto = (bf16_t*)(p.ws + WS_BTO); bf16_t* btglu = (bf16_t*)(p.ws + WS_BTGLU); bf16_t* btlru = (bf16_t*)(p.ws + WS_BTLRU);
    { const float* src = p.in[4] + (size_t)l * D * NIN; const int tx = TID & 63, ty = TID >> 6; float v[8];
      { const int t = b < 32 * 169 ? b : 0; const int kt = t / 169, ntl = t - kt * 169; const int ncl = (ntl * 64 + tx < NIN) ? ntl * 64 + tx : NIN - 1;
#pragma unroll
        for (int i = 0; i < 8; ++i) v[i] = src[(size_t)(kt * 64 + ty + 8 * i) * NIN + ncl]; }
      for (int t = b; t < 32 * 169; t += G) { const int kt = t / 169, ntl = t - kt * 169, k0 = kt * 64, n0 = ntl * 64;
#pragma unroll
          for (int i = 0; i < 8; ++i) tile[(ty + 8 * i) * 65 + tx] = v[i];
          { const int tn = (t + G < 32 * 169) ? t + G : t; const int ktn = tn / 169, ntn = tn - ktn * 169; const int ncl = (ntn * 64 + tx < NIN) ? ntn * 64 + tx : NIN - 1;
#pragma unroll
            for (int i = 0; i < 8; ++i) v[i] = src[(size_t)(ktn * 64 + ty + 8 * i) * NIN + ncl]; }
          LBAR();
#pragma unroll
          for (int i = 0; i < 8; ++i) { const int nn = ty + 8 * i; int n = n0 + nn;
              if (n < NIN) { n = (n < 2560) ? n : (n < 2592 ? n + (C_GLR - 2560) : n - 32); btin[(size_t)n * D + k0 + tx] = f2bf(tile[tx * 65 + nn]); } }
          LBAR(); } }
    for (size_t i = (size_t)b * 512 + TID; i < (size_t)(NINP - NIN) * D / 8; i += (size_t)G * 512) *(u32x4*)(btin + (size_t)NIN * D + i * 8) = (u32x4){0u, 0u, 0u, 0u};
    { const float* src = p.in[25] + (size_t)l * 512 * D; for (int t = (b + 64) % G; t < 8 * 32; t += G) { const int kt = t / 32, ntl = t - kt * 32; conv_tile(TID, src, D, kt * 64, ntl * 64, D, btout, D, 0, false, tile); } }
    { const float* src = p.in[26] + (size_t)l * 512 * D; for (int t = (b + 128) % G; t < 8 * 32; t += G) { const int kt = t / 32, ntl = t - kt * 32; conv_tile(TID, src, D, kt * 64, ntl * 64, D, btout, D, 512, false, tile); } }
    { const float* src = p.in[27] + (size_t)l * 1024 * D; for (int t = b; t < 16 * 32; t += G) { const int kt = t / 32, ntl = t - kt * 32; conv_tile(TID, src, D, kt * 64, ntl * 64, D, btout, D, 1024, false, tile); } }
    { const float* src = p.in[28] + (size_t)l * D * D; for (int t = b; t < 32 * 32; t += G) { const int kt = t / 32, ntl = t - kt * 32; conv_tile(TID, src, D, kt * 64, ntl * 64, D, bto, D, 0, false, tile); } }
    { const float* src = p.in[13] + (size_t)l * 512 * 512; for (int t = (b + 192) % G; t < 8 * 8; t += G) { const int kt = t / 8, ntl = t - kt * 8; conv_tile(TID, src, 512, kt * 64, ntl * 64, 512, btglu, 512, 0, false, tile); } }
    for (int t = (b + 32) % G; t < 128; t += G) { const int mat = t >> 2, sub = t & 3;
        const int dk = mat >> 3, nb = mat & 7, d = dk >> 1, kind = dk & 1;
        const float* src = p.in[kind ? 22 : 20] + ((size_t)(l * 2 + d) * 8 + nb) * 128 * 128;
        conv_tile(TID, src, 128, (sub >> 1) * 64, (sub & 1) * 64, 128, btlru + (size_t)mat * 128 * 128, 128, 0, false, tile); }
}
__device__ __forceinline__ double exp_small(double x) { double s = 1.0, t = 1.0; for (int i = 1; i <= 14; ++i) { t *= x / (double)i; s += t; } return s; }
__device__ __forceinline__ double exp_neg(double x) { double e = exp_small(x * (1.0 / 64.0)); for (int i = 0; i < 6; ++i) e *= e; return e; }
__device__ __forceinline__ void s5_tables_all(const int TID, const int BID, const Params& p) {
    for (int vidx = (int)(gridDim.x - 1 - BID) * 512 + TID; vidx < 4 * 4096; vidx += gridDim.x * 512) {
        const int l = vidx >> 12, idx = vidx & 4095;
        f32x2* pw = (f32x2*)(p.ws + WS_PW) + l * PWL; f32x2* bbar = (f32x2*)(p.ws + WS_BBAR) + l * BBL;
        const int g = idx >> 7, d = (idx >> 6) & 1, n = idx & 63;
        const double dt = exp_neg((double)p.in[7][(l * 2 + d) * 32 + g]);
        const double lr = (double)p.in[5][((size_t)(l * 2 + d) * 32 + g) * 64 + n], li = (double)p.in[6][((size_t)(l * 2 + d) * 32 + g) * 64 + n];
        const double mag = exp_neg(lr * dt);
        double ang = li * dt; const double twopi = 6.283185307179586476925287; ang -= twopi * rint(ang / twopi);
        const double a8 = ang * 0.125, a2 = a8 * a8;
        double sn = a8, cs = 1.0, ts = a8, tc = 1.0;
        for (int i = 1; i <= 9; ++i) { tc *= -a2 / (double)((2 * i - 1) * (2 * i)); cs += tc; ts *= -a2 / (double)((2 * i) * (2 * i + 1)); sn += ts; }
        for (int i = 0; i < 3; ++i) { const double c2 = cs * cs - sn * sn, s2 = 2.0 * cs * sn; cs = c2; sn = s2; }
        const double abr = mag * cs, abi = mag * sn;
        double pr = 1.0, pi = 0.0;
        for (int j = 0; j <= 16; ++j) { pw[((size_t)(g * 2 + d) * 17 + j) * 64 + n] = (f32x2){(float)pr, (float)pi}; const double nr = pr * abr - pi * abi, ni = pr * abi + pi * abr; pr = nr; pi = ni; }
        const double den = lr * lr + li * li, fr = ((abr - 1.0) * lr + abi * li) / den, fi = (abi * lr - (abr - 1.0) * li) / den;
        float brf[16], bif[16];
#pragma unroll
        for (int c4 = 0; c4 < 4; ++c4) { const f32x4 t0 = *(const f32x4*)(p.in[8] + (((size_t)l * 32 + g) * 64 + n) * 16 + c4 * 4), t1 = *(const f32x4*)(p.in[9] + (((size_t)l * 32 + g) * 64 + n) * 16 + c4 * 4);
#pragma unroll
            for (int e = 0; e < 4; ++e) { brf[c4 * 4 + e] = t0[e]; bif[c4 * 4 + e] = t1[e]; } }
#pragma unroll
        for (int c = 0; c < 16; ++c) { const double br = (double)brf[c], bi = (double)bif[c];
            bbar[((size_t)(g * 2 + d) * 64 + n) * 16 + c] = (f32x2){(float)(fr * br - fi * bi), (float)(fr * bi + fi * br)}; }
    }
}
__device__ __forceinline__ float s5_kval(const float* cre, const float* cim, const f32x2* pw, const f32x2* bbar, int l, int g, int d, int j, int c, int cp) {
    const float* cr = cre + (((size_t)(l * 2 + d) * 32 + g) * 16 + c) * 64; const float* ci = cim + (((size_t)(l * 2 + d) * 32 + g) * 16 + c) * 64;
    const f32x2* pp = pw + ((size_t)(g * 2 + d) * 17 + j) * 64; const f32x2* bb = bbar + ((size_t)(g * 2 + d) * 64) * 16 + cp;
    float s = 0.f;
#pragma unroll 16
    for (int n = 0; n < 64; ++n) { const f32x2 pv = pp[n]; const f32x2 bv = bb[(size_t)n * 16]; const float er = cr[n] * pv.x - ci[n] * pv.y, ei = cr[n] * pv.y + ci[n] * pv.x; s += er * bv.x - ei * bv.y; }
    return s;
}
__device__ __forceinline__ void s5_assemble_a(const int TID, const int BID, const Params& p, int l) {
    const f32x2* pw = (const f32x2*)(p.ws + WS_PW) + l * PWL; const f32x2* bbar = (const f32x2*)(p.ws + WS_BBAR) + l * BBL;
    float* kmat = (float*)(p.ws + WS_KMAT); bf16_t* pmat = (bf16_t*)(p.ws + WS_PMAT);
    const float* cre = p.in[10]; const float* cim = p.in[11];
    const size_t stride = (size_t)gridDim.x * 512;
    for (size_t idx = (size_t)BID * 512 + TID; idx < (size_t)32 * 2 * 16 * 256; idx += stride) {
        const int g = (int)(idx >> 13), d = (int)(idx >> 12) & 1, j = (int)(idx >> 8) & 15, c = (int)(idx >> 4) & 15, cp = (int)idx & 15;
        kmat[idx] = s5_kval(cre, cim, pw, bbar, l, g, d, j, c, cp);
    }
    for (size_t idx = (size_t)BID * 512 + TID; idx < (size_t)32 * 256 * 256; idx += stride) {
        const int g = (int)(idx >> 16), nout = (int)(idx >> 8) & 255, k = (int)idx & 255, d = nout >> 7, ri = (nout >> 6) & 1, n = nout & 63, s = k >> 4, cp = k & 15, j = d == 0 ? 15 - s : s;
        const f32x2 pv = pw[((size_t)(g * 2 + d) * 17 + j) * 64 + n]; const f32x2 bv = bbar[((size_t)(g * 2 + d) * 64 + n) * 16 + cp];
        pmat[idx] = f2bf(ri == 0 ? pv.x * bv.x - pv.y * bv.y : pv.x * bv.y + pv.y * bv.x);
    }
}
__device__ __forceinline__ void s5_assemble_w(const int TID, const int BID, const Params& p, int l) {
    const f32x2* pw = (const f32x2*)(p.ws + WS_PW) + l * PWL; const float* kmat = (const float*)(p.ws + WS_KMAT);
    bf16_t* wmat = (bf16_t*)(p.ws + WS_WMAT);
    const float* cre = p.in[10]; const float* cim = p.in[11];
    const size_t stride = (size_t)gridDim.x * 512;
    for (size_t idx = (size_t)BID * 512 + TID; idx < (size_t)32 * 256 * 512; idx += stride) {
        const int g = (int)(idx >> 17), nout = (int)(idx >> 9) & 255, k = (int)idx & 511, t = nout >> 4, c = nout & 15;
        float val;
        if (k < 256) { const int s = k >> 4, cp = k & 15; val = 0.f;
            const int jf = s <= t ? t - s : 0, jb = s >= t ? s - t : 0;
            const float kf = kmat[((((size_t)g * 2 + 0) * 16 + jf) * 16 + c) * 16 + cp], kb = kmat[((((size_t)g * 2 + 1) * 16 + jb) * 16 + c) * 16 + cp], dsk = p.in[12][l * 512 + g * 16 + c];
            val = (s <= t ? kf : 0.f) + (s >= t ? kb : 0.f) + ((s == t && c == cp) ? dsk : 0.f);
        } else { const int kk = k - 256, d = kk >> 7, ri = (kk >> 6) & 1, n = kk & 63, j = d == 0 ? t + 1 : 16 - t;
            const float cr = cre[(((size_t)(l * 2 + d) * 32 + g) * 16 + c) * 64 + n], ci = cim[(((size_t)(l * 2 + d) * 32 + g) * 16 + c) * 64 + n];
            const f32x2 pv = pw[((size_t)(g * 2 + d) * 17 + j) * 64 + n];
            val = ri == 0 ? cr * pv.x - ci * pv.y : -(cr * pv.y + ci * pv.x); }
        wmat[idx] = f2bf(val);
    }
}

__device__ __forceinline__ void scans_phase(const int TID, const int BID, const Params& p, const int l, const bool do_gla) {
    const int G = gridDim.x;
    const bool split = (G == 256);
    {
        const f32x2* pw = (const f32x2*)(p.ws + WS_PW) + l * PWL; const float* st = (const float*)(p.ws + WS_ST); bf16_t* ub = (bf16_t*)(p.ws + WS_UBUF);
        for (int idx = BID * 512 + TID; idx < 40960; idx += G * 512) {
            const int seq = idx >> 12, rem = idx & 4095, g = rem >> 7, d = (rem >> 6) & 1, n = rem & 63;
            const int ch0 = seq < 2 ? seq * 257 : 514 + (seq - 2) * 129, nc = seq < 2 ? 257 : 129;
            const f32x2 a16 = pw[((size_t)(g * 2 + d) * 17 + 16) * 64 + n];
            float sr = 0.f, si = 0.f;
            for (int s0 = 0; s0 < nc; s0 += 32) {
                float lr[32], li[32];
#pragma unroll
                for (int i = 0; i < 32; ++i) { const int step = s0 + i; lr[i] = 0.f; li[i] = 0.f;
                    { const int sc = step < nc ? step : nc - 1; const int c = d == 0 ? sc : nc - 1 - sc; const size_t row = (size_t)g * CHP + ch0 + c; lr[i] = st[row * 256 + d * 128 + n]; li[i] = st[row * 256 + d * 128 + 64 + n]; } }
#pragma unroll
                for (int i = 0; i < 32; ++i) { const int step = s0 + i;
                    if (step < nc) { const int c = d == 0 ? step : nc - 1 - step; const size_t row = (size_t)g * CHP + ch0 + c;
                        ub[row * 512 + 256 + d * 128 + n] = f2bf(sr); ub[row * 512 + 256 + d * 128 + 64 + n] = f2bf(si);
                        const float nr = a16.x * sr - a16.y * si + lr[i], ni = a16.x * si + a16.y * sr + li[i]; sr = nr; si = ni; } }
            }
        }
    }
    {
        const float* la = (const float*)(p.ws + WS_LRUA); const float* lh = (const float*)(p.ws + WS_LRUH); float* lc = (float*)(p.ws + WS_LRUC);
        const int vb0 = split ? BID - 80 : BID, vstride = split ? 1 << 20 : G;
        for (int vb = vb0; vb >= 0 && vb < 40; vb += vstride) {
            const int idx = vb * 512 + TID;
            const int seq = idx >> 11, d = (idx >> 10) & 1, ch = idx & 1023;
            const int cb = seq < 2 ? seq * 65 : 130 + (seq - 2) * 33, nc = seq < 2 ? 65 : 33;
            float cin = 0.f;
            for (int s0 = 0; s0 < nc; s0 += 16) {
                float A[16], H[16];
#pragma unroll
                for (int i = 0; i < 16; ++i) { const int step = s0 + i; A[i] = 1.f; H[i] = 0.f;
                    { const int sc = step < nc ? step : nc - 1; const int ci = cb + (d == 0 ? sc : nc - 1 - sc); const size_t o = ((size_t)ci * 2 + d) * 1024 + ch; A[i] = la[o]; H[i] = lh[o]; } }
#pragma unroll
                for (int i = 0; i < 16; ++i) { const int step = s0 + i;
                    if (step < nc) { const int ci = cb + (d == 0 ? step : nc - 1 - step); const size_t o = ((size_t)ci * 2 + d) * 1024 + ch; lc[o] = cin; cin = A[i] * cin + H[i]; } }
            }
        }
    }
    if (do_gla) {
        float* ds = (float*)(p.ws + WS_DS); const float* dec = (const float*)(p.ws + WS_DECAY);
        for (int it = 0; ; ++it) {
            int vb;
            if (split) { if (BID >= 120) { if (it >= 8) break; vb = (BID - 120) + 136 * it; } else { vb = 1088 + BID + 120 * it; if (vb >= 1280) break; } }
            else { vb = BID + G * it; if (vb >= 1280) break; }
            const int e = vb * 512 + TID;
            const int seq = e >> 16, rem = e & 65535, head = rem >> 14, d = (rem >> 13) & 1, el = rem & 8191, kk = el & 63;
            const int cb = seq < 2 ? seq * 65 : 130 + (seq - 2) * 33, nc = seq < 2 ? 65 : 33;
            float S = 0.f;
            for (int s0 = 0; s0 < nc; s0 += 16) {
                float tm[16], dc[16];
#pragma unroll
                for (int i = 0; i < 16; ++i) { const int step = s0 + i; tm[i] = 0.f; dc[i] = 1.f;
                    { const int sc = step < nc ? step : nc - 1; const int ci = cb + (d == 0 ? sc : nc - 1 - sc); const size_t o = ((size_t)(ci * 4 + head) * 2 + d); tm[i] = ds[o * 8192 + el]; dc[i] = dec[o * 64 + kk]; } }
#pragma unroll
                for (int i = 0; i < 16; ++i) { const int step = s0 + i;
                    if (step < nc) { const int ci = cb + (d == 0 ? step : nc - 1 - step); const size_t o = ((size_t)(ci * 4 + head) * 2 + d); ds[o * 8192 + el] = S; S = dc[i] * S + tm[i]; } }
            }
        }
    }
}

__device__ __forceinline__ f32x4 mma_lds(f32x4 acc, const LAS bf16_t* A, const LAS bf16_t* B, int ld, int nks, int lane) {
    const LAS bf16_t* ap = A + (lane & 15) * ld + (lane >> 4) * 8; const LAS bf16_t* bp = B + (lane & 15) * ld + (lane >> 4) * 8;
    for (int ks = 0; ks < nks; ++ks) acc = __builtin_amdgcn_mfma_f32_16x16x32_bf16(*(const LAS bf16x8*)(ap + ks * 32), *(const LAS bf16x8*)(bp + ks * 32), acc, 0, 0, 0);
    return acc;
}
constexpr int GL_GLR = 0, GL_BF = 16384, GL_BB = 32768, GL_OS = 0, GL_QE0 = 49152, GL_QE1 = 58368, GL_KE0 = 67584, GL_KE1 = 76800, GL_VT = 86016, GL_ATT = 104448, GL_SP0 = 113664, GL_SP1 = 132096;
constexpr int GLD = 72;
template <int MODE>
__device__ __forceinline__ void gla_item(const int TID, const Params& p, int l, int ci, int head, LAS unsigned char* lds, const float (&wg)[2][16], const float (&bg)[2]) {
    const int tid = TID, lane = tid & 63, wid = tid >> 6;
    const bf16_t* cols = (const bf16_t*)(p.ws + WS_COLS);
    int seq, c; chunk_info(ci, seq, c);
    const int tok0 = seq_start(seq) + (c == 0 ? -48 : 16 + 64 * (c - 1));
    const int rmin = (c == 0) ? 48 : 0;
    LAS float* glr_s = (LAS float*)(lds + GL_GLR); LAS float* bfs = (LAS float*)(lds + GL_BF); LAS float* bbs = (LAS float*)(lds + GL_BB);
    { const int r = tid >> 3, j4 = (tid & 7) * 4; f32x4 v = (f32x4){0.f, 0.f, 0.f, 0.f};
      { const int rc = r >= rmin ? r : rmin; const u32x2 w = *(const u32x2*)(cols + (size_t)(tok0 + rc) * NINP + C_GLR + j4); if (r >= rmin) { v[0] = bflo(w.x); v[1] = bfhi(w.x); v[2] = bflo(w.y); v[3] = bfhi(w.y); } }
      *(LAS f32x4*)(glr_s + r * 32 + j4) = v; }
    __syncthreads();
    { const int kk = tid & 63, rb = tid >> 6;
#pragma unroll
      for (int i = 0; i < 8; ++i) { const int r = rb + 8 * i; float x0 = bg[0], x1 = bg[1]; f32x4 gr[8];
#pragma unroll
          for (int j4 = 0; j4 < 8; ++j4) gr[j4] = *(const LAS f32x4*)(glr_s + r * 32 + j4 * 4);
#pragma unroll
          for (int j = 0; j < 16; ++j) { x0 += gr[j >> 2][j & 3] * wg[0][j]; x1 += gr[4 + (j >> 2)][j & 3] * wg[1][j]; }
          const bool ok = r >= rmin; bfs[r * 64 + kk] = ok ? logsig(x0) * 0.0625f : 0.f; bbs[r * 64 + kk] = ok ? logsig(x1) * 0.0625f : 0.f; } }
    __syncthreads();
    { const int col = tid & 127, part = tid >> 7, d = col >> 6, kk = col & 63; LAS float* bs = d ? bbs : bfs; LAS float* tot = glr_s;
      float v[16];
#pragma unroll
      for (int i = 0; i < 16; ++i) v[i] = bs[(part * 16 + i) * 64 + kk];
      if (d == 0) {
#pragma unroll
          for (int i = 1; i < 16; ++i) v[i] += v[i - 1];
          tot[part * 128 + col] = v[15]; }
      else {
#pragma unroll
          for (int i = 14; i >= 0; --i) v[i] += v[i + 1];
          tot[part * 128 + col] = v[0]; }
      __syncthreads();
      float off = 0.f;
#pragma unroll
      for (int pp = 0; pp < 4; ++pp) { const float t = tot[pp * 128 + col]; if (d == 0 ? pp < part : pp > part) off += t; }
#pragma unroll
      for (int i = 0; i < 16; ++i) bs[(part * 16 + i) * 64 + kk] = v[i] + off; }
    __syncthreads();
    LAS bf16_t* vT = (LAS bf16_t*)(lds + GL_VT);
    { const int r = tid >> 3, k8 = (tid & 7) * 8; const bool ok = r >= rmin;
      u32x4 qw = (u32x4){0u, 0u, 0u, 0u}, kw = qw;
      const int rc = ok ? r : rmin;
      { const u32x4 kl = *(const u32x4*)(cols + (size_t)(tok0 + rc) * NINP + C_K + head * 64 + k8); if (ok) kw = kl; if (MODE == 1) { const u32x4 ql = *(const u32x4*)(cols + (size_t)(tok0 + rc) * NINP + C_Q + head * 64 + k8); if (ok) qw = ql; } }
      float qv[8], kv[8];
#pragma unroll
      for (int i = 0; i < 4; ++i) { qv[2 * i] = bflo(qw[i]); qv[2 * i + 1] = bfhi(qw[i]); kv[2 * i] = bflo(kw[i]); kv[2 * i + 1] = bfhi(kw[i]); }
      if (MODE == 0) { LAS bf16_t* kd0 = (LAS bf16_t*)(lds + GL_QE0); LAS bf16_t* kd1 = (LAS bf16_t*)(lds + GL_QE1);
#pragma unroll
          for (int i = 0; i < 8; ++i) { const int kk = k8 + i; kd0[kk * GLD + r] = f2bf(kv[i] * __expf(bfs[63 * 64 + kk] - bfs[r * 64 + kk])); kd1[kk * GLD + r] = f2bf(kv[i] * __expf(bbs[kk] - bbs[r * 64 + kk])); }
      } else { LAS bf16_t* qe0 = (LAS bf16_t*)(lds + GL_QE0); LAS bf16_t* qe1 = (LAS bf16_t*)(lds + GL_QE1); LAS bf16_t* ke0 = (LAS bf16_t*)(lds + GL_KE0); LAS bf16_t* ke1 = (LAS bf16_t*)(lds + GL_KE1);
          u32x4 a, b2, c2, d2;
#pragma unroll
          for (int i = 0; i < 4; ++i) { const int kk = k8 + 2 * i; const float f0 = bfs[r * 64 + kk], f1 = bfs[r * 64 + kk + 1], g0 = bbs[r * 64 + kk], g1 = bbs[r * 64 + kk + 1];
              a[i] = cvt_pk_bf16(qv[2 * i] * 0.125f * __expf(f0), qv[2 * i + 1] * 0.125f * __expf(f1)); b2[i] = cvt_pk_bf16(qv[2 * i] * 0.125f * __expf(g0), qv[2 * i + 1] * 0.125f * __expf(g1));
              c2[i] = cvt_pk_bf16(kv[2 * i] * __expf(-f0), kv[2 * i + 1] * __expf(-f1)); d2[i] = cvt_pk_bf16(kv[2 * i] * __expf(-g0), kv[2 * i + 1] * __expf(-g1)); }
          *(LAS u32x4*)(qe0 + r * GLD + k8) = a; *(LAS u32x4*)(qe1 + r * GLD + k8) = b2; *(LAS u32x4*)(ke0 + r * GLD + k8) = c2; *(LAS u32x4*)(ke1 + r * GLD + k8) = d2; }
#pragma unroll
      for (int hh = 0; hh < 2; ++hh) { const int v8 = ((tid & 7) + 8 * hh) * 8; u32x4 vw = (u32x4){0u, 0u, 0u, 0u};
          { const u32x4 vl = *(const u32x4*)(cols + (size_t)(tok0 + rc) * NINP + C_V + head * 128 + v8); if (ok) vw = vl; }
#pragma unroll
          for (int i = 0; i < 4; ++i) { vT[(v8 + 2 * i) * GLD + r] = (bf16_t)(vw[i] & 0xffffu); vT[(v8 + 2 * i + 1) * GLD + r] = (bf16_t)(vw[i] >> 16); } }
    }
    if (MODE == 1) {
        const float* ds = (const float*)(p.ws + WS_DS); f32x4 sv[2][4];
#pragma unroll
        for (int d = 0; d < 2; ++d) { const float* src = ds + ((size_t)(ci * 4 + head) * 2 + d) * 8192;
#pragma unroll
            for (int i = 0; i < 4; ++i) sv[d][i] = *(const f32x4*)(src + (i * 512 + tid) * 4); }
#pragma unroll
        for (int d = 0; d < 2; ++d) { LAS bf16_t* sp = (LAS bf16_t*)(lds + (d ? GL_SP1 : GL_SP0));
#pragma unroll
            for (int i = 0; i < 4; ++i) { const int e = (i * 512 + tid) * 4; const f32x4 v = sv[d][i]; u32x2 w; w.x = cvt_pk_bf16(v[0], v[1]); w.y = cvt_pk_bf16(v[2], v[3]); *(LAS u32x2*)(sp + (e >> 6) * GLD + (e & 63)) = w; } }
    }
    __syncthreads();
    if (MODE == 0) {
        float* ds = (float*)(p.ws + WS_DS); float* dec = (float*)(p.ws + WS_DECAY);
        if (tid < 128) { const int d = tid >> 6, kk = tid & 63; dec[((size_t)(ci * 4 + head) * 2 + d) * 64 + kk] = __expf(d == 0 ? bfs[63 * 64 + kk] : bbs[kk]); }
#pragma unroll
        for (int d = 0; d < 2; ++d) { const LAS bf16_t* kd = (const LAS bf16_t*)(lds + (d ? GL_QE1 : GL_QE0)); float* dst = ds + ((size_t)(ci * 4 + head) * 2 + d) * 8192;
            for (int kt = 0; kt < 4; ++kt) { f32x4 acc = (f32x4){0.f, 0.f, 0.f, 0.f}; acc = mma_lds(acc, vT + wid * 16 * GLD, kd + kt * 16 * GLD, GLD, 2, lane);
#pragma unroll
                for (int j = 0; j < 4; ++j) dst[(wid * 16 + (lane >> 4) * 4 + j) * 64 + kt * 16 + (lane & 15)] = acc[j]; } }
        __syncthreads();
        return;
    }
    const LAS bf16_t* qe0 = (const LAS bf16_t*)(lds + GL_QE0); const LAS bf16_t* qe1 = (const LAS bf16_t*)(lds + GL_QE1); const LAS bf16_t* ke0 = (const LAS bf16_t*)(lds + GL_KE0); const LAS bf16_t* ke1 = (const LAS bf16_t*)(lds + GL_KE1);
    LAS bf16_t* att = (LAS bf16_t*)(lds + GL_ATT);
    { const int it = wid >> 1;
#pragma unroll
      for (int t2 = 0; t2 < 2; ++t2) { const int jt = (wid & 1) * 2 + t2; f32x4 af = (f32x4){0.f, 0.f, 0.f, 0.f}, ab = af;
          af = mma_lds(af, qe0 + it * 16 * GLD, ke0 + jt * 16 * GLD, GLD, 2, lane); ab = mma_lds(ab, qe1 + it * 16 * GLD, ke1 + jt * 16 * GLD, GLD, 2, lane);
#pragma unroll
          for (int j = 0; j < 4; ++j) { const int i_ = it * 16 + (lane >> 4) * 4 + j, j_ = jt * 16 + (lane & 15); att[i_ * GLD + j_] = f2bf((j_ <= i_ ? af[j] : 0.f) + (j_ >= i_ ? ab[j] : 0.f)); } } }
    __syncthreads();
    LAS float* os = (LAS float*)(lds + GL_OS);
    { const int it = wid >> 1; const LAS bf16_t* sp0 = (const LAS bf16_t*)(lds + GL_SP0); const LAS bf16_t* sp1 = (const LAS bf16_t*)(lds + GL_SP1);
#pragma unroll
      for (int t4 = 0; t4 < 4; ++t4) { const int vt = (wid & 1) * 4 + t4; f32x4 acc = (f32x4){0.f, 0.f, 0.f, 0.f};
          acc = mma_lds(acc, att + it * 16 * GLD, vT + vt * 16 * GLD, GLD, 2, lane); acc = mma_lds(acc, qe0 + it * 16 * GLD, sp0 + vt * 16 * GLD, GLD, 2, lane); acc = mma_lds(acc, qe1 + it * 16 * GLD, sp1 + vt * 16 * GLD, GLD, 2, lane);
#pragma unroll
          for (int j = 0; j < 4; ++j) os[(it * 16 + (lane >> 4) * 4 + j) * 132 + vt * 16 + (lane & 15)] = acc[j]; } }
    __syncthreads();
    { const int r = tid >> 3, v0 = (tid & 7) * 16; float o[16]; float ss = 0.f;
#pragma unroll
      for (int i = 0; i < 16; ++i) { o[i] = os[r * 132 + v0 + i]; ss += o[i] * o[i]; }
      ss += __shfl_xor(ss, 1); ss += __shfl_xor(ss, 2); ss += __shfl_xor(ss, 4);
      const float rs = rsqrtf(ss * (1.0f / 128.0f) + 1e-6f);
      if (r >= rmin) { const size_t tok = (size_t)(tok0 + r); const float* ng = p.in[17] + l * 512 + head * 128 + v0; bf16_t* yall = (bf16_t*)(p.ws + WS_YALL);
#pragma unroll
          for (int hh = 0; hh < 2; ++hh) { const u32x4 gw = *(const u32x4*)(cols + tok * NINP + C_GB + head * 128 + v0 + hh * 8); u32x4 w;
#pragma unroll
              for (int i = 0; i < 4; ++i) { const int e = hh * 8 + 2 * i; w[i] = cvt_pk_bf16(o[e] * rs * ng[e] * silu(bflo(gw[i])), o[e + 1] * rs * ng[e + 1] * silu(bfhi(gw[i]))); }
              *(u32x4*)(yall + tok * D + 512 + head * 128 + v0 + hh * 8) = w; } } }
    __syncthreads();
}

__device__ __forceinline__ float softplus_neg(float lam) { const float e = __expf(-lam); return lam + 0.f < -8.f ? -lam : (e < 0.02f ? e * (1.0f - e * (0.5f - e * (1.0f / 3.0f))) : __logf(1.0f + e)); }
__device__ __forceinline__ float one_minus_exp(float x) {
    return x > -0.5f ? -x * (1.0f + x * 0.5f * (1.0f + x * (1.0f / 3.0f) * (1.0f + x * 0.25f * (1.0f + x * 0.2f * (1.0f + x * (1.0f / 6.0f) * (1.0f + x * (1.0f / 7.0f))))))) : 1.0f - __expf(x);
}
template <int MODE>
__device__ __forceinline__ void lru_phase(const int TID, const int b, const int G, const Params& p, int l, LAS unsigned char* lds) {
    const int tid = TID, lane = tid & 63, wid = tid >> 6, q = lane >> 4;
    const bf16_t* cols = (const bf16_t*)(p.ws + WS_COLS);
    int it = b; if (it >= NCK * 8) return;
    const int nb = b & 7;
    LAS bf16_t* xcA = (LAS bf16_t*)lds; LAS float* xcf = (LAS float*)(lds + 17408);
    const int ch = tid & 127, rb = tid >> 7, gchc = nb * 128 + ch;
    const float w0 = p.in[18][(l * 4 + 0) * 1024 + gchc], w1 = p.in[18][(l * 4 + 1) * 1024 + gchc], w2 = p.in[18][(l * 4 + 2) * 1024 + gchc], w3 = p.in[18][(l * 4 + 3) * 1024 + gchc], cb = p.in[19][l * 1024 + gchc];
    const int chl = wid * 16 + (lane & 15), gch = nb * 128 + chl;
    float ba[2], bx[2], sp8[2];
#pragma unroll
    for (int d = 0; d < 2; ++d) { ba[d] = p.in[21][(l * 2 + d) * 1024 + gch]; bx[d] = p.in[23][(l * 2 + d) * 1024 + gch]; sp8[d] = 8.0f * softplus_neg(p.in[24][(l * 2 + d) * 1024 + gch]); }
    bf16x8 bfr[4][4];
    { const bf16_t* bt = (const bf16_t*)(p.ws + WS_BTLRU);
#pragma unroll
      for (int mat = 0; mat < 4; ++mat)
#pragma unroll
          for (int ks = 0; ks < 4; ++ks) bfr[mat][ks] = *(const bf16x8*)(bt + ((size_t)(mat * 8 + nb) * 128 + wid * 16 + (lane & 15)) * 128 + ks * 32 + q * 8); }
    bf16_t xr[19];
    { int seq, c; chunk_info(it >> 3, seq, c); const int s0 = seq_start(seq), L = seq_len(seq), pos0 = (c == 0 ? -48 : 16 + 64 * (c - 1));
      const bf16_t* xb = cols + (size_t)s0 * NINP + C_XC + gchc;
#pragma unroll
      for (int i = 0; i < 19; ++i) { const int pos = pos0 + rb * 16 - 2 + i; const int pc = pos < 0 ? 0 : (pos < L ? pos : L - 1); xr[i] = xb[(size_t)pc * NINP]; } }
    for (; it < NCK * 8; it += G) {
        const int ci = it >> 3;
        int seq, c; chunk_info(ci, seq, c);
        const int s0 = seq_start(seq);
        const int pos0 = (c == 0 ? -48 : 16 + 64 * (c - 1));
        const int rmin = (c == 0) ? 48 : 0;
        float xv[19];
        { const int L = seq_len(seq);
#pragma unroll
          for (int i = 0; i < 19; ++i) { const int pos = pos0 + rb * 16 - 2 + i; xv[i] = (pos >= 0 && pos < L) ? bf2f(xr[i]) : 0.f; } }
#pragma unroll
        for (int i = 0; i < 16; ++i) { const int r = rb * 16 + i; const float xc = (r >= rmin) ? cb + xv[i] * w0 + xv[i + 1] * w1 + xv[i + 2] * w2 + xv[i + 3] * w3 : 0.f;
            xcf[r * 132 + ch] = xc; xcA[r * 136 + ch] = f2bf(xc); }
        u32x4 gq[2]; float cin[2];
        if (MODE == 1) {
#pragma unroll
            for (int d = 0; d < 2; ++d) cin[d] = ((const float*)(p.ws + WS_LRUC))[((size_t)ci * 2 + d) * 1024 + gch];
            { const int r = tid >> 3; const int rr = r >= rmin ? r : rmin; const bf16_t* gp = cols + (size_t)(s0 + pos0 + rr) * NINP + C_GC + nb * 128 + (tid & 7) * 16;
              gq[0] = *(const u32x4*)gp; gq[1] = *(const u32x4*)(gp + 8); }
        }
        { const int itn = it + G;
          if (itn < NCK * 8) { int seqn, cn; chunk_info(itn >> 3, seqn, cn); const int s0n = seq_start(seqn), Ln = seq_len(seqn), pos0n = (cn == 0 ? -48 : 16 + 64 * (cn - 1));
              const bf16_t* xb = cols + (size_t)s0n * NINP + C_XC + gchc;
#pragma unroll
              for (int i = 0; i < 19; ++i) { const int pos = pos0n + rb * 16 - 2 + i; const int pc = pos < 0 ? 0 : (pos < Ln ? pos : Ln - 1); xr[i] = xb[(size_t)pc * NINP]; } } }
        LBAR();
        LAS bf16_t* gts = (LAS bf16_t*)(lds + 51200); LAS float* hfs = (LAS float*)(lds + 68608);
        float hsum[4][4];
#pragma unroll
        for (int d = 0; d < 2; ++d) {
            __builtin_amdgcn_sched_barrier(0);
            f32x4 acc[2][4];
#pragma unroll
            for (int rt = 0; rt < 4; ++rt) { bf16x8 afr[4];
#pragma unroll
                for (int ks = 0; ks < 4; ++ks) afr[ks] = *(const LAS bf16x8*)(xcA + (rt * 16 + (lane & 15)) * 136 + ks * 32 + q * 8);
#pragma unroll
                for (int kind = 0; kind < 2; ++kind) { f32x4 a = (f32x4){0.f, 0.f, 0.f, 0.f};
#pragma unroll
                    for (int ks = 0; ks < 4; ++ks) a = __builtin_amdgcn_mfma_f32_16x16x32_bf16(afr[ks], bfr[d * 2 + kind][ks], a, 0, 0, 0);
                    acc[kind][rt] = a; } }
            float a[4][4], bb[4][4];
#pragma unroll
            for (int rt = 0; rt < 4; ++rt)
#pragma unroll
                for (int j = 0; j < 4; ++j) { const int r = rt * 16 + q * 4 + j; const float rg = sigm(acc[0][rt][j] + ba[d]), ig = sigm(acc[1][rt][j] + bx[d]), la = -sp8[d] * rg;
                    const bool ok = r >= rmin; const float av = __expf(la), x2 = 2.0f * la; const float om = x2 > -0.5f ? -x2 * (1.0f + x2 * 0.5f * (1.0f + x2 * (1.0f / 3.0f) * (1.0f + x2 * 0.25f * (1.0f + x2 * 0.2f * (1.0f + x2 * (1.0f / 6.0f)))))) : 1.0f - av * av;
                    a[rt][j] = ok ? av : 1.0f; bb[rt][j] = ok ? __builtin_amdgcn_sqrtf(om) * ig * xcf[r * 132 + chl] : 0.f; }
            float LA[4], LB[4];
#pragma unroll
            for (int rt = 0; rt < 4; ++rt) { float A = 1.f, B = 0.f;
#pragma unroll
                for (int jj = 0; jj < 4; ++jj) { const int j = d == 0 ? jj : 3 - jj; B = a[rt][j] * B + bb[rt][j]; A *= a[rt][j]; }
                LA[rt] = A; LB[rt] = B; }
            const size_t co = ((size_t)ci * 2 + d) * 1024 + gch;
            float h = (MODE == 1) ? cin[d] : 0.f, Atot = 1.f; float hin[4];
#pragma unroll
            for (int rr = 0; rr < 4; ++rr) { const int rt = d == 0 ? rr : 3 - rr;
#pragma unroll
                for (int qi = 0; qi < 4; ++qi) { const int qq = d == 0 ? qi : 3 - qi;
                    const float Aq = __shfl(LA[rt], (lane & 15) + 16 * qq), Bq = __shfl(LB[rt], (lane & 15) + 16 * qq);
                    if (qq == q) hin[rt] = h;
                    h = Aq * h + Bq; Atot *= Aq; } }
            if (MODE == 0) { if (q == 0) { ((float*)(p.ws + WS_LRUA))[co] = Atot; ((float*)(p.ws + WS_LRUH))[co] = h; } }
            else {
#pragma unroll
                for (int rt = 0; rt < 4; ++rt) { float hh = hin[rt];
#pragma unroll
                    for (int jj = 0; jj < 4; ++jj) { const int j = d == 0 ? jj : 3 - jj; hh = a[rt][j] * hh + bb[rt][j];
                        if (d == 0) hfs[(rt * 16 + q * 4 + j) * 132 + chl] = hh; else hsum[rt][j] = hh; } }
                if (d == 0) { *(LAS u32x4*)(gts + (tid >> 3) * 136 + (tid & 7) * 16) = gq[0]; *(LAS u32x4*)(gts + (tid >> 3) * 136 + (tid & 7) * 16 + 8) = gq[1]; } }
        }
        if (MODE == 1) { bf16_t* yall = (bf16_t*)(p.ws + WS_YALL);
            LBAR();
#pragma unroll
            for (int rt = 0; rt < 4; ++rt)
#pragma unroll
                for (int j = 0; j < 4; ++j) { const int r = rt * 16 + q * 4 + j; xcA[r * 136 + chl] = f2bf((hsum[rt][j] + hfs[r * 132 + chl]) * silu(bf2f(gts[r * 136 + chl]))); }
            LBAR();
            { const int r = tid >> 3; if (r >= rmin) { const u32x4 y0 = *(const LAS u32x4*)(xcA + r * 136 + (tid & 7) * 16), y1 = *(const LAS u32x4*)(xcA + r * 136 + (tid & 7) * 16 + 8);
                bf16_t* yp = yall + (size_t)(s0 + pos0 + r) * D + 1024 + nb * 128 + (tid & 7) * 16; *(u32x4*)yp = y0; *(u32x4*)(yp + 8) = y1; } } }
        LBAR();
    }
}


template <int WHICH>
__device__ __forceinline__ void skinny_tail(const int TID, const int b0, const Params& p) {
    const int lane = TID & 63, wid = TID >> 6, q = lane >> 4;
    if (wid >= 5) return;
    for (int b = b0; b < 256; b += (int)gridDim.x) {
    const int ct = b & 127, rt = (b >> 7) * 5 + wid;
    const int row = 24576 + rt * 16 + (lane & 15);
    const int colb = ct * 16 + (lane & 15);
    const bf16_t* cols = (const bf16_t*)(p.ws + WS_COLS);
    if (WHICH == 0) {
        const bf16_t* A = (const bf16_t*)(p.ws + WS_YALL) + (size_t)row * D + q * 8; const bf16_t* B = (const bf16_t*)(p.ws + WS_BTOUT) + (size_t)colb * D + q * 8;
        bf16_t* mbf = (bf16_t*)(p.ws + WS_H);
        f32x4 msum = (f32x4){0.f, 0.f, 0.f, 0.f};
        unsigned char gt[3][4];
#pragma unroll
        for (int br = 0; br < 3; ++br)
#pragma unroll
            for (int j = 0; j < 4; ++j) { const int cc = colb & 255; gt[br][j] = ((const unsigned char*)(cols + (size_t)(24576 + rt * 16 + q * 4 + j) * NINP + C_MG))[(br * 8 + (colb >> 8)) * 256 + ((((cc & 127) >> 5) * 4 + ((cc & 31) >> 3)) * 2 + (cc >> 7)) * 8 + (cc & 7)]; }
        float gs[3][4];
#pragma unroll
        for (int br = 0; br < 3; ++br)
#pragma unroll
            for (int j = 0; j < 4; ++j) { gs[br][j] = (float)gt[br][j] * (1.0f / 255.0f); asm volatile("" : "+v"(gs[br][j])); }
#pragma unroll
        for (int br = 0; br < 3; ++br) { const int koff = br * 512, nks = br == 2 ? 32 : 16; f32x4 acc = (f32x4){0.f, 0.f, 0.f, 0.f};
            for (int k0 = 0; k0 < nks; k0 += 8) { bf16x8 av[8], bv[8];
#pragma unroll
                for (int i = 0; i < 8; ++i) { av[i] = *(const bf16x8*)(A + koff + (k0 + i) * 32); bv[i] = *(const bf16x8*)(B + koff + (k0 + i) * 32); }
#pragma unroll
                for (int i = 0; i < 8; ++i) acc = __builtin_amdgcn_mfma_f32_16x16x32_bf16(av[i], bv[i], acc, 0, 0, 0); }
#pragma unroll
            for (int j = 0; j < 4; ++j) msum[j] += gs[br][j] * acc[j]; }
#pragma unroll
        for (int j = 0; j < 4; ++j) { const int tok = 24576 + rt * 16 + q * 4 + j; mbf[(size_t)tok * D + colb] = f2bf(msum[j]); }
    } else {
        const bf16_t* A = (const bf16_t*)(p.ws + WS_H) + (size_t)row * D + q * 8; const bf16_t* B = (const bf16_t*)(p.ws + WS_BTO) + (size_t)colb * D + q * 8;
        float* z = (float*)(p.ws + WS_Z);
        f32x4 acc = (f32x4){0.f, 0.f, 0.f, 0.f};
        for (int k0 = 0; k0 < 64; k0 += 8) { bf16x8 av[8], bv[8];
#pragma unroll
            for (int i = 0; i < 8; ++i) { av[i] = *(const bf16x8*)(A + (k0 + i) * 32); bv[i] = *(const bf16x8*)(B + (k0 + i) * 32); }
#pragma unroll
            for (int i = 0; i < 8; ++i) acc = __builtin_amdgcn_mfma_f32_16x16x32_bf16(av[i], bv[i], acc, 0, 0, 0); }
#pragma unroll
        for (int j = 0; j < 4; ++j) { const int tok = 24576 + rt * 16 + q * 4 + j; z[(size_t)tok * D + colb] += acc[j]; }
    }
    }
}

#define XB_TMO      128
#define XB_XCNT(j)  (256  + 64 * (j))
#define XB_XSUB(j)  (1280 + 64 * (j))
#define XB_XGEN(j)  (2304 + 64 * (j))
#define XB_TOP      3328
#define XB_TOPGEN   3392
#define XCD_BAR_WORDS 3456
#define XB_SPIN_CAP (1u << 18)
__device__ __forceinline__ unsigned xb_ld(unsigned* p)              { return __hip_atomic_load(p, __ATOMIC_RELAXED, __HIP_MEMORY_SCOPE_AGENT); }
__device__ __forceinline__ unsigned xb_add(unsigned* p, unsigned v) { return __hip_atomic_fetch_add(p, v, __ATOMIC_RELAXED, __HIP_MEMORY_SCOPE_AGENT); }
__device__ __forceinline__ unsigned xb_xcc_id() { return (unsigned)__builtin_amdgcn_s_getreg((3 << 11) | 20) & 0xFu; }
#define XB_SPIN(cond, bar) do { unsigned _sp = 0; while (cond) { __builtin_amdgcn_s_sleep(1); \
    if ((++_sp & 255u) == 0u) { if (xb_ld(&(bar)[XB_TMO])) break; if (_sp > XB_SPIN_CAP) { atomicAdd(&(bar)[XB_TMO], 1u); break; } } } } while (0)
struct XcdBarrier { unsigned* bar; unsigned x; volatile LAS unsigned* st; };
__device__ __forceinline__ XcdBarrier xcd_barrier_post(unsigned* bar, volatile LAS unsigned* st) {
    XcdBarrier b; b.bar = bar; b.x = xb_xcc_id(); b.st = st;
    if (threadIdx.x == 0) (void)xb_add(&bar[XB_XCNT(b.x)], 1u);
    return b;
}
__device__ __forceinline__ void xcd_barrier_complete(unsigned* bar, unsigned x, unsigned& nloc, unsigned& nx) {
    const unsigned G = gridDim.x * gridDim.y * gridDim.z;
    unsigned sum, cnt, mine, sp = 0u;
    for (;;) {
        sum = 0u; cnt = 0u; mine = 0u;
#pragma unroll
        for (unsigned j = 0; j < 16; ++j) { const unsigned c = xb_ld(&bar[XB_XCNT(j)]); sum += c; cnt += (c > 0u) ? 1u : 0u; mine = (j == x) ? c : mine; }
        if (sum == G) break;
        __builtin_amdgcn_s_sleep(1);
        if ((++sp & 255u) == 0u) { if (xb_ld(&bar[XB_TMO])) break; if (sp > XB_SPIN_CAP) { atomicAdd(&bar[XB_TMO], 1u); break; } }
    }
    nloc = mine > 0u ? mine : 1u; nx = cnt > 0u ? cnt : 1u;
}
__device__ __forceinline__ void xcd_barrier(const XcdBarrier& b) {
    asm volatile("s_waitcnt vmcnt(0)" ::: "memory");
    __syncthreads();
    if (threadIdx.x == 0) {
        unsigned* bar = b.bar;
        __builtin_amdgcn_s_waitcnt(0);
        unsigned nloc = b.st[0], nx = b.st[1];
        if (nloc == 0u) { xcd_barrier_complete(bar, b.x, nloc, nx); b.st[0] = nloc; b.st[1] = nx; }
        const unsigned old = xb_add(&bar[XB_XSUB(b.x)], 1u);
        const unsigned gen = old / nloc;
        if (old + 1u == (gen + 1u) * nloc) {
            __builtin_amdgcn_fence(__ATOMIC_RELEASE, "agent");
            asm volatile("s_waitcnt vmcnt(0)" ::: "memory");
            const unsigned og = xb_add(&bar[XB_TOP], 1u);
            const unsigned tg = og / nx;
            if (og + 1u == (tg + 1u) * nx) xb_add(&bar[XB_TOPGEN], 1u);
            else XB_SPIN(xb_ld(&bar[XB_TOPGEN]) == tg, bar);
            __builtin_amdgcn_fence(__ATOMIC_ACQUIRE, "agent");
            xb_add(&bar[XB_XGEN(b.x)], 1u);
            asm volatile("s_waitcnt vmcnt(0)" ::: "memory");
        } else {
            XB_SPIN(xb_ld(&bar[XB_XGEN(b.x)]) == gen, bar);
            __builtin_amdgcn_fence(__ATOMIC_ACQUIRE, "agent");
            asm volatile("s_waitcnt vmcnt(0)" ::: "memory");
        }
    }
    __syncthreads();
}

__global__ void __launch_bounds__(512) fwd_megakernel(Params p_in) {
    extern __shared__ __attribute__((aligned(16))) unsigned char smem[];
    LAS unsigned char* lds = (LAS unsigned char*)smem;
    cg::grid_group grid = cg::this_grid();
    const int G = gridDim.x;
    const Params& p0 = p_in;
    volatile LAS unsigned* stw = (volatile LAS unsigned*)(lds + 150528);
    if (threadIdx.x == 0) { stw[0] = 0u; stw[1] = 0u; }
    __syncthreads();
    const XcdBarrier xb = xcd_barrier_post((unsigned*)(p_in.ws + WS_BAR), stw);
    for (int ph = p0.ph_lo; ph < p0.ph_hi; ++ph) {
        const int reps_ = (ph < 32 && (ph & 7) == DUP) ? 2 : 1;
        for (int rep_ = 0; rep_ < reps_; ++rep_) {
        int TID = threadIdx.x; asm volatile("" : "+v"(TID));
        int b = blockIdx.x; asm volatile("" : "+s"(b));
        Params p = p0; { unsigned long long t_ = (unsigned long long)p.ws; asm volatile("" : "+s"(t_)); p.ws = (unsigned char*)t_; }
        const char* ws = (const char*)p.ws;
        if (ph == 32) { final_norm_phase(TID, b, p); }
        else {
            const int l = ph >> 3, k = ph & 7;
            if (k == 0 && (PHM & 1)) { rmsnorm_phase(TID, b, p, l); convert_weights(TID, b, p, l, (LAS float*)lds); if (l == 0) s5_tables_all(TID, b, p); }
            else if (k == 1 && (PHM & 2)) {
                TileOrder S; S.nM = MP / 256; S.nN = NINP / 256; S.nwg = S.nM * S.nN; S.G = G; S.c = b; S.mult = 1; S.nt0 = D / 64; S.A = ws + WS_H; S.B = ws + WS_BTIN; S.tA = (size_t)256 * D * 2; S.tB = (size_t)256 * D * 2;
                EpiIn E; E.cols = (bf16_t*)(p.ws + WS_COLS); E.ubuf = (bf16_t*)(p.ws + WS_UBUF);
                gemm_phase(TID, lds, D, D, S, E);
                s5_assemble_a(TID, b, p, l);
            } else if (k == 2 && (PHM & 4)) {
                GroupOrder S; S.G = G; S.c = b; S.nt0 = 4; S.A = ws + WS_UBUF; S.B = ws + WS_PMAT; S.gsA = (size_t)CHP * 512 * 2; S.gsB = (size_t)256 * 256 * 2; S.tA = (size_t)256 * 512 * 2;
                EpiS5State E; E.st = (float*)(p.ws + WS_ST);
                if (SUBM & 4) gemm_phase(TID, lds, 512, 256, S, E);
                __syncthreads();
                { const int head_ = ((b + 128) % G) & 3, kk_ = TID & 63; float wg_[2][16], bg_[2];
                  _Pragma("unroll") for (int d = 0; d < 2; ++d) { bg_[d] = p.in[16][(l * 2 + d) * 256 + head_ * 64 + kk_]; _Pragma("unroll") for (int j = 0; j < 16; ++j) wg_[d][j] = p.in[15][((size_t)(l * 2 + d) * 16 + j) * 256 + head_ * 64 + kk_]; }
                  for (int it = (b + 128) % G; it < NCK * 4; it += G) gla_item<0>(TID, p, l, it >> 2, it & 3, lds, wg_, bg_); }
                lru_phase<0>(TID, b, G, p, l, lds);
                s5_assemble_w(TID, b, p, l);
            } else if (k == 3 && (PHM & 8)) { scans_phase(TID, b, p, l, rep_ == 0); }
            else if (k == 4 && (PHM & 16)) {
                GroupOrder S; S.G = G; S.c = b; S.nt0 = 8; S.A = ws + WS_UBUF; S.B = ws + WS_WMAT; S.gsA = (size_t)CHP * 512 * 2; S.gsB = (size_t)256 * 512 * 2; S.tA = (size_t)256 * 512 * 2;
                EpiS5Out E; E.zs5 = (bf16_t*)(p.ws + WS_ZS5);
                if (SUBM & 4) gemm_phase(TID, lds, 512, 512, S, E);
                __syncthreads();
                { const int head_ = ((b + 128) % G) & 3, kk_ = TID & 63; float wg_[2][16], bg_[2];
                  _Pragma("unroll") for (int d = 0; d < 2; ++d) { bg_[d] = p.in[16][(l * 2 + d) * 256 + head_ * 64 + kk_]; _Pragma("unroll") for (int j = 0; j < 16; ++j) wg_[d][j] = p.in[15][((size_t)(l * 2 + d) * 16 + j) * 256 + head_ * 64 + kk_]; }
                  for (int it = (b + 128) % G; it < NCK * 4; it += G) gla_item<1>(TID, p, l, it >> 2, it & 3, lds, wg_, bg_); }
                lru_phase<1>(TID, b, G, p, l, lds);
            } else if (k == 5 && (PHM & 32)) {
                TileOrder S; S.nM = MP / 256; S.nN = 2; S.nwg = S.nM * S.nN; S.G = G; S.c = b; S.mult = 1; S.nt0 = 8; S.A = ws + WS_ZS5; S.B = ws + WS_BTGLU; S.tA = (size_t)256 * 512 * 2; S.tB = (size_t)256 * 512 * 2;
                EpiGlu E; E.zs5 = (const bf16_t*)(p.ws + WS_ZS5); E.cols = (const bf16_t*)(p.ws + WS_COLS); E.bglu = p.in[14] + l * 512; E.yall = (bf16_t*)(p.ws + WS_YALL);
                gemm_phase(TID, lds, 512, 512, S, E);
            } else if (k == 6 && (PHM & 64)) {
                TileOrder S; S.nM = 96; S.nN = 8; S.nwg = S.nM * S.nN; S.G = G; S.c = b; S.mult = 3; S.nt0 = 8; S.A = ws + WS_YALL; S.B = ws + WS_BTOUT; S.tA = (size_t)256 * D * 2; S.tB = (size_t)256 * D * 2;
                EpiOut E; E.cols = (const bf16_t*)(p.ws + WS_COLS); E.mbf = (bf16_t*)(p.ws + WS_H);
                gemm_phase(TID, lds, D, D, S, E);
                skinny_tail<0>(TID, b, p);
            } else if (PHM & 128) {
                TileOrder S; S.nM = 96; S.nN = 8; S.nwg = S.nM * S.nN; S.G = G; S.c = b; S.mult = 1; S.nt0 = D / 64; S.A = ws + WS_H; S.B = ws + WS_BTO; S.tA = (size_t)256 * D * 2; S.tB = (size_t)256 * D * 2;
                EpiWo E; E.z = (float*)(p.ws + WS_Z);
                gemm_phase(TID, lds, D, D, S, E);
                skinny_tail<1>(TID, b, p);
            }
        }
        }
        if (p0.use_sync && ph + 1 < p0.ph_hi) { if (ph == p0.ph_lo) grid.sync(); else xcd_barrier(xb); }
    }
}

extern "C" void kernel_launch(void* const* d_in, const int* in_sizes, int n_in, void* d_out, int out_size, void* d_ws, size_t ws_size, hipStream_t stream) {
    static int grid = 0, coop = 1;
    if (grid == 0) {
        if (n_in != 30 || ws_size < WS_END) { fprintf(stderr, "kernel_launch: unexpected n_in %d or ws_size %zu (< %zu)\n", n_in, ws_size, (size_t)WS_END); grid = -1; return; }
        int dev = 0, cus = 0, per_cu = 0;
        (void)hipGetDevice(&dev); (void)hipDeviceGetAttribute(&cus, hipDeviceAttributeMultiprocessorCount, dev);
        if (hipFuncSetAttribute((const void*)fwd_megakernel, hipFuncAttributeMaxDynamicSharedMemorySize, LDS_BYTES) != hipSuccess) { fprintf(stderr, "kernel_launch: hipFuncSetAttribute failed\n"); grid = -1; return; }
        if (hipOccupancyMaxActiveBlocksPerMultiprocessor(&per_cu, (const void*)fwd_megakernel, 512, LDS_BYTES) != hipSuccess || per_cu < 1) { fprintf(stderr, "kernel_launch: occupancy query gave %d\n", per_cu); per_cu = 1; }
        (void)hipGetLastError();
        grid = cus * 1;
    }
    if (grid < 0) return;
    Params p{};
    for (int i = 0; i < 30; ++i) p.in[i] = (const float*)d_in[i];
    p.out = (float*)d_out; p.ws = (unsigned char*)d_ws; p.pad = 0;
    (void)hipMemsetAsync((char*)d_ws + WS_BAR, 0, 3456 * 4, stream);
    if (coop) {
        p.ph_lo = 0; p.ph_hi = 33; p.use_sync = 1;
        void* args[] = {&p};
        hipError_t e = hipLaunchCooperativeKernel((const void*)fwd_megakernel, dim3(grid), dim3(512), args, LDS_BYTES, stream);
        if (e == hipSuccess) return;
        fprintf(stderr, "kernel_launch: cooperative launch failed: %s (grid %d); falling back to one launch per phase\n", hipGetErrorString(e), grid);
        (void)hipGetLastError(); coop = 0;
    }
    for (int ph = 0; ph < 33; ++ph) { p.ph_lo = ph; p.ph_hi = ph + 1; p.use_sync = 0; hipLaunchKernelGGL(fwd_megakernel, dim3(grid), dim3(512), LDS_BYTES, stream, p); }
}
```

```cpp
#include <hip/hip_runtime.h>
#include <hip/hip_cooperative_groups.h>
#include <cstdio>
namespace cg = cooperative_groups;
#define LAS __attribute__((address_space(3)))
typedef unsigned short bf16_t;
typedef short bf16x8 __attribute__((ext_vector_type(8)));
typedef float f32x4 __attribute__((ext_vector_type(4)));
typedef float f32x2 __attribute__((ext_vector_type(2)));
typedef unsigned u32x2 __attribute__((ext_vector_type(2)));
typedef unsigned u32x4 __attribute__((ext_vector_type(4)));

constexpr int D = 2048, NTOK = 24736, MP = 24832, NINP = 11008, NIN = 10784;
constexpr int NCH16 = 1546, CHP = 1792, NCK = 394;
constexpr int C_GA = 512, C_Q = 1024, C_K = 1280, C_V = 1536, C_GB = 2048, C_XC = 2560, C_GC = 3584, C_MG = 4608, C_GLR = 10752;
constexpr int LDS_BYTES = 150528 + 16;
#ifndef SYNCREP
#define SYNCREP 1
#endif
#ifndef DUP
#define DUP -1
#endif
#ifndef SUBM
#define SUBM 7
#endif
#ifndef PHM
#define PHM 255
#endif

constexpr size_t al256(size_t x) { return (x + 255) & ~(size_t)255; }
constexpr size_t WS_Z = 0;
constexpr size_t WS_H = WS_Z + al256((size_t)MP * D * 4);
constexpr size_t WS_COLS = WS_H + al256((size_t)MP * D * 2);
constexpr size_t WS_YALL = WS_COLS + al256((size_t)MP * NINP * 2);
constexpr size_t WS_ZS5 = WS_YALL + al256((size_t)MP * D * 2);
constexpr size_t WS_UBUF = WS_ZS5 + al256((size_t)MP * 512 * 2);
constexpr size_t WS_ST = WS_UBUF + al256((size_t)32 * CHP * 512 * 2);
constexpr size_t WS_DS = WS_ST + al256((size_t)32 * CHP * 256 * 4);
constexpr size_t WS_M32 = WS_UBUF;
constexpr size_t WS_DECAY = WS_DS + al256((size_t)NCK * 4 * 2 * 8192 * 4);
constexpr size_t WS_LRUA = WS_DECAY + al256((size_t)NCK * 4 * 2 * 64 * 4);
constexpr size_t WS_LRUH = WS_LRUA + al256((size_t)NCK * 2 * 1024 * 4);
constexpr size_t WS_LRUC = WS_LRUH + al256((size_t)NCK * 2 * 1024 * 4);
constexpr size_t WS_PW = WS_LRUC + al256((size_t)NCK * 2 * 1024 * 4);
constexpr size_t WS_BBAR = WS_PW + al256((size_t)4 * 32 * 2 * 17 * 64 * 8);
constexpr size_t WS_WMAT = WS_BBAR + al256((size_t)4 * 32 * 2 * 64 * 16 * 8);
constexpr size_t WS_PMAT = WS_WMAT + al256((size_t)32 * 256 * 512 * 2);
constexpr size_t WS_BTIN = WS_PMAT + al256((size_t)32 * 256 * 256 * 2);
constexpr size_t WS_BTOUT = WS_BTIN + al256((size_t)NINP * D * 2);
constexpr size_t WS_BTO = WS_BTOUT + al256((size_t)D * D * 2);
constexpr size_t WS_BTGLU = WS_BTO + al256((size_t)D * D * 2);
constexpr size_t WS_BTLRU = WS_BTGLU + al256((size_t)512 * 512 * 2);
constexpr size_t WS_KMAT = WS_BTLRU + al256((size_t)32 * 128 * 128 * 2);
constexpr size_t WS_BAR = WS_KMAT + al256((size_t)32 * 2 * 16 * 256 * 4);
constexpr size_t WS_END = WS_BAR + al256((size_t)3456 * 4);
constexpr size_t PWL = (size_t)32 * 2 * 17 * 64, BBL = (size_t)32 * 2 * 64 * 16;
static_assert(WS_END <= (size_t)1413480448, "workspace too large");
static_assert((size_t)MP * D * 4 <= WS_DECAY - WS_UBUF, "m32 alias too small");

struct Params { const float* in[30]; float* out; unsigned char* ws; int ph_lo, ph_hi, use_sync, pad; };

#define LBAR() do { asm volatile("s_waitcnt lgkmcnt(0)" ::: "memory"); __builtin_amdgcn_s_barrier(); asm volatile("" ::: "memory"); } while (0)
__device__ __forceinline__ unsigned cvt_pk_bf16(float lo, float hi) { unsigned r; asm volatile("v_cvt_pk_bf16_f32 %0, %1, %2" : "=v"(r) : "v"(lo), "v"(hi)); return r; }
__device__ __forceinline__ bf16_t f2bf(float f) { return (bf16_t)(cvt_pk_bf16(f, 0.f) & 0xffffu); }
__device__ __forceinline__ float bf2f(bf16_t b) { return __uint_as_float(((unsigned)b) << 16); }
__device__ __forceinline__ float bflo(unsigned w) { return __uint_as_float(w << 16); }
__device__ __forceinline__ float bfhi(unsigned w) { return __uint_as_float(w & 0xffff0000u); }
__device__ __forceinline__ float sigm(float x) { return __builtin_amdgcn_rcpf(1.0f + __expf(-x)); }
__device__ __forceinline__ float silu(float x) { return x * sigm(x); }
__device__ __forceinline__ float gelu_t(float x) { const float u = 0.7978845608028654f * (x + 0.044715f * x * x * x); return x * sigm(2.0f * u); }
__device__ __forceinline__ float logsig(float x) { return -(fmaxf(-x, 0.f) + __logf(1.0f + __expf(-fabsf(x)))); }

__device__ __forceinline__ int seq_start(int s) { return s < 2 ? s * 4112 : 8224 + (s - 2) * 2064; }
__device__ __forceinline__ int seq_len(int s) { return s < 2 ? 4112 : 2064; }
__device__ __forceinline__ void chunk_info(int ci, int& seq, int& c) { if (ci < 130) { seq = ci / 65; c = ci - seq * 65; } else { const int t = ci - 130; const int q = t / 33; seq = 2 + q; c = t - q * 33; } }

constexpr int BM = 256, BK = 64, HALF = 128, HTB = HALF * BK * 2, STAGE_BYTES = 8 * HTB, NXCD = 8, WGM = 8;
__device__ __forceinline__ int lds_byte(int r, int c) { const int st = (r >> 4) * 2 + (c >> 5), rr = r & 15, cc = c & 31, ob = rr * 64 + cc * 2; return st * 1024 + (ob ^ (((ob >> 9) & 1) << 5)); }
__device__ __forceinline__ void stage_rc(int b, int& R, int& C) { const int st = b / 1024, sb = b % 1024, swz = sb ^ (((sb >> 9) & 1) << 5); R = (st >> 1) * 16 + swz / 64; C = (st & 1) * 32 + (swz % 64) / 2; }

struct Unit { int pm, pn, sub, nt; const char* a; const char* b; };

struct TileOrder {
    int nM, nN, nwg, G, c, mult, nt0; const char* A; const char* B; size_t tA, tB;
    __device__ __forceinline__ bool next(int i, Unit& u) const {
        const int ti = i / mult, sub = i - ti * mult;
        const long L = (long)ti * G + c; if (L >= nwg) return false;
        int wgid = (int)L; { const int q = nwg / NXCD, r = nwg % NXCD, xcd = wgid % NXCD, off = wgid / NXCD; wgid = (xcd < r ? xcd * (q + 1) : r * (q + 1) + (xcd - r) * q) + off; }
        const int nig = WGM * nN, gid = wgid / nig, fm = gid * WGM, gsz = (nM - fm) < WGM ? (nM - fm) : WGM;
        u.pm = fm + ((wgid % nig) % gsz); u.pn = (wgid % nig) / gsz; u.sub = sub;
        const int koff = (mult == 3) ? sub * 512 : 0; u.nt = (mult == 3) ? (sub == 2 ? 16 : 8) : nt0;
        u.a = A + (size_t)u.pm * tA + (size_t)koff * 2; u.b = B + (size_t)u.pn * tB + (size_t)koff * 2; return true;
    }
};
struct GroupOrder {
    int G, c, nt0; const char* A; const char* B; size_t gsA, gsB, tA;
    __device__ __forceinline__ bool next(int i, Unit& u) const {
        const int L = i * G + c; if (L >= 224) return false;
        const int g = L / 7, pm = L - g * 7; u.pm = pm; u.pn = 0; u.sub = g; u.nt = nt0;
        u.a = A + (size_t)g * gsA + (size_t)pm * tA; u.b = B + (size_t)g * gsB; return true;
    }
};

__device__ __forceinline__ int perm32(int rho) { const int n = rho >> 4, i = rho & 15; return 8 * (i >> 2) + 4 * n + (i & 3); }
template <class Epi, class Sched>
__device__ __forceinline__ void gemm_phase(const int TID, LAS unsigned char* lds, const int lda, const int ldb, const Sched& S, const Epi& E) {
    const int tid = TID, wid = __builtin_amdgcn_readfirstlane(tid >> 6), lane = tid & 63, wr = wid >> 2, wc = wid & 3, fr = lane & 15, fq = lane >> 4;
    unsigned voffA[2], voffB[2];
#pragma unroll
    for (int i = 0; i < 2; ++i) { int R, C; stage_rc(tid * 16 + i * 8192, R, C); const int Rb = Epi::PERM ? ((R & ~31) + perm32(R & 31)) : R; voffA[i] = (unsigned)(R * lda + C) * 2u; voffB[i] = (unsigned)(Rb * ldb + C) * 2u; }
    const size_t kstep = (size_t)(BK * 2);
    const size_t hA = (size_t)HALF * lda * 2, hB = (size_t)HALF * ldb * 2;
    const unsigned ldsw = (unsigned)wid * 1024u;
    const int aoff = lds_byte(wr * 64 + fr, fq * 8), boff = lds_byte(wc * 32 + fr, fq * 8);
#define PG8_SA(b, h) (((b) * 2 + (h)) * HTB)
#define PG8_SB(b, h) ((4 + (b) * 2 + (h)) * HTB)
#define PG8_STAGE(bufoff, gbase, voff) do { _Pragma("unroll") for (int _i = 0; _i < 2; ++_i) \
        __builtin_amdgcn_global_load_lds((const unsigned*)((const char*)(gbase) + (voff)[_i]), (LAS unsigned*)(lds + (bufoff) + ldsw + _i * 8192), 16, 0, 0); } while (0)
#define PG8_LDA(dst, b, h) do { _Pragma("unroll") for (int m = 0; m < 4; ++m) _Pragma("unroll") for (int k = 0; k < 2; ++k) dst[m][k] = *(const LAS bf16x8*)(lds + PG8_SA(b, h) + aoff + m * 2048 + k * 1024); } while (0)
#define PG8_LDB(dst, b, h) do { _Pragma("unroll") for (int n = 0; n < 2; ++n) _Pragma("unroll") for (int k = 0; k < 2; ++k) dst[n][k] = *(const LAS bf16x8*)(lds + PG8_SB(b, h) + boff + n * 2048 + k * 1024); } while (0)
#define PG8_MMA(ai, bj, At, Bt) do { __builtin_amdgcn_s_setprio(1); _Pragma("unroll") for (int m = 0; m < 4; ++m) _Pragma("unroll") for (int n = 0; n < 2; ++n) _Pragma("unroll") for (int k = 0; k < 2; ++k) \
        acc[ai][bj][m][n] = __builtin_amdgcn_mfma_f32_16x16x32_bf16(Bt[n][k], At[m][k], acc[ai][bj][m][n], 0, 0, 0); __builtin_amdgcn_s_setprio(0); } while (0)
#define PG8_WAIT_V(n) asm volatile("s_waitcnt vmcnt(" #n ")" ::: "memory")
#define PG8_WAIT_L(n) asm volatile("s_waitcnt lgkmcnt(" #n ")" ::: "memory")
#define PG8_BAR __builtin_amdgcn_s_barrier()
#define PG8_SCHED __builtin_amdgcn_sched_barrier(0)
    Unit cur, nxt; int ui = 0;
    if (!S.next(0, cur)) return;
    f32x4 acc[2][2][4][2];
#pragma unroll
    for (int a = 0; a < 2; ++a)
#pragma unroll
        for (int b = 0; b < 2; ++b)
#pragma unroll
            for (int m = 0; m < 4; ++m)
#pragma unroll
                for (int n = 0; n < 2; ++n) acc[a][b][m][n] = (f32x4){0.f, 0.f, 0.f, 0.f};
    bf16x8 At[4][2], B0[2][2], B1[2][2];
    const char* cA = cur.a; const char* cB = cur.b;
    PG8_STAGE(PG8_SB(0, 0), cB, voffB); PG8_STAGE(PG8_SA(0, 0), cA, voffA); PG8_STAGE(PG8_SB(0, 1), cB + hB, voffB); PG8_STAGE(PG8_SA(0, 1), cA + hA, voffA);
    if (wr == 1) PG8_BAR;
    PG8_WAIT_V(4); PG8_BAR;
    PG8_STAGE(PG8_SB(1, 0), cB + kstep, voffB); PG8_STAGE(PG8_SA(1, 0), cA + kstep, voffA); PG8_STAGE(PG8_SB(1, 1), cB + hB + kstep, voffB);
    PG8_WAIT_V(6); PG8_BAR;
    for (;;) {
        const bool has_next = S.next(ui + 1, nxt);
        const char* nA = has_next ? nxt.a : cA; const char* nB = has_next ? nxt.b : cB;
        const int nt = cur.nt;
        for (int t = 0; t < nt; t += 2) {
            const bool last = (t == nt - 2);
            const char* a1 = cA + (size_t)(t + 1) * kstep;
            const char* a2 = last ? nA : cA + (size_t)(t + 2) * kstep; const char* b2 = last ? nB : cB + (size_t)(t + 2) * kstep;
            const char* a3 = a2 + kstep; const char* b3 = b2 + kstep;
            PG8_LDB(B0, 0, 0); PG8_SCHED; PG8_LDA(At, 0, 0); PG8_STAGE(PG8_SA(1, 1), a1 + hA, voffA);
            PG8_WAIT_L(8); PG8_BAR; PG8_WAIT_L(0); PG8_MMA(0, 0, At, B0); PG8_BAR; PG8_SCHED;
            PG8_LDB(B1, 0, 1); PG8_STAGE(PG8_SB(0, 0), b2, voffB);
            PG8_BAR; PG8_WAIT_L(0); PG8_MMA(0, 1, At, B1); PG8_BAR;
            PG8_LDA(At, 0, 1); PG8_STAGE(PG8_SA(0, 0), a2, voffA);
            PG8_BAR; PG8_WAIT_L(0); PG8_MMA(1, 0, At, B0); PG8_BAR; PG8_SCHED;
            PG8_STAGE(PG8_SB(0, 1), b2 + hB, voffB);
            PG8_WAIT_V(6); PG8_BAR; PG8_MMA(1, 1, At, B1); PG8_BAR;
            PG8_LDB(B0, 1, 0); PG8_SCHED; PG8_LDA(At, 1, 0); PG8_STAGE(PG8_SA(0, 1), a2 + hA, voffA);
            PG8_WAIT_L(8); PG8_BAR; PG8_WAIT_L(0); PG8_MMA(0, 0, At, B0); PG8_BAR; PG8_SCHED;
            PG8_LDB(B1, 1, 1); PG8_STAGE(PG8_SB(1, 0), b3, voffB);
            PG8_BAR; PG8_WAIT_L(0); PG8_MMA(0, 1, At, B1); PG8_BAR;
            PG8_LDA(At, 1, 1); PG8_STAGE(PG8_SA(1, 0), a3, voffA);
            PG8_BAR; PG8_WAIT_L(0); PG8_MMA(1, 0, At, B0); PG8_BAR; PG8_SCHED;
            PG8_STAGE(PG8_SB(1, 1), b3 + hB, voffB);
            PG8_WAIT_V(6); PG8_BAR; PG8_MMA(1, 1, At, B1); PG8_BAR;
        }
        E(acc, cur, wr, wc, fr, fq);
        if (!has_next) break;
#pragma unroll
        for (int a = 0; a < 2; ++a)
#pragma unroll
            for (int b = 0; b < 2; ++b)
#pragma unroll
                for (int m = 0; m < 4; ++m)
#pragma unroll
                    for (int n = 0; n < 2; ++n) acc[a][b][m][n] = (f32x4){0.f, 0.f, 0.f, 0.f};
        cur = nxt; cA = nA; cB = nB; ++ui;
    }
    PG8_WAIT_V(0);
    if (wr == 0) PG8_BAR;
    PG8_BAR;
#undef PG8_SA
#undef PG8_SB
#undef PG8_STAGE
#undef PG8_LDA
#undef PG8_LDB
#undef PG8_MMA
#undef PG8_WAIT_V
#undef PG8_WAIT_L
#undef PG8_BAR
#undef PG8_SCHED
}

#define EPI_LOOP(...) \
    const int row0 = u.pm * BM + wr * 64 + fr, col0 = u.pn * BM + wc * 32 + 4 * fq; \
    _Pragma("unroll") for (int ai = 0; ai < 2; ++ai) _Pragma("unroll") for (int m = 0; m < 4; ++m) { const int r = row0 + ai * HALF + m * 16; \
        _Pragma("unroll") for (int bj = 0; bj < 2; ++bj) _Pragma("unroll") for (int n = 0; n < 2; ++n) { const int c = col0 + bj * HALF + n * 16; const f32x4 v = acc[ai][bj][m][n]; __VA_ARGS__ } }

#define EPI_PROWS(...) \
    const int row0 = u.pm * BM + wr * 64 + fr, col0 = u.pn * BM + wc * 32 + 8 * fq; \
    _Pragma("unroll") for (int ai = 0; ai < 2; ++ai) _Pragma("unroll") for (int m = 0; m < 4; ++m) { const int r = row0 + ai * HALF + m * 16; __VA_ARGS__ }
__device__ __forceinline__ u32x4 pack8(const f32x4 a, const f32x4 b) { u32x4 w; w[0] = cvt_pk_bf16(a[0], a[1]); w[1] = cvt_pk_bf16(a[2], a[3]); w[2] = cvt_pk_bf16(b[0], b[1]); w[3] = cvt_pk_bf16(b[2], b[3]); return w; }
__device__ __forceinline__ unsigned q8(float x) { return (unsigned)__float2uint_rn(sigm(x) * 255.0f); }
__device__ __forceinline__ unsigned q8x4(const f32x4 v) { return q8(v[0]) | (q8(v[1]) << 8) | (q8(v[2]) << 16) | (q8(v[3]) << 24); }
struct EpiIn { static constexpr bool PERM = true; bf16_t* cols; bf16_t* ubuf;
    __device__ __forceinline__ void operator()(const f32x4 (&acc)[2][2][4][2], const Unit& u, int wr, int wc, int fr, int fq) const {
        if (u.pn >= 18 && u.pn < 42) {
            EPI_PROWS({ u32x4 w; w[0] = q8x4(acc[ai][0][m][0]); w[1] = q8x4(acc[ai][0][m][1]); w[2] = q8x4(acc[ai][1][m][0]); w[3] = q8x4(acc[ai][1][m][1]);
                *(u32x4*)((unsigned char*)(cols + (size_t)r * NINP + C_MG) + (u.pn - 18) * 256 + (wc * 4 + fq) * 16) = w; })
        } else {
            EPI_PROWS({ _Pragma("unroll") for (int bj = 0; bj < 2; ++bj) { const int c = col0 + bj * HALF;
                bf16_t* dst = (u.pn < 2) ? ubuf + ((size_t)((c >> 4) * CHP + (r >> 4)) * 512 + (r & 15) * 16 + (c & 15)) : cols + (size_t)r * NINP + c;
                *(u32x4*)dst = pack8(acc[ai][bj][m][0], acc[ai][bj][m][1]); } })
        }
    } };
struct EpiS5State { static constexpr bool PERM = false; float* st;
    __device__ __forceinline__ void operator()(const f32x4 (&acc)[2][2][4][2], const Unit& u, int wr, int wc, int fr, int fq) const {
        EPI_LOOP({ *(f32x4*)(st + ((size_t)(u.sub * CHP + r)) * 256 + c) = v; })
    } };
struct EpiS5Out { static constexpr bool PERM = true; bf16_t* zs5;
    __device__ __forceinline__ void operator()(const f32x4 (&acc)[2][2][4][2], const Unit& u, int wr, int wc, int fr, int fq) const {
        EPI_PROWS({ if (r < NCH16) { _Pragma("unroll") for (int bj = 0; bj < 2; ++bj) { const int c = col0 + bj * HALF; f32x4 a = acc[ai][bj][m][0], b2 = acc[ai][bj][m][1];
            _Pragma("unroll") for (int e = 0; e < 4; ++e) { a[e] = gelu_t(a[e]); b2[e] = gelu_t(b2[e]); }
            *(u32x4*)(zs5 + (size_t)(r * 16 + (c >> 4)) * 512 + u.sub * 16 + (c & 15)) = pack8(a, b2); } } })
    } };
#define EPI_ROWS(...) \
    const int row0 = u.pm * BM + wr * 64 + fr, col0 = u.pn * BM + wc * 32 + 4 * fq; \
    _Pragma("unroll") for (int ai = 0; ai < 2; ++ai) _Pragma("unroll") for (int m = 0; m < 4; ++m) { const int r = row0 + ai * HALF + m * 16; __VA_ARGS__ }
#define QOFF(q) (((q) >> 1) * HALF + ((q) & 1) * 16)
#define EPI_PIPE(LOADF, COMPF) \
    const int row0 = u.pm * BM + wr * 64 + fr, col0 = u.pn * BM + wc * 32 + 8 * fq; \
    LOADF(0, 0); \
    _Pragma("unroll") for (int gi = 0; gi < 8; ++gi) { if (gi + 1 < 8) { if ((gi & 1) == 0) { LOADF(gi + 1, 1); } else { LOADF(gi + 1, 0); } } if ((gi & 1) == 0) { COMPF(gi, 0); } else { COMPF(gi, 1); } }
#define GROW(gi) (row0 + ((gi) >> 2) * HALF + ((gi) & 3) * 16)
struct EpiGlu { static constexpr bool PERM = true; const bf16_t* zs5; const bf16_t* cols; const float* bglu; bf16_t* yall;
    __device__ __forceinline__ void operator()(const f32x4 (&acc)[2][2][4][2], const Unit& u, int wr, int wc, int fr, int fq) const {
        u32x4 zz[2][2], gg[2][2]; f32x4 bb[2][2];
        { const int c0 = u.pn * BM + wc * 32 + 8 * fq; _Pragma("unroll") for (int bj = 0; bj < 2; ++bj) { bb[bj][0] = *(const f32x4*)(bglu + c0 + bj * HALF); bb[bj][1] = *(const f32x4*)(bglu + c0 + bj * HALF + 4); } }
#define GLU_LOAD(gi, bf) do { const int r_ = GROW(gi); _Pragma("unroll") for (int bj = 0; bj < 2; ++bj) { const int c = col0 + bj * HALF; zz[bf][bj] = *(const u32x4*)(zs5 + (size_t)r_ * 512 + c); gg[bf][bj] = *(const u32x4*)(cols + (size_t)r_ * NINP + C_GA + c); } } while (0)
#define GLU_COMP(gi, bf) do { const int r_ = GROW(gi); _Pragma("unroll") for (int bj = 0; bj < 2; ++bj) { const int c = col0 + bj * HALF; f32x4 o[2]; \
            _Pragma("unroll") for (int hf = 0; hf < 2; ++hf) { const f32x4 v = acc[(gi) >> 2][bj][(gi) & 3][hf]; \
                o[hf][0] = bflo(zz[bf][bj][2 * hf]) * sigm(v[0] + bb[bj][hf][0]) * silu(bflo(gg[bf][bj][2 * hf])); o[hf][1] = bfhi(zz[bf][bj][2 * hf]) * sigm(v[1] + bb[bj][hf][1]) * silu(bfhi(gg[bf][bj][2 * hf])); \
                o[hf][2] = bflo(zz[bf][bj][2 * hf + 1]) * sigm(v[2] + bb[bj][hf][2]) * silu(bflo(gg[bf][bj][2 * hf + 1])); o[hf][3] = bfhi(zz[bf][bj][2 * hf + 1]) * sigm(v[3] + bb[bj][hf][3]) * silu(bfhi(gg[bf][bj][2 * hf + 1])); } \
            *(u32x4*)(yall + (size_t)r_ * D + c) = pack8(o[0], o[1]); } } while (0)
        EPI_PIPE(GLU_LOAD, GLU_COMP)
#undef GLU_LOAD
#undef GLU_COMP
    } };
__device__ __forceinline__ float ub(unsigned w, int k) { return (float)((w >> (8 * k)) & 255u) * (1.0f / 255.0f); }
struct EpiOut { static constexpr bool PERM = true; const bf16_t* cols; bf16_t* mbf;
    __device__ __forceinline__ void operator()(const f32x4 (&acc)[2][2][4][2], const Unit& u, int wr, int wc, int fr, int fq) const {
        u32x4 gg[2], mm[2][2];
#define OUT_LOAD(gi, bf) do { const int r_ = GROW(gi); const bf16_t* mp = mbf + (size_t)r_ * D + col0; \
            gg[bf] = *(const u32x4*)((const unsigned char*)(cols + (size_t)r_ * NINP + C_MG) + (u.sub * 8 + u.pn) * 256 + (wc * 4 + fq) * 16); \
            _Pragma("unroll") for (int bj = 0; bj < 2; ++bj) { mm[bf][bj] = (u32x4){0u, 0u, 0u, 0u}; if (u.sub != 0) mm[bf][bj] = *(const u32x4*)(mp + bj * HALF); } } while (0)
#define OUT_COMP(gi, bf) do { const int r_ = GROW(gi); bf16_t* mp = mbf + (size_t)r_ * D + col0; _Pragma("unroll") for (int bj = 0; bj < 2; ++bj) { f32x4 o[2]; \
            _Pragma("unroll") for (int hf = 0; hf < 2; ++hf) { const f32x4 v = acc[(gi) >> 2][bj][(gi) & 3][hf]; const unsigned gw = gg[bf][bj * 2 + hf]; \
                o[hf][0] = bflo(mm[bf][bj][2 * hf]) + ub(gw, 0) * v[0]; o[hf][1] = bfhi(mm[bf][bj][2 * hf]) + ub(gw, 1) * v[1]; \
                o[hf][2] = bflo(mm[bf][bj][2 * hf + 1]) + ub(gw, 2) * v[2]; o[hf][3] = bfhi(mm[bf][bj][2 * hf + 1]) + ub(gw, 3) * v[3]; } \
            *(u32x4*)(mp + bj * HALF) = pack8(o[0], o[1]); } } while (0)
        EPI_PIPE(OUT_LOAD, OUT_COMP)
#undef OUT_LOAD
#undef OUT_COMP
    } };
struct EpiWo { static constexpr bool PERM = false; float* z;
    __device__ __forceinline__ void operator()(const f32x4 (&acc)[2][2][4][2], const Unit& u, int wr, int wc, int fr, int fq) const {
        EPI_ROWS({ if (r < NTOK) { float* zp = z + (size_t)r * D + col0; f32x4 pv[4];
            _Pragma("unroll") for (int q = 0; q < 4; ++q) pv[q] = *(const f32x4*)(zp + QOFF(q));
            _Pragma("unroll") for (int q = 0; q < 4; ++q) *(f32x4*)(zp + QOFF(q)) = pv[q] + acc[ai][q >> 1][m][q & 1]; } })
    } };

__device__ __forceinline__ const float* src_row(const Params& p, int r) {
    int s, pos; if (r < 8224) { s = r / 4112; pos = r - s * 4112; } else { const int t = r - 8224; const int q = t / 2064; s = 2 + q; pos = t - q * 2064; }
    if (pos < 16) return p.in[2] + (size_t)pos * D;
    return s < 2 ? p.in[0] + ((size_t)s * 4096 + (pos - 16)) * D : p.in[1] + ((size_t)(s - 2) * 2048 + (pos - 16)) * D;
}
__device__ __forceinline__ void rmsnorm_phase(const int TID, const int BID, const Params& p, int l) {
    float* z = (float*)(p.ws + WS_Z); bf16_t* h = (bf16_t*)(p.ws + WS_H); const float* g = p.in[3] + (size_t)l * D;
    const int lane = TID & 63, gw = BID * 8 + (TID >> 6), nw = gridDim.x * 8;
    f32x4 gg[8];
#pragma unroll
    for (int i = 0; i < 8; ++i) gg[i] = *(const f32x4*)(g + (i * 64 + lane) * 4);
    f32x4 xn[8];
    { const int r0 = gw < NTOK ? gw : NTOK - 1; const float* src = (l == 0) ? src_row(p, r0) : z + (size_t)r0 * D;
#pragma unroll
      for (int i = 0; i < 8; ++i) xn[i] = *(const f32x4*)(src + (i * 64 + lane) * 4); }
    for (int r = gw; r < MP; r += nw) {
        bf16_t* hr = h + (size_t)r * D;
        f32x4 x[8];
#pragma unroll
        for (int i = 0; i < 8; ++i) x[i] = xn[i];
        { const int rn = (r + nw < NTOK) ? r + nw : NTOK - 1; const float* src = (l == 0) ? src_row(p, rn) : z + (size_t)rn * D;
#pragma unroll
          for (int i = 0; i < 8; ++i) xn[i] = *(const f32x4*)(src + (i * 64 + lane) * 4); }
        if (r >= NTOK) { for (int i = 0; i < 4; ++i) *(u32x4*)(hr + (i * 64 + lane) * 8) = (u32x4){0u, 0u, 0u, 0u}; continue; }
        float ss = 0.f;
#pragma unroll
        for (int i = 0; i < 8; ++i) ss += x[i][0] * x[i][0] + x[i][1] * x[i][1] + x[i][2] * x[i][2] + x[i][3] * x[i][3];
#pragma unroll
        for (int o = 32; o >= 1; o >>= 1) ss += __shfl_xor(ss, o);
        const float rs = rsqrtf(ss * (1.0f / D) + 1e-6f);
#pragma unroll
        for (int i = 0; i < 8; ++i) { const int c = (i * 64 + lane) * 4;
            if (l == 0) *(f32x4*)(z + (size_t)r * D + c) = x[i];
            u32x2 w; w.x = cvt_pk_bf16(x[i][0] * rs * gg[i][0], x[i][1] * rs * gg[i][1]); w.y = cvt_pk_bf16(x[i][2] * rs * gg[i][2], x[i][3] * rs * gg[i][3]); *(u32x2*)(hr + c) = w; }
    }
}
__device__ __forceinline__ void final_norm_phase(const int TID, const int BID, const Params& p) {
    const float* z = (const float*)(p.ws + WS_Z); const float* g = p.in[29];
    const int lane = TID & 63, gw = BID * 8 + (TID >> 6), nw = gridDim.x * 8;
    for (int r = gw; r < NTOK; r += nw) {
        int s, pos; if (r < 8224) { s = r / 4112; pos = r - s * 4112; } else { const int t = r - 8224; const int q = t / 2064; s = 2 + q; pos = t - q * 2064; }
        if (pos < 16) continue;
        float* dst = s < 2 ? p.out + ((size_t)s * 4096 + (pos - 16)) * D : p.out + (size_t)2 * 4096 * D + ((size_t)(s - 2) * 2048 + (pos - 16)) * D;
        const float* src = z + (size_t)r * D;
        f32x4 x[8]; float ss = 0.f;
#pragma unroll
        for (int i = 0; i < 8; ++i) { x[i] = *(const f32x4*)(src + (i * 64 + lane) * 4); ss += x[i][0] * x[i][0] + x[i][1] * x[i][1] + x[i][2] * x[i][2] + x[i][3] * x[i][3]; }
#pragma unroll
        for (int o = 32; o >= 1; o >>= 1) ss += __shfl_xor(ss, o);
        const float rs = rsqrtf(ss * (1.0f / D) + 1e-6f);
#pragma unroll
        for (int i = 0; i < 8; ++i) { const int c = (i * 64 + lane) * 4; const f32x4 gg = *(const f32x4*)(g + c); f32x4 o; o[0] = x[i][0] * rs * gg[0]; o[1] = x[i][1] * rs * gg[1]; o[2] = x[i][2] * rs * gg[2]; o[3] = x[i][3] * rs * gg[3]; *(f32x4*)(dst + c) = o; }
    }
}
__device__ __forceinline__ void conv_tile(const int TID, const float* src, int ldn, int k0, int n0, int nvalid, bf16_t* dst, int ldd, int kofs, bool mapin, LAS float* tile) {
    const int tx = TID & 63, ty = TID >> 6;
    const int ncl = (n0 + tx < nvalid) ? n0 + tx : nvalid - 1;
#pragma unroll
    for (int i = 0; i < 8; ++i) { const int k = ty + 8 * i; tile[k * 65 + tx] = src[(size_t)(k0 + k) * ldn + ncl]; }
    __syncthreads();
#pragma unroll
    for (int i = 0; i < 8; ++i) { const int nn = ty + 8 * i; int n = n0 + nn;
        if (n < nvalid) { if (mapin) n = (n < 2560) ? n : (n < 2592 ? n + (C_GLR - 2560) : n - 32); dst[(size_t)n * ldd + kofs + k0 + tx] = f2bf(tile[tx * 65 + nn]); } }
    __syncthreads();
}
__device__ __forceinline__ void convert_weights(const int TID, const int BID, const Params& p, int l, LAS float* tile) {
    const int G = gridDim.x, b = BID;
    bf16_t* btin = (bf16_t*)(p.ws + WS_BTIN); bf16_t* btout = (bf16_t*)(p.ws + WS_BTOUT); bf16_t* bto = (bf16_t*)(p.ws + WS_BTO); bf16_t* btglu = (bf16_t*)(p.ws + WS_BTGLU); bf16_t* btlru = (bf16_t*)(p.ws + WS_BTLRU);
    { const float* src = p.in[4] + (size_t)l * D * NIN; const int tx = TID & 63, ty = TID >> 6; float v[8];
      { const int t = b < 32 * 169 ? b : 0; const int kt = t / 169, ntl = t - kt * 169; const int ncl = (ntl * 64 + tx < NIN) ? ntl * 64 + tx : NIN - 1;
#pragma unroll
        for (int i = 0; i < 8; ++i) v[i] = src[(size_t)(kt * 64 + ty + 8 * i) * NIN + ncl]; }
      for (int t = b; t < 32 * 169; t += G) { const int kt = t / 169, ntl = t - kt * 169, k0 = kt * 64, n0 = ntl * 64;
#pragma unroll
          for (int i = 0; i < 8; ++i) tile[(ty + 8 * i) * 65 + tx] = v[i];
          { const int tn = (t + G < 32 * 169) ? t + G : t; const int ktn = tn / 169, ntn = tn - ktn * 169; const int ncl = (ntn * 64 + tx < NIN) ? ntn * 64 + tx : NIN - 1;
#pragma unroll
            for (int i = 0; i < 8; ++i) v[i] = src[(size_t)(ktn * 64 + ty + 8 * i) * NIN + ncl]; }
          LBAR();
#pragma unroll
          for (int i = 0; i < 8; ++i) { const int nn = ty + 8 * i; int n = n0 + nn;
              if (n < NIN) { n = (n < 2560) ? n : (n < 2592 ? n + (C_GLR - 2560) : n - 32); btin[(size_t)n * D + k0 + tx] = f2bf(tile[tx * 65 + nn]); } }
          LBAR(); } }
    for (size_t i = (size_t)b * 512 + TID; i < (size_t)(NINP - NIN) * D / 8; i += (size_t)G * 512) *(u32x4*)(btin + (size_t)NIN * D + i * 8) = (u32x4){0u, 0u, 0u, 0u};
    { const float* src = p.in[25] + (size_t)l * 512 * D; for (int t = (b + 64) % G; t < 8 * 32; t += G) { const int kt = t / 32, ntl = t - kt * 32; conv_tile(TID, src, D, kt * 64, ntl * 64, D, btout, D, 0, false, tile); } }
    { const float* src = p.in[26] + (size_t)l * 512 * D; for (int t = (b + 128) % G; t < 8 * 32; t += G) { const int kt = t / 32, ntl = t - kt * 32; conv_tile(TID, src, D, kt * 64, ntl * 64, D, btout, D, 512, false, tile); } }
    { const float* src = p.in[27] + (size_t)l * 1024 * D; for (int t = b; t < 16 * 32; t += G) { const int kt = t / 32, ntl = t - kt * 32; conv_tile(TID, src, D, kt * 64, ntl * 64, D, btout, D, 1024, false, tile); } }
    { const float* src = p.in[28] + (size_t)l * D * D; for (int t = b; t < 32 * 32; t += G) { const int kt = t / 32, ntl = t - kt * 32; conv_tile(TID, src, D, kt * 64, ntl * 64, D, bto, D, 0, false, tile); } }
    { const float* src = p.in[13] + (size_t)l * 512 * 512; for (int t = (b + 192) % G; t < 8 * 8; t += G) { const int kt = t / 8, ntl = t - kt * 8; conv_tile(TID, src, 512, kt * 64, ntl * 64, 512, btglu, 512, 0, false, tile); } }
    for (int t = (b + 32) % G; t < 128; t += G) { const int mat = t >> 2, sub = t & 3;
        const int dk = mat >> 3, nb = mat & 7, d = dk >> 1, kind = dk & 1;
        const float* src = p.in[kind ? 22 : 20] + ((size_t)(l * 2 + d) * 8 + nb) * 128 * 128;
        conv_tile(TID, src, 128, (sub >> 1) * 64, (sub & 1) * 64, 128, btlru + (size_t)mat * 128 * 128, 128, 0, false, tile); }
}
__device__ __forceinline__ double exp_small(double x) { double s = 1.0, t = 1.0; for (int i = 1; i <= 14; ++i) { t *= x / (double)i; s += t; } return s; }
__device__ __forceinline__ double exp_neg(double x) { double e = exp_small(x * (1.0 / 64.0)); for (int i = 0; i < 6; ++i) e *= e; return e; }
__device__ __forceinline__ void s5_tables_all(const int TID, const int BID, const Params& p) {
    for (int vidx = (int)(gridDim.x - 1 - BID) * 512 + TID; vidx < 4 * 4096; vidx += gridDim.x * 512) {
        const int l = vidx >> 12, idx = vidx & 4095;
        f32x2* pw = (f32x2*)(p.ws + WS_PW) + l * PWL; f32x2* bbar = (f32x2*)(p.ws + WS_BBAR) + l * BBL;
        const int g = idx >> 7, d = (idx >> 6) & 1, n = idx & 63;
        const double dt = exp_neg((double)p.in[7][(l * 2 + d) * 32 + g]);
        const double lr = (double)p.in[5][((size_t)(l * 2 + d) * 32 + g) * 64 + n], li = (double)p.in[6][((size_t)(l * 2 + d) * 32 + g) * 64 + n];
        const double mag = exp_neg(lr * dt);
        double ang = li * dt; const double twopi = 6.283185307179586476925287; ang -= twopi * rint(ang / twopi);
        const double a8 = ang * 0.125, a2 = a8 * a8;
        double sn = a8, cs = 1.0, ts = a8, tc = 1.0;
        for (int i = 1; i <= 9; ++i) { tc *= -a2 / (double)((2 * i - 1) * (2 * i)); cs += tc; ts *= -a2 / (double)((2 * i) * (2 * i + 1)); sn += ts; }
        for (int i = 0; i < 3; ++i) { const double c2 = cs * cs - sn * sn, s2 = 2.0 * cs * sn; cs = c2; sn = s2; }
        const double abr = mag * cs, abi = mag * sn;
        double pr = 1.0, pi = 0.0;
        for (int j = 0; j <= 16; ++j) { pw[((size_t)(g * 2 + d) * 17 + j) * 64 + n] = (f32x2){(float)pr, (float)pi}; const double nr = pr * abr - pi * abi, ni = pr * abi + pi * abr; pr = nr; pi = ni; }
        const double den = lr * lr + li * li, fr = ((abr - 1.0) * lr + abi * li) / den, fi = (abi * lr - (abr - 1.0) * li) / den;
        float brf[16], bif[16];
#pragma unroll
        for (int c4 = 0; c4 < 4; ++c4) { const f32x4 t0 = *(const f32x4*)(p.in[8] + (((size_t)l * 32 + g) * 64 + n) * 16 + c4 * 4), t1 = *(const f32x4*)(p.in[9] + (((size_t)l * 32 + g) * 64 + n) * 16 + c4 * 4);
#pragma unroll
            for (int e = 0; e < 4; ++e) { brf[c4 * 4 + e] = t0[e]; bif[c4 * 4 + e] = t1[e]; } }
#pragma unroll
        for (int c = 0; c < 16; ++c) { const double br = (double)brf[c], bi = (double)bif[c];
            bbar[((size_t)(g * 2 + d) * 64 + n) * 16 + c] = (f32x2){(float)(fr * br - fi * bi), (float)(fr * bi + fi * br)}; }
    }
}
__device__ __forceinline__ float s5_kval(const float* cre, const float* cim, const f32x2* pw, const f32x2* bbar, int l, int g, int d, int j, int c, int cp) {
    const float* cr = cre + (((size_t)(l * 2 + d) * 32 + g) * 16 + c) * 64; const float* ci = cim + (((size_t)(l * 2 + d) * 32 + g) * 16 + c) * 64;
    const f32x2* pp = pw + ((size_t)(g * 2 + d) * 17 + j) * 64; const f32x2* bb = bbar + ((size_t)(g * 2 + d) * 64) * 16 + cp;
    float s = 0.f;
#pragma unroll 16
    for (int n = 0; n < 64; ++n) { const f32x2 pv = pp[n]; const f32x2 bv = bb[(size_t)n * 16]; const float er = cr[n] * pv.x - ci[n] * pv.y, ei = cr[n] * pv.y + ci[n] * pv.x; s += er * bv.x - ei * bv.y; }
    return s;
}
__device__ __forceinline__ void s5_assemble_a(const int TID, const int BID, const Params& p, int l) {
    const f32x2* pw = (const f32x2*)(p.ws + WS_PW) + l * PWL; const f32x2* bbar = (const f32x2*)(p.ws + WS_BBAR) + l * BBL;
    float* kmat = (float*)(p.ws + WS_KMAT); bf16_t* pmat = (bf16_t*)(p.ws + WS_PMAT);
    const float* cre = p.in[10]; const float* cim = p.in[11];
    const size_t stride = (size_t)gridDim.x * 512;
    for (size_t idx = (size_t)BID * 512 + TID; idx < (size_t)32 * 2 * 16 * 256; idx += stride) {
        const int g = (int)(idx >> 13), d = (int)(idx >> 12) & 1, j = (int)(idx >> 8) & 15, c = (int)(idx >> 4) & 15, cp = (int)idx & 15;
        kmat[idx] = s5_kval(cre, cim, pw, bbar, l, g, d, j, c, cp);
    }
    for (size_t idx = (size_t)BID * 512 + TID; idx < (size_t)32 * 256 * 256; idx += stride) {
        const int g = (int)(idx >> 16), nout = (int)(idx >> 8) & 255, k = (int)idx & 255, d = nout >> 7, ri = (nout >> 6) & 1, n = nout & 63, s = k >> 4, cp = k & 15, j = d == 0 ? 15 - s : s;
        const f32x2 pv = pw[((size_t)(g * 2 + d) * 17 + j) * 64 + n]; const f32x2 bv = bbar[((size_t)(g * 2 + d) * 64 + n) * 16 + cp];
        pmat[idx] = f2bf(ri == 0 ? pv.x * bv.x - pv.y * bv.y : pv.x * bv.y + pv.y * bv.x);
    }
}
__device__ __forceinline__ void s5_assemble_w(const int TID, const int BID, const Params& p, int l) {
    const f32x2* pw = (const f32x2*)(p.ws + WS_PW) + l * PWL; const float* kmat = (const float*)(p.ws + WS_KMAT);
    bf16_t* wmat = (bf16_t*)(p.ws + WS_WMAT);
    const float* cre = p.in[10]; const float* cim = p.in[11];
    const size_t stride = (size_t)gridDim.x * 512;
    for (size_t idx = (size_t)BID * 512 + TID; idx < (size_t)32 * 256 * 512; idx += stride) {
        const int g = (int)(idx >> 17), nout = (int)(idx >> 9) & 255, k = (int)idx & 511, t = nout >> 4, c = nout & 15;
        float val;
        if (k < 256) { const int s = k >> 4, cp = k & 15; val = 0.f;
            const int jf = s <= t ? t - s : 0, jb = s >= t ? s - t : 0;
            const float kf = kmat[((((size_t)g * 2 + 0) * 16 + jf) * 16 + c) * 16 + cp], kb = kmat[((((size_t)g * 2 + 1) * 16 + jb) * 16 + c) * 16 + cp], dsk = p.in[12][l * 512 + g * 16 + c];
            val = (s <= t ? kf : 0.f) + (s >= t ? kb : 0.f) + ((s == t && c == cp) ? dsk : 0.f);
        } else { const int kk = k - 256, d = kk >> 7, ri = (kk >> 6) & 1, n = kk & 63, j = d == 0 ? t + 1 : 16 - t;
            const float cr = cre[(((size_t)(l * 2 + d) * 32 + g) * 16 + c) * 64 + n], ci = cim[(((size_t)(l * 2 + d) * 32 + g) * 16 + c) * 64 + n];
            const f32x2 pv = pw[((size_t)(g * 2 + d) * 17 + j) * 64 + n];
            val = ri == 0 ? cr * pv.x - ci * pv.y : -(cr * pv.y + ci * pv.x); }
        wmat[idx] = f2bf(val);
    }
}

__device__ __forceinline__ void scans_phase(const int TID, const int BID, const Params& p, const int l, const bool do_gla) {
    const int G = gridDim.x;
    const bool split = (G == 256);
    {
        const f32x2* pw = (const f32x2*)(p.ws + WS_PW) + l * PWL; const float* st = (const float*)(p.ws + WS_ST); bf16_t* ub = (bf16_t*)(p.ws + WS_UBUF);
        for (int idx = BID * 512 + TID; idx < 40960; idx += G * 512) {
            const int seq = idx >> 12, rem = idx & 4095, g = rem >> 7, d = (rem >> 6) & 1, n = rem & 63;
            const int ch0 = seq < 2 ? seq * 257 : 514 + (seq - 2) * 129, nc = seq < 2 ? 257 : 129;
            const f32x2 a16 = pw[((size_t)(g * 2 + d) * 17 + 16) * 64 + n];
            float sr = 0.f, si = 0.f;
            for (int s0 = 0; s0 < nc; s0 += 32) {
                float lr[32], li[32];
#pragma unroll
                for (int i = 0; i < 32; ++i) { const int step = s0 + i; lr[i] = 0.f; li[i] = 0.f;
                    { const int sc = step < nc ? step : nc - 1; const int c = d == 0 ? sc : nc - 1 - sc; const size_t row = (size_t)g * CHP + ch0 + c; lr[i] = st[row * 256 + d * 128 + n]; li[i] = st[row * 256 + d * 128 + 64 + n]; } }
#pragma unroll
                for (int i = 0; i < 32; ++i) { const int step = s0 + i;
                    if (step < nc) { const int c = d == 0 ? step : nc - 1 - step; const size_t row = (size_t)g * CHP + ch0 + c;
                        ub[row * 512 + 256 + d * 128 + n] = f2bf(sr); ub[row * 512 + 256 + d * 128 + 64 + n] = f2bf(si);
                        const float nr = a16.x * sr - a16.y * si + lr[i], ni = a16.x * si + a16.y * sr + li[i]; sr = nr; si = ni; } }
            }
        }
    }
    {
        const float* la = (const float*)(p.ws + WS_LRUA); const float* lh = (const float*)(p.ws + WS_LRUH); float* lc = (float*)(p.ws + WS_LRUC);
        const int vb0 = split ? BID - 80 : BID, vstride = split ? 1 << 20 : G;
        for (int vb = vb0; vb >= 0 && vb < 40; vb += vstride) {
            const int idx = vb * 512 + TID;
            const int seq = idx >> 11, d = (idx >> 10) & 1, ch = idx & 1023;
            const int cb = seq < 2 ? seq * 65 : 130 + (seq - 2) * 33, nc = seq < 2 ? 65 : 33;
            float cin = 0.f;
            for (int s0 = 0; s0 < nc; s0 += 16) {
                float A[16], H[16];
#pragma unroll
                for (int i = 0; i < 16; ++i) { const int step = s0 + i; A[i] = 1.f; H[i] = 0.f;
                    { const int sc = step < nc ? step : nc - 1; const int ci = cb + (d == 0 ? sc : nc - 1 - sc); const size_t o = ((size_t)ci * 2 + d) * 1024 + ch; A[i] = la[o]; H[i] = lh[o]; } }
#pragma unroll
                for (int i = 0; i < 16; ++i) { const int step = s0 + i;
                    if (step < nc) { const int ci = cb + (d == 0 ? step : nc - 1 - step); const size_t o = ((size_t)ci * 2 + d) * 1024 + ch; lc[o] = cin; cin = A[i] * cin + H[i]; } }
            }
        }
    }
    if (do_gla) {
        float* ds = (float*)(p.ws + WS_DS); const float* dec = (const float*)(p.ws + WS_DECAY);
        for (int it = 0; ; ++it) {
            int vb;
            if (split) { if (BID >= 120) { if (it >= 8) break; vb = (BID - 120) + 136 * it; } else { vb = 1088 + BID + 120 * it; if (vb >= 1280) break; } }
            else { vb = BID + G * it; if (vb >= 1280) break; }
            const int e = vb * 512 + TID;
            const int seq = e >> 16, rem = e & 65535, head = rem >> 14, d = (rem >> 13) & 1, el = rem & 8191, kk = el & 63;
            const int cb = seq < 2 ? seq * 65 : 130 + (seq - 2) * 33, nc = seq < 2 ? 65 : 33;
            float S = 0.f;
            for (int s0 = 0; s0 < nc; s0 += 16) {
                float tm[16], dc[16];
#pragma unroll
                for (int i = 0; i < 16; ++i) { const int step = s0 + i; tm[i] = 0.f; dc[i] = 1.f;
                    { const int sc = step < nc ? step : nc - 1; const int ci = cb + (d == 0 ? sc : nc - 1 - sc); const size_t o = ((size_t)(ci * 4 + head) * 2 + d); tm[i] = ds[o * 8192 + el]; dc[i] = dec[o * 64 + kk]; } }
#pragma unroll
                for (int i = 0; i < 16; ++i) { const int step = s0 + i;
                    if (step < nc) { const int ci = cb + (d == 0 ? step : nc - 1 - step); const size_t o = ((size_t)(ci * 4 + head) * 2 + d); ds[o * 8192 + el] = S; S = dc[i] * S + tm[i]; } }
            }
        }
    }
}

__device__ __forceinline__ f32x4 mma_lds(f32x4 acc, const LAS bf16_t* A, const LAS bf16_t* B, int ld, int nks, int lane) {
    const LAS bf16_t* ap = A + (lane & 15) * ld + (lane >> 4) * 8; const LAS bf16_t* bp = B + (lane & 15) * ld + (lane >> 4) * 8;
    for (int ks = 0; ks < nks; ++ks) acc = __builtin_amdgcn_mfma_f32_16x16x32_bf16(*(const LAS bf16x8*)(ap + ks * 32), *(const LAS bf16x8*)(bp + ks * 32), acc, 0, 0, 0);
    return acc;
}
constexpr int GL_GLR = 0, GL_BF = 16384, GL_BB = 32768, GL_OS = 0, GL_QE0 = 49152, GL_QE1 = 58368, GL_KE0 = 67584, GL_KE1 = 76800, GL_VT = 86016, GL_ATT = 104448, GL_SP0 = 113664, GL_SP1 = 132096;
constexpr int GLD = 72;
template <int MODE>
__device__ __forceinline__ void gla_item(const int TID, const Params& p, int l, int ci, int head, LAS unsigned char* lds, const float (&wg)[2][16], const float (&bg)[2], const float (&ngv)[16]) {
    const int tid = TID, lane = tid & 63, wid = tid >> 6;
    const bf16_t* cols = (const bf16_t*)(p.ws + WS_COLS);
    int seq, c; chunk_info(ci, seq, c);
    const int tok0 = seq_start(seq) + (c == 0 ? -48 : 16 + 64 * (c - 1));
    const int rmin = (c == 0) ? 48 : 0;
    LAS float* glr_s = (LAS float*)(lds + GL_GLR); LAS float* bfs = (LAS float*)(lds + GL_BF); LAS float* bbs = (LAS float*)(lds + GL_BB);
    u32x4 kw = (u32x4){0u, 0u, 0u, 0u}, qw = kw, vwp[2], gwp[2];
    { const int r = tid >> 3, k8 = (tid & 7) * 8; const int rc = r >= rmin ? r : rmin; const bf16_t* rowp = cols + (size_t)(tok0 + rc) * NINP;
      kw = *(const u32x4*)(rowp + C_K + head * 64 + k8); if (MODE == 1) qw = *(const u32x4*)(rowp + C_Q + head * 64 + k8);
#pragma unroll
      for (int hh = 0; hh < 2; ++hh) { vwp[hh] = *(const u32x4*)(rowp + C_V + head * 128 + ((tid & 7) + 8 * hh) * 8); if (MODE == 1) gwp[hh] = *(const u32x4*)(rowp + C_GB + head * 128 + (tid & 7) * 16 + hh * 8); } }
    { const int r = tid >> 3, j4 = (tid & 7) * 4; f32x4 v = (f32x4){0.f, 0.f, 0.f, 0.f};
      { const int rc = r >= rmin ? r : rmin; const u32x2 w = *(const u32x2*)(cols + (size_t)(tok0 + rc) * NINP + C_GLR + j4); if (r >= rmin) { v[0] = bflo(w.x); v[1] = bfhi(w.x); v[2] = bflo(w.y); v[3] = bfhi(w.y); } }
      *(LAS f32x4*)(glr_s + r * 32 + j4) = v; }
    __syncthreads();
    { const int kk = tid & 63, rb = tid >> 6;
#pragma unroll
      for (int i = 0; i < 8; ++i) { const int r = rb + 8 * i; float x0 = bg[0], x1 = bg[1]; f32x4 gr[8];
#pragma unroll
          for (int j4 = 0; j4 < 8; ++j4) gr[j4] = *(const LAS f32x4*)(glr_s + r * 32 + j4 * 4);
#pragma unroll
          for (int j = 0; j < 16; ++j) { x0 += gr[j >> 2][j & 3] * wg[0][j]; x1 += gr[4 + (j >> 2)][j & 3] * wg[1][j]; }
          const bool ok = r >= rmin; bfs[r * 64 + kk] = ok ? logsig(x0) * 0.0625f : 0.f; bbs[r * 64 + kk] = ok ? logsig(x1) * 0.0625f : 0.f; } }
    __syncthreads();
    { const int col = tid & 127, part = tid >> 7, d = col >> 6, kk = col & 63; LAS float* bs = d ? bbs : bfs; LAS float* tot = glr_s;
      float v[16];
#pragma unroll
      for (int i = 0; i < 16; ++i) v[i] = bs[(part * 16 + i) * 64 + kk];
      if (d == 0) {
#pragma unroll
          for (int i = 1; i < 16; ++i) v[i] += v[i - 1];
          tot[part * 128 + col] = v[15]; }
      else {
#pragma unroll
          for (int i = 14; i >= 0; --i) v[i] += v[i + 1];
          tot[part * 128 + col] = v[0]; }
      __syncthreads();
      float off = 0.f;
#pragma unroll
      for (int pp = 0; pp < 4; ++pp) { const float t = tot[pp * 128 + col]; if (d == 0 ? pp < part : pp > part) off += t; }
#pragma unroll
      for (int i = 0; i < 16; ++i) bs[(part * 16 + i) * 64 + kk] = v[i] + off; }
    __syncthreads();
    LAS bf16_t* vT = (LAS bf16_t*)(lds + GL_VT);
    { const int r = tid >> 3, k8 = (tid & 7) * 8; const bool ok = r >= rmin;
      if (!ok) { kw = (u32x4){0u, 0u, 0u, 0u}; qw = kw; }
      float qv[8], kv[8];
#pragma unroll
      for (int i = 0; i < 4; ++i) { qv[2 * i] = bflo(qw[i]); qv[2 * i + 1] = bfhi(qw[i]); kv[2 * i] = bflo(kw[i]); kv[2 * i + 1] = bfhi(kw[i]); }
      if (MODE == 0) { LAS bf16_t* kd0 = (LAS bf16_t*)(lds + GL_QE0); LAS bf16_t* kd1 = (LAS bf16_t*)(lds + GL_QE1);
#pragma unroll
          for (int i = 0; i < 8; ++i) { const int kk = k8 + i; kd0[kk * GLD + r] = f2bf(kv[i] * __expf(bfs[63 * 64 + kk] - bfs[r * 64 + kk])); kd1[kk * GLD + r] = f2bf(kv[i] * __expf(bbs[kk] - bbs[r * 64 + kk])); }
      } else { LAS bf16_t* qe0 = (LAS bf16_t*)(lds + GL_QE0); LAS bf16_t* qe1 = (LAS bf16_t*)(lds + GL_QE1); LAS bf16_t* ke0 = (LAS bf16_t*)(lds + GL_KE0); LAS bf16_t* ke1 = (LAS bf16_t*)(lds + GL_KE1);
          u32x4 a, b2, c2, d2;
#pragma unroll
          for (int i = 0; i < 4; ++i) { const int kk = k8 + 2 * i; const float f0 = bfs[r * 64 + kk], f1 = bfs[r * 64 + kk + 1], g0 = bbs[r * 64 + kk], g1 = bbs[r * 64 + kk + 1];
              a[i] = cvt_pk_bf16(qv[2 * i] * 0.125f * __expf(f0), qv[2 * i + 1] * 0.125f * __expf(f1)); b2[i] = cvt_pk_bf16(qv[2 * i] * 0.125f * __expf(g0), qv[2 * i + 1] * 0.125f * __expf(g1));
              c2[i] = cvt_pk_bf16(kv[2 * i] * __expf(-f0), kv[2 * i + 1] * __expf(-f1)); d2[i] = cvt_pk_bf16(kv[2 * i] * __expf(-g0), kv[2 * i + 1] * __expf(-g1)); }
          *(LAS u32x4*)(qe0 + r * GLD + k8) = a; *(LAS u32x4*)(qe1 + r * GLD + k8) = b2; *(LAS u32x4*)(ke0 + r * GLD + k8) = c2; *(LAS u32x4*)(ke1 + r * GLD + k8) = d2; }
#pragma unroll
      for (int hh = 0; hh < 2; ++hh) { const int v8 = ((tid & 7) + 8 * hh) * 8; u32x4 vw = (u32x4){0u, 0u, 0u, 0u};
          if (ok) vw = vwp[hh];
#pragma unroll
          for (int i = 0; i < 4; ++i) { vT[(v8 + 2 * i) * GLD + r] = (bf16_t)(vw[i] & 0xffffu); vT[(v8 + 2 * i + 1) * GLD + r] = (bf16_t)(vw[i] >> 16); } }
    }
    if (MODE == 1) {
        const float* ds = (const float*)(p.ws + WS_DS); f32x4 sv[2][4];
#pragma unroll
        for (int d = 0; d < 2; ++d) { const float* src = ds + ((size_t)(ci * 4 + head) * 2 + d) * 8192;
#pragma unroll
            for (int i = 0; i < 4; ++i) sv[d][i] = *(const f32x4*)(src + (i * 512 + tid) * 4); }
#pragma unroll
        for (int d = 0; d < 2; ++d) { LAS bf16_t* sp = (LAS bf16_t*)(lds + (d ? GL_SP1 : GL_SP0));
#pragma unroll
            for (int i = 0; i < 4; ++i) { const int e = (i * 512 + tid) * 4; const f32x4 v = sv[d][i]; u32x2 w; w.x = cvt_pk_bf16(v[0], v[1]); w.y = cvt_pk_bf16(v[2], v[3]); *(LAS u32x2*)(sp + (e >> 6) * GLD + (e & 63)) = w; } }
    }
    __syncthreads();
    if (MODE == 0) {
        float* ds = (float*)(p.ws + WS_DS); float* dec = (float*)(p.ws + WS_DECAY);
        if (tid < 128) { const int d = tid >> 6, kk = tid & 63; dec[((size_t)(ci * 4 + head) * 2 + d) * 64 + kk] = __expf(d == 0 ? bfs[63 * 64 + kk] : bbs[kk]); }
#pragma unroll
        for (int d = 0; d < 2; ++d) { const LAS bf16_t* kd = (const LAS bf16_t*)(lds + (d ? GL_QE1 : GL_QE0)); float* dst = ds + ((size_t)(ci * 4 + head) * 2 + d) * 8192;
            for (int kt = 0; kt < 4; ++kt) { f32x4 acc = (f32x4){0.f, 0.f, 0.f, 0.f}; acc = mma_lds(acc, vT + wid * 16 * GLD, kd + kt * 16 * GLD, GLD, 2, lane);
#pragma unroll
                for (int j = 0; j < 4; ++j) dst[(wid * 16 + (lane >> 4) * 4 + j) * 64 + kt * 16 + (lane & 15)] = acc[j]; } }
        __syncthreads();
        return;
    }
    const LAS bf16_t* qe0 = (const LAS bf16_t*)(lds + GL_QE0); const LAS bf16_t* qe1 = (const LAS bf16_t*)(lds + GL_QE1); const LAS bf16_t* ke0 = (const LAS bf16_t*)(lds + GL_KE0); const LAS bf16_t* ke1 = (const LAS bf16_t*)(lds + GL_KE1);
    LAS bf16_t* att = (LAS bf16_t*)(lds + GL_ATT);
    { const int it = wid >> 1;
#pragma unroll
      for (int t2 = 0; t2 < 2; ++t2) { const int jt = (wid & 1) * 2 + t2; f32x4 af = (f32x4){0.f, 0.f, 0.f, 0.f}, ab = af;
          af = mma_lds(af, qe0 + it * 16 * GLD, ke0 + jt * 16 * GLD, GLD, 2, lane); ab = mma_lds(ab, qe1 + it * 16 * GLD, ke1 + jt * 16 * GLD, GLD, 2, lane);
#pragma unroll
          for (int j = 0; j < 4; ++j) { const int i_ = it * 16 + (lane >> 4) * 4 + j, j_ = jt * 16 + (lane & 15); att[i_ * GLD + j_] = f2bf((j_ <= i_ ? af[j] : 0.f) + (j_ >= i_ ? ab[j] : 0.f)); } } }
    __syncthreads();
    LAS float* os = (LAS float*)(lds + GL_OS);
    { const int it = wid >> 1; const LAS bf16_t* sp0 = (const LAS bf16_t*)(lds + GL_SP0); const LAS bf16_t* sp1 = (const LAS bf16_t*)(lds + GL_SP1);
#pragma unroll
      for (int t4 = 0; t4 < 4; ++t4) { const int vt = (wid & 1) * 4 + t4; f32x4 acc = (f32x4){0.f, 0.f, 0.f, 0.f};
          acc = mma_lds(acc, att + it * 16 * GLD, vT + vt * 16 * GLD, GLD, 2, lane); acc = mma_lds(acc, qe0 + it * 16 * GLD, sp0 + vt * 16 * GLD, GLD, 2, lane); acc = mma_lds(acc, qe1 + it * 16 * GLD, sp1 + vt * 16 * GLD, GLD, 2, lane);
#pragma unroll
          for (int j = 0; j < 4; ++j) os[(it * 16 + (lane >> 4) * 4 + j) * 132 + vt * 16 + (lane & 15)] = acc[j]; } }
    __syncthreads();
    { const int r = tid >> 3, v0 = (tid & 7) * 16; float o[16]; float ss = 0.f;
#pragma unroll
      for (int i = 0; i < 16; ++i) { o[i] = os[r * 132 + v0 + i]; ss += o[i] * o[i]; }
      ss += __shfl_xor(ss, 1); ss += __shfl_xor(ss, 2); ss += __shfl_xor(ss, 4);
      const float rs = rsqrtf(ss * (1.0f / 128.0f) + 1e-6f);
      if (r >= rmin) { const size_t tok = (size_t)(tok0 + r); bf16_t* yall = (bf16_t*)(p.ws + WS_YALL);
#pragma unroll
          for (int hh = 0; hh < 2; ++hh) { const u32x4 gw = gwp[hh]; u32x4 w;
#pragma unroll
              for (int i = 0; i < 4; ++i) { const int e = hh * 8 + 2 * i; w[i] = cvt_pk_bf16(o[e] * rs * ngv[e] * silu(bflo(gw[i])), o[e + 1] * rs * ngv[e + 1] * silu(bfhi(gw[i]))); }
              *(u32x4*)(yall + tok * D + 512 + head * 128 + v0 + hh * 8) = w; } } }
    __syncthreads();
}

__device__ __forceinline__ float softplus_neg(float lam) { const float e = __expf(-lam); return lam + 0.f < -8.f ? -lam : (e < 0.02f ? e * (1.0f - e * (0.5f - e * (1.0f / 3.0f))) : __logf(1.0f + e)); }
__device__ __forceinline__ float one_minus_exp(float x) {
    return x > -0.5f ? -x * (1.0f + x * 0.5f * (1.0f + x * (1.0f / 3.0f) * (1.0f + x * 0.25f * (1.0f + x * 0.2f * (1.0f + x * (1.0f / 6.0f) * (1.0f + x * (1.0f / 7.0f))))))) : 1.0f - __expf(x);
}
template <int MODE>
__device__ __forceinline__ void lru_phase(const int TID, const int b, const int G, const Params& p, int l, LAS unsigned char* lds) {
    const int tid = TID, lane = tid & 63, wid = tid >> 6, q = lane >> 4;
    const bf16_t* cols = (const bf16_t*)(p.ws + WS_COLS);
    int it = b; if (it >= NCK * 8) return;
    const int nb = b & 7;
    LAS bf16_t* xcA = (LAS bf16_t*)lds; LAS float* xcf = (LAS float*)(lds + 17408);
    const int ch = tid & 127, rb = tid >> 7, gchc = nb * 128 + ch;
    const float w0 = p.in[18][(l * 4 + 0) * 1024 + gchc], w1 = p.in[18][(l * 4 + 1) * 1024 + gchc], w2 = p.in[18][(l * 4 + 2) * 1024 + gchc], w3 = p.in[18][(l * 4 + 3) * 1024 + gchc], cb = p.in[19][l * 1024 + gchc];
    const int chl = wid * 16 + (lane & 15), gch = nb * 128 + chl;
    float ba[2], bx[2], sp8[2];
#pragma unroll
    for (int d = 0; d < 2; ++d) { ba[d] = p.in[21][(l * 2 + d) * 1024 + gch]; bx[d] = p.in[23][(l * 2 + d) * 1024 + gch]; sp8[d] = 8.0f * softplus_neg(p.in[24][(l * 2 + d) * 1024 + gch]); }
    bf16x8 bfr[4][4];
    { const bf16_t* bt = (const bf16_t*)(p.ws + WS_BTLRU);
#pragma unroll
      for (int mat = 0; mat < 4; ++mat)
#pragma unroll
          for (int ks = 0; ks < 4; ++ks) bfr[mat][ks] = *(const bf16x8*)(bt + ((size_t)(mat * 8 + nb) * 128 + wid * 16 + (lane & 15)) * 128 + ks * 32 + q * 8); }
    bf16_t xr[19];
    { int seq, c; chunk_info(it >> 3, seq, c); const int s0 = seq_start(seq), L = seq_len(seq), pos0 = (c == 0 ? -48 : 16 + 64 * (c - 1));
      const bf16_t* xb = cols + (size_t)s0 * NINP + C_XC + gchc;
#pragma unroll
      for (int i = 0; i < 19; ++i) { const int pos = pos0 + rb * 16 - 2 + i; const int pc = pos < 0 ? 0 : (pos < L ? pos : L - 1); xr[i] = xb[(size_t)pc * NINP]; } }
    for (; it < NCK * 8; it += G) {
        const int ci = it >> 3;
        int seq, c; chunk_info(ci, seq, c);
        const int s0 = seq_start(seq);
        const int pos0 = (c == 0 ? -48 : 16 + 64 * (c - 1));
        const int rmin = (c == 0) ? 48 : 0;
        float xv[19];
        { const int L = seq_len(seq);
#pragma unroll
          for (int i = 0; i < 19; ++i) { const int pos = pos0 + rb * 16 - 2 + i; xv[i] = (pos >= 0 && pos < L) ? bf2f(xr[i]) : 0.f; } }
#pragma unroll
        for (int i = 0; i < 16; ++i) { const int r = rb * 16 + i; const float xc = (r >= rmin) ? cb + xv[i] * w0 + xv[i + 1] * w1 + xv[i + 2] * w2 + xv[i + 3] * w3 : 0.f;
            xcf[r * 132 + ch] = xc; xcA[r * 136 + ch] = f2bf(xc); }
        u32x4 gq[2]; float cin[2];
        if (MODE == 1) {
#pragma unroll
            for (int d = 0; d < 2; ++d) cin[d] = ((const float*)(p.ws + WS_LRUC))[((size_t)ci * 2 + d) * 1024 + gch];
            { const int r = tid >> 3; const int rr = r >= rmin ? r : rmin; const bf16_t* gp = cols + (size_t)(s0 + pos0 + rr) * NINP + C_GC + nb * 128 + (tid & 7) * 16;
              gq[0] = *(const u32x4*)gp; gq[1] = *(const u32x4*)(gp + 8); }
        }
        { const int itn = it + G;
          if (itn < NCK * 8) { int seqn, cn; chunk_info(itn >> 3, seqn, cn); const int s0n = seq_start(seqn), Ln = seq_len(seqn), pos0n = (cn == 0 ? -48 : 16 + 64 * (cn - 1));
              const bf16_t* xb = cols + (size_t)s0n * NINP + C_XC + gchc;
#pragma unroll
              for (int i = 0; i < 19; ++i) { const int pos = pos0n + rb * 16 - 2 + i; const int pc = pos < 0 ? 0 : (pos < Ln ? pos : Ln - 1); xr[i] = xb[(size_t)pc * NINP]; } } }
        LBAR();
        LAS bf16_t* gts = (LAS bf16_t*)(lds + 51200); LAS float* hfs = (LAS float*)(lds + 68608);
        float hsum[4][4];
#pragma unroll
        for (int d = 0; d < 2; ++d) {
            __builtin_amdgcn_sched_barrier(0);
            f32x4 acc[2][4];
#pragma unroll
            for (int rt = 0; rt < 4; ++rt) { bf16x8 afr[4];
#pragma unroll
                for (int ks = 0; ks < 4; ++ks) afr[ks] = *(const LAS bf16x8*)(xcA + (rt * 16 + (lane & 15)) * 136 + ks * 32 + q * 8);
#pragma unroll
                for (int kind = 0; kind < 2; ++kind) { f32x4 a = (f32x4){0.f, 0.f, 0.f, 0.f};
#pragma unroll
                    for (int ks = 0; ks < 4; ++ks) a = __builtin_amdgcn_mfma_f32_16x16x32_bf16(afr[ks], bfr[d * 2 + kind][ks], a, 0, 0, 0);
                    acc[kind][rt] = a; } }
            float a[4][4], bb[4][4];
#pragma unroll
            for (int rt = 0; rt < 4; ++rt)
#pragma unroll
                for (int j = 0; j < 4; ++j) { const int r = rt * 16 + q * 4 + j; const float rg = sigm(acc[0][rt][j] + ba[d]), ig = sigm(acc[1][rt][j] + bx[d]), la = -sp8[d] * rg;
                    const bool ok = r >= rmin; const float av = __expf(la), x2 = 2.0f * la; const float om = x2 > -0.5f ? -x2 * (1.0f + x2 * 0.5f * (1.0f + x2 * (1.0f / 3.0f) * (1.0f + x2 * 0.25f * (1.0f + x2 * 0.2f * (1.0f + x2 * (1.0f / 6.0f)))))) : 1.0f - av * av;
                    a[rt][j] = ok ? av : 1.0f; bb[rt][j] = ok ? __builtin_amdgcn_sqrtf(om) * ig * xcf[r * 132 + chl] : 0.f; }
            float LA[4], LB[4];
#pragma unroll
            for (int rt = 0; rt < 4; ++rt) { float A = 1.f, B = 0.f;
#pragma unroll
                for (int jj = 0; jj < 4; ++jj) { const int j = d == 0 ? jj : 3 - jj; B = a[rt][j] * B + bb[rt][j]; A *= a[rt][j]; }
                LA[rt] = A; LB[rt] = B; }
            const size_t co = ((size_t)ci * 2 + d) * 1024 + gch;
            float h = (MODE == 1) ? cin[d] : 0.f, Atot = 1.f; float hin[4];
#pragma unroll
            for (int rr = 0; rr < 4; ++rr) { const int rt = d == 0 ? rr : 3 - rr;
#pragma unroll
                for (int qi = 0; qi < 4; ++qi) { const int qq = d == 0 ? qi : 3 - qi;
                    const float Aq = __shfl(LA[rt], (lane & 15) + 16 * qq), Bq = __shfl(LB[rt], (lane & 15) + 16 * qq);
                    if (qq == q) hin[rt] = h;
                    h = Aq * h + Bq; Atot *= Aq; } }
            if (MODE == 0) { if (q == 0) { ((float*)(p.ws + WS_LRUA))[co] = Atot; ((float*)(p.ws + WS_LRUH))[co] = h; } }
            else {
#pragma unroll
                for (int rt = 0; rt < 4; ++rt) { float hh = hin[rt];
#pragma unroll
                    for (int jj = 0; jj < 4; ++jj) { const int j = d == 0 ? jj : 3 - jj; hh = a[rt][j] * hh + bb[rt][j];
                        if (d == 0) hfs[(rt * 16 + q * 4 + j) * 132 + chl] = hh; else hsum[rt][j] = hh; } }
                if (d == 0) { *(LAS u32x4*)(gts + (tid >> 3) * 136 + (tid & 7) * 16) = gq[0]; *(LAS u32x4*)(gts + (tid >> 3) * 136 + (tid & 7) * 16 + 8) = gq[1]; } }
        }
        if (MODE == 1) { bf16_t* yall = (bf16_t*)(p.ws + WS_YALL);
            LBAR();
#pragma unroll
            for (int rt = 0; rt < 4; ++rt)
#pragma unroll
                for (int j = 0; j < 4; ++j) { const int r = rt * 16 + q * 4 + j; xcA[r * 136 + chl] = f2bf((hsum[rt][j] + hfs[r * 132 + chl]) * silu(bf2f(gts[r * 136 + chl]))); }
            LBAR();
            { const int r = tid >> 3; if (r >= rmin) { const u32x4 y0 = *(const LAS u32x4*)(xcA + r * 136 + (tid & 7) * 16), y1 = *(const LAS u32x4*)(xcA + r * 136 + (tid & 7) * 16 + 8);
                bf16_t* yp = yall + (size_t)(s0 + pos0 + r) * D + 1024 + nb * 128 + (tid & 7) * 16; *(u32x4*)yp = y0; *(u32x4*)(yp + 8) = y1; } } }
        LBAR();
    }
}


template <int WHICH>
__device__ __forceinline__ void skinny_tail(const int TID, const int b0, const Params& p) {
    const int lane = TID & 63, wid = TID >> 6, q = lane >> 4;
    if (wid >= 5) return;
    for (int b = b0; b < 256; b += (int)gridDim.x) {
    const int ct = b & 127, rt = (b >> 7) * 5 + wid;
    const int row = 24576 + rt * 16 + (lane & 15);
    const int colb = ct * 16 + (lane & 15);
    const bf16_t* cols = (const bf16_t*)(p.ws + WS_COLS);
    if (WHICH == 0) {
        const bf16_t* A = (const bf16_t*)(p.ws + WS_YALL) + (size_t)row * D + q * 8; const bf16_t* B = (const bf16_t*)(p.ws + WS_BTOUT) + (size_t)colb * D + q * 8;
        bf16_t* mbf = (bf16_t*)(p.ws + WS_H);
        f32x4 msum = (f32x4){0.f, 0.f, 0.f, 0.f};
        unsigned char gt[3][4];
#pragma unroll
        for (int br = 0; br < 3; ++br)
#pragma unroll
            for (int j = 0; j < 4; ++j) { const int cc = colb & 255; gt[br][j] = ((const unsigned char*)(cols + (size_t)(24576 + rt * 16 + q * 4 + j) * NINP + C_MG))[(br * 8 + (colb >> 8)) * 256 + ((((cc & 127) >> 5) * 4 + ((cc & 31) >> 3)) * 2 + (cc >> 7)) * 8 + (cc & 7)]; }
        float gs[3][4];
#pragma unroll
        for (int br = 0; br < 3; ++br)
#pragma unroll
            for (int j = 0; j < 4; ++j) { gs[br][j] = (float)gt[br][j] * (1.0f / 255.0f); asm volatile("" : "+v"(gs[br][j])); }
#pragma unroll
        for (int br = 0; br < 3; ++br) { const int koff = br * 512, nks = br == 2 ? 32 : 16; f32x4 acc = (f32x4){0.f, 0.f, 0.f, 0.f};
            for (int k0 = 0; k0 < nks; k0 += 8) { bf16x8 av[8], bv[8];
#pragma unroll
                for (int i = 0; i < 8; ++i) { av[i] = *(const bf16x8*)(A + koff + (k0 + i) * 32); bv[i] = *(const bf16x8*)(B + koff + (k0 + i) * 32); }
#pragma unroll
                for (int i = 0; i < 8; ++i) acc = __builtin_amdgcn_mfma_f32_16x16x32_bf16(av[i], bv[i], acc, 0, 0, 0); }
#pragma unroll
            for (int j = 0; j < 4; ++j) msum[j] += gs[br][j] * acc[j]; }
#pragma unroll
        for (int j = 0; j < 4; ++j) { const int tok = 24576 + rt * 16 + q * 4 + j; mbf[(size_t)tok * D + colb] = f2bf(msum[j]); }
    } else {
        const bf16_t* A = (const bf16_t*)(p.ws + WS_H) + (size_t)row * D + q * 8; const bf16_t* B = (const bf16_t*)(p.ws + WS_BTO) + (size_t)colb * D + q * 8;
        float* z = (float*)(p.ws + WS_Z);
        f32x4 acc = (f32x4){0.f, 0.f, 0.f, 0.f};
        for (int k0 = 0; k0 < 64; k0 += 8) { bf16x8 av[8], bv[8];
#pragma unroll
            for (int i = 0; i < 8; ++i) { av[i] = *(const bf16x8*)(A + (k0 + i) * 32); bv[i] = *(const bf16x8*)(B + (k0 + i) * 32); }
#pragma unroll
            for (int i = 0; i < 8; ++i) acc = __builtin_amdgcn_mfma_f32_16x16x32_bf16(av[i], bv[i], acc, 0, 0, 0); }
#pragma unroll
        for (int j = 0; j < 4; ++j) { const int tok = 24576 + rt * 16 + q * 4 + j; z[(size_t)tok * D + colb] += acc[j]; }
    }
    }
}

#define XB_TMO      128
#define XB_XCNT(j)  (256  + 64 * (j))
#define XB_XSUB(j)  (1280 + 64 * (j))
#define XB_XGEN(j)  (2304 + 64 * (j))
#define XB_TOP      3328
#define XB_TOPGEN   3392
#define XCD_BAR_WORDS 3456
#define XB_SPIN_CAP (1u << 18)
__device__ __forceinline__ unsigned xb_ld(unsigned* p)              { return __hip_atomic_load(p, __ATOMIC_RELAXED, __HIP_MEMORY_SCOPE_AGENT); }
__device__ __forceinline__ unsigned xb_add(unsigned* p, unsigned v) { return __hip_atomic_fetch_add(p, v, __ATOMIC_RELAXED, __HIP_MEMORY_SCOPE_AGENT); }
__device__ __forceinline__ unsigned xb_xcc_id() { return (unsigned)__builtin_amdgcn_s_getreg((3 << 11) | 20) & 0xFu; }
#define XB_SPIN(cond, bar) do { unsigned _sp = 0; while (cond) { __builtin_amdgcn_s_sleep(1); \
    if ((++_sp & 255u) == 0u) { if (xb_ld(&(bar)[XB_TMO])) break; if (_sp > XB_SPIN_CAP) { atomicAdd(&(bar)[XB_TMO], 1u); break; } } } } while (0)
struct XcdBarrier { unsigned* bar; unsigned x; volatile LAS unsigned* st; };
__device__ __forceinline__ XcdBarrier xcd_barrier_post(unsigned* bar, volatile LAS unsigned* st) {
    XcdBarrier b; b.bar = bar; b.x = xb_xcc_id(); b.st = st;
    if (threadIdx.x == 0) (void)xb_add(&bar[XB_XCNT(b.x)], 1u);
    return b;
}
__device__ __forceinline__ void xcd_barrier_complete(unsigned* bar, unsigned x, unsigned& nloc, unsigned& nx) {
    const unsigned G = gridDim.x * gridDim.y * gridDim.z;
    unsigned sum, cnt, mine, sp = 0u;
    for (;;) {
        sum = 0u; cnt = 0u; mine = 0u;
#pragma unroll
        for (unsigned j = 0; j < 16; ++j) { const unsigned c = xb_ld(&bar[XB_XCNT(j)]); sum += c; cnt += (c > 0u) ? 1u : 0u; mine = (j == x) ? c : mine; }
        if (sum == G) break;
        __builtin_amdgcn_s_sleep(1);
        if ((++sp & 255u) == 0u) { if (xb_ld(&bar[XB_TMO])) break; if (sp > XB_SPIN_CAP) { atomicAdd(&bar[XB_TMO], 1u); break; } }
    }
    nloc = mine > 0u ? mine : 1u; nx = cnt > 0u ? cnt : 1u;
}
__device__ __forceinline__ void xcd_barrier(const XcdBarrier& b) {
    asm volatile("s_waitcnt vmcnt(0)" ::: "memory");
    __syncthreads();
    if (threadIdx.x == 0) {
        unsigned* bar = b.bar;
        __builtin_amdgcn_s_waitcnt(0);
        unsigned nloc = b.st[0], nx = b.st[1];
        if (nloc == 0u) { xcd_barrier_complete(bar, b.x, nloc, nx); b.st[0] = nloc; b.st[1] = nx; }
        const unsigned old = xb_add(&bar[XB_XSUB(b.x)], 1u);
        const unsigned gen = old / nloc;
        if (old + 1u == (gen + 1u) * nloc) {
            __builtin_amdgcn_fence(__ATOMIC_RELEASE, "agent");
            asm volatile("s_waitcnt vmcnt(0)" ::: "memory");
            const unsigned og = xb_add(&bar[XB_TOP], 1u);
            const unsigned tg = og / nx;
            if (og + 1u == (tg + 1u) * nx) xb_add(&bar[XB_TOPGEN], 1u);
            else XB_SPIN(xb_ld(&bar[XB_TOPGEN]) == tg, bar);
            __builtin_amdgcn_fence(__ATOMIC_ACQUIRE, "agent");
            xb_add(&bar[XB_XGEN(b.x)], 1u);
            asm volatile("s_waitcnt vmcnt(0)" ::: "memory");
        } else {
            XB_SPIN(xb_ld(&bar[XB_XGEN(b.x)]) == gen, bar);
            __builtin_amdgcn_fence(__ATOMIC_ACQUIRE, "agent");
            asm volatile("s_waitcnt vmcnt(0)" ::: "memory");
        }
    }
    __syncthreads();
}

__global__ void __launch_bounds__(512) fwd_megakernel(Params p_in) {
    extern __shared__ __attribute__((aligned(16))) unsigned char smem[];
    LAS unsigned char* lds = (LAS unsigned char*)smem;
    cg::grid_group grid = cg::this_grid();
    const int G = gridDim.x;
    const Params& p0 = p_in;
    volatile LAS unsigned* stw = (volatile LAS unsigned*)(lds + 150528);
    if (threadIdx.x == 0) { stw[0] = 0u; stw[1] = 0u; }
    __syncthreads();
    const XcdBarrier xb = xcd_barrier_post((unsigned*)(p_in.ws + WS_BAR), stw);
    for (int ph = p0.ph_lo; ph < p0.ph_hi; ++ph) {
        const int reps_ = (ph < 32 && (ph & 7) == DUP) ? 2 : 1;
        for (int rep_ = 0; rep_ < reps_; ++rep_) {
        int TID = threadIdx.x; asm volatile("" : "+v"(TID));
        int b = blockIdx.x; asm volatile("" : "+s"(b));
        Params p = p0; { unsigned long long t_ = (unsigned long long)p.ws; asm volatile("" : "+s"(t_)); p.ws = (unsigned char*)t_; }
        const char* ws = (const char*)p.ws;
        if (ph == 32) { final_norm_phase(TID, b, p); }
        else {
            const int l = ph >> 3, k = ph & 7;
            if (k == 0 && (PHM & 1)) { rmsnorm_phase(TID, b, p, l); convert_weights(TID, b, p, l, (LAS float*)lds); if (l == 0) s5_tables_all(TID, b, p); }
            else if (k == 1 && (PHM & 2)) {
                TileOrder S; S.nM = MP / 256; S.nN = NINP / 256; S.nwg = S.nM * S.nN; S.G = G; S.c = b; S.mult = 1; S.nt0 = D / 64; S.A = ws + WS_H; S.B = ws + WS_BTIN; S.tA = (size_t)256 * D * 2; S.tB = (size_t)256 * D * 2;
                EpiIn E; E.cols = (bf16_t*)(p.ws + WS_COLS); E.ubuf = (bf16_t*)(p.ws + WS_UBUF);
                gemm_phase(TID, lds, D, D, S, E);
                s5_assemble_a(TID, b, p, l);
            } else if (k == 2 && (PHM & 4)) {
                GroupOrder S; S.G = G; S.c = b; S.nt0 = 4; S.A = ws + WS_UBUF; S.B = ws + WS_PMAT; S.gsA = (size_t)CHP * 512 * 2; S.gsB = (size_t)256 * 256 * 2; S.tA = (size_t)256 * 512 * 2;
                EpiS5State E; E.st = (float*)(p.ws + WS_ST);
                if (SUBM & 4) gemm_phase(TID, lds, 512, 256, S, E);
                __syncthreads();
                { const int head_ = ((b + 128) % G) & 3, kk_ = TID & 63; float wg_[2][16], bg_[2];
                  _Pragma("unroll") for (int d = 0; d < 2; ++d) { bg_[d] = p.in[16][(l * 2 + d) * 256 + head_ * 64 + kk_]; _Pragma("unroll") for (int j = 0; j < 16; ++j) wg_[d][j] = p.in[15][((size_t)(l * 2 + d) * 16 + j) * 256 + head_ * 64 + kk_]; }
                  float ng_[16]; _Pragma("unroll") for (int e = 0; e < 16; ++e) ng_[e] = p.in[17][l * 512 + head_ * 128 + (TID & 7) * 16 + e];
                  for (int it = (b + 128) % G; it < NCK * 4; it += G) gla_item<0>(TID, p, l, it >> 2, it & 3, lds, wg_, bg_, ng_); }
                lru_phase<0>(TID, b, G, p, l, lds);
                s5_assemble_w(TID, b, p, l);
            } else if (k == 3 && (PHM & 8)) { scans_phase(TID, b, p, l, rep_ == 0); }
            else if (k == 4 && (PHM & 16)) {
                GroupOrder S; S.G = G; S.c = b; S.nt0 = 8; S.A = ws + WS_UBUF; S.B = ws + WS_WMAT; S.gsA = (size_t)CHP * 512 * 2; S.gsB = (size_t)256 * 512 * 2; S.tA = (size_t)256 * 512 * 2;
                EpiS5Out E; E.zs5 = (bf16_t*)(p.ws + WS_ZS5);
                if (SUBM & 4) gemm_phase(TID, lds, 512, 512, S, E);
                __syncthreads();
                { const int head_ = ((b + 128) % G) & 3, kk_ = TID & 63; float wg_[2][16], bg_[2];
                  _Pragma("unroll") for (int d = 0; d < 2; ++d) { bg_[d] = p.in[16][(l * 2 + d) * 256 + head_ * 64 + kk_]; _Pragma("unroll") for (int j = 0; j < 16; ++j) wg_[d][j] = p.in[15][((size_t)(l * 2 + d) * 16 + j) * 256 + head_ * 64 + kk_]; }
                  float ng_[16]; _Pragma("unroll") for (int e = 0; e < 16; ++e) ng_[e] = p.in[17][l * 512 + head_ * 128 + (TID & 7) * 16 + e];
                  for (int it = (b + 128) % G; it < NCK * 4; it += G) gla_item<1>(TID, p, l, it >> 2, it & 3, lds, wg_, bg_, ng_); }
                lru_phase<1>(TID, b, G, p, l, lds);
            } else if (k == 5 && (PHM & 32)) {
                TileOrder S; S.nM = MP / 256; S.nN = 2; S.nwg = S.nM * S.nN; S.G = G; S.c = b; S.mult = 1; S.nt0 = 8; S.A = ws + WS_ZS5; S.B = ws + WS_BTGLU; S.tA = (size_t)256 * 512 * 2; S.tB = (size_t)256 * 512 * 2;
                EpiGlu E; E.zs5 = (const bf16_t*)(p.ws + WS_ZS5); E.cols = (const bf16_t*)(p.ws + WS_COLS); E.bglu = p.in[14] + l * 512; E.yall = (bf16_t*)(p.ws + WS_YALL);
                gemm_phase(TID, lds, 512, 512, S, E);
            } else if (k == 6 && (PHM & 64)) {
                TileOrder S; S.nM = 96; S.nN = 8; S.nwg = S.nM * S.nN; S.G = G; S.c = b; S.mult = 3; S.nt0 = 8; S.A = ws + WS_YALL; S.B = ws + WS_BTOUT; S.tA = (size_t)256 * D * 2; S.tB = (size_t)256 * D * 2;
                EpiOut E; E.cols = (const bf16_t*)(p.ws + WS_COLS); E.mbf = (bf16_t*)(p.ws + WS_H);
                gemm_phase(TID, lds, D, D, S, E);
                skinny_tail<0>(TID, b, p);
            } else if (PHM & 128) {
                TileOrder S; S.nM = 96; S.nN = 8; S.nwg = S.nM * S.nN; S.G = G; S.c = b; S.mult = 1; S.nt0 = D / 64; S.A = ws + WS_H; S.B = ws + WS_BTO; S.tA = (size_t)256 * D * 2; S.tB = (size_t)256 * D * 2;
                EpiWo E; E.z = (float*)(p.ws + WS_Z);
                gemm_phase(TID, lds, D, D, S, E);
                skinny_tail<1>(TID, b, p);
            }
        }
        }
        if (p0.use_sync && ph + 1 < p0.ph_hi) { if (ph == p0.ph_lo) grid.sync(); else xcd_barrier(xb); }
    }
}

extern "C" void kernel_launch(void* const* d_in, const int* in_sizes, int n_in, void* d_out, int out_size, void* d_ws, size_t ws_size, hipStream_t stream) {
    static int grid = 0, coop = 1;
    if (grid == 0) {
        if (n_in != 30 || ws_size < WS_END) { fprintf(stderr, "kernel_launch: unexpected n_in %d or ws_size %zu (< %zu)\n", n_in, ws_size, (size_t)WS_END); grid = -1; return; }
        int dev = 0, cus = 0, per_cu = 0;
        (void)hipGetDevice(&dev); (void)hipDeviceGetAttribute(&cus, hipDeviceAttributeMultiprocessorCount, dev);
        if (hipFuncSetAttribute((const void*)fwd_megakernel, hipFuncAttributeMaxDynamicSharedMemorySize, LDS_BYTES) != hipSuccess) { fprintf(stderr, "kernel_launch: hipFuncSetAttribute failed\n"); grid = -1; return; }
        if (hipOccupancyMaxActiveBlocksPerMultiprocessor(&per_cu, (const void*)fwd_megakernel, 512, LDS_BYTES) != hipSuccess || per_cu < 1) { fprintf(stderr, "kernel_launch: occupancy query gave %d\n", per_cu); per_cu = 1; }
        (void)hipGetLastError();
        grid = cus * 1;
    }
    if (grid < 0) return;
    Params p{};
    for (int i = 0; i < 30; ++i) p.in[i] = (const float*)d_in[i];
    p.out = (float*)d_out; p.ws = (unsigned char*)d_ws; p.pad = 0;
    (void)hipMemsetAsync((char*)d_ws + WS_BAR, 0, 3456 * 4, stream);
    if (coop) {
        p.ph_lo = 0; p.ph_hi = 33; p.use_sync = 1;
        void* args[] = {&p};
        hipError_t e = hipLaunchCooperativeKernel((const void*)fwd_megakernel, dim3(grid), dim3(512), args, LDS_BYTES, stream);
        if (e == hipSuccess) return;
        fprintf(stderr, "kernel_launch: cooperative launch failed: %s (grid %d); falling back to one launch per phase\n", hipGetErrorString(e), grid);
        (void)hipGetLastError(); coop = 0;
    }
    for (int ph = 0; ph < 33; ++ph) { p.ph_lo = ph; p.ph_hi = ph + 1; p.use_sync = 0; hipLaunchKernelGGL(fwd_megakernel, dim3(grid), dim3(512), LDS_BYTES, stream, p); }
}
```

```cpp
#include <hip/hip_runtime.h>
#include <hip/hip_cooperative_groups.h>
#include <cstdio>
namespace cg = cooperative_groups;
#define LAS __attribute__((address_space(3)))
typedef unsigned short bf16_t;
typedef short bf16x8 __attribute__((ext_vector_type(8)));
typedef float f32x4 __attribute__((ext_vector_type(4)));
typedef float f32x2 __attribute__((ext_vector_type(2)));
typedef unsigned u32x2 __attribute__((ext_vector_type(2)));
typedef unsigned u32x4 __attribute__((ext_vector_type(4)));

constexpr int D = 2048, NTOK = 24736, MP = 24832, NINP = 11008, NIN = 10784;
constexpr int NCH16 = 1546, CHP = 1792, NCK = 394;
constexpr int C_GA = 512, C_Q = 1024, C_K = 1280, C_V = 1536, C_GB = 2048, C_XC = 2560, C_GC = 3584, C_MG = 4608, C_GLR = 10752;
constexpr int LDS_BYTES = 150528 + 16;
#ifndef SYNCREP
#define SYNCREP 1
#endif
#ifndef DUP
#define DUP -1
#endif
#ifndef SUBM
#define SUBM 7
#endif
#ifndef PHM
#define PHM 255
#endif

constexpr size_t al256(size_t x) { return (x + 255) & ~(size_t)255; }
constexpr size_t WS_Z = 0;
constexpr size_t WS_H = WS_Z + al256((size_t)MP * D * 4);
constexpr size_t WS_COLS = WS_H + al256((size_t)MP * D * 2);
constexpr size_t WS_YALL = WS_COLS + al256((size_t)MP * NINP * 2);
constexpr size_t WS_ZS5 = WS_YALL + al256((size_t)MP * D * 2);
constexpr size_t WS_UBUF = WS_ZS5 + al256((size_t)MP * 512 * 2);
constexpr size_t WS_ST = WS_UBUF + al256((size_t)32 * CHP * 512 * 2);
constexpr size_t WS_DS = WS_ST + al256((size_t)32 * CHP * 256 * 4);
constexpr size_t WS_M32 = WS_UBUF;
constexpr size_t WS_DECAY = WS_DS + al256((size_t)NCK * 4 * 2 * 8192 * 4);
constexpr size_t WS_LRUA = WS_DECAY + al256((size_t)NCK * 4 * 2 * 64 * 4);
constexpr size_t WS_LRUH = WS_LRUA + al256((size_t)NCK * 2 * 1024 * 4);
constexpr size_t WS_LRUC = WS_LRUH + al256((size_t)NCK * 2 * 1024 * 4);
constexpr size_t WS_PW = WS_LRUC + al256((size_t)NCK * 2 * 1024 * 4);
constexpr size_t WS_BBAR = WS_PW + al256((size_t)4 * 32 * 2 * 17 * 64 * 8);
constexpr size_t WS_WMAT = WS_BBAR + al256((size_t)4 * 32 * 2 * 64 * 16 * 8);
constexpr size_t WS_PMAT = WS_WMAT + al256((size_t)32 * 256 * 512 * 2);
constexpr size_t WS_BTIN = WS_PMAT + al256((size_t)32 * 256 * 256 * 2);
constexpr size_t WS_BTOUT = WS_BTIN + al256((size_t)NINP * D * 2);
constexpr size_t WS_BTO = WS_BTOUT + al256((size_t)D * D * 2);
constexpr size_t WS_BTGLU = WS_BTO + al256((size_t)D * D * 2);
constexpr size_t WS_BTLRU = WS_BTGLU + al256((size_t)512 * 512 * 2);
constexpr size_t WS_KMAT = WS_BTLRU + al256((size_t)32 * 128 * 128 * 2);
constexpr size_t WS_BAR = WS_KMAT + al256((size_t)32 * 2 * 16 * 256 * 4);
constexpr size_t WS_END = WS_BAR + al256((size_t)3456 * 4);
constexpr size_t PWL = (size_t)32 * 2 * 17 * 64, BBL = (size_t)32 * 2 * 64 * 16;
static_assert(WS_END <= (size_t)1413480448, "workspace too large");
static_assert((size_t)MP * D * 4 <= WS_DECAY - WS_UBUF, "m32 alias too small");

struct Params { const float* in[30]; float* out; unsigned char* ws; int ph_lo, ph_hi, use_sync, pad; };

#define LBAR() do { asm volatile("s_waitcnt lgkmcnt(0)" ::: "memory"); __builtin_amdgcn_s_barrier(); asm volatile("" ::: "memory"); } while (0)
__device__ __forceinline__ unsigned cvt_pk_bf16(float lo, float hi) { unsigned r; asm volatile("v_cvt_pk_bf16_f32 %0, %1, %2" : "=v"(r) : "v"(lo), "v"(hi)); return r; }
__device__ __forceinline__ bf16_t f2bf(float f) { return (bf16_t)(cvt_pk_bf16(f, 0.f) & 0xffffu); }
__device__ __forceinline__ float bf2f(bf16_t b) { return __uint_as_float(((unsigned)b) << 16); }
__device__ __forceinline__ float bflo(unsigned w) { return __uint_as_float(w << 16); }
__device__ __forceinline__ float bfhi(unsigned w) { return __uint_as_float(w & 0xffff0000u); }
__device__ __forceinline__ float sigm(float x) { return __builtin_amdgcn_rcpf(1.0f + __expf(-x)); }
__device__ __forceinline__ float silu(float x) { return x * sigm(x); }
__device__ __forceinline__ float gelu_t(float x) { const float u = 0.7978845608028654f * (x + 0.044715f * x * x * x); return x * sigm(2.0f * u); }
__device__ __forceinline__ float logsig(float x) { return -(fmaxf(-x, 0.f) + __logf(1.0f + __expf(-fabsf(x)))); }

__device__ __forceinline__ int seq_start(int s) { return s < 2 ? s * 4112 : 8224 + (s - 2) * 2064; }
__device__ __forceinline__ int seq_len(int s) { return s < 2 ? 4112 : 2064; }
__device__ __forceinline__ void chunk_info(int ci, int& seq, int& c) { if (ci < 130) { seq = ci / 65; c = ci - seq * 65; } else { const int t = ci - 130; const int q = t / 33; seq = 2 + q; c = t - q * 33; } }

constexpr int BM = 256, BK = 64, HALF = 128, HTB = HALF * BK * 2, STAGE_BYTES = 8 * HTB, NXCD = 8, WGM = 8;
__device__ __forceinline__ int lds_byte(int r, int c) { const int st = (r >> 4) * 2 + (c >> 5), rr = r & 15, cc = c & 31, ob = rr * 64 + cc * 2; return st * 1024 + (ob ^ (((ob >> 9) & 1) << 5)); }
__device__ __forceinline__ void stage_rc(int b, int& R, int& C) { const int st = b / 1024, sb = b % 1024, swz = sb ^ (((sb >> 9) & 1) << 5); R = (st >> 1) * 16 + swz / 64; C = (st & 1) * 32 + (swz % 64) / 2; }

struct Unit { int pm, pn, sub, nt; const char* a; const char* b; };

struct TileOrder {
    int nM, nN, nwg, G, c, mult, nt0; const char* A; const char* B; size_t tA, tB;
    __device__ __forceinline__ bool next(int i, Unit& u) const {
        const int ti = i / mult, sub = i - ti * mult;
        const long L = (long)ti * G + c; if (L >= nwg) return false;
        int wgid = (int)L; { const int q = nwg / NXCD, r = nwg % NXCD, xcd = wgid % NXCD, off = wgid / NXCD; wgid = (xcd < r ? xcd * (q + 1) : r * (q + 1) + (xcd - r) * q) + off; }
        const int nig = WGM * nN, gid = wgid / nig, fm = gid * WGM, gsz = (nM - fm) < WGM ? (nM - fm) : WGM;
        u.pm = fm + ((wgid % nig) % gsz); u.pn = (wgid % nig) / gsz; u.sub = sub;
        const int koff = (mult == 3) ? sub * 512 : 0; u.nt = (mult == 3) ? (sub == 2 ? 16 : 8) : nt0;
        u.a = A + (size_t)u.pm * tA + (size_t)koff * 2; u.b = B + (size_t)u.pn * tB + (size_t)koff * 2; return true;
    }
};
struct GroupOrder {
    int G, c, nt0; const char* A; const char* B; size_t gsA, gsB, tA;
    __device__ __forceinline__ bool next(int i, Unit& u) const {
        const int L = i * G + c; if (L >= 224) return false;
        const int g = L / 7, pm = L - g * 7; u.pm = pm; u.pn = 0; u.sub = g; u.nt = nt0;
        u.a = A + (size_t)g * gsA + (size_t)pm * tA; u.b = B + (size_t)g * gsB; return true;
    }
};

__device__ __forceinline__ int perm32(int rho) { const int n = rho >> 4, i = rho & 15; return 8 * (i >> 2) + 4 * n + (i & 3); }
template <class Epi, class Sched>
__device__ __forceinline__ void gemm_phase(const int TID, LAS unsigned char* lds, const int lda, const int ldb, const Sched& S, const Epi& E) {
    const int tid = TID, wid = __builtin_amdgcn_readfirstlane(tid >> 6), lane = tid & 63, wr = wid >> 2, wc = wid & 3, fr = lane & 15, fq = lane >> 4;
    unsigned voffA[2], voffB[2];
#pragma unroll
    for (int i = 0; i < 2; ++i) { int R, C; stage_rc(tid * 16 + i * 8192, R, C); const int Rb = Epi::PERM ? ((R & ~31) + perm32(R & 31)) : R; voffA[i] = (unsigned)(R * lda + C) * 2u; voffB[i] = (unsigned)(Rb * ldb + C) * 2u; }
    const size_t kstep = (size_t)(BK * 2);
    const size_t hA = (size_t)HALF * lda * 2, hB = (size_t)HALF * ldb * 2;
    const unsigned ldsw = (unsigned)wid * 1024u;
    const int aoff = lds_byte(wr * 64 + fr, fq * 8), boff = lds_byte(wc * 32 + fr, fq * 8);
#define PG8_SA(b, h) (((b) * 2 + (h)) * HTB)
#define PG8_SB(b, h) ((4 + (b) * 2 + (h)) * HTB)
#define PG8_STAGE(bufoff, gbase, voff) do { _Pragma("unroll") for (int _i = 0; _i < 2; ++_i) \
        __builtin_amdgcn_global_load_lds((const unsigned*)((const char*)(gbase) + (voff)[_i]), (LAS unsigned*)(lds + (bufoff) + ldsw + _i * 8192), 16, 0, 0); } while (0)
#define PG8_LDA(dst, b, h) do { _Pragma("unroll") for (int m = 0; m < 4; ++m) _Pragma("unroll") for (int k = 0; k < 2; ++k) dst[m][k] = *(const LAS bf16x8*)(lds + PG8_SA(b, h) + aoff + m * 2048 + k * 1024); } while (0)
#define PG8_LDB(dst, b, h) do { _Pragma("unroll") for (int n = 0; n < 2; ++n) _Pragma("unroll") for (int k = 0; k < 2; ++k) dst[n][k] = *(const LAS bf16x8*)(lds + PG8_SB(b, h) + boff + n * 2048 + k * 1024); } while (0)
#define PG8_MMA(ai, bj, At, Bt) do { __builtin_amdgcn_s_setprio(1); _Pragma("unroll") for (int m = 0; m < 4; ++m) _Pragma("unroll") for (int n = 0; n < 2; ++n) _Pragma("unroll") for (int k = 0; k < 2; ++k) \
        acc[ai][bj][m][n] = __builtin_amdgcn_mfma_f32_16x16x32_bf16(Bt[n][k], At[m][k], acc[ai][bj][m][n], 0, 0, 0); __builtin_amdgcn_s_setprio(0); } while (0)
#define PG8_WAIT_V(n) asm volatile("s_waitcnt vmcnt(" #n ")" ::: "memory")
#define PG8_WAIT_L(n) asm volatile("s_waitcnt lgkmcnt(" #n ")" ::: "memory")
#define PG8_BAR __builtin_amdgcn_s_barrier()
#define PG8_SCHED __builtin_amdgcn_sched_barrier(0)
    Unit cur, nxt; int ui = 0;
    if (!S.next(0, cur)) return;
    f32x4 acc[2][2][4][2];
#pragma unroll
    for (int a = 0; a < 2; ++a)
#pragma unroll
        for (int b = 0; b < 2; ++b)
#pragma unroll
            for (int m = 0; m < 4; ++m)
#pragma unroll
                for (int n = 0; n < 2; ++n) acc[a][b][m][n] = (f32x4){0.f, 0.f, 0.f, 0.f};
    bf16x8 At[4][2], B0[2][2], B1[2][2];
    const char* cA = cur.a; const char* cB = cur.b;
    PG8_STAGE(PG8_SB(0, 0), cB, voffB); PG8_STAGE(PG8_SA(0, 0), cA, voffA); PG8_STAGE(PG8_SB(0, 1), cB + hB, voffB); PG8_STAGE(PG8_SA(0, 1), cA + hA, voffA);
    if (wr == 1) PG8_BAR;
    PG8_WAIT_V(4); PG8_BAR;
    PG8_STAGE(PG8_SB(1, 0), cB + kstep, voffB); PG8_STAGE(PG8_SA(1, 0), cA + kstep, voffA); PG8_STAGE(PG8_SB(1, 1), cB + hB + kstep, voffB);
    PG8_WAIT_V(6); PG8_BAR;
    for (;;) {
        const bool has_next = S.next(ui + 1, nxt);
        const char* nA = has_next ? nxt.a : cA; const char* nB = has_next ? nxt.b : cB;
        const int nt = cur.nt;
        for (int t = 0; t < nt; t += 2) {
            const bool last = (t == nt - 2);
            const char* a1 = cA + (size_t)(t + 1) * kstep;
            const char* a2 = last ? nA : cA + (size_t)(t + 2) * kstep; const char* b2 = last ? nB : cB + (size_t)(t + 2) * kstep;
            const char* a3 = a2 + kstep; const char* b3 = b2 + kstep;
            PG8_LDB(B0, 0, 0); PG8_SCHED; PG8_LDA(At, 0, 0); PG8_STAGE(PG8_SA(1, 1), a1 + hA, voffA);
            PG8_WAIT_L(8); PG8_BAR; PG8_WAIT_L(0); PG8_MMA(0, 0, At, B0); PG8_BAR; PG8_SCHED;
            PG8_LDB(B1, 0, 1); PG8_STAGE(PG8_SB(0, 0), b2, voffB);
            PG8_BAR; PG8_WAIT_L(0); PG8_MMA(0, 1, At, B1); PG8_BAR;
            PG8_LDA(At, 0, 1); PG8_STAGE(PG8_SA(0, 0), a2, voffA);
            PG8_BAR; PG8_WAIT_L(0); PG8_MMA(1, 0, At, B0); PG8_BAR; PG8_SCHED;
            PG8_STAGE(PG8_SB(0, 1), b2 + hB, voffB);
            PG8_WAIT_V(6); PG8_BAR; PG8_MMA(1, 1, At, B1); PG8_BAR;
            PG8_LDB(B0, 1, 0); PG8_SCHED; PG8_LDA(At, 1, 0); PG8_STAGE(PG8_SA(0, 1), a2 + hA, voffA);
            PG8_WAIT_L(8); PG8_BAR; PG8_WAIT_L(0); PG8_MMA(0, 0, At, B0); PG8_BAR; PG8_SCHED;
            PG8_LDB(B1, 1, 1); PG8_STAGE(PG8_SB(1, 0), b3, voffB);
            PG8_BAR; PG8_WAIT_L(0); PG8_MMA(0, 1, At, B1); PG8_BAR;
            PG8_LDA(At, 1, 1); PG8_STAGE(PG8_SA(1, 0), a3, voffA);
            PG8_BAR; PG8_WAIT_L(0); PG8_MMA(1, 0, At, B0); PG8_BAR; PG8_SCHED;
            PG8_STAGE(PG8_SB(1, 1), b3 + hB, voffB);
            PG8_WAIT_V(6); PG8_BAR; PG8_MMA(1, 1, At, B1); PG8_BAR;
        }
        E(acc, cur, wr, wc, fr, fq);
        if (!has_next) break;
#pragma unroll
        for (int a = 0; a < 2; ++a)
#pragma unroll
            for (int b = 0; b < 2; ++b)
#pragma unroll
                for (int m = 0; m < 4; ++m)
#pragma unroll
                    for (int n = 0; n < 2; ++n) acc[a][b][m][n] = (f32x4){0.f, 0.f, 0.f, 0.f};
        cur = nxt; cA = nA; cB = nB; ++ui;
    }
    PG8_WAIT_V(0);
    if (wr == 0) PG8_BAR;
    PG8_BAR;
#undef PG8_SA
#undef PG8_SB
#undef PG8_STAGE
#undef PG8_LDA
#undef PG8_LDB
#undef PG8_MMA
#undef PG8_WAIT_V
#undef PG8_WAIT_L
#undef PG8_BAR
#undef PG8_SCHED
}

#define EPI_LOOP(...) \
    const int row0 = u.pm * BM + wr * 64 + fr, col0 = u.pn * BM + wc * 32 + 4 * fq; \
    _Pragma("unroll") for (int ai = 0; ai < 2; ++ai) _Pragma("unroll") for (int m = 0; m < 4; ++m) { const int r = row0 + ai * HALF + m * 16; \
        _Pragma("unroll") for (int bj = 0; bj < 2; ++bj) _Pragma("unroll") for (int n = 0; n < 2; ++n) { const int c = col0 + bj * HALF + n * 16; const f32x4 v = acc[ai][bj][m][n]; __VA_ARGS__ } }

#define EPI_PROWS(...) \
    const int row0 = u.pm * BM + wr * 64 + fr, col0 = u.pn * BM + wc * 32 + 8 * fq; \
    _Pragma("unroll") for (int ai = 0; ai < 2; ++ai) _Pragma("unroll") for (int m = 0; m < 4; ++m) { const int r = row0 + ai * HALF + m * 16; __VA_ARGS__ }
__device__ __forceinline__ u32x4 pack8(const f32x4 a, const f32x4 b) { u32x4 w; w[0] = cvt_pk_bf16(a[0], a[1]); w[1] = cvt_pk_bf16(a[2], a[3]); w[2] = cvt_pk_bf16(b[0], b[1]); w[3] = cvt_pk_bf16(b[2], b[3]); return w; }
__device__ __forceinline__ unsigned q8(float x) { return (unsigned)__float2uint_rn(sigm(x) * 255.0f); }
__device__ __forceinline__ unsigned q8x4(const f32x4 v) { return q8(v[0]) | (q8(v[1]) << 8) | (q8(v[2]) << 16) | (q8(v[3]) << 24); }
struct EpiIn { static constexpr bool PERM = true; bf16_t* cols; bf16_t* ubuf;
    __device__ __forceinline__ void operator()(const f32x4 (&acc)[2][2][4][2], const Unit& u, int wr, int wc, int fr, int fq) const {
        if (u.pn >= 18 && u.pn < 42) {
            EPI_PROWS({ u32x4 w; w[0] = q8x4(acc[ai][0][m][0]); w[1] = q8x4(acc[ai][0][m][1]); w[2] = q8x4(acc[ai][1][m][0]); w[3] = q8x4(acc[ai][1][m][1]);
                *(u32x4*)((unsigned char*)(cols + (size_t)r * NINP + C_MG) + (u.pn - 18) * 256 + (wc * 4 + fq) * 16) = w; })
        } else {
            EPI_PROWS({ _Pragma("unroll") for (int bj = 0; bj < 2; ++bj) { const int c = col0 + bj * HALF;
                bf16_t* dst = (u.pn < 2) ? ubuf + ((size_t)((c >> 4) * CHP + (r >> 4)) * 512 + (r & 15) * 16 + (c & 15)) : cols + (size_t)r * NINP + c;
                *(u32x4*)dst = pack8(acc[ai][bj][m][0], acc[ai][bj][m][1]); } })
        }
    } };
struct EpiS5State { static constexpr bool PERM = false; float* st;
    __device__ __forceinline__ void operator()(const f32x4 (&acc)[2][2][4][2], const Unit& u, int wr, int wc, int fr, int fq) const {
        EPI_LOOP({ *(f32x4*)(st + ((size_t)(u.sub * CHP + r)) * 256 + c) = v; })
    } };
struct EpiS5Out { static constexpr bool PERM = true; bf16_t* zs5;
    __device__ __forceinline__ void operator()(const f32x4 (&acc)[2][2][4][2], const Unit& u, int wr, int wc, int fr, int fq) const {
        EPI_PROWS({ if (r < NCH16) { _Pragma("unroll") for (int bj = 0; bj < 2; ++bj) { const int c = col0 + bj * HALF; f32x4 a = acc[ai][bj][m][0], b2 = acc[ai][bj][m][1];
            _Pragma("unroll") for (int e = 0; e < 4; ++e) { a[e] = gelu_t(a[e]); b2[e] = gelu_t(b2[e]); }
            *(u32x4*)(zs5 + (size_t)(r * 16 + (c >> 4)) * 512 + u.sub * 16 + (c & 15)) = pack8(a, b2); } } })
    } };
#define EPI_ROWS(...) \
    const int row0 = u.pm * BM + wr * 64 + fr, col0 = u.pn * BM + wc * 32 + 4 * fq; \
    _Pragma("unroll") for (int ai = 0; ai < 2; ++ai) _Pragma("unroll") for (int m = 0; m < 4; ++m) { const int r = row0 + ai * HALF + m * 16; __VA_ARGS__ }
#define QOFF(q) (((q) >> 1) * HALF + ((q) & 1) * 16)
#define EPI_PIPE(LOADF, COMPF) \
    const int row0 = u.pm * BM + wr * 64 + fr, col0 = u.pn * BM + wc * 32 + 8 * fq; \
    LOADF(0, 0); \
    _Pragma("unroll") for (int gi = 0; gi < 8; ++gi) { if (gi + 1 < 8) { if ((gi & 1) == 0) { LOADF(gi + 1, 1); } else { LOADF(gi + 1, 0); } } if ((gi & 1) == 0) { COMPF(gi, 0); } else { COMPF(gi, 1); } }
#define GROW(gi) (row0 + ((gi) >> 2) * HALF + ((gi) & 3) * 16)
struct EpiGlu { static constexpr bool PERM = true; const bf16_t* zs5; const bf16_t* cols; const float* bglu; bf16_t* yall;
    __device__ __forceinline__ void operator()(const f32x4 (&acc)[2][2][4][2], const Unit& u, int wr, int wc, int fr, int fq) const {
        u32x4 zz[2][2], gg[2][2]; f32x4 bb[2][2];
        { const int c0 = u.pn * BM + wc * 32 + 8 * fq; _Pragma("unroll") for (int bj = 0; bj < 2; ++bj) { bb[bj][0] = *(const f32x4*)(bglu + c0 + bj * HALF); bb[bj][1] = *(const f32x4*)(bglu + c0 + bj * HALF + 4); } }
#define GLU_LOAD(gi, bf) do { const int r_ = GROW(gi); _Pragma("unroll") for (int bj = 0; bj < 2; ++bj) { const int c = col0 + bj * HALF; zz[bf][bj] = *(const u32x4*)(zs5 + (size_t)r_ * 512 + c); gg[bf][bj] = *(const u32x4*)(cols + (size_t)r_ * NINP + C_GA + c); } } while (0)
#define GLU_COMP(gi, bf) do { const int r_ = GROW(gi); _Pragma("unroll") for (int bj = 0; bj < 2; ++bj) { const int c = col0 + bj * HALF; f32x4 o[2]; \
            _Pragma("unroll") for (int hf = 0; hf < 2; ++hf) { const f32x4 v = acc[(gi) >> 2][bj][(gi) & 3][hf]; \
                o[hf][0] = bflo(zz[bf][bj][2 * hf]) * sigm(v[0] + bb[bj][hf][0]) * silu(bflo(gg[bf][bj][2 * hf])); o[hf][1] = bfhi(zz[bf][bj][2 * hf]) * sigm(v[1] + bb[bj][hf][1]) * silu(bfhi(gg[bf][bj][2 * hf])); \
                o[hf][2] = bflo(zz[bf][bj][2 * hf + 1]) * sigm(v[2] + bb[bj][hf][2]) * silu(bflo(gg[bf][bj][2 * hf + 1])); o[hf][3] = bfhi(zz[bf][bj][2 * hf + 1]) * sigm(v[3] + bb[bj][hf][3]) * silu(bfhi(gg[bf][bj][2 * hf + 1])); } \
            *(u32x4*)(yall + (size_t)r_ * D + c) = pack8(o[0], o[1]); } } while (0)
        EPI_PIPE(GLU_LOAD, GLU_COMP)
#undef GLU_LOAD
#undef GLU_COMP
    } };
__device__ __forceinline__ float ub(unsigned w, int k) { return (float)((w >> (8 * k)) & 255u) * (1.0f / 255.0f); }
struct EpiOut { static constexpr bool PERM = true; const bf16_t* cols; bf16_t* mbf;
    __device__ __forceinline__ void operator()(const f32x4 (&acc)[2][2][4][2], const Unit& u, int wr, int wc, int fr, int fq) const {
        u32x4 gg[2], mm[2][2];
#define OUT_LOAD(gi, bf) do { const int r_ = GROW(gi); const bf16_t* mp = mbf + (size_t)r_ * D + col0; \
            gg[bf] = *(const u32x4*)((const unsigned char*)(cols + (size_t)r_ * NINP + C_MG) + (u.sub * 8 + u.pn) * 256 + (wc * 4 + fq) * 16); \
            _Pragma("unroll") for (int bj = 0; bj < 2; ++bj) { mm[bf][bj] = (u32x4){0u, 0u, 0u, 0u}; if (u.sub != 0) mm[bf][bj] = *(const u32x4*)(mp + bj * HALF); } } while (0)
#define OUT_COMP(gi, bf) do { const int r_ = GROW(gi); bf16_t* mp = mbf + (size_t)r_ * D + col0; _Pragma("unroll") for (int bj = 0; bj < 2; ++bj) { f32x4 o[2]; \
            _Pragma("unroll") for (int hf = 0; hf < 2; ++hf) { const f32x4 v = acc[(gi) >> 2][bj][(gi) & 3][hf]; const unsigned gw = gg[bf][bj * 2 + hf]; \
                o[hf][0] = bflo(mm[bf][bj][2 * hf]) + ub(gw, 0) * v[0]; o[hf][1] = bfhi(mm[bf][bj][2 * hf]) + ub(gw, 1) * v[1]; \
                o[hf][2] = bflo(mm[bf][bj][2 * hf + 1]) + ub(gw, 2) * v[2]; o[hf][3] = bfhi(mm[bf][bj][2 * hf + 1]) + ub(gw, 3) * v[3]; } \
            *(u32x4*)(mp + bj * HALF) = pack8(o[0], o[1]); } } while (0)
        EPI_PIPE(OUT_LOAD, OUT_COMP)
#undef OUT_LOAD
#undef OUT_COMP
    } };
struct EpiWo { static constexpr bool PERM = false; float* z;
    __device__ __forceinline__ void operator()(const f32x4 (&acc)[2][2][4][2], const Unit& u, int wr, int wc, int fr, int fq) const {
        EPI_ROWS({ if (r < NTOK) { float* zp = z + (size_t)r * D + col0; f32x4 pv[4];
            _Pragma("unroll") for (int q = 0; q < 4; ++q) pv[q] = *(const f32x4*)(zp + QOFF(q));
            _Pragma("unroll") for (int q = 0; q < 4; ++q) *(f32x4*)(zp + QOFF(q)) = pv[q] + acc[ai][q >> 1][m][q & 1]; } })
    } };

__device__ __forceinline__ const float* src_row(const Params& p, int r) {
    int s, pos; if (r < 8224) { s = r / 4112; pos = r - s * 4112; } else { const int t = r - 8224; const int q = t / 2064; s = 2 + q; pos = t - q * 2064; }
    if (pos < 16) return p.in[2] + (size_t)pos * D;
    return s < 2 ? p.in[0] + ((size_t)s * 4096 + (pos - 16)) * D : p.in[1] + ((size_t)(s - 2) * 2048 + (pos - 16)) * D;
}
__device__ __forceinline__ void rmsnorm_phase(const int TID, const int BID, const Params& p, int l) {
    float* z = (float*)(p.ws + WS_Z); bf16_t* h = (bf16_t*)(p.ws + WS_H); const float* g = p.in[3] + (size_t)l * D;
    const int lane = TID & 63, gw = BID * 8 + (TID >> 6), nw = gridDim.x * 8;
    f32x4 gg[8];
#pragma unroll
    for (int i = 0; i < 8; ++i) gg[i] = *(const f32x4*)(g + (i * 64 + lane) * 4);
    f32x4 xn[8];
    { const int r0 = gw < NTOK ? gw : NTOK - 1; const float* src = (l == 0) ? src_row(p, r0) : z + (size_t)r0 * D;
#pragma unroll
      for (int i = 0; i < 8; ++i) xn[i] = *(const f32x4*)(src + (i * 64 + lane) * 4); }
    for (int r = gw; r < MP; r += nw) {
        bf16_t* hr = h + (size_t)r * D;
        f32x4 x[8];
#pragma unroll
        for (int i = 0; i < 8; ++i) x[i] = xn[i];
        { const int rn = (r + nw < NTOK) ? r + nw : NTOK - 1; const float* src = (l == 0) ? src_row(p, rn) : z + (size_t)rn * D;
#pragma unroll
          for (int i = 0; i < 8; ++i) xn[i] = *(const f32x4*)(src + (i * 64 + lane) * 4); }
        if (r >= NTOK) { for (int i = 0; i < 4; ++i) *(u32x4*)(hr + (i * 64 + lane) * 8) = (u32x4){0u, 0u, 0u, 0u}; continue; }
        float ss = 0.f;
#pragma unroll
        for (int i = 0; i < 8; ++i) ss += x[i][0] * x[i][0] + x[i][1] * x[i][1] + x[i][2] * x[i][2] + x[i][3] * x[i][3];
#pragma unroll
        for (int o = 32; o >= 1; o >>= 1) ss += __shfl_xor(ss, o);
        const float rs = rsqrtf(ss * (1.0f / D) + 1e-6f);
#pragma unroll
        for (int i = 0; i < 8; ++i) { const int c = (i * 64 + lane) * 4;
            if (l == 0) *(f32x4*)(z + (size_t)r * D + c) = x[i];
            u32x2 w; w.x = cvt_pk_bf16(x[i][0] * rs * gg[i][0], x[i][1] * rs * gg[i][1]); w.y = cvt_pk_bf16(x[i][2] * rs * gg[i][2], x[i][3] * rs * gg[i][3]); *(u32x2*)(hr + c) = w; }
    }
}
__device__ __forceinline__ void final_norm_phase(const int TID, const int BID, const Params& p) {
    const float* z = (const float*)(p.ws + WS_Z); const float* g = p.in[29];
    const int lane = TID & 63, gw = BID * 8 + (TID >> 6), nw = gridDim.x * 8;
    for (int r = gw; r < NTOK; r += nw) {
        int s, pos; if (r < 8224) { s = r / 4112; pos = r - s * 4112; } else { const int t = r - 8224; const int q = t / 2064; s = 2 + q; pos = t - q * 2064; }
        if (pos < 16) continue;
        float* dst = s < 2 ? p.out + ((size_t)s * 4096 + (pos - 16)) * D : p.out + (size_t)2 * 4096 * D + ((size_t)(s - 2) * 2048 + (pos - 16)) * D;
        const float* src = z + (size_t)r * D;
        f32x4 x[8]; float ss = 0.f;
#pragma unroll
        for (int i = 0; i < 8; ++i) { x[i] = *(const f32x4*)(src + (i * 64 + lane) * 4); ss += x[i][0] * x[i][0] + x[i][1] * x[i][1] + x[i][2] * x[i][2] + x[i][3] * x[i][3]; }
#pragma unroll
        for (int o = 32; o >= 1; o >>= 1) ss += __shfl_xor(ss, o);
        const float rs = rsqrtf(ss * (1.0f / D) + 1e-6f);
#pragma unroll
        for (int i = 0; i < 8; ++i) { const int c = (i * 64 + lane) * 4; const f32x4 gg = *(const f32x4*)(g + c); f32x4 o; o[0] = x[i][0] * rs * gg[0]; o[1] = x[i][1] * rs * gg[1]; o[2] = x[i][2] * rs * gg[2]; o[3] = x[i][3] * rs * gg[3]; *(f32x4*)(dst + c) = o; }
    }
}
__device__ __forceinline__ void conv_tile(const int TID, const float* src, int ldn, int k0, int n0, int nvalid, bf16_t* dst, int ldd, int kofs, bool mapin, LAS float* tile) {
    const int tx = TID & 63, ty = TID >> 6;
    const int ncl = (n0 + tx < nvalid) ? n0 + tx : nvalid - 1;
#pragma unroll
    for (int i = 0; i < 8; ++i) { const int k = ty + 8 * i; tile[k * 65 + tx] = src[(size_t)(k0 + k) * ldn + ncl]; }
    __syncthreads();
#pragma unroll
    for (int i = 0; i < 8; ++i) { const int nn = ty + 8 * i; int n = n0 + nn;
        if (n < nvalid) { if (mapin) n = (n < 2560) ? n : (n < 2592 ? n + (C_GLR - 2560) : n - 32); dst[(size_t)n * ldd + kofs + k0 + tx] = f2bf(tile[tx * 65 + nn]); } }
    __syncthreads();
}
__device__ __forceinline__ void convert_weights(const int TID, const int BID, const Params& p, int l, LAS float* tile) {
    const int G = gridDim.x, b = BID;
    bf16_t* btin = (bf16_t*)(p.ws + WS_BTIN); bf16_t* btout = (bf16_t*)(p.ws + WS_BTOUT); bf16_t* bto = (bf16_t*)(p.ws + WS_BTO); bf16_t* btglu = (bf16_t*)(p.ws + WS_BTGLU); bf16_t* btlru = (bf16_t*)(p.ws + WS_BTLRU);
    { const float* src = p.in[4] + (size_t)l * D * NIN; const int tx = TID & 63, ty = TID >> 6; float v[8];
      { const int t = b < 32 * 169 ? b : 0; const int kt = t / 169, ntl = t - kt * 169; const int ncl = (ntl * 64 + tx < NIN) ? ntl * 64 + tx : NIN - 1;
#pragma unroll
        for (int i = 0; i < 8; ++i) v[i] = src[(size_t)(kt * 64 + ty + 8 * i) * NIN + ncl]; }
      for (int t = b; t < 32 * 169; t += G) { const int kt = t / 169, ntl = t - kt * 169, k0 = kt * 64, n0 = ntl * 64;
#pragma unroll
          for (int i = 0; i < 8; ++i) tile[(ty + 8 * i) * 65 + tx] = v[i];
          { const int tn = (t + G < 32 * 169) ? t + G : t; const int ktn = tn / 169, ntn = tn - ktn * 169; const int ncl = (ntn * 64 + tx < NIN) ? ntn * 64 + tx : NIN - 1;
#pragma unroll
            for (int i = 0; i < 8; ++i) v[i] = src[(size_t)(ktn * 64 + ty + 8 * i) * NIN + ncl]; }
          LBAR();
#pragma unroll
          for (int i = 0; i < 8; ++i) { const int nn = ty + 8 * i; int n = n0 + nn;
              if (n < NIN) { n = (n < 2560) ? n : (n < 2592 ? n + (C_GLR - 2560) : n - 32); btin[(size_t)n * D + k0 + tx] = f2bf(tile[tx * 65 + nn]); } }
          LBAR(); } }
    for (size_t i = (size_t)b * 512 + TID; i < (size_t)(NINP - NIN) * D / 8; i += (size_t)G * 512) *(u32x4*)(btin + (size_t)NIN * D + i * 8) = (u32x4){0u, 0u, 0u, 0u};
    { const float* src = p.in[25] + (size_t)l * 512 * D; for (int t = (b + 64) % G; t < 8 * 32; t += G) { const int kt = t / 32, ntl = t - kt * 32; conv_tile(TID, src, D, kt * 64, ntl * 64, D, btout, D, 0, false, tile); } }
    { const float* src = p.in[26] + (size_t)l * 512 * D; for (int t = (b + 128) % G; t < 8 * 32; t += G) { const int kt = t / 32, ntl = t - kt * 32; conv_tile(TID, src, D, kt * 64, ntl * 64, D, btout, D, 512, false, tile); } }
    { const float* src = p.in[27] + (size_t)l * 1024 * D; for (int t = b; t < 16 * 32; t += G) { const int kt = t / 32, ntl = t - kt * 32; conv_tile(TID, src, D, kt * 64, ntl * 64, D, btout, D, 1024, false, tile); } }
    { const float* src = p.in[28] + (size_t)l * D * D; for (int t = b; t < 32 * 32; t += G) { const int kt = t / 32, ntl = t - kt * 32; conv_tile(TID, src, D, kt * 64, ntl * 64, D, bto, D, 0, false, tile); } }
    { const float* src = p.in[13] + (size_t)l * 512 * 512; for (int t = (b + 192) % G; t < 8 * 8; t += G) { const int kt = t / 8, ntl = t - kt * 8; conv_tile(TID, src, 512, kt * 64, ntl * 64, 512, btglu, 512, 0, false, tile); } }
    for (int t = (b + 32) % G; t < 128; t += G) { const int mat = t >> 2, sub = t & 3;
        const int dk = mat >> 3, nb = mat & 7, d = dk >> 1, kind = dk & 1;
        const float* src = p.in[kind ? 22 : 20] + ((size_t)(l * 2 + d) * 8 + nb) * 128 * 128;
        conv_tile(TID, src, 128, (sub >> 1) * 64, (sub & 1) * 64, 128, btlru + (size_t)mat * 128 * 128, 128, 0, false, tile); }
}
__device__ __forceinline__ double exp_small(double x) { double s = 1.0, t = 1.0; for (int i = 1; i <= 14; ++i) { t *= x / (double)i; s += t; } return s; }
__device__ __forceinline__ double exp_neg(double x) { double e = exp_small(x * (1.0 / 64.0)); for (int i = 0; i < 6; ++i) e *= e; return e; }
__device__ __forceinline__ void s5_tables_all(const int TID, const int BID, const Params& p) {
    for (int vidx = (int)(gridDim.x - 1 - BID) * 512 + TID; vidx < 4 * 4096; vidx += gridDim.x * 512) {
        const int l = vidx >> 12, idx = vidx & 4095;
        f32x2* pw = (f32x2*)(p.ws + WS_PW) + l * PWL; f32x2* bbar = (f32x2*)(p.ws + WS_BBAR) + l * BBL;
        const int g = idx >> 7, d = (idx >> 6) & 1, n = idx & 63;
        const double dt = exp_neg((double)p.in[7][(l * 2 + d) * 32 + g]);
        const double lr = (double)p.in[5][((size_t)(l * 2 + d) * 32 + g) * 64 + n], li = (double)p.in[6][((size_t)(l * 2 + d) * 32 + g) * 64 + n];
        const double mag = exp_neg(lr * dt);
        double ang = li * dt; const double twopi = 6.283185307179586476925287; ang -= twopi * rint(ang / twopi);
        const double a8 = ang * 0.125, a2 = a8 * a8;
        double sn = a8, cs = 1.0, ts = a8, tc = 1.0;
        for (int i = 1; i <= 9; ++i) { tc *= -a2 / (double)((2 * i - 1) * (2 * i)); cs += tc; ts *= -a2 / (double)((2 * i) * (2 * i + 1)); sn += ts; }
        for (int i = 0; i < 3; ++i) { const double c2 = cs * cs - sn * sn, s2 = 2.0 * cs * sn; cs = c2; sn = s2; }
        const double abr = mag * cs, abi = mag * sn;
        double pr = 1.0, pi = 0.0;
        for (int j = 0; j <= 16; ++j) { pw[((size_t)(g * 2 + d) * 17 + j) * 64 + n] = (f32x2){(float)pr, (float)pi}; const double nr = pr * abr - pi * abi, ni = pr * abi + pi * abr; pr = nr; pi = ni; }
        const double den = lr * lr + li * li, fr = ((abr - 1.0) * lr + abi * li) / den, fi = (abi * lr - (abr - 1.0) * li) / den;
        float brf[16], bif[16];
#pragma unroll
        for (int c4 = 0; c4 < 4; ++c4) { const f32x4 t0 = *(const f32x4*)(p.in[8] + (((size_t)l * 32 + g) * 64 + n) * 16 + c4 * 4), t1 = *(const f32x4*)(p.in[9] + (((size_t)l * 32 + g) * 64 + n) * 16 + c4 * 4);
#pragma unroll
            for (int e = 0; e < 4; ++e) { brf[c4 * 4 + e] = t0[e]; bif[c4 * 4 + e] = t1[e]; } }
#pragma unroll
        for (int c = 0; c < 16; ++c) { const double br = (double)brf[c], bi = (double)bif[c];
            bbar[((size_t)(g * 2 + d) * 64 + n) * 16 + c] = (f32x2){(float)(fr * br - fi * bi), (float)(fr * bi + fi * br)}; }
    }
}
__device__ __forceinline__ float s5_kval(const float* cre, const float* cim, const f32x2* pw, const f32x2* bbar, int l, int g, int d, int j, int c, int cp) {
    const float* cr = cre + (((size_t)(l * 2 + d) * 32 + g) * 16 + c) * 64; const float* ci = cim + (((size_t)(l * 2 + d) * 32 + g) * 16 + c) * 64;
    const f32x2* pp = pw + ((size_t)(g * 2 + d) * 17 + j) * 64; const f32x2* bb = bbar + ((size_t)(g * 2 + d) * 64) * 16 + cp;
    float s = 0.f;
#pragma unroll 16
    for (int n = 0; n < 64; ++n) { const f32x2 pv = pp[n]; const f32x2 bv = bb[(size_t)n * 16]; const float er = cr[n] * pv.x - ci[n] * pv.y, ei = cr[n] * pv.y + ci[n] * pv.x; s += er * bv.x - ei * bv.y; }
    return s;
}
__device__ __forceinline__ void s5_assemble_a(const int TID, const int BID, const Params& p, int l) {
    const f32x2* pw = (const f32x2*)(p.ws + WS_PW) + l * PWL; const f32x2* bbar = (const f32x2*)(p.ws + WS_BBAR) + l * BBL;
    float* kmat = (float*)(p.ws + WS_KMAT); bf16_t* pmat = (bf16_t*)(p.ws + WS_PMAT);
    const float* cre = p.in[10]; const float* cim = p.in[11];
    const size_t stride = (size_t)gridDim.x * 512;
    for (size_t idx = (size_t)BID * 512 + TID; idx < (size_t)32 * 2 * 16 * 256; idx += stride) {
        const int g = (int)(idx >> 13), d = (int)(idx >> 12) & 1, j = (int)(idx >> 8) & 15, c = (int)(idx >> 4) & 15, cp = (int)idx & 15;
        kmat[idx] = s5_kval(cre, cim, pw, bbar, l, g, d, j, c, cp);
    }
    for (size_t idx = (size_t)BID * 512 + TID; idx < (size_t)32 * 256 * 256; idx += stride) {
        const int g = (int)(idx >> 16), nout = (int)(idx >> 8) & 255, k = (int)idx & 255, d = nout >> 7, ri = (nout >> 6) & 1, n = nout & 63, s = k >> 4, cp = k & 15, j = d == 0 ? 15 - s : s;
        const f32x2 pv = pw[((size_t)(g * 2 + d) * 17 + j) * 64 + n]; const f32x2 bv = bbar[((size_t)(g * 2 + d) * 64 + n) * 16 + cp];
        pmat[idx] = f2bf(ri == 0 ? pv.x * bv.x - pv.y * bv.y : pv.x * bv.y + pv.y * bv.x);
    }
}
__device__ __forceinline__ void s5_assemble_w(const int TID, const int BID, const Params& p, int l) {
    const f32x2* pw = (const f32x2*)(p.ws + WS_PW) + l * PWL; const float* kmat = (const float*)(p.ws + WS_KMAT);
    bf16_t* wmat = (bf16_t*)(p.ws + WS_WMAT);
    const float* cre = p.in[10]; const float* cim = p.in[11];
    const size_t stride = (size_t)gridDim.x * 512;
    for (size_t idx = (size_t)BID * 512 + TID; idx < (size_t)32 * 256 * 512; idx += stride) {
        const int g = (int)(idx >> 17), nout = (int)(idx >> 9) & 255, k = (int)idx & 511, t = nout >> 4, c = nout & 15;
        float val;
        if (k < 256) { const int s = k >> 4, cp = k & 15; val = 0.f;
            const int jf = s <= t ? t - s : 0, jb = s >= t ? s - t : 0;
            const float kf = kmat[((((size_t)g * 2 + 0) * 16 + jf) * 16 + c) * 16 + cp], kb = kmat[((((size_t)g * 2 + 1) * 16 + jb) * 16 + c) * 16 + cp], dsk = p.in[12][l * 512 + g * 16 + c];
            val = (s <= t ? kf : 0.f) + (s >= t ? kb : 0.f) + ((s == t && c == cp) ? dsk : 0.f);
        } else { const int kk = k - 256, d = kk >> 7, ri = (kk >> 6) & 1, n = kk & 63, j = d == 0 ? t + 1 : 16 - t;
            const float cr = cre[(((size_t)(l * 2 + d) * 32 + g) * 16 + c) * 64 + n], ci = cim[(((size_t)(l * 2 + d) * 32 + g) * 16 + c) * 64 + n];
            const f32x2 pv = pw[((size_t)(g * 2 + d) * 17 + j) * 64 + n];
            val = ri == 0 ? cr * pv.x - ci * pv.y : -(cr * pv.y + ci * pv.x); }
        wmat[idx] = f2bf(val);
    }
}

__device__ __forceinline__ void scans_phase(const int TID, const int BID, const Params& p, const int l, const bool do_gla) {
    const int G = gridDim.x;
    const bool split = (G == 256);
    {
        const f32x2* pw = (const f32x2*)(p.ws + WS_PW) + l * PWL; const float* st = (const float*)(p.ws + WS_ST); bf16_t* ub = (bf16_t*)(p.ws + WS_UBUF);
        for (int idx = BID * 512 + TID; idx < 40960; idx += G * 512) {
            const int seq = idx >> 12, rem = idx & 4095, g = rem >> 7, d = (rem >> 6) & 1, n = rem & 63;
            const int ch0 = seq < 2 ? seq * 257 : 514 + (seq - 2) * 129, nc = seq < 2 ? 257 : 129;
            const f32x2 a16 = pw[((size_t)(g * 2 + d) * 17 + 16) * 64 + n];
            float sr = 0.f, si = 0.f;
            for (int s0 = 0; s0 < nc; s0 += 32) {
                float lr[32], li[32];
#pragma unroll
                for (int i = 0; i < 32; ++i) { const int step = s0 + i; lr[i] = 0.f; li[i] = 0.f;
                    { const int sc = step < nc ? step : nc - 1; const int c = d == 0 ? sc : nc - 1 - sc; const size_t row = (size_t)g * CHP + ch0 + c; lr[i] = st[row * 256 + d * 128 + n]; li[i] = st[row * 256 + d * 128 + 64 + n]; } }
#pragma unroll
                for (int i = 0; i < 32; ++i) { const int step = s0 + i;
                    if (step < nc) { const int c = d == 0 ? step : nc - 1 - step; const size_t row = (size_t)g * CHP + ch0 + c;
                        ub[row * 512 + 256 + d * 128 + n] = f2bf(sr); ub[row * 512 + 256 + d * 128 + 64 + n] = f2bf(si);
                        const float nr = a16.x * sr - a16.y * si + lr[i], ni = a16.x * si + a16.y * sr + li[i]; sr = nr; si = ni; } }
            }
        }
    }
    {
        const float* la = (const float*)(p.ws + WS_LRUA); const float* lh = (const float*)(p.ws + WS_LRUH); float* lc = (float*)(p.ws + WS_LRUC);
        const int vb0 = split ? BID - 80 : BID, vstride = split ? 1 << 20 : G;
        for (int vb = vb0; vb >= 0 && vb < 40; vb += vstride) {
            const int idx = vb * 512 + TID;
            const int seq = idx >> 11, d = (idx >> 10) & 1, ch = idx & 1023;
            const int cb = seq < 2 ? seq * 65 : 130 + (seq - 2) * 33, nc = seq < 2 ? 65 : 33;
            float cin = 0.f;
            for (int s0 = 0; s0 < nc; s0 += 16) {
                float A[16], H[16];
#pragma unroll
                for (int i = 0; i < 16; ++i) { const int step = s0 + i; A[i] = 1.f; H[i] = 0.f;
                    { const int sc = step < nc ? step : nc - 1; const int ci = cb + (d == 0 ? sc : nc - 1 - sc); const size_t o = ((size_t)ci * 2 + d) * 1024 + ch; A[i] = la[o]; H[i] = lh[o]; } }
#pragma unroll
                for (int i = 0; i < 16; ++i) { const int step = s0 + i;
                    if (step < nc) { const int ci = cb + (d == 0 ? step : nc - 1 - step); const size_t o = ((size_t)ci * 2 + d) * 1024 + ch; lc[o] = cin; cin = A[i] * cin + H[i]; } }
            }
        }
    }
    if (do_gla) {
        float* ds = (float*)(p.ws + WS_DS); const float* dec = (const float*)(p.ws + WS_DECAY);
        for (int it = 0; ; ++it) {
            int vb;
            if (split) { if (BID >= 120) { if (it >= 8) break; vb = (BID - 120) + 136 * it; } else { vb = 1088 + BID + 120 * it; if (vb >= 1280) break; } }
            else { vb = BID + G * it; if (vb >= 1280) break; }
            const int e = vb * 512 + TID;
            const int seq = e >> 16, rem = e & 65535, head = rem >> 14, d = (rem >> 13) & 1, el = rem & 8191, kk = el & 63;
            const int cb = seq < 2 ? seq * 65 : 130 + (seq - 2) * 33, nc = seq < 2 ? 65 : 33;
            float S = 0.f;
            for (int s0 = 0; s0 < nc; s0 += 16) {
                float tm[16], dc[16];
#pragma unroll
                for (int i = 0; i < 16; ++i) { const int step = s0 + i; tm[i] = 0.f; dc[i] = 1.f;
                    { const int sc = step < nc ? step : nc - 1; const int ci = cb + (d == 0 ? sc : nc - 1 - sc); const size_t o = ((size_t)(ci * 4 + head) * 2 + d); tm[i] = ds[o * 8192 + el]; dc[i] = dec[o * 64 + kk]; } }
#pragma unroll
                for (int i = 0; i < 16; ++i) { const int step = s0 + i;
                    if (step < nc) { const int ci = cb + (d == 0 ? step : nc - 1 - step); const size_t o = ((size_t)(ci * 4 + head) * 2 + d); ds[o * 8192 + el] = S; S = dc[i] * S + tm[i]; } }
            }
        }
    }
}

__device__ __forceinline__ f32x4 mma_lds(f32x4 acc, const LAS bf16_t* A, const LAS bf16_t* B, int ld, int nks, int lane) {
    const LAS bf16_t* ap = A + (lane & 15) * ld + (lane >> 4) * 8; const LAS bf16_t* bp = B + (lane & 15) * ld + (lane >> 4) * 8;
    for (int ks = 0; ks < nks; ++ks) acc = __builtin_amdgcn_mfma_f32_16x16x32_bf16(*(const LAS bf16x8*)(ap + ks * 32), *(const LAS bf16x8*)(bp + ks * 32), acc, 0, 0, 0);
    return acc;
}
constexpr int GL_GLR = 0, GL_BF = 16384, GL_BB = 32768, GL_OS = 0, GL_QE0 = 49152, GL_QE1 = 58368, GL_KE0 = 67584, GL_KE1 = 76800, GL_VT = 86016, GL_ATT = 104448, GL_SP0 = 113664, GL_SP1 = 132096;
constexpr int GLD = 72;
template <int MODE>
__device__ __forceinline__ void gla_item(const int TID, const Params& p, int l, int ci, int head, LAS unsigned char* lds, const float (&wg)[2][16], const float (&bg)[2], const float (&ngv)[16]) {
    const int tid = TID, lane = tid & 63, wid = tid >> 6;
    const bf16_t* cols = (const bf16_t*)(p.ws + WS_COLS);
    int seq, c; chunk_info(ci, seq, c);
    const int tok0 = seq_start(seq) + (c == 0 ? -48 : 16 + 64 * (c - 1));
    const int rmin = (c == 0) ? 48 : 0;
    LAS float* glr_s = (LAS float*)(lds + GL_GLR); LAS float* bfs = (LAS float*)(lds + GL_BF); LAS float* bbs = (LAS float*)(lds + GL_BB);
    u32x4 kw = (u32x4){0u, 0u, 0u, 0u}, qw = kw, vwp[2], gwp[2];
    { const int r = tid >> 3, k8 = (tid & 7) * 8; const int rc = r >= rmin ? r : rmin; const bf16_t* rowp = cols + (size_t)(tok0 + rc) * NINP;
      kw = *(const u32x4*)(rowp + C_K + head * 64 + k8); if (MODE == 1) qw = *(const u32x4*)(rowp + C_Q + head * 64 + k8);
#pragma unroll
      for (int hh = 0; hh < 2; ++hh) { vwp[hh] = *(const u32x4*)(rowp + C_V + head * 128 + ((tid & 7) + 8 * hh) * 8); if (MODE == 1) gwp[hh] = *(const u32x4*)(rowp + C_GB + head * 128 + (tid & 7) * 16 + hh * 8); } }
    { const int r = tid >> 3, j4 = (tid & 7) * 4; f32x4 v = (f32x4){0.f, 0.f, 0.f, 0.f};
      { const int rc = r >= rmin ? r : rmin; const u32x2 w = *(const u32x2*)(cols + (size_t)(tok0 + rc) * NINP + C_GLR + j4); if (r >= rmin) { v[0] = bflo(w.x); v[1] = bfhi(w.x); v[2] = bflo(w.y); v[3] = bfhi(w.y); } }
      *(LAS f32x4*)(glr_s + r * 32 + j4) = v; }
    __syncthreads();
    { const int kk = tid & 63, rb = tid >> 6;
#pragma unroll
      for (int i = 0; i < 8; ++i) { const int r = rb + 8 * i; float x0 = bg[0], x1 = bg[1]; f32x4 gr[8];
#pragma unroll
          for (int j4 = 0; j4 < 8; ++j4) gr[j4] = *(const LAS f32x4*)(glr_s + r * 32 + j4 * 4);
#pragma unroll
          for (int j = 0; j < 16; ++j) { x0 += gr[j >> 2][j & 3] * wg[0][j]; x1 += gr[4 + (j >> 2)][j & 3] * wg[1][j]; }
          const bool ok = r >= rmin; bfs[r * 64 + kk] = ok ? logsig(x0) * 0.0625f : 0.f; bbs[r * 64 + kk] = ok ? logsig(x1) * 0.0625f : 0.f; } }
    __syncthreads();
    { const int col = tid & 127, part = tid >> 7, d = col >> 6, kk = col & 63; LAS float* bs = d ? bbs : bfs; LAS float* tot = glr_s;
      float v[16];
#pragma unroll
      for (int i = 0; i < 16; ++i) v[i] = bs[(part * 16 + i) * 64 + kk];
      if (d == 0) {
#pragma unroll
          for (int i = 1; i < 16; ++i) v[i] += v[i - 1];
          tot[part * 128 + col] = v[15]; }
      else {
#pragma unroll
          for (int i = 14; i >= 0; --i) v[i] += v[i + 1];
          tot[part * 128 + col] = v[0]; }
      __syncthreads();
      float off = 0.f;
#pragma unroll
      for (int pp = 0; pp < 4; ++pp) { const float t = tot[pp * 128 + col]; if (d == 0 ? pp < part : pp > part) off += t; }
#pragma unroll
      for (int i = 0; i < 16; ++i) bs[(part * 16 + i) * 64 + kk] = v[i] + off; }
    __syncthreads();
    LAS bf16_t* vT = (LAS bf16_t*)(lds + GL_VT);
    { const int r = tid >> 3, k8 = (tid & 7) * 8; const bool ok = r >= rmin;
      if (!ok) { kw = (u32x4){0u, 0u, 0u, 0u}; qw = kw; }
      float qv[8], kv[8];
#pragma unroll
      for (int i = 0; i < 4; ++i) { qv[2 * i] = bflo(qw[i]); qv[2 * i + 1] = bfhi(qw[i]); kv[2 * i] = bflo(kw[i]); kv[2 * i + 1] = bfhi(kw[i]); }
      if (MODE == 0) { LAS bf16_t* kd0 = (LAS bf16_t*)(lds + GL_QE0); LAS bf16_t* kd1 = (LAS bf16_t*)(lds + GL_QE1);
#pragma unroll
          for (int i = 0; i < 8; ++i) { const int kk = k8 + i; kd0[kk * GLD + r] = f2bf(kv[i] * __expf(bfs[63 * 64 + kk] - bfs[r * 64 + kk])); kd1[kk * GLD + r] = f2bf(kv[i] * __expf(bbs[kk] - bbs[r * 64 + kk])); }
      } else { LAS bf16_t* qe0 = (LAS bf16_t*)(lds + GL_QE0); LAS bf16_t* qe1 = (LAS bf16_t*)(lds + GL_QE1); LAS bf16_t* ke0 = (LAS bf16_t*)(lds + GL_KE0); LAS bf16_t* ke1 = (LAS bf16_t*)(lds + GL_KE1);
          u32x4 a, b2, c2, d2;
#pragma unroll
          for (int i = 0; i < 4; ++i) { const int kk = k8 + 2 * i; const float f0 = bfs[r * 64 + kk], f1 = bfs[r * 64 + kk + 1], g0 = bbs[r * 64 + kk], g1 = bbs[r * 64 + kk + 1];
              a[i] = cvt_pk_bf16(qv[2 * i] * 0.125f * __expf(f0), qv[2 * i + 1] * 0.125f * __expf(f1)); b2[i] = cvt_pk_bf16(qv[2 * i] * 0.125f * __expf(g0), qv[2 * i + 1] * 0.125f * __expf(g1));
              c2[i] = cvt_pk_bf16(kv[2 * i] * __expf(-f0), kv[2 * i + 1] * __expf(-f1)); d2[i] = cvt_pk_bf16(kv[2 * i] * __expf(-g0), kv[2 * i + 1] * __expf(-g1)); }
          *(LAS u32x4*)(qe0 + r * GLD + k8) = a; *(LAS u32x4*)(qe1 + r * GLD + k8) = b2; *(LAS u32x4*)(ke0 + r * GLD + k8) = c2; *(LAS u32x4*)(ke1 + r * GLD + k8) = d2; }
#pragma unroll
      for (int hh = 0; hh < 2; ++hh) { const int v8 = ((tid & 7) + 8 * hh) * 8; u32x4 vw = (u32x4){0u, 0u, 0u, 0u};
          if (ok) vw = vwp[hh];
#pragma unroll
          for (int i = 0; i < 4; ++i) { vT[(v8 + 2 * i) * GLD + r] = (bf16_t)(vw[i] & 0xffffu); vT[(v8 + 2 * i + 1) * GLD + r] = (bf16_t)(vw[i] >> 16); } }
    }
    if (MODE == 1) {
        const float* ds = (const float*)(p.ws + WS_DS); f32x4 sv[2][4];
#pragma unroll
        for (int d = 0; d < 2; ++d) { const float* src = ds + ((size_t)(ci * 4 + head) * 2 + d) * 8192;
#pragma unroll
            for (int i = 0; i < 4; ++i) sv[d][i] = *(const f32x4*)(src + (i * 512 + tid) * 4); }
#pragma unroll
        for (int d = 0; d < 2; ++d) { LAS bf16_t* sp = (LAS bf16_t*)(lds + (d ? GL_SP1 : GL_SP0));
#pragma unroll
            for (int i = 0; i < 4; ++i) { const int e = (i * 512 + tid) * 4; const f32x4 v = sv[d][i]; u32x2 w; w.x = cvt_pk_bf16(v[0], v[1]); w.y = cvt_pk_bf16(v[2], v[3]); *(LAS u32x2*)(sp + (e >> 6) * GLD + (e & 63)) = w; } }
    }
    __syncthreads();
    if (MODE == 0) {
        float* ds = (float*)(p.ws + WS_DS); float* dec = (float*)(p.ws + WS_DECAY);
        if (tid < 128) { const int d = tid >> 6, kk = tid & 63; dec[((size_t)(ci * 4 + head) * 2 + d) * 64 + kk] = __expf(d == 0 ? bfs[63 * 64 + kk] : bbs[kk]); }
#pragma unroll
        for (int d = 0; d < 2; ++d) { const LAS bf16_t* kd = (const LAS bf16_t*)(lds + (d ? GL_QE1 : GL_QE0)); float* dst = ds + ((size_t)(ci * 4 + head) * 2 + d) * 8192;
            for (int kt = 0; kt < 4; ++kt) { f32x4 acc = (f32x4){0.f, 0.f, 0.f, 0.f}; acc = mma_lds(acc, vT + wid * 16 * GLD, kd + kt * 16 * GLD, GLD, 2, lane);
#pragma unroll
                for (int j = 0; j < 4; ++j) dst[(wid * 16 + (lane >> 4) * 4 + j) * 64 + kt * 16 + (lane & 15)] = acc[j]; } }
        __syncthreads();
        return;
    }
    const LAS bf16_t* qe0 = (const LAS bf16_t*)(lds + GL_QE0); const LAS bf16_t* qe1 = (const LAS bf16_t*)(lds + GL_QE1); const LAS bf16_t* ke0 = (const LAS bf16_t*)(lds + GL_KE0); const LAS bf16_t* ke1 = (const LAS bf16_t*)(lds + GL_KE1);
    LAS bf16_t* att = (LAS bf16_t*)(lds + GL_ATT);
    { const int it = wid >> 1;
#pragma unroll
      for (int t2 = 0; t2 < 2; ++t2) { const int jt = (wid & 1) * 2 + t2; f32x4 af = (f32x4){0.f, 0.f, 0.f, 0.f}, ab = af;
          af = mma_lds(af, qe0 + it * 16 * GLD, ke0 + jt * 16 * GLD, GLD, 2, lane); ab = mma_lds(ab, qe1 + it * 16 * GLD, ke1 + jt * 16 * GLD, GLD, 2, lane);
#pragma unroll
          for (int j = 0; j < 4; ++j) { const int i_ = it * 16 + (lane >> 4) * 4 + j, j_ = jt * 16 + (lane & 15); att[i_ * GLD + j_] = f2bf((j_ <= i_ ? af[j] : 0.f) + (j_ >= i_ ? ab[j] : 0.f)); } } }
    __syncthreads();
    LAS float* os = (LAS float*)(lds + GL_OS);
    { const int it = wid >> 1; const LAS bf16_t* sp0 = (const LAS bf16_t*)(lds + GL_SP0); const LAS bf16_t* sp1 = (const LAS bf16_t*)(lds + GL_SP1);
#pragma unroll
      for (int t4 = 0; t4 < 4; ++t4) { const int vt = (wid & 1) * 4 + t4; f32x4 acc = (f32x4){0.f, 0.f, 0.f, 0.f};
          acc = mma_lds(acc, att + it * 16 * GLD, vT + vt * 16 * GLD, GLD, 2, lane); acc = mma_lds(acc, qe0 + it * 16 * GLD, sp0 + vt * 16 * GLD, GLD, 2, lane); acc = mma_lds(acc, qe1 + it * 16 * GLD, sp1 + vt * 16 * GLD, GLD, 2, lane);
#pragma unroll
          for (int j = 0; j < 4; ++j) os[(it * 16 + (lane >> 4) * 4 + j) * 132 + vt * 16 + (lane & 15)] = acc[j]; } }
    __syncthreads();
    { const int r = tid >> 3, v0 = (tid & 7) * 16; float o[16]; float ss = 0.f;
#pragma unroll
      for (int i = 0; i < 16; ++i) { o[i] = os[r * 132 + v0 + i]; ss += o[i] * o[i]; }
      ss += __shfl_xor(ss, 1); ss += __shfl_xor(ss, 2); ss += __shfl_xor(ss, 4);
      const float rs = rsqrtf(ss * (1.0f / 128.0f) + 1e-6f);
      if (r >= rmin) { const size_t tok = (size_t)(tok0 + r); bf16_t* yall = (bf16_t*)(p.ws + WS_YALL);
#pragma unroll
          for (int hh = 0; hh < 2; ++hh) { const u32x4 gw = gwp[hh]; u32x4 w;
#pragma unroll
              for (int i = 0; i < 4; ++i) { const int e = hh * 8 + 2 * i; w[i] = cvt_pk_bf16(o[e] * rs * ngv[e] * silu(bflo(gw[i])), o[e + 1] * rs * ngv[e + 1] * silu(bfhi(gw[i]))); }
              *(u32x4*)(yall + tok * D + 512 + head * 128 + v0 + hh * 8) = w; } } }
    __syncthreads();
}

__device__ __forceinline__ float softplus_neg(float lam) { const float e = __expf(-lam); return lam + 0.f < -8.f ? -lam : (e < 0.02f ? e * (1.0f - e * (0.5f - e * (1.0f / 3.0f))) : __logf(1.0f + e)); }
__device__ __forceinline__ float one_minus_exp(float x) {
    return x > -0.5f ? -x * (1.0f + x * 0.5f * (1.0f + x * (1.0f / 3.0f) * (1.0f + x * 0.25f * (1.0f + x * 0.2f * (1.0f + x * (1.0f / 6.0f) * (1.0f + x * (1.0f / 7.0f))))))) : 1.0f - __expf(x);
}
template <int MODE>
__device__ __forceinline__ void lru_phase(const int TID, const int b, const int G, const Params& p, int l, LAS unsigned char* lds) {
    const int tid = TID, lane = tid & 63, wid = tid >> 6, q = lane >> 4;
    const bf16_t* cols = (const bf16_t*)(p.ws + WS_COLS);
    int it = b; if (it >= NCK * 8) return;
    const int nb = b & 7;
    LAS bf16_t* xcA = (LAS bf16_t*)lds; LAS float* xcf = (LAS float*)(lds + 17408);
    const int ch = tid & 127, rb = tid >> 7, gchc = nb * 128 + ch;
    const float w0 = p.in[18][(l * 4 + 0) * 1024 + gchc], w1 = p.in[18][(l * 4 + 1) * 1024 + gchc], w2 = p.in[18][(l * 4 + 2) * 1024 + gchc], w3 = p.in[18][(l * 4 + 3) * 1024 + gchc], cb = p.in[19][l * 1024 + gchc];
    const int chl = wid * 16 + (lane & 15), gch = nb * 128 + chl;
    float ba[2], bx[2], sp8[2];
#pragma unroll
    for (int d = 0; d < 2; ++d) { ba[d] = p.in[21][(l * 2 + d) * 1024 + gch]; bx[d] = p.in[23][(l * 2 + d) * 1024 + gch]; sp8[d] = 8.0f * softplus_neg(p.in[24][(l * 2 + d) * 1024 + gch]); }
    bf16x8 bfr[4][4];
    { const bf16_t* bt = (const bf16_t*)(p.ws + WS_BTLRU);
#pragma unroll
      for (int mat = 0; mat < 4; ++mat)
#pragma unroll
          for (int ks = 0; ks < 4; ++ks) bfr[mat][ks] = *(const bf16x8*)(bt + ((size_t)(mat * 8 + nb) * 128 + wid * 16 + (lane & 15)) * 128 + ks * 32 + q * 8); }
    bf16_t xr[19];
    { int seq, c; chunk_info(it >> 3, seq, c); const int s0 = seq_start(seq), L = seq_len(seq), pos0 = (c == 0 ? -48 : 16 + 64 * (c - 1));
      const bf16_t* xb = cols + (size_t)s0 * NINP + C_XC + gchc;
#pragma unroll
      for (int i = 0; i < 19; ++i) { const int pos = pos0 + rb * 16 - 2 + i; const int pc = pos < 0 ? 0 : (pos < L ? pos : L - 1); xr[i] = xb[(size_t)pc * NINP]; } }
    for (; it < NCK * 8; it += G) {
        const int ci = it >> 3;
        int seq, c; chunk_info(ci, seq, c);
        const int s0 = seq_start(seq);
        const int pos0 = (c == 0 ? -48 : 16 + 64 * (c - 1));
        const int rmin = (c == 0) ? 48 : 0;
        float xv[19];
        { const int L = seq_len(seq);
#pragma unroll
          for (int i = 0; i < 19; ++i) { const int pos = pos0 + rb * 16 - 2 + i; xv[i] = (pos >= 0 && pos < L) ? bf2f(xr[i]) : 0.f; } }
#pragma unroll
        for (int i = 0; i < 16; ++i) { const int r = rb * 16 + i; const float xc = (r >= rmin) ? cb + xv[i] * w0 + xv[i + 1] * w1 + xv[i + 2] * w2 + xv[i + 3] * w3 : 0.f;
            xcf[r * 132 + ch] = xc; xcA[r * 136 + ch] = f2bf(xc); }
        u32x4 gq[2]; float cin[2];
        if (MODE == 1) {
#pragma unroll
            for (int d = 0; d < 2; ++d) cin[d] = ((const float*)(p.ws + WS_LRUC))[((size_t)ci * 2 + d) * 1024 + gch];
            { const int r = tid >> 3; const int rr = r >= rmin ? r : rmin; const bf16_t* gp = cols + (size_t)(s0 + pos0 + rr) * NINP + C_GC + nb * 128 + (tid & 7) * 16;
              gq[0] = *(const u32x4*)gp; gq[1] = *(const u32x4*)(gp + 8); }
        }
        { const int itn = it + G;
          if (itn < NCK * 8) { int seqn, cn; chunk_info(itn >> 3, seqn, cn); const int s0n = seq_start(seqn), Ln = seq_len(seqn), pos0n = (cn == 0 ? -48 : 16 + 64 * (cn - 1));
              const bf16_t* xb = cols + (size_t)s0n * NINP + C_XC + gchc;
#pragma unroll
              for (int i = 0; i < 19; ++i) { const int pos = pos0n + rb * 16 - 2 + i; const int pc = pos < 0 ? 0 : (pos < Ln ? pos : Ln - 1); xr[i] = xb[(size_t)pc * NINP]; } } }
        LBAR();
        LAS bf16_t* gts = (LAS bf16_t*)(lds + 51200); LAS float* hfs = (LAS float*)(lds + 68608);
        float hsum[4][4];
#pragma unroll
        for (int d = 0; d < 2; ++d) {
            __builtin_amdgcn_sched_barrier(0);
            f32x4 acc[2][4];
#pragma unroll
            for (int rt = 0; rt < 4; ++rt) { bf16x8 afr[4];
#pragma unroll
                for (int ks = 0; ks < 4; ++ks) afr[ks] = *(const LAS bf16x8*)(xcA + (rt * 16 + (lane & 15)) * 136 + ks * 32 + q * 8);
#pragma unroll
                for (int kind = 0; kind < 2; ++kind) { f32x4 a = (f32x4){0.f, 0.f, 0.f, 0.f};
#pragma unroll
                    for (int ks = 0; ks < 4; ++ks) a = __builtin_amdgcn_mfma_f32_16x16x32_bf16(afr[ks], bfr[d * 2 + kind][ks], a, 0, 0, 0);
                    acc[kind][rt] = a; } }
            float a[4][4], bb[4][4];
#pragma unroll
            for (int rt = 0; rt < 4; ++rt)
#pragma unroll
                for (int j = 0; j < 4; ++j) { const int r = rt * 16 + q * 4 + j; const float rg = sigm(acc[0][rt][j] + ba[d]), ig = sigm(acc[1][rt][j] + bx[d]), la = -sp8[d] * rg;
                    const bool ok = r >= rmin; const float av = __expf(la), x2 = 2.0f * la; const float om = x2 > -0.25f ? -x2 * (1.0f + x2 * 0.5f * (1.0f + x2 * (1.0f / 3.0f) * (1.0f + x2 * 0.25f * (1.0f + x2 * 0.2f)))) : 1.0f - av * av;
                    a[rt][j] = ok ? av : 1.0f; bb[rt][j] = ok ? __builtin_amdgcn_sqrtf(om) * ig * xcf[r * 132 + chl] : 0.f; }
            float LA[4], LB[4];
#pragma unroll
            for (int rt = 0; rt < 4; ++rt) { float A = 1.f, B = 0.f;
#pragma unroll
                for (int jj = 0; jj < 4; ++jj) { const int j = d == 0 ? jj : 3 - jj; B = a[rt][j] * B + bb[rt][j]; A *= a[rt][j]; }
                LA[rt] = A; LB[rt] = B; }
            const size_t co = ((size_t)ci * 2 + d) * 1024 + gch;
            float h = (MODE == 1) ? cin[d] : 0.f, Atot = 1.f; float hin[4];
#pragma unroll
            for (int rr = 0; rr < 4; ++rr) { const int rt = d == 0 ? rr : 3 - rr;
#pragma unroll
                for (int qi = 0; qi < 4; ++qi) { const int qq = d == 0 ? qi : 3 - qi;
                    const float Aq = __shfl(LA[rt], (lane & 15) + 16 * qq), Bq = __shfl(LB[rt], (lane & 15) + 16 * qq);
                    if (qq == q) hin[rt] = h;
                    h = Aq * h + Bq; Atot *= Aq; } }
            if (MODE == 0) { if (q == 0) { ((float*)(p.ws + WS_LRUA))[co] = Atot; ((float*)(p.ws + WS_LRUH))[co] = h; } }
            else {
#pragma unroll
                for (int rt = 0; rt < 4; ++rt) { float hh = hin[rt];
#pragma unroll
                    for (int jj = 0; jj < 4; ++jj) { const int j = d == 0 ? jj : 3 - jj; hh = a[rt][j] * hh + bb[rt][j];
                        if (d == 0) hfs[(rt * 16 + q * 4 + j) * 132 + chl] = hh; else hsum[rt][j] = hh; } }
                if (d == 0) { *(LAS u32x4*)(gts + (tid >> 3) * 136 + (tid & 7) * 16) = gq[0]; *(LAS u32x4*)(gts + (tid >> 3) * 136 + (tid & 7) * 16 + 8) = gq[1]; } }
        }
        if (MODE == 1) { bf16_t* yall = (bf16_t*)(p.ws + WS_YALL);
            LBAR();
#pragma unroll
            for (int rt = 0; rt < 4; ++rt)
#pragma unroll
                for (int j = 0; j < 4; ++j) { const int r = rt * 16 + q * 4 + j; xcA[r * 136 + chl] = f2bf((hsum[rt][j] + hfs[r * 132 + chl]) * silu(bf2f(gts[r * 136 + chl]))); }
            LBAR();
            { const int r = tid >> 3; if (r >= rmin) { const u32x4 y0 = *(const LAS u32x4*)(xcA + r * 136 + (tid & 7) * 16), y1 = *(const LAS u32x4*)(xcA + r * 136 + (tid & 7) * 16 + 8);
                bf16_t* yp = yall + (size_t)(s0 + pos0 + r) * D + 1024 + nb * 128 + (tid & 7) * 16; *(u32x4*)yp = y0; *(u32x4*)(yp + 8) = y1; } } }
        LBAR();
    }
}


template <int WHICH>
__device__ __forceinline__ void skinny_tail(const int TID, const int b0, const Params& p) {
    const int lane = TID & 63, wid = TID >> 6, q = lane >> 4;
    if (wid >= 5) return;
    for (int b = b0; b < 256; b += (int)gridDim.x) {
    const int ct = b & 127, rt = (b >> 7) * 5 + wid;
    const int row = 24576 + rt * 16 + (lane & 15);
    const int colb = ct * 16 + (lane & 15);
    const bf16_t* cols = (const bf16_t*)(p.ws + WS_COLS);
    if (WHICH == 0) {
        const bf16_t* A = (const bf16_t*)(p.ws + WS_YALL) + (size_t)row * D + q * 8; const bf16_t* B = (const bf16_t*)(p.ws + WS_BTOUT) + (size_t)colb * D + q * 8;
        bf16_t* mbf = (bf16_t*)(p.ws + WS_H);
        f32x4 msum = (f32x4){0.f, 0.f, 0.f, 0.f};
        unsigned char gt[3][4];
#pragma unroll
        for (int br = 0; br < 3; ++br)
#pragma unroll
            for (int j = 0; j < 4; ++j) { const int cc = colb & 255; gt[br][j] = ((const unsigned char*)(cols + (size_t)(24576 + rt * 16 + q * 4 + j) * NINP + C_MG))[(br * 8 + (colb >> 8)) * 256 + ((((cc & 127) >> 5) * 4 + ((cc & 31) >> 3)) * 2 + (cc >> 7)) * 8 + (cc & 7)]; }
        float gs[3][4];
#pragma unroll
        for (int br = 0; br < 3; ++br)
#pragma unroll
            for (int j = 0; j < 4; ++j) { gs[br][j] = (float)gt[br][j] * (1.0f / 255.0f); asm volatile("" : "+v"(gs[br][j])); }
#pragma unroll
        for (int br = 0; br < 3; ++br) { const int koff = br * 512, nks = br == 2 ? 32 : 16; f32x4 acc = (f32x4){0.f, 0.f, 0.f, 0.f};
            for (int k0 = 0; k0 < nks; k0 += 8) { bf16x8 av[8], bv[8];
#pragma unroll
                for (int i = 0; i < 8; ++i) { av[i] = *(const bf16x8*)(A + koff + (k0 + i) * 32); bv[i] = *(const bf16x8*)(B + koff + (k0 + i) * 32); }
#pragma unroll
                for (int i = 0; i < 8; ++i) acc = __builtin_amdgcn_mfma_f32_16x16x32_bf16(av[i], bv[i], acc, 0, 0, 0); }
#pragma unroll
            for (int j = 0; j < 4; ++j) msum[j] += gs[br][j] * acc[j]; }
#pragma unroll
        for (int j = 0; j < 4; ++j) { const int tok = 24576 + rt * 16 + q * 4 + j; mbf[(size_t)tok * D + colb] = f2bf(msum[j]); }
    } else {
        const bf16_t* A = (const bf16_t*)(p.ws + WS_H) + (size_t)row * D + q * 8; const bf16_t* B = (const bf16_t*)(p.ws + WS_BTO) + (size_t)colb * D + q * 8;
        float* z = (float*)(p.ws + WS_Z);
        f32x4 acc = (f32x4){0.f, 0.f, 0.f, 0.f};
        for (int k0 = 0; k0 < 64; k0 += 8) { bf16x8 av[8], bv[8];
#pragma unroll
            for (int i = 0; i < 8; ++i) { av[i] = *(const bf16x8*)(A + (k0 + i) * 32); bv[i] = *(const bf16x8*)(B + (k0 + i) * 32); }
#pragma unroll
            for (int i = 0; i < 8; ++i) acc = __builtin_amdgcn_mfma_f32_16x16x32_bf16(av[i], bv[i], acc, 0, 0, 0); }
#pragma unroll
        for (int j = 0; j < 4; ++j) { const int tok = 24576 + rt * 16 + q * 4 + j; z[(size_t)tok * D + colb] += acc[j]; }
    }
    }
}

#define XB_TMO      128
#define XB_XCNT(j)  (256  + 64 * (j))
#define XB_XSUB(j)  (1280 + 64 * (j))
#define XB_XGEN(j)  (2304 + 64 * (j))
#define XB_TOP      3328
#define XB_TOPGEN   3392
#define XCD_BAR_WORDS 3456
#define XB_SPIN_CAP (1u << 18)
__device__ __forceinline__ unsigned xb_ld(unsigned* p)              { return __hip_atomic_load(p, __ATOMIC_RELAXED, __HIP_MEMORY_SCOPE_AGENT); }
__device__ __forceinline__ unsigned xb_add(unsigned* p, unsigned v) { return __hip_atomic_fetch_add(p, v, __ATOMIC_RELAXED, __HIP_MEMORY_SCOPE_AGENT); }
__device__ __forceinline__ unsigned xb_xcc_id() { return (unsigned)__builtin_amdgcn_s_getreg((3 << 11) | 20) & 0xFu; }
#define XB_SPIN(cond, bar) do { unsigned _sp = 0; while (cond) { __builtin_amdgcn_s_sleep(1); \
    if ((++_sp & 255u) == 0u) { if (xb_ld(&(bar)[XB_TMO])) break; if (_sp > XB_SPIN_CAP) { atomicAdd(&(bar)[XB_TMO], 1u); break; } } } } while (0)
struct XcdBarrier { unsigned* bar; unsigned x; volatile LAS unsigned* st; };
__device__ __forceinline__ XcdBarrier xcd_barrier_post(unsigned* bar, volatile LAS unsigned* st) {
    XcdBarrier b; b.bar = bar; b.x = xb_xcc_id(); b.st = st;
    if (threadIdx.x == 0) (void)xb_add(&bar[XB_XCNT(b.x)], 1u);
    return b;
}
__device__ __forceinline__ void xcd_barrier_complete(unsigned* bar, unsigned x, unsigned& nloc, unsigned& nx) {
    const unsigned G = gridDim.x * gridDim.y * gridDim.z;
    unsigned sum, cnt, mine, sp = 0u;
    for (;;) {
        sum = 0u; cnt = 0u; mine = 0u;
#pragma unroll
        for (unsigned j = 0; j < 16; ++j) { const unsigned c = xb_ld(&bar[XB_XCNT(j)]); sum += c; cnt += (c > 0u) ? 1u : 0u; mine = (j == x) ? c : mine; }
        if (sum == G) break;
        __builtin_amdgcn_s_sleep(1);
        if ((++sp & 255u) == 0u) { if (xb_ld(&bar[XB_TMO])) break; if (sp > XB_SPIN_CAP) { atomicAdd(&bar[XB_TMO], 1u); break; } }
    }
    nloc = mine > 0u ? mine : 1u; nx = cnt > 0u ? cnt : 1u;
}
__device__ __forceinline__ void xcd_barrier(const XcdBarrier& b) {
    asm volatile("s_waitcnt vmcnt(0)" ::: "memory");
    __syncthreads();
    if (threadIdx.x == 0) {
        unsigned* bar = b.bar;
        __builtin_amdgcn_s_waitcnt(0);
        unsigned nloc = b.st[0], nx = b.st[1];
        if (nloc == 0u) { xcd_barrier_complete(bar, b.x, nloc, nx); b.st[0] = nloc; b.st[1] = nx; }
        const unsigned old = xb_add(&bar[XB_XSUB(b.x)], 1u);
        const unsigned gen = old / nloc;
        if (old + 1u == (gen + 1u) * nloc) {
            __builtin_amdgcn_fence(__ATOMIC_RELEASE, "agent");
            asm volatile("s_waitcnt vmcnt(0)" ::: "memory");
            const unsigned og = xb_add(&bar[XB_TOP], 1u);
            const unsigned tg = og / nx;
            if (og + 1u == (tg + 1u) * nx) xb_add(&bar[XB_TOPGEN], 1u);
            else XB_SPIN(xb_ld(&bar[XB_TOPGEN]) == tg, bar);
            __builtin_amdgcn_fence(__ATOMIC_ACQUIRE, "agent");
            xb_add(&bar[XB_XGEN(b.x)], 1u);
            asm volatile("s_waitcnt vmcnt(0)" ::: "memory");
        } else {
            XB_SPIN(xb_ld(&bar[XB_XGEN(b.x)]) == gen, bar);
            __builtin_amdgcn_fence(__ATOMIC_ACQUIRE, "agent");
            asm volatile("s_waitcnt vmcnt(0)" ::: "memory");
        }
    }
    __syncthreads();
}

__global__ void __launch_bounds__(512) fwd_megakernel(Params p_in) {
    extern __shared__ __attribute__((aligned(16))) unsigned char smem[];
    LAS unsigned char* lds = (LAS unsigned char*)smem;
    cg::grid_group grid = cg::this_grid();
    const int G = gridDim.x;
    const Params& p0 = p_in;
    volatile LAS unsigned* stw = (volatile LAS unsigned*)(lds + 150528);
    if (threadIdx.x == 0) { stw[0] = 0u; stw[1] = 0u; }
    __syncthreads();
    const XcdBarrier xb = xcd_barrier_post((unsigned*)(p_in.ws + WS_BAR), stw);
    for (int ph = p0.ph_lo; ph < p0.ph_hi; ++ph) {
        const int reps_ = (ph < 32 && (ph & 7) == DUP) ? 2 : 1;
        for (int rep_ = 0; rep_ < reps_; ++rep_) {
        int TID = threadIdx.x; asm volatile("" : "+v"(TID));
        int b = blockIdx.x; asm volatile("" : "+s"(b));
        Params p = p0; { unsigned long long t_ = (unsigned long long)p.ws; asm volatile("" : "+s"(t_)); p.ws = (unsigned char*)t_; }
        const char* ws = (const char*)p.ws;
        if (ph == 32) { final_norm_phase(TID, b, p); }
        else {
            const int l = ph >> 3, k = ph & 7;
            if (k == 0 && (PHM & 1)) { rmsnorm_phase(TID, b, p, l); convert_weights(TID, b, p, l, (LAS float*)lds); if (l == 0) s5_tables_all(TID, b, p); }
            else if (k == 1 && (PHM & 2)) {
                TileOrder S; S.nM = MP / 256; S.nN = NINP / 256; S.nwg = S.nM * S.nN; S.G = G; S.c = b; S.mult = 1; S.nt0 = D / 64; S.A = ws + WS_H; S.B = ws + WS_BTIN; S.tA = (size_t)256 * D * 2; S.tB = (size_t)256 * D * 2;
                EpiIn E; E.cols = (bf16_t*)(p.ws + WS_COLS); E.ubuf = (bf16_t*)(p.ws + WS_UBUF);
                gemm_phase(TID, lds, D, D, S, E);
                s5_assemble_a(TID, b, p, l);
            } else if (k == 2 && (PHM & 4)) {
                GroupOrder S; S.G = G; S.c = b; S.nt0 = 4; S.A = ws + WS_UBUF; S.B = ws + WS_PMAT; S.gsA = (size_t)CHP * 512 * 2; S.gsB = (size_t)256 * 256 * 2; S.tA = (size_t)256 * 512 * 2;
                EpiS5State E; E.st = (float*)(p.ws + WS_ST);
                if (SUBM & 4) gemm_phase(TID, lds, 512, 256, S, E);
                __syncthreads();
                { const int head_ = ((b + 128) % G) & 3, kk_ = TID & 63; float wg_[2][16], bg_[2];
                  _Pragma("unroll") for (int d = 0; d < 2; ++d) { bg_[d] = p.in[16][(l * 2 + d) * 256 + head_ * 64 + kk_]; _Pragma("unroll") for (int j = 0; j < 16; ++j) wg_[d][j] = p.in[15][((size_t)(l * 2 + d) * 16 + j) * 256 + head_ * 64 + kk_]; }
                  float ng_[16]; _Pragma("unroll") for (int e = 0; e < 16; ++e) ng_[e] = p.in[17][l * 512 + head_ * 128 + (TID & 7) * 16 + e];
                  for (int it = (b + 128) % G; it < NCK * 4; it += G) gla_item<0>(TID, p, l, it >> 2, it & 3, lds, wg_, bg_, ng_); }
                lru_phase<0>(TID, b, G, p, l, lds);
                s5_assemble_w(TID, b, p, l);
            } else if (k == 3 && (PHM & 8)) { scans_phase(TID, b, p, l, rep_ == 0); }
            else if (k == 4 && (PHM & 16)) {
                GroupOrder S; S.G = G; S.c = b; S.nt0 = 8; S.A = ws + WS_UBUF; S.B = ws + WS_WMAT; S.gsA = (size_t)CHP * 512 * 2; S.gsB = (size_t)256 * 512 * 2; S.tA = (size_t)256 * 512 * 2;
                EpiS5Out E; E.zs5 = (bf16_t*)(p.ws + WS_ZS5);
                if (SUBM & 4) gemm_phase(TID, lds, 512, 512, S, E);
                __syncthreads();
                { const int head_ = ((b + 128) % G) & 3, kk_ = TID & 63; float wg_[2][16], bg_[2];
                  _Pragma("unroll") for (int d = 0; d < 2; ++d) { bg_[d] = p.in[16][(l * 2 + d) * 256 + head_ * 64 + kk_]; _Pragma("unroll") for (int j = 0; j < 16; ++j) wg_[d][j] = p.in[15][((size_t)(l * 2 + d) * 16 + j) * 256 + head_ * 64 + kk_]; }
                  float ng_[16]; _Pragma("unroll") for (int e = 0; e < 16; ++e) ng_[e] = p.in[17][l * 512 + head_ * 128 + (TID & 7) * 16 + e];
                  for (int it = (b + 128) % G; it < NCK * 4; it += G) gla_item<1>(TID, p, l, it >> 2, it & 3, lds, wg_, bg_, ng_); }
                lru_phase<1>(TID, b, G, p, l, lds);
            } else if (k == 5 && (PHM & 32)) {
                TileOrder S; S.nM = MP / 256; S.nN = 2; S.nwg = S.nM * S.nN; S.G = G; S.c = b; S.mult = 1; S.nt0 = 8; S.A = ws + WS_ZS5; S.B = ws + WS_BTGLU; S.tA = (size_t)256 * 512 * 2; S.tB = (size_t)256 * 512 * 2;
                EpiGlu E; E.zs5 = (const bf16_t*)(p.ws + WS_ZS5); E.cols = (const bf16_t*)(p.ws + WS_COLS); E.bglu = p.in[14] + l * 512; E.yall = (bf16_t*)(p.ws + WS_YALL);
                gemm_phase(TID, lds, 512, 512, S, E);
            } else if (k == 6 && (PHM & 64)) {
                TileOrder S; S.nM = 96; S.nN = 8; S.nwg = S.nM * S.nN; S.G = G; S.c = b; S.mult = 3; S.nt0 = 8; S.A = ws + WS_YALL; S.B = ws + WS_BTOUT; S.tA = (size_t)256 * D * 2; S.tB = (size_t)256 * D * 2;
                EpiOut E; E.cols = (const bf16_t*)(p.ws + WS_COLS); E.mbf = (bf16_t*)(p.ws + WS_H);
                gemm_phase(TID, lds, D, D, S, E);
                skinny_tail<0>(TID, b, p);
            } else if (PHM & 128) {
                TileOrder S; S.nM = 96; S.nN = 8; S.nwg = S.nM * S.nN; S.G = G; S.c = b; S.mult = 1; S.nt0 = D / 64; S.A = ws + WS_H; S.B = ws + WS_BTO; S.tA = (size_t)256 * D * 2; S.tB = (size_t)256 * D * 2;
                EpiWo E; E.z = (float*)(p.ws + WS_Z);
                gemm_phase(TID, lds, D, D, S, E);
                skinny_tail<1>(TID, b, p);
            }
        }
        }
        if (p0.use_sync && ph + 1 < p0.ph_hi) { if (ph == p0.ph_lo) grid.sync(); else xcd_barrier(xb); }
    }
}

extern "C" void kernel_launch(void* const* d_in, const int* in_sizes, int n_in, void* d_out, int out_size, void* d_ws, size_t ws_size, hipStream_t stream) {
    static int grid = 0, coop = 1;
    if (grid == 0) {
        if (n_in != 30 || ws_size < WS_END) { fprintf(stderr, "kernel_launch: unexpected n_in %d or ws_size %zu (< %zu)\n", n_in, ws_size, (size_t)WS_END); grid = -1; return; }
        int dev = 0, cus = 0, per_cu = 0;
        (void)hipGetDevice(&dev); (void)hipDeviceGetAttribute(&cus, hipDeviceAttributeMultiprocessorCount, dev);
        if (hipFuncSetAttribute((const void*)fwd_megakernel, hipFuncAttributeMaxDynamicSharedMemorySize, LDS_BYTES) != hipSuccess) { fprintf(stderr, "kernel_launch: hipFuncSetAttribute failed\n"); grid = -1; return; }
        if (hipOccupancyMaxActiveBlocksPerMultiprocessor(&per_cu, (const void*)fwd_megakernel, 512, LDS_BYTES) != hipSuccess || per_cu < 1) { fprintf(stderr, "kernel_launch: occupancy query gave %d\n", per_cu); per_cu = 1; }
        (void)hipGetLastError();
        grid = cus * 1;
    }
    if (grid < 0) return;
    Params p{};
    for (int i = 0; i < 30; ++i) p.in[i] = (const float*)d_in[i];
    p.out = (float*)d_out; p.ws = (unsigned char*)d_ws; p.pad = 0;
    (void)hipMemsetAsync((char*)d_ws + WS_BAR, 0, 3456 * 4, stream);
    if (coop) {
        p.ph_lo = 0; p.ph_hi = 33; p.use_sync = 1;
        void* args[] = {&p};
        hipError_t e = hipLaunchCooperativeKernel((const void*)fwd_megakernel, dim3(grid), dim3(512), args, LDS_BYTES, stream);
        if (e == hipSuccess) return;
        fprintf(stderr, "kernel_launch: cooperative launch failed: %s (grid %d); falling back to one launch per phase\n", hipGetErrorString(e), grid);
        (void)hipGetLastError(); coop = 0;
    }
    for (int ph = 0; ph < 33; ++ph) { p.ph_lo = ph; p.ph_hi = ph + 1; p.use_sync = 0; hipLaunchKernelGGL(fwd_megakernel, dim3(grid), dim3(512), LDS_BYTES, stream, p); }
}
```

```cpp
#include <hip/hip_runtime.h>
#include <hip/hip_cooperative_groups.h>
#include <cstdio>
namespace cg = cooperative_groups;
#define LAS __attribute__((address_space(3)))
typedef unsigned short bf16_t;
typedef short bf16x8 __attribute__((ext_vector_type(8)));
typedef float f32x4 __attribute__((ext_vector_type(4)));
typedef float f32x2 __attribute__((ext_vector_type(2)));
typedef unsigned u32x2 __attribute__((ext_vector_type(2)));
typedef unsigned u32x4 __attribute__((ext_vector_type(4)));

constexpr int D = 2048, NTOK = 24736, MP = 24832, NINP = 11008, NIN = 10784;
constexpr int NCH16 = 1546, CHP = 1792, NCK = 394;
constexpr int C_GA = 512, C_Q = 1024, C_K = 1280, C_V = 1536, C_GB = 2048, C_XC = 2560, C_GC = 3584, C_MG = 4608, C_GLR = 10752;
constexpr int LDS_BYTES = 150528 + 16;
#ifndef SYNCREP
#define SYNCREP 1
#endif
#ifndef DUP
#define DUP -1
#endif
#ifndef SUBM
#define SUBM 7
#endif
#ifndef PHM
#define PHM 255
#endif

constexpr size_t al256(size_t x) { return (x + 255) & ~(size_t)255; }
constexpr size_t WS_Z = 0;
constexpr size_t WS_H = WS_Z + al256((size_t)MP * D * 4);
constexpr size_t WS_COLS = WS_H + al256((size_t)MP * D * 2);
constexpr size_t WS_YALL = WS_COLS + al256((size_t)MP * NINP * 2);
constexpr size_t WS_ZS5 = WS_YALL + al256((size_t)MP * D * 2);
constexpr size_t WS_UBUF = WS_ZS5 + al256((size_t)MP * 512 * 2);
constexpr size_t WS_ST = WS_UBUF + al256((size_t)32 * CHP * 512 * 2);
constexpr size_t WS_DS = WS_ST + al256((size_t)32 * CHP * 256 * 4);
constexpr size_t WS_M32 = WS_UBUF;
constexpr size_t WS_DECAY = WS_DS + al256((size_t)NCK * 4 * 2 * 8192 * 4);
constexpr size_t WS_LRUA = WS_DECAY + al256((size_t)NCK * 4 * 2 * 64 * 4);
constexpr size_t WS_LRUH = WS_LRUA + al256((size_t)NCK * 2 * 1024 * 4);
constexpr size_t WS_LRUC = WS_LRUH + al256((size_t)NCK * 2 * 1024 * 4);
constexpr size_t WS_PW = WS_LRUC + al256((size_t)NCK * 2 * 1024 * 4);
constexpr size_t WS_BBAR = WS_PW + al256((size_t)4 * 32 * 2 * 17 * 64 * 8);
constexpr size_t WS_WMAT = WS_BBAR + al256((size_t)4 * 32 * 2 * 64 * 16 * 8);
constexpr size_t WS_PMAT = WS_WMAT + al256((size_t)32 * 256 * 512 * 2);
constexpr size_t WS_BTIN = WS_PMAT + al256((size_t)32 * 256 * 256 * 2);
constexpr size_t WS_BTOUT = WS_BTIN + al256((size_t)NINP * D * 2);
constexpr size_t WS_BTO = WS_BTOUT + al256((size_t)D * D * 2);
constexpr size_t WS_BTGLU = WS_BTO + al256((size_t)D * D * 2);
constexpr size_t WS_BTLRU = WS_BTGLU + al256((size_t)512 * 512 * 2);
constexpr size_t WS_KMAT = WS_BTLRU + al256((size_t)32 * 128 * 128 * 2);
constexpr size_t WS_BAR = WS_KMAT + al256((size_t)32 * 2 * 16 * 256 * 4);
constexpr size_t WS_END = WS_BAR + al256((size_t)3456 * 4);
constexpr size_t PWL = (size_t)32 * 2 * 17 * 64, BBL = (size_t)32 * 2 * 64 * 16;
static_assert(WS_END <= (size_t)1413480448, "workspace too large");
static_assert((size_t)MP * D * 4 <= WS_DECAY - WS_UBUF, "m32 alias too small");

struct Params { const float* in[30]; float* out; unsigned char* ws; int ph_lo, ph_hi, use_sync, pad; };

#define LBAR() do { asm volatile("s_waitcnt lgkmcnt(0)" ::: "memory"); __builtin_amdgcn_s_barrier(); asm volatile("" ::: "memory"); } while (0)
__device__ __forceinline__ unsigned cvt_pk_bf16(float lo, float hi) { unsigned r; asm volatile("v_cvt_pk_bf16_f32 %0, %1, %2" : "=v"(r) : "v"(lo), "v"(hi)); return r; }
__device__ __forceinline__ bf16_t f2bf(float f) { return (bf16_t)(cvt_pk_bf16(f, 0.f) & 0xffffu); }
__device__ __forceinline__ float bf2f(bf16_t b) { return __uint_as_float(((unsigned)b) << 16); }
__device__ __forceinline__ float bflo(unsigned w) { return __uint_as_float(w << 16); }
__device__ __forceinline__ float bfhi(unsigned w) { return __uint_as_float(w & 0xffff0000u); }
__device__ __forceinline__ float sigm(float x) { return __builtin_amdgcn_rcpf(1.0f + __expf(-x)); }
__device__ __forceinline__ float silu(float x) { return x * sigm(x); }
__device__ __forceinline__ float gelu_t(float x) { const float u = 0.7978845608028654f * (x + 0.044715f * x * x * x); return x * sigm(2.0f * u); }
__device__ __forceinline__ float logsig(float x) { return -(fmaxf(-x, 0.f) + __logf(1.0f + __expf(-fabsf(x)))); }

__device__ __forceinline__ int seq_start(int s) { return s < 2 ? s * 4112 : 8224 + (s - 2) * 2064; }
__device__ __forceinline__ int seq_len(int s) { return s < 2 ? 4112 : 2064; }
__device__ __forceinline__ void chunk_info(int ci, int& seq, int& c) { if (ci < 130) { seq = ci / 65; c = ci - seq * 65; } else { const int t = ci - 130; const int q = t / 33; seq = 2 + q; c = t - q * 33; } }

constexpr int BM = 256, BK = 64, HALF = 128, HTB = HALF * BK * 2, STAGE_BYTES = 8 * HTB, NXCD = 8, WGM = 8;
__device__ __forceinline__ int lds_byte(int r, int c) { const int st = (r >> 4) * 2 + (c >> 5), rr = r & 15, cc = c & 31, ob = rr * 64 + cc * 2; return st * 1024 + (ob ^ (((ob >> 9) & 1) << 5)); }
__device__ __forceinline__ void stage_rc(int b, int& R, int& C) { const int st = b / 1024, sb = b % 1024, swz = sb ^ (((sb >> 9) & 1) << 5); R = (st >> 1) * 16 + swz / 64; C = (st & 1) * 32 + (swz % 64) / 2; }

struct Unit { int pm, pn, sub, nt; const char* a; const char* b; };

struct TileOrder {
    int nM, nN, nwg, G, c, mult, nt0; const char* A; const char* B; size_t tA, tB;
    __device__ __forceinline__ bool next(int i, Unit& u) const {
        const int ti = i / mult, sub = i - ti * mult;
        const long L = (long)ti * G + c; if (L >= nwg) return false;
        int wgid = (int)L; { const int q = nwg / NXCD, r = nwg % NXCD, xcd = wgid % NXCD, off = wgid / NXCD; wgid = (xcd < r ? xcd * (q + 1) : r * (q + 1) + (xcd - r) * q) + off; }
        const int nig = WGM * nN, gid = wgid / nig, fm = gid * WGM, gsz = (nM - fm) < WGM ? (nM - fm) : WGM;
        u.pm = fm + ((wgid % nig) % gsz); u.pn = (wgid % nig) / gsz; u.sub = sub;
        const int koff = (mult == 3) ? sub * 512 : 0; u.nt = (mult == 3) ? (sub == 2 ? 16 : 8) : nt0;
        u.a = A + (size_t)u.pm * tA + (size_t)koff * 2; u.b = B + (size_t)u.pn * tB + (size_t)koff * 2; return true;
    }
};
struct GroupOrder {
    int G, c, nt0; const char* A; const char* B; size_t gsA, gsB, tA;
    __device__ __forceinline__ bool next(int i, Unit& u) const {
        const int L = i * G + c; if (L >= 224) return false;
        const int g = L / 7, pm = L - g * 7; u.pm = pm; u.pn = 0; u.sub = g; u.nt = nt0;
        u.a = A + (size_t)g * gsA + (size_t)pm * tA; u.b = B + (size_t)g * gsB; return true;
    }
};

__device__ __forceinline__ int perm32(int rho) { const int n = rho >> 4, i = rho & 15; return 8 * (i >> 2) + 4 * n + (i & 3); }
template <class Epi, class Sched>
__device__ __forceinline__ void gemm_phase(const int TID, LAS unsigned char* lds, const int lda, const int ldb, const Sched& S, const Epi& E) {
    const int tid = TID, wid = __builtin_amdgcn_readfirstlane(tid >> 6), lane = tid & 63, wr = wid >> 2, wc = wid & 3, fr = lane & 15, fq = lane >> 4;
    unsigned voffA[2], voffB[2];
#pragma unroll
    for (int i = 0; i < 2; ++i) { int R, C; stage_rc(tid * 16 + i * 8192, R, C); const int Rb = Epi::PERM ? ((R & ~31) + perm32(R & 31)) : R; voffA[i] = (unsigned)(R * lda + C) * 2u; voffB[i] = (unsigned)(Rb * ldb + C) * 2u; }
    const size_t kstep = (size_t)(BK * 2);
    const size_t hA = (size_t)HALF * lda * 2, hB = (size_t)HALF * ldb * 2;
    const unsigned ldsw = (unsigned)wid * 1024u;
    const int aoff = lds_byte(wr * 64 + fr, fq * 8), boff = lds_byte(wc * 32 + fr, fq * 8);
#define PG8_SA(b, h) (((b) * 2 + (h)) * HTB)
#define PG8_SB(b, h) ((4 + (b) * 2 + (h)) * HTB)
#define PG8_STAGE(bufoff, gbase, voff) do { _Pragma("unroll") for (int _i = 0; _i < 2; ++_i) \
        __builtin_amdgcn_global_load_lds((const unsigned*)((const char*)(gbase) + (voff)[_i]), (LAS unsigned*)(lds + (bufoff) + ldsw + _i * 8192), 16, 0, 0); } while (0)
#define PG8_LDA(dst, b, h) do { _Pragma("unroll") for (int m = 0; m < 4; ++m) _Pragma("unroll") for (int k = 0; k < 2; ++k) dst[m][k] = *(const LAS bf16x8*)(lds + PG8_SA(b, h) + aoff + m * 2048 + k * 1024); } while (0)
#define PG8_LDB(dst, b, h) do { _Pragma("unroll") for (int n = 0; n < 2; ++n) _Pragma("unroll") for (int k = 0; k < 2; ++k) dst[n][k] = *(const LAS bf16x8*)(lds + PG8_SB(b, h) + boff + n * 2048 + k * 1024); } while (0)
#define PG8_MMA(ai, bj, At, Bt) do { __builtin_amdgcn_s_setprio(1); _Pragma("unroll") for (int m = 0; m < 4; ++m) _Pragma("unroll") for (int n = 0; n < 2; ++n) _Pragma("unroll") for (int k = 0; k < 2; ++k) \
        acc[ai][bj][m][n] = __builtin_amdgcn_mfma_f32_16x16x32_bf16(Bt[n][k], At[m][k], acc[ai][bj][m][n], 0, 0, 0); __builtin_amdgcn_s_setprio(0); } while (0)
#define PG8_WAIT_V(n) asm volatile("s_waitcnt vmcnt(" #n ")" ::: "memory")
#define PG8_WAIT_L(n) asm volatile("s_waitcnt lgkmcnt(" #n ")" ::: "memory")
#define PG8_BAR __builtin_amdgcn_s_barrier()
#define PG8_SCHED __builtin_amdgcn_sched_barrier(0)
    Unit cur, nxt; int ui = 0;
    if (!S.next(0, cur)) return;
    f32x4 acc[2][2][4][2];
#pragma unroll
    for (int a = 0; a < 2; ++a)
#pragma unroll
        for (int b = 0; b < 2; ++b)
#pragma unroll
            for (int m = 0; m < 4; ++m)
#pragma unroll
                for (int n = 0; n < 2; ++n) acc[a][b][m][n] = (f32x4){0.f, 0.f, 0.f, 0.f};
    bf16x8 At[4][2], B0[2][2], B1[2][2];
    const char* cA = cur.a; const char* cB = cur.b;
    PG8_STAGE(PG8_SB(0, 0), cB, voffB); PG8_STAGE(PG8_SA(0, 0), cA, voffA); PG8_STAGE(PG8_SB(0, 1), cB + hB, voffB); PG8_STAGE(PG8_SA(0, 1), cA + hA, voffA);
    if (wr == 1) PG8_BAR;
    PG8_WAIT_V(4); PG8_BAR;
    PG8_STAGE(PG8_SB(1, 0), cB + kstep, voffB); PG8_STAGE(PG8_SA(1, 0), cA + kstep, voffA); PG8_STAGE(PG8_SB(1, 1), cB + hB + kstep, voffB);
    PG8_WAIT_V(6); PG8_BAR;
    for (;;) {
        const bool has_next = S.next(ui + 1, nxt);
        const char* nA = has_next ? nxt.a : cA; const char* nB = has_next ? nxt.b : cB;
        const int nt = cur.nt;
        for (int t = 0; t < nt; t += 2) {
            const bool last = (t == nt - 2);
            const char* a1 = cA + (size_t)(t + 1) * kstep;
            const char* a2 = last ? nA : cA + (size_t)(t + 2) * kstep; const char* b2 = last ? nB : cB + (size_t)(t + 2) * kstep;
            const char* a3 = a2 + kstep; const char* b3 = b2 + kstep;
            PG8_LDB(B0, 0, 0); PG8_SCHED; PG8_LDA(At, 0, 0); PG8_STAGE(PG8_SA(1, 1), a1 + hA, voffA);
            PG8_WAIT_L(8); PG8_BAR; PG8_WAIT_L(0); PG8_MMA(0, 0, At, B0); PG8_BAR; PG8_SCHED;
            PG8_LDB(B1, 0, 1); PG8_STAGE(PG8_SB(0, 0), b2, voffB);
            PG8_BAR; PG8_WAIT_L(0); PG8_MMA(0, 1, At, B1); PG8_BAR;
            PG8_LDA(At, 0, 1); PG8_STAGE(PG8_SA(0, 0), a2, voffA);
            PG8_BAR; PG8_WAIT_L(0); PG8_MMA(1, 0, At, B0); PG8_BAR; PG8_SCHED;
            PG8_STAGE(PG8_SB(0, 1), b2 + hB, voffB);
            PG8_WAIT_V(6); PG8_BAR; PG8_MMA(1, 1, At, B1); PG8_BAR;
            PG8_LDB(B0, 1, 0); PG8_SCHED; PG8_LDA(At, 1, 0); PG8_STAGE(PG8_SA(0, 1), a2 + hA, voffA);
            PG8_WAIT_L(8); PG8_BAR; PG8_WAIT_L(0); PG8_MMA(0, 0, At, B0); PG8_BAR; PG8_SCHED;
            PG8_LDB(B1, 1, 1); PG8_STAGE(PG8_SB(1, 0), b3, voffB);
            PG8_BAR; PG8_WAIT_L(0); PG8_MMA(0, 1, At, B1); PG8_BAR;
            PG8_LDA(At, 1, 1); PG8_STAGE(PG8_SA(1, 0), a3, voffA);
            PG8_BAR; PG8_WAIT_L(0); PG8_MMA(1, 0, At, B0); PG8_BAR; PG8_SCHED;
            PG8_STAGE(PG8_SB(1, 1), b3 + hB, voffB);
            PG8_WAIT_V(6); PG8_BAR; PG8_MMA(1, 1, At, B1); PG8_BAR;
        }
        E(acc, cur, wr, wc, fr, fq);
        if (!has_next) break;
#pragma unroll
        for (int a = 0; a < 2; ++a)
#pragma unroll
            for (int b = 0; b < 2; ++b)
#pragma unroll
                for (int m = 0; m < 4; ++m)
#pragma unroll
                    for (int n = 0; n < 2; ++n) acc[a][b][m][n] = (f32x4){0.f, 0.f, 0.f, 0.f};
        cur = nxt; cA = nA; cB = nB; ++ui;
    }
    PG8_WAIT_V(0);
    if (wr == 0) PG8_BAR;
    PG8_BAR;
#undef PG8_SA
#undef PG8_SB
#undef PG8_STAGE
#undef PG8_LDA
#undef PG8_LDB
#undef PG8_MMA
#undef PG8_WAIT_V
#undef PG8_WAIT_L
#undef PG8_BAR
#undef PG8_SCHED
}

#define EPI_LOOP(...) \
    const int row0 = u.pm * BM + wr * 64 + fr, col0 = u.pn * BM + wc * 32 + 4 * fq; \
    _Pragma("unroll") for (int ai = 0; ai < 2; ++ai) _Pragma("unroll") for (int m = 0; m < 4; ++m) { const int r = row0 + ai * HALF + m * 16; \
        _Pragma("unroll") for (int bj = 0; bj < 2; ++bj) _Pragma("unroll") for (int n = 0; n < 2; ++n) { const int c = col0 + bj * HALF + n * 16; const f32x4 v = acc[ai][bj][m][n]; __VA_ARGS__ } }

#define EPI_PROWS(...) \
    const int row0 = u.pm * BM + wr * 64 + fr, col0 = u.pn * BM + wc * 32 + 8 * fq; \
    _Pragma("unroll") for (int ai = 0; ai < 2; ++ai) _Pragma("unroll") for (int m = 0; m < 4; ++m) { const int r = row0 + ai * HALF + m * 16; __VA_ARGS__ }
__device__ __forceinline__ u32x4 pack8(const f32x4 a, const f32x4 b) { u32x4 w; w[0] = cvt_pk_bf16(a[0], a[1]); w[1] = cvt_pk_bf16(a[2], a[3]); w[2] = cvt_pk_bf16(b[0], b[1]); w[3] = cvt_pk_bf16(b[2], b[3]); return w; }
__device__ __forceinline__ unsigned q8(float x) { return (unsigned)__float2uint_rn(sigm(x) * 255.0f); }
__device__ __forceinline__ unsigned q8x4(const f32x4 v) { return q8(v[0]) | (q8(v[1]) << 8) | (q8(v[2]) << 16) | (q8(v[3]) << 24); }
struct EpiIn { static constexpr bool PERM = true; bf16_t* cols; bf16_t* ubuf;
    __device__ __forceinline__ void operator()(const f32x4 (&acc)[2][2][4][2], const Unit& u, int wr, int wc, int fr, int fq) const {
        if (u.pn >= 18 && u.pn < 42) {
            EPI_PROWS({ u32x4 w; w[0] = q8x4(acc[ai][0][m][0]); w[1] = q8x4(acc[ai][0][m][1]); w[2] = q8x4(acc[ai][1][m][0]); w[3] = q8x4(acc[ai][1][m][1]);
                *(u32x4*)((unsigned char*)(cols + (size_t)r * NINP + C_MG) + (u.pn - 18) * 256 + (wc * 4 + fq) * 16) = w; })
        } else {
            EPI_PROWS({ _Pragma("unroll") for (int bj = 0; bj < 2; ++bj) { const int c = col0 + bj * HALF;
                bf16_t* dst = (u.pn < 2) ? ubuf + ((size_t)((c >> 4) * CHP + (r >> 4)) * 512 + (r & 15) * 16 + (c & 15)) : cols + (size_t)r * NINP + c;
                *(u32x4*)dst = pack8(acc[ai][bj][m][0], acc[ai][bj][m][1]); } })
        }
    } };
struct EpiS5State { static constexpr bool PERM = false; float* st;
    __device__ __forceinline__ void operator()(const f32x4 (&acc)[2][2][4][2], const Unit& u, int wr, int wc, int fr, int fq) const {
        EPI_LOOP({ *(f32x4*)(st + ((size_t)(u.sub * CHP + r)) * 256 + c) = v; })
    } };
struct EpiS5Out { static constexpr bool PERM = true; bf16_t* zs5;
    __device__ __forceinline__ void operator()(const f32x4 (&acc)[2][2][4][2], const Unit& u, int wr, int wc, int fr, int fq) const {
        EPI_PROWS({ if (r < NCH16) { _Pragma("unroll") for (int bj = 0; bj < 2; ++bj) { const int c = col0 + bj * HALF; f32x4 a = acc[ai][bj][m][0], b2 = acc[ai][bj][m][1];
            _Pragma("unroll") for (int e = 0; e < 4; ++e) { a[e] = gelu_t(a[e]); b2[e] = gelu_t(b2[e]); }
            *(u32x4*)(zs5 + (size_t)(r * 16 + (c >> 4)) * 512 + u.sub * 16 + (c & 15)) = pack8(a, b2); } } })
    } };
#define EPI_ROWS(...) \
    const int row0 = u.pm * BM + wr * 64 + fr, col0 = u.pn * BM + wc * 32 + 4 * fq; \
    _Pragma("unroll") for (int ai = 0; ai < 2; ++ai) _Pragma("unroll") for (int m = 0; m < 4; ++m) { const int r = row0 + ai * HALF + m * 16; __VA_ARGS__ }
#define QOFF(q) (((q) >> 1) * HALF + ((q) & 1) * 16)
#define EPI_PIPE(LOADF, COMPF) \
    const int row0 = u.pm * BM + wr * 64 + fr, col0 = u.pn * BM + wc * 32 + 8 * fq; \
    LOADF(0, 0); \
    _Pragma("unroll") for (int gi = 0; gi < 8; ++gi) { if (gi + 1 < 8) { if ((gi & 1) == 0) { LOADF(gi + 1, 1); } else { LOADF(gi + 1, 0); } } if ((gi & 1) == 0) { COMPF(gi, 0); } else { COMPF(gi, 1); } }
#define GROW(gi) (row0 + ((gi) >> 2) * HALF + ((gi) & 3) * 16)
struct EpiGlu { static constexpr bool PERM = true; const bf16_t* zs5; const bf16_t* cols; const float* bglu; bf16_t* yall;
    __device__ __forceinline__ void operator()(const f32x4 (&acc)[2][2][4][2], const Unit& u, int wr, int wc, int fr, int fq) const {
        u32x4 zz[2][2], gg[2][2]; f32x4 bb[2][2];
        { const int c0 = u.pn * BM + wc * 32 + 8 * fq; _Pragma("unroll") for (int bj = 0; bj < 2; ++bj) { bb[bj][0] = *(const f32x4*)(bglu + c0 + bj * HALF); bb[bj][1] = *(const f32x4*)(bglu + c0 + bj * HALF + 4); } }
#define GLU_LOAD(gi, bf) do { const int r_ = GROW(gi); _Pragma("unroll") for (int bj = 0; bj < 2; ++bj) { const int c = col0 + bj * HALF; zz[bf][bj] = *(const u32x4*)(zs5 + (size_t)r_ * 512 + c); gg[bf][bj] = *(const u32x4*)(cols + (size_t)r_ * NINP + C_GA + c); } } while (0)
#define GLU_COMP(gi, bf) do { const int r_ = GROW(gi); _Pragma("unroll") for (int bj = 0; bj < 2; ++bj) { const int c = col0 + bj * HALF; f32x4 o[2]; \
            _Pragma("unroll") for (int hf = 0; hf < 2; ++hf) { const f32x4 v = acc[(gi) >> 2][bj][(gi) & 3][hf]; \
                o[hf][0] = bflo(zz[bf][bj][2 * hf]) * sigm(v[0] + bb[bj][hf][0]) * silu(bflo(gg[bf][bj][2 * hf])); o[hf][1] = bfhi(zz[bf][bj][2 * hf]) * sigm(v[1] + bb[bj][hf][1]) * silu(bfhi(gg[bf][bj][2 * hf])); \
                o[hf][2] = bflo(zz[bf][bj][2 * hf + 1]) * sigm(v[2] + bb[bj][hf][2]) * silu(bflo(gg[bf][bj][2 * hf + 1])); o[hf][3] = bfhi(zz[bf][bj][2 * hf + 1]) * sigm(v[3] + bb[bj][hf][3]) * silu(bfhi(gg[bf][bj][2 * hf + 1])); } \
            *(u32x4*)(yall + (size_t)r_ * D + c) = pack8(o[0], o[1]); } } while (0)
        EPI_PIPE(GLU_LOAD, GLU_COMP)
#undef GLU_LOAD
#undef GLU_COMP
    } };
__device__ __forceinline__ float ub(unsigned w, int k) { return (float)((w >> (8 * k)) & 255u) * (1.0f / 255.0f); }
struct EpiOut { static constexpr bool PERM = true; const bf16_t* cols; bf16_t* mbf;
    __device__ __forceinline__ void operator()(const f32x4 (&acc)[2][2][4][2], const Unit& u, int wr, int wc, int fr, int fq) const {
        u32x4 gg[8], mm[2][2];
        { const int row0g = u.pm * BM + wr * 64 + fr;
#pragma unroll
          for (int gi = 0; gi < 8; ++gi) gg[gi] = *(const u32x4*)((const unsigned char*)(cols + (size_t)(row0g + (gi >> 2) * HALF + (gi & 3) * 16) * NINP + C_MG) + (u.sub * 8 + u.pn) * 256 + (wc * 4 + fq) * 16); }
#define OUT_LOAD(gi, bf) do { const int r_ = GROW(gi); const bf16_t* mp = mbf + (size_t)r_ * D + col0; \
            _Pragma("unroll") for (int bj = 0; bj < 2; ++bj) { mm[bf][bj] = (u32x4){0u, 0u, 0u, 0u}; if (u.sub != 0) mm[bf][bj] = *(const u32x4*)(mp + bj * HALF); } } while (0)
#define OUT_COMP(gi, bf) do { const int r_ = GROW(gi); bf16_t* mp = mbf + (size_t)r_ * D + col0; _Pragma("unroll") for (int bj = 0; bj < 2; ++bj) { f32x4 o[2]; \
            _Pragma("unroll") for (int hf = 0; hf < 2; ++hf) { const f32x4 v = acc[(gi) >> 2][bj][(gi) & 3][hf]; const unsigned gw = gg[gi][bj * 2 + hf]; \
                o[hf][0] = bflo(mm[bf][bj][2 * hf]) + ub(gw, 0) * v[0]; o[hf][1] = bfhi(mm[bf][bj][2 * hf]) + ub(gw, 1) * v[1]; \
                o[hf][2] = bflo(mm[bf][bj][2 * hf + 1]) + ub(gw, 2) * v[2]; o[hf][3] = bfhi(mm[bf][bj][2 * hf + 1]) + ub(gw, 3) * v[3]; } \
            *(u32x4*)(mp + bj * HALF) = pack8(o[0], o[1]); } } while (0)
        EPI_PIPE(OUT_LOAD, OUT_COMP)
#undef OUT_LOAD
#undef OUT_COMP
    } };
struct EpiWo { static constexpr bool PERM = false; float* z;
    __device__ __forceinline__ void operator()(const f32x4 (&acc)[2][2][4][2], const Unit& u, int wr, int wc, int fr, int fq) const {
        EPI_ROWS({ if (r < NTOK) { float* zp = z + (size_t)r * D + col0; f32x4 pv[4];
            _Pragma("unroll") for (int q = 0; q < 4; ++q) pv[q] = *(const f32x4*)(zp + QOFF(q));
            _Pragma("unroll") for (int q = 0; q < 4; ++q) *(f32x4*)(zp + QOFF(q)) = pv[q] + acc[ai][q >> 1][m][q & 1]; } })
    } };

__device__ __forceinline__ const float* src_row(const Params& p, int r) {
    int s, pos; if (r < 8224) { s = r / 4112; pos = r - s * 4112; } else { const int t = r - 8224; const int q = t / 2064; s = 2 + q; pos = t - q * 2064; }
    if (pos < 16) return p.in[2] + (size_t)pos * D;
    return s < 2 ? p.in[0] + ((size_t)s * 4096 + (pos - 16)) * D : p.in[1] + ((size_t)(s - 2) * 2048 + (pos - 16)) * D;
}
__device__ __forceinline__ void rmsnorm_phase(const int TID, const int BID, const Params& p, int l) {
    float* z = (float*)(p.ws + WS_Z); bf16_t* h = (bf16_t*)(p.ws + WS_H); const float* g = p.in[3] + (size_t)l * D;
    const int lane = TID & 63, gw = BID * 8 + (TID >> 6), nw = gridDim.x * 8;
    f32x4 gg[8];
#pragma unroll
    for (int i = 0; i < 8; ++i) gg[i] = *(const f32x4*)(g + (i * 64 + lane) * 4);
    f32x4 xn[8];
    { const int r0 = gw < NTOK ? gw : NTOK - 1; const float* src = (l == 0) ? src_row(p, r0) : z + (size_t)r0 * D;
#pragma unroll
      for (int i = 0; i < 8; ++i) xn[i] = *(const f32x4*)(src + (i * 64 + lane) * 4); }
    for (int r = gw; r < MP; r += nw) {
        bf16_t* hr = h + (size_t)r * D;
        f32x4 x[8];
#pragma unroll
        for (int i = 0; i < 8; ++i) x[i] = xn[i];
        { const int rn = (r + nw < NTOK) ? r + nw : NTOK - 1; const float* src = (l == 0) ? src_row(p, rn) : z + (size_t)rn * D;
#pragma unroll
          for (int i = 0; i < 8; ++i) xn[i] = *(const f32x4*)(src + (i * 64 + lane) * 4); }
        if (r >= NTOK) { for (int i = 0; i < 4; ++i) *(u32x4*)(hr + (i * 64 + lane) * 8) = (u32x4){0u, 0u, 0u, 0u}; continue; }
        float ss = 0.f;
#pragma unroll
        for (int i = 0; i < 8; ++i) ss += x[i][0] * x[i][0] + x[i][1] * x[i][1] + x[i][2] * x[i][2] + x[i][3] * x[i][3];
#pragma unroll
        for (int o = 32; o >= 1; o >>= 1) ss += __shfl_xor(ss, o);
        const float rs = rsqrtf(ss * (1.0f / D) + 1e-6f);
#pragma unroll
        for (int i = 0; i < 8; ++i) { const int c = (i * 64 + lane) * 4;
            if (l == 0) *(f32x4*)(z + (size_t)r * D + c) = x[i];
            u32x2 w; w.x = cvt_pk_bf16(x[i][0] * rs * gg[i][0], x[i][1] * rs * gg[i][1]); w.y = cvt_pk_bf16(x[i][2] * rs * gg[i][2], x[i][3] * rs * gg[i][3]); *(u32x2*)(hr + c) = w; }
    }
}
__device__ __forceinline__ void final_norm_phase(const int TID, const int BID, const Params& p) {
    const float* z = (const float*)(p.ws + WS_Z); const float* g = p.in[29];
    const int lane = TID & 63, gw = BID * 8 + (TID >> 6), nw = gridDim.x * 8;
    for (int r = gw; r < NTOK; r += nw) {
        int s, pos; if (r < 8224) { s = r / 4112; pos = r - s * 4112; } else { const int t = r - 8224; const int q = t / 2064; s = 2 + q; pos = t - q * 2064; }
        if (pos < 16) continue;
        float* dst = s < 2 ? p.out + ((size_t)s * 4096 + (pos - 16)) * D : p.out + (size_t)2 * 4096 * D + ((size_t)(s - 2) * 2048 + (pos - 16)) * D;
        const float* src = z + (size_t)r * D;
        f32x4 x[8]; float ss = 0.f;
#pragma unroll
        for (int i = 0; i < 8; ++i) { x[i] = *(const f32x4*)(src + (i * 64 + lane) * 4); ss += x[i][0] * x[i][0] + x[i][1] * x[i][1] + x[i][2] * x[i][2] + x[i][3] * x[i][3]; }
#pragma unroll
        for (int o = 32; o >= 1; o >>= 1) ss += __shfl_xor(ss, o);
        const float rs = rsqrtf(ss * (1.0f / D) + 1e-6f);
#pragma unroll
        for (int i = 0; i < 8; ++i) { const int c = (i * 64 + lane) * 4; const f32x4 gg = *(const f32x4*)(g + c); f32x4 o; o[0] = x[i][0] * rs * gg[0]; o[1] = x[i][1] * rs * gg[1]; o[2] = x[i][2] * rs * gg[2]; o[3] = x[i][3] * rs * gg[3]; *(f32x4*)(dst + c) = o; }
    }
}
__device__ __forceinline__ void conv_tile(const int TID, const float* src, int ldn, int k0, int n0, int nvalid, bf16_t* dst, int ldd, int kofs, bool mapin, LAS float* tile) {
    const int tx = TID & 63, ty = TID >> 6;
    const int ncl = (n0 + tx < nvalid) ? n0 + tx : nvalid - 1;
#pragma unroll
    for (int i = 0; i < 8; ++i) { const int k = ty + 8 * i; tile[k * 65 + tx] = src[(size_t)(k0 + k) * ldn + ncl]; }
    __syncthreads();
#pragma unroll
    for (int i = 0; i < 8; ++i) { const int nn = ty + 8 * i; int n = n0 + nn;
        if (n < nvalid) { if (mapin) n = (n < 2560) ? n : (n < 2592 ? n + (C_GLR - 2560) : n - 32); dst[(size_t)n * ldd + kofs + k0 + tx] = f2bf(tile[tx * 65 + nn]); } }
    __syncthreads();
}
__device__ __forceinline__ void convert_weights(const int TID, const int BID, const Params& p, int l, LAS float* tile) {
    const int G = gridDim.x, b = BID;
    bf16_t* btin = (bf16_t*)(p.ws + WS_BTIN); bf16_t* btout = (bf16_t*)(p.ws + WS_BTOUT); bf16_t* bto = (bf16_t*)(p.ws + WS_BTO); bf16_t* btglu = (bf16_t*)(p.ws + WS_BTGLU); bf16_t* btlru = (bf16_t*)(p.ws + WS_BTLRU);
    { const float* src = p.in[4] + (size_t)l * D * NIN; const int tx = TID & 63, ty = TID >> 6; float v[8];
      { const int t = b < 32 * 169 ? b : 0; const int kt = t / 169, ntl = t - kt * 169; const int ncl = (ntl * 64 + tx < NIN) ? ntl * 64 + tx : NIN - 1;
#pragma unroll
        for (int i = 0; i < 8; ++i) v[i] = src[(size_t)(kt * 64 + ty + 8 * i) * NIN + ncl]; }
      for (int t = b; t < 32 * 169; t += G) { const int kt = t / 169, ntl = t - kt * 169, k0 = kt * 64, n0 = ntl * 64;
#pragma unroll
          for (int i = 0; i < 8; ++i) tile[(ty + 8 * i) * 65 + tx] = v[i];
          { const int tn = (t + G < 32 * 169) ? t + G : t; const int ktn = tn / 169, ntn = tn - ktn * 169; const int ncl = (ntn * 64 + tx < NIN) ? ntn * 64 + tx : NIN - 1;
#pragma unroll
            for (int i = 0; i < 8; ++i) v[i] = src[(size_t)(ktn * 64 + ty + 8 * i) * NIN + ncl]; }
          LBAR();
#pragma unroll
          for (int i = 0; i < 8; ++i) { const int nn = ty + 8 * i; int n = n0 + nn;
              if (n < NIN) { n = (n < 2560) ? n : (n < 2592 ? n + (C_GLR - 2560) : n - 32); btin[(size_t)n * D + k0 + tx] = f2bf(tile[tx * 65 + nn]); } }
          LBAR(); } }
    for (size_t i = (size_t)b * 512 + TID; i < (size_t)(NINP - NIN) * D / 8; i += (size_t)G * 512) *(u32x4*)(btin + (size_t)NIN * D + i * 8) = (u32x4){0u, 0u, 0u, 0u};
    { const float* src = p.in[25] + (size_t)l * 512 * D; for (int t = (b + 64) % G; t < 8 * 32; t += G) { const int kt = t / 32, ntl = t - kt * 32; conv_tile(TID, src, D, kt * 64, ntl * 64, D, btout, D, 0, false, tile); } }
    { const float* src = p.in[26] + (size_t)l * 512 * D; for (int t = (b + 128) % G; t < 8 * 32; t += G) { const int kt = t / 32, ntl = t - kt * 32; conv_tile(TID, src, D, kt * 64, ntl * 64, D, btout, D, 512, false, tile); } }
    { const float* src = p.in[27] + (size_t)l * 1024 * D; for (int t = b; t < 16 * 32; t += G) { const int kt = t / 32, ntl = t - kt * 32; conv_tile(TID, src, D, kt * 64, ntl * 64, D, btout, D, 1024, false, tile); } }
    { const float* src = p.in[28] + (size_t)l * D * D; for (int t = b; t < 32 * 32; t += G) { const int kt = t / 32, ntl = t - kt * 32; conv_tile(TID, src, D, kt * 64, ntl * 64, D, bto, D, 0, false, tile); } }
    { const float* src = p.in[13] + (size_t)l * 512 * 512; for (int t = (b + 192) % G; t < 8 * 8; t += G) { const int kt = t / 8, ntl = t - kt * 8; conv_tile(TID, src, 512, kt * 64, ntl * 64, 512, btglu, 512, 0, false, tile); } }
    for (int t = (b + 32) % G; t < 128; t += G) { const int mat = t >> 2, sub = t & 3;
        const int dk = mat >> 3, nb = mat & 7, d = dk >> 1, kind = dk & 1;
        const float* src = p.in[kind ? 22 : 20] + ((size_t)(l * 2 + d) * 8 + nb) * 128 * 128;
        conv_tile(TID, src, 128, (sub >> 1) * 64, (sub & 1) * 64, 128, btlru + (size_t)mat * 128 * 128, 128, 0, false, tile); }
}
__device__ __forceinline__ double exp_small(double x) { double s = 1.0, t = 1.0; for (int i = 1; i <= 14; ++i) { t *= x / (double)i; s += t; } return s; }
__device__ __forceinline__ double exp_neg(double x) { double e = exp_small(x * (1.0 / 64.0)); for (int i = 0; i < 6; ++i) e *= e; return e; }
__device__ __forceinline__ void s5_tables_all(const int TID, const int BID, const Params& p) {
    for (int vidx = (int)(gridDim.x - 1 - BID) * 512 + TID; vidx < 4 * 4096; vidx += gridDim.x * 512) {
        const int l = vidx >> 12, idx = vidx & 4095;
        f32x2* pw = (f32x2*)(p.ws + WS_PW) + l * PWL; f32x2* bbar = (f32x2*)(p.ws + WS_BBAR) + l * BBL;
        const int g = idx >> 7, d = (idx >> 6) & 1, n = idx & 63;
        const double dt = exp_neg((double)p.in[7][(l * 2 + d) * 32 + g]);
        const double lr = (double)p.in[5][((size_t)(l * 2 + d) * 32 + g) * 64 + n], li = (double)p.in[6][((size_t)(l * 2 + d) * 32 + g) * 64 + n];
        const double mag = exp_neg(lr * dt);
        double ang = li * dt; const double twopi = 6.283185307179586476925287; ang -= twopi * rint(ang / twopi);
        const double a8 = ang * 0.125, a2 = a8 * a8;
        double sn = a8, cs = 1.0, ts = a8, tc = 1.0;
        for (int i = 1; i <= 9; ++i) { tc *= -a2 / (double)((2 * i - 1) * (2 * i)); cs += tc; ts *= -a2 / (double)((2 * i) * (2 * i + 1)); sn += ts; }
        for (int i = 0; i < 3; ++i) { const double c2 = cs * cs - sn * sn, s2 = 2.0 * cs * sn; cs = c2; sn = s2; }
        const double abr = mag * cs, abi = mag * sn;
        double pr = 1.0, pi = 0.0;
        for (int j = 0; j <= 16; ++j) { pw[((size_t)(g * 2 + d) * 17 + j) * 64 + n] = (f32x2){(float)pr, (float)pi}; const double nr = pr * abr - pi * abi, ni = pr * abi + pi * abr; pr = nr; pi = ni; }
        const double den = lr * lr + li * li, fr = ((abr - 1.0) * lr + abi * li) / den, fi = (abi * lr - (abr - 1.0) * li) / den;
        float brf[16], bif[16];
#pragma unroll
        for (int c4 = 0; c4 < 4; ++c4) { const f32x4 t0 = *(const f32x4*)(p.in[8] + (((size_t)l * 32 + g) * 64 + n) * 16 + c4 * 4), t1 = *(const f32x4*)(p.in[9] + (((size_t)l * 32 + g) * 64 + n) * 16 + c4 * 4);
#pragma unroll
            for (int e = 0; e < 4; ++e) { brf[c4 * 4 + e] = t0[e]; bif[c4 * 4 + e] = t1[e]; } }
#pragma unroll
        for (int c = 0; c < 16; ++c) { const double br = (double)brf[c], bi = (double)bif[c];
            bbar[((size_t)(g * 2 + d) * 64 + n) * 16 + c] = (f32x2){(float)(fr * br - fi * bi), (float)(fr * bi + fi * br)}; }
    }
}
__device__ __forceinline__ float s5_kval(const float* cre, const float* cim, const f32x2* pw, const f32x2* bbar, int l, int g, int d, int j, int c, int cp) {
    const float* cr = cre + (((size_t)(l * 2 + d) * 32 + g) * 16 + c) * 64; const float* ci = cim + (((size_t)(l * 2 + d) * 32 + g) * 16 + c) * 64;
    const f32x2* pp = pw + ((size_t)(g * 2 + d) * 17 + j) * 64; const f32x2* bb = bbar + ((size_t)(g * 2 + d) * 64) * 16 + cp;
    float s = 0.f;
#pragma unroll 16
    for (int n = 0; n < 64; ++n) { const f32x2 pv = pp[n]; const f32x2 bv = bb[(size_t)n * 16]; const float er = cr[n] * pv.x - ci[n] * pv.y, ei = cr[n] * pv.y + ci[n] * pv.x; s += er * bv.x - ei * bv.y; }
    return s;
}
__device__ __forceinline__ void s5_assemble_a(const int TID, const int BID, const Params& p, int l) {
    const f32x2* pw = (const f32x2*)(p.ws + WS_PW) + l * PWL; const f32x2* bbar = (const f32x2*)(p.ws + WS_BBAR) + l * BBL;
    float* kmat = (float*)(p.ws + WS_KMAT); bf16_t* pmat = (bf16_t*)(p.ws + WS_PMAT);
    const float* cre = p.in[10]; const float* cim = p.in[11];
    const size_t stride = (size_t)gridDim.x * 512;
    for (size_t idx = (size_t)BID * 512 + TID; idx < (size_t)32 * 2 * 16 * 256; idx += stride) {
        const int g = (int)(idx >> 13), d = (int)(idx >> 12) & 1, j = (int)(idx >> 8) & 15, c = (int)(idx >> 4) & 15, cp = (int)idx & 15;
        kmat[idx] = s5_kval(cre, cim, pw, bbar, l, g, d, j, c, cp);
    }
    for (size_t idx = (size_t)BID * 512 + TID; idx < (size_t)32 * 256 * 256; idx += stride) {
        const int g = (int)(idx >> 16), nout = (int)(idx >> 8) & 255, k = (int)idx & 255, d = nout >> 7, ri = (nout >> 6) & 1, n = nout & 63, s = k >> 4, cp = k & 15, j = d == 0 ? 15 - s : s;
        const f32x2 pv = pw[((size_t)(g * 2 + d) * 17 + j) * 64 + n]; const f32x2 bv = bbar[((size_t)(g * 2 + d) * 64 + n) * 16 + cp];
        pmat[idx] = f2bf(ri == 0 ? pv.x * bv.x - pv.y * bv.y : pv.x * bv.y + pv.y * bv.x);
    }
}
__device__ __forceinline__ void s5_assemble_w(const int TID, const int BID, const Params& p, int l) {
    const f32x2* pw = (const f32x2*)(p.ws + WS_PW) + l * PWL; const float* kmat = (const float*)(p.ws + WS_KMAT);
    bf16_t* wmat = (bf16_t*)(p.ws + WS_WMAT);
    const float* cre = p.in[10]; const float* cim = p.in[11];
    const size_t stride = (size_t)gridDim.x * 512;
    for (size_t idx = (size_t)BID * 512 + TID; idx < (size_t)32 * 256 * 512; idx += stride) {
        const int g = (int)(idx >> 17), nout = (int)(idx >> 9) & 255, k = (int)idx & 511, t = nout >> 4, c = nout & 15;
        float val;
        if (k < 256) { const int s = k >> 4, cp = k & 15; val = 0.f;
            const int jf = s <= t ? t - s : 0, jb = s >= t ? s - t : 0;
            const float kf = kmat[((((size_t)g * 2 + 0) * 16 + jf) * 16 + c) * 16 + cp], kb = kmat[((((size_t)g * 2 + 1) * 16 + jb) * 16 + c) * 16 + cp], dsk = p.in[12][l * 512 + g * 16 + c];
            val = (s <= t ? kf : 0.f) + (s >= t ? kb : 0.f) + ((s == t && c == cp) ? dsk : 0.f);
        } else { const int kk = k - 256, d = kk >> 7, ri = (kk >> 6) & 1, n = kk & 63, j = d == 0 ? t + 1 : 16 - t;
            const float cr = cre[(((size_t)(l * 2 + d) * 32 + g) * 16 + c) * 64 + n], ci = cim[(((size_t)(l * 2 + d) * 32 + g) * 16 + c) * 64 + n];
            const f32x2 pv = pw[((size_t)(g * 2 + d) * 17 + j) * 64 + n];
            val = ri == 0 ? cr * pv.x - ci * pv.y : -(cr * pv.y + ci * pv.x); }
        wmat[idx] = f2bf(val);
    }
}

__device__ __forceinline__ void scans_phase(const int TID, const int BID, const Params& p, const int l, const bool do_gla) {
    const int G = gridDim.x;
    const bool split = (G == 256);
    {
        const f32x2* pw = (const f32x2*)(p.ws + WS_PW) + l * PWL; const float* st = (const float*)(p.ws + WS_ST); bf16_t* ub = (bf16_t*)(p.ws + WS_UBUF);
        for (int idx = BID * 512 + TID; idx < 40960; idx += G * 512) {
            const int seq = idx >> 12, rem = idx & 4095, g = rem >> 7, d = (rem >> 6) & 1, n = rem & 63;
            const int ch0 = seq < 2 ? seq * 257 : 514 + (seq - 2) * 129, nc = seq < 2 ? 257 : 129;
            const f32x2 a16 = pw[((size_t)(g * 2 + d) * 17 + 16) * 64 + n];
            float sr = 0.f, si = 0.f;
            for (int s0 = 0; s0 < nc; s0 += 32) {
                float lr[32], li[32];
#pragma unroll
                for (int i = 0; i < 32; ++i) { const int step = s0 + i; lr[i] = 0.f; li[i] = 0.f;
                    { const int sc = step < nc ? step : nc - 1; const int c = d == 0 ? sc : nc - 1 - sc; const size_t row = (size_t)g * CHP + ch0 + c; lr[i] = st[row * 256 + d * 128 + n]; li[i] = st[row * 256 + d * 128 + 64 + n]; } }
#pragma unroll
                for (int i = 0; i < 32; ++i) { const int step = s0 + i;
                    if (step < nc) { const int c = d == 0 ? step : nc - 1 - step; const size_t row = (size_t)g * CHP + ch0 + c;
                        ub[row * 512 + 256 + d * 128 + n] = f2bf(sr); ub[row * 512 + 256 + d * 128 + 64 + n] = f2bf(si);
                        const float nr = a16.x * sr - a16.y * si + lr[i], ni = a16.x * si + a16.y * sr + li[i]; sr = nr; si = ni; } }
            }
        }
    }
    {
        const float* la = (const float*)(p.ws + WS_LRUA); const float* lh = (const float*)(p.ws + WS_LRUH); float* lc = (float*)(p.ws + WS_LRUC);
        const int vb0 = split ? BID - 80 : BID, vstride = split ? 1 << 20 : G;
        for (int vb = vb0; vb >= 0 && vb < 40; vb += vstride) {
            const int idx = vb * 512 + TID;
            const int seq = idx >> 11, d = (idx >> 10) & 1, ch = idx & 1023;
            const int cb = seq < 2 ? seq * 65 : 130 + (seq - 2) * 33, nc = seq < 2 ? 65 : 33;
            float cin = 0.f;
            for (int s0 = 0; s0 < nc; s0 += 16) {
                float A[16], H[16];
#pragma unroll
                for (int i = 0; i < 16; ++i) { const int step = s0 + i; A[i] = 1.f; H[i] = 0.f;
                    { const int sc = step < nc ? step : nc - 1; const int ci = cb + (d == 0 ? sc : nc - 1 - sc); const size_t o = ((size_t)ci * 2 + d) * 1024 + ch; A[i] = la[o]; H[i] = lh[o]; } }
#pragma unroll
                for (int i = 0; i < 16; ++i) { const int step = s0 + i;
                    if (step < nc) { const int ci = cb + (d == 0 ? step : nc - 1 - step); const size_t o = ((size_t)ci * 2 + d) * 1024 + ch; lc[o] = cin; cin = A[i] * cin + H[i]; } }
            }
        }
    }
    if (do_gla) {
        float* ds = (float*)(p.ws + WS_DS); const float* dec = (const float*)(p.ws + WS_DECAY);
        for (int it = 0; ; ++it) {
            int vb;
            if (split) { if (BID >= 120) { if (it >= 8) break; vb = (BID - 120) + 136 * it; } else { vb = 1088 + BID + 120 * it; if (vb >= 1280) break; } }
            else { vb = BID + G * it; if (vb >= 1280) break; }
            const int e = vb * 512 + TID;
            const int seq = e >> 16, rem = e & 65535, head = rem >> 14, d = (rem >> 13) & 1, el = rem & 8191, kk = el & 63;
            const int cb = seq < 2 ? seq * 65 : 130 + (seq - 2) * 33, nc = seq < 2 ? 65 : 33;
            float S = 0.f;
            for (int s0 = 0; s0 < nc; s0 += 16) {
                float tm[16], dc[16];
#pragma unroll
                for (int i = 0; i < 16; ++i) { const int step = s0 + i; tm[i] = 0.f; dc[i] = 1.f;
                    { const int sc = step < nc ? step : nc - 1; const int ci = cb + (d == 0 ? sc : nc - 1 - sc); const size_t o = ((size_t)(ci * 4 + head) * 2 + d); tm[i] = ds[o * 8192 + el]; dc[i] = dec[o * 64 + kk]; } }
#pragma unroll
                for (int i = 0; i < 16; ++i) { const int step = s0 + i;
                    if (step < nc) { const int ci = cb + (d == 0 ? step : nc - 1 - step); const size_t o = ((size_t)(ci * 4 + head) * 2 + d); ds[o * 8192 + el] = S; S = dc[i] * S + tm[i]; } }
            }
        }
    }
}

__device__ __forceinline__ f32x4 mma_lds(f32x4 acc, const LAS bf16_t* A, const LAS bf16_t* B, int ld, int nks, int lane) {
    const LAS bf16_t* ap = A + (lane & 15) * ld + (lane >> 4) * 8; const LAS bf16_t* bp = B + (lane & 15) * ld + (lane >> 4) * 8;
    for (int ks = 0; ks < nks; ++ks) acc = __builtin_amdgcn_mfma_f32_16x16x32_bf16(*(const LAS bf16x8*)(ap + ks * 32), *(const LAS bf16x8*)(bp + ks * 32), acc, 0, 0, 0);
    return acc;
}
constexpr int GL_GLR = 0, GL_BF = 16384, GL_BB = 32768, GL_OS = 0, GL_QE0 = 49152, GL_QE1 = 58368, GL_KE0 = 67584, GL_KE1 = 76800, GL_VT = 86016, GL_ATT = 104448, GL_SP0 = 113664, GL_SP1 = 132096;
constexpr int GLD = 72;
template <int MODE>
__device__ __forceinline__ void gla_item(const int TID, const Params& p, int l, int ci, int head, LAS unsigned char* lds, const float (&wg)[2][16], const float (&bg)[2], const float (&ngv)[16]) {
    const int tid = TID, lane = tid & 63, wid = tid >> 6;
    const bf16_t* cols = (const bf16_t*)(p.ws + WS_COLS);
    int seq, c; chunk_info(ci, seq, c);
    const int tok0 = seq_start(seq) + (c == 0 ? -48 : 16 + 64 * (c - 1));
    const int rmin = (c == 0) ? 48 : 0;
    LAS float* glr_s = (LAS float*)(lds + GL_GLR); LAS float* bfs = (LAS float*)(lds + GL_BF); LAS float* bbs = (LAS float*)(lds + GL_BB);
    u32x4 kw = (u32x4){0u, 0u, 0u, 0u}, qw = kw, vwp[2], gwp[2];
    { const int r = tid >> 3, k8 = (tid & 7) * 8; const int rc = r >= rmin ? r : rmin; const bf16_t* rowp = cols + (size_t)(tok0 + rc) * NINP;
      kw = *(const u32x4*)(rowp + C_K + head * 64 + k8); if (MODE == 1) qw = *(const u32x4*)(rowp + C_Q + head * 64 + k8);
#pragma unroll
      for (int hh = 0; hh < 2; ++hh) { vwp[hh] = *(const u32x4*)(rowp + C_V + head * 128 + ((tid & 7) + 8 * hh) * 8); if (MODE == 1) gwp[hh] = *(const u32x4*)(rowp + C_GB + head * 128 + (tid & 7) * 16 + hh * 8); } }
    { const int r = tid >> 3, j4 = (tid & 7) * 4; f32x4 v = (f32x4){0.f, 0.f, 0.f, 0.f};
      { const int rc = r >= rmin ? r : rmin; const u32x2 w = *(const u32x2*)(cols + (size_t)(tok0 + rc) * NINP + C_GLR + j4); if (r >= rmin) { v[0] = bflo(w.x); v[1] = bfhi(w.x); v[2] = bflo(w.y); v[3] = bfhi(w.y); } }
      *(LAS f32x4*)(glr_s + r * 32 + j4) = v; }
    __syncthreads();
    { const int kk = tid & 63, rb = tid >> 6;
#pragma unroll
      for (int i = 0; i < 8; ++i) { const int r = rb + 8 * i; float x0 = bg[0], x1 = bg[1]; f32x4 gr[8];
#pragma unroll
          for (int j4 = 0; j4 < 8; ++j4) gr[j4] = *(const LAS f32x4*)(glr_s + r * 32 + j4 * 4);
#pragma unroll
          for (int j = 0; j < 16; ++j) { x0 += gr[j >> 2][j & 3] * wg[0][j]; x1 += gr[4 + (j >> 2)][j & 3] * wg[1][j]; }
          const bool ok = r >= rmin; bfs[r * 64 + kk] = ok ? logsig(x0) * 0.0625f : 0.f; bbs[r * 64 + kk] = ok ? logsig(x1) * 0.0625f : 0.f; } }
    __syncthreads();
    { const int col = tid & 127, part = tid >> 7, d = col >> 6, kk = col & 63; LAS float* bs = d ? bbs : bfs; LAS float* tot = glr_s;
      float v[16];
#pragma unroll
      for (int i = 0; i < 16; ++i) v[i] = bs[(part * 16 + i) * 64 + kk];
      if (d == 0) {
#pragma unroll
          for (int i = 1; i < 16; ++i) v[i] += v[i - 1];
          tot[part * 128 + col] = v[15]; }
      else {
#pragma unroll
          for (int i = 14; i >= 0; --i) v[i] += v[i + 1];
          tot[part * 128 + col] = v[0]; }
      __syncthreads();
      float off = 0.f;
#pragma unroll
      for (int pp = 0; pp < 4; ++pp) { const float t = tot[pp * 128 + col]; if (d == 0 ? pp < part : pp > part) off += t; }
#pragma unroll
      for (int i = 0; i < 16; ++i) bs[(part * 16 + i) * 64 + kk] = v[i] + off; }
    __syncthreads();
    LAS bf16_t* vT = (LAS bf16_t*)(lds + GL_VT);
    { const int r = tid >> 3, k8 = (tid & 7) * 8; const bool ok = r >= rmin;
      if (!ok) { kw = (u32x4){0u, 0u, 0u, 0u}; qw = kw; }
      float qv[8], kv[8];
#pragma unroll
      for (int i = 0; i < 4; ++i) { qv[2 * i] = bflo(qw[i]); qv[2 * i + 1] = bfhi(qw[i]); kv[2 * i] = bflo(kw[i]); kv[2 * i + 1] = bfhi(kw[i]); }
      if (MODE == 0) { LAS bf16_t* kd0 = (LAS bf16_t*)(lds + GL_QE0); LAS bf16_t* kd1 = (LAS bf16_t*)(lds + GL_QE1);
#pragma unroll
          for (int i = 0; i < 8; ++i) { const int kk = k8 + i; kd0[kk * GLD + r] = f2bf(kv[i] * __expf(bfs[63 * 64 + kk] - bfs[r * 64 + kk])); kd1[kk * GLD + r] = f2bf(kv[i] * __expf(bbs[kk] - bbs[r * 64 + kk])); }
      } else { LAS bf16_t* qe0 = (LAS bf16_t*)(lds + GL_QE0); LAS bf16_t* qe1 = (LAS bf16_t*)(lds + GL_QE1); LAS bf16_t* ke0 = (LAS bf16_t*)(lds + GL_KE0); LAS bf16_t* ke1 = (LAS bf16_t*)(lds + GL_KE1);
          u32x4 a, b2, c2, d2;
#pragma unroll
          for (int i = 0; i < 4; ++i) { const int kk = k8 + 2 * i; const float f0 = bfs[r * 64 + kk], f1 = bfs[r * 64 + kk + 1], g0 = bbs[r * 64 + kk], g1 = bbs[r * 64 + kk + 1];
              a[i] = cvt_pk_bf16(qv[2 * i] * 0.125f * __expf(f0), qv[2 * i + 1] * 0.125f * __expf(f1)); b2[i] = cvt_pk_bf16(qv[2 * i] * 0.125f * __expf(g0), qv[2 * i + 1] * 0.125f * __expf(g1));
              c2[i] = cvt_pk_bf16(kv[2 * i] * __expf(-f0), kv[2 * i + 1] * __expf(-f1)); d2[i] = cvt_pk_bf16(kv[2 * i] * __expf(-g0), kv[2 * i + 1] * __expf(-g1)); }
          *(LAS u32x4*)(qe0 + r * GLD + k8) = a; *(LAS u32x4*)(qe1 + r * GLD + k8) = b2; *(LAS u32x4*)(ke0 + r * GLD + k8) = c2; *(LAS u32x4*)(ke1 + r * GLD + k8) = d2; }
#pragma unroll
      for (int hh = 0; hh < 2; ++hh) { const int v8 = ((tid & 7) + 8 * hh) * 8; u32x4 vw = (u32x4){0u, 0u, 0u, 0u};
          if (ok) vw = vwp[hh];
#pragma unroll
          for (int i = 0; i < 4; ++i) { vT[(v8 + 2 * i) * GLD + r] = (bf16_t)(vw[i] & 0xffffu); vT[(v8 + 2 * i + 1) * GLD + r] = (bf16_t)(vw[i] >> 16); } }
    }
    if (MODE == 1) {
        const float* ds = (const float*)(p.ws + WS_DS); f32x4 sv[2][4];
#pragma unroll
        for (int d = 0; d < 2; ++d) { const float* src = ds + ((size_t)(ci * 4 + head) * 2 + d) * 8192;
#pragma unroll
            for (int i = 0; i < 4; ++i) sv[d][i] = *(const f32x4*)(src + (i * 512 + tid) * 4); }
#pragma unroll
        for (int d = 0; d < 2; ++d) { LAS bf16_t* sp = (LAS bf16_t*)(lds + (d ? GL_SP1 : GL_SP0));
#pragma unroll
            for (int i = 0; i < 4; ++i) { const int e = (i * 512 + tid) * 4; const f32x4 v = sv[d][i]; u32x2 w; w.x = cvt_pk_bf16(v[0], v[1]); w.y = cvt_pk_bf16(v[2], v[3]); *(LAS u32x2*)(sp + (e >> 6) * GLD + (e & 63)) = w; } }
    }
    __syncthreads();
    if (MODE == 0) {
        float* ds = (float*)(p.ws + WS_DS); float* dec = (float*)(p.ws + WS_DECAY);
        if (tid < 128) { const int d = tid >> 6, kk = tid & 63; dec[((size_t)(ci * 4 + head) * 2 + d) * 64 + kk] = __expf(d == 0 ? bfs[63 * 64 + kk] : bbs[kk]); }
#pragma unroll
        for (int d = 0; d < 2; ++d) { const LAS bf16_t* kd = (const LAS bf16_t*)(lds + (d ? GL_QE1 : GL_QE0)); float* dst = ds + ((size_t)(ci * 4 + head) * 2 + d) * 8192;
            for (int kt = 0; kt < 4; ++kt) { f32x4 acc = (f32x4){0.f, 0.f, 0.f, 0.f}; acc = mma_lds(acc, vT + wid * 16 * GLD, kd + kt * 16 * GLD, GLD, 2, lane);
#pragma unroll
                for (int j = 0; j < 4; ++j) dst[(wid * 16 + (lane >> 4) * 4 + j) * 64 + kt * 16 + (lane & 15)] = acc[j]; } }
        __syncthreads();
        return;
    }
    const LAS bf16_t* qe0 = (const LAS bf16_t*)(lds + GL_QE0); const LAS bf16_t* qe1 = (const LAS bf16_t*)(lds + GL_QE1); const LAS bf16_t* ke0 = (const LAS bf16_t*)(lds + GL_KE0); const LAS bf16_t* ke1 = (const LAS bf16_t*)(lds + GL_KE1);
    LAS bf16_t* att = (LAS bf16_t*)(lds + GL_ATT);
    { const int it = wid >> 1;
#pragma unroll
      for (int t2 = 0; t2 < 2; ++t2) { const int jt = (wid & 1) * 2 + t2; f32x4 af = (f32x4){0.f, 0.f, 0.f, 0.f}, ab = af;
          af = mma_lds(af, qe0 + it * 16 * GLD, ke0 + jt * 16 * GLD, GLD, 2, lane); ab = mma_lds(ab, qe1 + it * 16 * GLD, ke1 + jt * 16 * GLD, GLD, 2, lane);
#pragma unroll
          for (int j = 0; j < 4; ++j) { const int i_ = it * 16 + (lane >> 4) * 4 + j, j_ = jt * 16 + (lane & 15); att[i_ * GLD + j_] = f2bf((j_ <= i_ ? af[j] : 0.f) + (j_ >= i_ ? ab[j] : 0.f)); } } }
    __syncthreads();
    LAS float* os = (LAS float*)(lds + GL_OS);
    { const int it = wid >> 1; const LAS bf16_t* sp0 = (const LAS bf16_t*)(lds + GL_SP0); const LAS bf16_t* sp1 = (const LAS bf16_t*)(lds + GL_SP1);
#pragma unroll
      for (int t4 = 0; t4 < 4; ++t4) { const int vt = (wid & 1) * 4 + t4; f32x4 acc = (f32x4){0.f, 0.f, 0.f, 0.f};
          acc = mma_lds(acc, att + it * 16 * GLD, vT + vt * 16 * GLD, GLD, 2, lane); acc = mma_lds(acc, qe0 + it * 16 * GLD, sp0 + vt * 16 * GLD, GLD, 2, lane); acc = mma_lds(acc, qe1 + it * 16 * GLD, sp1 + vt * 16 * GLD, GLD, 2, lane);
#pragma unroll
          for (int j = 0; j < 4; ++j) os[(it * 16 + (lane >> 4) * 4 + j) * 132 + vt * 16 + (lane & 15)] = acc[j]; } }
    __syncthreads();
    { const int r = tid >> 3, v0 = (tid & 7) * 16; float o[16]; float ss = 0.f;
#pragma unroll
      for (int i = 0; i < 16; ++i) { o[i] = os[r * 132 + v0 + i]; ss += o[i] * o[i]; }
      ss += __shfl_xor(ss, 1); ss += __shfl_xor(ss, 2); ss += __shfl_xor(ss, 4);
      const float rs = rsqrtf(ss * (1.0f / 128.0f) + 1e-6f);
      if (r >= rmin) { const size_t tok = (size_t)(tok0 + r); bf16_t* yall = (bf16_t*)(p.ws + WS_YALL);
#pragma unroll
          for (int hh = 0; hh < 2; ++hh) { const u32x4 gw = gwp[hh]; u32x4 w;
#pragma unroll
              for (int i = 0; i < 4; ++i) { const int e = hh * 8 + 2 * i; w[i] = cvt_pk_bf16(o[e] * rs * ngv[e] * silu(bflo(gw[i])), o[e + 1] * rs * ngv[e + 1] * silu(bfhi(gw[i]))); }
              *(u32x4*)(yall + tok * D + 512 + head * 128 + v0 + hh * 8) = w; } } }
    __syncthreads();
}

__device__ __forceinline__ float softplus_neg(float lam) { const float e = __expf(-lam); return lam + 0.f < -8.f ? -lam : (e < 0.02f ? e * (1.0f - e * (0.5f - e * (1.0f / 3.0f))) : __logf(1.0f + e)); }
__device__ __forceinline__ float one_minus_exp(float x) {
    return x > -0.5f ? -x * (1.0f + x * 0.5f * (1.0f + x * (1.0f / 3.0f) * (1.0f + x * 0.25f * (1.0f + x * 0.2f * (1.0f + x * (1.0f / 6.0f) * (1.0f + x * (1.0f / 7.0f))))))) : 1.0f - __expf(x);
}
template <int MODE>
__device__ __forceinline__ void lru_phase(const int TID, const int b, const int G, const Params& p, int l, LAS unsigned char* lds) {
    const int tid = TID, lane = tid & 63, wid = tid >> 6, q = lane >> 4;
    const bf16_t* cols = (const bf16_t*)(p.ws + WS_COLS);
    int it = b; if (it >= NCK * 8) return;
    const int nb = b & 7;
    LAS bf16_t* xcA = (LAS bf16_t*)lds; LAS float* xcf = (LAS float*)(lds + 17408);
    const int ch = tid & 127, rb = tid >> 7, gchc = nb * 128 + ch;
    const float w0 = p.in[18][(l * 4 + 0) * 1024 + gchc], w1 = p.in[18][(l * 4 + 1) * 1024 + gchc], w2 = p.in[18][(l * 4 + 2) * 1024 + gchc], w3 = p.in[18][(l * 4 + 3) * 1024 + gchc], cb = p.in[19][l * 1024 + gchc];
    const int chl = wid * 16 + (lane & 15), gch = nb * 128 + chl;
    float ba[2], bx[2], sp8[2];
#pragma unroll
    for (int d = 0; d < 2; ++d) { ba[d] = p.in[21][(l * 2 + d) * 1024 + gch]; bx[d] = p.in[23][(l * 2 + d) * 1024 + gch]; sp8[d] = 8.0f * softplus_neg(p.in[24][(l * 2 + d) * 1024 + gch]); }
    bf16x8 bfr[4][4];
    { const bf16_t* bt = (const bf16_t*)(p.ws + WS_BTLRU);
#pragma unroll
      for (int mat = 0; mat < 4; ++mat)
#pragma unroll
          for (int ks = 0; ks < 4; ++ks) bfr[mat][ks] = *(const bf16x8*)(bt + ((size_t)(mat * 8 + nb) * 128 + wid * 16 + (lane & 15)) * 128 + ks * 32 + q * 8); }
    bf16_t xr[19];
    { int seq, c; chunk_info(it >> 3, seq, c); const int s0 = seq_start(seq), L = seq_len(seq), pos0 = (c == 0 ? -48 : 16 + 64 * (c - 1));
      const bf16_t* xb = cols + (size_t)s0 * NINP + C_XC + gchc;
#pragma unroll
      for (int i = 0; i < 19; ++i) { const int pos = pos0 + rb * 16 - 2 + i; const int pc = pos < 0 ? 0 : (pos < L ? pos : L - 1); xr[i] = xb[(size_t)pc * NINP]; } }
    for (; it < NCK * 8; it += G) {
        const int ci = it >> 3;
        int seq, c; chunk_info(ci, seq, c);
        const int s0 = seq_start(seq);
        const int pos0 = (c == 0 ? -48 : 16 + 64 * (c - 1));
        const int rmin = (c == 0) ? 48 : 0;
        float xv[19];
        { const int L = seq_len(seq);
#pragma unroll
          for (int i = 0; i < 19; ++i) { const int pos = pos0 + rb * 16 - 2 + i; xv[i] = (pos >= 0 && pos < L) ? bf2f(xr[i]) : 0.f; } }
#pragma unroll
        for (int i = 0; i < 16; ++i) { const int r = rb * 16 + i; const float xc = (r >= rmin) ? cb + xv[i] * w0 + xv[i + 1] * w1 + xv[i + 2] * w2 + xv[i + 3] * w3 : 0.f;
            xcf[r * 132 + ch] = xc; xcA[r * 136 + ch] = f2bf(xc); }
        u32x4 gq[2]; float cin[2];
        if (MODE == 1) {
#pragma unroll
            for (int d = 0; d < 2; ++d) cin[d] = ((const float*)(p.ws + WS_LRUC))[((size_t)ci * 2 + d) * 1024 + gch];
            { const int r = tid >> 3; const int rr = r >= rmin ? r : rmin; const bf16_t* gp = cols + (size_t)(s0 + pos0 + rr) * NINP + C_GC + nb * 128 + (tid & 7) * 16;
              gq[0] = *(const u32x4*)gp; gq[1] = *(const u32x4*)(gp + 8); }
        }
        { const int itn = it + G;
          if (itn < NCK * 8) { int seqn, cn; chunk_info(itn >> 3, seqn, cn); const int s0n = seq_start(seqn), Ln = seq_len(seqn), pos0n = (cn == 0 ? -48 : 16 + 64 * (cn - 1));
              const bf16_t* xb = cols + (size_t)s0n * NINP + C_XC + gchc;
#pragma unroll
              for (int i = 0; i < 19; ++i) { const int pos = pos0n + rb * 16 - 2 + i; const int pc = pos < 0 ? 0 : (pos < Ln ? pos : Ln - 1); xr[i] = xb[(size_t)pc * NINP]; } } }
        LBAR();
        LAS bf16_t* gts = (LAS bf16_t*)(lds + 51200); LAS float* hfs = (LAS float*)(lds + 68608);
        float hsum[4][4];
#pragma unroll
        for (int d = 0; d < 2; ++d) {
            __builtin_amdgcn_sched_barrier(0);
            f32x4 acc[2][4];
#pragma unroll
            for (int rt = 0; rt < 4; ++rt) { bf16x8 afr[4];
#pragma unroll
                for (int ks = 0; ks < 4; ++ks) afr[ks] = *(const LAS bf16x8*)(xcA + (rt * 16 + (lane & 15)) * 136 + ks * 32 + q * 8);
#pragma unroll
                for (int kind = 0; kind < 2; ++kind) { f32x4 a = (f32x4){0.f, 0.f, 0.f, 0.f};
#pragma unroll
                    for (int ks = 0; ks < 4; ++ks) a = __builtin_amdgcn_mfma_f32_16x16x32_bf16(afr[ks], bfr[d * 2 + kind][ks], a, 0, 0, 0);
                    acc[kind][rt] = a; } }
            float a[4][4], bb[4][4];
#pragma unroll
            for (int rt = 0; rt < 4; ++rt)
#pragma unroll
                for (int j = 0; j < 4; ++j) { const int r = rt * 16 + q * 4 + j; const float rg = sigm(acc[0][rt][j] + ba[d]), ig = sigm(acc[1][rt][j] + bx[d]), la = -sp8[d] * rg;
                    const bool ok = r >= rmin; const float av = __expf(la), x2 = 2.0f * la; const float om = x2 > -0.25f ? -x2 * (1.0f + x2 * 0.5f * (1.0f + x2 * (1.0f / 3.0f) * (1.0f + x2 * 0.25f * (1.0f + x2 * 0.2f)))) : 1.0f - av * av;
                    a[rt][j] = ok ? av : 1.0f; bb[rt][j] = ok ? __builtin_amdgcn_sqrtf(om) * ig * xcf[r * 132 + chl] : 0.f; }
            float LA[4], LB[4];
#pragma unroll
            for (int rt = 0; rt < 4; ++rt) { float A = 1.f, B = 0.f;
#pragma unroll
                for (int jj = 0; jj < 4; ++jj) { const int j = d == 0 ? jj : 3 - jj; B = a[rt][j] * B + bb[rt][j]; A *= a[rt][j]; }
                LA[rt] = A; LB[rt] = B; }
            const size_t co = ((size_t)ci * 2 + d) * 1024 + gch;
            float h = (MODE == 1) ? cin[d] : 0.f, Atot = 1.f; float hin[4];
#pragma unroll
            for (int rr = 0; rr < 4; ++rr) { const int rt = d == 0 ? rr : 3 - rr;
#pragma unroll
                for (int qi = 0; qi < 4; ++qi) { const int qq = d == 0 ? qi : 3 - qi;
                    const float Aq = __shfl(LA[rt], (lane & 15) + 16 * qq), Bq = __shfl(LB[rt], (lane & 15) + 16 * qq);
                    if (qq == q) hin[rt] = h;
                    h = Aq * h + Bq; Atot *= Aq; } }
            if (MODE == 0) { if (q == 0) { ((float*)(p.ws + WS_LRUA))[co] = Atot; ((float*)(p.ws + WS_LRUH))[co] = h; } }
            else {
#pragma unroll
                for (int rt = 0; rt < 4; ++rt) { float hh = hin[rt];
#pragma unroll
                    for (int jj = 0; jj < 4; ++jj) { const int j = d == 0 ? jj : 3 - jj; hh = a[rt][j] * hh + bb[rt][j];
                        if (d == 0) hfs[(rt * 16 + q * 4 + j) * 132 + chl] = hh; else hsum[rt][j] = hh; } }
                if (d == 0) { *(LAS u32x4*)(gts + (tid >> 3) * 136 + (tid & 7) * 16) = gq[0]; *(LAS u32x4*)(gts + (tid >> 3) * 136 + (tid & 7) * 16 + 8) = gq[1]; } }
        }
        if (MODE == 1) { bf16_t* yall = (bf16_t*)(p.ws + WS_YALL);
            LBAR();
#pragma unroll
            for (int rt = 0; rt < 4; ++rt)
#pragma unroll
                for (int j = 0; j < 4; ++j) { const int r = rt * 16 + q * 4 + j; xcA[r * 136 + chl] = f2bf((hsum[rt][j] + hfs[r * 132 + chl]) * silu(bf2f(gts[r * 136 + chl]))); }
            LBAR();
            { const int r = tid >> 3; if (r >= rmin) { const u32x4 y0 = *(const LAS u32x4*)(xcA + r * 136 + (tid & 7) * 16), y1 = *(const LAS u32x4*)(xcA + r * 136 + (tid & 7) * 16 + 8);
                bf16_t* yp = yall + (size_t)(s0 + pos0 + r) * D + 1024 + nb * 128 + (tid & 7) * 16; *(u32x4*)yp = y0; *(u32x4*)(yp + 8) = y1; } } }
        LBAR();
    }
}


template <int WHICH>
__device__ __forceinline__ void skinny_tail(const int TID, const int b0, const Params& p) {
    const int lane = TID & 63, wid = TID >> 6, q = lane >> 4;
    if (wid >= 5) return;
    for (int b = b0; b < 256; b += (int)gridDim.x) {
    const int ct = b & 127, rt = (b >> 7) * 5 + wid;
    const int row = 24576 + rt * 16 + (lane & 15);
    const int colb = ct * 16 + (lane & 15);
    const bf16_t* cols = (const bf16_t*)(p.ws + WS_COLS);
    if (WHICH == 0) {
        const bf16_t* A = (const bf16_t*)(p.ws + WS_YALL) + (size_t)row * D + q * 8; const bf16_t* B = (const bf16_t*)(p.ws + WS_BTOUT) + (size_t)colb * D + q * 8;
        bf16_t* mbf = (bf16_t*)(p.ws + WS_H);
        f32x4 msum = (f32x4){0.f, 0.f, 0.f, 0.f};
        unsigned char gt[3][4];
#pragma unroll
        for (int br = 0; br < 3; ++br)
#pragma unroll
            for (int j = 0; j < 4; ++j) { const int cc = colb & 255; gt[br][j] = ((const unsigned char*)(cols + (size_t)(24576 + rt * 16 + q * 4 + j) * NINP + C_MG))[(br * 8 + (colb >> 8)) * 256 + ((((cc & 127) >> 5) * 4 + ((cc & 31) >> 3)) * 2 + (cc >> 7)) * 8 + (cc & 7)]; }
        float gs[3][4];
#pragma unroll
        for (int br = 0; br < 3; ++br)
#pragma unroll
            for (int j = 0; j < 4; ++j) { gs[br][j] = (float)gt[br][j] * (1.0f / 255.0f); asm volatile("" : "+v"(gs[br][j])); }
#pragma unroll
        for (int br = 0; br < 3; ++br) { const int koff = br * 512, nks = br == 2 ? 32 : 16; f32x4 acc = (f32x4){0.f, 0.f, 0.f, 0.f};
            for (int k0 = 0; k0 < nks; k0 += 8) { bf16x8 av[8], bv[8];
#pragma unroll
                for (int i = 0; i < 8; ++i) { av[i] = *(const bf16x8*)(A + koff + (k0 + i) * 32); bv[i] = *(const bf16x8*)(B + koff + (k0 + i) * 32); }
#pragma unroll
                for (int i = 0; i < 8; ++i) acc = __builtin_amdgcn_mfma_f32_16x16x32_bf16(av[i], bv[i], acc, 0, 0, 0); }
#pragma unroll
            for (int j = 0; j < 4; ++j) msum[j] += gs[br][j] * acc[j]; }
#pragma unroll
        for (int j = 0; j < 4; ++j) { const int tok = 24576 + rt * 16 + q * 4 + j; mbf[(size_t)tok * D + colb] = f2bf(msum[j]); }
    } else {
        const bf16_t* A = (const bf16_t*)(p.ws + WS_H) + (size_t)row * D + q * 8; const bf16_t* B = (const bf16_t*)(p.ws + WS_BTO) + (size_t)colb * D + q * 8;
        float* z = (float*)(p.ws + WS_Z);
        f32x4 acc = (f32x4){0.f, 0.f, 0.f, 0.f};
        for (int k0 = 0; k0 < 64; k0 += 8) { bf16x8 av[8], bv[8];
#pragma unroll
            for (int i = 0; i < 8; ++i) { av[i] = *(const bf16x8*)(A + (k0 + i) * 32); bv[i] = *(const bf16x8*)(B + (k0 + i) * 32); }
#pragma unroll
            for (int i = 0; i < 8; ++i) acc = __builtin_amdgcn_mfma_f32_16x16x32_bf16(av[i], bv[i], acc, 0, 0, 0); }
#pragma unroll
        for (int j = 0; j < 4; ++j) { const int tok = 24576 + rt * 16 + q * 4 + j; z[(size_t)tok * D + colb] += acc[j]; }
    }
    }
}

#define XB_TMO      128
#define XB_XCNT(j)  (256  + 64 * (j))
#define XB_XSUB(j)  (1280 + 64 * (j))
#define XB_XGEN(j)  (2304 + 64 * (j))
#define XB_TOP      3328
#define XB_TOPGEN   3392
#define XCD_BAR_WORDS 3456
#define XB_SPIN_CAP (1u << 18)
__device__ __forceinline__ unsigned xb_ld(unsigned* p)              { return __hip_atomic_load(p, __ATOMIC_RELAXED, __HIP_MEMORY_SCOPE_AGENT); }
__device__ __forceinline__ unsigned xb_add(unsigned* p, unsigned v) { return __hip_atomic_fetch_add(p, v, __ATOMIC_RELAXED, __HIP_MEMORY_SCOPE_AGENT); }
__device__ __forceinline__ unsigned xb_xcc_id() { return (unsigned)__builtin_amdgcn_s_getreg((3 << 11) | 20) & 0xFu; }
#define XB_SPIN(cond, bar) do { unsigned _sp = 0; while (cond) { __builtin_amdgcn_s_sleep(1); \
    if ((++_sp & 255u) == 0u) { if (xb_ld(&(bar)[XB_TMO])) break; if (_sp > XB_SPIN_CAP) { atomicAdd(&(bar)[XB_TMO], 1u); break; } } } } while (0)
struct XcdBarrier { unsigned* bar; unsigned x; volatile LAS unsigned* st; };
__device__ __forceinline__ XcdBarrier xcd_barrier_post(unsigned* bar, volatile LAS unsigned* st) {
    XcdBarrier b; b.bar = bar; b.x = xb_xcc_id(); b.st = st;
    if (threadIdx.x == 0) (void)xb_add(&bar[XB_XCNT(b.x)], 1u);
    return b;
}
__device__ __forceinline__ void xcd_barrier_complete(unsigned* bar, unsigned x, unsigned& nloc, unsigned& nx) {
    const unsigned G = gridDim.x * gridDim.y * gridDim.z;
    unsigned sum, cnt, mine, sp = 0u;
    for (;;) {
        sum = 0u; cnt = 0u; mine = 0u;
#pragma unroll
        for (unsigned j = 0; j < 16; ++j) { const unsigned c = xb_ld(&bar[XB_XCNT(j)]); sum += c; cnt += (c > 0u) ? 1u : 0u; mine = (j == x) ? c : mine; }
        if (sum == G) break;
        __builtin_amdgcn_s_sleep(1);
        if ((++sp & 255u) == 0u) { if (xb_ld(&bar[XB_TMO])) break; if (sp > XB_SPIN_CAP) { atomicAdd(&bar[XB_TMO], 1u); break; } }
    }
    nloc = mine > 0u ? mine : 1u; nx = cnt > 0u ? cnt : 1u;
}
__device__ __forceinline__ void xcd_barrier(const XcdBarrier& b) {
    asm volatile("s_waitcnt vmcnt(0)" ::: "memory");
    __syncthreads();
    if (threadIdx.x == 0) {
        unsigned* bar = b.bar;
        __builtin_amdgcn_s_waitcnt(0);
        unsigned nloc = b.st[0], nx = b.st[1];
        if (nloc == 0u) { xcd_barrier_complete(bar, b.x, nloc, nx); b.st[0] = nloc; b.st[1] = nx; }
        const unsigned old = xb_add(&bar[XB_XSUB(b.x)], 1u);
        const unsigned gen = old / nloc;
        if (old + 1u == (gen + 1u) * nloc) {
            __builtin_amdgcn_fence(__ATOMIC_RELEASE, "agent");
            asm volatile("s_waitcnt vmcnt(0)" ::: "memory");
            const unsigned og = xb_add(&bar[XB_TOP], 1u);
            const unsigned tg = og / nx;
            if (og + 1u == (tg + 1u) * nx) xb_add(&bar[XB_TOPGEN], 1u);
            else XB_SPIN(xb_ld(&bar[XB_TOPGEN]) == tg, bar);
            __builtin_amdgcn_fence(__ATOMIC_ACQUIRE, "agent");
            xb_add(&bar[XB_XGEN(b.x)], 1u);
            asm volatile("s_waitcnt vmcnt(0)" ::: "memory");
        } else {
            XB_SPIN(xb_ld(&bar[XB_XGEN(b.x)]) == gen, bar);
            __builtin_amdgcn_fence(__ATOMIC_ACQUIRE, "agent");
            asm volatile("s_waitcnt vmcnt(0)" ::: "memory");
        }
    }
    __syncthreads();
}

__global__ void __launch_bounds__(512) fwd_megakernel(Params p_in) {
    extern __shared__ __attribute__((aligned(16))) unsigned char smem[];
    LAS unsigned char* lds = (LAS unsigned char*)smem;
    cg::grid_group grid = cg::this_grid();
    const int G = gridDim.x;
    const Params& p0 = p_in;
    volatile LAS unsigned* stw = (volatile LAS unsigned*)(lds + 150528);
    if (threadIdx.x == 0) { stw[0] = 0u; stw[1] = 0u; }
    __syncthreads();
    const XcdBarrier xb = xcd_barrier_post((unsigned*)(p_in.ws + WS_BAR), stw);
    for (int ph = p0.ph_lo; ph < p0.ph_hi; ++ph) {
        const int reps_ = (ph < 32 && (ph & 7) == DUP) ? 2 : 1;
        for (int rep_ = 0; rep_ < reps_; ++rep_) {
        int TID = threadIdx.x; asm volatile("" : "+v"(TID));
        int b = blockIdx.x; asm volatile("" : "+s"(b));
        Params p = p0; { unsigned long long t_ = (unsigned long long)p.ws; asm volatile("" : "+s"(t_)); p.ws = (unsigned char*)t_; }
        const char* ws = (const char*)p.ws;
        if (ph == 32) { final_norm_phase(TID, b, p); }
        else {
            const int l = ph >> 3, k = ph & 7;
            if (k == 0 && (PHM & 1)) { rmsnorm_phase(TID, b, p, l); convert_weights(TID, b, p, l, (LAS float*)lds); if (l == 0) s5_tables_all(TID, b, p); }
            else if (k == 1 && (PHM & 2)) {
                TileOrder S; S.nM = MP / 256; S.nN = NINP / 256; S.nwg = S.nM * S.nN; S.G = G; S.c = b; S.mult = 1; S.nt0 = D / 64; S.A = ws + WS_H; S.B = ws + WS_BTIN; S.tA = (size_t)256 * D * 2; S.tB = (size_t)256 * D * 2;
                EpiIn E; E.cols = (bf16_t*)(p.ws + WS_COLS); E.ubuf = (bf16_t*)(p.ws + WS_UBUF);
                gemm_phase(TID, lds, D, D, S, E);
                s5_assemble_a(TID, b, p, l);
            } else if (k == 2 && (PHM & 4)) {
                GroupOrder S; S.G = G; S.c = b; S.nt0 = 4; S.A = ws + WS_UBUF; S.B = ws + WS_PMAT; S.gsA = (size_t)CHP * 512 * 2; S.gsB = (size_t)256 * 256 * 2; S.tA = (size_t)256 * 512 * 2;
                EpiS5State E; E.st = (float*)(p.ws + WS_ST);
                if (SUBM & 4) gemm_phase(TID, lds, 512, 256, S, E);
                __syncthreads();
                { const int head_ = ((b + 128) % G) & 3, kk_ = TID & 63; float wg_[2][16], bg_[2];
                  _Pragma("unroll") for (int d = 0; d < 2; ++d) { bg_[d] = p.in[16][(l * 2 + d) * 256 + head_ * 64 + kk_]; _Pragma("unroll") for (int j = 0; j < 16; ++j) wg_[d][j] = p.in[15][((size_t)(l * 2 + d) * 16 + j) * 256 + head_ * 64 + kk_]; }
                  float ng_[16]; _Pragma("unroll") for (int e = 0; e < 16; ++e) ng_[e] = p.in[17][l * 512 + head_ * 128 + (TID & 7) * 16 + e];
                  for (int it = (b + 128) % G; it < NCK * 4; it += G) gla_item<0>(TID, p, l, it >> 2, it & 3, lds, wg_, bg_, ng_); }
                lru_phase<0>(TID, b, G, p, l, lds);
                s5_assemble_w(TID, b, p, l);
            } else if (k == 3 && (PHM & 8)) { scans_phase(TID, b, p, l, rep_ == 0); }
            else if (k == 4 && (PHM & 16)) {
                GroupOrder S; S.G = G; S.c = b; S.nt0 = 8; S.A = ws + WS_UBUF; S.B = ws + WS_WMAT; S.gsA = (size_t)CHP * 512 * 2; S.gsB = (size_t)256 * 512 * 2; S.tA = (size_t)256 * 512 * 2;
                EpiS5Out E; E.zs5 = (bf16_t*)(p.ws + WS_ZS5);
                if (SUBM & 4) gemm_phase(TID, lds, 512, 512, S, E);
                __syncthreads();
                { const int head_ = ((b + 128) % G) & 3, kk_ = TID & 63; float wg_[2][16], bg_[2];
                  _Pragma("unroll") for (int d = 0; d < 2; ++d) { bg_[d] = p.in[16][(l * 2 + d) * 256 + head_ * 64 + kk_]; _Pragma("unroll") for (int j = 0; j < 16; ++j) wg_[d][j] = p.in[15][((size_t)(l * 2 + d) * 16 + j) * 256 + head_ * 64 + kk_]; }
                  float ng_[16]; _Pragma("unroll") for (int e = 0; e < 16; ++e) ng_[e] = p.in[17][l * 512 + head_ * 128 + (TID & 7) * 16 + e];
                  for (int it = (b + 128) % G; it < NCK * 4; it += G) gla_item<1>(TID, p, l, it >> 2, it & 3, lds, wg_, bg_, ng_); }
                lru_phase<1>(TID, b, G, p, l, lds);
            } else if (k == 5 && (PHM & 32)) {
                TileOrder S; S.nM = MP / 256; S.nN = 2; S.nwg = S.nM * S.nN; S.G = G; S.c = b; S.mult = 1; S.nt0 = 8; S.A = ws + WS_ZS5; S.B = ws + WS_BTGLU; S.tA = (size_t)256 * 512 * 2; S.tB = (size_t)256 * 512 * 2;
                EpiGlu E; E.zs5 = (const bf16_t*)(p.ws + WS_ZS5); E.cols = (const bf16_t*)(p.ws + WS_COLS); E.bglu = p.in[14] + l * 512; E.yall = (bf16_t*)(p.ws + WS_YALL);
                gemm_phase(TID, lds, 512, 512, S, E);
            } else if (k == 6 && (PHM & 64)) {
                TileOrder S; S.nM = 96; S.nN = 8; S.nwg = S.nM * S.nN; S.G = G; S.c = b; S.mult = 3; S.nt0 = 8; S.A = ws + WS_YALL; S.B = ws + WS_BTOUT; S.tA = (size_t)256 * D * 2; S.tB = (size_t)256 * D * 2;
                EpiOut E; E.cols = (const bf16_t*)(p.ws + WS_COLS); E.mbf = (bf16_t*)(p.ws + WS_H);
                gemm_phase(TID, lds, D, D, S, E);
                skinny_tail<0>(TID, b, p);
            } else if (PHM & 128) {
                TileOrder S; S.nM = 96; S.nN = 8; S.nwg = S.nM * S.nN; S.G = G; S.c = b; S.mult = 1; S.nt0 = D / 64; S.A = ws + WS_H; S.B = ws + WS_BTO; S.tA = (size_t)256 * D * 2; S.tB = (size_t)256 * D * 2;
                EpiWo E; E.z = (float*)(p.ws + WS_Z);
                gemm_phase(TID, lds, D, D, S, E);
                skinny_tail<1>(TID, b, p);
            }
        }
        }
        if (p0.use_sync && ph + 1 < p0.ph_hi) { if (ph == p0.ph_lo) grid.sync(); else xcd_barrier(xb); }
    }
}

extern "C" void kernel_launch(void* const* d_in, const int* in_sizes, int n_in, void* d_out, int out_size, void* d_ws, size_t ws_size, hipStream_t stream) {
    static int grid = 0, coop = 1;
    if (grid == 0) {
        if (n_in != 30 || ws_size < WS_END) { fprintf(stderr, "kernel_launch: unexpected n_in %d or ws_size %zu (< %zu)\n", n_in, ws_size, (size_t)WS_END); grid = -1; return; }
        int dev = 0, cus = 0, per_cu = 0;
        (void)hipGetDevice(&dev); (void)hipDeviceGetAttribute(&cus, hipDeviceAttributeMultiprocessorCount, dev);
        if (hipFuncSetAttribute((const void*)fwd_megakernel, hipFuncAttributeMaxDynamicSharedMemorySize, LDS_BYTES) != hipSuccess) { fprintf(stderr, "kernel_launch: hipFuncSetAttribute failed\n"); grid = -1; return; }
        if (hipOccupancyMaxActiveBlocksPerMultiprocessor(&per_cu, (const void*)fwd_megakernel, 512, LDS_BYTES) != hipSuccess || per_cu < 1) { fprintf(stderr, "kernel_launch: occupancy query gave %d\n", per_cu); per_cu = 1; }
        (void)hipGetLastError();
        grid = cus * 1;
    }
    if (grid < 0) return;
    Params p{};
    for (int i = 0; i < 30; ++i) p.in[i] = (const float*)d_in[i];
    p.out = (float*)d_out; p.ws = (unsigned char*)d_ws; p.pad = 0;
    (void)hipMemsetAsync((char*)d_ws + WS_BAR, 0, 3456 * 4, stream);
    if (coop) {
        p.ph_lo = 0; p.ph_hi = 33; p.use_sync = 1;
        void* args[] = {&p};
        hipError_t e = hipLaunchCooperativeKernel((const void*)fwd_megakernel, dim3(grid), dim3(512), args, LDS_BYTES, stream);
        if (e == hipSuccess) return;
        fprintf(stderr, "kernel_launch: cooperative launch failed: %s (grid %d); falling back to one launch per phase\n", hipGetErrorString(e), grid);
        (void)hipGetLastError(); coop = 0;
    }
    for (int ph = 0; ph < 33; ++ph) { p.ph_lo = ph; p.ph_hi = ph + 1; p.use_sync = 0; hipLaunchKernelGGL(fwd_megakernel, dim3(grid), dim3(512), LDS_BYTES, stream, p); }
}
```

```cpp
#include <hip/hip_runtime.h>
#include <hip/hip_cooperative_groups.h>
#include <cstdio>
namespace cg = cooperative_groups;
#define LAS __attribute__((address_space(3)))
typedef unsigned short bf16_t;
typedef short bf16x8 __attribute__((ext_vector_type(8)));
typedef float f32x4 __attribute__((ext_vector_type(4)));
typedef float f32x2 __attribute__((ext_vector_type(2)));
typedef unsigned u32x2 __attribute__((ext_vector_type(2)));
typedef unsigned u32x4 __attribute__((ext_vector_type(4)));

constexpr int D = 2048, NTOK = 24736, MP = 24832, NINP = 11008, NIN = 10784;
constexpr int NCH16 = 1546, CHP = 1792, NCK = 394;
constexpr int C_GA = 512, C_Q = 1024, C_K = 1280, C_V = 1536, C_GB = 2048, C_XC = 2560, C_GC = 3584, C_MG = 4608, C_GLR = 10752;
constexpr int LDS_BYTES = 150528 + 16;
#ifndef SYNCREP
#define SYNCREP 1
#endif
#ifndef DUP
#define DUP -1
#endif
#ifndef SUBM
#define SUBM 7
#endif
#ifndef PHM
#define PHM 255
#endif

constexpr size_t al256(size_t x) { return (x + 255) & ~(size_t)255; }
constexpr size_t WS_Z = 0;
constexpr size_t WS_H = WS_Z + al256((size_t)MP * D * 4);
constexpr size_t WS_COLS = WS_H + al256((size_t)MP * D * 2);
constexpr size_t WS_YALL = WS_COLS + al256((size_t)MP * NINP * 2);
constexpr size_t WS_ZS5 = WS_YALL + al256((size_t)MP * D * 2);
constexpr size_t WS_UBUF = WS_ZS5 + al256((size_t)MP * 512 * 2);
constexpr size_t WS_ST = WS_UBUF + al256((size_t)32 * CHP * 512 * 2);
constexpr size_t WS_DS = WS_ST + al256((size_t)32 * CHP * 256 * 4);
constexpr size_t WS_M32 = WS_UBUF;
constexpr size_t WS_DECAY = WS_DS + al256((size_t)NCK * 4 * 2 * 8192 * 4);
constexpr size_t WS_LRUA = WS_DECAY + al256((size_t)NCK * 4 * 2 * 64 * 4);
constexpr size_t WS_LRUH = WS_LRUA + al256((size_t)NCK * 2 * 1024 * 4);
constexpr size_t WS_LRUC = WS_LRUH + al256((size_t)NCK * 2 * 1024 * 4);
constexpr size_t WS_PW = WS_LRUC + al256((size_t)NCK * 2 * 1024 * 4);
constexpr size_t WS_BBAR = WS_PW + al256((size_t)4 * 32 * 2 * 17 * 64 * 8);
constexpr size_t WS_WMAT = WS_BBAR + al256((size_t)4 * 32 * 2 * 64 * 16 * 8);
constexpr size_t WS_PMAT = WS_WMAT + al256((size_t)32 * 256 * 512 * 2);
constexpr size_t WS_BTIN = WS_PMAT + al256((size_t)32 * 256 * 256 * 2);
constexpr size_t WS_BTOUT = WS_BTIN + al256((size_t)NINP * D * 2);
constexpr size_t WS_BTO = WS_BTOUT + al256((size_t)D * D * 2);
constexpr size_t WS_BTGLU = WS_BTO + al256((size_t)D * D * 2);
constexpr size_t WS_BTLRU = WS_BTGLU + al256((size_t)512 * 512 * 2);
constexpr size_t WS_KMAT = WS_BTLRU + al256((size_t)32 * 128 * 128 * 2);
constexpr size_t WS_BAR = WS_KMAT + al256((size_t)32 * 2 * 16 * 256 * 4);
constexpr size_t WS_END = WS_BAR + al256((size_t)3456 * 4);
constexpr size_t WS_GB = WS_END;
constexpr size_t WS_END2 = WS_GB + al256((size_t)NCK * 4 * 8192 * 4);
constexpr size_t PWL = (size_t)32 * 2 * 17 * 64, BBL = (size_t)32 * 2 * 64 * 16;
static_assert(WS_END2 <= (size_t)1413480448, "workspace too large");
static_assert((size_t)MP * D * 4 <= WS_DECAY - WS_UBUF, "m32 alias too small");

struct Params { const float* in[30]; float* out; unsigned char* ws; int ph_lo, ph_hi, use_sync, pad; };

#define LBAR() do { asm volatile("s_waitcnt lgkmcnt(0)" ::: "memory"); __builtin_amdgcn_s_barrier(); asm volatile("" ::: "memory"); } while (0)
__device__ __forceinline__ unsigned cvt_pk_bf16(float lo, float hi) { unsigned r; asm volatile("v_cvt_pk_bf16_f32 %0, %1, %2" : "=v"(r) : "v"(lo), "v"(hi)); return r; }
__device__ __forceinline__ bf16_t f2bf(float f) { return (bf16_t)(cvt_pk_bf16(f, 0.f) & 0xffffu); }
__device__ __forceinline__ float bf2f(bf16_t b) { return __uint_as_float(((unsigned)b) << 16); }
__device__ __forceinline__ float bflo(unsigned w) { return __uint_as_float(w << 16); }
__device__ __forceinline__ float bfhi(unsigned w) { return __uint_as_float(w & 0xffff0000u); }
__device__ __forceinline__ float sigm(float x) { return __builtin_amdgcn_rcpf(1.0f + __expf(-x)); }
__device__ __forceinline__ float silu(float x) { return x * sigm(x); }
__device__ __forceinline__ float gelu_t(float x) { const float u = 0.7978845608028654f * (x + 0.044715f * x * x * x); return x * sigm(2.0f * u); }
__device__ __forceinline__ float logsig(float x) { return -(fmaxf(-x, 0.f) + __logf(1.0f + __expf(-fabsf(x)))); }

__device__ __forceinline__ int seq_start(int s) { return s < 2 ? s * 4112 : 8224 + (s - 2) * 2064; }
__device__ __forceinline__ int seq_len(int s) { return s < 2 ? 4112 : 2064; }
__device__ __forceinline__ void chunk_info(int ci, int& seq, int& c) { if (ci < 130) { seq = ci / 65; c = ci - seq * 65; } else { const int t = ci - 130; const int q = t / 33; seq = 2 + q; c = t - q * 33; } }

constexpr int BM = 256, BK = 64, HALF = 128, HTB = HALF * BK * 2, STAGE_BYTES = 8 * HTB, NXCD = 8, WGM = 8;
__device__ __forceinline__ int lds_byte(int r, int c) { const int st = (r >> 4) * 2 + (c >> 5), rr = r & 15, cc = c & 31, ob = rr * 64 + cc * 2; return st * 1024 + (ob ^ (((ob >> 9) & 1) << 5)); }
__device__ __forceinline__ void stage_rc(int b, int& R, int& C) { const int st = b / 1024, sb = b % 1024, swz = sb ^ (((sb >> 9) & 1) << 5); R = (st >> 1) * 16 + swz / 64; C = (st & 1) * 32 + (swz % 64) / 2; }

struct Unit { int pm, pn, sub, nt; const char* a; const char* b; };

struct TileOrder {
    int nM, nN, nwg, G, c, mult, nt0; const char* A; const char* B; size_t tA, tB;
    __device__ __forceinline__ bool next(int i, Unit& u) const {
        const int ti = i / mult, sub = i - ti * mult;
        const long L = (long)ti * G + c; if (L >= nwg) return false;
        int wgid = (int)L; { const int q = nwg / NXCD, r = nwg % NXCD, xcd = wgid % NXCD, off = wgid / NXCD; wgid = (xcd < r ? xcd * (q + 1) : r * (q + 1) + (xcd - r) * q) + off; }
        const int nig = WGM * nN, gid = wgid / nig, fm = gid * WGM, gsz = (nM - fm) < WGM ? (nM - fm) : WGM;
        u.pm = fm + ((wgid % nig) % gsz); u.pn = (wgid % nig) / gsz; u.sub = sub;
        const int koff = (mult == 3) ? sub * 512 : 0; u.nt = (mult == 3) ? (sub == 2 ? 16 : 8) : nt0;
        u.a = A + (size_t)u.pm * tA + (size_t)koff * 2; u.b = B + (size_t)u.pn * tB + (size_t)koff * 2; return true;
    }
};
struct GroupOrder {
    int G, c, nt0; const char* A; const char* B; size_t gsA, gsB, tA;
    __device__ __forceinline__ bool next(int i, Unit& u) const {
        const int L = i * G + c; if (L >= 224) return false;
        const int g = L / 7, pm = L - g * 7; u.pm = pm; u.pn = 0; u.sub = g; u.nt = nt0;
        u.a = A + (size_t)g * gsA + (size_t)pm * tA; u.b = B + (size_t)g * gsB; return true;
    }
};

__device__ __forceinline__ int perm32(int rho) { const int n = rho >> 4, i = rho & 15; return 8 * (i >> 2) + 4 * n + (i & 3); }
template <class Epi, class Sched>
__device__ __forceinline__ void gemm_phase(const int TID, LAS unsigned char* lds, const int lda, const int ldb, const Sched& S, const Epi& E) {
    const int tid = TID, wid = __builtin_amdgcn_readfirstlane(tid >> 6), lane = tid & 63, wr = wid >> 2, wc = wid & 3, fr = lane & 15, fq = lane >> 4;
    unsigned voffA[2], voffB[2];
#pragma unroll
    for (int i = 0; i < 2; ++i) { int R, C; stage_rc(tid * 16 + i * 8192, R, C); const int Rb = Epi::PERM ? ((R & ~31) + perm32(R & 31)) : R; voffA[i] = (unsigned)(R * lda + C) * 2u; voffB[i] = (unsigned)(Rb * ldb + C) * 2u; }
    const size_t kstep = (size_t)(BK * 2);
    const size_t hA = (size_t)HALF * lda * 2, hB = (size_t)HALF * ldb * 2;
    const unsigned ldsw = (unsigned)wid * 1024u;
    const int aoff = lds_byte(wr * 64 + fr, fq * 8), boff = lds_byte(wc * 32 + fr, fq * 8);
#define PG8_SA(b, h) (((b) * 2 + (h)) * HTB)
#define PG8_SB(b, h) ((4 + (b) * 2 + (h)) * HTB)
#define PG8_STAGE(bufoff, gbase, voff) do { _Pragma("unroll") for (int _i = 0; _i < 2; ++_i) \
        __builtin_amdgcn_global_load_lds((const unsigned*)((const char*)(gbase) + (voff)[_i]), (LAS unsigned*)(lds + (bufoff) + ldsw + _i * 8192), 16, 0, 0); } while (0)
#define PG8_LDA(dst, b, h) do { _Pragma("unroll") for (int m = 0; m < 4; ++m) _Pragma("unroll") for (int k = 0; k < 2; ++k) dst[m][k] = *(const LAS bf16x8*)(lds + PG8_SA(b, h) + aoff + m * 2048 + k * 1024); } while (0)
#define PG8_LDB(dst, b, h) do { _Pragma("unroll") for (int n = 0; n < 2; ++n) _Pragma("unroll") for (int k = 0; k < 2; ++k) dst[n][k] = *(const LAS bf16x8*)(lds + PG8_SB(b, h) + boff + n * 2048 + k * 1024); } while (0)
#define PG8_MMA(ai, bj, At, Bt) do { __builtin_amdgcn_s_setprio(1); _Pragma("unroll") for (int m = 0; m < 4; ++m) _Pragma("unroll") for (int n = 0; n < 2; ++n) _Pragma("unroll") for (int k = 0; k < 2; ++k) \
        acc[ai][bj][m][n] = __builtin_amdgcn_mfma_f32_16x16x32_bf16(Bt[n][k], At[m][k], acc[ai][bj][m][n], 0, 0, 0); __builtin_amdgcn_s_setprio(0); } while (0)
#define PG8_WAIT_V(n) asm volatile("s_waitcnt vmcnt(" #n ")" ::: "memory")
#define PG8_WAIT_L(n) asm volatile("s_waitcnt lgkmcnt(" #n ")" ::: "memory")
#define PG8_BAR __builtin_amdgcn_s_barrier()
#define PG8_SCHED __builtin_amdgcn_sched_barrier(0)
    Unit cur, nxt; int ui = 0;
    if (!S.next(0, cur)) return;
    f32x4 acc[2][2][4][2];
#pragma unroll
    for (int a = 0; a < 2; ++a)
#pragma unroll
        for (int b = 0; b < 2; ++b)
#pragma unroll
            for (int m = 0; m < 4; ++m)
#pragma unroll
                for (int n = 0; n < 2; ++n) acc[a][b][m][n] = (f32x4){0.f, 0.f, 0.f, 0.f};
    bf16x8 At[4][2], B0[2][2], B1[2][2];
    const char* cA = cur.a; const char* cB = cur.b;
    PG8_STAGE(PG8_SB(0, 0), cB, voffB); PG8_STAGE(PG8_SA(0, 0), cA, voffA); PG8_STAGE(PG8_SB(0, 1), cB + hB, voffB); PG8_STAGE(PG8_SA(0, 1), cA + hA, voffA);
    if (wr == 1) PG8_BAR;
    PG8_WAIT_V(4); PG8_BAR;
    PG8_STAGE(PG8_SB(1, 0), cB + kstep, voffB); PG8_STAGE(PG8_SA(1, 0), cA + kstep, voffA); PG8_STAGE(PG8_SB(1, 1), cB + hB + kstep, voffB);
    PG8_WAIT_V(6); PG8_BAR;
    for (;;) {
        const bool has_next = S.next(ui + 1, nxt);
        const char* nA = has_next ? nxt.a : cA; const char* nB = has_next ? nxt.b : cB;
        const int nt = cur.nt;
        for (int t = 0; t < nt; t += 2) {
            const bool last = (t == nt - 2);
            const char* a1 = cA + (size_t)(t + 1) * kstep;
            const char* a2 = last ? nA : cA + (size_t)(t + 2) * kstep; const char* b2 = last ? nB : cB + (size_t)(t + 2) * kstep;
            const char* a3 = a2 + kstep; const char* b3 = b2 + kstep;
            PG8_LDB(B0, 0, 0); PG8_SCHED; PG8_LDA(At, 0, 0); PG8_STAGE(PG8_SA(1, 1), a1 + hA, voffA);
            PG8_WAIT_L(8); PG8_BAR; PG8_WAIT_L(0); PG8_MMA(0, 0, At, B0); PG8_BAR; PG8_SCHED;
            PG8_LDB(B1, 0, 1); PG8_STAGE(PG8_SB(0, 0), b2, voffB);
            PG8_BAR; PG8_WAIT_L(0); PG8_MMA(0, 1, At, B1); PG8_BAR;
            PG8_LDA(At, 0, 1); PG8_STAGE(PG8_SA(0, 0), a2, voffA);
            PG8_BAR; PG8_WAIT_L(0); PG8_MMA(1, 0, At, B0); PG8_BAR; PG8_SCHED;
            PG8_STAGE(PG8_SB(0, 1), b2 + hB, voffB);
            PG8_WAIT_V(6); PG8_BAR; PG8_MMA(1, 1, At, B1); PG8_BAR;
            PG8_LDB(B0, 1, 0); PG8_SCHED; PG8_LDA(At, 1, 0); PG8_STAGE(PG8_SA(0, 1), a2 + hA, voffA);
            PG8_WAIT_L(8); PG8_BAR; PG8_WAIT_L(0); PG8_MMA(0, 0, At, B0); PG8_BAR; PG8_SCHED;
            PG8_LDB(B1, 1, 1); PG8_STAGE(PG8_SB(1, 0), b3, voffB);
            PG8_BAR; PG8_WAIT_L(0); PG8_MMA(0, 1, At, B1); PG8_BAR;
            PG8_LDA(At, 1, 1); PG8_STAGE(PG8_SA(1, 0), a3, voffA);
            PG8_BAR; PG8_WAIT_L(0); PG8_MMA(1, 0, At, B0); PG8_BAR; PG8_SCHED;
            PG8_STAGE(PG8_SB(1, 1), b3 + hB, voffB);
            PG8_WAIT_V(6); PG8_BAR; PG8_MMA(1, 1, At, B1); PG8_BAR;
        }
        E(acc, cur, wr, wc, fr, fq);
        if (!has_next) break;
#pragma unroll
        for (int a = 0; a < 2; ++a)
#pragma unroll
            for (int b = 0; b < 2; ++b)
#pragma unroll
                for (int m = 0; m < 4; ++m)
#pragma unroll
                    for (int n = 0; n < 2; ++n) acc[a][b][m][n] = (f32x4){0.f, 0.f, 0.f, 0.f};
        cur = nxt; cA = nA; cB = nB; ++ui;
    }
    PG8_WAIT_V(0);
    if (wr == 0) PG8_BAR;
    PG8_BAR;
#undef PG8_SA
#undef PG8_SB
#undef PG8_STAGE
#undef PG8_LDA
#undef PG8_LDB
#undef PG8_MMA
#undef PG8_WAIT_V
#undef PG8_WAIT_L
#undef PG8_BAR
#undef PG8_SCHED
}

#define EPI_LOOP(...) \
    const int row0 = u.pm * BM + wr * 64 + fr, col0 = u.pn * BM + wc * 32 + 4 * fq; \
    _Pragma("unroll") for (int ai = 0; ai < 2; ++ai) _Pragma("unroll") for (int m = 0; m < 4; ++m) { const int r = row0 + ai * HALF + m * 16; \
        _Pragma("unroll") for (int bj = 0; bj < 2; ++bj) _Pragma("unroll") for (int n = 0; n < 2; ++n) { const int c = col0 + bj * HALF + n * 16; const f32x4 v = acc[ai][bj][m][n]; __VA_ARGS__ } }

#define EPI_PROWS(...) \
    const int row0 = u.pm * BM + wr * 64 + fr, col0 = u.pn * BM + wc * 32 + 8 * fq; \
    _Pragma("unroll") for (int ai = 0; ai < 2; ++ai) _Pragma("unroll") for (int m = 0; m < 4; ++m) { const int r = row0 + ai * HALF + m * 16; __VA_ARGS__ }
__device__ __forceinline__ u32x4 pack8(const f32x4 a, const f32x4 b) { u32x4 w; w[0] = cvt_pk_bf16(a[0], a[1]); w[1] = cvt_pk_bf16(a[2], a[3]); w[2] = cvt_pk_bf16(b[0], b[1]); w[3] = cvt_pk_bf16(b[2], b[3]); return w; }
__device__ __forceinline__ unsigned q8(float x) { return (unsigned)__float2uint_rn(sigm(x) * 255.0f); }
__device__ __forceinline__ unsigned q8x4(const f32x4 v) { return q8(v[0]) | (q8(v[1]) << 8) | (q8(v[2]) << 16) | (q8(v[3]) << 24); }
struct EpiIn { static constexpr bool PERM = true; bf16_t* cols; bf16_t* ubuf;
    __device__ __forceinline__ void operator()(const f32x4 (&acc)[2][2][4][2], const Unit& u, int wr, int wc, int fr, int fq) const {
        if (u.pn >= 18 && u.pn < 42) {
            EPI_PROWS({ u32x4 w; w[0] = q8x4(acc[ai][0][m][0]); w[1] = q8x4(acc[ai][0][m][1]); w[2] = q8x4(acc[ai][1][m][0]); w[3] = q8x4(acc[ai][1][m][1]);
                *(u32x4*)((unsigned char*)(cols + (size_t)r * NINP + C_MG) + (u.pn - 18) * 256 + (wc * 4 + fq) * 16) = w; })
        } else {
            EPI_PROWS({ _Pragma("unroll") for (int bj = 0; bj < 2; ++bj) { const int c = col0 + bj * HALF;
                bf16_t* dst = (u.pn < 2) ? ubuf + ((size_t)((c >> 4) * CHP + (r >> 4)) * 512 + (r & 15) * 16 + (c & 15)) : cols + (size_t)r * NINP + c;
                *(u32x4*)dst = pack8(acc[ai][bj][m][0], acc[ai][bj][m][1]); } })
        }
    } };
struct EpiS5State { static constexpr bool PERM = false; float* st;
    __device__ __forceinline__ void operator()(const f32x4 (&acc)[2][2][4][2], const Unit& u, int wr, int wc, int fr, int fq) const {
        EPI_LOOP({ *(f32x4*)(st + ((size_t)(u.sub * CHP + r)) * 256 + c) = v; })
    } };
struct EpiS5Out { static constexpr bool PERM = true; bf16_t* zs5;
    __device__ __forceinline__ void operator()(const f32x4 (&acc)[2][2][4][2], const Unit& u, int wr, int wc, int fr, int fq) const {
        EPI_PROWS({ if (r < NCH16) { _Pragma("unroll") for (int bj = 0; bj < 2; ++bj) { const int c = col0 + bj * HALF; f32x4 a = acc[ai][bj][m][0], b2 = acc[ai][bj][m][1];
            _Pragma("unroll") for (int e = 0; e < 4; ++e) { a[e] = gelu_t(a[e]); b2[e] = gelu_t(b2[e]); }
            *(u32x4*)(zs5 + (size_t)(r * 16 + (c >> 4)) * 512 + u.sub * 16 + (c & 15)) = pack8(a, b2); } } })
    } };
#define EPI_ROWS(...) \
    const int row0 = u.pm * BM + wr * 64 + fr, col0 = u.pn * BM + wc * 32 + 4 * fq; \
    _Pragma("unroll") for (int ai = 0; ai < 2; ++ai) _Pragma("unroll") for (int m = 0; m < 4; ++m) { const int r = row0 + ai * HALF + m * 16; __VA_ARGS__ }
#define QOFF(q) (((q) >> 1) * HALF + ((q) & 1) * 16)
#define EPI_PIPE(LOADF, COMPF) \
    const int row0 = u.pm * BM + wr * 64 + fr, col0 = u.pn * BM + wc * 32 + 8 * fq; \
    LOADF(0, 0); \
    _Pragma("unroll") for (int gi = 0; gi < 8; ++gi) { if (gi + 1 < 8) { if ((gi & 1) == 0) { LOADF(gi + 1, 1); } else { LOADF(gi + 1, 0); } } if ((gi & 1) == 0) { COMPF(gi, 0); } else { COMPF(gi, 1); } }
#define GROW(gi) (row0 + ((gi) >> 2) * HALF + ((gi) & 3) * 16)
struct EpiGlu { static constexpr bool PERM = true; const bf16_t* zs5; const bf16_t* cols; const float* bglu; bf16_t* yall;
    __device__ __forceinline__ void operator()(const f32x4 (&acc)[2][2][4][2], const Unit& u, int wr, int wc, int fr, int fq) const {
        u32x4 zz[2][2], gg[2][2]; f32x4 bb[2][2];
        { const int c0 = u.pn * BM + wc * 32 + 8 * fq; _Pragma("unroll") for (int bj = 0; bj < 2; ++bj) { bb[bj][0] = *(const f32x4*)(bglu + c0 + bj * HALF); bb[bj][1] = *(const f32x4*)(bglu + c0 + bj * HALF + 4); } }
#define GLU_LOAD(gi, bf) do { const int r_ = GROW(gi); _Pragma("unroll") for (int bj = 0; bj < 2; ++bj) { const int c = col0 + bj * HALF; zz[bf][bj] = *(const u32x4*)(zs5 + (size_t)r_ * 512 + c); gg[bf][bj] = *(const u32x4*)(cols + (size_t)r_ * NINP + C_GA + c); } } while (0)
#define GLU_COMP(gi, bf) do { const int r_ = GROW(gi); _Pragma("unroll") for (int bj = 0; bj < 2; ++bj) { const int c = col0 + bj * HALF; f32x4 o[2]; \
            _Pragma("unroll") for (int hf = 0; hf < 2; ++hf) { const f32x4 v = acc[(gi) >> 2][bj][(gi) & 3][hf]; \
                o[hf][0] = bflo(zz[bf][bj][2 * hf]) * sigm(v[0] + bb[bj][hf][0]) * silu(bflo(gg[bf][bj][2 * hf])); o[hf][1] = bfhi(zz[bf][bj][2 * hf]) * sigm(v[1] + bb[bj][hf][1]) * silu(bfhi(gg[bf][bj][2 * hf])); \
                o[hf][2] = bflo(zz[bf][bj][2 * hf + 1]) * sigm(v[2] + bb[bj][hf][2]) * silu(bflo(gg[bf][bj][2 * hf + 1])); o[hf][3] = bfhi(zz[bf][bj][2 * hf + 1]) * sigm(v[3] + bb[bj][hf][3]) * silu(bfhi(gg[bf][bj][2 * hf + 1])); } \
            *(u32x4*)(yall + (size_t)r_ * D + c) = pack8(o[0], o[1]); } } while (0)
        EPI_PIPE(GLU_LOAD, GLU_COMP)
#undef GLU_LOAD
#undef GLU_COMP
    } };
__device__ __forceinline__ float ub(unsigned w, int k) { return (float)((w >> (8 * k)) & 255u) * (1.0f / 255.0f); }
struct EpiOut { static constexpr bool PERM = true; const bf16_t* cols; bf16_t* mbf;
    __device__ __forceinline__ void operator()(const f32x4 (&acc)[2][2][4][2], const Unit& u, int wr, int wc, int fr, int fq) const {
        u32x4 gg[8], mm[2][2];
        { const int row0g = u.pm * BM + wr * 64 + fr;
#pragma unroll
          for (int gi = 0; gi < 8; ++gi) gg[gi] = *(const u32x4*)((const unsigned char*)(cols + (size_t)(row0g + (gi >> 2) * HALF + (gi & 3) * 16) * NINP + C_MG) + (u.sub * 8 + u.pn) * 256 + (wc * 4 + fq) * 16); }
#define OUT_LOAD(gi, bf) do { const int r_ = GROW(gi); const bf16_t* mp = mbf + (size_t)r_ * D + col0; \
            _Pragma("unroll") for (int bj = 0; bj < 2; ++bj) { mm[bf][bj] = (u32x4){0u, 0u, 0u, 0u}; if (u.sub != 0) mm[bf][bj] = *(const u32x4*)(mp + bj * HALF); } } while (0)
#define OUT_COMP(gi, bf) do { const int r_ = GROW(gi); bf16_t* mp = mbf + (size_t)r_ * D + col0; _Pragma("unroll") for (int bj = 0; bj < 2; ++bj) { f32x4 o[2]; \
            _Pragma("unroll") for (int hf = 0; hf < 2; ++hf) { const f32x4 v = acc[(gi) >> 2][bj][(gi) & 3][hf]; const unsigned gw = gg[gi][bj * 2 + hf]; \
                o[hf][0] = bflo(mm[bf][bj][2 * hf]) + ub(gw, 0) * v[0]; o[hf][1] = bfhi(mm[bf][bj][2 * hf]) + ub(gw, 1) * v[1]; \
                o[hf][2] = bflo(mm[bf][bj][2 * hf + 1]) + ub(gw, 2) * v[2]; o[hf][3] = bfhi(mm[bf][bj][2 * hf + 1]) + ub(gw, 3) * v[3]; } \
            *(u32x4*)(mp + bj * HALF) = pack8(o[0], o[1]); } } while (0)
        EPI_PIPE(OUT_LOAD, OUT_COMP)
#undef OUT_LOAD
#undef OUT_COMP
    } };
struct EpiWo { static constexpr bool PERM = false; float* z;
    __device__ __forceinline__ void operator()(const f32x4 (&acc)[2][2][4][2], const Unit& u, int wr, int wc, int fr, int fq) const {
        EPI_ROWS({ if (r < NTOK) { float* zp = z + (size_t)r * D + col0; f32x4 pv[4];
            _Pragma("unroll") for (int q = 0; q < 4; ++q) pv[q] = *(const f32x4*)(zp + QOFF(q));
            _Pragma("unroll") for (int q = 0; q < 4; ++q) *(f32x4*)(zp + QOFF(q)) = pv[q] + acc[ai][q >> 1][m][q & 1]; } })
    } };

__device__ __forceinline__ const float* src_row(const Params& p, int r) {
    int s, pos; if (r < 8224) { s = r / 4112; pos = r - s * 4112; } else { const int t = r - 8224; const int q = t / 2064; s = 2 + q; pos = t - q * 2064; }
    if (pos < 16) return p.in[2] + (size_t)pos * D;
    return s < 2 ? p.in[0] + ((size_t)s * 4096 + (pos - 16)) * D : p.in[1] + ((size_t)(s - 2) * 2048 + (pos - 16)) * D;
}
__device__ __forceinline__ void rmsnorm_phase(const int TID, const int BID, const Params& p, int l) {
    float* z = (float*)(p.ws + WS_Z); bf16_t* h = (bf16_t*)(p.ws + WS_H); const float* g = p.in[3] + (size_t)l * D;
    const int lane = TID & 63, gw = BID * 8 + (TID >> 6), nw = gridDim.x * 8;
    f32x4 gg[8];
#pragma unroll
    for (int i = 0; i < 8; ++i) gg[i] = *(const f32x4*)(g + (i * 64 + lane) * 4);
    f32x4 xn[8];
    { const int r0 = gw < NTOK ? gw : NTOK - 1; const float* src = (l == 0) ? src_row(p, r0) : z + (size_t)r0 * D;
#pragma unroll
      for (int i = 0; i < 8; ++i) xn[i] = *(const f32x4*)(src + (i * 64 + lane) * 4); }
    for (int r = gw; r < MP; r += nw) {
        bf16_t* hr = h + (size_t)r * D;
        f32x4 x[8];
#pragma unroll
        for (int i = 0; i < 8; ++i) x[i] = xn[i];
        { const int rn = (r + nw < NTOK) ? r + nw : NTOK - 1; const float* src = (l == 0) ? src_row(p, rn) : z + (size_t)rn * D;
#pragma unroll
          for (int i = 0; i < 8; ++i) xn[i] = *(const f32x4*)(src + (i * 64 + lane) * 4); }
        if (r >= NTOK) { for (int i = 0; i < 4; ++i) *(u32x4*)(hr + (i * 64 + lane) * 8) = (u32x4){0u, 0u, 0u, 0u}; continue; }
        float ss = 0.f;
#pragma unroll
        for (int i = 0; i < 8; ++i) ss += x[i][0] * x[i][0] + x[i][1] * x[i][1] + x[i][2] * x[i][2] + x[i][3] * x[i][3];
#pragma unroll
        for (int o = 32; o >= 1; o >>= 1) ss += __shfl_xor(ss, o);
        const float rs = rsqrtf(ss * (1.0f / D) + 1e-6f);
#pragma unroll
        for (int i = 0; i < 8; ++i) { const int c = (i * 64 + lane) * 4;
            if (l == 0) *(f32x4*)(z + (size_t)r * D + c) = x[i];
            u32x2 w; w.x = cvt_pk_bf16(x[i][0] * rs * gg[i][0], x[i][1] * rs * gg[i][1]); w.y = cvt_pk_bf16(x[i][2] * rs * gg[i][2], x[i][3] * rs * gg[i][3]); *(u32x2*)(hr + c) = w; }
    }
}
__device__ __forceinline__ void final_norm_phase(const int TID, const int BID, const Params& p) {
    const float* z = (const float*)(p.ws + WS_Z); const float* g = p.in[29];
    const int lane = TID & 63, gw = BID * 8 + (TID >> 6), nw = gridDim.x * 8;
    for (int r = gw; r < NTOK; r += nw) {
        int s, pos; if (r < 8224) { s = r / 4112; pos = r - s * 4112; } else { const int t = r - 8224; const int q = t / 2064; s = 2 + q; pos = t - q * 2064; }
        if (pos < 16) continue;
        float* dst = s < 2 ? p.out + ((size_t)s * 4096 + (pos - 16)) * D : p.out + (size_t)2 * 4096 * D + ((size_t)(s - 2) * 2048 + (pos - 16)) * D;
        const float* src = z + (size_t)r * D;
        f32x4 x[8]; float ss = 0.f;
#pragma unroll
        for (int i = 0; i < 8; ++i) { x[i] = *(const f32x4*)(src + (i * 64 + lane) * 4); ss += x[i][0] * x[i][0] + x[i][1] * x[i][1] + x[i][2] * x[i][2] + x[i][3] * x[i][3]; }
#pragma unroll
        for (int o = 32; o >= 1; o >>= 1) ss += __shfl_xor(ss, o);
        const float rs = rsqrtf(ss * (1.0f / D) + 1e-6f);
#pragma unroll
        for (int i = 0; i < 8; ++i) { const int c = (i * 64 + lane) * 4; const f32x4 gg = *(const f32x4*)(g + c); f32x4 o; o[0] = x[i][0] * rs * gg[0]; o[1] = x[i][1] * rs * gg[1]; o[2] = x[i][2] * rs * gg[2]; o[3] = x[i][3] * rs * gg[3]; *(f32x4*)(dst + c) = o; }
    }
}
__device__ __forceinline__ void conv_tile(const int TID, const float* src, int ldn, int k0, int n0, int nvalid, bf16_t* dst, int ldd, int kofs, bool mapin, LAS float* tile) {
    const int tx = TID & 63, ty = TID >> 6;
    const int ncl = (n0 + tx < nvalid) ? n0 + tx : nvalid - 1;
#pragma unroll
    for (int i = 0; i < 8; ++i) { const int k = ty + 8 * i; tile[k * 65 + tx] = src[(size_t)(k0 + k) * ldn + ncl]; }
    __syncthreads();
#pragma unroll
    for (int i = 0; i < 8; ++i) { const int nn = ty + 8 * i; int n = n0 + nn;
        if (n < nvalid) { if (mapin) n = (n < 2560) ? n : (n < 2592 ? n + (C_GLR - 2560) : n - 32); dst[(size_t)n * ldd + kofs + k0 + tx] = f2bf(tile[tx * 65 + nn]); } }
    __syncthreads();
}
__device__ __forceinline__ void convert_weights(const int TID, const int BID, const Params& p, int l, LAS float* tile) {
    const int G = gridDim.x, b = BID;
    bf16_t* btin = (bf16_t*)(p.ws + WS_BTIN); bf16_t* btout = (bf16_t*)(p.ws + WS_BTOUT); bf16_t* bto = (bf16_t*)(p.ws + WS_BTO); bf16_t* btglu = (bf16_t*)(p.ws + WS_BTGLU); bf16_t* btlru = (bf16_t*)(p.ws + WS_BTLRU);
    { const float* src = p.in[4] + (size_t)l * D * NIN; const int tx = TID & 63, ty = TID >> 6; float v[8];
      { const int t = b < 32 * 169 ? b : 0; const int kt = t / 169, ntl = t - kt * 169; const int ncl = (ntl * 64 + tx < NIN) ? ntl * 64 + tx : NIN - 1;
#pragma unroll
        for (int i = 0; i < 8; ++i) v[i] = src[(size_t)(kt * 64 + ty + 8 * i) * NIN + ncl]; }
      for (int t = b; t < 32 * 169; t += G) { const int kt = t / 169, ntl = t - kt * 169, k0 = kt * 64, n0 = ntl * 64;
#pragma unroll
          for (int i = 0; i < 8; ++i) tile[(ty + 8 * i) * 65 + tx] = v[i];
          { const int tn = (t + G < 32 * 169) ? t + G : t; const int ktn = tn / 169, ntn = tn - ktn * 169; const int ncl = (ntn * 64 + tx < NIN) ? ntn * 64 + tx : NIN - 1;
#pragma unroll
            for (int i = 0; i < 8; ++i) v[i] = src[(size_t)(ktn * 64 + ty + 8 * i) * NIN + ncl]; }
          LBAR();
#pragma unroll
          for (int i = 0; i < 8; ++i) { const int nn = ty + 8 * i; int n = n0 + nn;
              if (n < NIN) { n = (n < 2560) ? n : (n < 2592 ? n + (C_GLR - 2560) : n - 32); btin[(size_t)n * D + k0 + tx] = f2bf(tile[tx * 65 + nn]); } }
          LBAR(); } }
    for (size_t i = (size_t)b * 512 + TID; i < (size_t)(NINP - NIN) * D / 8; i += (size_t)G * 512) *(u32x4*)(btin + (size_t)NIN * D + i * 8) = (u32x4){0u, 0u, 0u, 0u};
    { const float* src = p.in[25] + (size_t)l * 512 * D; for (int t = (b + 64) % G; t < 8 * 32; t += G) { const int kt = t / 32, ntl = t - kt * 32; conv_tile(TID, src, D, kt * 64, ntl * 64, D, btout, D, 0, false, tile); } }
    { const float* src = p.in[26] + (size_t)l * 512 * D; for (int t = (b + 128) % G; t < 8 * 32; t += G) { const int kt = t / 32, ntl = t - kt * 32; conv_tile(TID, src, D, kt * 64, ntl * 64, D, btout, D, 512, false, tile); } }
    { const float* src = p.in[27] + (size_t)l * 1024 * D; for (int t = b; t < 16 * 32; t += G) { const int kt = t / 32, ntl = t - kt * 32; conv_tile(TID, src, D, kt * 64, ntl * 64, D, btout, D, 1024, false, tile); } }
    { const float* src = p.in[28] + (size_t)l * D * D; for (int t = b; t < 32 * 32; t += G) { const int kt = t / 32, ntl = t - kt * 32; conv_tile(TID, src, D, kt * 64, ntl * 64, D, bto, D, 0, false, tile); } }
    { const float* src = p.in[13] + (size_t)l * 512 * 512; for (int t = (b + 192) % G; t < 8 * 8; t += G) { const int kt = t / 8, ntl = t - kt * 8; conv_tile(TID, src, 512, kt * 64, ntl * 64, 512, btglu, 512, 0, false, tile); } }
    for (int t = (b + 32) % G; t < 128; t += G) { const int mat = t >> 2, sub = t & 3;
        const int dk = mat >> 3, nb = mat & 7, d = dk >> 1, kind = dk & 1;
        const float* src = p.in[kind ? 22 : 20] + ((size_t)(l * 2 + d) * 8 + nb) * 128 * 128;
        conv_tile(TID, src, 128, (sub >> 1) * 64, (sub & 1) * 64, 128, btlru + (size_t)mat * 128 * 128, 128, 0, false, tile); }
}
__device__ __forceinline__ double exp_small(double x) { double s = 1.0, t = 1.0; for (int i = 1; i <= 14; ++i) { t *= x / (double)i; s += t; } return s; }
__device__ __forceinline__ double exp_neg(double x) { double e = exp_small(x * (1.0 / 64.0)); for (int i = 0; i < 6; ++i) e *= e; return e; }
__device__ __forceinline__ void s5_tables_all(const int TID, const int BID, const Params& p) {
    for (int vidx = (int)(gridDim.x - 1 - BID) * 512 + TID; vidx < 4 * 4096; vidx += gridDim.x * 512) {
        const int l = vidx >> 12, idx = vidx & 4095;
        f32x2* pw = (f32x2*)(p.ws + WS_PW) + l * PWL; f32x2* bbar = (f32x2*)(p.ws + WS_BBAR) + l * BBL;
        const int g = idx >> 7, d = (idx >> 6) & 1, n = idx & 63;
        const double dt = exp_neg((double)p.in[7][(l * 2 + d) * 32 + g]);
        const double lr = (double)p.in[5][((size_t)(l * 2 + d) * 32 + g) * 64 + n], li = (double)p.in[6][((size_t)(l * 2 + d) * 32 + g) * 64 + n];
        const double mag = exp_neg(lr * dt);
        double ang = li * dt; const double twopi = 6.283185307179586476925287; ang -= twopi * rint(ang / twopi);
        const double a8 = ang * 0.125, a2 = a8 * a8;
        double sn = a8, cs = 1.0, ts = a8, tc = 1.0;
        for (int i = 1; i <= 9; ++i) { tc *= -a2 / (double)((2 * i - 1) * (2 * i)); cs += tc; ts *= -a2 / (double)((2 * i) * (2 * i + 1)); sn += ts; }
        for (int i = 0; i < 3; ++i) { const double c2 = cs * cs - sn * sn, s2 = 2.0 * cs * sn; cs = c2; sn = s2; }
        const double abr = mag * cs, abi = mag * sn;
        double pr = 1.0, pi = 0.0;
        for (int j = 0; j <= 16; ++j) { pw[((size_t)(g * 2 + d) * 17 + j) * 64 + n] = (f32x2){(float)pr, (float)pi}; const double nr = pr * abr - pi * abi, ni = pr * abi + pi * abr; pr = nr; pi = ni; }
        const double den = lr * lr + li * li, fr = ((abr - 1.0) * lr + abi * li) / den, fi = (abi * lr - (abr - 1.0) * li) / den;
        float brf[16], bif[16];
#pragma unroll
        for (int c4 = 0; c4 < 4; ++c4) { const f32x4 t0 = *(const f32x4*)(p.in[8] + (((size_t)l * 32 + g) * 64 + n) * 16 + c4 * 4), t1 = *(const f32x4*)(p.in[9] + (((size_t)l * 32 + g) * 64 + n) * 16 + c4 * 4);
#pragma unroll
            for (int e = 0; e < 4; ++e) { brf[c4 * 4 + e] = t0[e]; bif[c4 * 4 + e] = t1[e]; } }
#pragma unroll
        for (int c = 0; c < 16; ++c) { const double br = (double)brf[c], bi = (double)bif[c];
            bbar[((size_t)(g * 2 + d) * 64 + n) * 16 + c] = (f32x2){(float)(fr * br - fi * bi), (float)(fr * bi + fi * br)}; }
    }
}
__device__ __forceinline__ float s5_kval(const float* cre, const float* cim, const f32x2* pw, const f32x2* bbar, int l, int g, int d, int j, int c, int cp) {
    const float* cr = cre + (((size_t)(l * 2 + d) * 32 + g) * 16 + c) * 64; const float* ci = cim + (((size_t)(l * 2 + d) * 32 + g) * 16 + c) * 64;
    const f32x2* pp = pw + ((size_t)(g * 2 + d) * 17 + j) * 64; const f32x2* bb = bbar + ((size_t)(g * 2 + d) * 64) * 16 + cp;
    float s = 0.f;
#pragma unroll 16
    for (int n = 0; n < 64; ++n) { const f32x2 pv = pp[n]; const f32x2 bv = bb[(size_t)n * 16]; const float er = cr[n] * pv.x - ci[n] * pv.y, ei = cr[n] * pv.y + ci[n] * pv.x; s += er * bv.x - ei * bv.y; }
    return s;
}
__device__ __forceinline__ void s5_assemble_a(const int TID, const int BID, const Params& p, int l) {
    const f32x2* pw = (const f32x2*)(p.ws + WS_PW) + l * PWL; const f32x2* bbar = (const f32x2*)(p.ws + WS_BBAR) + l * BBL;
    float* kmat = (float*)(p.ws + WS_KMAT); bf16_t* pmat = (bf16_t*)(p.ws + WS_PMAT);
    const float* cre = p.in[10]; const float* cim = p.in[11];
    const size_t stride = (size_t)gridDim.x * 512;
    for (size_t idx = (size_t)BID * 512 + TID; idx < (size_t)32 * 2 * 16 * 256; idx += stride) {
        const int g = (int)(idx >> 13), d = (int)(idx >> 12) & 1, j = (int)(idx >> 8) & 15, c = (int)(idx >> 4) & 15, cp = (int)idx & 15;
        kmat[idx] = s5_kval(cre, cim, pw, bbar, l, g, d, j, c, cp);
    }
    for (size_t idx = (size_t)BID * 512 + TID; idx < (size_t)32 * 256 * 256; idx += stride) {
        const int g = (int)(idx >> 16), nout = (int)(idx >> 8) & 255, k = (int)idx & 255, d = nout >> 7, ri = (nout >> 6) & 1, n = nout & 63, s = k >> 4, cp = k & 15, j = d == 0 ? 15 - s : s;
        const f32x2 pv = pw[((size_t)(g * 2 + d) * 17 + j) * 64 + n]; const f32x2 bv = bbar[((size_t)(g * 2 + d) * 64 + n) * 16 + cp];
        pmat[idx] = f2bf(ri == 0 ? pv.x * bv.x - pv.y * bv.y : pv.x * bv.y + pv.y * bv.x);
    }
}
__device__ __forceinline__ void s5_assemble_w(const int TID, const int BID, const Params& p, int l) {
    const f32x2* pw = (const f32x2*)(p.ws + WS_PW) + l * PWL; const float* kmat = (const float*)(p.ws + WS_KMAT);
    bf16_t* wmat = (bf16_t*)(p.ws + WS_WMAT);
    const float* cre = p.in[10]; const float* cim = p.in[11];
    const size_t stride = (size_t)gridDim.x * 512;
    for (size_t idx = (size_t)BID * 512 + TID; idx < (size_t)32 * 256 * 512; idx += stride) {
        const int g = (int)(idx >> 17), nout = (int)(idx >> 9) & 255, k = (int)idx & 511, t = nout >> 4, c = nout & 15;
        float val;
        if (k < 256) { const int s = k >> 4, cp = k & 15; val = 0.f;
            const int jf = s <= t ? t - s : 0, jb = s >= t ? s - t : 0;
            const float kf = kmat[((((size_t)g * 2 + 0) * 16 + jf) * 16 + c) * 16 + cp], kb = kmat[((((size_t)g * 2 + 1) * 16 + jb) * 16 + c) * 16 + cp], dsk = p.in[12][l * 512 + g * 16 + c];
            val = (s <= t ? kf : 0.f) + (s >= t ? kb : 0.f) + ((s == t && c == cp) ? dsk : 0.f);
        } else { const int kk = k - 256, d = kk >> 7, ri = (kk >> 6) & 1, n = kk & 63, j = d == 0 ? t + 1 : 16 - t;
            const float cr = cre[(((size_t)(l * 2 + d) * 32 + g) * 16 + c) * 64 + n], ci = cim[(((size_t)(l * 2 + d) * 32 + g) * 16 + c) * 64 + n];
            const f32x2 pv = pw[((size_t)(g * 2 + d) * 17 + j) * 64 + n];
            val = ri == 0 ? cr * pv.x - ci * pv.y : -(cr * pv.y + ci * pv.x); }
        wmat[idx] = f2bf(val);
    }
}

__device__ __forceinline__ void scans_phase(const int TID, const int BID, const Params& p, const int l, const bool do_gla) {
    const int G = gridDim.x;
    const bool split = (G == 256);
    {
        const f32x2* pw = (const f32x2*)(p.ws + WS_PW) + l * PWL; const float* st = (const float*)(p.ws + WS_ST); bf16_t* ub = (bf16_t*)(p.ws + WS_UBUF);
        for (int idx = BID * 512 + TID; idx < 40960; idx += G * 512) {
            const int seq = idx >> 12, rem = idx & 4095, g = rem >> 7, d = (rem >> 6) & 1, n = rem & 63;
            const int ch0 = seq < 2 ? seq * 257 : 514 + (seq - 2) * 129, nc = seq < 2 ? 257 : 129;
            const f32x2 a16 = pw[((size_t)(g * 2 + d) * 17 + 16) * 64 + n];
            float sr = 0.f, si = 0.f;
            for (int s0 = 0; s0 < nc; s0 += 32) {
                float lr[32], li[32];
#pragma unroll
                for (int i = 0; i < 32; ++i) { const int step = s0 + i; lr[i] = 0.f; li[i] = 0.f;
                    { const int sc = step < nc ? step : nc - 1; const int c = d == 0 ? sc : nc - 1 - sc; const size_t row = (size_t)g * CHP + ch0 + c; lr[i] = st[row * 256 + d * 128 + n]; li[i] = st[row * 256 + d * 128 + 64 + n]; } }
#pragma unroll
                for (int i = 0; i < 32; ++i) { const int step = s0 + i;
                    if (step < nc) { const int c = d == 0 ? step : nc - 1 - step; const size_t row = (size_t)g * CHP + ch0 + c;
                        ub[row * 512 + 256 + d * 128 + n] = f2bf(sr); ub[row * 512 + 256 + d * 128 + 64 + n] = f2bf(si);
                        const float nr = a16.x * sr - a16.y * si + lr[i], ni = a16.x * si + a16.y * sr + li[i]; sr = nr; si = ni; } }
            }
        }
    }
    {
        const float* la = (const float*)(p.ws + WS_LRUA); const float* lh = (const float*)(p.ws + WS_LRUH); float* lc = (float*)(p.ws + WS_LRUC);
        const int vb0 = split ? BID - 80 : BID, vstride = split ? 1 << 20 : G;
        for (int vb = vb0; vb >= 0 && vb < 40; vb += vstride) {
            const int idx = vb * 512 + TID;
            const int seq = idx >> 11, d = (idx >> 10) & 1, ch = idx & 1023;
            const int cb = seq < 2 ? seq * 65 : 130 + (seq - 2) * 33, nc = seq < 2 ? 65 : 33;
            float cin = 0.f;
            for (int s0 = 0; s0 < nc; s0 += 16) {
                float A[16], H[16];
#pragma unroll
                for (int i = 0; i < 16; ++i) { const int step = s0 + i; A[i] = 1.f; H[i] = 0.f;
                    { const int sc = step < nc ? step : nc - 1; const int ci = cb + (d == 0 ? sc : nc - 1 - sc); const size_t o = ((size_t)ci * 2 + d) * 1024 + ch; A[i] = la[o]; H[i] = lh[o]; } }
#pragma unroll
                for (int i = 0; i < 16; ++i) { const int step = s0 + i;
                    if (step < nc) { const int ci = cb + (d == 0 ? step : nc - 1 - step); const size_t o = ((size_t)ci * 2 + d) * 1024 + ch; lc[o] = cin; cin = A[i] * cin + H[i]; } }
            }
        }
    }
    if (do_gla) {
        float* ds = (float*)(p.ws + WS_DS); const float* dec = (const float*)(p.ws + WS_DECAY);
        for (int it = 0; ; ++it) {
            int vb;
            if (split) { if (BID >= 120) { if (it >= 8) break; vb = (BID - 120) + 136 * it; } else { vb = 1088 + BID + 120 * it; if (vb >= 1280) break; } }
            else { vb = BID + G * it; if (vb >= 1280) break; }
            const int e = vb * 512 + TID;
            const int seq = e >> 16, rem = e & 65535, head = rem >> 14, d = (rem >> 13) & 1, el = rem & 8191, kk = el & 63;
            const int cb = seq < 2 ? seq * 65 : 130 + (seq - 2) * 33, nc = seq < 2 ? 65 : 33;
            float S = 0.f;
            for (int s0 = 0; s0 < nc; s0 += 16) {
                float tm[16], dc[16];
#pragma unroll
                for (int i = 0; i < 16; ++i) { const int step = s0 + i; tm[i] = 0.f; dc[i] = 1.f;
                    { const int sc = step < nc ? step : nc - 1; const int ci = cb + (d == 0 ? sc : nc - 1 - sc); const size_t o = ((size_t)(ci * 4 + head) * 2 + d); tm[i] = ds[o * 8192 + el]; dc[i] = dec[o * 64 + kk]; } }
#pragma unroll
                for (int i = 0; i < 16; ++i) { const int step = s0 + i;
                    if (step < nc) { const int ci = cb + (d == 0 ? step : nc - 1 - step); const size_t o = ((size_t)(ci * 4 + head) * 2 + d); ds[o * 8192 + el] = S; S = dc[i] * S + tm[i]; } }
            }
        }
    }
}

__device__ __forceinline__ f32x4 mma_lds(f32x4 acc, const LAS bf16_t* A, const LAS bf16_t* B, int ld, int nks, int lane) {
    const LAS bf16_t* ap = A + (lane & 15) * ld + (lane >> 4) * 8; const LAS bf16_t* bp = B + (lane & 15) * ld + (lane >> 4) * 8;
    for (int ks = 0; ks < nks; ++ks) acc = __builtin_amdgcn_mfma_f32_16x16x32_bf16(*(const LAS bf16x8*)(ap + ks * 32), *(const LAS bf16x8*)(bp + ks * 32), acc, 0, 0, 0);
    return acc;
}
constexpr int GL_GLR = 0, GL_BF = 16384, GL_BB = 32768, GL_OS = 0, GL_QE0 = 49152, GL_QE1 = 58368, GL_KE0 = 67584, GL_KE1 = 76800, GL_VT = 86016, GL_ATT = 104448, GL_SP0 = 113664, GL_SP1 = 132096;
constexpr int GLD = 72;
template <int MODE>
__device__ __forceinline__ void gla_item(const int TID, const Params& p, int l, int ci, int head, LAS unsigned char* lds, const float (&wg)[2][16], const float (&bg)[2], const float (&ngv)[16]) {
    const int tid = TID, lane = tid & 63, wid = tid >> 6;
    const bf16_t* cols = (const bf16_t*)(p.ws + WS_COLS);
    int seq, c; chunk_info(ci, seq, c);
    const int tok0 = seq_start(seq) + (c == 0 ? -48 : 16 + 64 * (c - 1));
    const int rmin = (c == 0) ? 48 : 0;
    LAS float* glr_s = (LAS float*)(lds + GL_GLR); LAS float* bfs = (LAS float*)(lds + GL_BF); LAS float* bbs = (LAS float*)(lds + GL_BB);
    f32x4 gbv[4];
    if (MODE == 1) { const float* gb = (const float*)(p.ws + WS_GB) + (size_t)(ci * 4 + head) * 8192;
#pragma unroll
      for (int i = 0; i < 4; ++i) gbv[i] = *(const f32x4*)(gb + (i * 512 + tid) * 4); }
    u32x4 kw = (u32x4){0u, 0u, 0u, 0u}, qw = kw, vwp[2], gwp[2];
    { const int r = tid >> 3, k8 = (tid & 7) * 8; const int rc = r >= rmin ? r : rmin; const bf16_t* rowp = cols + (size_t)(tok0 + rc) * NINP;
      kw = *(const u32x4*)(rowp + C_K + head * 64 + k8); if (MODE == 1) qw = *(const u32x4*)(rowp + C_Q + head * 64 + k8);
#pragma unroll
      for (int hh = 0; hh < 2; ++hh) { vwp[hh] = *(const u32x4*)(rowp + C_V + head * 128 + ((tid & 7) + 8 * hh) * 8); if (MODE == 1) gwp[hh] = *(const u32x4*)(rowp + C_GB + head * 128 + (tid & 7) * 16 + hh * 8); } }
    if (MODE == 0) {
    { const int r = tid >> 3, j4 = (tid & 7) * 4; f32x4 v = (f32x4){0.f, 0.f, 0.f, 0.f};
      { const int rc = r >= rmin ? r : rmin; const u32x2 w = *(const u32x2*)(cols + (size_t)(tok0 + rc) * NINP + C_GLR + j4); if (r >= rmin) { v[0] = bflo(w.x); v[1] = bfhi(w.x); v[2] = bflo(w.y); v[3] = bfhi(w.y); } }
      *(LAS f32x4*)(glr_s + r * 32 + j4) = v; }
    __syncthreads();
    { const int kk = tid & 63, rb = tid >> 6;
#pragma unroll
      for (int i = 0; i < 8; ++i) { const int r = rb + 8 * i; float x0 = bg[0], x1 = bg[1]; f32x4 gr[8];
#pragma unroll
          for (int j4 = 0; j4 < 8; ++j4) gr[j4] = *(const LAS f32x4*)(glr_s + r * 32 + j4 * 4);
#pragma unroll
          for (int j = 0; j < 16; ++j) { x0 += gr[j >> 2][j & 3] * wg[0][j]; x1 += gr[4 + (j >> 2)][j & 3] * wg[1][j]; }
          const bool ok = r >= rmin; bfs[r * 64 + kk] = ok ? logsig(x0) * 0.0625f : 0.f; bbs[r * 64 + kk] = ok ? logsig(x1) * 0.0625f : 0.f; } }
    __syncthreads();
    { const int col = tid & 127, part = tid >> 7, d = col >> 6, kk = col & 63; LAS float* bs = d ? bbs : bfs; LAS float* tot = glr_s;
      float v[16];
#pragma unroll
      for (int i = 0; i < 16; ++i) v[i] = bs[(part * 16 + i) * 64 + kk];
      if (d == 0) {
#pragma unroll
          for (int i = 1; i < 16; ++i) v[i] += v[i - 1];
          tot[part * 128 + col] = v[15]; }
      else {
#pragma unroll
          for (int i = 14; i >= 0; --i) v[i] += v[i + 1];
          tot[part * 128 + col] = v[0]; }
      __syncthreads();
      float off = 0.f;
#pragma unroll
      for (int pp = 0; pp < 4; ++pp) { const float t = tot[pp * 128 + col]; if (d == 0 ? pp < part : pp > part) off += t; }
#pragma unroll
      for (int i = 0; i < 16; ++i) bs[(part * 16 + i) * 64 + kk] = v[i] + off; }
    __syncthreads();
    { float* gb = (float*)(p.ws + WS_GB) + (size_t)(ci * 4 + head) * 8192;
#pragma unroll
      for (int i = 0; i < 4; ++i) { const int e = (i * 512 + tid) * 4; *(f32x4*)(gb + e) = *(const LAS f32x4*)(bfs + e); } }
    } else {
      __syncthreads();
#pragma unroll
      for (int i = 0; i < 4; ++i) { const int e = (i * 512 + tid) * 4; *(LAS f32x4*)(bfs + e) = gbv[i]; }
      __syncthreads();
    }
    LAS bf16_t* vT = (LAS bf16_t*)(lds + GL_VT);
    { const int r = tid >> 3, k8 = (tid & 7) * 8; const bool ok = r >= rmin;
      if (!ok) { kw = (u32x4){0u, 0u, 0u, 0u}; qw = kw; }
      float qv[8], kv[8];
#pragma unroll
      for (int i = 0; i < 4; ++i) { qv[2 * i] = bflo(qw[i]); qv[2 * i + 1] = bfhi(qw[i]); kv[2 * i] = bflo(kw[i]); kv[2 * i + 1] = bfhi(kw[i]); }
      if (MODE == 0) { LAS bf16_t* kd0 = (LAS bf16_t*)(lds + GL_QE0); LAS bf16_t* kd1 = (LAS bf16_t*)(lds + GL_QE1);
#pragma unroll
          for (int i = 0; i < 8; ++i) { const int kk = k8 + i; kd0[kk * GLD + r] = f2bf(kv[i] * __expf(bfs[63 * 64 + kk] - bfs[r * 64 + kk])); kd1[kk * GLD + r] = f2bf(kv[i] * __expf(bbs[kk] - bbs[r * 64 + kk])); }
      } else { LAS bf16_t* qe0 = (LAS bf16_t*)(lds + GL_QE0); LAS bf16_t* qe1 = (LAS bf16_t*)(lds + GL_QE1); LAS bf16_t* ke0 = (LAS bf16_t*)(lds + GL_KE0); LAS bf16_t* ke1 = (LAS bf16_t*)(lds + GL_KE1);
          u32x4 a, b2, c2, d2;
#pragma unroll
          for (int i = 0; i < 4; ++i) { const int kk = k8 + 2 * i; const float f0 = bfs[r * 64 + kk], f1 = bfs[r * 64 + kk + 1], g0 = bbs[r * 64 + kk], g1 = bbs[r * 64 + kk + 1];
              a[i] = cvt_pk_bf16(qv[2 * i] * 0.125f * __expf(f0), qv[2 * i + 1] * 0.125f * __expf(f1)); b2[i] = cvt_pk_bf16(qv[2 * i] * 0.125f * __expf(g0), qv[2 * i + 1] * 0.125f * __expf(g1));
              c2[i] = cvt_pk_bf16(kv[2 * i] * __expf(-f0), kv[2 * i + 1] * __expf(-f1)); d2[i] = cvt_pk_bf16(kv[2 * i] * __expf(-g0), kv[2 * i + 1] * __expf(-g1)); }
          *(LAS u32x4*)(qe0 + r * GLD + k8) = a; *(LAS u32x4*)(qe1 + r * GLD + k8) = b2; *(LAS u32x4*)(ke0 + r * GLD + k8) = c2; *(LAS u32x4*)(ke1 + r * GLD + k8) = d2; }
#pragma unroll
      for (int hh = 0; hh < 2; ++hh) { const int v8 = ((tid & 7) + 8 * hh) * 8; u32x4 vw = (u32x4){0u, 0u, 0u, 0u};
          if (ok) vw = vwp[hh];
#pragma unroll
          for (int i = 0; i < 4; ++i) { vT[(v8 + 2 * i) * GLD + r] = (bf16_t)(vw[i] & 0xffffu); vT[(v8 + 2 * i + 1) * GLD + r] = (bf16_t)(vw[i] >> 16); } }
    }
    if (MODE == 1) {
        const float* ds = (const float*)(p.ws + WS_DS); f32x4 sv[2][4];
#pragma unroll
        for (int d = 0; d < 2; ++d) { const float* src = ds + ((size_t)(ci * 4 + head) * 2 + d) * 8192;
#pragma unroll
            for (int i = 0; i < 4; ++i) sv[d][i] = *(const f32x4*)(src + (i * 512 + tid) * 4); }
#pragma unroll
        for (int d = 0; d < 2; ++d) { LAS bf16_t* sp = (LAS bf16_t*)(lds + (d ? GL_SP1 : GL_SP0));
#pragma unroll
            for (int i = 0; i < 4; ++i) { const int e = (i * 512 + tid) * 4; const f32x4 v = sv[d][i]; u32x2 w; w.x = cvt_pk_bf16(v[0], v[1]); w.y = cvt_pk_bf16(v[2], v[3]); *(LAS u32x2*)(sp + (e >> 6) * GLD + (e & 63)) = w; } }
    }
    __syncthreads();
    if (MODE == 0) {
        float* ds = (float*)(p.ws + WS_DS); float* dec = (float*)(p.ws + WS_DECAY);
        if (tid < 128) { const int d = tid >> 6, kk = tid & 63; dec[((size_t)(ci * 4 + head) * 2 + d) * 64 + kk] = __expf(d == 0 ? bfs[63 * 64 + kk] : bbs[kk]); }
#pragma unroll
        for (int d = 0; d < 2; ++d) { const LAS bf16_t* kd = (const LAS bf16_t*)(lds + (d ? GL_QE1 : GL_QE0)); float* dst = ds + ((size_t)(ci * 4 + head) * 2 + d) * 8192;
            for (int kt = 0; kt < 4; ++kt) { f32x4 acc = (f32x4){0.f, 0.f, 0.f, 0.f}; acc = mma_lds(acc, vT + wid * 16 * GLD, kd + kt * 16 * GLD, GLD, 2, lane);
#pragma unroll
                for (int j = 0; j < 4; ++j) dst[(wid * 16 + (lane >> 4) * 4 + j) * 64 + kt * 16 + (lane & 15)] = acc[j]; } }
        __syncthreads();
        return;
    }
    const LAS bf16_t* qe0 = (const LAS bf16_t*)(lds + GL_QE0); const LAS bf16_t* qe1 = (const LAS bf16_t*)(lds + GL_QE1); const LAS bf16_t* ke0 = (const LAS bf16_t*)(lds + GL_KE0); const LAS bf16_t* ke1 = (const LAS bf16_t*)(lds + GL_KE1);
    LAS bf16_t* att = (LAS bf16_t*)(lds + GL_ATT);
    { const int it = wid >> 1;
#pragma unroll
      for (int t2 = 0; t2 < 2; ++t2) { const int jt = (wid & 1) * 2 + t2; f32x4 af = (f32x4){0.f, 0.f, 0.f, 0.f}, ab = af;
          af = mma_lds(af, qe0 + it * 16 * GLD, ke0 + jt * 16 * GLD, GLD, 2, lane); ab = mma_lds(ab, qe1 + it * 16 * GLD, ke1 + jt * 16 * GLD, GLD, 2, lane);
#pragma unroll
          for (int j = 0; j < 4; ++j) { const int i_ = it * 16 + (lane >> 4) * 4 + j, j_ = jt * 16 + (lane & 15); att[i_ * GLD + j_] = f2bf((j_ <= i_ ? af[j] : 0.f) + (j_ >= i_ ? ab[j] : 0.f)); } } }
    __syncthreads();
    LAS float* os = (LAS float*)(lds + GL_OS);
    { const int it = wid >> 1; const LAS bf16_t* sp0 = (const LAS bf16_t*)(lds + GL_SP0); const LAS bf16_t* sp1 = (const LAS bf16_t*)(lds + GL_SP1);
#pragma unroll
      for (int t4 = 0; t4 < 4; ++t4) { const int vt = (wid & 1) * 4 + t4; f32x4 acc = (f32x4){0.f, 0.f, 0.f, 0.f};
          acc = mma_lds(acc, att + it * 16 * GLD, vT + vt * 16 * GLD, GLD, 2, lane); acc = mma_lds(acc, qe0 + it * 16 * GLD, sp0 + vt * 16 * GLD, GLD, 2, lane); acc = mma_lds(acc, qe1 + it * 16 * GLD, sp1 + vt * 16 * GLD, GLD, 2, lane);
#pragma unroll
          for (int j = 0; j < 4; ++j) os[(it * 16 + (lane >> 4) * 4 + j) * 132 + vt * 16 + (lane & 15)] = acc[j]; } }
    __syncthreads();
    { const int r = tid >> 3, v0 = (tid & 7) * 16; float o[16]; float ss = 0.f;
#pragma unroll
      for (int i = 0; i < 16; ++i) { o[i] = os[r * 132 + v0 + i]; ss += o[i] * o[i]; }
      ss += __shfl_xor(ss, 1); ss += __shfl_xor(ss, 2); ss += __shfl_xor(ss, 4);
      const float rs = rsqrtf(ss * (1.0f / 128.0f) + 1e-6f);
      if (r >= rmin) { const size_t tok = (size_t)(tok0 + r); bf16_t* yall = (bf16_t*)(p.ws + WS_YALL);
#pragma unroll
          for (int hh = 0; hh < 2; ++hh) { const u32x4 gw = gwp[hh]; u32x4 w;
#pragma unroll
              for (int i = 0; i < 4; ++i) { const int e = hh * 8 + 2 * i; w[i] = cvt_pk_bf16(o[e] * rs * ngv[e] * silu(bflo(gw[i])), o[e + 1] * rs * ngv[e + 1] * silu(bfhi(gw[i]))); }
              *(u32x4*)(yall + tok * D + 512 + head * 128 + v0 + hh * 8) = w; } } }
    __syncthreads();
}

__device__ __forceinline__ float softplus_neg(float lam) { const float e = __expf(-lam); return lam + 0.f < -8.f ? -lam : (e < 0.02f ? e * (1.0f - e * (0.5f - e * (1.0f / 3.0f))) : __logf(1.0f + e)); }
__device__ __forceinline__ float one_minus_exp(float x) {
    return x > -0.5f ? -x * (1.0f + x * 0.5f * (1.0f + x * (1.0f / 3.0f) * (1.0f + x * 0.25f * (1.0f + x * 0.2f * (1.0f + x * (1.0f / 6.0f) * (1.0f + x * (1.0f / 7.0f))))))) : 1.0f - __expf(x);
}
template <int MODE>
__device__ __forceinline__ void lru_phase(const int TID, const int b, const int G, const Params& p, int l, LAS unsigned char* lds) {
    const int tid = TID, lane = tid & 63, wid = tid >> 6, q = lane >> 4;
    const bf16_t* cols = (const bf16_t*)(p.ws + WS_COLS);
    int it = b; if (it >= NCK * 8) return;
    const int nb = b & 7;
    LAS bf16_t* xcA = (LAS bf16_t*)lds; LAS float* xcf = (LAS float*)(lds + 17408);
    const int ch = tid & 127, rb = tid >> 7, gchc = nb * 128 + ch;
    const float w0 = p.in[18][(l * 4 + 0) * 1024 + gchc], w1 = p.in[18][(l * 4 + 1) * 1024 + gchc], w2 = p.in[18][(l * 4 + 2) * 1024 + gchc], w3 = p.in[18][(l * 4 + 3) * 1024 + gchc], cb = p.in[19][l * 1024 + gchc];
    const int chl = wid * 16 + (lane & 15), gch = nb * 128 + chl;
    float ba[2], bx[2], sp8[2];
#pragma unroll
    for (int d = 0; d < 2; ++d) { ba[d] = p.in[21][(l * 2 + d) * 1024 + gch]; bx[d] = p.in[23][(l * 2 + d) * 1024 + gch]; sp8[d] = 8.0f * softplus_neg(p.in[24][(l * 2 + d) * 1024 + gch]); }
    bf16x8 bfr[4][4];
    { const bf16_t* bt = (const bf16_t*)(p.ws + WS_BTLRU);
#pragma unroll
      for (int mat = 0; mat < 4; ++mat)
#pragma unroll
          for (int ks = 0; ks < 4; ++ks) bfr[mat][ks] = *(const bf16x8*)(bt + ((size_t)(mat * 8 + nb) * 128 + wid * 16 + (lane & 15)) * 128 + ks * 32 + q * 8); }
    bf16_t xr[19];
    { int seq, c; chunk_info(it >> 3, seq, c); const int s0 = seq_start(seq), L = seq_len(seq), pos0 = (c == 0 ? -48 : 16 + 64 * (c - 1));
      const bf16_t* xb = cols + (size_t)s0 * NINP + C_XC + gchc;
#pragma unroll
      for (int i = 0; i < 19; ++i) { const int pos = pos0 + rb * 16 - 2 + i; const int pc = pos < 0 ? 0 : (pos < L ? pos : L - 1); xr[i] = xb[(size_t)pc * NINP]; } }
    for (; it < NCK * 8; it += G) {
        const int ci = it >> 3;
        int seq, c; chunk_info(ci, seq, c);
        const int s0 = seq_start(seq);
        const int pos0 = (c == 0 ? -48 : 16 + 64 * (c - 1));
        const int rmin = (c == 0) ? 48 : 0;
        float xv[19];
        { const int L = seq_len(seq);
#pragma unroll
          for (int i = 0; i < 19; ++i) { const int pos = pos0 + rb * 16 - 2 + i; xv[i] = (pos >= 0 && pos < L) ? bf2f(xr[i]) : 0.f; } }
#pragma unroll
        for (int i = 0; i < 16; ++i) { const int r = rb * 16 + i; const float xc = (r >= rmin) ? cb + xv[i] * w0 + xv[i + 1] * w1 + xv[i + 2] * w2 + xv[i + 3] * w3 : 0.f;
            xcf[r * 132 + ch] = xc; xcA[r * 136 + ch] = f2bf(xc); }
        u32x4 gq[2]; float cin[2];
        if (MODE == 1) {
#pragma unroll
            for (int d = 0; d < 2; ++d) cin[d] = ((const float*)(p.ws + WS_LRUC))[((size_t)ci * 2 + d) * 1024 + gch];
            { const int r = tid >> 3; const int rr = r >= rmin ? r : rmin; const bf16_t* gp = cols + (size_t)(s0 + pos0 + rr) * NINP + C_GC + nb * 128 + (tid & 7) * 16;
              gq[0] = *(const u32x4*)gp; gq[1] = *(const u32x4*)(gp + 8); }
        }
        { const int itn = it + G;
          if (itn < NCK * 8) { int seqn, cn; chunk_info(itn >> 3, seqn, cn); const int s0n = seq_start(seqn), Ln = seq_len(seqn), pos0n = (cn == 0 ? -48 : 16 + 64 * (cn - 1));
              const bf16_t* xb = cols + (size_t)s0n * NINP + C_XC + gchc;
#pragma unroll
              for (int i = 0; i < 19; ++i) { const int pos = pos0n + rb * 16 - 2 + i; const int pc = pos < 0 ? 0 : (pos < Ln ? pos : Ln - 1); xr[i] = xb[(size_t)pc * NINP]; } } }
        LBAR();
        LAS bf16_t* gts = (LAS bf16_t*)(lds + 51200); LAS float* hfs = (LAS float*)(lds + 68608);
        float hsum[4][4];
#pragma unroll
        for (int d = 0; d < 2; ++d) {
            __builtin_amdgcn_sched_barrier(0);
            f32x4 acc[2][4];
#pragma unroll
            for (int rt = 0; rt < 4; ++rt) { bf16x8 afr[4];
#pragma unroll
                for (int ks = 0; ks < 4; ++ks) afr[ks] = *(const LAS bf16x8*)(xcA + (rt * 16 + (lane & 15)) * 136 + ks * 32 + q * 8);
#pragma unroll
                for (int kind = 0; kind < 2; ++kind) { f32x4 a = (f32x4){0.f, 0.f, 0.f, 0.f};
#pragma unroll
                    for (int ks = 0; ks < 4; ++ks) a = __builtin_amdgcn_mfma_f32_16x16x32_bf16(afr[ks], bfr[d * 2 + kind][ks], a, 0, 0, 0);
                    acc[kind][rt] = a; } }
            float a[4][4], bb[4][4];
#pragma unroll
            for (int rt = 0; rt < 4; ++rt)
#pragma unroll
                for (int j = 0; j < 4; ++j) { const int r = rt * 16 + q * 4 + j; const float rg = sigm(acc[0][rt][j] + ba[d]), ig = sigm(acc[1][rt][j] + bx[d]), la = -sp8[d] * rg;
                    const bool ok = r >= rmin; const float av = __expf(la), x2 = 2.0f * la; const float om = x2 > -0.25f ? -x2 * (1.0f + x2 * 0.5f * (1.0f + x2 * (1.0f / 3.0f) * (1.0f + x2 * 0.25f * (1.0f + x2 * 0.2f)))) : 1.0f - av * av;
                    a[rt][j] = ok ? av : 1.0f; bb[rt][j] = ok ? __builtin_amdgcn_sqrtf(om) * ig * xcf[r * 132 + chl] : 0.f; }
            float LA[4], LB[4];
#pragma unroll
            for (int rt = 0; rt < 4; ++rt) { float A = 1.f, B = 0.f;
#pragma unroll
                for (int jj = 0; jj < 4; ++jj) { const int j = d == 0 ? jj : 3 - jj; B = a[rt][j] * B + bb[rt][j]; A *= a[rt][j]; }
                LA[rt] = A; LB[rt] = B; }
            const size_t co = ((size_t)ci * 2 + d) * 1024 + gch;
            float h = (MODE == 1) ? cin[d] : 0.f, Atot = 1.f; float hin[4];
#pragma unroll
            for (int rr = 0; rr < 4; ++rr) { const int rt = d == 0 ? rr : 3 - rr;
#pragma unroll
                for (int qi = 0; qi < 4; ++qi) { const int qq = d == 0 ? qi : 3 - qi;
                    const float Aq = __shfl(LA[rt], (lane & 15) + 16 * qq), Bq = __shfl(LB[rt], (lane & 15) + 16 * qq);
                    if (qq == q) hin[rt] = h;
                    h = Aq * h + Bq; Atot *= Aq; } }
            if (MODE == 0) { if (q == 0) { ((float*)(p.ws + WS_LRUA))[co] = Atot; ((float*)(p.ws + WS_LRUH))[co] = h; } }
            else {
#pragma unroll
                for (int rt = 0; rt < 4; ++rt) { float hh = hin[rt];
#pragma unroll
                    for (int jj = 0; jj < 4; ++jj) { const int j = d == 0 ? jj : 3 - jj; hh = a[rt][j] * hh + bb[rt][j];
                        if (d == 0) hfs[(rt * 16 + q * 4 + j) * 132 + chl] = hh; else hsum[rt][j] = hh; } }
                if (d == 0) { *(LAS u32x4*)(gts + (tid >> 3) * 136 + (tid & 7) * 16) = gq[0]; *(LAS u32x4*)(gts + (tid >> 3) * 136 + (tid & 7) * 16 + 8) = gq[1]; } }
        }
        if (MODE == 1) { bf16_t* yall = (bf16_t*)(p.ws + WS_YALL);
            LBAR();
#pragma unroll
            for (int rt = 0; rt < 4; ++rt)
#pragma unroll
                for (int j = 0; j < 4; ++j) { const int r = rt * 16 + q * 4 + j; xcA[r * 136 + chl] = f2bf((hsum[rt][j] + hfs[r * 132 + chl]) * silu(bf2f(gts[r * 136 + chl]))); }
            LBAR();
            { const int r = tid >> 3; if (r >= rmin) { const u32x4 y0 = *(const LAS u32x4*)(xcA + r * 136 + (tid & 7) * 16), y1 = *(const LAS u32x4*)(xcA + r * 136 + (tid & 7) * 16 + 8);
                bf16_t* yp = yall + (size_t)(s0 + pos0 + r) * D + 1024 + nb * 128 + (tid & 7) * 16; *(u32x4*)yp = y0; *(u32x4*)(yp + 8) = y1; } } }
        LBAR();
    }
}


template <int WHICH>
__device__ __forceinline__ void skinny_tail(const int TID, const int b0, const Params& p) {
    const int lane = TID & 63, wid = TID >> 6, q = lane >> 4;
    if (wid >= 5) return;
    for (int b = b0; b < 256; b += (int)gridDim.x) {
    const int ct = b & 127, rt = (b >> 7) * 5 + wid;
    const int row = 24576 + rt * 16 + (lane & 15);
    const int colb = ct * 16 + (lane & 15);
    const bf16_t* cols = (const bf16_t*)(p.ws + WS_COLS);
    if (WHICH == 0) {
        const bf16_t* A = (const bf16_t*)(p.ws + WS_YALL) + (size_t)row * D + q * 8; const bf16_t* B = (const bf16_t*)(p.ws + WS_BTOUT) + (size_t)colb * D + q * 8;
        bf16_t* mbf = (bf16_t*)(p.ws + WS_H);
        f32x4 msum = (f32x4){0.f, 0.f, 0.f, 0.f};
        unsigned char gt[3][4];
#pragma unroll
        for (int br = 0; br < 3; ++br)
#pragma unroll
            for (int j = 0; j < 4; ++j) { const int cc = colb & 255; gt[br][j] = ((const unsigned char*)(cols + (size_t)(24576 + rt * 16 + q * 4 + j) * NINP + C_MG))[(br * 8 + (colb >> 8)) * 256 + ((((cc & 127) >> 5) * 4 + ((cc & 31) >> 3)) * 2 + (cc >> 7)) * 8 + (cc & 7)]; }
        float gs[3][4];
#pragma unroll
        for (int br = 0; br < 3; ++br)
#pragma unroll
            for (int j = 0; j < 4; ++j) { gs[br][j] = (float)gt[br][j] * (1.0f / 255.0f); asm volatile("" : "+v"(gs[br][j])); }
#pragma unroll
        for (int br = 0; br < 3; ++br) { const int koff = br * 512, nks = br == 2 ? 32 : 16; f32x4 acc = (f32x4){0.f, 0.f, 0.f, 0.f};
            for (int k0 = 0; k0 < nks; k0 += 8) { bf16x8 av[8], bv[8];
#pragma unroll
                for (int i = 0; i < 8; ++i) { av[i] = *(const bf16x8*)(A + koff + (k0 + i) * 32); bv[i] = *(const bf16x8*)(B + koff + (k0 + i) * 32); }
#pragma unroll
                for (int i = 0; i < 8; ++i) acc = __builtin_amdgcn_mfma_f32_16x16x32_bf16(av[i], bv[i], acc, 0, 0, 0); }
#pragma unroll
            for (int j = 0; j < 4; ++j) msum[j] += gs[br][j] * acc[j]; }
#pragma unroll
        for (int j = 0; j < 4; ++j) { const int tok = 24576 + rt * 16 + q * 4 + j; mbf[(size_t)tok * D + colb] = f2bf(msum[j]); }
    } else {
        const bf16_t* A = (const bf16_t*)(p.ws + WS_H) + (size_t)row * D + q * 8; const bf16_t* B = (const bf16_t*)(p.ws + WS_BTO) + (size_t)colb * D + q * 8;
        float* z = (float*)(p.ws + WS_Z);
        f32x4 acc = (f32x4){0.f, 0.f, 0.f, 0.f};
        for (int k0 = 0; k0 < 64; k0 += 8) { bf16x8 av[8], bv[8];
#pragma unroll
            for (int i = 0; i < 8; ++i) { av[i] = *(const bf16x8*)(A + (k0 + i) * 32); bv[i] = *(const bf16x8*)(B + (k0 + i) * 32); }
#pragma unroll
            for (int i = 0; i < 8; ++i) acc = __builtin_amdgcn_mfma_f32_16x16x32_bf16(av[i], bv[i], acc, 0, 0, 0); }
#pragma unroll
        for (int j = 0; j < 4; ++j) { const int tok = 24576 + rt * 16 + q * 4 + j; z[(size_t)tok * D + colb] += acc[j]; }
    }
    }
}

#define XB_TMO      128
#define XB_XCNT(j)  (256  + 64 * (j))
#define XB_XSUB(j)  (1280 + 64 * (j))
#define XB_XGEN(j)  (2304 + 64 * (j))
#define XB_TOP      3328
#define XB_TOPGEN   3392
#define XCD_BAR_WORDS 3456
#define XB_SPIN_CAP (1u << 18)
__device__ __forceinline__ unsigned xb_ld(unsigned* p)              { return __hip_atomic_load(p, __ATOMIC_RELAXED, __HIP_MEMORY_SCOPE_AGENT); }
__device__ __forceinline__ unsigned xb_add(unsigned* p, unsigned v) { return __hip_atomic_fetch_add(p, v, __ATOMIC_RELAXED, __HIP_MEMORY_SCOPE_AGENT); }
__device__ __forceinline__ unsigned xb_xcc_id() { return (unsigned)__builtin_amdgcn_s_getreg((3 << 11) | 20) & 0xFu; }
#define XB_SPIN(cond, bar) do { unsigned _sp = 0; while (cond) { __builtin_amdgcn_s_sleep(1); \
    if ((++_sp & 255u) == 0u) { if (xb_ld(&(bar)[XB_TMO])) break; if (_sp > XB_SPIN_CAP) { atomicAdd(&(bar)[XB_TMO], 1u); break; } } } } while (0)
struct XcdBarrier { unsigned* bar; unsigned x; volatile LAS unsigned* st; };
__device__ __forceinline__ XcdBarrier xcd_barrier_post(unsigned* bar, volatile LAS unsigned* st) {
    XcdBarrier b; b.bar = bar; b.x = xb_xcc_id(); b.st = st;
    if (threadIdx.x == 0) (void)xb_add(&bar[XB_XCNT(b.x)], 1u);
    return b;
}
__device__ __forceinline__ void xcd_barrier_complete(unsigned* bar, unsigned x, unsigned& nloc, unsigned& nx) {
    const unsigned G = gridDim.x * gridDim.y * gridDim.z;
    unsigned sum, cnt, mine, sp = 0u;
    for (;;) {
        sum = 0u; cnt = 0u; mine = 0u;
#pragma unroll
        for (unsigned j = 0; j < 16; ++j) { const unsigned c = xb_ld(&bar[XB_XCNT(j)]); sum += c; cnt += (c > 0u) ? 1u : 0u; mine = (j == x) ? c : mine; }
        if (sum == G) break;
        __builtin_amdgcn_s_sleep(1);
        if ((++sp & 255u) == 0u) { if (xb_ld(&bar[XB_TMO])) break; if (sp > XB_SPIN_CAP) { atomicAdd(&bar[XB_TMO], 1u); break; } }
    }
    nloc = mine > 0u ? mine : 1u; nx = cnt > 0u ? cnt : 1u;
}
__device__ __forceinline__ void xcd_barrier(const XcdBarrier& b) {
    asm volatile("s_waitcnt vmcnt(0)" ::: "memory");
    __syncthreads();
    if (threadIdx.x == 0) {
        unsigned* bar = b.bar;
        __builtin_amdgcn_s_waitcnt(0);
        unsigned nloc = b.st[0], nx = b.st[1];
        if (nloc == 0u) { xcd_barrier_complete(bar, b.x, nloc, nx); b.st[0] = nloc; b.st[1] = nx; }
        const unsigned old = xb_add(&bar[XB_XSUB(b.x)], 1u);
        const unsigned gen = old / nloc;
        if (old + 1u == (gen + 1u) * nloc) {
            __builtin_amdgcn_fence(__ATOMIC_RELEASE, "agent");
            asm volatile("s_waitcnt vmcnt(0)" ::: "memory");
            const unsigned og = xb_add(&bar[XB_TOP], 1u);
            const unsigned tg = og / nx;
            if (og + 1u == (tg + 1u) * nx) xb_add(&bar[XB_TOPGEN], 1u);
            else XB_SPIN(xb_ld(&bar[XB_TOPGEN]) == tg, bar);
            __builtin_amdgcn_fence(__ATOMIC_ACQUIRE, "agent");
            xb_add(&bar[XB_XGEN(b.x)], 1u);
            asm volatile("s_waitcnt vmcnt(0)" ::: "memory");
        } else {
            XB_SPIN(xb_ld(&bar[XB_XGEN(b.x)]) == gen, bar);
            __builtin_amdgcn_fence(__ATOMIC_ACQUIRE, "agent");
            asm volatile("s_waitcnt vmcnt(0)" ::: "memory");
        }
    }
    __syncthreads();
}

__global__ void __launch_bounds__(512) fwd_megakernel(Params p_in) {
    extern __shared__ __attribute__((aligned(16))) unsigned char smem[];
    LAS unsigned char* lds = (LAS unsigned char*)smem;
    cg::grid_group grid = cg::this_grid();
    const int G = gridDim.x;
    const Params& p0 = p_in;
    volatile LAS unsigned* stw = (volatile LAS unsigned*)(lds + 150528);
    if (threadIdx.x == 0) { stw[0] = 0u; stw[1] = 0u; }
    __syncthreads();
    const XcdBarrier xb = xcd_barrier_post((unsigned*)(p_in.ws + WS_BAR), stw);
    for (int ph = p0.ph_lo; ph < p0.ph_hi; ++ph) {
        const int reps_ = (ph < 32 && (ph & 7) == DUP) ? 2 : 1;
        for (int rep_ = 0; rep_ < reps_; ++rep_) {
        int TID = threadIdx.x; asm volatile("" : "+v"(TID));
        int b = blockIdx.x; asm volatile("" : "+s"(b));
        Params p = p0; { unsigned long long t_ = (unsigned long long)p.ws; asm volatile("" : "+s"(t_)); p.ws = (unsigned char*)t_; }
        const char* ws = (const char*)p.ws;
        if (ph == 32) { final_norm_phase(TID, b, p); }
        else {
            const int l = ph >> 3, k = ph & 7;
            if (k == 0 && (PHM & 1)) { rmsnorm_phase(TID, b, p, l); convert_weights(TID, b, p, l, (LAS float*)lds); if (l == 0) s5_tables_all(TID, b, p); }
            else if (k == 1 && (PHM & 2)) {
                TileOrder S; S.nM = MP / 256; S.nN = NINP / 256; S.nwg = S.nM * S.nN; S.G = G; S.c = b; S.mult = 1; S.nt0 = D / 64; S.A = ws + WS_H; S.B = ws + WS_BTIN; S.tA = (size_t)256 * D * 2; S.tB = (size_t)256 * D * 2;
                EpiIn E; E.cols = (bf16_t*)(p.ws + WS_COLS); E.ubuf = (bf16_t*)(p.ws + WS_UBUF);
                gemm_phase(TID, lds, D, D, S, E);
                s5_assemble_a(TID, b, p, l);
            } else if (k == 2 && (PHM & 4)) {
                GroupOrder S; S.G = G; S.c = b; S.nt0 = 4; S.A = ws + WS_UBUF; S.B = ws + WS_PMAT; S.gsA = (size_t)CHP * 512 * 2; S.gsB = (size_t)256 * 256 * 2; S.tA = (size_t)256 * 512 * 2;
                EpiS5State E; E.st = (float*)(p.ws + WS_ST);
                if (SUBM & 4) gemm_phase(TID, lds, 512, 256, S, E);
                __syncthreads();
                { const int head_ = ((b + 128) % G) & 3, kk_ = TID & 63; float wg_[2][16], bg_[2];
                  _Pragma("unroll") for (int d = 0; d < 2; ++d) { bg_[d] = p.in[16][(l * 2 + d) * 256 + head_ * 64 + kk_]; _Pragma("unroll") for (int j = 0; j < 16; ++j) wg_[d][j] = p.in[15][((size_t)(l * 2 + d) * 16 + j) * 256 + head_ * 64 + kk_]; }
                  float ng_[16]; _Pragma("unroll") for (int e = 0; e < 16; ++e) ng_[e] = p.in[17][l * 512 + head_ * 128 + (TID & 7) * 16 + e];
                  for (int it = (b + 128) % G; it < NCK * 4; it += G) gla_item<0>(TID, p, l, it >> 2, it & 3, lds, wg_, bg_, ng_); }
                lru_phase<0>(TID, b, G, p, l, lds);
                s5_assemble_w(TID, b, p, l);
            } else if (k == 3 && (PHM & 8)) { scans_phase(TID, b, p, l, rep_ == 0); }
            else if (k == 4 && (PHM & 16)) {
                GroupOrder S; S.G = G; S.c = b; S.nt0 = 8; S.A = ws + WS_UBUF; S.B = ws + WS_WMAT; S.gsA = (size_t)CHP * 512 * 2; S.gsB = (size_t)256 * 512 * 2; S.tA = (size_t)256 * 512 * 2;
                EpiS5Out E; E.zs5 = (bf16_t*)(p.ws + WS_ZS5);
                if (SUBM & 4) gemm_phase(TID, lds, 512, 512, S, E);
                __syncthreads();
                { const int head_ = ((b + 128) % G) & 3, kk_ = TID & 63; float wg_[2][16], bg_[2];
                  _Pragma("unroll") for (int d = 0; d < 2; ++d) { bg_[d] = p.in[16][(l * 2 + d) * 256 + head_ * 64 + kk_]; _Pragma("unroll") for (int j = 0; j < 16; ++j) wg_[d][j] = p.in[15][((size_t)(l * 2 + d) * 16 + j) * 256 + head_ * 64 + kk_]; }
                  float ng_[16]; _Pragma("unroll") for (int e = 0; e < 16; ++e) ng_[e] = p.in[17][l * 512 + head_ * 128 + (TID & 7) * 16 + e];
                  for (int it = (b + 128) % G; it < NCK * 4; it += G) gla_item<1>(TID, p, l, it >> 2, it & 3, lds, wg_, bg_, ng_); }
                lru_phase<1>(TID, b, G, p, l, lds);
            } else if (k == 5 && (PHM & 32)) {
                TileOrder S; S.nM = MP / 256; S.nN = 2; S.nwg = S.nM * S.nN; S.G = G; S.c = b; S.mult = 1; S.nt0 = 8; S.A = ws + WS_ZS5; S.B = ws + WS_BTGLU; S.tA = (size_t)256 * 512 * 2; S.tB = (size_t)256 * 512 * 2;
                EpiGlu E; E.zs5 = (const bf16_t*)(p.ws + WS_ZS5); E.cols = (const bf16_t*)(p.ws + WS_COLS); E.bglu = p.in[14] + l * 512; E.yall = (bf16_t*)(p.ws + WS_YALL);
                gemm_phase(TID, lds, 512, 512, S, E);
            } else if (k == 6 && (PHM & 64)) {
                TileOrder S; S.nM = 96; S.nN = 8; S.nwg = S.nM * S.nN; S.G = G; S.c = b; S.mult = 3; S.nt0 = 8; S.A = ws + WS_YALL; S.B = ws + WS_BTOUT; S.tA = (size_t)256 * D * 2; S.tB = (size_t)256 * D * 2;
                EpiOut E; E.cols = (const bf16_t*)(p.ws + WS_COLS); E.mbf = (bf16_t*)(p.ws + WS_H);
                gemm_phase(TID, lds, D, D, S, E);
                skinny_tail<0>(TID, b, p);
            } else if (PHM & 128) {
                TileOrder S; S.nM = 96; S.nN = 8; S.nwg = S.nM * S.nN; S.G = G; S.c = b; S.mult = 1; S.nt0 = D / 64; S.A = ws + WS_H; S.B = ws + WS_BTO; S.tA = (size_t)256 * D * 2; S.tB = (size_t)256 * D * 2;
                EpiWo E; E.z = (float*)(p.ws + WS_Z);
                gemm_phase(TID, lds, D, D, S, E);
                skinny_tail<1>(TID, b, p);
            }
        }
        }
        if (p0.use_sync && ph + 1 < p0.ph_hi) { if (ph == p0.ph_lo) grid.sync(); else xcd_barrier(xb); }
    }
}

extern "C" void kernel_launch(void* const* d_in, const int* in_sizes, int n_in, void* d_out, int out_size, void* d_ws, size_t ws_size, hipStream_t stream) {
    static int grid = 0, coop = 1;
    if (grid == 0) {
        if (n_in != 30 || ws_size < WS_END2) { fprintf(stderr, "kernel_launch: unexpected n_in %d or ws_size %zu (< %zu)\n", n_in, ws_size, (size_t)WS_END); grid = -1; return; }
        int dev = 0, cus = 0, per_cu = 0;
        (void)hipGetDevice(&dev); (void)hipDeviceGetAttribute(&cus, hipDeviceAttributeMultiprocessorCount, dev);
        if (hipFuncSetAttribute((const void*)fwd_megakernel, hipFuncAttributeMaxDynamicSharedMemorySize, LDS_BYTES) != hipSuccess) { fprintf(stderr, "kernel_launch: hipFuncSetAttribute failed\n"); grid = -1; return; }
        if (hipOccupancyMaxActiveBlocksPerMultiprocessor(&per_cu, (const void*)fwd_megakernel, 512, LDS_BYTES) != hipSuccess || per_cu < 1) { fprintf(stderr, "kernel_launch: occupancy query gave %d\n", per_cu); per_cu = 1; }
        (void)hipGetLastError();
        grid = cus * 1;
    }
    if (grid < 0) return;
    Params p{};
    for (int i = 0; i < 30; ++i) p.in[i] = (const float*)d_in[i];
    p.out = (float*)d_out; p.ws = (unsigned char*)d_ws; p.pad = 0;
    (void)hipMemsetAsync((char*)d_ws + WS_BAR, 0, 3456 * 4, stream);
    if (coop) {
        p.ph_lo = 0; p.ph_hi = 33; p.use_sync = 1;
        void* args[] = {&p};
        hipError_t e = hipLaunchCooperativeKernel((const void*)fwd_megakernel, dim3(grid), dim3(512), args, LDS_BYTES, stream);
        if (e == hipSuccess) return;
        fprintf(stderr, "kernel_launch: cooperative launch failed: %s (grid %d); falling back to one launch per phase\n", hipGetErrorString(e), grid);
        (void)hipGetLastError(); coop = 0;
    }
    for (int ph = 0; ph < 33; ++ph) { p.ph_lo = ph; p.ph_hi = ph + 1; p.use_sync = 0; hipLaunchKernelGGL(fwd_megakernel, dim3(grid), dim3(512), LDS_BYTES, stream, p); }
}
```

```cpp
#include <hip/hip_runtime.h>
#include <hip/hip_cooperative_groups.h>
#include <cstdio>
namespace cg = cooperative_groups;
#define LAS __attribute__((address_space(3)))
typedef unsigned short bf16_t;
typedef short bf16x8 __attribute__((ext_vector_type(8)));
typedef float f32x4 __attribute__((ext_vector_type(4)));
typedef float f32x2 __attribute__((ext_vector_type(2)));
typedef unsigned u32x2 __attribute__((ext_vector_type(2)));
typedef unsigned u32x4 __attribute__((ext_vector_type(4)));

constexpr int D = 2048, NTOK = 24736, MP = 24832, NINP = 11008, NIN = 10784;
constexpr int NCH16 = 1546, CHP = 1792, NCK = 394;
constexpr int C_GA = 512, C_Q = 1024, C_K = 1280, C_V = 1536, C_GB = 2048, C_XC = 2560, C_GC = 3584, C_MG = 4608, C_GLR = 10752;
constexpr int LDS_BYTES = 150528 + 16;
#ifndef SYNCREP
#define SYNCREP 1
#endif
#ifndef DUP
#define DUP -1
#endif
#ifndef SUBM
#define SUBM 7
#endif
#ifndef PHM
#define PHM 255
#endif

constexpr size_t al256(size_t x) { return (x + 255) & ~(size_t)255; }
constexpr size_t WS_Z = 0;
constexpr size_t WS_H = WS_Z + al256((size_t)MP * D * 4);
constexpr size_t WS_COLS = WS_H + al256((size_t)MP * D * 2);
constexpr size_t WS_YALL = WS_COLS + al256((size_t)MP * NINP * 2);
constexpr size_t WS_ZS5 = WS_YALL + al256((size_t)MP * D * 2);
constexpr size_t WS_UBUF = WS_ZS5 + al256((size_t)MP * 512 * 2);
constexpr size_t WS_ST = WS_UBUF + al256((size_t)32 * CHP * 512 * 2);
constexpr size_t WS_DS = WS_ST + al256((size_t)32 * CHP * 256 * 4);
constexpr size_t WS_M32 = WS_UBUF;
constexpr size_t WS_DECAY = WS_DS + al256((size_t)NCK * 4 * 2 * 8192 * 4);
constexpr size_t WS_LRUA = WS_DECAY + al256((size_t)NCK * 4 * 2 * 64 * 4);
constexpr size_t WS_LRUH = WS_LRUA + al256((size_t)NCK * 2 * 1024 * 4);
constexpr size_t WS_LRUC = WS_LRUH + al256((size_t)NCK * 2 * 1024 * 4);
constexpr size_t WS_PW = WS_LRUC + al256((size_t)NCK * 2 * 1024 * 4);
constexpr size_t WS_BBAR = WS_PW + al256((size_t)4 * 32 * 2 * 17 * 64 * 8);
constexpr size_t WS_WMAT = WS_BBAR + al256((size_t)4 * 32 * 2 * 64 * 16 * 8);
constexpr size_t WS_PMAT = WS_WMAT + al256((size_t)32 * 256 * 512 * 2);
constexpr size_t WS_BTIN = WS_PMAT + al256((size_t)32 * 256 * 256 * 2);
constexpr size_t WS_BTOUT = WS_BTIN + al256((size_t)NINP * D * 2);
constexpr size_t WS_BTO = WS_BTOUT + al256((size_t)D * D * 2);
constexpr size_t WS_BTGLU = WS_BTO + al256((size_t)D * D * 2);
constexpr size_t WS_BTLRU = WS_BTGLU + al256((size_t)512 * 512 * 2);
constexpr size_t WS_KMAT = WS_BTLRU + al256((size_t)32 * 128 * 128 * 2);
constexpr size_t WS_BAR = WS_KMAT + al256((size_t)32 * 2 * 16 * 256 * 4);
constexpr size_t WS_END = WS_BAR + al256((size_t)3456 * 4);
constexpr size_t WS_GB = WS_END;
constexpr size_t WS_END2 = WS_GB + al256((size_t)NCK * 4 * 8192 * 4);
constexpr size_t PWL = (size_t)32 * 2 * 17 * 64, BBL = (size_t)32 * 2 * 64 * 16;
static_assert(WS_END2 <= (size_t)1413480448, "workspace too large");
static_assert((size_t)MP * D * 4 <= WS_DECAY - WS_UBUF, "m32 alias too small");

struct Params { const float* in[30]; float* out; unsigned char* ws; int ph_lo, ph_hi, use_sync, pad; };

#define LBAR() do { asm volatile("s_waitcnt lgkmcnt(0)" ::: "memory"); __builtin_amdgcn_s_barrier(); asm volatile("" ::: "memory"); } while (0)
__device__ __forceinline__ unsigned cvt_pk_bf16(float lo, float hi) { unsigned r; asm volatile("v_cvt_pk_bf16_f32 %0, %1, %2" : "=v"(r) : "v"(lo), "v"(hi)); return r; }
__device__ __forceinline__ bf16_t f2bf(float f) { return (bf16_t)(cvt_pk_bf16(f, 0.f) & 0xffffu); }
__device__ __forceinline__ float bf2f(bf16_t b) { return __uint_as_float(((unsigned)b) << 16); }
__device__ __forceinline__ float bflo(unsigned w) { return __uint_as_float(w << 16); }
__device__ __forceinline__ float bfhi(unsigned w) { return __uint_as_float(w & 0xffff0000u); }
__device__ __forceinline__ float sigm(float x) { return __builtin_amdgcn_rcpf(1.0f + __expf(-x)); }
__device__ __forceinline__ float silu(float x) { return x * sigm(x); }
__device__ __forceinline__ float gelu_t(float x) { const float u = 0.7978845608028654f * (x + 0.044715f * x * x * x); return x * sigm(2.0f * u); }
__device__ __forceinline__ float logsig(float x) { return -(fmaxf(-x, 0.f) + __logf(1.0f + __expf(-fabsf(x)))); }

__device__ __forceinline__ int seq_start(int s) { return s < 2 ? s * 4112 : 8224 + (s - 2) * 2064; }
__device__ __forceinline__ int seq_len(int s) { return s < 2 ? 4112 : 2064; }
__device__ __forceinline__ void chunk_info(int ci, int& seq, int& c) { if (ci < 130) { seq = ci / 65; c = ci - seq * 65; } else { const int t = ci - 130; const int q = t / 33; seq = 2 + q; c = t - q * 33; } }

constexpr int BM = 256, BK = 64, HALF = 128, HTB = HALF * BK * 2, STAGE_BYTES = 8 * HTB, NXCD = 8, WGM = 8;
__device__ __forceinline__ int lds_byte(int r, int c) { const int st = (r >> 4) * 2 + (c >> 5), rr = r & 15, cc = c & 31, ob = rr * 64 + cc * 2; return st * 1024 + (ob ^ (((ob >> 9) & 1) << 5)); }
__device__ __forceinline__ void stage_rc(int b, int& R, int& C) { const int st = b / 1024, sb = b % 1024, swz = sb ^ (((sb >> 9) & 1) << 5); R = (st >> 1) * 16 + swz / 64; C = (st & 1) * 32 + (swz % 64) / 2; }

struct Unit { int pm, pn, sub, nt; const char* a; const char* b; };

struct TileOrder {
    int nM, nN, nwg, G, c, mult, nt0; const char* A; const char* B; size_t tA, tB;
    __device__ __forceinline__ bool next(int i, Unit& u) const {
        const int ti = i / mult, sub = i - ti * mult;
        const long L = (long)ti * G + c; if (L >= nwg) return false;
        int wgid = (int)L; { const int q = nwg / NXCD, r = nwg % NXCD, xcd = wgid % NXCD, off = wgid / NXCD; wgid = (xcd < r ? xcd * (q + 1) : r * (q + 1) + (xcd - r) * q) + off; }
        const int nig = WGM * nN, gid = wgid / nig, fm = gid * WGM, gsz = (nM - fm) < WGM ? (nM - fm) : WGM;
        u.pm = fm + ((wgid % nig) % gsz); u.pn = (wgid % nig) / gsz; u.sub = sub;
        const int koff = (mult == 3) ? sub * 512 : 0; u.nt = (mult == 3) ? (sub == 2 ? 16 : 8) : nt0;
        u.a = A + (size_t)u.pm * tA + (size_t)koff * 2; u.b = B + (size_t)u.pn * tB + (size_t)koff * 2; return true;
    }
};
struct GroupOrder {
    int G, c, nt0; const char* A; const char* B; size_t gsA, gsB, tA;
    __device__ __forceinline__ bool next(int i, Unit& u) const {
        const int L = i * G + c; if (L >= 224) return false;
        const int g = L / 7, pm = L - g * 7; u.pm = pm; u.pn = 0; u.sub = g; u.nt = nt0;
        u.a = A + (size_t)g * gsA + (size_t)pm * tA; u.b = B + (size_t)g * gsB; return true;
    }
};

__device__ __forceinline__ int perm32(int rho) { const int n = rho >> 4, i = rho & 15; return 8 * (i >> 2) + 4 * n + (i & 3); }
template <class Epi, class Sched>
__device__ __forceinline__ void gemm_phase(const int TID, LAS unsigned char* lds, const int lda, const int ldb, const Sched& S, const Epi& E) {
    const int tid = TID, wid = __builtin_amdgcn_readfirstlane(tid >> 6), lane = tid & 63, wr = wid >> 2, wc = wid & 3, fr = lane & 15, fq = lane >> 4;
    unsigned voffA[2], voffB[2];
#pragma unroll
    for (int i = 0; i < 2; ++i) { int R, C; stage_rc(tid * 16 + i * 8192, R, C); const int Rb = Epi::PERM ? ((R & ~31) + perm32(R & 31)) : R; voffA[i] = (unsigned)(R * lda + C) * 2u; voffB[i] = (unsigned)(Rb * ldb + C) * 2u; }
    const size_t kstep = (size_t)(BK * 2);
    const size_t hA = (size_t)HALF * lda * 2, hB = (size_t)HALF * ldb * 2;
    const unsigned ldsw = (unsigned)wid * 1024u;
    const int aoff = lds_byte(wr * 64 + fr, fq * 8), boff = lds_byte(wc * 32 + fr, fq * 8);
#define PG8_SA(b, h) (((b) * 2 + (h)) * HTB)
#define PG8_SB(b, h) ((4 + (b) * 2 + (h)) * HTB)
#define PG8_STAGE(bufoff, gbase, voff) do { _Pragma("unroll") for (int _i = 0; _i < 2; ++_i) \
        __builtin_amdgcn_global_load_lds((const unsigned*)((const char*)(gbase) + (voff)[_i]), (LAS unsigned*)(lds + (bufoff) + ldsw + _i * 8192), 16, 0, 0); } while (0)
#define PG8_LDA(dst, b, h) do { _Pragma("unroll") for (int m = 0; m < 4; ++m) _Pragma("unroll") for (int k = 0; k < 2; ++k) dst[m][k] = *(const LAS bf16x8*)(lds + PG8_SA(b, h) + aoff + m * 2048 + k * 1024); } while (0)
#define PG8_LDB(dst, b, h) do { _Pragma("unroll") for (int n = 0; n < 2; ++n) _Pragma("unroll") for (int k = 0; k < 2; ++k) dst[n][k] = *(const LAS bf16x8*)(lds + PG8_SB(b, h) + boff + n * 2048 + k * 1024); } while (0)
#define PG8_MMA(ai, bj, At, Bt) do { __builtin_amdgcn_s_setprio(1); _Pragma("unroll") for (int m = 0; m < 4; ++m) _Pragma("unroll") for (int n = 0; n < 2; ++n) _Pragma("unroll") for (int k = 0; k < 2; ++k) \
        acc[ai][bj][m][n] = __builtin_amdgcn_mfma_f32_16x16x32_bf16(Bt[n][k], At[m][k], acc[ai][bj][m][n], 0, 0, 0); __builtin_amdgcn_s_setprio(0); } while (0)
#define PG8_WAIT_V(n) asm volatile("s_waitcnt vmcnt(" #n ")" ::: "memory")
#define PG8_WAIT_L(n) asm volatile("s_waitcnt lgkmcnt(" #n ")" ::: "memory")
#define PG8_BAR __builtin_amdgcn_s_barrier()
#define PG8_SCHED __builtin_amdgcn_sched_barrier(0)
    Unit cur, nxt; int ui = 0;
    if (!S.next(0, cur)) return;
    f32x4 acc[2][2][4][2];
#pragma unroll
    for (int a = 0; a < 2; ++a)
#pragma unroll
        for (int b = 0; b < 2; ++b)
#pragma unroll
            for (int m = 0; m < 4; ++m)
#pragma unroll
                for (int n = 0; n < 2; ++n) acc[a][b][m][n] = (f32x4){0.f, 0.f, 0.f, 0.f};
    bf16x8 At[4][2], B0[2][2], B1[2][2];
    const char* cA = cur.a; const char* cB = cur.b;
    PG8_STAGE(PG8_SB(0, 0), cB, voffB); PG8_STAGE(PG8_SA(0, 0), cA, voffA); PG8_STAGE(PG8_SB(0, 1), cB + hB, voffB); PG8_STAGE(PG8_SA(0, 1), cA + hA, voffA);
    if (wr == 1) PG8_BAR;
    PG8_WAIT_V(4); PG8_BAR;
    PG8_STAGE(PG8_SB(1, 0), cB + kstep, voffB); PG8_STAGE(PG8_SA(1, 0), cA + kstep, voffA); PG8_STAGE(PG8_SB(1, 1), cB + hB + kstep, voffB);
    PG8_WAIT_V(6); PG8_BAR;
    for (;;) {
        const bool has_next = S.next(ui + 1, nxt);
        const char* nA = has_next ? nxt.a : cA; const char* nB = has_next ? nxt.b : cB;
        const int nt = cur.nt;
        for (int t = 0; t < nt; t += 2) {
            const bool last = (t == nt - 2);
            const char* a1 = cA + (size_t)(t + 1) * kstep;
            const char* a2 = last ? nA : cA + (size_t)(t + 2) * kstep; const char* b2 = last ? nB : cB + (size_t)(t + 2) * kstep;
            const char* a3 = a2 + kstep; const char* b3 = b2 + kstep;
            PG8_LDB(B0, 0, 0); PG8_SCHED; PG8_LDA(At, 0, 0); PG8_STAGE(PG8_SA(1, 1), a1 + hA, voffA);
            PG8_WAIT_L(8); PG8_BAR; PG8_WAIT_L(0); PG8_MMA(0, 0, At, B0); PG8_BAR; PG8_SCHED;
            PG8_LDB(B1, 0, 1); PG8_STAGE(PG8_SB(0, 0), b2, voffB);
            PG8_BAR; PG8_WAIT_L(0); PG8_MMA(0, 1, At, B1); PG8_BAR;
            PG8_LDA(At, 0, 1); PG8_STAGE(PG8_SA(0, 0), a2, voffA);
            PG8_BAR; PG8_WAIT_L(0); PG8_MMA(1, 0, At, B0); PG8_BAR; PG8_SCHED;
            PG8_STAGE(PG8_SB(0, 1), b2 + hB, voffB);
            PG8_WAIT_V(6); PG8_BAR; PG8_MMA(1, 1, At, B1); PG8_BAR;
            PG8_LDB(B0, 1, 0); PG8_SCHED; PG8_LDA(At, 1, 0); PG8_STAGE(PG8_SA(0, 1), a2 + hA, voffA);
            PG8_WAIT_L(8); PG8_BAR; PG8_WAIT_L(0); PG8_MMA(0, 0, At, B0); PG8_BAR; PG8_SCHED;
            PG8_LDB(B1, 1, 1); PG8_STAGE(PG8_SB(1, 0), b3, voffB);
            PG8_BAR; PG8_WAIT_L(0); PG8_MMA(0, 1, At, B1); PG8_BAR;
            PG8_LDA(At, 1, 1); PG8_STAGE(PG8_SA(1, 0), a3, voffA);
            PG8_BAR; PG8_WAIT_L(0); PG8_MMA(1, 0, At, B0); PG8_BAR; PG8_SCHED;
            PG8_STAGE(PG8_SB(1, 1), b3 + hB, voffB);
            PG8_WAIT_V(6); PG8_BAR; PG8_MMA(1, 1, At, B1); PG8_BAR;
        }
        E(acc, cur, wr, wc, fr, fq);
        if (!has_next) break;
#pragma unroll
        for (int a = 0; a < 2; ++a)
#pragma unroll
            for (int b = 0; b < 2; ++b)
#pragma unroll
                for (int m = 0; m < 4; ++m)
#pragma unroll
                    for (int n = 0; n < 2; ++n) acc[a][b][m][n] = (f32x4){0.f, 0.f, 0.f, 0.f};
        cur = nxt; cA = nA; cB = nB; ++ui;
    }
    PG8_WAIT_V(0);
    if (wr == 0) PG8_BAR;
    PG8_BAR;
#undef PG8_SA
#undef PG8_SB
#undef PG8_STAGE
#undef PG8_LDA
#undef PG8_LDB
#undef PG8_MMA
#undef PG8_WAIT_V
#undef PG8_WAIT_L
#undef PG8_BAR
#undef PG8_SCHED
}

#define EPI_LOOP(...) \
    const int row0 = u.pm * BM + wr * 64 + fr, col0 = u.pn * BM + wc * 32 + 4 * fq; \
    _Pragma("unroll") for (int ai = 0; ai < 2; ++ai) _Pragma("unroll") for (int m = 0; m < 4; ++m) { const int r = row0 + ai * HALF + m * 16; \
        _Pragma("unroll") for (int bj = 0; bj < 2; ++bj) _Pragma("unroll") for (int n = 0; n < 2; ++n) { const int c = col0 + bj * HALF + n * 16; const f32x4 v = acc[ai][bj][m][n]; __VA_ARGS__ } }

#define EPI_PROWS(...) \
    const int row0 = u.pm * BM + wr * 64 + fr, col0 = u.pn * BM + wc * 32 + 8 * fq; \
    _Pragma("unroll") for (int ai = 0; ai < 2; ++ai) _Pragma("unroll") for (int m = 0; m < 4; ++m) { const int r = row0 + ai * HALF + m * 16; __VA_ARGS__ }
__device__ __forceinline__ u32x4 pack8(const f32x4 a, const f32x4 b) { u32x4 w; w[0] = cvt_pk_bf16(a[0], a[1]); w[1] = cvt_pk_bf16(a[2], a[3]); w[2] = cvt_pk_bf16(b[0], b[1]); w[3] = cvt_pk_bf16(b[2], b[3]); return w; }
__device__ __forceinline__ unsigned q8(float x) { return (unsigned)__float2uint_rn(sigm(x) * 255.0f); }
__device__ __forceinline__ unsigned q8x4(const f32x4 v) { return q8(v[0]) | (q8(v[1]) << 8) | (q8(v[2]) << 16) | (q8(v[3]) << 24); }
struct EpiIn { static constexpr bool PERM = true; bf16_t* cols; bf16_t* ubuf;
    __device__ __forceinline__ void operator()(const f32x4 (&acc)[2][2][4][2], const Unit& u, int wr, int wc, int fr, int fq) const {
        if (u.pn >= 18 && u.pn < 42) {
            EPI_PROWS({ u32x4 w; w[0] = q8x4(acc[ai][0][m][0]); w[1] = q8x4(acc[ai][0][m][1]); w[2] = q8x4(acc[ai][1][m][0]); w[3] = q8x4(acc[ai][1][m][1]);
                *(u32x4*)((unsigned char*)(cols + (size_t)r * NINP + C_MG) + (u.pn - 18) * 256 + (wc * 4 + fq) * 16) = w; })
        } else {
            EPI_PROWS({ _Pragma("unroll") for (int bj = 0; bj < 2; ++bj) { const int c = col0 + bj * HALF;
                bf16_t* dst = (u.pn < 2) ? ubuf + ((size_t)((c >> 4) * CHP + (r >> 4)) * 512 + (r & 15) * 16 + (c & 15)) : cols + (size_t)r * NINP + c;
                *(u32x4*)dst = pack8(acc[ai][bj][m][0], acc[ai][bj][m][1]); } })
        }
    } };
struct EpiS5State { static constexpr bool PERM = false; float* st;
    __device__ __forceinline__ void operator()(const f32x4 (&acc)[2][2][4][2], const Unit& u, int wr, int wc, int fr, int fq) const {
        EPI_LOOP({ *(f32x4*)(st + ((size_t)(u.sub * CHP + r)) * 256 + c) = v; })
    } };
struct EpiS5Out { static constexpr bool PERM = true; bf16_t* zs5;
    __device__ __forceinline__ void operator()(const f32x4 (&acc)[2][2][4][2], const Unit& u, int wr, int wc, int fr, int fq) const {
        EPI_PROWS({ if (r < NCH16) { _Pragma("unroll") for (int bj = 0; bj < 2; ++bj) { const int c = col0 + bj * HALF; f32x4 a = acc[ai][bj][m][0], b2 = acc[ai][bj][m][1];
            _Pragma("unroll") for (int e = 0; e < 4; ++e) { a[e] = gelu_t(a[e]); b2[e] = gelu_t(b2[e]); }
            *(u32x4*)(zs5 + (size_t)(r * 16 + (c >> 4)) * 512 + u.sub * 16 + (c & 15)) = pack8(a, b2); } } })
    } };
#define EPI_ROWS(...) \
    const int row0 = u.pm * BM + wr * 64 + fr, col0 = u.pn * BM + wc * 32 + 4 * fq; \
    _Pragma("unroll") for (int ai = 0; ai < 2; ++ai) _Pragma("unroll") for (int m = 0; m < 4; ++m) { const int r = row0 + ai * HALF + m * 16; __VA_ARGS__ }
#define QOFF(q) (((q) >> 1) * HALF + ((q) & 1) * 16)
#define EPI_PIPE(LOADF, COMPF) \
    const int row0 = u.pm * BM + wr * 64 + fr, col0 = u.pn * BM + wc * 32 + 8 * fq; \
    LOADF(0, 0); \
    _Pragma("unroll") for (int gi = 0; gi < 8; ++gi) { if (gi + 1 < 8) { if ((gi & 1) == 0) { LOADF(gi + 1, 1); } else { LOADF(gi + 1, 0); } } if ((gi & 1) == 0) { COMPF(gi, 0); } else { COMPF(gi, 1); } }
#define GROW(gi) (row0 + ((gi) >> 2) * HALF + ((gi) & 3) * 16)
struct EpiGlu { static constexpr bool PERM = true; const bf16_t* zs5; const bf16_t* cols; const float* bglu; bf16_t* yall;
    __device__ __forceinline__ void operator()(const f32x4 (&acc)[2][2][4][2], const Unit& u, int wr, int wc, int fr, int fq) const {
        u32x4 zz[2][2], gg[2][2]; f32x4 bb[2][2];
        { const int c0 = u.pn * BM + wc * 32 + 8 * fq; _Pragma("unroll") for (int bj = 0; bj < 2; ++bj) { bb[bj][0] = *(const f32x4*)(bglu + c0 + bj * HALF); bb[bj][1] = *(const f32x4*)(bglu + c0 + bj * HALF + 4); } }
#define GLU_LOAD(gi, bf) do { const int r_ = GROW(gi); _Pragma("unroll") for (int bj = 0; bj < 2; ++bj) { const int c = col0 + bj * HALF; zz[bf][bj] = *(const u32x4*)(zs5 + (size_t)r_ * 512 + c); gg[bf][bj] = *(const u32x4*)(cols + (size_t)r_ * NINP + C_GA + c); } } while (0)
#define GLU_COMP(gi, bf) do { const int r_ = GROW(gi); _Pragma("unroll") for (int bj = 0; bj < 2; ++bj) { const int c = col0 + bj * HALF; f32x4 o[2]; \
            _Pragma("unroll") for (int hf = 0; hf < 2; ++hf) { const f32x4 v = acc[(gi) >> 2][bj][(gi) & 3][hf]; \
                o[hf][0] = bflo(zz[bf][bj][2 * hf]) * sigm(v[0] + bb[bj][hf][0]) * silu(bflo(gg[bf][bj][2 * hf])); o[hf][1] = bfhi(zz[bf][bj][2 * hf]) * sigm(v[1] + bb[bj][hf][1]) * silu(bfhi(gg[bf][bj][2 * hf])); \
                o[hf][2] = bflo(zz[bf][bj][2 * hf + 1]) * sigm(v[2] + bb[bj][hf][2]) * silu(bflo(gg[bf][bj][2 * hf + 1])); o[hf][3] = bfhi(zz[bf][bj][2 * hf + 1]) * sigm(v[3] + bb[bj][hf][3]) * silu(bfhi(gg[bf][bj][2 * hf + 1])); } \
            *(u32x4*)(yall + (size_t)r_ * D + c) = pack8(o[0], o[1]); } } while (0)
        EPI_PIPE(GLU_LOAD, GLU_COMP)
#undef GLU_LOAD
#undef GLU_COMP
    } };
__device__ __forceinline__ float ub(unsigned w, int k) { return (float)((w >> (8 * k)) & 255u) * (1.0f / 255.0f); }
struct EpiOut { static constexpr bool PERM = true; const bf16_t* cols; bf16_t* mbf;
    __device__ __forceinline__ void operator()(const f32x4 (&acc)[2][2][4][2], const Unit& u, int wr, int wc, int fr, int fq) const {
        u32x4 gg[8], mm[2][2];
        { const int row0g = u.pm * BM + wr * 64 + fr;
#pragma unroll
          for (int gi = 0; gi < 8; ++gi) gg[gi] = *(const u32x4*)((const unsigned char*)(cols + (size_t)(row0g + (gi >> 2) * HALF + (gi & 3) * 16) * NINP + C_MG) + (u.sub * 8 + u.pn) * 256 + (wc * 4 + fq) * 16); }
#define OUT_LOAD(gi, bf) do { const int r_ = GROW(gi); const bf16_t* mp = mbf + (size_t)r_ * D + col0; \
            _Pragma("unroll") for (int bj = 0; bj < 2; ++bj) { mm[bf][bj] = (u32x4){0u, 0u, 0u, 0u}; if (u.sub != 0) mm[bf][bj] = *(const u32x4*)(mp + bj * HALF); } } while (0)
#define OUT_COMP(gi, bf) do { const int r_ = GROW(gi); bf16_t* mp = mbf + (size_t)r_ * D + col0; _Pragma("unroll") for (int bj = 0; bj < 2; ++bj) { f32x4 o[2]; \
            _Pragma("unroll") for (int hf = 0; hf < 2; ++hf) { const f32x4 v = acc[(gi) >> 2][bj][(gi) & 3][hf]; const unsigned gw = gg[gi][bj * 2 + hf]; \
                o[hf][0] = bflo(mm[bf][bj][2 * hf]) + ub(gw, 0) * v[0]; o[hf][1] = bfhi(mm[bf][bj][2 * hf]) + ub(gw, 1) * v[1]; \
                o[hf][2] = bflo(mm[bf][bj][2 * hf + 1]) + ub(gw, 2) * v[2]; o[hf][3] = bfhi(mm[bf][bj][2 * hf + 1]) + ub(gw, 3) * v[3]; } \
            *(u32x4*)(mp + bj * HALF) = pack8(o[0], o[1]); } } while (0)
        EPI_PIPE(OUT_LOAD, OUT_COMP)
#undef OUT_LOAD
#undef OUT_COMP
    } };
__device__ __forceinline__ const float* src_row(const Params& p, int r);
struct EpiWo { static constexpr bool PERM = false; float* z; const Params* pp; int first;
    __device__ __forceinline__ void operator()(const f32x4 (&acc)[2][2][4][2], const Unit& u, int wr, int wc, int fr, int fq) const {
        EPI_ROWS({ if (r < NTOK) { float* zp = z + (size_t)r * D + col0; const float* rp = first ? src_row(*pp, r) + col0 : zp; f32x4 pv[4];
            _Pragma("unroll") for (int q = 0; q < 4; ++q) pv[q] = *(const f32x4*)(rp + QOFF(q));
            _Pragma("unroll") for (int q = 0; q < 4; ++q) *(f32x4*)(zp + QOFF(q)) = pv[q] + acc[ai][q >> 1][m][q & 1]; } })
    } };

__device__ __forceinline__ const float* src_row(const Params& p, int r) {
    int s, pos; if (r < 8224) { s = r / 4112; pos = r - s * 4112; } else { const int t = r - 8224; const int q = t / 2064; s = 2 + q; pos = t - q * 2064; }
    if (pos < 16) return p.in[2] + (size_t)pos * D;
    return s < 2 ? p.in[0] + ((size_t)s * 4096 + (pos - 16)) * D : p.in[1] + ((size_t)(s - 2) * 2048 + (pos - 16)) * D;
}
__device__ __forceinline__ void rmsnorm_phase(const int TID, const int BID, const Params& p, int l) {
    float* z = (float*)(p.ws + WS_Z); bf16_t* h = (bf16_t*)(p.ws + WS_H); const float* g = p.in[3] + (size_t)l * D;
    const int lane = TID & 63, gw = BID * 8 + (TID >> 6), nw = gridDim.x * 8;
    f32x4 gg[8];
#pragma unroll
    for (int i = 0; i < 8; ++i) gg[i] = *(const f32x4*)(g + (i * 64 + lane) * 4);
    f32x4 xn[8];
    { const int r0 = gw < NTOK ? gw : NTOK - 1; const float* src = (l == 0) ? src_row(p, r0) : z + (size_t)r0 * D;
#pragma unroll
      for (int i = 0; i < 8; ++i) xn[i] = *(const f32x4*)(src + (i * 64 + lane) * 4); }
    for (int r = gw; r < MP; r += nw) {
        bf16_t* hr = h + (size_t)r * D;
        f32x4 x[8];
#pragma unroll
        for (int i = 0; i < 8; ++i) x[i] = xn[i];
        { const int rn = (r + nw < NTOK) ? r + nw : NTOK - 1; const float* src = (l == 0) ? src_row(p, rn) : z + (size_t)rn * D;
#pragma unroll
          for (int i = 0; i < 8; ++i) xn[i] = *(const f32x4*)(src + (i * 64 + lane) * 4); }
        if (r >= NTOK) { for (int i = 0; i < 4; ++i) *(u32x4*)(hr + (i * 64 + lane) * 8) = (u32x4){0u, 0u, 0u, 0u}; continue; }
        float ss = 0.f;
#pragma unroll
        for (int i = 0; i < 8; ++i) ss += x[i][0] * x[i][0] + x[i][1] * x[i][1] + x[i][2] * x[i][2] + x[i][3] * x[i][3];
#pragma unroll
        for (int o = 32; o >= 1; o >>= 1) ss += __shfl_xor(ss, o);
        const float rs = rsqrtf(ss * (1.0f / D) + 1e-6f);
#pragma unroll
        for (int i = 0; i < 8; ++i) { const int c = (i * 64 + lane) * 4;
            u32x2 w; w.x = cvt_pk_bf16(x[i][0] * rs * gg[i][0], x[i][1] * rs * gg[i][1]); w.y = cvt_pk_bf16(x[i][2] * rs * gg[i][2], x[i][3] * rs * gg[i][3]); *(u32x2*)(hr + c) = w; }
    }
}
__device__ __forceinline__ void final_norm_phase(const int TID, const int BID, const Params& p) {
    const float* z = (const float*)(p.ws + WS_Z); const float* g = p.in[29];
    const int lane = TID & 63, gw = BID * 8 + (TID >> 6), nw = gridDim.x * 8;
    for (int r = gw; r < NTOK; r += nw) {
        int s, pos; if (r < 8224) { s = r / 4112; pos = r - s * 4112; } else { const int t = r - 8224; const int q = t / 2064; s = 2 + q; pos = t - q * 2064; }
        if (pos < 16) continue;
        float* dst = s < 2 ? p.out + ((size_t)s * 4096 + (pos - 16)) * D : p.out + (size_t)2 * 4096 * D + ((size_t)(s - 2) * 2048 + (pos - 16)) * D;
        const float* src = z + (size_t)r * D;
        f32x4 x[8]; float ss = 0.f;
#pragma unroll
        for (int i = 0; i < 8; ++i) { x[i] = *(const f32x4*)(src + (i * 64 + lane) * 4); ss += x[i][0] * x[i][0] + x[i][1] * x[i][1] + x[i][2] * x[i][2] + x[i][3] * x[i][3]; }
#pragma unroll
        for (int o = 32; o >= 1; o >>= 1) ss += __shfl_xor(ss, o);
        const float rs = rsqrtf(ss * (1.0f / D) + 1e-6f);
#pragma unroll
        for (int i = 0; i < 8; ++i) { const int c = (i * 64 + lane) * 4; const f32x4 gg = *(const f32x4*)(g + c); f32x4 o; o[0] = x[i][0] * rs * gg[0]; o[1] = x[i][1] * rs * gg[1]; o[2] = x[i][2] * rs * gg[2]; o[3] = x[i][3] * rs * gg[3]; *(f32x4*)(dst + c) = o; }
    }
}
__device__ __forceinline__ void conv_tile(const int TID, const float* src, int ldn, int k0, int n0, int nvalid, bf16_t* dst, int ldd, int kofs, bool mapin, LAS float* tile) {
    const int tx = TID & 63, ty = TID >> 6;
    const int ncl = (n0 + tx < nvalid) ? n0 + tx : nvalid - 1;
#pragma unroll
    for (int i = 0; i < 8; ++i) { const int k = ty + 8 * i; tile[k * 65 + tx] = src[(size_t)(k0 + k) * ldn + ncl]; }
    __syncthreads();
#pragma unroll
    for (int i = 0; i < 8; ++i) { const int nn = ty + 8 * i; int n = n0 + nn;
        if (n < nvalid) { if (mapin) n = (n < 2560) ? n : (n < 2592 ? n + (C_GLR - 2560) : n - 32); dst[(size_t)n * ldd + kofs + k0 + tx] = f2bf(tile[tx * 65 + nn]); } }
    __syncthreads();
}
__device__ __forceinline__ void convert_weights(const int TID, const int BID, const Params& p, int l, LAS float* tile) {
    const int G = gridDim.x, b = BID;
    bf16_t* btin = (bf16_t*)(p.ws + WS_BTIN); bf16_t* btout = (bf16_t*)(p.ws + WS_BTOUT); bf16_t* bto = (bf16_t*)(p.ws + WS_BTO); bf16_t* btglu = (bf16_t*)(p.ws + WS_BTGLU); bf16_t* btlru = (bf16_t*)(p.ws + WS_BTLRU);
    { const float* src = p.in[4] + (size_t)l * D * NIN; const int tx = TID & 63, ty = TID >> 6; float v[8];
      { const int t = b < 32 * 169 ? b : 0; const int kt = t / 169, ntl = t - kt * 169; const int ncl = (ntl * 64 + tx < NIN) ? ntl * 64 + tx : NIN - 1;
#pragma unroll
        for (int i = 0; i < 8; ++i) v[i] = src[(size_t)(kt * 64 + ty + 8 * i) * NIN + ncl]; }
      for (int t = b; t < 32 * 169; t += G) { const int kt = t / 169, ntl = t - kt * 169, k0 = kt * 64, n0 = ntl * 64;
#pragma unroll
          for (int i = 0; i < 8; ++i) tile[(ty + 8 * i) * 65 + tx] = v[i];
          { const int tn = (t + G < 32 * 169) ? t + G : t; const int ktn = tn / 169, ntn = tn - ktn * 169; const int ncl = (ntn * 64 + tx < NIN) ? ntn * 64 + tx : NIN - 1;
#pragma unroll
            for (int i = 0; i < 8; ++i) v[i] = src[(size_t)(ktn * 64 + ty + 8 * i) * NIN + ncl]; }
          LBAR();
#pragma unroll
          for (int i = 0; i < 8; ++i) { const int nn = ty + 8 * i; int n = n0 + nn;
              if (n < NIN) { n = (n < 2560) ? n : (n < 2592 ? n + (C_GLR - 2560) : n - 32); btin[(size_t)n * D + k0 + tx] = f2bf(tile[tx * 65 + nn]); } }
          LBAR(); } }
    for (size_t i = (size_t)b * 512 + TID; i < (size_t)(NINP - NIN) * D / 8; i += (size_t)G * 512) *(u32x4*)(btin + (size_t)NIN * D + i * 8) = (u32x4){0u, 0u, 0u, 0u};
    { const float* src = p.in[25] + (size_t)l * 512 * D; for (int t = (b + 64) % G; t < 8 * 32; t += G) { const int kt = t / 32, ntl = t - kt * 32; conv_tile(TID, src, D, kt * 64, ntl * 64, D, btout, D, 0, false, tile); } }
    { const float* src = p.in[26] + (size_t)l * 512 * D; for (int t = (b + 128) % G; t < 8 * 32; t += G) { const int kt = t / 32, ntl = t - kt * 32; conv_tile(TID, src, D, kt * 64, ntl * 64, D, btout, D, 512, false, tile); } }
    { const float* src = p.in[27] + (size_t)l * 1024 * D; for (int t = b; t < 16 * 32; t += G) { const int kt = t / 32, ntl = t - kt * 32; conv_tile(TID, src, D, kt * 64, ntl * 64, D, btout, D, 1024, false, tile); } }
    { const float* src = p.in[28] + (size_t)l * D * D; for (int t = b; t < 32 * 32; t += G) { const int kt = t / 32, ntl = t - kt * 32; conv_tile(TID, src, D, kt * 64, ntl * 64, D, bto, D, 0, false, tile); } }
    { const float* src = p.in[13] + (size_t)l * 512 * 512; for (int t = (b + 192) % G; t < 8 * 8; t += G) { const int kt = t / 8, ntl = t - kt * 8; conv_tile(TID, src, 512, kt * 64, ntl * 64, 512, btglu, 512, 0, false, tile); } }
    for (int t = (b + 32) % G; t < 128; t += G) { const int mat = t >> 2, sub = t & 3;
        const int dk = mat >> 3, nb = mat & 7, d = dk >> 1, kind = dk & 1;
        const float* src = p.in[kind ? 22 : 20] + ((size_t)(l * 2 + d) * 8 + nb) * 128 * 128;
        conv_tile(TID, src, 128, (sub >> 1) * 64, (sub & 1) * 64, 128, btlru + (size_t)mat * 128 * 128, 128, 0, false, tile); }
}
__device__ __forceinline__ double exp_small(double x) { double s = 1.0, t = 1.0; for (int i = 1; i <= 14; ++i) { t *= x / (double)i; s += t; } return s; }
__device__ __forceinline__ double exp_neg(double x) { double e = exp_small(x * (1.0 / 64.0)); for (int i = 0; i < 6; ++i) e *= e; return e; }
__device__ __forceinline__ void s5_tables_all(const int TID, const int BID, const Params& p) {
    for (int vidx = (int)(gridDim.x - 1 - BID) * 512 + TID; vidx < 4 * 4096; vidx += gridDim.x * 512) {
        const int l = vidx >> 12, idx = vidx & 4095;
        f32x2* pw = (f32x2*)(p.ws + WS_PW) + l * PWL; f32x2* bbar = (f32x2*)(p.ws + WS_BBAR) + l * BBL;
        const int g = idx >> 7, d = (idx >> 6) & 1, n = idx & 63;
        const double dt = exp_neg((double)p.in[7][(l * 2 + d) * 32 + g]);
        const double lr = (double)p.in[5][((size_t)(l * 2 + d) * 32 + g) * 64 + n], li = (double)p.in[6][((size_t)(l * 2 + d) * 32 + g) * 64 + n];
        const double mag = exp_neg(lr * dt);
        double ang = li * dt; const double twopi = 6.283185307179586476925287; ang -= twopi * rint(ang / twopi);
        const double a8 = ang * 0.125, a2 = a8 * a8;
        double sn = a8, cs = 1.0, ts = a8, tc = 1.0;
        for (int i = 1; i <= 9; ++i) { tc *= -a2 / (double)((2 * i - 1) * (2 * i)); cs += tc; ts *= -a2 / (double)((2 * i) * (2 * i + 1)); sn += ts; }
        for (int i = 0; i < 3; ++i) { const double c2 = cs * cs - sn * sn, s2 = 2.0 * cs * sn; cs = c2; sn = s2; }
        const double abr = mag * cs, abi = mag * sn;
        double pr = 1.0, pi = 0.0;
        for (int j = 0; j <= 16; ++j) { pw[((size_t)(g * 2 + d) * 17 + j) * 64 + n] = (f32x2){(float)pr, (float)pi}; const double nr = pr * abr - pi * abi, ni = pr * abi + pi * abr; pr = nr; pi = ni; }
        const double den = lr * lr + li * li, fr = ((abr - 1.0) * lr + abi * li) / den, fi = (abi * lr - (abr - 1.0) * li) / den;
        float brf[16], bif[16];
#pragma unroll
        for (int c4 = 0; c4 < 4; ++c4) { const f32x4 t0 = *(const f32x4*)(p.in[8] + (((size_t)l * 32 + g) * 64 + n) * 16 + c4 * 4), t1 = *(const f32x4*)(p.in[9] + (((size_t)l * 32 + g) * 64 + n) * 16 + c4 * 4);
#pragma unroll
            for (int e = 0; e < 4; ++e) { brf[c4 * 4 + e] = t0[e]; bif[c4 * 4 + e] = t1[e]; } }
#pragma unroll
        for (int c = 0; c < 16; ++c) { const double br = (double)brf[c], bi = (double)bif[c];
            bbar[((size_t)(g * 2 + d) * 64 + n) * 16 + c] = (f32x2){(float)(fr * br - fi * bi), (float)(fr * bi + fi * br)}; }
    }
}
__device__ __forceinline__ float s5_kval(const float* cre, const float* cim, const f32x2* pw, const f32x2* bbar, int l, int g, int d, int j, int c, int cp) {
    const float* cr = cre + (((size_t)(l * 2 + d) * 32 + g) * 16 + c) * 64; const float* ci = cim + (((size_t)(l * 2 + d) * 32 + g) * 16 + c) * 64;
    const f32x2* pp = pw + ((size_t)(g * 2 + d) * 17 + j) * 64; const f32x2* bb = bbar + ((size_t)(g * 2 + d) * 64) * 16 + cp;
    float s = 0.f;
#pragma unroll 16
    for (int n = 0; n < 64; ++n) { const f32x2 pv = pp[n]; const f32x2 bv = bb[(size_t)n * 16]; const float er = cr[n] * pv.x - ci[n] * pv.y, ei = cr[n] * pv.y + ci[n] * pv.x; s += er * bv.x - ei * bv.y; }
    return s;
}
__device__ __forceinline__ void s5_assemble_a(const int TID, const int BID, const Params& p, int l) {
    const f32x2* pw = (const f32x2*)(p.ws + WS_PW) + l * PWL; const f32x2* bbar = (const f32x2*)(p.ws + WS_BBAR) + l * BBL;
    float* kmat = (float*)(p.ws + WS_KMAT); bf16_t* pmat = (bf16_t*)(p.ws + WS_PMAT);
    const float* cre = p.in[10]; const float* cim = p.in[11];
    const size_t stride = (size_t)gridDim.x * 512;
    for (size_t idx = (size_t)BID * 512 + TID; idx < (size_t)32 * 2 * 16 * 256; idx += stride) {
        const int g = (int)(idx >> 13), d = (int)(idx >> 12) & 1, j = (int)(idx >> 8) & 15, c = (int)(idx >> 4) & 15, cp = (int)idx & 15;
        kmat[idx] = s5_kval(cre, cim, pw, bbar, l, g, d, j, c, cp);
    }
    for (size_t idx = (size_t)BID * 512 + TID; idx < (size_t)32 * 256 * 256; idx += stride) {
        const int g = (int)(idx >> 16), nout = (int)(idx >> 8) & 255, k = (int)idx & 255, d = nout >> 7, ri = (nout >> 6) & 1, n = nout & 63, s = k >> 4, cp = k & 15, j = d == 0 ? 15 - s : s;
        const f32x2 pv = pw[((size_t)(g * 2 + d) * 17 + j) * 64 + n]; const f32x2 bv = bbar[((size_t)(g * 2 + d) * 64 + n) * 16 + cp];
        pmat[idx] = f2bf(ri == 0 ? pv.x * bv.x - pv.y * bv.y : pv.x * bv.y + pv.y * bv.x);
    }
}
__device__ __forceinline__ void s5_assemble_w(const int TID, const int BID, const Params& p, int l) {
    const f32x2* pw = (const f32x2*)(p.ws + WS_PW) + l * PWL; const float* kmat = (const float*)(p.ws + WS_KMAT);
    bf16_t* wmat = (bf16_t*)(p.ws + WS_WMAT);
    const float* cre = p.in[10]; const float* cim = p.in[11];
    const size_t stride = (size_t)gridDim.x * 512;
    for (size_t idx = (size_t)BID * 512 + TID; idx < (size_t)32 * 256 * 512; idx += stride) {
        const int g = (int)(idx >> 17), nout = (int)(idx >> 9) & 255, k = (int)idx & 511, t = nout >> 4, c = nout & 15;
        float val;
        if (k < 256) { const int s = k >> 4, cp = k & 15; val = 0.f;
            const int jf = s <= t ? t - s : 0, jb = s >= t ? s - t : 0;
            const float kf = kmat[((((size_t)g * 2 + 0) * 16 + jf) * 16 + c) * 16 + cp], kb = kmat[((((size_t)g * 2 + 1) * 16 + jb) * 16 + c) * 16 + cp], dsk = p.in[12][l * 512 + g * 16 + c];
            val = (s <= t ? kf : 0.f) + (s >= t ? kb : 0.f) + ((s == t && c == cp) ? dsk : 0.f);
        } else { const int kk = k - 256, d = kk >> 7, ri = (kk >> 6) & 1, n = kk & 63, j = d == 0 ? t + 1 : 16 - t;
            const float cr = cre[(((size_t)(l * 2 + d) * 32 + g) * 16 + c) * 64 + n], ci = cim[(((size_t)(l * 2 + d) * 32 + g) * 16 + c) * 64 + n];
            const f32x2 pv = pw[((size_t)(g * 2 + d) * 17 + j) * 64 + n];
            val = ri == 0 ? cr * pv.x - ci * pv.y : -(cr * pv.y + ci * pv.x); }
        wmat[idx] = f2bf(val);
    }
}

__device__ __forceinline__ void scans_phase(const int TID, const int BID, const Params& p, const int l, const bool do_gla) {
    const int G = gridDim.x;
    const bool split = (G == 256);
    {
        const f32x2* pw = (const f32x2*)(p.ws + WS_PW) + l * PWL; const float* st = (const float*)(p.ws + WS_ST); bf16_t* ub = (bf16_t*)(p.ws + WS_UBUF);
        for (int idx = BID * 512 + TID; idx < 40960; idx += G * 512) {
            const int seq = idx >> 12, rem = idx & 4095, g = rem >> 7, d = (rem >> 6) & 1, n = rem & 63;
            const int ch0 = seq < 2 ? seq * 257 : 514 + (seq - 2) * 129, nc = seq < 2 ? 257 : 129;
            const f32x2 a16 = pw[((size_t)(g * 2 + d) * 17 + 16) * 64 + n];
            float sr = 0.f, si = 0.f;
            for (int s0 = 0; s0 < nc; s0 += 32) {
                float lr[32], li[32];
#pragma unroll
                for (int i = 0; i < 32; ++i) { const int step = s0 + i; lr[i] = 0.f; li[i] = 0.f;
                    { const int sc = step < nc ? step : nc - 1; const int c = d == 0 ? sc : nc - 1 - sc; const size_t row = (size_t)g * CHP + ch0 + c; lr[i] = st[row * 256 + d * 128 + n]; li[i] = st[row * 256 + d * 128 + 64 + n]; } }
#pragma unroll
                for (int i = 0; i < 32; ++i) { const int step = s0 + i;
                    if (step < nc) { const int c = d == 0 ? step : nc - 1 - step; const size_t row = (size_t)g * CHP + ch0 + c;
                        ub[row * 512 + 256 + d * 128 + n] = f2bf(sr); ub[row * 512 + 256 + d * 128 + 64 + n] = f2bf(si);
                        const float nr = a16.x * sr - a16.y * si + lr[i], ni = a16.x * si + a16.y * sr + li[i]; sr = nr; si = ni; } }
            }
        }
    }
    {
        const float* la = (const float*)(p.ws + WS_LRUA); const float* lh = (const float*)(p.ws + WS_LRUH); float* lc = (float*)(p.ws + WS_LRUC);
        const int vb0 = split ? BID - 80 : BID, vstride = split ? 1 << 20 : G;
        for (int vb = vb0; vb >= 0 && vb < 40; vb += vstride) {
            const int idx = vb * 512 + TID;
            const int seq = idx >> 11, d = (idx >> 10) & 1, ch = idx & 1023;
            const int cb = seq < 2 ? seq * 65 : 130 + (seq - 2) * 33, nc = seq < 2 ? 65 : 33;
            float cin = 0.f;
            for (int s0 = 0; s0 < nc; s0 += 16) {
                float A[16], H[16];
#pragma unroll
                for (int i = 0; i < 16; ++i) { const int step = s0 + i; A[i] = 1.f; H[i] = 0.f;
                    { const int sc = step < nc ? step : nc - 1; const int ci = cb + (d == 0 ? sc : nc - 1 - sc); const size_t o = ((size_t)ci * 2 + d) * 1024 + ch; A[i] = la[o]; H[i] = lh[o]; } }
#pragma unroll
                for (int i = 0; i < 16; ++i) { const int step = s0 + i;
                    if (step < nc) { const int ci = cb + (d == 0 ? step : nc - 1 - step); const size_t o = ((size_t)ci * 2 + d) * 1024 + ch; lc[o] = cin; cin = A[i] * cin + H[i]; } }
            }
        }
    }
    if (do_gla) {
        float* ds = (float*)(p.ws + WS_DS); const float* dec = (const float*)(p.ws + WS_DECAY);
        for (int it = 0; ; ++it) {
            int vb;
            if (split) { if (BID >= 120) { if (it >= 8) break; vb = (BID - 120) + 136 * it; } else { vb = 1088 + BID + 120 * it; if (vb >= 1280) break; } }
            else { vb = BID + G * it; if (vb >= 1280) break; }
            const int e = vb * 512 + TID;
            const int seq = e >> 16, rem = e & 65535, head = rem >> 14, d = (rem >> 13) & 1, el = rem & 8191, kk = el & 63;
            const int cb = seq < 2 ? seq * 65 : 130 + (seq - 2) * 33, nc = seq < 2 ? 65 : 33;
            float S = 0.f;
            for (int s0 = 0; s0 < nc; s0 += 16) {
                float tm[16], dc[16];
#pragma unroll
                for (int i = 0; i < 16; ++i) { const int step = s0 + i; tm[i] = 0.f; dc[i] = 1.f;
                    { const int sc = step < nc ? step : nc - 1; const int ci = cb + (d == 0 ? sc : nc - 1 - sc); const size_t o = ((size_t)(ci * 4 + head) * 2 + d); tm[i] = ds[o * 8192 + el]; dc[i] = dec[o * 64 + kk]; } }
#pragma unroll
                for (int i = 0; i < 16; ++i) { const int step = s0 + i;
                    if (step < nc) { const int ci = cb + (d == 0 ? step : nc - 1 - step); const size_t o = ((size_t)(ci * 4 + head) * 2 + d); ds[o * 8192 + el] = S; S = dc[i] * S + tm[i]; } }
            }
        }
    }
}

__device__ __forceinline__ f32x4 mma_lds(f32x4 acc, const LAS bf16_t* A, const LAS bf16_t* B, int ld, int nks, int lane) {
    const LAS bf16_t* ap = A + (lane & 15) * ld + (lane >> 4) * 8; const LAS bf16_t* bp = B + (lane & 15) * ld + (lane >> 4) * 8;
    for (int ks = 0; ks < nks; ++ks) acc = __builtin_amdgcn_mfma_f32_16x16x32_bf16(*(const LAS bf16x8*)(ap + ks * 32), *(const LAS bf16x8*)(bp + ks * 32), acc, 0, 0, 0);
    return acc;
}
constexpr int GL_GLR = 0, GL_BF = 16384, GL_BB = 32768, GL_OS = 0, GL_QE0 = 49152, GL_QE1 = 58368, GL_KE0 = 67584, GL_KE1 = 76800, GL_VT = 86016, GL_ATT = 104448, GL_SP0 = 113664, GL_SP1 = 132096;
constexpr int GLD = 72;
template <int MODE>
__device__ __forceinline__ void gla_item(const int TID, const Params& p, int l, int ci, int head, LAS unsigned char* lds, const float (&wg)[2][16], const float (&bg)[2], const float (&ngv)[16]) {
    const int tid = TID, lane = tid & 63, wid = tid >> 6;
    const bf16_t* cols = (const bf16_t*)(p.ws + WS_COLS);
    int seq, c; chunk_info(ci, seq, c);
    const int tok0 = seq_start(seq) + (c == 0 ? -48 : 16 + 64 * (c - 1));
    const int rmin = (c == 0) ? 48 : 0;
    LAS float* glr_s = (LAS float*)(lds + GL_GLR); LAS float* bfs = (LAS float*)(lds + GL_BF); LAS float* bbs = (LAS float*)(lds + GL_BB);
    f32x4 gbv[4];
    if (MODE == 1) { const float* gb = (const float*)(p.ws + WS_GB) + (size_t)(ci * 4 + head) * 8192;
#pragma unroll
      for (int i = 0; i < 4; ++i) gbv[i] = *(const f32x4*)(gb + (i * 512 + tid) * 4); }
    u32x4 kw = (u32x4){0u, 0u, 0u, 0u}, qw = kw, vwp[2], gwp[2];
    { const int r = tid >> 3, k8 = (tid & 7) * 8; const int rc = r >= rmin ? r : rmin; const bf16_t* rowp = cols + (size_t)(tok0 + rc) * NINP;
      kw = *(const u32x4*)(rowp + C_K + head * 64 + k8); if (MODE == 1) qw = *(const u32x4*)(rowp + C_Q + head * 64 + k8);
#pragma unroll
      for (int hh = 0; hh < 2; ++hh) { vwp[hh] = *(const u32x4*)(rowp + C_V + head * 128 + ((tid & 7) + 8 * hh) * 8); if (MODE == 1) gwp[hh] = *(const u32x4*)(rowp + C_GB + head * 128 + (tid & 7) * 16 + hh * 8); } }
    if (MODE == 0) {
    { const int r = tid >> 3, j4 = (tid & 7) * 4; f32x4 v = (f32x4){0.f, 0.f, 0.f, 0.f};
      { const int rc = r >= rmin ? r : rmin; const u32x2 w = *(const u32x2*)(cols + (size_t)(tok0 + rc) * NINP + C_GLR + j4); if (r >= rmin) { v[0] = bflo(w.x); v[1] = bfhi(w.x); v[2] = bflo(w.y); v[3] = bfhi(w.y); } }
      *(LAS f32x4*)(glr_s + r * 32 + j4) = v; }
    __syncthreads();
    { const int kk = tid & 63, rb = tid >> 6;
#pragma unroll
      for (int i = 0; i < 8; ++i) { const int r = rb + 8 * i; float x0 = bg[0], x1 = bg[1]; f32x4 gr[8];
#pragma unroll
          for (int j4 = 0; j4 < 8; ++j4) gr[j4] = *(const LAS f32x4*)(glr_s + r * 32 + j4 * 4);
#pragma unroll
          for (int j = 0; j < 16; ++j) { x0 += gr[j >> 2][j & 3] * wg[0][j]; x1 += gr[4 + (j >> 2)][j & 3] * wg[1][j]; }
          const bool ok = r >= rmin; bfs[r * 64 + kk] = ok ? logsig(x0) * 0.0625f : 0.f; bbs[r * 64 + kk] = ok ? logsig(x1) * 0.0625f : 0.f; } }
    __syncthreads();
    { const int col = tid & 127, part = tid >> 7, d = col >> 6, kk = col & 63; LAS float* bs = d ? bbs : bfs; LAS float* tot = glr_s;
      float v[16];
#pragma unroll
      for (int i = 0; i < 16; ++i) v[i] = bs[(part * 16 + i) * 64 + kk];
      if (d == 0) {
#pragma unroll
          for (int i = 1; i < 16; ++i) v[i] += v[i - 1];
          tot[part * 128 + col] = v[15]; }
      else {
#pragma unroll
          for (int i = 14; i >= 0; --i) v[i] += v[i + 1];
          tot[part * 128 + col] = v[0]; }
      __syncthreads();
      float off = 0.f;
#pragma unroll
      for (int pp = 0; pp < 4; ++pp) { const float t = tot[pp * 128 + col]; if (d == 0 ? pp < part : pp > part) off += t; }
#pragma unroll
      for (int i = 0; i < 16; ++i) bs[(part * 16 + i) * 64 + kk] = v[i] + off; }
    __syncthreads();
    { float* gb = (float*)(p.ws + WS_GB) + (size_t)(ci * 4 + head) * 8192;
#pragma unroll
      for (int i = 0; i < 4; ++i) { const int e = (i * 512 + tid) * 4; *(f32x4*)(gb + e) = *(const LAS f32x4*)(bfs + e); } }
    } else {
      __syncthreads();
#pragma unroll
      for (int i = 0; i < 4; ++i) { const int e = (i * 512 + tid) * 4; *(LAS f32x4*)(bfs + e) = gbv[i]; }
      __syncthreads();
    }
    LAS bf16_t* vT = (LAS bf16_t*)(lds + GL_VT);
    { const int r = tid >> 3, k8 = (tid & 7) * 8; const bool ok = r >= rmin;
      if (!ok) { kw = (u32x4){0u, 0u, 0u, 0u}; qw = kw; }
      float qv[8], kv[8];
#pragma unroll
      for (int i = 0; i < 4; ++i) { qv[2 * i] = bflo(qw[i]); qv[2 * i + 1] = bfhi(qw[i]); kv[2 * i] = bflo(kw[i]); kv[2 * i + 1] = bfhi(kw[i]); }
      if (MODE == 0) { LAS bf16_t* kd0 = (LAS bf16_t*)(lds + GL_QE0); LAS bf16_t* kd1 = (LAS bf16_t*)(lds + GL_QE1);
#pragma unroll
          for (int i = 0; i < 8; ++i) { const int kk = k8 + i; kd0[kk * GLD + r] = f2bf(kv[i] * __expf(bfs[63 * 64 + kk] - bfs[r * 64 + kk])); kd1[kk * GLD + r] = f2bf(kv[i] * __expf(bbs[kk] - bbs[r * 64 + kk])); }
      } else { LAS bf16_t* qe0 = (LAS bf16_t*)(lds + GL_QE0); LAS bf16_t* qe1 = (LAS bf16_t*)(lds + GL_QE1); LAS bf16_t* ke0 = (LAS bf16_t*)(lds + GL_KE0); LAS bf16_t* ke1 = (LAS bf16_t*)(lds + GL_KE1);
          u32x4 a, b2, c2, d2;
#pragma unroll
          for (int i = 0; i < 4; ++i) { const int kk = k8 + 2 * i; const float f0 = bfs[r * 64 + kk], f1 = bfs[r * 64 + kk + 1], g0 = bbs[r * 64 + kk], g1 = bbs[r * 64 + kk + 1];
              a[i] = cvt_pk_bf16(qv[2 * i] * 0.125f * __expf(f0), qv[2 * i + 1] * 0.125f * __expf(f1)); b2[i] = cvt_pk_bf16(qv[2 * i] * 0.125f * __expf(g0), qv[2 * i + 1] * 0.125f * __expf(g1));
              c2[i] = cvt_pk_bf16(kv[2 * i] * __expf(-f0), kv[2 * i + 1] * __expf(-f1)); d2[i] = cvt_pk_bf16(kv[2 * i] * __expf(-g0), kv[2 * i + 1] * __expf(-g1)); }
          *(LAS u32x4*)(qe0 + r * GLD + k8) = a; *(LAS u32x4*)(qe1 + r * GLD + k8) = b2; *(LAS u32x4*)(ke0 + r * GLD + k8) = c2; *(LAS u32x4*)(ke1 + r * GLD + k8) = d2; }
#pragma unroll
      for (int hh = 0; hh < 2; ++hh) { const int v8 = ((tid & 7) + 8 * hh) * 8; u32x4 vw = (u32x4){0u, 0u, 0u, 0u};
          if (ok) vw = vwp[hh];
#pragma unroll
          for (int i = 0; i < 4; ++i) { vT[(v8 + 2 * i) * GLD + r] = (bf16_t)(vw[i] & 0xffffu); vT[(v8 + 2 * i + 1) * GLD + r] = (bf16_t)(vw[i] >> 16); } }
    }
    if (MODE == 1) {
        const float* ds = (const float*)(p.ws + WS_DS); f32x4 sv[2][4];
#pragma unroll
        for (int d = 0; d < 2; ++d) { const float* src = ds + ((size_t)(ci * 4 + head) * 2 + d) * 8192;
#pragma unroll
            for (int i = 0; i < 4; ++i) sv[d][i] = *(const f32x4*)(src + (i * 512 + tid) * 4); }
#pragma unroll
        for (int d = 0; d < 2; ++d) { LAS bf16_t* sp = (LAS bf16_t*)(lds + (d ? GL_SP1 : GL_SP0));
#pragma unroll
            for (int i = 0; i < 4; ++i) { const int e = (i * 512 + tid) * 4; const f32x4 v = sv[d][i]; u32x2 w; w.x = cvt_pk_bf16(v[0], v[1]); w.y = cvt_pk_bf16(v[2], v[3]); *(LAS u32x2*)(sp + (e >> 6) * GLD + (e & 63)) = w; } }
    }
    __syncthreads();
    if (MODE == 0) {
        float* ds = (float*)(p.ws + WS_DS); float* dec = (float*)(p.ws + WS_DECAY);
        if (tid < 128) { const int d = tid >> 6, kk = tid & 63; dec[((size_t)(ci * 4 + head) * 2 + d) * 64 + kk] = __expf(d == 0 ? bfs[63 * 64 + kk] : bbs[kk]); }
#pragma unroll
        for (int d = 0; d < 2; ++d) { const LAS bf16_t* kd = (const LAS bf16_t*)(lds + (d ? GL_QE1 : GL_QE0)); float* dst = ds + ((size_t)(ci * 4 + head) * 2 + d) * 8192;
            for (int kt = 0; kt < 4; ++kt) { f32x4 acc = (f32x4){0.f, 0.f, 0.f, 0.f}; acc = mma_lds(acc, vT + wid * 16 * GLD, kd + kt * 16 * GLD, GLD, 2, lane);
#pragma unroll
                for (int j = 0; j < 4; ++j) dst[(wid * 16 + (lane >> 4) * 4 + j) * 64 + kt * 16 + (lane & 15)] = acc[j]; } }
        __syncthreads();
        return;
    }
    const LAS bf16_t* qe0 = (const LAS bf16_t*)(lds + GL_QE0); const LAS bf16_t* qe1 = (const LAS bf16_t*)(lds + GL_QE1); const LAS bf16_t* ke0 = (const LAS bf16_t*)(lds + GL_KE0); const LAS bf16_t* ke1 = (const LAS bf16_t*)(lds + GL_KE1);
    LAS bf16_t* att = (LAS bf16_t*)(lds + GL_ATT);
    { const int it = wid >> 1;
#pragma unroll
      for (int t2 = 0; t2 < 2; ++t2) { const int jt = (wid & 1) * 2 + t2; f32x4 af = (f32x4){0.f, 0.f, 0.f, 0.f}, ab = af;
          af = mma_lds(af, qe0 + it * 16 * GLD, ke0 + jt * 16 * GLD, GLD, 2, lane); ab = mma_lds(ab, qe1 + it * 16 * GLD, ke1 + jt * 16 * GLD, GLD, 2, lane);
#pragma unroll
          for (int j = 0; j < 4; ++j) { const int i_ = it * 16 + (lane >> 4) * 4 + j, j_ = jt * 16 + (lane & 15); att[i_ * GLD + j_] = f2bf((j_ <= i_ ? af[j] : 0.f) + (j_ >= i_ ? ab[j] : 0.f)); } } }
    __syncthreads();
    LAS float* os = (LAS float*)(lds + GL_OS);
    { const int it = wid >> 1; const LAS bf16_t* sp0 = (const LAS bf16_t*)(lds + GL_SP0); const LAS bf16_t* sp1 = (const LAS bf16_t*)(lds + GL_SP1);
#pragma unroll
      for (int t4 = 0; t4 < 4; ++t4) { const int vt = (wid & 1) * 4 + t4; f32x4 acc = (f32x4){0.f, 0.f, 0.f, 0.f};
          acc = mma_lds(acc, att + it * 16 * GLD, vT + vt * 16 * GLD, GLD, 2, lane); acc = mma_lds(acc, qe0 + it * 16 * GLD, sp0 + vt * 16 * GLD, GLD, 2, lane); acc = mma_lds(acc, qe1 + it * 16 * GLD, sp1 + vt * 16 * GLD, GLD, 2, lane);
#pragma unroll
          for (int j = 0; j < 4; ++j) os[(it * 16 + (lane >> 4) * 4 + j) * 132 + vt * 16 + (lane & 15)] = acc[j]; } }
    __syncthreads();
    { const int r = tid >> 3, v0 = (tid & 7) * 16; float o[16]; float ss = 0.f;
#pragma unroll
      for (int i = 0; i < 16; ++i) { o[i] = os[r * 132 + v0 + i]; ss += o[i] * o[i]; }
      ss += __shfl_xor(ss, 1); ss += __shfl_xor(ss, 2); ss += __shfl_xor(ss, 4);
      const float rs = rsqrtf(ss * (1.0f / 128.0f) + 1e-6f);
      if (r >= rmin) { const size_t tok = (size_t)(tok0 + r); bf16_t* yall = (bf16_t*)(p.ws + WS_YALL);
#pragma unroll
          for (int hh = 0; hh < 2; ++hh) { const u32x4 gw = gwp[hh]; u32x4 w;
#pragma unroll
              for (int i = 0; i < 4; ++i) { const int e = hh * 8 + 2 * i; w[i] = cvt_pk_bf16(o[e] * rs * ngv[e] * silu(bflo(gw[i])), o[e + 1] * rs * ngv[e + 1] * silu(bfhi(gw[i]))); }
              *(u32x4*)(yall + tok * D + 512 + head * 128 + v0 + hh * 8) = w; } } }
    __syncthreads();
}

__device__ __forceinline__ float softplus_neg(float lam) { const float e = __expf(-lam); return lam + 0.f < -8.f ? -lam : (e < 0.02f ? e * (1.0f - e * (0.5f - e * (1.0f / 3.0f))) : __logf(1.0f + e)); }
__device__ __forceinline__ float one_minus_exp(float x) {
    return x > -0.5f ? -x * (1.0f + x * 0.5f * (1.0f + x * (1.0f / 3.0f) * (1.0f + x * 0.25f * (1.0f + x * 0.2f * (1.0f + x * (1.0f / 6.0f) * (1.0f + x * (1.0f / 7.0f))))))) : 1.0f - __expf(x);
}
template <int MODE>
__device__ __forceinline__ void lru_phase(const int TID, const int b, const int G, const Params& p, int l, LAS unsigned char* lds) {
    const int tid = TID, lane = tid & 63, wid = tid >> 6, q = lane >> 4;
    const bf16_t* cols = (const bf16_t*)(p.ws + WS_COLS);
    int it = b; if (it >= NCK * 8) return;
    const int nb = b & 7;
    LAS bf16_t* xcA = (LAS bf16_t*)lds; LAS float* xcf = (LAS float*)(lds + 17408);
    const int ch = tid & 127, rb = tid >> 7, gchc = nb * 128 + ch;
    const float w0 = p.in[18][(l * 4 + 0) * 1024 + gchc], w1 = p.in[18][(l * 4 + 1) * 1024 + gchc], w2 = p.in[18][(l * 4 + 2) * 1024 + gchc], w3 = p.in[18][(l * 4 + 3) * 1024 + gchc], cb = p.in[19][l * 1024 + gchc];
    const int chl = wid * 16 + (lane & 15), gch = nb * 128 + chl;
    float ba[2], bx[2], sp8[2];
#pragma unroll
    for (int d = 0; d < 2; ++d) { ba[d] = p.in[21][(l * 2 + d) * 1024 + gch]; bx[d] = p.in[23][(l * 2 + d) * 1024 + gch]; sp8[d] = 8.0f * softplus_neg(p.in[24][(l * 2 + d) * 1024 + gch]); }
    bf16x8 bfr[4][4];
    { const bf16_t* bt = (const bf16_t*)(p.ws + WS_BTLRU);
#pragma unroll
      for (int mat = 0; mat < 4; ++mat)
#pragma unroll
          for (int ks = 0; ks < 4; ++ks) bfr[mat][ks] = *(const bf16x8*)(bt + ((size_t)(mat * 8 + nb) * 128 + wid * 16 + (lane & 15)) * 128 + ks * 32 + q * 8); }
    bf16_t xr[19];
    { int seq, c; chunk_info(it >> 3, seq, c); const int s0 = seq_start(seq), L = seq_len(seq), pos0 = (c == 0 ? -48 : 16 + 64 * (c - 1));
      const bf16_t* xb = cols + (size_t)s0 * NINP + C_XC + gchc;
#pragma unroll
      for (int i = 0; i < 19; ++i) { const int pos = pos0 + rb * 16 - 2 + i; const int pc = pos < 0 ? 0 : (pos < L ? pos : L - 1); xr[i] = xb[(size_t)pc * NINP]; } }
    for (; it < NCK * 8; it += G) {
        const int ci = it >> 3;
        int seq, c; chunk_info(ci, seq, c);
        const int s0 = seq_start(seq);
        const int pos0 = (c == 0 ? -48 : 16 + 64 * (c - 1));
        const int rmin = (c == 0) ? 48 : 0;
        float xv[19];
        { const int L = seq_len(seq);
#pragma unroll
          for (int i = 0; i < 19; ++i) { const int pos = pos0 + rb * 16 - 2 + i; xv[i] = (pos >= 0 && pos < L) ? bf2f(xr[i]) : 0.f; } }
#pragma unroll
        for (int i = 0; i < 16; ++i) { const int r = rb * 16 + i; const float xc = (r >= rmin) ? cb + xv[i] * w0 + xv[i + 1] * w1 + xv[i + 2] * w2 + xv[i + 3] * w3 : 0.f;
            xcf[r * 132 + ch] = xc; xcA[r * 136 + ch] = f2bf(xc); }
        u32x4 gq[2]; float cin[2];
        if (MODE == 1) {
#pragma unroll
            for (int d = 0; d < 2; ++d) cin[d] = ((const float*)(p.ws + WS_LRUC))[((size_t)ci * 2 + d) * 1024 + gch];
            { const int r = tid >> 3; const int rr = r >= rmin ? r : rmin; const bf16_t* gp = cols + (size_t)(s0 + pos0 + rr) * NINP + C_GC + nb * 128 + (tid & 7) * 16;
              gq[0] = *(const u32x4*)gp; gq[1] = *(const u32x4*)(gp + 8); }
        }
        { const int itn = it + G;
          if (itn < NCK * 8) { int seqn, cn; chunk_info(itn >> 3, seqn, cn); const int s0n = seq_start(seqn), Ln = seq_len(seqn), pos0n = (cn == 0 ? -48 : 16 + 64 * (cn - 1));
              const bf16_t* xb = cols + (size_t)s0n * NINP + C_XC + gchc;
#pragma unroll
              for (int i = 0; i < 19; ++i) { const int pos = pos0n + rb * 16 - 2 + i; const int pc = pos < 0 ? 0 : (pos < Ln ? pos : Ln - 1); xr[i] = xb[(size_t)pc * NINP]; } } }
        LBAR();
        LAS bf16_t* gts = (LAS bf16_t*)(lds + 51200); LAS float* hfs = (LAS float*)(lds + 68608);
        float hsum[4][4];
#pragma unroll
        for (int d = 0; d < 2; ++d) {
            __builtin_amdgcn_sched_barrier(0);
            f32x4 acc[2][4];
#pragma unroll
            for (int rt = 0; rt < 4; ++rt) { bf16x8 afr[4];
#pragma unroll
                for (int ks = 0; ks < 4; ++ks) afr[ks] = *(const LAS bf16x8*)(xcA + (rt * 16 + (lane & 15)) * 136 + ks * 32 + q * 8);
#pragma unroll
                for (int kind = 0; kind < 2; ++kind) { f32x4 a = (f32x4){0.f, 0.f, 0.f, 0.f};
#pragma unroll
                    for (int ks = 0; ks < 4; ++ks) a = __builtin_amdgcn_mfma_f32_16x16x32_bf16(afr[ks], bfr[d * 2 + kind][ks], a, 0, 0, 0);
                    acc[kind][rt] = a; } }
            float a[4][4], bb[4][4];
#pragma unroll
            for (int rt = 0; rt < 4; ++rt)
#pragma unroll
                for (int j = 0; j < 4; ++j) { const int r = rt * 16 + q * 4 + j; const float rg = sigm(acc[0][rt][j] + ba[d]), ig = sigm(acc[1][rt][j] + bx[d]), la = -sp8[d] * rg;
                    const bool ok = r >= rmin; const float av = __expf(la), x2 = 2.0f * la; const float om = x2 > -0.25f ? -x2 * (1.0f + x2 * 0.5f * (1.0f + x2 * (1.0f / 3.0f) * (1.0f + x2 * 0.25f * (1.0f + x2 * 0.2f)))) : 1.0f - av * av;
                    a[rt][j] = ok ? av : 1.0f; bb[rt][j] = ok ? __builtin_amdgcn_sqrtf(om) * ig * xcf[r * 132 + chl] : 0.f; }
            float LA[4], LB[4];
#pragma unroll
            for (int rt = 0; rt < 4; ++rt) { float A = 1.f, B = 0.f;
#pragma unroll
                for (int jj = 0; jj < 4; ++jj) { const int j = d == 0 ? jj : 3 - jj; B = a[rt][j] * B + bb[rt][j]; A *= a[rt][j]; }
                LA[rt] = A; LB[rt] = B; }
            const size_t co = ((size_t)ci * 2 + d) * 1024 + gch;
            float h = (MODE == 1) ? cin[d] : 0.f, Atot = 1.f; float hin[4];
#pragma unroll
            for (int rr = 0; rr < 4; ++rr) { const int rt = d == 0 ? rr : 3 - rr;
#pragma unroll
                for (int qi = 0; qi < 4; ++qi) { const int qq = d == 0 ? qi : 3 - qi;
                    const float Aq = __shfl(LA[rt], (lane & 15) + 16 * qq), Bq = __shfl(LB[rt], (lane & 15) + 16 * qq);
                    if (qq == q) hin[rt] = h;
                    h = Aq * h + Bq; Atot *= Aq; } }
            if (MODE == 0) { if (q == 0) { ((float*)(p.ws + WS_LRUA))[co] = Atot; ((float*)(p.ws + WS_LRUH))[co] = h; } }
            else {
#pragma unroll
                for (int rt = 0; rt < 4; ++rt) { float hh = hin[rt];
#pragma unroll
                    for (int jj = 0; jj < 4; ++jj) { const int j = d == 0 ? jj : 3 - jj; hh = a[rt][j] * hh + bb[rt][j];
                        if (d == 0) hfs[(rt * 16 + q * 4 + j) * 132 + chl] = hh; else hsum[rt][j] = hh; } }
                if (d == 0) { *(LAS u32x4*)(gts + (tid >> 3) * 136 + (tid & 7) * 16) = gq[0]; *(LAS u32x4*)(gts + (tid >> 3) * 136 + (tid & 7) * 16 + 8) = gq[1]; } }
        }
        if (MODE == 1) { bf16_t* yall = (bf16_t*)(p.ws + WS_YALL);
            LBAR();
#pragma unroll
            for (int rt = 0; rt < 4; ++rt)
#pragma unroll
                for (int j = 0; j < 4; ++j) { const int r = rt * 16 + q * 4 + j; xcA[r * 136 + chl] = f2bf((hsum[rt][j] + hfs[r * 132 + chl]) * silu(bf2f(gts[r * 136 + chl]))); }
            LBAR();
            { const int r = tid >> 3; if (r >= rmin) { const u32x4 y0 = *(const LAS u32x4*)(xcA + r * 136 + (tid & 7) * 16), y1 = *(const LAS u32x4*)(xcA + r * 136 + (tid & 7) * 16 + 8);
                bf16_t* yp = yall + (size_t)(s0 + pos0 + r) * D + 1024 + nb * 128 + (tid & 7) * 16; *(u32x4*)yp = y0; *(u32x4*)(yp + 8) = y1; } } }
        LBAR();
    }
}


template <int WHICH>
__device__ __forceinline__ void skinny_tail(const int TID, const int b0, const Params& p, const int first) {
    const int lane = TID & 63, wid = TID >> 6, q = lane >> 4;
    if (wid >= 5) return;
    for (int b = b0; b < 256; b += (int)gridDim.x) {
    const int ct = b & 127, rt = (b >> 7) * 5 + wid;
    const int row = 24576 + rt * 16 + (lane & 15);
    const int colb = ct * 16 + (lane & 15);
    const bf16_t* cols = (const bf16_t*)(p.ws + WS_COLS);
    if (WHICH == 0) {
        const bf16_t* A = (const bf16_t*)(p.ws + WS_YALL) + (size_t)row * D + q * 8; const bf16_t* B = (const bf16_t*)(p.ws + WS_BTOUT) + (size_t)colb * D + q * 8;
        bf16_t* mbf = (bf16_t*)(p.ws + WS_H);
        f32x4 msum = (f32x4){0.f, 0.f, 0.f, 0.f};
        unsigned char gt[3][4];
#pragma unroll
        for (int br = 0; br < 3; ++br)
#pragma unroll
            for (int j = 0; j < 4; ++j) { const int cc = colb & 255; gt[br][j] = ((const unsigned char*)(cols + (size_t)(24576 + rt * 16 + q * 4 + j) * NINP + C_MG))[(br * 8 + (colb >> 8)) * 256 + ((((cc & 127) >> 5) * 4 + ((cc & 31) >> 3)) * 2 + (cc >> 7)) * 8 + (cc & 7)]; }
        float gs[3][4];
#pragma unroll
        for (int br = 0; br < 3; ++br)
#pragma unroll
            for (int j = 0; j < 4; ++j) { gs[br][j] = (float)gt[br][j] * (1.0f / 255.0f); asm volatile("" : "+v"(gs[br][j])); }
#pragma unroll
        for (int br = 0; br < 3; ++br) { const int koff = br * 512, nks = br == 2 ? 32 : 16; f32x4 acc = (f32x4){0.f, 0.f, 0.f, 0.f};
            for (int k0 = 0; k0 < nks; k0 += 8) { bf16x8 av[8], bv[8];
#pragma unroll
                for (int i = 0; i < 8; ++i) { av[i] = *(const bf16x8*)(A + koff + (k0 + i) * 32); bv[i] = *(const bf16x8*)(B + koff + (k0 + i) * 32); }
#pragma unroll
                for (int i = 0; i < 8; ++i) acc = __builtin_amdgcn_mfma_f32_16x16x32_bf16(av[i], bv[i], acc, 0, 0, 0); }
#pragma unroll
            for (int j = 0; j < 4; ++j) msum[j] += gs[br][j] * acc[j]; }
#pragma unroll
        for (int j = 0; j < 4; ++j) { const int tok = 24576 + rt * 16 + q * 4 + j; mbf[(size_t)tok * D + colb] = f2bf(msum[j]); }
    } else {
        const bf16_t* A = (const bf16_t*)(p.ws + WS_H) + (size_t)row * D + q * 8; const bf16_t* B = (const bf16_t*)(p.ws + WS_BTO) + (size_t)colb * D + q * 8;
        float* z = (float*)(p.ws + WS_Z);
        f32x4 acc = (f32x4){0.f, 0.f, 0.f, 0.f};
        for (int k0 = 0; k0 < 64; k0 += 8) { bf16x8 av[8], bv[8];
#pragma unroll
            for (int i = 0; i < 8; ++i) { av[i] = *(const bf16x8*)(A + (k0 + i) * 32); bv[i] = *(const bf16x8*)(B + (k0 + i) * 32); }
#pragma unroll
            for (int i = 0; i < 8; ++i) acc = __builtin_amdgcn_mfma_f32_16x16x32_bf16(av[i], bv[i], acc, 0, 0, 0); }
#pragma unroll
        for (int j = 0; j < 4; ++j) { const int tok = 24576 + rt * 16 + q * 4 + j; const float res = first ? src_row(p, tok)[colb] : z[(size_t)tok * D + colb]; z[(size_t)tok * D + colb] = res + acc[j]; }
    }
    }
}

#define XB_TMO      128
#define XB_XCNT(j)  (256  + 64 * (j))
#define XB_XSUB(j)  (1280 + 64 * (j))
#define XB_XGEN(j)  (2304 + 64 * (j))
#define XB_TOP      3328
#define XB_TOPGEN   3392
#define XCD_BAR_WORDS 3456
#define XB_SPIN_CAP (1u << 18)
__device__ __forceinline__ unsigned xb_ld(unsigned* p)              { return __hip_atomic_load(p, __ATOMIC_RELAXED, __HIP_MEMORY_SCOPE_AGENT); }
__device__ __forceinline__ unsigned xb_add(unsigned* p, unsigned v) { return __hip_atomic_fetch_add(p, v, __ATOMIC_RELAXED, __HIP_MEMORY_SCOPE_AGENT); }
__device__ __forceinline__ unsigned xb_xcc_id() { return (unsigned)__builtin_amdgcn_s_getreg((3 << 11) | 20) & 0xFu; }
#define XB_SPIN(cond, bar) do { unsigned _sp = 0; while (cond) { __builtin_amdgcn_s_sleep(1); \
    if ((++_sp & 255u) == 0u) { if (xb_ld(&(bar)[XB_TMO])) break; if (_sp > XB_SPIN_CAP) { atomicAdd(&(bar)[XB_TMO], 1u); break; } } } } while (0)
struct XcdBarrier { unsigned* bar; unsigned x; volatile LAS unsigned* st; };
__device__ __forceinline__ XcdBarrier xcd_barrier_post(unsigned* bar, volatile LAS unsigned* st) {
    XcdBarrier b; b.bar = bar; b.x = xb_xcc_id(); b.st = st;
    if (threadIdx.x == 0) (void)xb_add(&bar[XB_XCNT(b.x)], 1u);
    return b;
}
__device__ __forceinline__ void xcd_barrier_complete(unsigned* bar, unsigned x, unsigned& nloc, unsigned& nx) {
    const unsigned G = gridDim.x * gridDim.y * gridDim.z;
    unsigned sum, cnt, mine, sp = 0u;
    for (;;) {
        sum = 0u; cnt = 0u; mine = 0u;
#pragma unroll
        for (unsigned j = 0; j < 16; ++j) { const unsigned c = xb_ld(&bar[XB_XCNT(j)]); sum += c; cnt += (c > 0u) ? 1u : 0u; mine = (j == x) ? c : mine; }
        if (sum == G) break;
        __builtin_amdgcn_s_sleep(1);
        if ((++sp & 255u) == 0u) { if (xb_ld(&bar[XB_TMO])) break; if (sp > XB_SPIN_CAP) { atomicAdd(&bar[XB_TMO], 1u); break; } }
    }
    nloc = mine > 0u ? mine : 1u; nx = cnt > 0u ? cnt : 1u;
}
__device__ __forceinline__ void xcd_barrier(const XcdBarrier& b) {
    asm volatile("s_waitcnt vmcnt(0)" ::: "memory");
    __syncthreads();
    if (threadIdx.x == 0) {
        unsigned* bar = b.bar;
        __builtin_amdgcn_s_waitcnt(0);
        unsigned nloc = b.st[0], nx = b.st[1];
        if (nloc == 0u) { xcd_barrier_complete(bar, b.x, nloc, nx); b.st[0] = nloc; b.st[1] = nx; }
        const unsigned old = xb_add(&bar[XB_XSUB(b.x)], 1u);
        const unsigned gen = old / nloc;
        if (old + 1u == (gen + 1u) * nloc) {
            __builtin_amdgcn_fence(__ATOMIC_RELEASE, "agent");
            asm volatile("s_waitcnt vmcnt(0)" ::: "memory");
            const unsigned og = xb_add(&bar[XB_TOP], 1u);
            const unsigned tg = og / nx;
            if (og + 1u == (tg + 1u) * nx) xb_add(&bar[XB_TOPGEN], 1u);
            else XB_SPIN(xb_ld(&bar[XB_TOPGEN]) == tg, bar);
            __builtin_amdgcn_fence(__ATOMIC_ACQUIRE, "agent");
            xb_add(&bar[XB_XGEN(b.x)], 1u);
            asm volatile("s_waitcnt vmcnt(0)" ::: "memory");
        } else {
            XB_SPIN(xb_ld(&bar[XB_XGEN(b.x)]) == gen, bar);
            __builtin_amdgcn_fence(__ATOMIC_ACQUIRE, "agent");
            asm volatile("s_waitcnt vmcnt(0)" ::: "memory");
        }
    }
    __syncthreads();
}

__global__ void __launch_bounds__(512) fwd_megakernel(Params p_in) {
    extern __shared__ __attribute__((aligned(16))) unsigned char smem[];
    LAS unsigned char* lds = (LAS unsigned char*)smem;
    cg::grid_group grid = cg::this_grid();
    const int G = gridDim.x;
    const Params& p0 = p_in;
    volatile LAS unsigned* stw = (volatile LAS unsigned*)(lds + 150528);
    if (threadIdx.x == 0) { stw[0] = 0u; stw[1] = 0u; }
    __syncthreads();
    const XcdBarrier xb = xcd_barrier_post((unsigned*)(p_in.ws + WS_BAR), stw);
    for (int ph = p0.ph_lo; ph < p0.ph_hi; ++ph) {
        const int reps_ = (ph < 32 && (ph & 7) == DUP) ? 2 : 1;
        for (int rep_ = 0; rep_ < reps_; ++rep_) {
        int TID = threadIdx.x; asm volatile("" : "+v"(TID));
        int b = blockIdx.x; asm volatile("" : "+s"(b));
        Params p = p0; { unsigned long long t_ = (unsigned long long)p.ws; asm volatile("" : "+s"(t_)); p.ws = (unsigned char*)t_; }
        const char* ws = (const char*)p.ws;
        if (ph == 32) { final_norm_phase(TID, b, p); }
        else {
            const int l = ph >> 3, k = ph & 7;
            if (k == 0 && (PHM & 1)) { rmsnorm_phase(TID, b, p, l); convert_weights(TID, b, p, l, (LAS float*)lds); if (l == 0) s5_tables_all(TID, b, p); }
            else if (k == 1 && (PHM & 2)) {
                TileOrder S; S.nM = MP / 256; S.nN = NINP / 256; S.nwg = S.nM * S.nN; S.G = G; S.c = b; S.mult = 1; S.nt0 = D / 64; S.A = ws + WS_H; S.B = ws + WS_BTIN; S.tA = (size_t)256 * D * 2; S.tB = (size_t)256 * D * 2;
                EpiIn E; E.cols = (bf16_t*)(p.ws + WS_COLS); E.ubuf = (bf16_t*)(p.ws + WS_UBUF);
                gemm_phase(TID, lds, D, D, S, E);
                s5_assemble_a(TID, b, p, l);
            } else if (k == 2 && (PHM & 4)) {
                GroupOrder S; S.G = G; S.c = b; S.nt0 = 4; S.A = ws + WS_UBUF; S.B = ws + WS_PMAT; S.gsA = (size_t)CHP * 512 * 2; S.gsB = (size_t)256 * 256 * 2; S.tA = (size_t)256 * 512 * 2;
                EpiS5State E; E.st = (float*)(p.ws + WS_ST);
                if (SUBM & 4) gemm_phase(TID, lds, 512, 256, S, E);
                __syncthreads();
                { const int head_ = ((b + 128) % G) & 3, kk_ = TID & 63; float wg_[2][16], bg_[2];
                  _Pragma("unroll") for (int d = 0; d < 2; ++d) { bg_[d] = p.in[16][(l * 2 + d) * 256 + head_ * 64 + kk_]; _Pragma("unroll") for (int j = 0; j < 16; ++j) wg_[d][j] = p.in[15][((size_t)(l * 2 + d) * 16 + j) * 256 + head_ * 64 + kk_]; }
                  float ng_[16]; _Pragma("unroll") for (int e = 0; e < 16; ++e) ng_[e] = p.in[17][l * 512 + head_ * 128 + (TID & 7) * 16 + e];
                  for (int it = (b + 128) % G; it < NCK * 4; it += G) gla_item<0>(TID, p, l, it >> 2, it & 3, lds, wg_, bg_, ng_); }
                lru_phase<0>(TID, b, G, p, l, lds);
                s5_assemble_w(TID, b, p, l);
            } else if (k == 3 && (PHM & 8)) { scans_phase(TID, b, p, l, rep_ == 0); }
            else if (k == 4 && (PHM & 16)) {
                GroupOrder S; S.G = G; S.c = b; S.nt0 = 8; S.A = ws + WS_UBUF; S.B = ws + WS_WMAT; S.gsA = (size_t)CHP * 512 * 2; S.gsB = (size_t)256 * 512 * 2; S.tA = (size_t)256 * 512 * 2;
                EpiS5Out E; E.zs5 = (bf16_t*)(p.ws + WS_ZS5);
                if (SUBM & 4) gemm_phase(TID, lds, 512, 512, S, E);
                __syncthreads();
                { const int head_ = ((b + 128) % G) & 3, kk_ = TID & 63; float wg_[2][16], bg_[2];
                  _Pragma("unroll") for (int d = 0; d < 2; ++d) { bg_[d] = p.in[16][(l * 2 + d) * 256 + head_ * 64 + kk_]; _Pragma("unroll") for (int j = 0; j < 16; ++j) wg_[d][j] = p.in[15][((size_t)(l * 2 + d) * 16 + j) * 256 + head_ * 64 + kk_]; }
                  float ng_[16]; _Pragma("unroll") for (int e = 0; e < 16; ++e) ng_[e] = p.in[17][l * 512 + head_ * 128 + (TID & 7) * 16 + e];
                  for (int it = (b + 128) % G; it < NCK * 4; it += G) gla_item<1>(TID, p, l, it >> 2, it & 3, lds, wg_, bg_, ng_); }
                lru_phase<1>(TID, b, G, p, l, lds);
            } else if (k == 5 && (PHM & 32)) {
                TileOrder S; S.nM = MP / 256; S.nN = 2; S.nwg = S.nM * S.nN; S.G = G; S.c = b; S.mult = 1; S.nt0 = 8; S.A = ws + WS_ZS5; S.B = ws + WS_BTGLU; S.tA = (size_t)256 * 512 * 2; S.tB = (size_t)256 * 512 * 2;
                EpiGlu E; E.zs5 = (const bf16_t*)(p.ws + WS_ZS5); E.cols = (const bf16_t*)(p.ws + WS_COLS); E.bglu = p.in[14] + l * 512; E.yall = (bf16_t*)(p.ws + WS_YALL);
                gemm_phase(TID, lds, 512, 512, S, E);
            } else if (k == 6 && (PHM & 64)) {
                TileOrder S; S.nM = 96; S.nN = 8; S.nwg = S.nM * S.nN; S.G = G; S.c = b; S.mult = 3; S.nt0 = 8; S.A = ws + WS_YALL; S.B = ws + WS_BTOUT; S.tA = (size_t)256 * D * 2; S.tB = (size_t)256 * D * 2;
                EpiOut E; E.cols = (const bf16_t*)(p.ws + WS_COLS); E.mbf = (bf16_t*)(p.ws + WS_H);
                gemm_phase(TID, lds, D, D, S, E);
                skinny_tail<0>(TID, b, p, 0);
            } else if (PHM & 128) {
                TileOrder S; S.nM = 96; S.nN = 8; S.nwg = S.nM * S.nN; S.G = G; S.c = b; S.mult = 1; S.nt0 = D / 64; S.A = ws + WS_H; S.B = ws + WS_BTO; S.tA = (size_t)256 * D * 2; S.tB = (size_t)256 * D * 2;
                EpiWo E; E.z = (float*)(p.ws + WS_Z); E.pp = &p; E.first = (l == 0);
                gemm_phase(TID, lds, D, D, S, E);
                skinny_tail<1>(TID, b, p, l == 0);
            }
        }
        }
        if (p0.use_sync && ph + 1 < p0.ph_hi) { if (ph == p0.ph_lo) grid.sync(); else xcd_barrier(xb); }
    }
}

extern "C" void kernel_launch(void* const* d_in, const int* in_sizes, int n_in, void* d_out, int out_size, void* d_ws, size_t ws_size, hipStream_t stream) {
    static int grid = 0, coop = 1;
    if (grid == 0) {
        if (n_in != 30 || ws_size < WS_END2) { fprintf(stderr, "kernel_launch: unexpected n_in %d or ws_size %zu (< %zu)\n", n_in, ws_size, (size_t)WS_END); grid = -1; return; }
        int dev = 0, cus = 0, per_cu = 0;
        (void)hipGetDevice(&dev); (void)hipDeviceGetAttribute(&cus, hipDeviceAttributeMultiprocessorCount, dev);
        if (hipFuncSetAttribute((const void*)fwd_megakernel, hipFuncAttributeMaxDynamicSharedMemorySize, LDS_BYTES) != hipSuccess) { fprintf(stderr, "kernel_launch: hipFuncSetAttribute failed\n"); grid = -1; return; }
        if (hipOccupancyMaxActiveBlocksPerMultiprocessor(&per_cu, (const void*)fwd_megakernel, 512, LDS_BYTES) != hipSuccess || per_cu < 1) { fprintf(stderr, "kernel_launch: occupancy query gave %d\n", per_cu); per_cu = 1; }
        (void)hipGetLastError();
        grid = cus * 1;
    }
    if (grid < 0) return;
    Params p{};
    for (int i = 0; i < 30; ++i) p.in[i] = (const float*)d_in[i];
    p.out = (float*)d_out; p.ws = (unsigned char*)d_ws; p.pad = 0;
    (void)hipMemsetAsync((char*)d_ws + WS_BAR, 0, 3456 * 4, stream);
    if (coop) {
        p.ph_lo = 0; p.ph_hi = 33; p.use_sync = 1;
        void* args[] = {&p};
        hipError_t e = hipLaunchCooperativeKernel((const void*)fwd_megakernel, dim3(grid), dim3(512), args, LDS_BYTES, stream);
        if (e == hipSuccess) return;
        fprintf(stderr, "kernel_launch: cooperative launch failed: %s (grid %d); falling back to one launch per phase\n", hipGetErrorString(e), grid);
        (void)hipGetLastError(); coop = 0;
    }
    for (int ph = 0; ph < 33; ++ph) { p.ph_lo = ph; p.ph_hi = ph + 1; p.use_sync = 0; hipLaunchKernelGGL(fwd_megakernel, dim3(grid), dim3(512), LDS_BYTES, stream, p); }
}
```

```cpp
#include <hip/hip_runtime.h>
#include <hip/hip_cooperative_groups.h>
#include <cstdio>
namespace cg = cooperative_groups;
#define LAS __attribute__((address_space(3)))
typedef unsigned short bf16_t;
typedef short bf16x8 __attribute__((ext_vector_type(8)));
typedef float f32x4 __attribute__((ext_vector_type(4)));
typedef float f32x2 __attribute__((ext_vector_type(2)));
typedef unsigned u32x2 __attribute__((ext_vector_type(2)));
typedef unsigned u32x4 __attribute__((ext_vector_type(4)));

constexpr int D = 2048, NTOK = 24736, MP = 24832, NINP = 11008, NIN = 10784;
constexpr int NCH16 = 1546, CHP = 1792, NCK = 394;
constexpr int C_GA = 512, C_Q = 1024, C_K = 1280, C_V = 1536, C_GB = 2048, C_XC = 2560, C_GC = 3584, C_MG = 4608, C_GLR = 10752;
constexpr int LDS_BYTES = 150528 + 16;
#ifndef SYNCREP
#define SYNCREP 1
#endif
#ifndef DUP
#define DUP -1
#endif
#ifndef SUBM
#define SUBM 7
#endif
#ifndef PHM
#define PHM 255
#endif

constexpr size_t al256(size_t x) { return (x + 255) & ~(size_t)255; }
constexpr size_t WS_Z = 0;
constexpr size_t WS_H = WS_Z + al256((size_t)MP * D * 4);
constexpr size_t WS_COLS = WS_H + al256((size_t)MP * D * 2);
constexpr size_t WS_YALL = WS_COLS + al256((size_t)MP * NINP * 2);
constexpr size_t WS_ZS5 = WS_YALL + al256((size_t)MP * D * 2);
constexpr size_t WS_UBUF = WS_ZS5 + al256((size_t)MP * 512 * 2);
constexpr size_t WS_ST = WS_UBUF + al256((size_t)32 * CHP * 512 * 2);
constexpr size_t WS_DS = WS_ST + al256((size_t)32 * CHP * 256 * 4);
constexpr size_t WS_M32 = WS_UBUF;
constexpr size_t WS_DECAY = WS_DS + al256((size_t)NCK * 4 * 2 * 8192 * 4);
constexpr size_t WS_LRUA = WS_DECAY + al256((size_t)NCK * 4 * 2 * 64 * 4);
constexpr size_t WS_LRUH = WS_LRUA + al256((size_t)NCK * 2 * 1024 * 4);
constexpr size_t WS_LRUC = WS_LRUH + al256((size_t)NCK * 2 * 1024 * 4);
constexpr size_t WS_PW = WS_LRUC + al256((size_t)NCK * 2 * 1024 * 4);
constexpr size_t WS_BBAR = WS_PW + al256((size_t)4 * 32 * 2 * 17 * 64 * 8);
constexpr size_t WS_WMAT = WS_BBAR + al256((size_t)4 * 32 * 2 * 64 * 16 * 8);
constexpr size_t WS_PMAT = WS_WMAT + al256((size_t)32 * 256 * 512 * 2);
constexpr size_t WS_BTIN = WS_PMAT + al256((size_t)32 * 256 * 256 * 2);
constexpr size_t WS_BTOUT = WS_BTIN + al256((size_t)NINP * D * 2);
constexpr size_t WS_BTO = WS_BTOUT + al256((size_t)D * D * 2);
constexpr size_t WS_BTGLU = WS_BTO + al256((size_t)D * D * 2);
constexpr size_t WS_BTLRU = WS_BTGLU + al256((size_t)512 * 512 * 2);
constexpr size_t WS_KMAT = WS_BTLRU + al256((size_t)32 * 128 * 128 * 2);
constexpr size_t WS_BAR = WS_KMAT + al256((size_t)32 * 2 * 16 * 256 * 4);
constexpr size_t WS_END = WS_BAR + al256((size_t)3456 * 4);
constexpr size_t WS_GB = WS_END;
constexpr size_t WS_END2 = WS_GB + al256((size_t)NCK * 4 * 8192 * 4);
constexpr size_t PWL = (size_t)32 * 2 * 17 * 64, BBL = (size_t)32 * 2 * 64 * 16;
static_assert(WS_END2 <= (size_t)1413480448, "workspace too large");
static_assert((size_t)MP * D * 4 <= WS_DECAY - WS_UBUF, "m32 alias too small");

struct Params { const float* in[30]; float* out; unsigned char* ws; int ph_lo, ph_hi, use_sync, pad; };

#define LBAR() do { asm volatile("s_waitcnt lgkmcnt(0)" ::: "memory"); __builtin_amdgcn_s_barrier(); asm volatile("" ::: "memory"); } while (0)
__device__ __forceinline__ unsigned cvt_pk_bf16(float lo, float hi) { unsigned r; asm volatile("v_cvt_pk_bf16_f32 %0, %1, %2" : "=v"(r) : "v"(lo), "v"(hi)); return r; }
__device__ __forceinline__ bf16_t f2bf(float f) { return (bf16_t)(cvt_pk_bf16(f, 0.f) & 0xffffu); }
__device__ __forceinline__ float bf2f(bf16_t b) { return __uint_as_float(((unsigned)b) << 16); }
__device__ __forceinline__ float bflo(unsigned w) { return __uint_as_float(w << 16); }
__device__ __forceinline__ float bfhi(unsigned w) { return __uint_as_float(w & 0xffff0000u); }
__device__ __forceinline__ float sigm(float x) { return __builtin_amdgcn_rcpf(1.0f + __expf(-x)); }
__device__ __forceinline__ float silu(float x) { return x * sigm(x); }
__device__ __forceinline__ float gelu_t(float x) { const float u = 0.7978845608028654f * (x + 0.044715f * x * x * x); return x * sigm(2.0f * u); }
__device__ __forceinline__ float logsig(float x) { return -(fmaxf(-x, 0.f) + __logf(1.0f + __expf(-fabsf(x)))); }

__device__ __forceinline__ int seq_start(int s) { return s < 2 ? s * 4112 : 8224 + (s - 2) * 2064; }
__device__ __forceinline__ int seq_len(int s) { return s < 2 ? 4112 : 2064; }
__device__ __forceinline__ void chunk_info(int ci, int& seq, int& c) { if (ci < 130) { seq = ci / 65; c = ci - seq * 65; } else { const int t = ci - 130; const int q = t / 33; seq = 2 + q; c = t - q * 33; } }

constexpr int BM = 256, BK = 64, HALF = 128, HTB = HALF * BK * 2, STAGE_BYTES = 8 * HTB, NXCD = 8, WGM = 8;
__device__ __forceinline__ int lds_byte(int r, int c) { const int st = (r >> 4) * 2 + (c >> 5), rr = r & 15, cc = c & 31, ob = rr * 64 + cc * 2; return st * 1024 + (ob ^ (((ob >> 9) & 1) << 5)); }
__device__ __forceinline__ void stage_rc(int b, int& R, int& C) { const int st = b / 1024, sb = b % 1024, swz = sb ^ (((sb >> 9) & 1) << 5); R = (st >> 1) * 16 + swz / 64; C = (st & 1) * 32 + (swz % 64) / 2; }

struct Unit { int pm, pn, sub, nt; const char* a; const char* b; };

struct TileOrder {
    int nM, nN, nwg, G, c, mult, nt0; const char* A; const char* B; size_t tA, tB;
    __device__ __forceinline__ bool next(int i, Unit& u) const {
        const int ti = i / mult, sub = i - ti * mult;
        const long L = (long)ti * G + c; if (L >= nwg) return false;
        int wgid = (int)L; { const int q = nwg / NXCD, r = nwg % NXCD, xcd = wgid % NXCD, off = wgid / NXCD; wgid = (xcd < r ? xcd * (q + 1) : r * (q + 1) + (xcd - r) * q) + off; }
        const int nig = WGM * nN, gid = wgid / nig, fm = gid * WGM, gsz = (nM - fm) < WGM ? (nM - fm) : WGM;
        u.pm = fm + ((wgid % nig) % gsz); u.pn = (wgid % nig) / gsz; u.sub = sub;
        const int koff = (mult == 3) ? sub * 512 : 0; u.nt = (mult == 3) ? (sub == 2 ? 16 : 8) : nt0;
        u.a = A + (size_t)u.pm * tA + (size_t)koff * 2; u.b = B + (size_t)u.pn * tB + (size_t)koff * 2; return true;
    }
};
struct GroupOrder {
    int G, c, nt0; const char* A; const char* B; size_t gsA, gsB, tA;
    __device__ __forceinline__ bool next(int i, Unit& u) const {
        const int L = i * G + c; if (L >= 224) return false;
        const int g = L / 7, pm = L - g * 7; u.pm = pm; u.pn = 0; u.sub = g; u.nt = nt0;
        u.a = A + (size_t)g * gsA + (size_t)pm * tA; u.b = B + (size_t)g * gsB; return true;
    }
};

__device__ __forceinline__ int perm32(int rho) { const int n = rho >> 4, i = rho & 15; return 8 * (i >> 2) + 4 * n + (i & 3); }
template <class Epi, class Sched>
__device__ __forceinline__ void gemm_phase(const int TID, LAS unsigned char* lds, const int lda, const int ldb, const Sched& S, const Epi& E) {
    const int tid = TID, wid = __builtin_amdgcn_readfirstlane(tid >> 6), lane = tid & 63, wr = wid >> 2, wc = wid & 3, fr = lane & 15, fq = lane >> 4;
    unsigned voffA[2], voffB[2];
#pragma unroll
    for (int i = 0; i < 2; ++i) { int R, C; stage_rc(tid * 16 + i * 8192, R, C); const int Rb = Epi::PERM ? ((R & ~31) + perm32(R & 31)) : R; voffA[i] = (unsigned)(R * lda + C) * 2u; voffB[i] = (unsigned)(Rb * ldb + C) * 2u; }
    const size_t kstep = (size_t)(BK * 2);
    const size_t hA = (size_t)HALF * lda * 2, hB = (size_t)HALF * ldb * 2;
    const unsigned ldsw = (unsigned)wid * 1024u;
    const int aoff = lds_byte(wr * 64 + fr, fq * 8), boff = lds_byte(wc * 32 + fr, fq * 8);
#define PG8_SA(b, h) (((b) * 2 + (h)) * HTB)
#define PG8_SB(b, h) ((4 + (b) * 2 + (h)) * HTB)
#define PG8_STAGE(bufoff, gbase, voff) do { _Pragma("unroll") for (int _i = 0; _i < 2; ++_i) \
        __builtin_amdgcn_global_load_lds((const unsigned*)((const char*)(gbase) + (voff)[_i]), (LAS unsigned*)(lds + (bufoff) + ldsw + _i * 8192), 16, 0, 0); } while (0)
#define PG8_LDA(dst, b, h) do { _Pragma("unroll") for (int m = 0; m < 4; ++m) _Pragma("unroll") for (int k = 0; k < 2; ++k) dst[m][k] = *(const LAS bf16x8*)(lds + PG8_SA(b, h) + aoff + m * 2048 + k * 1024); } while (0)
#define PG8_LDB(dst, b, h) do { _Pragma("unroll") for (int n = 0; n < 2; ++n) _Pragma("unroll") for (int k = 0; k < 2; ++k) dst[n][k] = *(const LAS bf16x8*)(lds + PG8_SB(b, h) + boff + n * 2048 + k * 1024); } while (0)
#define PG8_MMA(ai, bj, At, Bt) do { __builtin_amdgcn_s_setprio(1); _Pragma("unroll") for (int m = 0; m < 4; ++m) _Pragma("unroll") for (int n = 0; n < 2; ++n) _Pragma("unroll") for (int k = 0; k < 2; ++k) \
        acc[ai][bj][m][n] = __builtin_amdgcn_mfma_f32_16x16x32_bf16(Bt[n][k], At[m][k], acc[ai][bj][m][n], 0, 0, 0); __builtin_amdgcn_s_setprio(0); } while (0)
#define PG8_WAIT_V(n) asm volatile("s_waitcnt vmcnt(" #n ")" ::: "memory")
#define PG8_WAIT_L(n) asm volatile("s_waitcnt lgkmcnt(" #n ")" ::: "memory")
#define PG8_BAR __builtin_amdgcn_s_barrier()
#define PG8_SCHED __builtin_amdgcn_sched_barrier(0)
    Unit cur, nxt; int ui = 0;
    if (!S.next(0, cur)) return;
    f32x4 acc[2][2][4][2];
#pragma unroll
    for (int a = 0; a < 2; ++a)
#pragma unroll
        for (int b = 0; b < 2; ++b)
#pragma unroll
            for (int m = 0; m < 4; ++m)
#pragma unroll
                for (int n = 0; n < 2; ++n) acc[a][b][m][n] = (f32x4){0.f, 0.f, 0.f, 0.f};
    bf16x8 At[4][2], B0[2][2], B1[2][2];
    const char* cA = cur.a; const char* cB = cur.b;
    PG8_STAGE(PG8_SB(0, 0), cB, voffB); PG8_STAGE(PG8_SA(0, 0), cA, voffA); PG8_STAGE(PG8_SB(0, 1), cB + hB, voffB); PG8_STAGE(PG8_SA(0, 1), cA + hA, voffA);
    if (wr == 1) PG8_BAR;
    PG8_WAIT_V(4); PG8_BAR;
    PG8_STAGE(PG8_SB(1, 0), cB + kstep, voffB); PG8_STAGE(PG8_SA(1, 0), cA + kstep, voffA); PG8_STAGE(PG8_SB(1, 1), cB + hB + kstep, voffB);
    PG8_WAIT_V(6); PG8_BAR;
    for (;;) {
        const bool has_next = S.next(ui + 1, nxt);
        const char* nA = has_next ? nxt.a : cA; const char* nB = has_next ? nxt.b : cB;
        const int nt = cur.nt;
        for (int t = 0; t < nt; t += 2) {
            const bool last = (t == nt - 2);
            const char* a1 = cA + (size_t)(t + 1) * kstep;
            const char* a2 = last ? nA : cA + (size_t)(t + 2) * kstep; const char* b2 = last ? nB : cB + (size_t)(t + 2) * kstep;
            const char* a3 = a2 + kstep; const char* b3 = b2 + kstep;
            PG8_LDB(B0, 0, 0); PG8_SCHED; PG8_LDA(At, 0, 0); PG8_STAGE(PG8_SA(1, 1), a1 + hA, voffA);
            PG8_WAIT_L(8); PG8_BAR; PG8_WAIT_L(0); PG8_MMA(0, 0, At, B0); PG8_BAR; PG8_SCHED;
            PG8_LDB(B1, 0, 1); PG8_STAGE(PG8_SB(0, 0), b2, voffB);
            PG8_BAR; PG8_WAIT_L(0); PG8_MMA(0, 1, At, B1); PG8_BAR;
            PG8_LDA(At, 0, 1); PG8_STAGE(PG8_SA(0, 0), a2, voffA);
            PG8_BAR; PG8_WAIT_L(0); PG8_MMA(1, 0, At, B0); PG8_BAR; PG8_SCHED;
            PG8_STAGE(PG8_SB(0, 1), b2 + hB, voffB);
            PG8_WAIT_V(6); PG8_BAR; PG8_MMA(1, 1, At, B1); PG8_BAR;
            PG8_LDB(B0, 1, 0); PG8_SCHED; PG8_LDA(At, 1, 0); PG8_STAGE(PG8_SA(0, 1), a2 + hA, voffA);
            PG8_WAIT_L(8); PG8_BAR; PG8_WAIT_L(0); PG8_MMA(0, 0, At, B0); PG8_BAR; PG8_SCHED;
            PG8_LDB(B1, 1, 1); PG8_STAGE(PG8_SB(1, 0), b3, voffB);
            PG8_BAR; PG8_WAIT_L(0); PG8_MMA(0, 1, At, B1); PG8_BAR;
            PG8_LDA(At, 1, 1); PG8_STAGE(PG8_SA(1, 0), a3, voffA);
            PG8_BAR; PG8_WAIT_L(0); PG8_MMA(1, 0, At, B0); PG8_BAR; PG8_SCHED;
            PG8_STAGE(PG8_SB(1, 1), b3 + hB, voffB);
            PG8_WAIT_V(6); PG8_BAR; PG8_MMA(1, 1, At, B1); PG8_BAR;
        }
        E(acc, cur, wr, wc, fr, fq);
        if (!has_next) break;
#pragma unroll
        for (int a = 0; a < 2; ++a)
#pragma unroll
            for (int b = 0; b < 2; ++b)
#pragma unroll
                for (int m = 0; m < 4; ++m)
#pragma unroll
                    for (int n = 0; n < 2; ++n) acc[a][b][m][n] = (f32x4){0.f, 0.f, 0.f, 0.f};
        cur = nxt; cA = nA; cB = nB; ++ui;
    }
    PG8_WAIT_V(0);
    if (wr == 0) PG8_BAR;
    PG8_BAR;
#undef PG8_SA
#undef PG8_SB
#undef PG8_STAGE
#undef PG8_LDA
#undef PG8_LDB
#undef PG8_MMA
#undef PG8_WAIT_V
#undef PG8_WAIT_L
#undef PG8_BAR
#undef PG8_SCHED
}

#define EPI_LOOP(...) \
    const int row0 = u.pm * BM + wr * 64 + fr, col0 = u.pn * BM + wc * 32 + 4 * fq; \
    _Pragma("unroll") for (int ai = 0; ai < 2; ++ai) _Pragma("unroll") for (int m = 0; m < 4; ++m) { const int r = row0 + ai * HALF + m * 16; \
        _Pragma("unroll") for (int bj = 0; bj < 2; ++bj) _Pragma("unroll") for (int n = 0; n < 2; ++n) { const int c = col0 + bj * HALF + n * 16; const f32x4 v = acc[ai][bj][m][n]; __VA_ARGS__ } }

#define EPI_PROWS(...) \
    const int row0 = u.pm * BM + wr * 64 + fr, col0 = u.pn * BM + wc * 32 + 8 * fq; \
    _Pragma("unroll") for (int ai = 0; ai < 2; ++ai) _Pragma("unroll") for (int m = 0; m < 4; ++m) { const int r = row0 + ai * HALF + m * 16; __VA_ARGS__ }
__device__ __forceinline__ u32x4 pack8(const f32x4 a, const f32x4 b) { u32x4 w; w[0] = cvt_pk_bf16(a[0], a[1]); w[1] = cvt_pk_bf16(a[2], a[3]); w[2] = cvt_pk_bf16(b[0], b[1]); w[3] = cvt_pk_bf16(b[2], b[3]); return w; }
__device__ __forceinline__ unsigned q8(float x) { return (unsigned)__float2uint_rn(sigm(x) * 255.0f); }
__device__ __forceinline__ unsigned q8x4(const f32x4 v) { return q8(v[0]) | (q8(v[1]) << 8) | (q8(v[2]) << 16) | (q8(v[3]) << 24); }
struct EpiIn { static constexpr bool PERM = true; bf16_t* cols; bf16_t* ubuf;
    __device__ __forceinline__ void operator()(const f32x4 (&acc)[2][2][4][2], const Unit& u, int wr, int wc, int fr, int fq) const {
        if (u.pn >= 18 && u.pn < 42) {
            EPI_PROWS({ u32x4 w; w[0] = q8x4(acc[ai][0][m][0]); w[1] = q8x4(acc[ai][0][m][1]); w[2] = q8x4(acc[ai][1][m][0]); w[3] = q8x4(acc[ai][1][m][1]);
                *(u32x4*)((unsigned char*)(cols + (size_t)r * NINP + C_MG) + (u.pn - 18) * 256 + (wc * 4 + fq) * 16) = w; })
        } else {
            EPI_PROWS({ _Pragma("unroll") for (int bj = 0; bj < 2; ++bj) { const int c = col0 + bj * HALF;
                bf16_t* dst = (u.pn < 2) ? ubuf + ((size_t)((c >> 4) * CHP + (r >> 4)) * 512 + (r & 15) * 16 + (c & 15)) : cols + (size_t)r * NINP + c;
                *(u32x4*)dst = pack8(acc[ai][bj][m][0], acc[ai][bj][m][1]); } })
        }
    } };
struct EpiS5State { static constexpr bool PERM = false; float* st;
    __device__ __forceinline__ void operator()(const f32x4 (&acc)[2][2][4][2], const Unit& u, int wr, int wc, int fr, int fq) const {
        EPI_LOOP({ *(f32x4*)(st + ((size_t)(u.sub * CHP + r)) * 256 + c) = v; })
    } };
struct EpiS5Out { static constexpr bool PERM = true; bf16_t* zs5;
    __device__ __forceinline__ void operator()(const f32x4 (&acc)[2][2][4][2], const Unit& u, int wr, int wc, int fr, int fq) const {
        EPI_PROWS({ if (r < NCH16) { _Pragma("unroll") for (int bj = 0; bj < 2; ++bj) { const int c = col0 + bj * HALF; f32x4 a = acc[ai][bj][m][0], b2 = acc[ai][bj][m][1];
            _Pragma("unroll") for (int e = 0; e < 4; ++e) { a[e] = gelu_t(a[e]); b2[e] = gelu_t(b2[e]); }
            *(u32x4*)(zs5 + (size_t)(r * 16 + (c >> 4)) * 512 + u.sub * 16 + (c & 15)) = pack8(a, b2); } } })
    } };
#define EPI_ROWS(...) \
    const int row0 = u.pm * BM + wr * 64 + fr, col0 = u.pn * BM + wc * 32 + 4 * fq; \
    _Pragma("unroll") for (int ai = 0; ai < 2; ++ai) _Pragma("unroll") for (int m = 0; m < 4; ++m) { const int r = row0 + ai * HALF + m * 16; __VA_ARGS__ }
#define QOFF(q) (((q) >> 1) * HALF + ((q) & 1) * 16)
#define EPI_PIPE(LOADF, COMPF) \
    const int row0 = u.pm * BM + wr * 64 + fr, col0 = u.pn * BM + wc * 32 + 8 * fq; \
    LOADF(0, 0); \
    _Pragma("unroll") for (int gi = 0; gi < 8; ++gi) { if (gi + 1 < 8) { if ((gi & 1) == 0) { LOADF(gi + 1, 1); } else { LOADF(gi + 1, 0); } } if ((gi & 1) == 0) { COMPF(gi, 0); } else { COMPF(gi, 1); } }
#define GROW(gi) (row0 + ((gi) >> 2) * HALF + ((gi) & 3) * 16)
struct EpiGlu { static constexpr bool PERM = true; const bf16_t* zs5; const bf16_t* cols; const float* bglu; bf16_t* yall;
    __device__ __forceinline__ void operator()(const f32x4 (&acc)[2][2][4][2], const Unit& u, int wr, int wc, int fr, int fq) const {
        u32x4 zz[2][2], gg[2][2]; f32x4 bb[2][2];
        { const int c0 = u.pn * BM + wc * 32 + 8 * fq; _Pragma("unroll") for (int bj = 0; bj < 2; ++bj) { bb[bj][0] = *(const f32x4*)(bglu + c0 + bj * HALF); bb[bj][1] = *(const f32x4*)(bglu + c0 + bj * HALF + 4); } }
#define GLU_LOAD(gi, bf) do { const int r_ = GROW(gi); _Pragma("unroll") for (int bj = 0; bj < 2; ++bj) { const int c = col0 + bj * HALF; zz[bf][bj] = *(const u32x4*)(zs5 + (size_t)r_ * 512 + c); gg[bf][bj] = *(const u32x4*)(cols + (size_t)r_ * NINP + C_GA + c); } } while (0)
#define GLU_COMP(gi, bf) do { const int r_ = GROW(gi); _Pragma("unroll") for (int bj = 0; bj < 2; ++bj) { const int c = col0 + bj * HALF; f32x4 o[2]; \
            _Pragma("unroll") for (int hf = 0; hf < 2; ++hf) { const f32x4 v = acc[(gi) >> 2][bj][(gi) & 3][hf]; \
                o[hf][0] = bflo(zz[bf][bj][2 * hf]) * sigm(v[0] + bb[bj][hf][0]) * silu(bflo(gg[bf][bj][2 * hf])); o[hf][1] = bfhi(zz[bf][bj][2 * hf]) * sigm(v[1] + bb[bj][hf][1]) * silu(bfhi(gg[bf][bj][2 * hf])); \
                o[hf][2] = bflo(zz[bf][bj][2 * hf + 1]) * sigm(v[2] + bb[bj][hf][2]) * silu(bflo(gg[bf][bj][2 * hf + 1])); o[hf][3] = bfhi(zz[bf][bj][2 * hf + 1]) * sigm(v[3] + bb[bj][hf][3]) * silu(bfhi(gg[bf][bj][2 * hf + 1])); } \
            *(u32x4*)(yall + (size_t)r_ * D + c) = pack8(o[0], o[1]); } } while (0)
        EPI_PIPE(GLU_LOAD, GLU_COMP)
#undef GLU_LOAD
#undef GLU_COMP
    } };
__device__ __forceinline__ float ub(unsigned w, int k) { return (float)((w >> (8 * k)) & 255u) * (1.0f / 255.0f); }
struct EpiOut { static constexpr bool PERM = true; const bf16_t* cols; bf16_t* mbf;
    __device__ __forceinline__ void operator()(const f32x4 (&acc)[2][2][4][2], const Unit& u, int wr, int wc, int fr, int fq) const {
        u32x4 gg[8], mm[2][2];
        { const int row0g = u.pm * BM + wr * 64 + fr;
#pragma unroll
          for (int gi = 0; gi < 8; ++gi) gg[gi] = *(const u32x4*)((const unsigned char*)(cols + (size_t)(row0g + (gi >> 2) * HALF + (gi & 3) * 16) * NINP + C_MG) + (u.sub * 8 + u.pn) * 256 + (wc * 4 + fq) * 16); }
#define OUT_LOAD(gi, bf) do { const int r_ = GROW(gi); const bf16_t* mp = mbf + (size_t)r_ * D + col0; \
            _Pragma("unroll") for (int bj = 0; bj < 2; ++bj) { mm[bf][bj] = (u32x4){0u, 0u, 0u, 0u}; if (u.sub != 0) mm[bf][bj] = *(const u32x4*)(mp + bj * HALF); } } while (0)
#define OUT_COMP(gi, bf) do { const int r_ = GROW(gi); bf16_t* mp = mbf + (size_t)r_ * D + col0; _Pragma("unroll") for (int bj = 0; bj < 2; ++bj) { f32x4 o[2]; \
            _Pragma("unroll") for (int hf = 0; hf < 2; ++hf) { const f32x4 v = acc[(gi) >> 2][bj][(gi) & 3][hf]; const unsigned gw = gg[gi][bj * 2 + hf]; \
                o[hf][0] = bflo(mm[bf][bj][2 * hf]) + ub(gw, 0) * v[0]; o[hf][1] = bfhi(mm[bf][bj][2 * hf]) + ub(gw, 1) * v[1]; \
                o[hf][2] = bflo(mm[bf][bj][2 * hf + 1]) + ub(gw, 2) * v[2]; o[hf][3] = bfhi(mm[bf][bj][2 * hf + 1]) + ub(gw, 3) * v[3]; } \
            *(u32x4*)(mp + bj * HALF) = pack8(o[0], o[1]); } } while (0)
        EPI_PIPE(OUT_LOAD, OUT_COMP)
#undef OUT_LOAD
#undef OUT_COMP
    } };
__device__ __forceinline__ const float* src_row(const Params& p, int r);
struct EpiWo { static constexpr bool PERM = false; float* z; const Params* pp; int first;
    __device__ __forceinline__ void operator()(const f32x4 (&acc)[2][2][4][2], const Unit& u, int wr, int wc, int fr, int fq) const {
        EPI_ROWS({ if (r < NTOK) { float* zp = z + (size_t)r * D + col0; const float* rp = first ? src_row(*pp, r) + col0 : zp; f32x4 pv[4];
            _Pragma("unroll") for (int q = 0; q < 4; ++q) pv[q] = *(const f32x4*)(rp + QOFF(q));
            _Pragma("unroll") for (int q = 0; q < 4; ++q) *(f32x4*)(zp + QOFF(q)) = pv[q] + acc[ai][q >> 1][m][q & 1]; } })
    } };

__device__ __forceinline__ const float* src_row(const Params& p, int r) {
    int s, pos; if (r < 8224) { s = r / 4112; pos = r - s * 4112; } else { const int t = r - 8224; const int q = t / 2064; s = 2 + q; pos = t - q * 2064; }
    if (pos < 16) return p.in[2] + (size_t)pos * D;
    return s < 2 ? p.in[0] + ((size_t)s * 4096 + (pos - 16)) * D : p.in[1] + ((size_t)(s - 2) * 2048 + (pos - 16)) * D;
}
__device__ __forceinline__ void rmsnorm_phase(const int TID, const int BID, const Params& p, int l) {
    float* z = (float*)(p.ws + WS_Z); bf16_t* h = (bf16_t*)(p.ws + WS_H); const float* g = p.in[3] + (size_t)l * D;
    const int lane = TID & 63, gw = BID * 8 + (TID >> 6), nw = gridDim.x * 8;
    f32x4 gg[8];
#pragma unroll
    for (int i = 0; i < 8; ++i) gg[i] = *(const f32x4*)(g + (i * 64 + lane) * 4);
    f32x4 xn[8];
    { const int r0 = gw < NTOK ? gw : NTOK - 1; const float* src = (l == 0) ? src_row(p, r0) : z + (size_t)r0 * D;
#pragma unroll
      for (int i = 0; i < 8; ++i) xn[i] = *(const f32x4*)(src + (i * 64 + lane) * 4); }
    for (int r = gw; r < MP; r += nw) {
        bf16_t* hr = h + (size_t)r * D;
        f32x4 x[8];
#pragma unroll
        for (int i = 0; i < 8; ++i) x[i] = xn[i];
        { const int rn = (r + nw < NTOK) ? r + nw : NTOK - 1; const float* src = (l == 0) ? src_row(p, rn) : z + (size_t)rn * D;
#pragma unroll
          for (int i = 0; i < 8; ++i) xn[i] = *(const f32x4*)(src + (i * 64 + lane) * 4); }
        if (r >= NTOK) { for (int i = 0; i < 4; ++i) *(u32x4*)(hr + (i * 64 + lane) * 8) = (u32x4){0u, 0u, 0u, 0u}; continue; }
        float ss = 0.f;
#pragma unroll
        for (int i = 0; i < 8; ++i) ss += x[i][0] * x[i][0] + x[i][1] * x[i][1] + x[i][2] * x[i][2] + x[i][3] * x[i][3];
#pragma unroll
        for (int o = 32; o >= 1; o >>= 1) ss += __shfl_xor(ss, o);
        const float rs = rsqrtf(ss * (1.0f / D) + 1e-6f);
#pragma unroll
        for (int i = 0; i < 8; ++i) { const int c = (i * 64 + lane) * 4;
            u32x2 w; w.x = cvt_pk_bf16(x[i][0] * rs * gg[i][0], x[i][1] * rs * gg[i][1]); w.y = cvt_pk_bf16(x[i][2] * rs * gg[i][2], x[i][3] * rs * gg[i][3]); *(u32x2*)(hr + c) = w; }
    }
}
__device__ __forceinline__ void final_norm_phase(const int TID, const int BID, const Params& p) {
    const float* z = (const float*)(p.ws + WS_Z); const float* g = p.in[29];
    const int lane = TID & 63, gw = BID * 8 + (TID >> 6), nw = gridDim.x * 8;
    for (int r = gw; r < NTOK; r += nw) {
        int s, pos; if (r < 8224) { s = r / 4112; pos = r - s * 4112; } else { const int t = r - 8224; const int q = t / 2064; s = 2 + q; pos = t - q * 2064; }
        if (pos < 16) continue;
        float* dst = s < 2 ? p.out + ((size_t)s * 4096 + (pos - 16)) * D : p.out + (size_t)2 * 4096 * D + ((size_t)(s - 2) * 2048 + (pos - 16)) * D;
        const float* src = z + (size_t)r * D;
        f32x4 x[8]; float ss = 0.f;
#pragma unroll
        for (int i = 0; i < 8; ++i) { x[i] = *(const f32x4*)(src + (i * 64 + lane) * 4); ss += x[i][0] * x[i][0] + x[i][1] * x[i][1] + x[i][2] * x[i][2] + x[i][3] * x[i][3]; }
#pragma unroll
        for (int o = 32; o >= 1; o >>= 1) ss += __shfl_xor(ss, o);
        const float rs = rsqrtf(ss * (1.0f / D) + 1e-6f);
#pragma unroll
        for (int i = 0; i < 8; ++i) { const int c = (i * 64 + lane) * 4; const f32x4 gg = *(const f32x4*)(g + c); f32x4 o; o[0] = x[i][0] * rs * gg[0]; o[1] = x[i][1] * rs * gg[1]; o[2] = x[i][2] * rs * gg[2]; o[3] = x[i][3] * rs * gg[3]; *(f32x4*)(dst + c) = o; }
    }
}
__device__ __forceinline__ void conv_tile(const int TID, const float* src, int ldn, int k0, int n0, int nvalid, bf16_t* dst, int ldd, int kofs, bool mapin, LAS float* tile) {
    const int tx = TID & 63, ty = TID >> 6;
    const int ncl = (n0 + tx < nvalid) ? n0 + tx : nvalid - 1;
#pragma unroll
    for (int i = 0; i < 8; ++i) { const int k = ty + 8 * i; tile[k * 65 + tx] = src[(size_t)(k0 + k) * ldn + ncl]; }
    __syncthreads();
#pragma unroll
    for (int i = 0; i < 8; ++i) { const int nn = ty + 8 * i; int n = n0 + nn;
        if (n < nvalid) { if (mapin) n = (n < 2560) ? n : (n < 2592 ? n + (C_GLR - 2560) : n - 32); dst[(size_t)n * ldd + kofs + k0 + tx] = f2bf(tile[tx * 65 + nn]); } }
    __syncthreads();
}
__device__ __forceinline__ void convert_weights(const int TID, const int BID, const Params& p, int l, LAS float* tile) {
    const int G = gridDim.x, b = BID;
    bf16_t* btin = (bf16_t*)(p.ws + WS_BTIN); bf16_t* btout = (bf16_t*)(p.ws + WS_BTOUT); bf16_t* bto = (bf16_t*)(p.ws + WS_BTO); bf16_t* btglu = (bf16_t*)(p.ws + WS_BTGLU); bf16_t* btlru = (bf16_t*)(p.ws + WS_BTLRU);
    { const float* src = p.in[4] + (size_t)l * D * NIN; const int tx = TID & 63, ty = TID >> 6; float v[8];
      { const int t = b < 32 * 169 ? b : 0; const int kt = t / 169, ntl = t - kt * 169; const int ncl = (ntl * 64 + tx < NIN) ? ntl * 64 + tx : NIN - 1;
#pragma unroll
        for (int i = 0; i < 8; ++i) v[i] = src[(size_t)(kt * 64 + ty + 8 * i) * NIN + ncl]; }
      for (int t = b; t < 32 * 169; t += G) { const int kt = t / 169, ntl = t - kt * 169, k0 = kt * 64, n0 = ntl * 64;
#pragma unroll
          for (int i = 0; i < 8; ++i) tile[(ty + 8 * i) * 65 + tx] = v[i];
          { const int tn = (t + G < 32 * 169) ? t + G : t; const int ktn = tn / 169, ntn = tn - ktn * 169; const int ncl = (ntn * 64 + tx < NIN) ? ntn * 64 + tx : NIN - 1;
#pragma unroll
            for (int i = 0; i < 8; ++i) v[i] = src[(size_t)(ktn * 64 + ty + 8 * i) * NIN + ncl]; }
          LBAR();
#pragma unroll
          for (int i = 0; i < 8; ++i) { const int nn = ty + 8 * i; int n = n0 + nn;
              if (n < NIN) { n = (n < 2560) ? n : (n < 2592 ? n + (C_GLR - 2560) : n - 32); btin[(size_t)n * D + k0 + tx] = f2bf(tile[tx * 65 + nn]); } }
          LBAR(); } }
    for (size_t i = (size_t)b * 512 + TID; i < (size_t)(NINP - NIN) * D / 8; i += (size_t)G * 512) *(u32x4*)(btin + (size_t)NIN * D + i * 8) = (u32x4){0u, 0u, 0u, 0u};
    { const float* src = p.in[25] + (size_t)l * 512 * D; for (int t = (b + 64) % G; t < 8 * 32; t += G) { const int kt = t / 32, ntl = t - kt * 32; conv_tile(TID, src, D, kt * 64, ntl * 64, D, btout, D, 0, false, tile); } }
    { const float* src = p.in[26] + (size_t)l * 512 * D; for (int t = (b + 128) % G; t < 8 * 32; t += G) { const int kt = t / 32, ntl = t - kt * 32; conv_tile(TID, src, D, kt * 64, ntl * 64, D, btout, D, 512, false, tile); } }
    { const float* src = p.in[27] + (size_t)l * 1024 * D; for (int t = b; t < 16 * 32; t += G) { const int kt = t / 32, ntl = t - kt * 32; conv_tile(TID, src, D, kt * 64, ntl * 64, D, btout, D, 1024, false, tile); } }
    { const float* src = p.in[28] + (size_t)l * D * D; for (int t = b; t < 32 * 32; t += G) { const int kt = t / 32, ntl = t - kt * 32; conv_tile(TID, src, D, kt * 64, ntl * 64, D, bto, D, 0, false, tile); } }
    { const float* src = p.in[13] + (size_t)l * 512 * 512; for (int t = (b + 192) % G; t < 8 * 8; t += G) { const int kt = t / 8, ntl = t - kt * 8; conv_tile(TID, src, 512, kt * 64, ntl * 64, 512, btglu, 512, 0, false, tile); } }
    for (int t = (b + 32) % G; t < 128; t += G) { const int mat = t >> 2, sub = t & 3;
        const int dk = mat >> 3, nb = mat & 7, d = dk >> 1, kind = dk & 1;
        const float* src = p.in[kind ? 22 : 20] + ((size_t)(l * 2 + d) * 8 + nb) * 128 * 128;
        conv_tile(TID, src, 128, (sub >> 1) * 64, (sub & 1) * 64, 128, btlru + (size_t)mat * 128 * 128, 128, 0, false, tile); }
}
__device__ __forceinline__ double exp_small(double x) { double s = 1.0, t = 1.0; for (int i = 1; i <= 14; ++i) { t *= x / (double)i; s += t; } return s; }
__device__ __forceinline__ double exp_neg(double x) { double e = exp_small(x * (1.0 / 64.0)); for (int i = 0; i < 6; ++i) e *= e; return e; }
__device__ __forceinline__ void s5_tables_all(const int TID, const int BID, const Params& p) {
    for (int vidx = (int)(gridDim.x - 1 - BID) * 512 + TID; vidx < 4 * 4096; vidx += gridDim.x * 512) {
        const int l = vidx >> 12, idx = vidx & 4095;
        f32x2* pw = (f32x2*)(p.ws + WS_PW) + l * PWL; f32x2* bbar = (f32x2*)(p.ws + WS_BBAR) + l * BBL;
        const int g = idx >> 7, d = (idx >> 6) & 1, n = idx & 63;
        const double dt = exp_neg((double)p.in[7][(l * 2 + d) * 32 + g]);
        const double lr = (double)p.in[5][((size_t)(l * 2 + d) * 32 + g) * 64 + n], li = (double)p.in[6][((size_t)(l * 2 + d) * 32 + g) * 64 + n];
        const double mag = exp_neg(lr * dt);
        double ang = li * dt; const double twopi = 6.283185307179586476925287; ang -= twopi * rint(ang / twopi);
        const double a8 = ang * 0.125, a2 = a8 * a8;
        double sn = a8, cs = 1.0, ts = a8, tc = 1.0;
        for (int i = 1; i <= 9; ++i) { tc *= -a2 / (double)((2 * i - 1) * (2 * i)); cs += tc; ts *= -a2 / (double)((2 * i) * (2 * i + 1)); sn += ts; }
        for (int i = 0; i < 3; ++i) { const double c2 = cs * cs - sn * sn, s2 = 2.0 * cs * sn; cs = c2; sn = s2; }
        const double abr = mag * cs, abi = mag * sn;
        double pr = 1.0, pi = 0.0;
        for (int j = 0; j <= 16; ++j) { pw[((size_t)(g * 2 + d) * 17 + j) * 64 + n] = (f32x2){(float)pr, (float)pi}; const double nr = pr * abr - pi * abi, ni = pr * abi + pi * abr; pr = nr; pi = ni; }
        const double den = lr * lr + li * li, fr = ((abr - 1.0) * lr + abi * li) / den, fi = (abi * lr - (abr - 1.0) * li) / den;
        float brf[16], bif[16];
#pragma unroll
        for (int c4 = 0; c4 < 4; ++c4) { const f32x4 t0 = *(const f32x4*)(p.in[8] + (((size_t)l * 32 + g) * 64 + n) * 16 + c4 * 4), t1 = *(const f32x4*)(p.in[9] + (((size_t)l * 32 + g) * 64 + n) * 16 + c4 * 4);
#pragma unroll
            for (int e = 0; e < 4; ++e) { brf[c4 * 4 + e] = t0[e]; bif[c4 * 4 + e] = t1[e]; } }
#pragma unroll
        for (int c = 0; c < 16; ++c) { const double br = (double)brf[c], bi = (double)bif[c];
            bbar[((size_t)(g * 2 + d) * 64 + n) * 16 + c] = (f32x2){(float)(fr * br - fi * bi), (float)(fr * bi + fi * br)}; }
    }
}
__device__ __forceinline__ float s5_kval(const float* cre, const float* cim, const f32x2* pw, const f32x2* bbar, int l, int g, int d, int j, int c, int cp) {
    const float* cr = cre + (((size_t)(l * 2 + d) * 32 + g) * 16 + c) * 64; const float* ci = cim + (((size_t)(l * 2 + d) * 32 + g) * 16 + c) * 64;
    const f32x2* pp = pw + ((size_t)(g * 2 + d) * 17 + j) * 64; const f32x2* bb = bbar + ((size_t)(g * 2 + d) * 64) * 16 + cp;
    float s = 0.f;
#pragma unroll 16
    for (int n = 0; n < 64; ++n) { const f32x2 pv = pp[n]; const f32x2 bv = bb[(size_t)n * 16]; const float er = cr[n] * pv.x - ci[n] * pv.y, ei = cr[n] * pv.y + ci[n] * pv.x; s += er * bv.x - ei * bv.y; }
    return s;
}
__device__ __forceinline__ void s5_assemble_a(const int TID, const int BID, const Params& p, int l) {
    const f32x2* pw = (const f32x2*)(p.ws + WS_PW) + l * PWL; const f32x2* bbar = (const f32x2*)(p.ws + WS_BBAR) + l * BBL;
    float* kmat = (float*)(p.ws + WS_KMAT); bf16_t* pmat = (bf16_t*)(p.ws + WS_PMAT);
    const float* cre = p.in[10]; const float* cim = p.in[11];
    const size_t stride = (size_t)gridDim.x * 512;
    for (size_t idx = (size_t)BID * 512 + TID; idx < (size_t)32 * 2 * 16 * 256; idx += stride) {
        const int g = (int)(idx >> 13), d = (int)(idx >> 12) & 1, j = (int)(idx >> 8) & 15, c = (int)(idx >> 4) & 15, cp = (int)idx & 15;
        kmat[idx] = s5_kval(cre, cim, pw, bbar, l, g, d, j, c, cp);
    }
    for (size_t idx = (size_t)BID * 512 + TID; idx < (size_t)32 * 256 * 256; idx += stride) {
        const int g = (int)(idx >> 16), nout = (int)(idx >> 8) & 255, k = (int)idx & 255, d = nout >> 7, ri = (nout >> 6) & 1, n = nout & 63, s = k >> 4, cp = k & 15, j = d == 0 ? 15 - s : s;
        const f32x2 pv = pw[((size_t)(g * 2 + d) * 17 + j) * 64 + n]; const f32x2 bv = bbar[((size_t)(g * 2 + d) * 64 + n) * 16 + cp];
        pmat[idx] = f2bf(ri == 0 ? pv.x * bv.x - pv.y * bv.y : pv.x * bv.y + pv.y * bv.x);
    }
}
__device__ __forceinline__ void s5_assemble_w(const int TID, const int BID, const Params& p, int l) {
    const f32x2* pw = (const f32x2*)(p.ws + WS_PW) + l * PWL; const float* kmat = (const float*)(p.ws + WS_KMAT);
    bf16_t* wmat = (bf16_t*)(p.ws + WS_WMAT);
    const float* cre = p.in[10]; const float* cim = p.in[11];
    const size_t stride = (size_t)gridDim.x * 512;
    for (size_t idx = (size_t)BID * 512 + TID; idx < (size_t)32 * 256 * 512; idx += stride) {
        const int g = (int)(idx >> 17), nout = (int)(idx >> 9) & 255, k = (int)idx & 511, t = nout >> 4, c = nout & 15;
        float val;
        if (k < 256) { const int s = k >> 4, cp = k & 15; val = 0.f;
            const int jf = s <= t ? t - s : 0, jb = s >= t ? s - t : 0;
            const float kf = kmat[((((size_t)g * 2 + 0) * 16 + jf) * 16 + c) * 16 + cp], kb = kmat[((((size_t)g * 2 + 1) * 16 + jb) * 16 + c) * 16 + cp], dsk = p.in[12][l * 512 + g * 16 + c];
            val = (s <= t ? kf : 0.f) + (s >= t ? kb : 0.f) + ((s == t && c == cp) ? dsk : 0.f);
        } else { const int kk = k - 256, d = kk >> 7, ri = (kk >> 6) & 1, n = kk & 63, j = d == 0 ? t + 1 : 16 - t;
            const float cr = cre[(((size_t)(l * 2 + d) * 32 + g) * 16 + c) * 64 + n], ci = cim[(((size_t)(l * 2 + d) * 32 + g) * 16 + c) * 64 + n];
            const f32x2 pv = pw[((size_t)(g * 2 + d) * 17 + j) * 64 + n];
            val = ri == 0 ? cr * pv.x - ci * pv.y : -(cr * pv.y + ci * pv.x); }
        wmat[idx] = f2bf(val);
    }
}

__device__ __forceinline__ void scans_phase(const int TID, const int BID, const Params& p, const int l, const bool do_gla) {
    const int G = gridDim.x;
    const bool split = (G == 256);
    {
        const f32x2* pw = (const f32x2*)(p.ws + WS_PW) + l * PWL; const float* st = (const float*)(p.ws + WS_ST); bf16_t* ub = (bf16_t*)(p.ws + WS_UBUF);
        for (int idx = BID * 512 + TID; idx < 40960; idx += G * 512) {
            const int seq = idx >> 12, rem = idx & 4095, g = rem >> 7, d = (rem >> 6) & 1, n = rem & 63;
            const int ch0 = seq < 2 ? seq * 257 : 514 + (seq - 2) * 129, nc = seq < 2 ? 257 : 129;
            const f32x2 a16 = pw[((size_t)(g * 2 + d) * 17 + 16) * 64 + n];
            float sr = 0.f, si = 0.f;
            for (int s0 = 0; s0 < nc; s0 += 32) {
                float lr[32], li[32];
#pragma unroll
                for (int i = 0; i < 32; ++i) { const int step = s0 + i; lr[i] = 0.f; li[i] = 0.f;
                    { const int sc = step < nc ? step : nc - 1; const int c = d == 0 ? sc : nc - 1 - sc; const size_t row = (size_t)g * CHP + ch0 + c; lr[i] = st[row * 256 + d * 128 + n]; li[i] = st[row * 256 + d * 128 + 64 + n]; } }
#pragma unroll
                for (int i = 0; i < 32; ++i) { const int step = s0 + i;
                    if (step < nc) { const int c = d == 0 ? step : nc - 1 - step; const size_t row = (size_t)g * CHP + ch0 + c;
                        ub[row * 512 + 256 + d * 128 + n] = f2bf(sr); ub[row * 512 + 256 + d * 128 + 64 + n] = f2bf(si);
                        const float nr = a16.x * sr - a16.y * si + lr[i], ni = a16.x * si + a16.y * sr + li[i]; sr = nr; si = ni; } }
            }
        }
    }
    {
        const float* la = (const float*)(p.ws + WS_LRUA); const float* lh = (const float*)(p.ws + WS_LRUH); float* lc = (float*)(p.ws + WS_LRUC);
        const int vb0 = split ? BID - 80 : BID, vstride = split ? 1 << 20 : G;
        for (int vb = vb0; vb >= 0 && vb < 40; vb += vstride) {
            const int idx = vb * 512 + TID;
            const int seq = idx >> 11, d = (idx >> 10) & 1, ch = idx & 1023;
            const int cb = seq < 2 ? seq * 65 : 130 + (seq - 2) * 33, nc = seq < 2 ? 65 : 33;
            float cin = 0.f;
            for (int s0 = 0; s0 < nc; s0 += 16) {
                float A[16], H[16];
#pragma unroll
                for (int i = 0; i < 16; ++i) { const int step = s0 + i; A[i] = 1.f; H[i] = 0.f;
                    { const int sc = step < nc ? step : nc - 1; const int ci = cb + (d == 0 ? sc : nc - 1 - sc); const size_t o = ((size_t)ci * 2 + d) * 1024 + ch; A[i] = la[o]; H[i] = lh[o]; } }
#pragma unroll
                for (int i = 0; i < 16; ++i) { const int step = s0 + i;
                    if (step < nc) { const int ci = cb + (d == 0 ? step : nc - 1 - step); const size_t o = ((size_t)ci * 2 + d) * 1024 + ch; lc[o] = cin; cin = A[i] * cin + H[i]; } }
            }
        }
    }
    if (do_gla) {
        float* ds = (float*)(p.ws + WS_DS); const float* dec = (const float*)(p.ws + WS_DECAY);
        for (int it = 0; ; ++it) {
            int vb;
            if (split) { if (BID >= 120) { if (it >= 8) break; vb = (BID - 120) + 136 * it; } else { vb = 1088 + BID + 120 * it; if (vb >= 1280) break; } }
            else { vb = BID + G * it; if (vb >= 1280) break; }
            const int e = vb * 512 + TID;
            const int seq = e >> 16, rem = e & 65535, head = rem >> 14, d = (rem >> 13) & 1, el = rem & 8191, kk = el & 63;
            const int cb = seq < 2 ? seq * 65 : 130 + (seq - 2) * 33, nc = seq < 2 ? 65 : 33;
            float S = 0.f;
            for (int s0 = 0; s0 < nc; s0 += 16) {
                float tm[16], dc[16];
#pragma unroll
                for (int i = 0; i < 16; ++i) { const int step = s0 + i; tm[i] = 0.f; dc[i] = 1.f;
                    { const int sc = step < nc ? step : nc - 1; const int ci = cb + (d == 0 ? sc : nc - 1 - sc); const size_t o = ((size_t)(ci * 4 + head) * 2 + d); tm[i] = ds[o * 8192 + el]; dc[i] = dec[o * 64 + kk]; } }
#pragma unroll
                for (int i = 0; i < 16; ++i) { const int step = s0 + i;
                    if (step < nc) { const int ci = cb + (d == 0 ? step : nc - 1 - step); const size_t o = ((size_t)(ci * 4 + head) * 2 + d); ds[o * 8192 + el] = S; S = dc[i] * S + tm[i]; } }
            }
        }
    }
}

__device__ __forceinline__ f32x4 mma_lds(f32x4 acc, const LAS bf16_t* A, const LAS bf16_t* B, int ld, int nks, int lane) {
    const LAS bf16_t* ap = A + (lane & 15) * ld + (lane >> 4) * 8; const LAS bf16_t* bp = B + (lane & 15) * ld + (lane >> 4) * 8;
    for (int ks = 0; ks < nks; ++ks) acc = __builtin_amdgcn_mfma_f32_16x16x32_bf16(*(const LAS bf16x8*)(ap + ks * 32), *(const LAS bf16x8*)(bp + ks * 32), acc, 0, 0, 0);
    return acc;
}
__device__ __forceinline__ f32x4 mma_lds_sw(f32x4 acc, const LAS bf16_t* A, int rowA0, const LAS bf16_t* B, int rowB0, int ld, int nks, int lane) {
    const int swa = rowA0 >= 0 ? (((rowA0 + (lane & 15)) >> 3) & 7) : 0, swb = rowB0 >= 0 ? (((rowB0 + (lane & 15)) >> 3) & 7) : 0;
    const LAS bf16_t* ap = A + (lane & 15) * ld; const LAS bf16_t* bp = B + (lane & 15) * ld;
    for (int ks = 0; ks < nks; ++ks) { const int cb = ks * 4 + (lane >> 4);
        acc = __builtin_amdgcn_mfma_f32_16x16x32_bf16(*(const LAS bf16x8*)(ap + ((cb ^ swa) << 3)), *(const LAS bf16x8*)(bp + ((cb ^ swb) << 3)), acc, 0, 0, 0); }
    return acc;
}
#define SWZ(row, col) (((((col) >> 3) ^ (((row) >> 3) & 7)) << 3) + ((col) & 7))
constexpr int GL_GLR = 0, GL_BF = 16384, GL_BB = 32768, GL_OS = 0, GL_QE0 = 49152, GL_QE1 = 58368, GL_KE0 = 67584, GL_KE1 = 76800, GL_VT = 86016, GL_ATT = 104448, GL_SP0 = 113664, GL_SP1 = 132096;
constexpr int GLD = 72;
template <int MODE>
__device__ __forceinline__ void gla_item(const int TID, const Params& p, int l, int ci, int head, LAS unsigned char* lds, const float (&wg)[2][16], const float (&bg)[2], const float (&ngv)[16]) {
    const int tid = TID, lane = tid & 63, wid = tid >> 6;
    const bf16_t* cols = (const bf16_t*)(p.ws + WS_COLS);
    int seq, c; chunk_info(ci, seq, c);
    const int tok0 = seq_start(seq) + (c == 0 ? -48 : 16 + 64 * (c - 1));
    const int rmin = (c == 0) ? 48 : 0;
    LAS float* glr_s = (LAS float*)(lds + GL_GLR); LAS float* bfs = (LAS float*)(lds + GL_BF); LAS float* bbs = (LAS float*)(lds + GL_BB);
    f32x4 gbv[4];
    if (MODE == 1) { const float* gb = (const float*)(p.ws + WS_GB) + (size_t)(ci * 4 + head) * 8192;
#pragma unroll
      for (int i = 0; i < 4; ++i) gbv[i] = *(const f32x4*)(gb + (i * 512 + tid) * 4); }
    u32x4 kw = (u32x4){0u, 0u, 0u, 0u}, qw = kw, vwp[2], gwp[2];
    { const int r = tid >> 3, k8 = (tid & 7) * 8; const int rc = r >= rmin ? r : rmin; const bf16_t* rowp = cols + (size_t)(tok0 + rc) * NINP;
      kw = *(const u32x4*)(rowp + C_K + head * 64 + k8); if (MODE == 1) qw = *(const u32x4*)(rowp + C_Q + head * 64 + k8);
#pragma unroll
      for (int hh = 0; hh < 2; ++hh) { vwp[hh] = *(const u32x4*)(rowp + C_V + head * 128 + ((tid & 7) + 8 * hh) * 8); if (MODE == 1) gwp[hh] = *(const u32x4*)(rowp + C_GB + head * 128 + (tid & 7) * 16 + hh * 8); } }
    if (MODE == 0) {
    { const int r = tid >> 3, j4 = (tid & 7) * 4; f32x4 v = (f32x4){0.f, 0.f, 0.f, 0.f};
      { const int rc = r >= rmin ? r : rmin; const u32x2 w = *(const u32x2*)(cols + (size_t)(tok0 + rc) * NINP + C_GLR + j4); if (r >= rmin) { v[0] = bflo(w.x); v[1] = bfhi(w.x); v[2] = bflo(w.y); v[3] = bfhi(w.y); } }
      *(LAS f32x4*)(glr_s + r * 32 + j4) = v; }
    __syncthreads();
    { const int kk = tid & 63, rb = tid >> 6;
#pragma unroll
      for (int i = 0; i < 8; ++i) { const int r = rb + 8 * i; float x0 = bg[0], x1 = bg[1]; f32x4 gr[8];
#pragma unroll
          for (int j4 = 0; j4 < 8; ++j4) gr[j4] = *(const LAS f32x4*)(glr_s + r * 32 + j4 * 4);
#pragma unroll
          for (int j = 0; j < 16; ++j) { x0 += gr[j >> 2][j & 3] * wg[0][j]; x1 += gr[4 + (j >> 2)][j & 3] * wg[1][j]; }
          const bool ok = r >= rmin; bfs[r * 64 + kk] = ok ? logsig(x0) * 0.0625f : 0.f; bbs[r * 64 + kk] = ok ? logsig(x1) * 0.0625f : 0.f; } }
    __syncthreads();
    { const int col = tid & 127, part = tid >> 7, d = col >> 6, kk = col & 63; LAS float* bs = d ? bbs : bfs; LAS float* tot = glr_s;
      float v[16];
#pragma unroll
      for (int i = 0; i < 16; ++i) v[i] = bs[(part * 16 + i) * 64 + kk];
      if (d == 0) {
#pragma unroll
          for (int i = 1; i < 16; ++i) v[i] += v[i - 1];
          tot[part * 128 + col] = v[15]; }
      else {
#pragma unroll
          for (int i = 14; i >= 0; --i) v[i] += v[i + 1];
          tot[part * 128 + col] = v[0]; }
      __syncthreads();
      float off = 0.f;
#pragma unroll
      for (int pp = 0; pp < 4; ++pp) { const float t = tot[pp * 128 + col]; if (d == 0 ? pp < part : pp > part) off += t; }
#pragma unroll
      for (int i = 0; i < 16; ++i) bs[(part * 16 + i) * 64 + kk] = v[i] + off; }
    __syncthreads();
    { float* gb = (float*)(p.ws + WS_GB) + (size_t)(ci * 4 + head) * 8192;
#pragma unroll
      for (int i = 0; i < 4; ++i) { const int e = (i * 512 + tid) * 4; *(f32x4*)(gb + e) = *(const LAS f32x4*)(bfs + e); } }
    } else {
      __syncthreads();
#pragma unroll
      for (int i = 0; i < 4; ++i) { const int e = (i * 512 + tid) * 4; *(LAS f32x4*)(bfs + e) = gbv[i]; }
      __syncthreads();
    }
    LAS bf16_t* vT = (LAS bf16_t*)(lds + GL_VT);
    { const int r = tid >> 3, k8 = (tid & 7) * 8; const bool ok = r >= rmin;
      if (!ok) { kw = (u32x4){0u, 0u, 0u, 0u}; qw = kw; }
      float qv[8], kv[8];
#pragma unroll
      for (int i = 0; i < 4; ++i) { qv[2 * i] = bflo(qw[i]); qv[2 * i + 1] = bfhi(qw[i]); kv[2 * i] = bflo(kw[i]); kv[2 * i + 1] = bfhi(kw[i]); }
      if (MODE == 0) { LAS bf16_t* kd0 = (LAS bf16_t*)(lds + GL_QE0); LAS bf16_t* kd1 = (LAS bf16_t*)(lds + GL_QE1);
#pragma unroll
          for (int i = 0; i < 8; ++i) { const int kk = k8 + i; kd0[kk * GLD + SWZ(kk, r)] = f2bf(kv[i] * __expf(bfs[63 * 64 + kk] - bfs[r * 64 + kk])); kd1[kk * GLD + SWZ(kk, r)] = f2bf(kv[i] * __expf(bbs[kk] - bbs[r * 64 + kk])); }
      } else { LAS bf16_t* qe0 = (LAS bf16_t*)(lds + GL_QE0); LAS bf16_t* qe1 = (LAS bf16_t*)(lds + GL_QE1); LAS bf16_t* ke0 = (LAS bf16_t*)(lds + GL_KE0); LAS bf16_t* ke1 = (LAS bf16_t*)(lds + GL_KE1);
          u32x4 a, b2, c2, d2;
#pragma unroll
          for (int i = 0; i < 4; ++i) { const int kk = k8 + 2 * i; const float f0 = bfs[r * 64 + kk], f1 = bfs[r * 64 + kk + 1], g0 = bbs[r * 64 + kk], g1 = bbs[r * 64 + kk + 1];
              a[i] = cvt_pk_bf16(qv[2 * i] * 0.125f * __expf(f0), qv[2 * i + 1] * 0.125f * __expf(f1)); b2[i] = cvt_pk_bf16(qv[2 * i] * 0.125f * __expf(g0), qv[2 * i + 1] * 0.125f * __expf(g1));
              c2[i] = cvt_pk_bf16(kv[2 * i] * __expf(-f0), kv[2 * i + 1] * __expf(-f1)); d2[i] = cvt_pk_bf16(kv[2 * i] * __expf(-g0), kv[2 * i + 1] * __expf(-g1)); }
          *(LAS u32x4*)(qe0 + r * GLD + k8) = a; *(LAS u32x4*)(qe1 + r * GLD + k8) = b2; *(LAS u32x4*)(ke0 + r * GLD + k8) = c2; *(LAS u32x4*)(ke1 + r * GLD + k8) = d2; }
#pragma unroll
      for (int hh = 0; hh < 2; ++hh) { const int v8 = ((tid & 7) + 8 * hh) * 8; u32x4 vw = (u32x4){0u, 0u, 0u, 0u};
          if (ok) vw = vwp[hh];
#pragma unroll
          for (int i = 0; i < 4; ++i) { vT[(v8 + 2 * i) * GLD + SWZ(v8, r)] = (bf16_t)(vw[i] & 0xffffu); vT[(v8 + 2 * i + 1) * GLD + SWZ(v8, r)] = (bf16_t)(vw[i] >> 16); } }
    }
    if (MODE == 1) {
        const float* ds = (const float*)(p.ws + WS_DS); f32x4 sv[2][4];
#pragma unroll
        for (int d = 0; d < 2; ++d) { const float* src = ds + ((size_t)(ci * 4 + head) * 2 + d) * 8192;
#pragma unroll
            for (int i = 0; i < 4; ++i) sv[d][i] = *(const f32x4*)(src + (i * 512 + tid) * 4); }
#pragma unroll
        for (int d = 0; d < 2; ++d) { LAS bf16_t* sp = (LAS bf16_t*)(lds + (d ? GL_SP1 : GL_SP0));
#pragma unroll
            for (int i = 0; i < 4; ++i) { const int e = (i * 512 + tid) * 4; const f32x4 v = sv[d][i]; u32x2 w; w.x = cvt_pk_bf16(v[0], v[1]); w.y = cvt_pk_bf16(v[2], v[3]); *(LAS u32x2*)(sp + (e >> 6) * GLD + (e & 63)) = w; } }
    }
    __syncthreads();
    if (MODE == 0) {
        float* ds = (float*)(p.ws + WS_DS); float* dec = (float*)(p.ws + WS_DECAY);
        if (tid < 128) { const int d = tid >> 6, kk = tid & 63; dec[((size_t)(ci * 4 + head) * 2 + d) * 64 + kk] = __expf(d == 0 ? bfs[63 * 64 + kk] : bbs[kk]); }
#pragma unroll
        for (int d = 0; d < 2; ++d) { const LAS bf16_t* kd = (const LAS bf16_t*)(lds + (d ? GL_QE1 : GL_QE0)); float* dst = ds + ((size_t)(ci * 4 + head) * 2 + d) * 8192;
            for (int kt = 0; kt < 4; ++kt) { f32x4 acc = (f32x4){0.f, 0.f, 0.f, 0.f}; acc = mma_lds_sw(acc, vT + wid * 16 * GLD, wid * 16, kd + kt * 16 * GLD, kt * 16, GLD, 2, lane);
#pragma unroll
                for (int j = 0; j < 4; ++j) dst[(wid * 16 + (lane >> 4) * 4 + j) * 64 + kt * 16 + (lane & 15)] = acc[j]; } }
        __syncthreads();
        return;
    }
    const LAS bf16_t* qe0 = (const LAS bf16_t*)(lds + GL_QE0); const LAS bf16_t* qe1 = (const LAS bf16_t*)(lds + GL_QE1); const LAS bf16_t* ke0 = (const LAS bf16_t*)(lds + GL_KE0); const LAS bf16_t* ke1 = (const LAS bf16_t*)(lds + GL_KE1);
    LAS bf16_t* att = (LAS bf16_t*)(lds + GL_ATT);
    { const int it = wid >> 1;
#pragma unroll
      for (int t2 = 0; t2 < 2; ++t2) { const int jt = (wid & 1) * 2 + t2; f32x4 af = (f32x4){0.f, 0.f, 0.f, 0.f}, ab = af;
          af = mma_lds(af, qe0 + it * 16 * GLD, ke0 + jt * 16 * GLD, GLD, 2, lane); ab = mma_lds(ab, qe1 + it * 16 * GLD, ke1 + jt * 16 * GLD, GLD, 2, lane);
#pragma unroll
          for (int j = 0; j < 4; ++j) { const int i_ = it * 16 + (lane >> 4) * 4 + j, j_ = jt * 16 + (lane & 15); att[i_ * GLD + j_] = f2bf((j_ <= i_ ? af[j] : 0.f) + (j_ >= i_ ? ab[j] : 0.f)); } } }
    __syncthreads();
    LAS float* os = (LAS float*)(lds + GL_OS);
    { const int it = wid >> 1; const LAS bf16_t* sp0 = (const LAS bf16_t*)(lds + GL_SP0); const LAS bf16_t* sp1 = (const LAS bf16_t*)(lds + GL_SP1);
#pragma unroll
      for (int t4 = 0; t4 < 4; ++t4) { const int vt = (wid & 1) * 4 + t4; f32x4 acc = (f32x4){0.f, 0.f, 0.f, 0.f};
          acc = mma_lds_sw(acc, att + it * 16 * GLD, -1, vT + vt * 16 * GLD, vt * 16, GLD, 2, lane); acc = mma_lds(acc, qe0 + it * 16 * GLD, sp0 + vt * 16 * GLD, GLD, 2, lane); acc = mma_lds(acc, qe1 + it * 16 * GLD, sp1 + vt * 16 * GLD, GLD, 2, lane);
#pragma unroll
          for (int j = 0; j < 4; ++j) os[(it * 16 + (lane >> 4) * 4 + j) * 132 + vt * 16 + (lane & 15)] = acc[j]; } }
    __syncthreads();
    { const int r = tid >> 3, v0 = (tid & 7) * 16; float o[16]; float ss = 0.f;
#pragma unroll
      for (int i = 0; i < 16; ++i) { o[i] = os[r * 132 + v0 + i]; ss += o[i] * o[i]; }
      ss += __shfl_xor(ss, 1); ss += __shfl_xor(ss, 2); ss += __shfl_xor(ss, 4);
      const float rs = rsqrtf(ss * (1.0f / 128.0f) + 1e-6f);
      if (r >= rmin) { const size_t tok = (size_t)(tok0 + r); bf16_t* yall = (bf16_t*)(p.ws + WS_YALL);
#pragma unroll
          for (int hh = 0; hh < 2; ++hh) { const u32x4 gw = gwp[hh]; u32x4 w;
#pragma unroll
              for (int i = 0; i < 4; ++i) { const int e = hh * 8 + 2 * i; w[i] = cvt_pk_bf16(o[e] * rs * ngv[e] * silu(bflo(gw[i])), o[e + 1] * rs * ngv[e + 1] * silu(bfhi(gw[i]))); }
              *(u32x4*)(yall + tok * D + 512 + head * 128 + v0 + hh * 8) = w; } } }
    __syncthreads();
}

__device__ __forceinline__ float softplus_neg(float lam) { const float e = __expf(-lam); return lam + 0.f < -8.f ? -lam : (e < 0.02f ? e * (1.0f - e * (0.5f - e * (1.0f / 3.0f))) : __logf(1.0f + e)); }
__device__ __forceinline__ float one_minus_exp(float x) {
    return x > -0.5f ? -x * (1.0f + x * 0.5f * (1.0f + x * (1.0f / 3.0f) * (1.0f + x * 0.25f * (1.0f + x * 0.2f * (1.0f + x * (1.0f / 6.0f) * (1.0f + x * (1.0f / 7.0f))))))) : 1.0f - __expf(x);
}
template <int MODE>
__device__ __forceinline__ void lru_phase(const int TID, const int b, const int G, const Params& p, int l, LAS unsigned char* lds) {
    const int tid = TID, lane = tid & 63, wid = tid >> 6, q = lane >> 4;
    const bf16_t* cols = (const bf16_t*)(p.ws + WS_COLS);
    int it = b; if (it >= NCK * 8) return;
    const int nb = b & 7;
    LAS bf16_t* xcA = (LAS bf16_t*)lds; LAS float* xcf = (LAS float*)(lds + 17408);
    const int ch = tid & 127, rb = tid >> 7, gchc = nb * 128 + ch;
    const float w0 = p.in[18][(l * 4 + 0) * 1024 + gchc], w1 = p.in[18][(l * 4 + 1) * 1024 + gchc], w2 = p.in[18][(l * 4 + 2) * 1024 + gchc], w3 = p.in[18][(l * 4 + 3) * 1024 + gchc], cb = p.in[19][l * 1024 + gchc];
    const int chl = wid * 16 + (lane & 15), gch = nb * 128 + chl;
    float ba[2], bx[2], sp8[2];
#pragma unroll
    for (int d = 0; d < 2; ++d) { ba[d] = p.in[21][(l * 2 + d) * 1024 + gch]; bx[d] = p.in[23][(l * 2 + d) * 1024 + gch]; sp8[d] = 8.0f * softplus_neg(p.in[24][(l * 2 + d) * 1024 + gch]); }
    bf16x8 bfr[4][4];
    { const bf16_t* bt = (const bf16_t*)(p.ws + WS_BTLRU);
#pragma unroll
      for (int mat = 0; mat < 4; ++mat)
#pragma unroll
          for (int ks = 0; ks < 4; ++ks) bfr[mat][ks] = *(const bf16x8*)(bt + ((size_t)(mat * 8 + nb) * 128 + wid * 16 + (lane & 15)) * 128 + ks * 32 + q * 8); }
    bf16_t xr[19];
    { int seq, c; chunk_info(it >> 3, seq, c); const int s0 = seq_start(seq), L = seq_len(seq), pos0 = (c == 0 ? -48 : 16 + 64 * (c - 1));
      const bf16_t* xb = cols + (size_t)s0 * NINP + C_XC + gchc;
#pragma unroll
      for (int i = 0; i < 19; ++i) { const int pos = pos0 + rb * 16 - 2 + i; const int pc = pos < 0 ? 0 : (pos < L ? pos : L - 1); xr[i] = xb[(size_t)pc * NINP]; } }
    for (; it < NCK * 8; it += G) {
        const int ci = it >> 3;
        int seq, c; chunk_info(ci, seq, c);
        const int s0 = seq_start(seq);
        const int pos0 = (c == 0 ? -48 : 16 + 64 * (c - 1));
        const int rmin = (c == 0) ? 48 : 0;
        float xv[19];
        { const int L = seq_len(seq);
#pragma unroll
          for (int i = 0; i < 19; ++i) { const int pos = pos0 + rb * 16 - 2 + i; xv[i] = (pos >= 0 && pos < L) ? bf2f(xr[i]) : 0.f; } }
#pragma unroll
        for (int i = 0; i < 16; ++i) { const int r = rb * 16 + i; const float xc = (r >= rmin) ? cb + xv[i] * w0 + xv[i + 1] * w1 + xv[i + 2] * w2 + xv[i + 3] * w3 : 0.f;
            xcf[r * 132 + ch] = xc; xcA[r * 136 + ch] = f2bf(xc); }
        u32x4 gq[2]; float cin[2];
        if (MODE == 1) {
#pragma unroll
            for (int d = 0; d < 2; ++d) cin[d] = ((const float*)(p.ws + WS_LRUC))[((size_t)ci * 2 + d) * 1024 + gch];
            { const int r = tid >> 3; const int rr = r >= rmin ? r : rmin; const bf16_t* gp = cols + (size_t)(s0 + pos0 + rr) * NINP + C_GC + nb * 128 + (tid & 7) * 16;
              gq[0] = *(const u32x4*)gp; gq[1] = *(const u32x4*)(gp + 8); }
        }
        { const int itn = it + G;
          if (itn < NCK * 8) { int seqn, cn; chunk_info(itn >> 3, seqn, cn); const int s0n = seq_start(seqn), Ln = seq_len(seqn), pos0n = (cn == 0 ? -48 : 16 + 64 * (cn - 1));
              const bf16_t* xb = cols + (size_t)s0n * NINP + C_XC + gchc;
#pragma unroll
              for (int i = 0; i < 19; ++i) { const int pos = pos0n + rb * 16 - 2 + i; const int pc = pos < 0 ? 0 : (pos < Ln ? pos : Ln - 1); xr[i] = xb[(size_t)pc * NINP]; } } }
        LBAR();
        LAS bf16_t* gts = (LAS bf16_t*)(lds + 51200); LAS float* hfs = (LAS float*)(lds + 68608);
        float hsum[4][4];
#pragma unroll
        for (int d = 0; d < 2; ++d) {
            __builtin_amdgcn_sched_barrier(0);
            f32x4 acc[2][4];
#pragma unroll
            for (int rt = 0; rt < 4; ++rt) { bf16x8 afr[4];
#pragma unroll
                for (int ks = 0; ks < 4; ++ks) afr[ks] = *(const LAS bf16x8*)(xcA + (rt * 16 + (lane & 15)) * 136 + ks * 32 + q * 8);
#pragma unroll
                for (int kind = 0; kind < 2; ++kind) { f32x4 a = (f32x4){0.f, 0.f, 0.f, 0.f};
#pragma unroll
                    for (int ks = 0; ks < 4; ++ks) a = __builtin_amdgcn_mfma_f32_16x16x32_bf16(afr[ks], bfr[d * 2 + kind][ks], a, 0, 0, 0);
                    acc[kind][rt] = a; } }
            float a[4][4], bb[4][4];
#pragma unroll
            for (int rt = 0; rt < 4; ++rt)
#pragma unroll
                for (int j = 0; j < 4; ++j) { const int r = rt * 16 + q * 4 + j; const float rg = sigm(acc[0][rt][j] + ba[d]), ig = sigm(acc[1][rt][j] + bx[d]), la = -sp8[d] * rg;
                    const bool ok = r >= rmin; const float av = __expf(la), x2 = 2.0f * la; const float om = x2 > -0.25f ? -x2 * (1.0f + x2 * 0.5f * (1.0f + x2 * (1.0f / 3.0f) * (1.0f + x2 * 0.25f * (1.0f + x2 * 0.2f)))) : 1.0f - av * av;
                    a[rt][j] = ok ? av : 1.0f; bb[rt][j] = ok ? __builtin_amdgcn_sqrtf(om) * ig * xcf[r * 132 + chl] : 0.f; }
            float LA[4], LB[4];
#pragma unroll
            for (int rt = 0; rt < 4; ++rt) { float A = 1.f, B = 0.f;
#pragma unroll
                for (int jj = 0; jj < 4; ++jj) { const int j = d == 0 ? jj : 3 - jj; B = a[rt][j] * B + bb[rt][j]; A *= a[rt][j]; }
                LA[rt] = A; LB[rt] = B; }
            const size_t co = ((size_t)ci * 2 + d) * 1024 + gch;
            float h = (MODE == 1) ? cin[d] : 0.f, Atot = 1.f; float hin[4];
#pragma unroll
            for (int rr = 0; rr < 4; ++rr) { const int rt = d == 0 ? rr : 3 - rr;
#pragma unroll
                for (int qi = 0; qi < 4; ++qi) { const int qq = d == 0 ? qi : 3 - qi;
                    const float Aq = __shfl(LA[rt], (lane & 15) + 16 * qq), Bq = __shfl(LB[rt], (lane & 15) + 16 * qq);
                    if (qq == q) hin[rt] = h;
                    h = Aq * h + Bq; Atot *= Aq; } }
            if (MODE == 0) { if (q == 0) { ((float*)(p.ws + WS_LRUA))[co] = Atot; ((float*)(p.ws + WS_LRUH))[co] = h; } }
            else {
#pragma unroll
                for (int rt = 0; rt < 4; ++rt) { float hh = hin[rt];
#pragma unroll
                    for (int jj = 0; jj < 4; ++jj) { const int j = d == 0 ? jj : 3 - jj; hh = a[rt][j] * hh + bb[rt][j];
                        if (d == 0) hfs[(rt * 16 + q * 4 + j) * 132 + chl] = hh; else hsum[rt][j] = hh; } }
                if (d == 0) { *(LAS u32x4*)(gts + (tid >> 3) * 136 + (tid & 7) * 16) = gq[0]; *(LAS u32x4*)(gts + (tid >> 3) * 136 + (tid & 7) * 16 + 8) = gq[1]; } }
        }
        if (MODE == 1) { bf16_t* yall = (bf16_t*)(p.ws + WS_YALL);
            LBAR();
#pragma unroll
            for (int rt = 0; rt < 4; ++rt)
#pragma unroll
                for (int j = 0; j < 4; ++j) { const int r = rt * 16 + q * 4 + j; xcA[r * 136 + chl] = f2bf((hsum[rt][j] + hfs[r * 132 + chl]) * silu(bf2f(gts[r * 136 + chl]))); }
            LBAR();
            { const int r = tid >> 3; if (r >= rmin) { const u32x4 y0 = *(const LAS u32x4*)(xcA + r * 136 + (tid & 7) * 16), y1 = *(const LAS u32x4*)(xcA + r * 136 + (tid & 7) * 16 + 8);
                bf16_t* yp = yall + (size_t)(s0 + pos0 + r) * D + 1024 + nb * 128 + (tid & 7) * 16; *(u32x4*)yp = y0; *(u32x4*)(yp + 8) = y1; } } }
        LBAR();
    }
}


template <int WHICH>
__device__ __forceinline__ void skinny_tail(const int TID, const int b0, const Params& p, const int first) {
    const int lane = TID & 63, wid = TID >> 6, q = lane >> 4;
    if (wid >= 5) return;
    for (int b = b0; b < 256; b += (int)gridDim.x) {
    const int ct = b & 127, rt = (b >> 7) * 5 + wid;
    const int row = 24576 + rt * 16 + (lane & 15);
    const int colb = ct * 16 + (lane & 15);
    const bf16_t* cols = (const bf16_t*)(p.ws + WS_COLS);
    if (WHICH == 0) {
        const bf16_t* A = (const bf16_t*)(p.ws + WS_YALL) + (size_t)row * D + q * 8; const bf16_t* B = (const bf16_t*)(p.ws + WS_BTOUT) + (size_t)colb * D + q * 8;
        bf16_t* mbf = (bf16_t*)(p.ws + WS_H);
        f32x4 msum = (f32x4){0.f, 0.f, 0.f, 0.f};
        unsigned char gt[3][4];
#pragma unroll
        for (int br = 0; br < 3; ++br)
#pragma unroll
            for (int j = 0; j < 4; ++j) { const int cc = colb & 255; gt[br][j] = ((const unsigned char*)(cols + (size_t)(24576 + rt * 16 + q * 4 + j) * NINP + C_MG))[(br * 8 + (colb >> 8)) * 256 + ((((cc & 127) >> 5) * 4 + ((cc & 31) >> 3)) * 2 + (cc >> 7)) * 8 + (cc & 7)]; }
        float gs[3][4];
#pragma unroll
        for (int br = 0; br < 3; ++br)
#pragma unroll
            for (int j = 0; j < 4; ++j) { gs[br][j] = (float)gt[br][j] * (1.0f / 255.0f); asm volatile("" : "+v"(gs[br][j])); }
#pragma unroll
        for (int br = 0; br < 3; ++br) { const int koff = br * 512, nks = br == 2 ? 32 : 16; f32x4 acc = (f32x4){0.f, 0.f, 0.f, 0.f};
            for (int k0 = 0; k0 < nks; k0 += 8) { bf16x8 av[8], bv[8];
#pragma unroll
                for (int i = 0; i < 8; ++i) { av[i] = *(const bf16x8*)(A + koff + (k0 + i) * 32); bv[i] = *(const bf16x8*)(B + koff + (k0 + i) * 32); }
#pragma unroll
                for (int i = 0; i < 8; ++i) acc = __builtin_amdgcn_mfma_f32_16x16x32_bf16(av[i], bv[i], acc, 0, 0, 0); }
#pragma unroll
            for (int j = 0; j < 4; ++j) msum[j] += gs[br][j] * acc[j]; }
#pragma unroll
        for (int j = 0; j < 4; ++j) { const int tok = 24576 + rt * 16 + q * 4 + j; mbf[(size_t)tok * D + colb] = f2bf(msum[j]); }
    } else {
        const bf16_t* A = (const bf16_t*)(p.ws + WS_H) + (size_t)row * D + q * 8; const bf16_t* B = (const bf16_t*)(p.ws + WS_BTO) + (size_t)colb * D + q * 8;
        float* z = (float*)(p.ws + WS_Z);
        f32x4 acc = (f32x4){0.f, 0.f, 0.f, 0.f};
        for (int k0 = 0; k0 < 64; k0 += 8) { bf16x8 av[8], bv[8];
#pragma unroll
            for (int i = 0; i < 8; ++i) { av[i] = *(const bf16x8*)(A + (k0 + i) * 32); bv[i] = *(const bf16x8*)(B + (k0 + i) * 32); }
#pragma unroll
            for (int i = 0; i < 8; ++i) acc = __builtin_amdgcn_mfma_f32_16x16x32_bf16(av[i], bv[i], acc, 0, 0, 0); }
#pragma unroll
        for (int j = 0; j < 4; ++j) { const int tok = 24576 + rt * 16 + q * 4 + j; const float res = first ? src_row(p, tok)[colb] : z[(size_t)tok * D + colb]; z[(size_t)tok * D + colb] = res + acc[j]; }
    }
    }
}

#define XB_TMO      128
#define XB_XCNT(j)  (256  + 64 * (j))
#define XB_XSUB(j)  (1280 + 64 * (j))
#define XB_XGEN(j)  (2304 + 64 * (j))
#define XB_TOP      3328
#define XB_TOPGEN   3392
#define XCD_BAR_WORDS 3456
#define XB_SPIN_CAP (1u << 18)
__device__ __forceinline__ unsigned xb_ld(unsigned* p)              { return __hip_atomic_load(p, __ATOMIC_RELAXED, __HIP_MEMORY_SCOPE_AGENT); }
__device__ __forceinline__ unsigned xb_add(unsigned* p, unsigned v) { return __hip_atomic_fetch_add(p, v, __ATOMIC_RELAXED, __HIP_MEMORY_SCOPE_AGENT); }
__device__ __forceinline__ unsigned xb_xcc_id() { return (unsigned)__builtin_amdgcn_s_getreg((3 << 11) | 20) & 0xFu; }
#define XB_SPIN(cond, bar) do { unsigned _sp = 0; while (cond) { __builtin_amdgcn_s_sleep(1); \
    if ((++_sp & 255u) == 0u) { if (xb_ld(&(bar)[XB_TMO])) break; if (_sp > XB_SPIN_CAP) { atomicAdd(&(bar)[XB_TMO], 1u); break; } } } } while (0)
struct XcdBarrier { unsigned* bar; unsigned x; volatile LAS unsigned* st; };
__device__ __forceinline__ XcdBarrier xcd_barrier_post(unsigned* bar, volatile LAS unsigned* st) {
    XcdBarrier b; b.bar = bar; b.x = xb_xcc_id(); b.st = st;
    if (threadIdx.x == 0) (void)xb_add(&bar[XB_XCNT(b.x)], 1u);
    return b;
}
__device__ __forceinline__ void xcd_barrier_complete(unsigned* bar, unsigned x, unsigned& nloc, unsigned& nx) {
    const unsigned G = gridDim.x * gridDim.y * gridDim.z;
    unsigned sum, cnt, mine, sp = 0u;
    for (;;) {
        sum = 0u; cnt = 0u; mine = 0u;
#pragma unroll
        for (unsigned j = 0; j < 16; ++j) { const unsigned c = xb_ld(&bar[XB_XCNT(j)]); sum += c; cnt += (c > 0u) ? 1u : 0u; mine = (j == x) ? c : mine; }
        if (sum == G) break;
        __builtin_amdgcn_s_sleep(1);
        if ((++sp & 255u) == 0u) { if (xb_ld(&bar[XB_TMO])) break; if (sp > XB_SPIN_CAP) { atomicAdd(&bar[XB_TMO], 1u); break; } }
    }
    nloc = mine > 0u ? mine : 1u; nx = cnt > 0u ? cnt : 1u;
}
__device__ __forceinline__ void xcd_barrier(const XcdBarrier& b) {
    asm volatile("s_waitcnt vmcnt(0)" ::: "memory");
    __syncthreads();
    if (threadIdx.x == 0) {
        unsigned* bar = b.bar;
        __builtin_amdgcn_s_waitcnt(0);
        unsigned nloc = b.st[0], nx = b.st[1];
        if (nloc == 0u) { xcd_barrier_complete(bar, b.x, nloc, nx); b.st[0] = nloc; b.st[1] = nx; }
        const unsigned old = xb_add(&bar[XB_XSUB(b.x)], 1u);
        const unsigned gen = old / nloc;
        if (old + 1u == (gen + 1u) * nloc) {
            __builtin_amdgcn_fence(__ATOMIC_RELEASE, "agent");
            asm volatile("s_waitcnt vmcnt(0)" ::: "memory");
            const unsigned og = xb_add(&bar[XB_TOP], 1u);
            const unsigned tg = og / nx;
            if (og + 1u == (tg + 1u) * nx) xb_add(&bar[XB_TOPGEN], 1u);
            else XB_SPIN(xb_ld(&bar[XB_TOPGEN]) == tg, bar);
            __builtin_amdgcn_fence(__ATOMIC_ACQUIRE, "agent");
            xb_add(&bar[XB_XGEN(b.x)], 1u);
            asm volatile("s_waitcnt vmcnt(0)" ::: "memory");
        } else {
            XB_SPIN(xb_ld(&bar[XB_XGEN(b.x)]) == gen, bar);
            __builtin_amdgcn_fence(__ATOMIC_ACQUIRE, "agent");
            asm volatile("s_waitcnt vmcnt(0)" ::: "memory");
        }
    }
    __syncthreads();
}

__global__ void __launch_bounds__(512) fwd_megakernel(Params p_in) {
    extern __shared__ __attribute__((aligned(16))) unsigned char smem[];
    LAS unsigned char* lds = (LAS unsigned char*)smem;
    cg::grid_group grid = cg::this_grid();
    const int G = gridDim.x;
    const Params& p0 = p_in;
    volatile LAS unsigned* stw = (volatile LAS unsigned*)(lds + 150528);
    if (threadIdx.x == 0) { stw[0] = 0u; stw[1] = 0u; }
    __syncthreads();
    const XcdBarrier xb = xcd_barrier_post((unsigned*)(p_in.ws + WS_BAR), stw);
    for (int ph = p0.ph_lo; ph < p0.ph_hi; ++ph) {
        const int reps_ = (ph < 32 && (ph & 7) == DUP) ? 2 : 1;
        for (int rep_ = 0; rep_ < reps_; ++rep_) {
        int TID = threadIdx.x; asm volatile("" : "+v"(TID));
        int b = blockIdx.x; asm volatile("" : "+s"(b));
        Params p = p0; { unsigned long long t_ = (unsigned long long)p.ws; asm volatile("" : "+s"(t_)); p.ws = (unsigned char*)t_; }
        const char* ws = (const char*)p.ws;
        if (ph == 32) { final_norm_phase(TID, b, p); }
        else {
            const int l = ph >> 3, k = ph & 7;
            if (k == 0 && (PHM & 1)) { rmsnorm_phase(TID, b, p, l); convert_weights(TID, b, p, l, (LAS float*)lds); if (l == 0) s5_tables_all(TID, b, p); }
            else if (k == 1 && (PHM & 2)) {
                TileOrder S; S.nM = MP / 256; S.nN = NINP / 256; S.nwg = S.nM * S.nN; S.G = G; S.c = b; S.mult = 1; S.nt0 = D / 64; S.A = ws + WS_H; S.B = ws + WS_BTIN; S.tA = (size_t)256 * D * 2; S.tB = (size_t)256 * D * 2;
                EpiIn E; E.cols = (bf16_t*)(p.ws + WS_COLS); E.ubuf = (bf16_t*)(p.ws + WS_UBUF);
                gemm_phase(TID, lds, D, D, S, E);
                s5_assemble_a(TID, b, p, l);
            } else if (k == 2 && (PHM & 4)) {
                GroupOrder S; S.G = G; S.c = b; S.nt0 = 4; S.A = ws + WS_UBUF; S.B = ws + WS_PMAT; S.gsA = (size_t)CHP * 512 * 2; S.gsB = (size_t)256 * 256 * 2; S.tA = (size_t)256 * 512 * 2;
                EpiS5State E; E.st = (float*)(p.ws + WS_ST);
                if (SUBM & 4) gemm_phase(TID, lds, 512, 256, S, E);
                __syncthreads();
                { const int head_ = ((b + 128) % G) & 3, kk_ = TID & 63; float wg_[2][16], bg_[2];
                  _Pragma("unroll") for (int d = 0; d < 2; ++d) { bg_[d] = p.in[16][(l * 2 + d) * 256 + head_ * 64 + kk_]; _Pragma("unroll") for (int j = 0; j < 16; ++j) wg_[d][j] = p.in[15][((size_t)(l * 2 + d) * 16 + j) * 256 + head_ * 64 + kk_]; }
                  float ng_[16]; _Pragma("unroll") for (int e = 0; e < 16; ++e) ng_[e] = p.in[17][l * 512 + head_ * 128 + (TID & 7) * 16 + e];
                  for (int it = (b + 128) % G; it < NCK * 4; it += G) gla_item<0>(TID, p, l, it >> 2, it & 3, lds, wg_, bg_, ng_); }
                lru_phase<0>(TID, b, G, p, l, lds);
                s5_assemble_w(TID, b, p, l);
            } else if (k == 3 && (PHM & 8)) { scans_phase(TID, b, p, l, rep_ == 0); }
            else if (k == 4 && (PHM & 16)) {
                GroupOrder S; S.G = G; S.c = b; S.nt0 = 8; S.A = ws + WS_UBUF; S.B = ws + WS_WMAT; S.gsA = (size_t)CHP * 512 * 2; S.gsB = (size_t)256 * 512 * 2; S.tA = (size_t)256 * 512 * 2;
                EpiS5Out E; E.zs5 = (bf16_t*)(p.ws + WS_ZS5);
                if (SUBM & 4) gemm_phase(TID, lds, 512, 512, S, E);
                __syncthreads();
                { const int head_ = ((b + 128) % G) & 3, kk_ = TID & 63; float wg_[2][16], bg_[2];
                  _Pragma("unroll") for (int d = 0; d < 2; ++d) { bg_[d] = p.in[16][(l * 2 + d) * 256 + head_ * 64 + kk_]; _Pragma("unroll") for (int j = 0; j < 16; ++j) wg_[d][j] = p.in[15][((size_t)(l * 2 + d) * 16 + j) * 256 + head_ * 64 + kk_]; }
                  float ng_[16]; _Pragma("unroll") for (int e = 0; e < 16; ++e) ng_[e] = p.in[17][l * 512 + head_ * 128 + (TID & 7) * 16 + e];
                  for (int it = (b + 128) % G; it < NCK * 4; it += G) gla_item<1>(TID, p, l, it >> 2, it & 3, lds, wg_, bg_, ng_); }
                lru_phase<1>(TID, b, G, p, l, lds);
            } else if (k == 5 && (PHM & 32)) {
                TileOrder S; S.nM = MP / 256; S.nN = 2; S.nwg = S.nM * S.nN; S.G = G; S.c = b; S.mult = 1; S.nt0 = 8; S.A = ws + WS_ZS5; S.B = ws + WS_BTGLU; S.tA = (size_t)256 * 512 * 2; S.tB = (size_t)256 * 512 * 2;
                EpiGlu E; E.zs5 = (const bf16_t*)(p.ws + WS_ZS5); E.cols = (const bf16_t*)(p.ws + WS_COLS); E.bglu = p.in[14] + l * 512; E.yall = (bf16_t*)(p.ws + WS_YALL);
                gemm_phase(TID, lds, 512, 512, S, E);
            } else if (k == 6 && (PHM & 64)) {
                TileOrder S; S.nM = 96; S.nN = 8; S.nwg = S.nM * S.nN; S.G = G; S.c = b; S.mult = 3; S.nt0 = 8; S.A = ws + WS_YALL; S.B = ws + WS_BTOUT; S.tA = (size_t)256 * D * 2; S.tB = (size_t)256 * D * 2;
                EpiOut E; E.cols = (const bf16_t*)(p.ws + WS_COLS); E.mbf = (bf16_t*)(p.ws + WS_H);
                gemm_phase(TID, lds, D, D, S, E);
                skinny_tail<0>(TID, b, p, 0);
            } else if (PHM & 128) {
                TileOrder S; S.nM = 96; S.nN = 8; S.nwg = S.nM * S.nN; S.G = G; S.c = b; S.mult = 1; S.nt0 = D / 64; S.A = ws + WS_H; S.B = ws + WS_BTO; S.tA = (size_t)256 * D * 2; S.tB = (size_t)256 * D * 2;
                EpiWo E; E.z = (float*)(p.ws + WS_Z); E.pp = &p; E.first = (l == 0);
                gemm_phase(TID, lds, D, D, S, E);
                skinny_tail<1>(TID, b, p, l == 0);
            }
        }
        }
        if (p0.use_sync && ph + 1 < p0.ph_hi) { if (ph == p0.ph_lo) grid.sync(); else xcd_barrier(xb); }
    }
}

extern "C" void kernel_launch(void* const* d_in, const int* in_sizes, int n_in, void* d_out, int out_size, void* d_ws, size_t ws_size, hipStream_t stream) {
    static int grid = 0, coop = 1;
    if (grid == 0) {
        if (n_in != 30 || ws_size < WS_END2) { fprintf(stderr, "kernel_launch: unexpected n_in %d or ws_size %zu (< %zu)\n", n_in, ws_size, (size_t)WS_END); grid = -1; return; }
        int dev = 0, cus = 0, per_cu = 0;
        (void)hipGetDevice(&dev); (void)hipDeviceGetAttribute(&cus, hipDeviceAttributeMultiprocessorCount, dev);
        if (hipFuncSetAttribute((const void*)fwd_megakernel, hipFuncAttributeMaxDynamicSharedMemorySize, LDS_BYTES) != hipSuccess) { fprintf(stderr, "kernel_launch: hipFuncSetAttribute failed\n"); grid = -1; return; }
        if (hipOccupancyMaxActiveBlocksPerMultiprocessor(&per_cu, (const void*)fwd_megakernel, 512, LDS_BYTES) != hipSuccess || per_cu < 1) { fprintf(stderr, "kernel_launch: occupancy query gave %d\n", per_cu); per_cu = 1; }
        (void)hipGetLastError();
        grid = cus * 1;
    }
    if (grid < 0) return;
    Params p{};
    for (int i = 0; i < 30; ++i) p.in[i] = (const float*)d_in[i];
    p.out = (float*)d_out; p.ws = (unsigned char*)d_ws; p.pad = 0;
    (void)hipMemsetAsync((char*)d_ws + WS_BAR, 0, 3456 * 4, stream);
    if (coop) {
        p.ph_lo = 0; p.ph_hi = 33; p.use_sync = 1;
        void* args[] = {&p};
        hipError_t e = hipLaunchCooperativeKernel((const void*)fwd_megakernel, dim3(grid), dim3(512), args, LDS_BYTES, stream);
        if (e == hipSuccess) return;
        fprintf(stderr, "kernel_launch: cooperative launch failed: %s (grid %d); falling back to one launch per phase\n", hipGetErrorString(e), grid);
        (void)hipGetLastError(); coop = 0;
    }
    for (int ph = 0; ph < 33; ++ph) { p.ph_lo = ph; p.ph_hi = ph + 1; p.use_sync = 0; hipLaunchKernelGGL(fwd_megakernel, dim3(grid), dim3(512), LDS_BYTES, stream, p); }
}
```

```cpp
#include <hip/hip_runtime.h>
#include <hip/hip_cooperative_groups.h>
#include <cstdio>
namespace cg = cooperative_groups;
#define LAS __attribute__((address_space(3)))
typedef unsigned short bf16_t;
typedef short bf16x8 __attribute__((ext_vector_type(8)));
typedef float f32x4 __attribute__((ext_vector_type(4)));
typedef float f32x2 __attribute__((ext_vector_type(2)));
typedef unsigned u32x2 __attribute__((ext_vector_type(2)));
typedef unsigned u32x4 __attribute__((ext_vector_type(4)));

constexpr int D = 2048, NTOK = 24736, MP = 24832, NINP = 11008, NIN = 10784;
constexpr int NCH16 = 1546, CHP = 1792, NCK = 394;
constexpr int C_GA = 512, C_Q = 1024, C_K = 1280, C_V = 1536, C_GB = 2048, C_XC = 2560, C_GC = 3584, C_MG = 4608, C_GLR = 10752;
constexpr int LDS_BYTES = 150528 + 16;
#ifndef SYNCREP
#define SYNCREP 1
#endif
#ifndef DUP
#define DUP -1
#endif
#ifndef SUBM
#define SUBM 7
#endif
#ifndef PHM
#define PHM 255
#endif

constexpr size_t al256(size_t x) { return (x + 255) & ~(size_t)255; }
constexpr size_t WS_Z = 0;
constexpr size_t WS_H = WS_Z + al256((size_t)MP * D * 4);
constexpr size_t WS_COLS = WS_H + al256((size_t)MP * D * 2);
constexpr size_t WS_YALL = WS_COLS + al256((size_t)MP * NINP * 2);
constexpr size_t WS_ZS5 = WS_YALL + al256((size_t)MP * D * 2);
constexpr size_t WS_UBUF = WS_ZS5 + al256((size_t)MP * 512 * 2);
constexpr size_t WS_ST = WS_UBUF + al256((size_t)32 * CHP * 512 * 2);
constexpr size_t WS_DS = WS_ST + al256((size_t)32 * CHP * 256 * 4);
constexpr size_t WS_M32 = WS_UBUF;
constexpr size_t WS_DECAY = WS_DS + al256((size_t)NCK * 4 * 2 * 8192 * 4);
constexpr size_t WS_LRUA = WS_DECAY + al256((size_t)NCK * 4 * 2 * 64 * 4);
constexpr size_t WS_LRUH = WS_LRUA + al256((size_t)NCK * 2 * 1024 * 4);
constexpr size_t WS_LRUC = WS_LRUH + al256((size_t)NCK * 2 * 1024 * 4);
constexpr size_t WS_PW = WS_LRUC + al256((size_t)NCK * 2 * 1024 * 4);
constexpr size_t WS_BBAR = WS_PW + al256((size_t)4 * 32 * 2 * 17 * 64 * 8);
constexpr size_t WS_WMAT = WS_BBAR + al256((size_t)4 * 32 * 2 * 64 * 16 * 8);
constexpr size_t WS_PMAT = WS_WMAT + al256((size_t)32 * 256 * 512 * 2);
constexpr size_t WS_BTIN = WS_PMAT + al256((size_t)32 * 256 * 256 * 2);
constexpr size_t WS_BTOUT = WS_BTIN + al256((size_t)NINP * D * 2);
constexpr size_t WS_BTO = WS_BTOUT + al256((size_t)D * D * 2);
constexpr size_t WS_BTGLU = WS_BTO + al256((size_t)D * D * 2);
constexpr size_t WS_BTLRU = WS_BTGLU + al256((size_t)512 * 512 * 2);
constexpr size_t WS_KMAT = WS_BTLRU + al256((size_t)32 * 128 * 128 * 2);
constexpr size_t WS_BAR = WS_KMAT + al256((size_t)32 * 2 * 16 * 256 * 4);
constexpr size_t WS_END = WS_BAR + al256((size_t)3456 * 4);
constexpr size_t WS_GB = WS_END;
constexpr size_t WS_END2 = WS_GB + al256((size_t)NCK * 4 * 8192 * 4);
constexpr size_t PWL = (size_t)32 * 2 * 17 * 64, BBL = (size_t)32 * 2 * 64 * 16;
static_assert(WS_END2 <= (size_t)1413480448, "workspace too large");
static_assert((size_t)MP * D * 4 <= WS_DECAY - WS_UBUF, "m32 alias too small");

struct Params { const float* in[30]; float* out; unsigned char* ws; int ph_lo, ph_hi, use_sync, pad; };

#define LBAR() do { asm volatile("s_waitcnt lgkmcnt(0)" ::: "memory"); __builtin_amdgcn_s_barrier(); asm volatile("" ::: "memory"); } while (0)
__device__ __forceinline__ unsigned cvt_pk_bf16(float lo, float hi) { unsigned r; asm volatile("v_cvt_pk_bf16_f32 %0, %1, %2" : "=v"(r) : "v"(lo), "v"(hi)); return r; }
__device__ __forceinline__ bf16_t f2bf(float f) { return (bf16_t)(cvt_pk_bf16(f, 0.f) & 0xffffu); }
__device__ __forceinline__ float bf2f(bf16_t b) { return __uint_as_float(((unsigned)b) << 16); }
__device__ __forceinline__ float bflo(unsigned w) { return __uint_as_float(w << 16); }
__device__ __forceinline__ float bfhi(unsigned w) { return __uint_as_float(w & 0xffff0000u); }
__device__ __forceinline__ float sigm(float x) { return __builtin_amdgcn_rcpf(1.0f + __expf(-x)); }
__device__ __forceinline__ float silu(float x) { return x * sigm(x); }
__device__ __forceinline__ float gelu_t(float x) { const float u = 0.7978845608028654f * (x + 0.044715f * x * x * x); return x * sigm(2.0f * u); }
__device__ __forceinline__ float logsig(float x) { return -(fmaxf(-x, 0.f) + __logf(1.0f + __expf(-fabsf(x)))); }

__device__ __forceinline__ int seq_start(int s) { return s < 2 ? s * 4112 : 8224 + (s - 2) * 2064; }
__device__ __forceinline__ int seq_len(int s) { return s < 2 ? 4112 : 2064; }
__device__ __forceinline__ void chunk_info(int ci, int& seq, int& c) { if (ci < 130) { seq = ci / 65; c = ci - seq * 65; } else { const int t = ci - 130; const int q = t / 33; seq = 2 + q; c = t - q * 33; } }

constexpr int BM = 256, BK = 64, HALF = 128, HTB = HALF * BK * 2, STAGE_BYTES = 8 * HTB, NXCD = 8, WGM = 8;
__device__ __forceinline__ int lds_byte(int r, int c) { const int st = (r >> 4) * 2 + (c >> 5), rr = r & 15, cc = c & 31, ob = rr * 64 + cc * 2; return st * 1024 + (ob ^ (((ob >> 9) & 1) << 5)); }
__device__ __forceinline__ void stage_rc(int b, int& R, int& C) { const int st = b / 1024, sb = b % 1024, swz = sb ^ (((sb >> 9) & 1) << 5); R = (st >> 1) * 16 + swz / 64; C = (st & 1) * 32 + (swz % 64) / 2; }

struct Unit { int pm, pn, sub, nt; const char* a; const char* b; };

struct TileOrder {
    int nM, nN, nwg, G, c, mult, nt0; const char* A; const char* B; size_t tA, tB;
    __device__ __forceinline__ bool next(int i, Unit& u) const {
        const int ti = i / mult, sub = i - ti * mult;
        const long L = (long)ti * G + c; if (L >= nwg) return false;
        int wgid = (int)L; { const int q = nwg / NXCD, r = nwg % NXCD, xcd = wgid % NXCD, off = wgid / NXCD; wgid = (xcd < r ? xcd * (q + 1) : r * (q + 1) + (xcd - r) * q) + off; }
        const int nig = WGM * nN, gid = wgid / nig, fm = gid * WGM, gsz = (nM - fm) < WGM ? (nM - fm) : WGM;
        u.pm = fm + ((wgid % nig) % gsz); u.pn = (wgid % nig) / gsz; u.sub = sub;
        const int koff = (mult == 3) ? sub * 512 : 0; u.nt = (mult == 3) ? (sub == 2 ? 16 : 8) : nt0;
        u.a = A + (size_t)u.pm * tA + (size_t)koff * 2; u.b = B + (size_t)u.pn * tB + (size_t)koff * 2; return true;
    }
};
struct GroupOrder {
    int G, c, nt0; const char* A; const char* B; size_t gsA, gsB, tA;
    __device__ __forceinline__ bool next(int i, Unit& u) const {
        const int L = i * G + c; if (L >= 224) return false;
        const int g = L / 7, pm = L - g * 7; u.pm = pm; u.pn = 0; u.sub = g; u.nt = nt0;
        u.a = A + (size_t)g * gsA + (size_t)pm * tA; u.b = B + (size_t)g * gsB; return true;
    }
};

__device__ __forceinline__ int perm32(int rho) { const int n = rho >> 4, i = rho & 15; return 8 * (i >> 2) + 4 * n + (i & 3); }
template <class Epi, class Sched>
__device__ __forceinline__ void gemm_phase(const int TID, LAS unsigned char* lds, const int lda, const int ldb, const Sched& S, const Epi& E) {
    const int tid = TID, wid = __builtin_amdgcn_readfirstlane(tid >> 6), lane = tid & 63, wr = wid >> 2, wc = wid & 3, fr = lane & 15, fq = lane >> 4;
    unsigned voffA[2], voffB[2];
#pragma unroll
    for (int i = 0; i < 2; ++i) { int R, C; stage_rc(tid * 16 + i * 8192, R, C); const int Rb = Epi::PERM ? ((R & ~31) + perm32(R & 31)) : R; voffA[i] = (unsigned)(R * lda + C) * 2u; voffB[i] = (unsigned)(Rb * ldb + C) * 2u; }
    const size_t kstep = (size_t)(BK * 2);
    const size_t hA = (size_t)HALF * lda * 2, hB = (size_t)HALF * ldb * 2;
    const unsigned ldsw = (unsigned)wid * 1024u;
    const int aoff = lds_byte(wr * 64 + fr, fq * 8), boff = lds_byte(wc * 32 + fr, fq * 8);
#define PG8_SA(b, h) (((b) * 2 + (h)) * HTB)
#define PG8_SB(b, h) ((4 + (b) * 2 + (h)) * HTB)
#define PG8_STAGE(bufoff, gbase, voff) do { _Pragma("unroll") for (int _i = 0; _i < 2; ++_i) \
        __builtin_amdgcn_global_load_lds((const unsigned*)((const char*)(gbase) + (voff)[_i]), (LAS unsigned*)(lds + (bufoff) + ldsw + _i * 8192), 16, 0, 0); } while (0)
#define PG8_LDA(dst, b, h) do { _Pragma("unroll") for (int m = 0; m < 4; ++m) _Pragma("unroll") for (int k = 0; k < 2; ++k) dst[m][k] = *(const LAS bf16x8*)(lds + PG8_SA(b, h) + aoff + m * 2048 + k * 1024); } while (0)
#define PG8_LDB(dst, b, h) do { _Pragma("unroll") for (int n = 0; n < 2; ++n) _Pragma("unroll") for (int k = 0; k < 2; ++k) dst[n][k] = *(const LAS bf16x8*)(lds + PG8_SB(b, h) + boff + n * 2048 + k * 1024); } while (0)
#define PG8_MMA(ai, bj, At, Bt) do { __builtin_amdgcn_s_setprio(1); _Pragma("unroll") for (int m = 0; m < 4; ++m) _Pragma("unroll") for (int n = 0; n < 2; ++n) _Pragma("unroll") for (int k = 0; k < 2; ++k) \
        acc[ai][bj][m][n] = __builtin_amdgcn_mfma_f32_16x16x32_bf16(Bt[n][k], At[m][k], acc[ai][bj][m][n], 0, 0, 0); __builtin_amdgcn_s_setprio(0); } while (0)
#define PG8_WAIT_V(n) asm volatile("s_waitcnt vmcnt(" #n ")" ::: "memory")
#define PG8_WAIT_L(n) asm volatile("s_waitcnt lgkmcnt(" #n ")" ::: "memory")
#define PG8_BAR __builtin_amdgcn_s_barrier()
#define PG8_SCHED __builtin_amdgcn_sched_barrier(0)
    Unit cur, nxt; int ui = 0;
    if (!S.next(0, cur)) return;
    f32x4 acc[2][2][4][2];
#pragma unroll
    for (int a = 0; a < 2; ++a)
#pragma unroll
        for (int b = 0; b < 2; ++b)
#pragma unroll
            for (int m = 0; m < 4; ++m)
#pragma unroll
                for (int n = 0; n < 2; ++n) acc[a][b][m][n] = (f32x4){0.f, 0.f, 0.f, 0.f};
    bf16x8 At[4][2], B0[2][2], B1[2][2];
    const char* cA = cur.a; const char* cB = cur.b;
    PG8_STAGE(PG8_SB(0, 0), cB, voffB); PG8_STAGE(PG8_SA(0, 0), cA, voffA); PG8_STAGE(PG8_SB(0, 1), cB + hB, voffB); PG8_STAGE(PG8_SA(0, 1), cA + hA, voffA);
    if (wr == 1) PG8_BAR;
    PG8_WAIT_V(4); PG8_BAR;
    PG8_STAGE(PG8_SB(1, 0), cB + kstep, voffB); PG8_STAGE(PG8_SA(1, 0), cA + kstep, voffA); PG8_STAGE(PG8_SB(1, 1), cB + hB + kstep, voffB);
    PG8_WAIT_V(6); PG8_BAR;
    for (;;) {
        const bool has_next = S.next(ui + 1, nxt);
        const char* nA = has_next ? nxt.a : cA; const char* nB = has_next ? nxt.b : cB;
        const int nt = cur.nt;
        for (int t = 0; t < nt; t += 2) {
            const bool last = (t == nt - 2);
            const char* a1 = cA + (size_t)(t + 1) * kstep;
            const char* a2 = last ? nA : cA + (size_t)(t + 2) * kstep; const char* b2 = last ? nB : cB + (size_t)(t + 2) * kstep;
            const char* a3 = a2 + kstep; const char* b3 = b2 + kstep;
            PG8_LDB(B0, 0, 0); PG8_SCHED; PG8_LDA(At, 0, 0); PG8_STAGE(PG8_SA(1, 1), a1 + hA, voffA);
            PG8_WAIT_L(8); PG8_BAR; PG8_WAIT_L(0); PG8_MMA(0, 0, At, B0); PG8_BAR; PG8_SCHED;
            PG8_LDB(B1, 0, 1); PG8_STAGE(PG8_SB(0, 0), b2, voffB);
            PG8_BAR; PG8_WAIT_L(0); PG8_MMA(0, 1, At, B1); PG8_BAR;
            PG8_LDA(At, 0, 1); PG8_STAGE(PG8_SA(0, 0), a2, voffA);
            PG8_BAR; PG8_WAIT_L(0); PG8_MMA(1, 0, At, B0); PG8_BAR; PG8_SCHED;
            PG8_STAGE(PG8_SB(0, 1), b2 + hB, voffB);
            PG8_WAIT_V(6); PG8_BAR; PG8_MMA(1, 1, At, B1); PG8_BAR;
            PG8_LDB(B0, 1, 0); PG8_SCHED; PG8_LDA(At, 1, 0); PG8_STAGE(PG8_SA(0, 1), a2 + hA, voffA);
            PG8_WAIT_L(8); PG8_BAR; PG8_WAIT_L(0); PG8_MMA(0, 0, At, B0); PG8_BAR; PG8_SCHED;
            PG8_LDB(B1, 1, 1); PG8_STAGE(PG8_SB(1, 0), b3, voffB);
            PG8_BAR; PG8_WAIT_L(0); PG8_MMA(0, 1, At, B1); PG8_BAR;
            PG8_LDA(At, 1, 1); PG8_STAGE(PG8_SA(1, 0), a3, voffA);
            PG8_BAR; PG8_WAIT_L(0); PG8_MMA(1, 0, At, B0); PG8_BAR; PG8_SCHED;
            PG8_STAGE(PG8_SB(1, 1), b3 + hB, voffB);
            PG8_WAIT_V(6); PG8_BAR; PG8_MMA(1, 1, At, B1); PG8_BAR;
        }
        E(acc, cur, wr, wc, fr, fq);
        if (!has_next) break;
#pragma unroll
        for (int a = 0; a < 2; ++a)
#pragma unroll
            for (int b = 0; b < 2; ++b)
#pragma unroll
                for (int m = 0; m < 4; ++m)
#pragma unroll
                    for (int n = 0; n < 2; ++n) acc[a][b][m][n] = (f32x4){0.f, 0.f, 0.f, 0.f};
        cur = nxt; cA = nA; cB = nB; ++ui;
    }
    PG8_WAIT_V(0);
    if (wr == 0) PG8_BAR;
    PG8_BAR;
#undef PG8_SA
#undef PG8_SB
#undef PG8_STAGE
#undef PG8_LDA
#undef PG8_LDB
#undef PG8_MMA
#undef PG8_WAIT_V
#undef PG8_WAIT_L
#undef PG8_BAR
#undef PG8_SCHED
}

#define EPI_LOOP(...) \
    const int row0 = u.pm * BM + wr * 64 + fr, col0 = u.pn * BM + wc * 32 + 4 * fq; \
    _Pragma("unroll") for (int ai = 0; ai < 2; ++ai) _Pragma("unroll") for (int m = 0; m < 4; ++m) { const int r = row0 + ai * HALF + m * 16; \
        _Pragma("unroll") for (int bj = 0; bj < 2; ++bj) _Pragma("unroll") for (int n = 0; n < 2; ++n) { const int c = col0 + bj * HALF + n * 16; const f32x4 v = acc[ai][bj][m][n]; __VA_ARGS__ } }

#define EPI_PROWS(...) \
    const int row0 = u.pm * BM + wr * 64 + fr, col0 = u.pn * BM + wc * 32 + 8 * fq; \
    _Pragma("unroll") for (int ai = 0; ai < 2; ++ai) _Pragma("unroll") for (int m = 0; m < 4; ++m) { const int r = row0 + ai * HALF + m * 16; __VA_ARGS__ }
__device__ __forceinline__ u32x4 pack8(const f32x4 a, const f32x4 b) { u32x4 w; w[0] = cvt_pk_bf16(a[0], a[1]); w[1] = cvt_pk_bf16(a[2], a[3]); w[2] = cvt_pk_bf16(b[0], b[1]); w[3] = cvt_pk_bf16(b[2], b[3]); return w; }
__device__ __forceinline__ unsigned q8(float x) { return (unsigned)__float2uint_rn(sigm(x) * 255.0f); }
__device__ __forceinline__ unsigned q8x4(const f32x4 v) { return q8(v[0]) | (q8(v[1]) << 8) | (q8(v[2]) << 16) | (q8(v[3]) << 24); }
struct EpiIn { static constexpr bool PERM = true; bf16_t* cols; bf16_t* ubuf;
    __device__ __forceinline__ void operator()(const f32x4 (&acc)[2][2][4][2], const Unit& u, int wr, int wc, int fr, int fq) const {
        if (u.pn >= 18 && u.pn < 42) {
            EPI_PROWS({ u32x4 w; w[0] = q8x4(acc[ai][0][m][0]); w[1] = q8x4(acc[ai][0][m][1]); w[2] = q8x4(acc[ai][1][m][0]); w[3] = q8x4(acc[ai][1][m][1]);
                *(u32x4*)((unsigned char*)(cols + (size_t)r * NINP + C_MG) + (u.pn - 18) * 256 + (wc * 4 + fq) * 16) = w; })
        } else {
            EPI_PROWS({ _Pragma("unroll") for (int bj = 0; bj < 2; ++bj) { const int c = col0 + bj * HALF;
                bf16_t* dst = (u.pn < 2) ? ubuf + ((size_t)((c >> 4) * CHP + (r >> 4)) * 512 + (r & 15) * 16 + (c & 15)) : cols + (size_t)r * NINP + c;
                *(u32x4*)dst = pack8(acc[ai][bj][m][0], acc[ai][bj][m][1]); } })
        }
    } };
struct EpiS5State { static constexpr bool PERM = false; float* st;
    __device__ __forceinline__ void operator()(const f32x4 (&acc)[2][2][4][2], const Unit& u, int wr, int wc, int fr, int fq) const {
        EPI_LOOP({ *(f32x4*)(st + ((size_t)(u.sub * CHP + r)) * 256 + c) = v; })
    } };
struct EpiS5Out { static constexpr bool PERM = true; bf16_t* zs5;
    __device__ __forceinline__ void operator()(const f32x4 (&acc)[2][2][4][2], const Unit& u, int wr, int wc, int fr, int fq) const {
        EPI_PROWS({ if (r < NCH16) { _Pragma("unroll") for (int bj = 0; bj < 2; ++bj) { const int c = col0 + bj * HALF; f32x4 a = acc[ai][bj][m][0], b2 = acc[ai][bj][m][1];
            _Pragma("unroll") for (int e = 0; e < 4; ++e) { a[e] = gelu_t(a[e]); b2[e] = gelu_t(b2[e]); }
            *(u32x4*)(zs5 + (size_t)(r * 16 + (c >> 4)) * 512 + u.sub * 16 + (c & 15)) = pack8(a, b2); } } })
    } };
#define EPI_ROWS(...) \
    const int row0 = u.pm * BM + wr * 64 + fr, col0 = u.pn * BM + wc * 32 + 4 * fq; \
    _Pragma("unroll") for (int ai = 0; ai < 2; ++ai) _Pragma("unroll") for (int m = 0; m < 4; ++m) { const int r = row0 + ai * HALF + m * 16; __VA_ARGS__ }
#define QOFF(q) (((q) >> 1) * HALF + ((q) & 1) * 16)
#define EPI_PIPE(LOADF, COMPF) \
    const int row0 = u.pm * BM + wr * 64 + fr, col0 = u.pn * BM + wc * 32 + 8 * fq; \
    LOADF(0, 0); \
    _Pragma("unroll") for (int gi = 0; gi < 8; ++gi) { if (gi + 1 < 8) { if ((gi & 1) == 0) { LOADF(gi + 1, 1); } else { LOADF(gi + 1, 0); } } if ((gi & 1) == 0) { COMPF(gi, 0); } else { COMPF(gi, 1); } }
#define GROW(gi) (row0 + ((gi) >> 2) * HALF + ((gi) & 3) * 16)
struct EpiGlu { static constexpr bool PERM = true; const bf16_t* zs5; const bf16_t* cols; const float* bglu; bf16_t* yall;
    __device__ __forceinline__ void operator()(const f32x4 (&acc)[2][2][4][2], const Unit& u, int wr, int wc, int fr, int fq) const {
        u32x4 zz[2][2], gg[2][2]; f32x4 bb[2][2];
        { const int c0 = u.pn * BM + wc * 32 + 8 * fq; _Pragma("unroll") for (int bj = 0; bj < 2; ++bj) { bb[bj][0] = *(const f32x4*)(bglu + c0 + bj * HALF); bb[bj][1] = *(const f32x4*)(bglu + c0 + bj * HALF + 4); } }
#define GLU_LOAD(gi, bf) do { const int r_ = GROW(gi); _Pragma("unroll") for (int bj = 0; bj < 2; ++bj) { const int c = col0 + bj * HALF; zz[bf][bj] = *(const u32x4*)(zs5 + (size_t)r_ * 512 + c); gg[bf][bj] = *(const u32x4*)(cols + (size_t)r_ * NINP + C_GA + c); } } while (0)
#define GLU_COMP(gi, bf) do { const int r_ = GROW(gi); _Pragma("unroll") for (int bj = 0; bj < 2; ++bj) { const int c = col0 + bj * HALF; f32x4 o[2]; \
            _Pragma("unroll") for (int hf = 0; hf < 2; ++hf) { const f32x4 v = acc[(gi) >> 2][bj][(gi) & 3][hf]; \
                o[hf][0] = bflo(zz[bf][bj][2 * hf]) * sigm(v[0] + bb[bj][hf][0]) * silu(bflo(gg[bf][bj][2 * hf])); o[hf][1] = bfhi(zz[bf][bj][2 * hf]) * sigm(v[1] + bb[bj][hf][1]) * silu(bfhi(gg[bf][bj][2 * hf])); \
                o[hf][2] = bflo(zz[bf][bj][2 * hf + 1]) * sigm(v[2] + bb[bj][hf][2]) * silu(bflo(gg[bf][bj][2 * hf + 1])); o[hf][3] = bfhi(zz[bf][bj][2 * hf + 1]) * sigm(v[3] + bb[bj][hf][3]) * silu(bfhi(gg[bf][bj][2 * hf + 1])); } \
            *(u32x4*)(yall + (size_t)r_ * D + c) = pack8(o[0], o[1]); } } while (0)
        EPI_PIPE(GLU_LOAD, GLU_COMP)
#undef GLU_LOAD
#undef GLU_COMP
    } };
__device__ __forceinline__ float ub(unsigned w, int k) { return (float)((w >> (8 * k)) & 255u) * (1.0f / 255.0f); }
struct EpiOut { static constexpr bool PERM = true; const bf16_t* cols; bf16_t* mbf;
    __device__ __forceinline__ void operator()(const f32x4 (&acc)[2][2][4][2], const Unit& u, int wr, int wc, int fr, int fq) const {
        u32x4 gg[8], mm[2][2];
        { const int row0g = u.pm * BM + wr * 64 + fr;
#pragma unroll
          for (int gi = 0; gi < 8; ++gi) gg[gi] = *(const u32x4*)((const unsigned char*)(cols + (size_t)(row0g + (gi >> 2) * HALF + (gi & 3) * 16) * NINP + C_MG) + (u.sub * 8 + u.pn) * 256 + (wc * 4 + fq) * 16); }
#define OUT_LOAD(gi, bf) do { const int r_ = GROW(gi); const bf16_t* mp = mbf + (size_t)r_ * D + col0; \
            _Pragma("unroll") for (int bj = 0; bj < 2; ++bj) { mm[bf][bj] = (u32x4){0u, 0u, 0u, 0u}; if (u.sub != 0) mm[bf][bj] = *(const u32x4*)(mp + bj * HALF); } } while (0)
#define OUT_COMP(gi, bf) do { const int r_ = GROW(gi); bf16_t* mp = mbf + (size_t)r_ * D + col0; _Pragma("unroll") for (int bj = 0; bj < 2; ++bj) { f32x4 o[2]; \
            _Pragma("unroll") for (int hf = 0; hf < 2; ++hf) { const f32x4 v = acc[(gi) >> 2][bj][(gi) & 3][hf]; const unsigned gw = gg[gi][bj * 2 + hf]; \
                o[hf][0] = bflo(mm[bf][bj][2 * hf]) + ub(gw, 0) * v[0]; o[hf][1] = bfhi(mm[bf][bj][2 * hf]) + ub(gw, 1) * v[1]; \
                o[hf][2] = bflo(mm[bf][bj][2 * hf + 1]) + ub(gw, 2) * v[2]; o[hf][3] = bfhi(mm[bf][bj][2 * hf + 1]) + ub(gw, 3) * v[3]; } \
            *(u32x4*)(mp + bj * HALF) = pack8(o[0], o[1]); } } while (0)
        EPI_PIPE(OUT_LOAD, OUT_COMP)
#undef OUT_LOAD
#undef OUT_COMP
    } };
__device__ __forceinline__ const float* src_row(const Params& p, int r);
struct EpiWo { static constexpr bool PERM = false; float* z; const Params* pp; int first;
    __device__ __forceinline__ void operator()(const f32x4 (&acc)[2][2][4][2], const Unit& u, int wr, int wc, int fr, int fq) const {
        EPI_ROWS({ if (r < NTOK) { float* zp = z + (size_t)r * D + col0; const float* rp = first ? src_row(*pp, r) + col0 : zp; f32x4 pv[4];
            _Pragma("unroll") for (int q = 0; q < 4; ++q) pv[q] = *(const f32x4*)(rp + QOFF(q));
            _Pragma("unroll") for (int q = 0; q < 4; ++q) *(f32x4*)(zp + QOFF(q)) = pv[q] + acc[ai][q >> 1][m][q & 1]; } })
    } };

__device__ __forceinline__ const float* src_row(const Params& p, int r) {
    int s, pos; if (r < 8224) { s = r / 4112; pos = r - s * 4112; } else { const int t = r - 8224; const int q = t / 2064; s = 2 + q; pos = t - q * 2064; }
    if (pos < 16) return p.in[2] + (size_t)pos * D;
    return s < 2 ? p.in[0] + ((size_t)s * 4096 + (pos - 16)) * D : p.in[1] + ((size_t)(s - 2) * 2048 + (pos - 16)) * D;
}
__device__ __forceinline__ void rmsnorm_phase(const int TID, const int BID, const Params& p, int l) {
    float* z = (float*)(p.ws + WS_Z); bf16_t* h = (bf16_t*)(p.ws + WS_H); const float* g = p.in[3] + (size_t)l * D;
    const int lane = TID & 63, gw = BID * 8 + (TID >> 6), nw = gridDim.x * 8;
    f32x4 gg[8];
#pragma unroll
    for (int i = 0; i < 8; ++i) gg[i] = *(const f32x4*)(g + (i * 64 + lane) * 4);
    f32x4 xn[8];
    { const int r0 = gw < NTOK ? gw : NTOK - 1; const float* src = (l == 0) ? src_row(p, r0) : z + (size_t)r0 * D;
#pragma unroll
      for (int i = 0; i < 8; ++i) xn[i] = *(const f32x4*)(src + (i * 64 + lane) * 4); }
    for (int r = gw; r < MP; r += nw) {
        bf16_t* hr = h + (size_t)r * D;
        f32x4 x[8];
#pragma unroll
        for (int i = 0; i < 8; ++i) x[i] = xn[i];
        { const int rn = (r + nw < NTOK) ? r + nw : NTOK - 1; const float* src = (l == 0) ? src_row(p, rn) : z + (size_t)rn * D;
#pragma unroll
          for (int i = 0; i < 8; ++i) xn[i] = *(const f32x4*)(src + (i * 64 + lane) * 4); }
        if (r >= NTOK) { for (int i = 0; i < 4; ++i) *(u32x4*)(hr + (i * 64 + lane) * 8) = (u32x4){0u, 0u, 0u, 0u}; continue; }
        float ss = 0.f;
#pragma unroll
        for (int i = 0; i < 8; ++i) ss += x[i][0] * x[i][0] + x[i][1] * x[i][1] + x[i][2] * x[i][2] + x[i][3] * x[i][3];
#pragma unroll
        for (int o = 32; o >= 1; o >>= 1) ss += __shfl_xor(ss, o);
        const float rs = rsqrtf(ss * (1.0f / D) + 1e-6f);
#pragma unroll
        for (int i = 0; i < 8; ++i) { const int c = (i * 64 + lane) * 4;
            u32x2 w; w.x = cvt_pk_bf16(x[i][0] * rs * gg[i][0], x[i][1] * rs * gg[i][1]); w.y = cvt_pk_bf16(x[i][2] * rs * gg[i][2], x[i][3] * rs * gg[i][3]); *(u32x2*)(hr + c) = w; }
    }
}
__device__ __forceinline__ void final_norm_phase(const int TID, const int BID, const Params& p) {
    const float* z = (const float*)(p.ws + WS_Z); const float* g = p.in[29];
    const int lane = TID & 63, gw = BID * 8 + (TID >> 6), nw = gridDim.x * 8;
    f32x4 gg[8];
#pragma unroll
    for (int i = 0; i < 8; ++i) gg[i] = *(const f32x4*)(g + (i * 64 + lane) * 4);
    f32x4 xn[8];
    { const int r0 = gw < NTOK ? gw : NTOK - 1;
#pragma unroll
      for (int i = 0; i < 8; ++i) xn[i] = *(const f32x4*)(z + (size_t)r0 * D + (i * 64 + lane) * 4); }
    for (int r = gw; r < NTOK; r += nw) {
        f32x4 x[8];
#pragma unroll
        for (int i = 0; i < 8; ++i) x[i] = xn[i];
        { const int rn = (r + nw < NTOK) ? r + nw : NTOK - 1;
#pragma unroll
          for (int i = 0; i < 8; ++i) xn[i] = *(const f32x4*)(z + (size_t)rn * D + (i * 64 + lane) * 4); }
        int s, pos; if (r < 8224) { s = r / 4112; pos = r - s * 4112; } else { const int t = r - 8224; const int q = t / 2064; s = 2 + q; pos = t - q * 2064; }
        if (pos < 16) continue;
        float* dst = s < 2 ? p.out + ((size_t)s * 4096 + (pos - 16)) * D : p.out + (size_t)2 * 4096 * D + ((size_t)(s - 2) * 2048 + (pos - 16)) * D;
        float ss = 0.f;
#pragma unroll
        for (int i = 0; i < 8; ++i) ss += x[i][0] * x[i][0] + x[i][1] * x[i][1] + x[i][2] * x[i][2] + x[i][3] * x[i][3];
#pragma unroll
        for (int o = 32; o >= 1; o >>= 1) ss += __shfl_xor(ss, o);
        const float rs = rsqrtf(ss * (1.0f / D) + 1e-6f);
#pragma unroll
        for (int i = 0; i < 8; ++i) { const int c = (i * 64 + lane) * 4; f32x4 o; o[0] = x[i][0] * rs * gg[i][0]; o[1] = x[i][1] * rs * gg[i][1]; o[2] = x[i][2] * rs * gg[i][2]; o[3] = x[i][3] * rs * gg[i][3]; __builtin_nontemporal_store(o, (f32x4*)(dst + c)); }
    }
}
__device__ __forceinline__ void conv_tile(const int TID, const float* src, int ldn, int k0, int n0, int nvalid, bf16_t* dst, int ldd, int kofs, bool mapin, LAS float* tile) {
    const int tx = TID & 63, ty = TID >> 6;
    const int ncl = (n0 + tx < nvalid) ? n0 + tx : nvalid - 1;
#pragma unroll
    for (int i = 0; i < 8; ++i) { const int k = ty + 8 * i; tile[k * 65 + tx] = src[(size_t)(k0 + k) * ldn + ncl]; }
    __syncthreads();
#pragma unroll
    for (int i = 0; i < 8; ++i) { const int nn = ty + 8 * i; int n = n0 + nn;
        if (n < nvalid) { if (mapin) n = (n < 2560) ? n : (n < 2592 ? n + (C_GLR - 2560) : n - 32); dst[(size_t)n * ldd + kofs + k0 + tx] = f2bf(tile[tx * 65 + nn]); } }
    __syncthreads();
}
__device__ __forceinline__ void convert_weights(const int TID, const int BID, const Params& p, int l, LAS float* tile) {
    const int G = gridDim.x, b = BID;
    bf16_t* btin = (bf16_t*)(p.ws + WS_BTIN); bf16_t* btout = (bf16_t*)(p.ws + WS_BTOUT); bf16_t* bto = (bf16_t*)(p.ws + WS_BTO); bf16_t* btglu = (bf16_t*)(p.ws + WS_BTGLU); bf16_t* btlru = (bf16_t*)(p.ws + WS_BTLRU);
    { const float* src = p.in[4] + (size_t)l * D * NIN; const int tx = TID & 63, ty = TID >> 6; float v[8];
      { const int t = b < 32 * 169 ? b : 0; const int kt = t / 169, ntl = t - kt * 169; const int ncl = (ntl * 64 + tx < NIN) ? ntl * 64 + tx : NIN - 1;
#pragma unroll
        for (int i = 0; i < 8; ++i) v[i] = src[(size_t)(kt * 64 + ty + 8 * i) * NIN + ncl]; }
      for (int t = b; t < 32 * 169; t += G) { const int kt = t / 169, ntl = t - kt * 169, k0 = kt * 64, n0 = ntl * 64;
#pragma unroll
          for (int i = 0; i < 8; ++i) tile[(ty + 8 * i) * 65 + tx] = v[i];
          { const int tn = (t + G < 32 * 169) ? t + G : t; const int ktn = tn / 169, ntn = tn - ktn * 169; const int ncl = (ntn * 64 + tx < NIN) ? ntn * 64 + tx : NIN - 1;
#pragma unroll
            for (int i = 0; i < 8; ++i) v[i] = src[(size_t)(ktn * 64 + ty + 8 * i) * NIN + ncl]; }
          LBAR();
#pragma unroll
          for (int i = 0; i < 8; ++i) { const int nn = ty + 8 * i; int n = n0 + nn;
              if (n < NIN) { n = (n < 2560) ? n : (n < 2592 ? n + (C_GLR - 2560) : n - 32); btin[(size_t)n * D + k0 + tx] = f2bf(tile[tx * 65 + nn]); } }
          LBAR(); } }
    for (size_t i = (size_t)b * 512 + TID; i < (size_t)(NINP - NIN) * D / 8; i += (size_t)G * 512) *(u32x4*)(btin + (size_t)NIN * D + i * 8) = (u32x4){0u, 0u, 0u, 0u};
    { const float* src = p.in[25] + (size_t)l * 512 * D; for (int t = (b + 64) % G; t < 8 * 32; t += G) { const int kt = t / 32, ntl = t - kt * 32; conv_tile(TID, src, D, kt * 64, ntl * 64, D, btout, D, 0, false, tile); } }
    { const float* src = p.in[26] + (size_t)l * 512 * D; for (int t = (b + 128) % G; t < 8 * 32; t += G) { const int kt = t / 32, ntl = t - kt * 32; conv_tile(TID, src, D, kt * 64, ntl * 64, D, btout, D, 512, false, tile); } }
    { const float* src = p.in[27] + (size_t)l * 1024 * D; for (int t = b; t < 16 * 32; t += G) { const int kt = t / 32, ntl = t - kt * 32; conv_tile(TID, src, D, kt * 64, ntl * 64, D, btout, D, 1024, false, tile); } }
    { const float* src = p.in[28] + (size_t)l * D * D; for (int t = b; t < 32 * 32; t += G) { const int kt = t / 32, ntl = t - kt * 32; conv_tile(TID, src, D, kt * 64, ntl * 64, D, bto, D, 0, false, tile); } }
    { const float* src = p.in[13] + (size_t)l * 512 * 512; for (int t = (b + 192) % G; t < 8 * 8; t += G) { const int kt = t / 8, ntl = t - kt * 8; conv_tile(TID, src, 512, kt * 64, ntl * 64, 512, btglu, 512, 0, false, tile); } }
    for (int t = (b + 32) % G; t < 128; t += G) { const int mat = t >> 2, sub = t & 3;
        const int dk = mat >> 3, nb = mat & 7, d = dk >> 1, kind = dk & 1;
        const float* src = p.in[kind ? 22 : 20] + ((size_t)(l * 2 + d) * 8 + nb) * 128 * 128;
        conv_tile(TID, src, 128, (sub >> 1) * 64, (sub & 1) * 64, 128, btlru + (size_t)mat * 128 * 128, 128, 0, false, tile); }
}
__device__ __forceinline__ double exp_small(double x) { double s = 1.0, t = 1.0; for (int i = 1; i <= 14; ++i) { t *= x / (double)i; s += t; } return s; }
__device__ __forceinline__ double exp_neg(double x) { double e = exp_small(x * (1.0 / 64.0)); for (int i = 0; i < 6; ++i) e *= e; return e; }
__device__ __forceinline__ void s5_tables_all(const int TID, const int BID, const Params& p) {
    for (int vidx = (int)(gridDim.x - 1 - BID) * 512 + TID; vidx < 4 * 4096; vidx += gridDim.x * 512) {
        const int l = vidx >> 12, idx = vidx & 4095;
        f32x2* pw = (f32x2*)(p.ws + WS_PW) + l * PWL; f32x2* bbar = (f32x2*)(p.ws + WS_BBAR) + l * BBL;
        const int g = idx >> 7, d = (idx >> 6) & 1, n = idx & 63;
        const double dt = exp_neg((double)p.in[7][(l * 2 + d) * 32 + g]);
        const double lr = (double)p.in[5][((size_t)(l * 2 + d) * 32 + g) * 64 + n], li = (double)p.in[6][((size_t)(l * 2 + d) * 32 + g) * 64 + n];
        const double mag = exp_neg(lr * dt);
        double ang = li * dt; const double twopi = 6.283185307179586476925287; ang -= twopi * rint(ang / twopi);
        const double a8 = ang * 0.125, a2 = a8 * a8;
        double sn = a8, cs = 1.0, ts = a8, tc = 1.0;
        for (int i = 1; i <= 9; ++i) { tc *= -a2 / (double)((2 * i - 1) * (2 * i)); cs += tc; ts *= -a2 / (double)((2 * i) * (2 * i + 1)); sn += ts; }
        for (int i = 0; i < 3; ++i) { const double c2 = cs * cs - sn * sn, s2 = 2.0 * cs * sn; cs = c2; sn = s2; }
        const double abr = mag * cs, abi = mag * sn;
        double pr = 1.0, pi = 0.0;
        for (int j = 0; j <= 16; ++j) { pw[((size_t)(g * 2 + d) * 17 + j) * 64 + n] = (f32x2){(float)pr, (float)pi}; const double nr = pr * abr - pi * abi, ni = pr * abi + pi * abr; pr = nr; pi = ni; }
        const double den = lr * lr + li * li, fr = ((abr - 1.0) * lr + abi * li) / den, fi = (abi * lr - (abr - 1.0) * li) / den;
        float brf[16], bif[16];
#pragma unroll
        for (int c4 = 0; c4 < 4; ++c4) { const f32x4 t0 = *(const f32x4*)(p.in[8] + (((size_t)l * 32 + g) * 64 + n) * 16 + c4 * 4), t1 = *(const f32x4*)(p.in[9] + (((size_t)l * 32 + g) * 64 + n) * 16 + c4 * 4);
#pragma unroll
            for (int e = 0; e < 4; ++e) { brf[c4 * 4 + e] = t0[e]; bif[c4 * 4 + e] = t1[e]; } }
#pragma unroll
        for (int c = 0; c < 16; ++c) { const double br = (double)brf[c], bi = (double)bif[c];
            bbar[((size_t)(g * 2 + d) * 64 + n) * 16 + c] = (f32x2){(float)(fr * br - fi * bi), (float)(fr * bi + fi * br)}; }
    }
}
__device__ __forceinline__ float s5_kval(const float* cre, const float* cim, const f32x2* pw, const f32x2* bbar, int l, int g, int d, int j, int c, int cp) {
    const float* cr = cre + (((size_t)(l * 2 + d) * 32 + g) * 16 + c) * 64; const float* ci = cim + (((size_t)(l * 2 + d) * 32 + g) * 16 + c) * 64;
    const f32x2* pp = pw + ((size_t)(g * 2 + d) * 17 + j) * 64; const f32x2* bb = bbar + ((size_t)(g * 2 + d) * 64) * 16 + cp;
    float s = 0.f;
#pragma unroll 16
    for (int n = 0; n < 64; ++n) { const f32x2 pv = pp[n]; const f32x2 bv = bb[(size_t)n * 16]; const float er = cr[n] * pv.x - ci[n] * pv.y, ei = cr[n] * pv.y + ci[n] * pv.x; s += er * bv.x - ei * bv.y; }
    return s;
}
__device__ __forceinline__ void s5_assemble_a(const int TID, const int BID, const Params& p, int l) {
    const f32x2* pw = (const f32x2*)(p.ws + WS_PW) + l * PWL; const f32x2* bbar = (const f32x2*)(p.ws + WS_BBAR) + l * BBL;
    float* kmat = (float*)(p.ws + WS_KMAT); bf16_t* pmat = (bf16_t*)(p.ws + WS_PMAT);
    const float* cre = p.in[10]; const float* cim = p.in[11];
    const size_t stride = (size_t)gridDim.x * 512;
    for (size_t idx = (size_t)BID * 512 + TID; idx < (size_t)32 * 2 * 16 * 256; idx += stride) {
        const int g = (int)(idx >> 13), d = (int)(idx >> 12) & 1, j = (int)(idx >> 8) & 15, c = (int)(idx >> 4) & 15, cp = (int)idx & 15;
        kmat[idx] = s5_kval(cre, cim, pw, bbar, l, g, d, j, c, cp);
    }
    for (size_t idx = (size_t)BID * 512 + TID; idx < (size_t)32 * 256 * 256; idx += stride) {
        const int g = (int)(idx >> 16), nout = (int)(idx >> 8) & 255, k = (int)idx & 255, d = nout >> 7, ri = (nout >> 6) & 1, n = nout & 63, s = k >> 4, cp = k & 15, j = d == 0 ? 15 - s : s;
        const f32x2 pv = pw[((size_t)(g * 2 + d) * 17 + j) * 64 + n]; const f32x2 bv = bbar[((size_t)(g * 2 + d) * 64 + n) * 16 + cp];
        pmat[idx] = f2bf(ri == 0 ? pv.x * bv.x - pv.y * bv.y : pv.x * bv.y + pv.y * bv.x);
    }
}
__device__ __forceinline__ void s5_assemble_w(const int TID, const int BID, const Params& p, int l) {
    const f32x2* pw = (const f32x2*)(p.ws + WS_PW) + l * PWL; const float* kmat = (const float*)(p.ws + WS_KMAT);
    bf16_t* wmat = (bf16_t*)(p.ws + WS_WMAT);
    const float* cre = p.in[10]; const float* cim = p.in[11];
    const size_t stride = (size_t)gridDim.x * 512;
    for (size_t idx = (size_t)BID * 512 + TID; idx < (size_t)32 * 256 * 512; idx += stride) {
        const int g = (int)(idx >> 17), nout = (int)(idx >> 9) & 255, k = (int)idx & 511, t = nout >> 4, c = nout & 15;
        float val;
        if (k < 256) { const int s = k >> 4, cp = k & 15; val = 0.f;
            const int jf = s <= t ? t - s : 0, jb = s >= t ? s - t : 0;
            const float kf = kmat[((((size_t)g * 2 + 0) * 16 + jf) * 16 + c) * 16 + cp], kb = kmat[((((size_t)g * 2 + 1) * 16 + jb) * 16 + c) * 16 + cp], dsk = p.in[12][l * 512 + g * 16 + c];
            val = (s <= t ? kf : 0.f) + (s >= t ? kb : 0.f) + ((s == t && c == cp) ? dsk : 0.f);
        } else { const int kk = k - 256, d = kk >> 7, ri = (kk >> 6) & 1, n = kk & 63, j = d == 0 ? t + 1 : 16 - t;
            const float cr = cre[(((size_t)(l * 2 + d) * 32 + g) * 16 + c) * 64 + n], ci = cim[(((size_t)(l * 2 + d) * 32 + g) * 16 + c) * 64 + n];
            const f32x2 pv = pw[((size_t)(g * 2 + d) * 17 + j) * 64 + n];
            val = ri == 0 ? cr * pv.x - ci * pv.y : -(cr * pv.y + ci * pv.x); }
        wmat[idx] = f2bf(val);
    }
}

__device__ __forceinline__ void scans_phase(const int TID, const int BID, const Params& p, const int l, const bool do_gla) {
    const int G = gridDim.x;
    const bool split = (G == 256);
    {
        const f32x2* pw = (const f32x2*)(p.ws + WS_PW) + l * PWL; const float* st = (const float*)(p.ws + WS_ST); bf16_t* ub = (bf16_t*)(p.ws + WS_UBUF);
        for (int idx = BID * 512 + TID; idx < 40960; idx += G * 512) {
            const int seq = idx >> 12, rem = idx & 4095, g = rem >> 7, d = (rem >> 6) & 1, n = rem & 63;
            const int ch0 = seq < 2 ? seq * 257 : 514 + (seq - 2) * 129, nc = seq < 2 ? 257 : 129;
            const f32x2 a16 = pw[((size_t)(g * 2 + d) * 17 + 16) * 64 + n];
            float sr = 0.f, si = 0.f;
            for (int s0 = 0; s0 < nc; s0 += 32) {
                float lr[32], li[32];
#pragma unroll
                for (int i = 0; i < 32; ++i) { const int step = s0 + i; lr[i] = 0.f; li[i] = 0.f;
                    { const int sc = step < nc ? step : nc - 1; const int c = d == 0 ? sc : nc - 1 - sc; const size_t row = (size_t)g * CHP + ch0 + c; lr[i] = st[row * 256 + d * 128 + n]; li[i] = st[row * 256 + d * 128 + 64 + n]; } }
#pragma unroll
                for (int i = 0; i < 32; ++i) { const int step = s0 + i;
                    if (step < nc) { const int c = d == 0 ? step : nc - 1 - step; const size_t row = (size_t)g * CHP + ch0 + c;
                        ub[row * 512 + 256 + d * 128 + n] = f2bf(sr); ub[row * 512 + 256 + d * 128 + 64 + n] = f2bf(si);
                        const float nr = a16.x * sr - a16.y * si + lr[i], ni = a16.x * si + a16.y * sr + li[i]; sr = nr; si = ni; } }
            }
        }
    }
    {
        const float* la = (const float*)(p.ws + WS_LRUA); const float* lh = (const float*)(p.ws + WS_LRUH); float* lc = (float*)(p.ws + WS_LRUC);
        const int vb0 = split ? BID - 80 : BID, vstride = split ? 1 << 20 : G;
        for (int vb = vb0; vb >= 0 && vb < 40; vb += vstride) {
            const int idx = vb * 512 + TID;
            const int seq = idx >> 11, d = (idx >> 10) & 1, ch = idx & 1023;
            const int cb = seq < 2 ? seq * 65 : 130 + (seq - 2) * 33, nc = seq < 2 ? 65 : 33;
            float cin = 0.f;
            for (int s0 = 0; s0 < nc; s0 += 16) {
                float A[16], H[16];
#pragma unroll
                for (int i = 0; i < 16; ++i) { const int step = s0 + i; A[i] = 1.f; H[i] = 0.f;
                    { const int sc = step < nc ? step : nc - 1; const int ci = cb + (d == 0 ? sc : nc - 1 - sc); const size_t o = ((size_t)ci * 2 + d) * 1024 + ch; A[i] = la[o]; H[i] = lh[o]; } }
#pragma unroll
                for (int i = 0; i < 16; ++i) { const int step = s0 + i;
                    if (step < nc) { const int ci = cb + (d == 0 ? step : nc - 1 - step); const size_t o = ((size_t)ci * 2 + d) * 1024 + ch; lc[o] = cin; cin = A[i] * cin + H[i]; } }
            }
        }
    }
    if (do_gla) {
        float* ds = (float*)(p.ws + WS_DS); const float* dec = (const float*)(p.ws + WS_DECAY);
        for (int it = 0; ; ++it) {
            int vb;
            if (split) { if (BID >= 120) { if (it >= 8) break; vb = (BID - 120) + 136 * it; } else { vb = 1088 + BID + 120 * it; if (vb >= 1280) break; } }
            else { vb = BID + G * it; if (vb >= 1280) break; }
            const int e = vb * 512 + TID;
            const int seq = e >> 16, rem = e & 65535, head = rem >> 14, d = (rem >> 13) & 1, el = rem & 8191, kk = el & 63;
            const int cb = seq < 2 ? seq * 65 : 130 + (seq - 2) * 33, nc = seq < 2 ? 65 : 33;
            float S = 0.f;
            for (int s0 = 0; s0 < nc; s0 += 16) {
                float tm[16], dc[16];
#pragma unroll
                for (int i = 0; i < 16; ++i) { const int step = s0 + i; tm[i] = 0.f; dc[i] = 1.f;
                    { const int sc = step < nc ? step : nc - 1; const int ci = cb + (d == 0 ? sc : nc - 1 - sc); const size_t o = ((size_t)(ci * 4 + head) * 2 + d); tm[i] = ds[o * 8192 + el]; dc[i] = dec[o * 64 + kk]; } }
#pragma unroll
                for (int i = 0; i < 16; ++i) { const int step = s0 + i;
                    if (step < nc) { const int ci = cb + (d == 0 ? step : nc - 1 - step); const size_t o = ((size_t)(ci * 4 + head) * 2 + d); ds[o * 8192 + el] = S; S = dc[i] * S + tm[i]; } }
            }
        }
    }
}

__device__ __forceinline__ f32x4 mma_lds(f32x4 acc, const LAS bf16_t* A, const LAS bf16_t* B, int ld, int nks, int lane) {
    const LAS bf16_t* ap = A + (lane & 15) * ld + (lane >> 4) * 8; const LAS bf16_t* bp = B + (lane & 15) * ld + (lane >> 4) * 8;
    for (int ks = 0; ks < nks; ++ks) acc = __builtin_amdgcn_mfma_f32_16x16x32_bf16(*(const LAS bf16x8*)(ap + ks * 32), *(const LAS bf16x8*)(bp + ks * 32), acc, 0, 0, 0);
    return acc;
}
__device__ __forceinline__ f32x4 mma_lds_sw(f32x4 acc, const LAS bf16_t* A, int rowA0, const LAS bf16_t* B, int rowB0, int ld, int nks, int lane) {
    const int swa = rowA0 >= 0 ? (((rowA0 + (lane & 15)) >> 3) & 7) : 0, swb = rowB0 >= 0 ? (((rowB0 + (lane & 15)) >> 3) & 7) : 0;
    const LAS bf16_t* ap = A + (lane & 15) * ld; const LAS bf16_t* bp = B + (lane & 15) * ld;
    for (int ks = 0; ks < nks; ++ks) { const int cb = ks * 4 + (lane >> 4);
        acc = __builtin_amdgcn_mfma_f32_16x16x32_bf16(*(const LAS bf16x8*)(ap + ((cb ^ swa) << 3)), *(const LAS bf16x8*)(bp + ((cb ^ swb) << 3)), acc, 0, 0, 0); }
    return acc;
}
#define SWZ(row, col) (((((col) >> 3) ^ (((row) >> 3) & 7)) << 3) + ((col) & 7))
constexpr int GL_GLR = 0, GL_BF = 16384, GL_BB = 32768, GL_OS = 0, GL_QE0 = 49152, GL_QE1 = 58368, GL_KE0 = 67584, GL_KE1 = 76800, GL_VT = 86016, GL_ATT = 104448, GL_SP0 = 113664, GL_SP1 = 132096;
constexpr int GLD = 72;
template <int MODE>
__device__ __forceinline__ void gla_item(const int TID, const Params& p, int l, int ci, int head, LAS unsigned char* lds, const float (&wg)[2][16], const float (&bg)[2], const float (&ngv)[16]) {
    const int tid = TID, lane = tid & 63, wid = tid >> 6;
    const bf16_t* cols = (const bf16_t*)(p.ws + WS_COLS);
    int seq, c; chunk_info(ci, seq, c);
    const int tok0 = seq_start(seq) + (c == 0 ? -48 : 16 + 64 * (c - 1));
    const int rmin = (c == 0) ? 48 : 0;
    LAS float* glr_s = (LAS float*)(lds + GL_GLR); LAS float* bfs = (LAS float*)(lds + GL_BF); LAS float* bbs = (LAS float*)(lds + GL_BB);
    f32x4 gbv[4];
    if (MODE == 1) { const float* gb = (const float*)(p.ws + WS_GB) + (size_t)(ci * 4 + head) * 8192;
#pragma unroll
      for (int i = 0; i < 4; ++i) gbv[i] = *(const f32x4*)(gb + (i * 512 + tid) * 4); }
    u32x4 kw = (u32x4){0u, 0u, 0u, 0u}, qw = kw, vwp[2], gwp[2];
    { const int r = tid >> 3, k8 = (tid & 7) * 8; const int rc = r >= rmin ? r : rmin; const bf16_t* rowp = cols + (size_t)(tok0 + rc) * NINP;
      kw = *(const u32x4*)(rowp + C_K + head * 64 + k8); if (MODE == 1) qw = *(const u32x4*)(rowp + C_Q + head * 64 + k8);
#pragma unroll
      for (int hh = 0; hh < 2; ++hh) { vwp[hh] = *(const u32x4*)(rowp + C_V + head * 128 + ((tid & 7) + 8 * hh) * 8); if (MODE == 1) gwp[hh] = *(const u32x4*)(rowp + C_GB + head * 128 + (tid & 7) * 16 + hh * 8); } }
    if (MODE == 0) {
    { const int r = tid >> 3, j4 = (tid & 7) * 4; f32x4 v = (f32x4){0.f, 0.f, 0.f, 0.f};
      { const int rc = r >= rmin ? r : rmin; const u32x2 w = *(const u32x2*)(cols + (size_t)(tok0 + rc) * NINP + C_GLR + j4); if (r >= rmin) { v[0] = bflo(w.x); v[1] = bfhi(w.x); v[2] = bflo(w.y); v[3] = bfhi(w.y); } }
      *(LAS f32x4*)(glr_s + r * 32 + j4) = v; }
    __syncthreads();
    { const int kk = tid & 63, rb = tid >> 6;
#pragma unroll
      for (int i = 0; i < 8; ++i) { const int r = rb + 8 * i; float x0 = bg[0], x1 = bg[1]; f32x4 gr[8];
#pragma unroll
          for (int j4 = 0; j4 < 8; ++j4) gr[j4] = *(const LAS f32x4*)(glr_s + r * 32 + j4 * 4);
#pragma unroll
          for (int j = 0; j < 16; ++j) { x0 += gr[j >> 2][j & 3] * wg[0][j]; x1 += gr[4 + (j >> 2)][j & 3] * wg[1][j]; }
          const bool ok = r >= rmin; bfs[r * 64 + kk] = ok ? logsig(x0) * 0.0625f : 0.f; bbs[r * 64 + kk] = ok ? logsig(x1) * 0.0625f : 0.f; } }
    __syncthreads();
    { const int col = tid & 127, part = tid >> 7, d = col >> 6, kk = col & 63; LAS float* bs = d ? bbs : bfs; LAS float* tot = glr_s;
      float v[16];
#pragma unroll
      for (int i = 0; i < 16; ++i) v[i] = bs[(part * 16 + i) * 64 + kk];
      if (d == 0) {
#pragma unroll
          for (int i = 1; i < 16; ++i) v[i] += v[i - 1];
          tot[part * 128 + col] = v[15]; }
      else {
#pragma unroll
          for (int i = 14; i >= 0; --i) v[i] += v[i + 1];
          tot[part * 128 + col] = v[0]; }
      __syncthreads();
      float off = 0.f;
#pragma unroll
      for (int pp = 0; pp < 4; ++pp) { const float t = tot[pp * 128 + col]; if (d == 0 ? pp < part : pp > part) off += t; }
#pragma unroll
      for (int i = 0; i < 16; ++i) bs[(part * 16 + i) * 64 + kk] = v[i] + off; }
    __syncthreads();
    { float* gb = (float*)(p.ws + WS_GB) + (size_t)(ci * 4 + head) * 8192;
#pragma unroll
      for (int i = 0; i < 4; ++i) { const int e = (i * 512 + tid) * 4; *(f32x4*)(gb + e) = *(const LAS f32x4*)(bfs + e); } }
    } else {
      __syncthreads();
#pragma unroll
      for (int i = 0; i < 4; ++i) { const int e = (i * 512 + tid) * 4; *(LAS f32x4*)(bfs + e) = gbv[i]; }
      __syncthreads();
    }
    LAS bf16_t* vT = (LAS bf16_t*)(lds + GL_VT);
    { const int r = tid >> 3, k8 = (tid & 7) * 8; const bool ok = r >= rmin;
      if (!ok) { kw = (u32x4){0u, 0u, 0u, 0u}; qw = kw; }
      float qv[8], kv[8];
#pragma unroll
      for (int i = 0; i < 4; ++i) { qv[2 * i] = bflo(qw[i]); qv[2 * i + 1] = bfhi(qw[i]); kv[2 * i] = bflo(kw[i]); kv[2 * i + 1] = bfhi(kw[i]); }
      if (MODE == 0) { LAS bf16_t* kd0 = (LAS bf16_t*)(lds + GL_QE0); LAS bf16_t* kd1 = (LAS bf16_t*)(lds + GL_QE1);
#pragma unroll
          for (int i = 0; i < 8; ++i) { const int kk = k8 + i; kd0[kk * GLD + SWZ(kk, r)] = f2bf(kv[i] * __expf(bfs[63 * 64 + kk] - bfs[r * 64 + kk])); kd1[kk * GLD + SWZ(kk, r)] = f2bf(kv[i] * __expf(bbs[kk] - bbs[r * 64 + kk])); }
      } else { LAS bf16_t* qe0 = (LAS bf16_t*)(lds + GL_QE0); LAS bf16_t* qe1 = (LAS bf16_t*)(lds + GL_QE1); LAS bf16_t* ke0 = (LAS bf16_t*)(lds + GL_KE0); LAS bf16_t* ke1 = (LAS bf16_t*)(lds + GL_KE1);
          u32x4 a, b2, c2, d2;
#pragma unroll
          for (int i = 0; i < 4; ++i) { const int kk = k8 + 2 * i; const float f0 = bfs[r * 64 + kk], f1 = bfs[r * 64 + kk + 1], g0 = bbs[r * 64 + kk], g1 = bbs[r * 64 + kk + 1];
              a[i] = cvt_pk_bf16(qv[2 * i] * 0.125f * __expf(f0), qv[2 * i + 1] * 0.125f * __expf(f1)); b2[i] = cvt_pk_bf16(qv[2 * i] * 0.125f * __expf(g0), qv[2 * i + 1] * 0.125f * __expf(g1));
              c2[i] = cvt_pk_bf16(kv[2 * i] * __expf(-f0), kv[2 * i + 1] * __expf(-f1)); d2[i] = cvt_pk_bf16(kv[2 * i] * __expf(-g0), kv[2 * i + 1] * __expf(-g1)); }
          *(LAS u32x4*)(qe0 + r * GLD + k8) = a; *(LAS u32x4*)(qe1 + r * GLD + k8) = b2; *(LAS u32x4*)(ke0 + r * GLD + k8) = c2; *(LAS u32x4*)(ke1 + r * GLD + k8) = d2; }
#pragma unroll
      for (int hh = 0; hh < 2; ++hh) { const int v8 = ((tid & 7) + 8 * hh) * 8; u32x4 vw = (u32x4){0u, 0u, 0u, 0u};
          if (ok) vw = vwp[hh];
#pragma unroll
          for (int i = 0; i < 4; ++i) { vT[(v8 + 2 * i) * GLD + SWZ(v8, r)] = (bf16_t)(vw[i] & 0xffffu); vT[(v8 + 2 * i + 1) * GLD + SWZ(v8, r)] = (bf16_t)(vw[i] >> 16); } }
    }
    if (MODE == 1) {
        const float* ds = (const float*)(p.ws + WS_DS); f32x4 sv[2][4];
#pragma unroll
        for (int d = 0; d < 2; ++d) { const float* src = ds + ((size_t)(ci * 4 + head) * 2 + d) * 8192;
#pragma unroll
            for (int i = 0; i < 4; ++i) sv[d][i] = *(const f32x4*)(src + (i * 512 + tid) * 4); }
#pragma unroll
        for (int d = 0; d < 2; ++d) { LAS bf16_t* sp = (LAS bf16_t*)(lds + (d ? GL_SP1 : GL_SP0));
#pragma unroll
            for (int i = 0; i < 4; ++i) { const int e = (i * 512 + tid) * 4; const f32x4 v = sv[d][i]; u32x2 w; w.x = cvt_pk_bf16(v[0], v[1]); w.y = cvt_pk_bf16(v[2], v[3]); *(LAS u32x2*)(sp + (e >> 6) * GLD + (e & 63)) = w; } }
    }
    __syncthreads();
    if (MODE == 0) {
        float* ds = (float*)(p.ws + WS_DS); float* dec = (float*)(p.ws + WS_DECAY);
        if (tid < 128) { const int d = tid >> 6, kk = tid & 63; dec[((size_t)(ci * 4 + head) * 2 + d) * 64 + kk] = __expf(d == 0 ? bfs[63 * 64 + kk] : bbs[kk]); }
#pragma unroll
        for (int d = 0; d < 2; ++d) { const LAS bf16_t* kd = (const LAS bf16_t*)(lds + (d ? GL_QE1 : GL_QE0)); float* dst = ds + ((size_t)(ci * 4 + head) * 2 + d) * 8192;
            for (int kt = 0; kt < 4; ++kt) { f32x4 acc = (f32x4){0.f, 0.f, 0.f, 0.f}; acc = mma_lds_sw(acc, vT + wid * 16 * GLD, wid * 16, kd + kt * 16 * GLD, kt * 16, GLD, 2, lane);
#pragma unroll
                for (int j = 0; j < 4; ++j) dst[(wid * 16 + (lane >> 4) * 4 + j) * 64 + kt * 16 + (lane & 15)] = acc[j]; } }
        __syncthreads();
        return;
    }
    const LAS bf16_t* qe0 = (const LAS bf16_t*)(lds + GL_QE0); const LAS bf16_t* qe1 = (const LAS bf16_t*)(lds + GL_QE1); const LAS bf16_t* ke0 = (const LAS bf16_t*)(lds + GL_KE0); const LAS bf16_t* ke1 = (const LAS bf16_t*)(lds + GL_KE1);
    LAS bf16_t* att = (LAS bf16_t*)(lds + GL_ATT);
    { const int it = wid >> 1;
#pragma unroll
      for (int t2 = 0; t2 < 2; ++t2) { const int jt = (wid & 1) * 2 + t2; f32x4 af = (f32x4){0.f, 0.f, 0.f, 0.f}, ab = af;
          af = mma_lds(af, qe0 + it * 16 * GLD, ke0 + jt * 16 * GLD, GLD, 2, lane); ab = mma_lds(ab, qe1 + it * 16 * GLD, ke1 + jt * 16 * GLD, GLD, 2, lane);
#pragma unroll
          for (int j = 0; j < 4; ++j) { const int i_ = it * 16 + (lane >> 4) * 4 + j, j_ = jt * 16 + (lane & 15); att[i_ * GLD + j_] = f2bf((j_ <= i_ ? af[j] : 0.f) + (j_ >= i_ ? ab[j] : 0.f)); } } }
    __syncthreads();
    LAS float* os = (LAS float*)(lds + GL_OS);
    { const int it = wid >> 1; const LAS bf16_t* sp0 = (const LAS bf16_t*)(lds + GL_SP0); const LAS bf16_t* sp1 = (const LAS bf16_t*)(lds + GL_SP1);
#pragma unroll
      for (int t4 = 0; t4 < 4; ++t4) { const int vt = (wid & 1) * 4 + t4; f32x4 acc = (f32x4){0.f, 0.f, 0.f, 0.f};
          acc = mma_lds_sw(acc, att + it * 16 * GLD, -1, vT + vt * 16 * GLD, vt * 16, GLD, 2, lane); acc = mma_lds(acc, qe0 + it * 16 * GLD, sp0 + vt * 16 * GLD, GLD, 2, lane); acc = mma_lds(acc, qe1 + it * 16 * GLD, sp1 + vt * 16 * GLD, GLD, 2, lane);
#pragma unroll
          for (int j = 0; j < 4; ++j) os[(it * 16 + (lane >> 4) * 4 + j) * 132 + vt * 16 + (lane & 15)] = acc[j]; } }
    __syncthreads();
    { const int r = tid >> 3, v0 = (tid & 7) * 16; float o[16]; float ss = 0.f;
#pragma unroll
      for (int i = 0; i < 16; ++i) { o[i] = os[r * 132 + v0 + i]; ss += o[i] * o[i]; }
      ss += __shfl_xor(ss, 1); ss += __shfl_xor(ss, 2); ss += __shfl_xor(ss, 4);
      const float rs = rsqrtf(ss * (1.0f / 128.0f) + 1e-6f);
      if (r >= rmin) { const size_t tok = (size_t)(tok0 + r); bf16_t* yall = (bf16_t*)(p.ws + WS_YALL);
#pragma unroll
          for (int hh = 0; hh < 2; ++hh) { const u32x4 gw = gwp[hh]; u32x4 w;
#pragma unroll
              for (int i = 0; i < 4; ++i) { const int e = hh * 8 + 2 * i; w[i] = cvt_pk_bf16(o[e] * rs * ngv[e] * silu(bflo(gw[i])), o[e + 1] * rs * ngv[e + 1] * silu(bfhi(gw[i]))); }
              *(u32x4*)(yall + tok * D + 512 + head * 128 + v0 + hh * 8) = w; } } }
    __syncthreads();
}

__device__ __forceinline__ float softplus_neg(float lam) { const float e = __expf(-lam); return lam + 0.f < -8.f ? -lam : (e < 0.02f ? e * (1.0f - e * (0.5f - e * (1.0f / 3.0f))) : __logf(1.0f + e)); }
__device__ __forceinline__ float one_minus_exp(float x) {
    return x > -0.5f ? -x * (1.0f + x * 0.5f * (1.0f + x * (1.0f / 3.0f) * (1.0f + x * 0.25f * (1.0f + x * 0.2f * (1.0f + x * (1.0f / 6.0f) * (1.0f + x * (1.0f / 7.0f))))))) : 1.0f - __expf(x);
}
template <int MODE>
__device__ __forceinline__ void lru_phase(const int TID, const int b, const int G, const Params& p, int l, LAS unsigned char* lds) {
    const int tid = TID, lane = tid & 63, wid = tid >> 6, q = lane >> 4;
    const bf16_t* cols = (const bf16_t*)(p.ws + WS_COLS);
    int it = b; if (it >= NCK * 8) return;
    const int nb = b & 7;
    LAS bf16_t* xcA = (LAS bf16_t*)lds; LAS float* xcf = (LAS float*)(lds + 17408);
    const int ch = tid & 127, rb = tid >> 7, gchc = nb * 128 + ch;
    const float w0 = p.in[18][(l * 4 + 0) * 1024 + gchc], w1 = p.in[18][(l * 4 + 1) * 1024 + gchc], w2 = p.in[18][(l * 4 + 2) * 1024 + gchc], w3 = p.in[18][(l * 4 + 3) * 1024 + gchc], cb = p.in[19][l * 1024 + gchc];
    const int chl = wid * 16 + (lane & 15), gch = nb * 128 + chl;
    float ba[2], bx[2], sp8[2];
#pragma unroll
    for (int d = 0; d < 2; ++d) { ba[d] = p.in[21][(l * 2 + d) * 1024 + gch]; bx[d] = p.in[23][(l * 2 + d) * 1024 + gch]; sp8[d] = 8.0f * softplus_neg(p.in[24][(l * 2 + d) * 1024 + gch]); }
    bf16x8 bfr[4][4];
    { const bf16_t* bt = (const bf16_t*)(p.ws + WS_BTLRU);
#pragma unroll
      for (int mat = 0; mat < 4; ++mat)
#pragma unroll
          for (int ks = 0; ks < 4; ++ks) bfr[mat][ks] = *(const bf16x8*)(bt + ((size_t)(mat * 8 + nb) * 128 + wid * 16 + (lane & 15)) * 128 + ks * 32 + q * 8); }
    bf16_t xr[19];
    { int seq, c; chunk_info(it >> 3, seq, c); const int s0 = seq_start(seq), L = seq_len(seq), pos0 = (c == 0 ? -48 : 16 + 64 * (c - 1));
      const bf16_t* xb = cols + (size_t)s0 * NINP + C_XC + gchc;
#pragma unroll
      for (int i = 0; i < 19; ++i) { const int pos = pos0 + rb * 16 - 2 + i; const int pc = pos < 0 ? 0 : (pos < L ? pos : L - 1); xr[i] = xb[(size_t)pc * NINP]; } }
    for (; it < NCK * 8; it += G) {
        const int ci = it >> 3;
        int seq, c; chunk_info(ci, seq, c);
        const int s0 = seq_start(seq);
        const int pos0 = (c == 0 ? -48 : 16 + 64 * (c - 1));
        const int rmin = (c == 0) ? 48 : 0;
        float xv[19];
        { const int L = seq_len(seq);
#pragma unroll
          for (int i = 0; i < 19; ++i) { const int pos = pos0 + rb * 16 - 2 + i; xv[i] = (pos >= 0 && pos < L) ? bf2f(xr[i]) : 0.f; } }
#pragma unroll
        for (int i = 0; i < 16; ++i) { const int r = rb * 16 + i; const float xc = (r >= rmin) ? cb + xv[i] * w0 + xv[i + 1] * w1 + xv[i + 2] * w2 + xv[i + 3] * w3 : 0.f;
            xcf[r * 132 + ch] = xc; xcA[r * 136 + ch] = f2bf(xc); }
        u32x4 gq[2]; float cin[2];
        if (MODE == 1) {
#pragma unroll
            for (int d = 0; d < 2; ++d) cin[d] = ((const float*)(p.ws + WS_LRUC))[((size_t)ci * 2 + d) * 1024 + gch];
            { const int r = tid >> 3; const int rr = r >= rmin ? r : rmin; const bf16_t* gp = cols + (size_t)(s0 + pos0 + rr) * NINP + C_GC + nb * 128 + (tid & 7) * 16;
              gq[0] = *(const u32x4*)gp; gq[1] = *(const u32x4*)(gp + 8); }
        }
        { const int itn = it + G;
          if (itn < NCK * 8) { int seqn, cn; chunk_info(itn >> 3, seqn, cn); const int s0n = seq_start(seqn), Ln = seq_len(seqn), pos0n = (cn == 0 ? -48 : 16 + 64 * (cn - 1));
              const bf16_t* xb = cols + (size_t)s0n * NINP + C_XC + gchc;
#pragma unroll
              for (int i = 0; i < 19; ++i) { const int pos = pos0n + rb * 16 - 2 + i; const int pc = pos < 0 ? 0 : (pos < Ln ? pos : Ln - 1); xr[i] = xb[(size_t)pc * NINP]; } } }
        LBAR();
        LAS bf16_t* gts = (LAS bf16_t*)(lds + 51200); LAS float* hfs = (LAS float*)(lds + 68608);
        float hsum[4][4];
#pragma unroll
        for (int d = 0; d < 2; ++d) {
            __builtin_amdgcn_sched_barrier(0);
            f32x4 acc[2][4];
#pragma unroll
            for (int rt = 0; rt < 4; ++rt) { bf16x8 afr[4];
#pragma unroll
                for (int ks = 0; ks < 4; ++ks) afr[ks] = *(const LAS bf16x8*)(xcA + (rt * 16 + (lane & 15)) * 136 + ks * 32 + q * 8);
#pragma unroll
                for (int kind = 0; kind < 2; ++kind) { f32x4 a = (f32x4){0.f, 0.f, 0.f, 0.f};
#pragma unroll
                    for (int ks = 0; ks < 4; ++ks) a = __builtin_amdgcn_mfma_f32_16x16x32_bf16(afr[ks], bfr[d * 2 + kind][ks], a, 0, 0, 0);
                    acc[kind][rt] = a; } }
            float a[4][4], bb[4][4];
#pragma unroll
            for (int rt = 0; rt < 4; ++rt)
#pragma unroll
                for (int j = 0; j < 4; ++j) { const int r = rt * 16 + q * 4 + j; const float rg = sigm(acc[0][rt][j] + ba[d]), ig = sigm(acc[1][rt][j] + bx[d]), la = -sp8[d] * rg;
                    const bool ok = r >= rmin; const float av = __expf(la), x2 = 2.0f * la; const float om = x2 > -0.25f ? -x2 * (1.0f + x2 * 0.5f * (1.0f + x2 * (1.0f / 3.0f) * (1.0f + x2 * 0.25f * (1.0f + x2 * 0.2f)))) : 1.0f - av * av;
                    a[rt][j] = ok ? av : 1.0f; bb[rt][j] = ok ? __builtin_amdgcn_sqrtf(om) * ig * xcf[r * 132 + chl] : 0.f; }
            float LA[4], LB[4];
#pragma unroll
            for (int rt = 0; rt < 4; ++rt) { float A = 1.f, B = 0.f;
#pragma unroll
                for (int jj = 0; jj < 4; ++jj) { const int j = d == 0 ? jj : 3 - jj; B = a[rt][j] * B + bb[rt][j]; A *= a[rt][j]; }
                LA[rt] = A; LB[rt] = B; }
            const size_t co = ((size_t)ci * 2 + d) * 1024 + gch;
            float h = (MODE == 1) ? cin[d] : 0.f, Atot = 1.f; float hin[4];
#pragma unroll
            for (int rr = 0; rr < 4; ++rr) { const int rt = d == 0 ? rr : 3 - rr;
#pragma unroll
                for (int qi = 0; qi < 4; ++qi) { const int qq = d == 0 ? qi : 3 - qi;
                    const float Aq = __shfl(LA[rt], (lane & 15) + 16 * qq), Bq = __shfl(LB[rt], (lane & 15) + 16 * qq);
                    if (qq == q) hin[rt] = h;
                    h = Aq * h + Bq; Atot *= Aq; } }
            if (MODE == 0) { if (q == 0) { ((float*)(p.ws + WS_LRUA))[co] = Atot; ((float*)(p.ws + WS_LRUH))[co] = h; } }
            else {
#pragma unroll
                for (int rt = 0; rt < 4; ++rt) { float hh = hin[rt];
#pragma unroll
                    for (int jj = 0; jj < 4; ++jj) { const int j = d == 0 ? jj : 3 - jj; hh = a[rt][j] * hh + bb[rt][j];
                        if (d == 0) hfs[(rt * 16 + q * 4 + j) * 132 + chl] = hh; else hsum[rt][j] = hh; } }
                if (d == 0) { *(LAS u32x4*)(gts + (tid >> 3) * 136 + (tid & 7) * 16) = gq[0]; *(LAS u32x4*)(gts + (tid >> 3) * 136 + (tid & 7) * 16 + 8) = gq[1]; } }
        }
        if (MODE == 1) { bf16_t* yall = (bf16_t*)(p.ws + WS_YALL);
            LBAR();
#pragma unroll
            for (int rt = 0; rt < 4; ++rt)
#pragma unroll
                for (int j = 0; j < 4; ++j) { const int r = rt * 16 + q * 4 + j; xcA[r * 136 + chl] = f2bf((hsum[rt][j] + hfs[r * 132 + chl]) * silu(bf2f(gts[r * 136 + chl]))); }
            LBAR();
            { const int r = tid >> 3; if (r >= rmin) { const u32x4 y0 = *(const LAS u32x4*)(xcA + r * 136 + (tid & 7) * 16), y1 = *(const LAS u32x4*)(xcA + r * 136 + (tid & 7) * 16 + 8);
                bf16_t* yp = yall + (size_t)(s0 + pos0 + r) * D + 1024 + nb * 128 + (tid & 7) * 16; *(u32x4*)yp = y0; *(u32x4*)(yp + 8) = y1; } } }
        LBAR();
    }
}


template <int WHICH>
__device__ __forceinline__ void skinny_tail(const int TID, const int b0, const Params& p, const int first) {
    const int lane = TID & 63, wid = TID >> 6, q = lane >> 4;
    if (wid >= 5) return;
    for (int b = b0; b < 256; b += (int)gridDim.x) {
    const int ct = b & 127, rt = (b >> 7) * 5 + wid;
    const int row = 24576 + rt * 16 + (lane & 15);
    const int colb = ct * 16 + (lane & 15);
    const bf16_t* cols = (const bf16_t*)(p.ws + WS_COLS);
    if (WHICH == 0) {
        const bf16_t* A = (const bf16_t*)(p.ws + WS_YALL) + (size_t)row * D + q * 8; const bf16_t* B = (const bf16_t*)(p.ws + WS_BTOUT) + (size_t)colb * D + q * 8;
        bf16_t* mbf = (bf16_t*)(p.ws + WS_H);
        f32x4 msum = (f32x4){0.f, 0.f, 0.f, 0.f};
        unsigned char gt[3][4];
#pragma unroll
        for (int br = 0; br < 3; ++br)
#pragma unroll
            for (int j = 0; j < 4; ++j) { const int cc = colb & 255; gt[br][j] = ((const unsigned char*)(cols + (size_t)(24576 + rt * 16 + q * 4 + j) * NINP + C_MG))[(br * 8 + (colb >> 8)) * 256 + ((((cc & 127) >> 5) * 4 + ((cc & 31) >> 3)) * 2 + (cc >> 7)) * 8 + (cc & 7)]; }
        float gs[3][4];
#pragma unroll
        for (int br = 0; br < 3; ++br)
#pragma unroll
            for (int j = 0; j < 4; ++j) { gs[br][j] = (float)gt[br][j] * (1.0f / 255.0f); asm volatile("" : "+v"(gs[br][j])); }
#pragma unroll
        for (int br = 0; br < 3; ++br) { const int koff = br * 512, nks = br == 2 ? 32 : 16; f32x4 acc = (f32x4){0.f, 0.f, 0.f, 0.f};
            for (int k0 = 0; k0 < nks; k0 += 8) { bf16x8 av[8], bv[8];
#pragma unroll
                for (int i = 0; i < 8; ++i) { av[i] = *(const bf16x8*)(A + koff + (k0 + i) * 32); bv[i] = *(const bf16x8*)(B + koff + (k0 + i) * 32); }
#pragma unroll
                for (int i = 0; i < 8; ++i) acc = __builtin_amdgcn_mfma_f32_16x16x32_bf16(av[i], bv[i], acc, 0, 0, 0); }
#pragma unroll
            for (int j = 0; j < 4; ++j) msum[j] += gs[br][j] * acc[j]; }
#pragma unroll
        for (int j = 0; j < 4; ++j) { const int tok = 24576 + rt * 16 + q * 4 + j; mbf[(size_t)tok * D + colb] = f2bf(msum[j]); }
    } else {
        const bf16_t* A = (const bf16_t*)(p.ws + WS_H) + (size_t)row * D + q * 8; const bf16_t* B = (const bf16_t*)(p.ws + WS_BTO) + (size_t)colb * D + q * 8;
        float* z = (float*)(p.ws + WS_Z);
        f32x4 acc = (f32x4){0.f, 0.f, 0.f, 0.f};
        for (int k0 = 0; k0 < 64; k0 += 8) { bf16x8 av[8], bv[8];
#pragma unroll
            for (int i = 0; i < 8; ++i) { av[i] = *(const bf16x8*)(A + (k0 + i) * 32); bv[i] = *(const bf16x8*)(B + (k0 + i) * 32); }
#pragma unroll
            for (int i = 0; i < 8; ++i) acc = __builtin_amdgcn_mfma_f32_16x16x32_bf16(av[i], bv[i], acc, 0, 0, 0); }
#pragma unroll
        for (int j = 0; j < 4; ++j) { const int tok = 24576 + rt * 16 + q * 4 + j; const float res = first ? src_row(p, tok)[colb] : z[(size_t)tok * D + colb]; z[(size_t)tok * D + colb] = res + acc[j]; }
    }
    }
}

#define XB_TMO      128
#define XB_XCNT(j)  (256  + 64 * (j))
#define XB_XSUB(j)  (1280 + 64 * (j))
#define XB_XGEN(j)  (2304 + 64 * (j))
#define XB_TOP      3328
#define XB_TOPGEN   3392
#define XCD_BAR_WORDS 3456
#define XB_SPIN_CAP (1u << 18)
__device__ __forceinline__ unsigned xb_ld(unsigned* p)              { return __hip_atomic_load(p, __ATOMIC_RELAXED, __HIP_MEMORY_SCOPE_AGENT); }
__device__ __forceinline__ unsigned xb_add(unsigned* p, unsigned v) { return __hip_atomic_fetch_add(p, v, __ATOMIC_RELAXED, __HIP_MEMORY_SCOPE_AGENT); }
__device__ __forceinline__ unsigned xb_xcc_id() { return (unsigned)__builtin_amdgcn_s_getreg((3 << 11) | 20) & 0xFu; }
#define XB_SPIN(cond, bar) do { unsigned _sp = 0; while (cond) { __builtin_amdgcn_s_sleep(1); \
    if ((++_sp & 255u) == 0u) { if (xb_ld(&(bar)[XB_TMO])) break; if (_sp > XB_SPIN_CAP) { atomicAdd(&(bar)[XB_TMO], 1u); break; } } } } while (0)
struct XcdBarrier { unsigned* bar; unsigned x; volatile LAS unsigned* st; };
__device__ __forceinline__ XcdBarrier xcd_barrier_post(unsigned* bar, volatile LAS unsigned* st) {
    XcdBarrier b; b.bar = bar; b.x = xb_xcc_id(); b.st = st;
    if (threadIdx.x == 0) (void)xb_add(&bar[XB_XCNT(b.x)], 1u);
    return b;
}
__device__ __forceinline__ void xcd_barrier_complete(unsigned* bar, unsigned x, unsigned& nloc, unsigned& nx) {
    const unsigned G = gridDim.x * gridDim.y * gridDim.z;
    unsigned sum, cnt, mine, sp = 0u;
    for (;;) {
        sum = 0u; cnt = 0u; mine = 0u;
#pragma unroll
        for (unsigned j = 0; j < 16; ++j) { const unsigned c = xb_ld(&bar[XB_XCNT(j)]); sum += c; cnt += (c > 0u) ? 1u : 0u; mine = (j == x) ? c : mine; }
        if (sum == G) break;
        __builtin_amdgcn_s_sleep(1);
        if ((++sp & 255u) == 0u) { if (xb_ld(&bar[XB_TMO])) break; if (sp > XB_SPIN_CAP) { atomicAdd(&bar[XB_TMO], 1u); break; } }
    }
    nloc = mine > 0u ? mine : 1u; nx = cnt > 0u ? cnt : 1u;
}
__device__ __forceinline__ void xcd_barrier(const XcdBarrier& b) {
    asm volatile("s_waitcnt vmcnt(0)" ::: "memory");
    __syncthreads();
    if (threadIdx.x == 0) {
        unsigned* bar = b.bar;
        __builtin_amdgcn_s_waitcnt(0);
        unsigned nloc = b.st[0], nx = b.st[1];
        if (nloc == 0u) { xcd_barrier_complete(bar, b.x, nloc, nx); b.st[0] = nloc; b.st[1] = nx; }
        const unsigned old = xb_add(&bar[XB_XSUB(b.x)], 1u);
        const unsigned gen = old / nloc;
        if (old + 1u == (gen + 1u) * nloc) {
            __builtin_amdgcn_fence(__ATOMIC_RELEASE, "agent");
            asm volatile("s_waitcnt vmcnt(0)" ::: "memory");
            const unsigned og = xb_add(&bar[XB_TOP], 1u);
            const unsigned tg = og / nx;
            if (og + 1u == (tg + 1u) * nx) xb_add(&bar[XB_TOPGEN], 1u);
            else XB_SPIN(xb_ld(&bar[XB_TOPGEN]) == tg, bar);
            __builtin_amdgcn_fence(__ATOMIC_ACQUIRE, "agent");
            xb_add(&bar[XB_XGEN(b.x)], 1u);
            asm volatile("s_waitcnt vmcnt(0)" ::: "memory");
        } else {
            XB_SPIN(xb_ld(&bar[XB_XGEN(b.x)]) == gen, bar);
            __builtin_amdgcn_fence(__ATOMIC_ACQUIRE, "agent");
            asm volatile("s_waitcnt vmcnt(0)" ::: "memory");
        }
    }
    __syncthreads();
}

__global__ void __launch_bounds__(512) fwd_megakernel(Params p_in) {
    extern __shared__ __attribute__((aligned(16))) unsigned char smem[];
    LAS unsigned char* lds = (LAS unsigned char*)smem;
    cg::grid_group grid = cg::this_grid();
    const int G = gridDim.x;
    const Params& p0 = p_in;
    volatile LAS unsigned* stw = (volatile LAS unsigned*)(lds + 150528);
    if (threadIdx.x == 0) { stw[0] = 0u; stw[1] = 0u; }
    __syncthreads();
    const XcdBarrier xb = xcd_barrier_post((unsigned*)(p_in.ws + WS_BAR), stw);
    for (int ph = p0.ph_lo; ph < p0.ph_hi; ++ph) {
        const int reps_ = (ph < 32 && (ph & 7) == DUP) ? 2 : 1;
        for (int rep_ = 0; rep_ < reps_; ++rep_) {
        int TID = threadIdx.x; asm volatile("" : "+v"(TID));
        int b = blockIdx.x; asm volatile("" : "+s"(b));
        Params p = p0; { unsigned long long t_ = (unsigned long long)p.ws; asm volatile("" : "+s"(t_)); p.ws = (unsigned char*)t_; }
        const char* ws = (const char*)p.ws;
        if (ph == 32) { final_norm_phase(TID, b, p); }
        else {
            const int l = ph >> 3, k = ph & 7;
            if (k == 0 && (PHM & 1)) { rmsnorm_phase(TID, b, p, l); convert_weights(TID, b, p, l, (LAS float*)lds); if (l == 0) s5_tables_all(TID, b, p); }
            else if (k == 1 && (PHM & 2)) {
                TileOrder S; S.nM = MP / 256; S.nN = NINP / 256; S.nwg = S.nM * S.nN; S.G = G; S.c = b; S.mult = 1; S.nt0 = D / 64; S.A = ws + WS_H; S.B = ws + WS_BTIN; S.tA = (size_t)256 * D * 2; S.tB = (size_t)256 * D * 2;
                EpiIn E; E.cols = (bf16_t*)(p.ws + WS_COLS); E.ubuf = (bf16_t*)(p.ws + WS_UBUF);
                gemm_phase(TID, lds, D, D, S, E);
                s5_assemble_a(TID, b, p, l);
            } else if (k == 2 && (PHM & 4)) {
                GroupOrder S; S.G = G; S.c = b; S.nt0 = 4; S.A = ws + WS_UBUF; S.B = ws + WS_PMAT; S.gsA = (size_t)CHP * 512 * 2; S.gsB = (size_t)256 * 256 * 2; S.tA = (size_t)256 * 512 * 2;
                EpiS5State E; E.st = (float*)(p.ws + WS_ST);
                if (SUBM & 4) gemm_phase(TID, lds, 512, 256, S, E);
                __syncthreads();
                { const int head_ = ((b + 128) % G) & 3, kk_ = TID & 63; float wg_[2][16], bg_[2];
                  _Pragma("unroll") for (int d = 0; d < 2; ++d) { bg_[d] = p.in[16][(l * 2 + d) * 256 + head_ * 64 + kk_]; _Pragma("unroll") for (int j = 0; j < 16; ++j) wg_[d][j] = p.in[15][((size_t)(l * 2 + d) * 16 + j) * 256 + head_ * 64 + kk_]; }
                  float ng_[16]; _Pragma("unroll") for (int e = 0; e < 16; ++e) ng_[e] = p.in[17][l * 512 + head_ * 128 + (TID & 7) * 16 + e];
                  for (int it = (b + 128) % G; it < NCK * 4; it += G) gla_item<0>(TID, p, l, it >> 2, it & 3, lds, wg_, bg_, ng_); }
                lru_phase<0>(TID, b, G, p, l, lds);
                s5_assemble_w(TID, b, p, l);
            } else if (k == 3 && (PHM & 8)) { scans_phase(TID, b, p, l, rep_ == 0); }
            else if (k == 4 && (PHM & 16)) {
                GroupOrder S; S.G = G; S.c = b; S.nt0 = 8; S.A = ws + WS_UBUF; S.B = ws + WS_WMAT; S.gsA = (size_t)CHP * 512 * 2; S.gsB = (size_t)256 * 512 * 2; S.tA = (size_t)256 * 512 * 2;
                EpiS5Out E; E.zs5 = (bf16_t*)(p.ws + WS_ZS5);
                if (SUBM & 4) gemm_phase(TID, lds, 512, 512, S, E);
                __syncthreads();
                { const int head_ = ((b + 128) % G) & 3, kk_ = TID & 63; float wg_[2][16], bg_[2];
                  _Pragma("unroll") for (int d = 0; d < 2; ++d) { bg_[d] = p.in[16][(l * 2 + d) * 256 + head_ * 64 + kk_]; _Pragma("unroll") for (int j = 0; j < 16; ++j) wg_[d][j] = p.in[15][((size_t)(l * 2 + d) * 16 + j) * 256 + head_ * 64 + kk_]; }
                  float ng_[16]; _Pragma("unroll") for (int e = 0; e < 16; ++e) ng_[e] = p.in[17][l * 512 + head_ * 128 + (TID & 7) * 16 + e];
                  for (int it = (b + 128) % G; it < NCK * 4; it += G) gla_item<1>(TID, p, l, it >> 2, it & 3, lds, wg_, bg_, ng_); }
                lru_phase<1>(TID, b, G, p, l, lds);
            } else if (k == 5 && (PHM & 32)) {
                TileOrder S; S.nM = MP / 256; S.nN = 2; S.nwg = S.nM * S.nN; S.G = G; S.c = b; S.mult = 1; S.nt0 = 8; S.A = ws + WS_ZS5; S.B = ws + WS_BTGLU; S.tA = (size_t)256 * 512 * 2; S.tB = (size_t)256 * 512 * 2;
                EpiGlu E; E.zs5 = (const bf16_t*)(p.ws + WS_ZS5); E.cols = (const bf16_t*)(p.ws + WS_COLS); E.bglu = p.in[14] + l * 512; E.yall = (bf16_t*)(p.ws + WS_YALL);
                gemm_phase(TID, lds, 512, 512, S, E);
            } else if (k == 6 && (PHM & 64)) {
                TileOrder S; S.nM = 96; S.nN = 8; S.nwg = S.nM * S.nN; S.G = G; S.c = b; S.mult = 3; S.nt0 = 8; S.A = ws + WS_YALL; S.B = ws + WS_BTOUT; S.tA = (size_t)256 * D * 2; S.tB = (size_t)256 * D * 2;
                EpiOut E; E.cols = (const bf16_t*)(p.ws + WS_COLS); E.mbf = (bf16_t*)(p.ws + WS_H);
                gemm_phase(TID, lds, D, D, S, E);
                skinny_tail<0>(TID, b, p, 0);
            } else if (PHM & 128) {
                TileOrder S; S.nM = 96; S.nN = 8; S.nwg = S.nM * S.nN; S.G = G; S.c = b; S.mult = 1; S.nt0 = D / 64; S.A = ws + WS_H; S.B = ws + WS_BTO; S.tA = (size_t)256 * D * 2; S.tB = (size_t)256 * D * 2;
                EpiWo E; E.z = (float*)(p.ws + WS_Z); E.pp = &p; E.first = (l == 0);
                gemm_phase(TID, lds, D, D, S, E);
                skinny_tail<1>(TID, b, p, l == 0);
            }
        }
        }
        if (p0.use_sync && ph + 1 < p0.ph_hi) { if (ph == p0.ph_lo) grid.sync(); else xcd_barrier(xb); }
    }
}

extern "C" void kernel_launch(void* const* d_in, const int* in_sizes, int n_in, void* d_out, int out_size, void* d_ws, size_t ws_size, hipStream_t stream) {
    static int grid = 0, coop = 1;
    if (grid == 0) {
        if (n_in != 30 || ws_size < WS_END2) { fprintf(stderr, "kernel_launch: unexpected n_in %d or ws_size %zu (< %zu)\n", n_in, ws_size, (size_t)WS_END); grid = -1; return; }
        int dev = 0, cus = 0, per_cu = 0;
        (void)hipGetDevice(&dev); (void)hipDeviceGetAttribute(&cus, hipDeviceAttributeMultiprocessorCount, dev);
        if (hipFuncSetAttribute((const void*)fwd_megakernel, hipFuncAttributeMaxDynamicSharedMemorySize, LDS_BYTES) != hipSuccess) { fprintf(stderr, "kernel_launch: hipFuncSetAttribute failed\n"); grid = -1; return; }
        if (hipOccupancyMaxActiveBlocksPerMultiprocessor(&per_cu, (const void*)fwd_megakernel, 512, LDS_BYTES) != hipSuccess || per_cu < 1) { fprintf(stderr, "kernel_launch: occupancy query gave %d\n", per_cu); per_cu = 1; }
        (void)hipGetLastError();
        grid = cus * 1;
    }
    if (grid < 0) return;
    Params p{};
    for (int i = 0; i < 30; ++i) p.in[i] = (const float*)d_in[i];
    p.out = (float*)d_out; p.ws = (unsigned char*)d_ws; p.pad = 0;
    (void)hipMemsetAsync((char*)d_ws + WS_BAR, 0, 3456 * 4, stream);
    if (coop) {
        p.ph_lo = 0; p.ph_hi = 33; p.use_sync = 1;
        void* args[] = {&p};
        hipError_t e = hipLaunchCooperativeKernel((const void*)fwd_megakernel, dim3(grid), dim3(512), args, LDS_BYTES, stream);
        if (e == hipSuccess) return;
        fprintf(stderr, "kernel_launch: cooperative launch failed: %s (grid %d); falling back to one launch per phase\n", hipGetErrorString(e), grid);
        (void)hipGetLastError(); coop = 0;
    }
    for (int ph = 0; ph < 33; ++ph) { p.ph_lo = ph; p.ph_hi = ph + 1; p.use_sync = 0; hipLaunchKernelGGL(fwd_megakernel, dim3(grid), dim3(512), LDS_BYTES, stream, p); }
}
```

```cpp
#include <hip/hip_runtime.h>
#include <hip/hip_cooperative_groups.h>
#include <cstdio>
namespace cg = cooperative_groups;
#define LAS __attribute__((address_space(3)))
typedef unsigned short bf16_t;
typedef short bf16x8 __attribute__((ext_vector_type(8)));
typedef float f32x4 __attribute__((ext_vector_type(4)));
typedef float f32x2 __attribute__((ext_vector_type(2)));
typedef unsigned u32x2 __attribute__((ext_vector_type(2)));
typedef unsigned u32x4 __attribute__((ext_vector_type(4)));

constexpr int D = 2048, NTOK = 24736, MP = 24832, NINP = 11008, NIN = 10784;
constexpr int NCH16 = 1546, CHP = 1792, NCK = 394;
constexpr int C_GA = 512, C_Q = 1024, C_K = 1280, C_V = 1536, C_GB = 2048, C_XC = 2560, C_GC = 3584, C_MG = 4608, C_GLR = 10752;
constexpr int LDS_BYTES = 150528 + 16;
#ifndef SYNCREP
#define SYNCREP 1
#endif
#ifndef DUP
#define DUP -1
#endif
#ifndef SUBM
#define SUBM 7
#endif
#ifndef PHM
#define PHM 255
#endif

constexpr size_t al256(size_t x) { return (x + 255) & ~(size_t)255; }
constexpr size_t WS_Z = 0;
constexpr size_t WS_H = WS_Z + al256((size_t)MP * D * 4);
constexpr size_t WS_COLS = WS_H + al256((size_t)MP * D * 2);
constexpr size_t WS_YALL = WS_COLS + al256((size_t)MP * NINP * 2);
constexpr size_t WS_ZS5 = WS_YALL + al256((size_t)MP * D * 2);
constexpr size_t WS_UBUF = WS_ZS5 + al256((size_t)MP * 512 * 2);
constexpr size_t WS_ST = WS_UBUF + al256((size_t)32 * CHP * 512 * 2);
constexpr size_t WS_DS = WS_ST + al256((size_t)32 * CHP * 256 * 4);
constexpr size_t WS_M32 = WS_UBUF;
constexpr size_t WS_DECAY = WS_DS + al256((size_t)NCK * 4 * 2 * 8192 * 4);
constexpr size_t WS_LRUA = WS_DECAY + al256((size_t)NCK * 4 * 2 * 64 * 4);
constexpr size_t WS_LRUH = WS_LRUA + al256((size_t)NCK * 2 * 1024 * 4);
constexpr size_t WS_LRUC = WS_LRUH + al256((size_t)NCK * 2 * 1024 * 4);
constexpr size_t WS_PW = WS_LRUC + al256((size_t)NCK * 2 * 1024 * 4);
constexpr size_t WS_BBAR = WS_PW + al256((size_t)4 * 32 * 2 * 17 * 64 * 8);
constexpr size_t WS_WMAT = WS_BBAR + al256((size_t)4 * 32 * 2 * 64 * 16 * 8);
constexpr size_t WS_PMAT = WS_WMAT + al256((size_t)32 * 256 * 512 * 2);
constexpr size_t WS_BTIN = WS_PMAT + al256((size_t)32 * 256 * 256 * 2);
constexpr size_t WS_BTOUT = WS_BTIN + al256((size_t)NINP * D * 2);
constexpr size_t WS_BTO = WS_BTOUT + al256((size_t)D * D * 2);
constexpr size_t WS_BTGLU = WS_BTO + al256((size_t)D * D * 2);
constexpr size_t WS_BTLRU = WS_BTGLU + al256((size_t)512 * 512 * 2);
constexpr size_t WS_KMAT = WS_BTLRU + al256((size_t)32 * 128 * 128 * 2);
constexpr size_t WS_BAR = WS_KMAT + al256((size_t)32 * 2 * 16 * 256 * 4);
constexpr size_t WS_END = WS_BAR + al256((size_t)3456 * 4);
constexpr size_t WS_GB = WS_END;
constexpr size_t WS_END2 = WS_GB + al256((size_t)NCK * 4 * 8192 * 4);
constexpr size_t PWL = (size_t)32 * 2 * 17 * 64, BBL = (size_t)32 * 2 * 64 * 16;
static_assert(WS_END2 <= (size_t)1413480448, "workspace too large");
static_assert((size_t)MP * D * 4 <= WS_DECAY - WS_UBUF, "m32 alias too small");

struct Params { const float* in[30]; float* out; unsigned char* ws; int ph_lo, ph_hi, use_sync, pad; };

#define LBAR() do { asm volatile("s_waitcnt lgkmcnt(0)" ::: "memory"); __builtin_amdgcn_s_barrier(); asm volatile("" ::: "memory"); } while (0)
__device__ __forceinline__ unsigned cvt_pk_bf16(float lo, float hi) { unsigned r; asm volatile("v_cvt_pk_bf16_f32 %0, %1, %2" : "=v"(r) : "v"(lo), "v"(hi)); return r; }
__device__ __forceinline__ bf16_t f2bf(float f) { return (bf16_t)(cvt_pk_bf16(f, 0.f) & 0xffffu); }
__device__ __forceinline__ float bf2f(bf16_t b) { return __uint_as_float(((unsigned)b) << 16); }
__device__ __forceinline__ float bflo(unsigned w) { return __uint_as_float(w << 16); }
__device__ __forceinline__ float bfhi(unsigned w) { return __uint_as_float(w & 0xffff0000u); }
__device__ __forceinline__ float sigm(float x) { return __builtin_amdgcn_rcpf(1.0f + __expf(-x)); }
__device__ __forceinline__ float silu(float x) { return x * sigm(x); }
__device__ __forceinline__ float gelu_t(float x) { const float u = 0.7978845608028654f * (x + 0.044715f * x * x * x); return x * sigm(2.0f * u); }
__device__ __forceinline__ float logsig(float x) { return -(fmaxf(-x, 0.f) + __logf(1.0f + __expf(-fabsf(x)))); }

__device__ __forceinline__ int seq_start(int s) { return s < 2 ? s * 4112 : 8224 + (s - 2) * 2064; }
__device__ __forceinline__ int seq_len(int s) { return s < 2 ? 4112 : 2064; }
__device__ __forceinline__ void chunk_info(int ci, int& seq, int& c) { if (ci < 130) { seq = ci / 65; c = ci - seq * 65; } else { const int t = ci - 130; const int q = t / 33; seq = 2 + q; c = t - q * 33; } }

constexpr int BM = 256, BK = 64, HALF = 128, HTB = HALF * BK * 2, STAGE_BYTES = 8 * HTB, NXCD = 8, WGM = 8;
__device__ __forceinline__ int lds_byte(int r, int c) { const int st = (r >> 4) * 2 + (c >> 5), rr = r & 15, cc = c & 31, ob = rr * 64 + cc * 2; return st * 1024 + (ob ^ (((ob >> 9) & 1) << 5)); }
__device__ __forceinline__ void stage_rc(int b, int& R, int& C) { const int st = b / 1024, sb = b % 1024, swz = sb ^ (((sb >> 9) & 1) << 5); R = (st >> 1) * 16 + swz / 64; C = (st & 1) * 32 + (swz % 64) / 2; }

struct Unit { int pm, pn, sub, nt; const char* a; const char* b; };

struct TileOrder {
    int nM, nN, nwg, G, c, mult, nt0; const char* A; const char* B; size_t tA, tB;
    __device__ __forceinline__ bool next(int i, Unit& u) const {
        const int ti = i / mult, sub = i - ti * mult;
        const long L = (long)ti * G + c; if (L >= nwg) return false;
        int wgid = (int)L; { const int q = nwg / NXCD, r = nwg % NXCD, xcd = wgid % NXCD, off = wgid / NXCD; wgid = (xcd < r ? xcd * (q + 1) : r * (q + 1) + (xcd - r) * q) + off; }
        const int nig = WGM * nN, gid = wgid / nig, fm = gid * WGM, gsz = (nM - fm) < WGM ? (nM - fm) : WGM;
        u.pm = fm + ((wgid % nig) % gsz); u.pn = (wgid % nig) / gsz; u.sub = sub;
        const int koff = (mult == 3) ? sub * 512 : 0; u.nt = (mult == 3) ? (sub == 2 ? 16 : 8) : nt0;
        u.a = A + (size_t)u.pm * tA + (size_t)koff * 2; u.b = B + (size_t)u.pn * tB + (size_t)koff * 2; return true;
    }
};
struct GroupOrder {
    int G, c, nt0; const char* A; const char* B; size_t gsA, gsB, tA;
    __device__ __forceinline__ bool next(int i, Unit& u) const {
        const int L = i * G + c; if (L >= 224) return false;
        const int g = L / 7, pm = L - g * 7; u.pm = pm; u.pn = 0; u.sub = g; u.nt = nt0;
        u.a = A + (size_t)g * gsA + (size_t)pm * tA; u.b = B + (size_t)g * gsB; return true;
    }
};

__device__ __forceinline__ int perm32(int rho) { const int n = rho >> 4, i = rho & 15; return 8 * (i >> 2) + 4 * n + (i & 3); }
template <class Epi, class Sched>
__device__ __forceinline__ void gemm_phase(const int TID, LAS unsigned char* lds, const int lda, const int ldb, const Sched& S, const Epi& E) {
    const int tid = TID, wid = __builtin_amdgcn_readfirstlane(tid >> 6), lane = tid & 63, wr = wid >> 2, wc = wid & 3, fr = lane & 15, fq = lane >> 4;
    unsigned voffA[2], voffB[2];
#pragma unroll
    for (int i = 0; i < 2; ++i) { int R, C; stage_rc(tid * 16 + i * 8192, R, C); const int Rb = Epi::PERM ? ((R & ~31) + perm32(R & 31)) : R; voffA[i] = (unsigned)(R * lda + C) * 2u; voffB[i] = (unsigned)(Rb * ldb + C) * 2u; }
    const size_t kstep = (size_t)(BK * 2);
    const size_t hA = (size_t)HALF * lda * 2, hB = (size_t)HALF * ldb * 2;
    const unsigned ldsw = (unsigned)wid * 1024u;
    const int aoff = lds_byte(wr * 64 + fr, fq * 8), boff = lds_byte(wc * 32 + fr, fq * 8);
#define PG8_SA(b, h) (((b) * 2 + (h)) * HTB)
#define PG8_SB(b, h) ((4 + (b) * 2 + (h)) * HTB)
#define PG8_STAGE(bufoff, gbase, voff) do { _Pragma("unroll") for (int _i = 0; _i < 2; ++_i) \
        __builtin_amdgcn_global_load_lds((const unsigned*)((const char*)(gbase) + (voff)[_i]), (LAS unsigned*)(lds + (bufoff) + ldsw + _i * 8192), 16, 0, 0); } while (0)
#define PG8_LDA(dst, b, h) do { _Pragma("unroll") for (int m = 0; m < 4; ++m) _Pragma("unroll") for (int k = 0; k < 2; ++k) dst[m][k] = *(const LAS bf16x8*)(lds + PG8_SA(b, h) + aoff + m * 2048 + k * 1024); } while (0)
#define PG8_LDB(dst, b, h) do { _Pragma("unroll") for (int n = 0; n < 2; ++n) _Pragma("unroll") for (int k = 0; k < 2; ++k) dst[n][k] = *(const LAS bf16x8*)(lds + PG8_SB(b, h) + boff + n * 2048 + k * 1024); } while (0)
#define PG8_MMA(ai, bj, At, Bt) do { __builtin_amdgcn_s_setprio(1); _Pragma("unroll") for (int m = 0; m < 4; ++m) _Pragma("unroll") for (int n = 0; n < 2; ++n) _Pragma("unroll") for (int k = 0; k < 2; ++k) \
        acc[ai][bj][m][n] = __builtin_amdgcn_mfma_f32_16x16x32_bf16(Bt[n][k], At[m][k], acc[ai][bj][m][n], 0, 0, 0); __builtin_amdgcn_s_setprio(0); } while (0)
#define PG8_WAIT_V(n) asm volatile("s_waitcnt vmcnt(" #n ")" ::: "memory")
#define PG8_WAIT_L(n) asm volatile("s_waitcnt lgkmcnt(" #n ")" ::: "memory")
#define PG8_BAR __builtin_amdgcn_s_barrier()
#define PG8_SCHED __builtin_amdgcn_sched_barrier(0)
    Unit cur, nxt; int ui = 0;
    if (!S.next(0, cur)) return;
    f32x4 acc[2][2][4][2];
#pragma unroll
    for (int a = 0; a < 2; ++a)
#pragma unroll
        for (int b = 0; b < 2; ++b)
#pragma unroll
            for (int m = 0; m < 4; ++m)
#pragma unroll
                for (int n = 0; n < 2; ++n) acc[a][b][m][n] = (f32x4){0.f, 0.f, 0.f, 0.f};
    bf16x8 At[4][2], B0[2][2], B1[2][2];
    const char* cA = cur.a; const char* cB = cur.b;
    PG8_STAGE(PG8_SB(0, 0), cB, voffB); PG8_STAGE(PG8_SA(0, 0), cA, voffA); PG8_STAGE(PG8_SB(0, 1), cB + hB, voffB); PG8_STAGE(PG8_SA(0, 1), cA + hA, voffA);
    if (wr == 1) PG8_BAR;
    PG8_WAIT_V(4); PG8_BAR;
    PG8_STAGE(PG8_SB(1, 0), cB + kstep, voffB); PG8_STAGE(PG8_SA(1, 0), cA + kstep, voffA); PG8_STAGE(PG8_SB(1, 1), cB + hB + kstep, voffB);
    PG8_WAIT_V(6); PG8_BAR;
    for (;;) {
        const bool has_next = S.next(ui + 1, nxt);
        const char* nA = has_next ? nxt.a : cA; const char* nB = has_next ? nxt.b : cB;
        const int nt = cur.nt;
        for (int t = 0; t < nt; t += 2) {
            const bool last = (t == nt - 2);
            const char* a1 = cA + (size_t)(t + 1) * kstep;
            const char* a2 = last ? nA : cA + (size_t)(t + 2) * kstep; const char* b2 = last ? nB : cB + (size_t)(t + 2) * kstep;
            const char* a3 = a2 + kstep; const char* b3 = b2 + kstep;
            PG8_LDB(B0, 0, 0); PG8_SCHED; PG8_LDA(At, 0, 0); PG8_STAGE(PG8_SA(1, 1), a1 + hA, voffA);
            PG8_WAIT_L(8); PG8_BAR; PG8_WAIT_L(0); PG8_MMA(0, 0, At, B0); PG8_BAR; PG8_SCHED;
            PG8_LDB(B1, 0, 1); PG8_STAGE(PG8_SB(0, 0), b2, voffB);
            PG8_BAR; PG8_WAIT_L(0); PG8_MMA(0, 1, At, B1); PG8_BAR;
            PG8_LDA(At, 0, 1); PG8_STAGE(PG8_SA(0, 0), a2, voffA);
            PG8_BAR; PG8_WAIT_L(0); PG8_MMA(1, 0, At, B0); PG8_BAR; PG8_SCHED;
            PG8_STAGE(PG8_SB(0, 1), b2 + hB, voffB);
            PG8_WAIT_V(6); PG8_BAR; PG8_MMA(1, 1, At, B1); PG8_BAR;
            PG8_LDB(B0, 1, 0); PG8_SCHED; PG8_LDA(At, 1, 0); PG8_STAGE(PG8_SA(0, 1), a2 + hA, voffA);
            PG8_WAIT_L(8); PG8_BAR; PG8_WAIT_L(0); PG8_MMA(0, 0, At, B0); PG8_BAR; PG8_SCHED;
            PG8_LDB(B1, 1, 1); PG8_STAGE(PG8_SB(1, 0), b3, voffB);
            PG8_BAR; PG8_WAIT_L(0); PG8_MMA(0, 1, At, B1); PG8_BAR;
            PG8_LDA(At, 1, 1); PG8_STAGE(PG8_SA(1, 0), a3, voffA);
            PG8_BAR; PG8_WAIT_L(0); PG8_MMA(1, 0, At, B0); PG8_BAR; PG8_SCHED;
            PG8_STAGE(PG8_SB(1, 1), b3 + hB, voffB);
            PG8_WAIT_V(6); PG8_BAR; PG8_MMA(1, 1, At, B1); PG8_BAR;
        }
        E(acc, cur, wr, wc, fr, fq);
        if (!has_next) break;
#pragma unroll
        for (int a = 0; a < 2; ++a)
#pragma unroll
            for (int b = 0; b < 2; ++b)
#pragma unroll
                for (int m = 0; m < 4; ++m)
#pragma unroll
                    for (int n = 0; n < 2; ++n) acc[a][b][m][n] = (f32x4){0.f, 0.f, 0.f, 0.f};
        cur = nxt; cA = nA; cB = nB; ++ui;
    }
    PG8_WAIT_V(0);
    if (wr == 0) PG8_BAR;
    PG8_BAR;
#undef PG8_SA
#undef PG8_SB
#undef PG8_STAGE
#undef PG8_LDA
#undef PG8_LDB
#undef PG8_MMA
#undef PG8_WAIT_V
#undef PG8_WAIT_L
#undef PG8_BAR
#undef PG8_SCHED
}

#define EPI_LOOP(...) \
    const int row0 = u.pm * BM + wr * 64 + fr, col0 = u.pn * BM + wc * 32 + 4 * fq; \
    _Pragma("unroll") for (int ai = 0; ai < 2; ++ai) _Pragma("unroll") for (int m = 0; m < 4; ++m) { const int r = row0 + ai * HALF + m * 16; \
        _Pragma("unroll") for (int bj = 0; bj < 2; ++bj) _Pragma("unroll") for (int n = 0; n < 2; ++n) { const int c = col0 + bj * HALF + n * 16; const f32x4 v = acc[ai][bj][m][n]; __VA_ARGS__ } }

#define EPI_PROWS(...) \
    const int row0 = u.pm * BM + wr * 64 + fr, col0 = u.pn * BM + wc * 32 + 8 * fq; \
    _Pragma("unroll") for (int ai = 0; ai < 2; ++ai) _Pragma("unroll") for (int m = 0; m < 4; ++m) { const int r = row0 + ai * HALF + m * 16; __VA_ARGS__ }
__device__ __forceinline__ u32x4 pack8(const f32x4 a, const f32x4 b) { u32x4 w; w[0] = cvt_pk_bf16(a[0], a[1]); w[1] = cvt_pk_bf16(a[2], a[3]); w[2] = cvt_pk_bf16(b[0], b[1]); w[3] = cvt_pk_bf16(b[2], b[3]); return w; }
__device__ __forceinline__ unsigned q8(float x) { return (unsigned)__float2uint_rn(sigm(x) * 255.0f); }
__device__ __forceinline__ unsigned q8x4(const f32x4 v) { return q8(v[0]) | (q8(v[1]) << 8) | (q8(v[2]) << 16) | (q8(v[3]) << 24); }
struct EpiIn { static constexpr bool PERM = true; bf16_t* cols; bf16_t* ubuf;
    __device__ __forceinline__ void operator()(const f32x4 (&acc)[2][2][4][2], const Unit& u, int wr, int wc, int fr, int fq) const {
        if (u.pn >= 18 && u.pn < 42) {
            EPI_PROWS({ u32x4 w; w[0] = q8x4(acc[ai][0][m][0]); w[1] = q8x4(acc[ai][0][m][1]); w[2] = q8x4(acc[ai][1][m][0]); w[3] = q8x4(acc[ai][1][m][1]);
                *(u32x4*)((unsigned char*)(cols + (size_t)r * NINP + C_MG) + (u.pn - 18) * 256 + (wc * 4 + fq) * 16) = w; })
        } else {
            EPI_PROWS({ _Pragma("unroll") for (int bj = 0; bj < 2; ++bj) { const int c = col0 + bj * HALF;
                bf16_t* dst = (u.pn < 2) ? ubuf + ((size_t)((c >> 4) * CHP + (r >> 4)) * 512 + (r & 15) * 16 + (c & 15)) : cols + (size_t)r * NINP + c;
                *(u32x4*)dst = pack8(acc[ai][bj][m][0], acc[ai][bj][m][1]); } })
        }
    } };
struct EpiS5State { static constexpr bool PERM = false; float* st;
    __device__ __forceinline__ void operator()(const f32x4 (&acc)[2][2][4][2], const Unit& u, int wr, int wc, int fr, int fq) const {
        EPI_LOOP({ u32x2 w; w.x = cvt_pk_bf16(v[0], v[1]); w.y = cvt_pk_bf16(v[2], v[3]); *(u32x2*)((bf16_t*)st + ((size_t)(u.sub * CHP + r)) * 256 + c) = w; })
    } };
struct EpiS5Out { static constexpr bool PERM = true; bf16_t* zs5;
    __device__ __forceinline__ void operator()(const f32x4 (&acc)[2][2][4][2], const Unit& u, int wr, int wc, int fr, int fq) const {
        EPI_PROWS({ if (r < NCH16) { _Pragma("unroll") for (int bj = 0; bj < 2; ++bj) { const int c = col0 + bj * HALF; f32x4 a = acc[ai][bj][m][0], b2 = acc[ai][bj][m][1];
            _Pragma("unroll") for (int e = 0; e < 4; ++e) { a[e] = gelu_t(a[e]); b2[e] = gelu_t(b2[e]); }
            *(u32x4*)(zs5 + (size_t)(r * 16 + (c >> 4)) * 512 + u.sub * 16 + (c & 15)) = pack8(a, b2); } } })
    } };
#define EPI_ROWS(...) \
    const int row0 = u.pm * BM + wr * 64 + fr, col0 = u.pn * BM + wc * 32 + 4 * fq; \
    _Pragma("unroll") for (int ai = 0; ai < 2; ++ai) _Pragma("unroll") for (int m = 0; m < 4; ++m) { const int r = row0 + ai * HALF + m * 16; __VA_ARGS__ }
#define QOFF(q) (((q) >> 1) * HALF + ((q) & 1) * 16)
#define EPI_PIPE(LOADF, COMPF) \
    const int row0 = u.pm * BM + wr * 64 + fr, col0 = u.pn * BM + wc * 32 + 8 * fq; \
    LOADF(0, 0); \
    _Pragma("unroll") for (int gi = 0; gi < 8; ++gi) { if (gi + 1 < 8) { if ((gi & 1) == 0) { LOADF(gi + 1, 1); } else { LOADF(gi + 1, 0); } } if ((gi & 1) == 0) { COMPF(gi, 0); } else { COMPF(gi, 1); } }
#define GROW(gi) (row0 + ((gi) >> 2) * HALF + ((gi) & 3) * 16)
struct EpiGlu { static constexpr bool PERM = true; const bf16_t* zs5; const bf16_t* cols; const float* bglu; bf16_t* yall;
    __device__ __forceinline__ void operator()(const f32x4 (&acc)[2][2][4][2], const Unit& u, int wr, int wc, int fr, int fq) const {
        u32x4 zz[2][2], gg[2][2]; f32x4 bb[2][2];
        { const int c0 = u.pn * BM + wc * 32 + 8 * fq; _Pragma("unroll") for (int bj = 0; bj < 2; ++bj) { bb[bj][0] = *(const f32x4*)(bglu + c0 + bj * HALF); bb[bj][1] = *(const f32x4*)(bglu + c0 + bj * HALF + 4); } }
#define GLU_LOAD(gi, bf) do { const int r_ = GROW(gi); _Pragma("unroll") for (int bj = 0; bj < 2; ++bj) { const int c = col0 + bj * HALF; zz[bf][bj] = *(const u32x4*)(zs5 + (size_t)r_ * 512 + c); gg[bf][bj] = *(const u32x4*)(cols + (size_t)r_ * NINP + C_GA + c); } } while (0)
#define GLU_COMP(gi, bf) do { const int r_ = GROW(gi); _Pragma("unroll") for (int bj = 0; bj < 2; ++bj) { const int c = col0 + bj * HALF; f32x4 o[2]; \
            _Pragma("unroll") for (int hf = 0; hf < 2; ++hf) { const f32x4 v = acc[(gi) >> 2][bj][(gi) & 3][hf]; \
                o[hf][0] = bflo(zz[bf][bj][2 * hf]) * sigm(v[0] + bb[bj][hf][0]) * silu(bflo(gg[bf][bj][2 * hf])); o[hf][1] = bfhi(zz[bf][bj][2 * hf]) * sigm(v[1] + bb[bj][hf][1]) * silu(bfhi(gg[bf][bj][2 * hf])); \
                o[hf][2] = bflo(zz[bf][bj][2 * hf + 1]) * sigm(v[2] + bb[bj][hf][2]) * silu(bflo(gg[bf][bj][2 * hf + 1])); o[hf][3] = bfhi(zz[bf][bj][2 * hf + 1]) * sigm(v[3] + bb[bj][hf][3]) * silu(bfhi(gg[bf][bj][2 * hf + 1])); } \
            *(u32x4*)(yall + (size_t)r_ * D + c) = pack8(o[0], o[1]); } } while (0)
        EPI_PIPE(GLU_LOAD, GLU_COMP)
#undef GLU_LOAD
#undef GLU_COMP
    } };
__device__ __forceinline__ float ub(unsigned w, int k) { return (float)((w >> (8 * k)) & 255u) * (1.0f / 255.0f); }
struct EpiOut { static constexpr bool PERM = true; const bf16_t* cols; bf16_t* mbf;
    __device__ __forceinline__ void operator()(const f32x4 (&acc)[2][2][4][2], const Unit& u, int wr, int wc, int fr, int fq) const {
        u32x4 gg[8], mm[2][2];
        { const int row0g = u.pm * BM + wr * 64 + fr;
#pragma unroll
          for (int gi = 0; gi < 8; ++gi) gg[gi] = *(const u32x4*)((const unsigned char*)(cols + (size_t)(row0g + (gi >> 2) * HALF + (gi & 3) * 16) * NINP + C_MG) + (u.sub * 8 + u.pn) * 256 + (wc * 4 + fq) * 16); }
#define OUT_LOAD(gi, bf) do { const int r_ = GROW(gi); const bf16_t* mp = mbf + (size_t)r_ * D + col0; \
            _Pragma("unroll") for (int bj = 0; bj < 2; ++bj) { mm[bf][bj] = (u32x4){0u, 0u, 0u, 0u}; if (u.sub != 0) mm[bf][bj] = *(const u32x4*)(mp + bj * HALF); } } while (0)
#define OUT_COMP(gi, bf) do { const int r_ = GROW(gi); bf16_t* mp = mbf + (size_t)r_ * D + col0; _Pragma("unroll") for (int bj = 0; bj < 2; ++bj) { f32x4 o[2]; \
            _Pragma("unroll") for (int hf = 0; hf < 2; ++hf) { const f32x4 v = acc[(gi) >> 2][bj][(gi) & 3][hf]; const unsigned gw = gg[gi][bj * 2 + hf]; \
                o[hf][0] = bflo(mm[bf][bj][2 * hf]) + ub(gw, 0) * v[0]; o[hf][1] = bfhi(mm[bf][bj][2 * hf]) + ub(gw, 1) * v[1]; \
                o[hf][2] = bflo(mm[bf][bj][2 * hf + 1]) + ub(gw, 2) * v[2]; o[hf][3] = bfhi(mm[bf][bj][2 * hf + 1]) + ub(gw, 3) * v[3]; } \
            *(u32x4*)(mp + bj * HALF) = pack8(o[0], o[1]); } } while (0)
        EPI_PIPE(OUT_LOAD, OUT_COMP)
#undef OUT_LOAD
#undef OUT_COMP
    } };
__device__ __forceinline__ const float* src_row(const Params& p, int r);
struct EpiWo { static constexpr bool PERM = false; float* z; const Params* pp; int first;
    __device__ __forceinline__ void operator()(const f32x4 (&acc)[2][2][4][2], const Unit& u, int wr, int wc, int fr, int fq) const {
        EPI_ROWS({ if (r < NTOK) { float* zp = z + (size_t)r * D + col0; const float* rp = first ? src_row(*pp, r) + col0 : zp; f32x4 pv[4];
            _Pragma("unroll") for (int q = 0; q < 4; ++q) pv[q] = *(const f32x4*)(rp + QOFF(q));
            _Pragma("unroll") for (int q = 0; q < 4; ++q) *(f32x4*)(zp + QOFF(q)) = pv[q] + acc[ai][q >> 1][m][q & 1]; } })
    } };

__device__ __forceinline__ const float* src_row(const Params& p, int r) {
    int s, pos; if (r < 8224) { s = r / 4112; pos = r - s * 4112; } else { const int t = r - 8224; const int q = t / 2064; s = 2 + q; pos = t - q * 2064; }
    if (pos < 16) return p.in[2] + (size_t)pos * D;
    return s < 2 ? p.in[0] + ((size_t)s * 4096 + (pos - 16)) * D : p.in[1] + ((size_t)(s - 2) * 2048 + (pos - 16)) * D;
}
__device__ __forceinline__ void rmsnorm_phase(const int TID, const int BID, const Params& p, int l) {
    float* z = (float*)(p.ws + WS_Z); bf16_t* h = (bf16_t*)(p.ws + WS_H); const float* g = p.in[3] + (size_t)l * D;
    const int lane = TID & 63, gw = BID * 8 + (TID >> 6), nw = gridDim.x * 8;
    f32x4 gg[8];
#pragma unroll
    for (int i = 0; i < 8; ++i) gg[i] = *(const f32x4*)(g + (i * 64 + lane) * 4);
    f32x4 xn[8];
    { const int r0 = gw < NTOK ? gw : NTOK - 1; const float* src = (l == 0) ? src_row(p, r0) : z + (size_t)r0 * D;
#pragma unroll
      for (int i = 0; i < 8; ++i) xn[i] = *(const f32x4*)(src + (i * 64 + lane) * 4); }
    for (int r = gw; r < MP; r += nw) {
        bf16_t* hr = h + (size_t)r * D;
        f32x4 x[8];
#pragma unroll
        for (int i = 0; i < 8; ++i) x[i] = xn[i];
        { const int rn = (r + nw < NTOK) ? r + nw : NTOK - 1; const float* src = (l == 0) ? src_row(p, rn) : z + (size_t)rn * D;
#pragma unroll
          for (int i = 0; i < 8; ++i) xn[i] = *(const f32x4*)(src + (i * 64 + lane) * 4); }
        if (r >= NTOK) { for (int i = 0; i < 4; ++i) *(u32x4*)(hr + (i * 64 + lane) * 8) = (u32x4){0u, 0u, 0u, 0u}; continue; }
        float ss = 0.f;
#pragma unroll
        for (int i = 0; i < 8; ++i) ss += x[i][0] * x[i][0] + x[i][1] * x[i][1] + x[i][2] * x[i][2] + x[i][3] * x[i][3];
#pragma unroll
        for (int o = 32; o >= 1; o >>= 1) ss += __shfl_xor(ss, o);
        const float rs = rsqrtf(ss * (1.0f / D) + 1e-6f);
#pragma unroll
        for (int i = 0; i < 8; ++i) { const int c = (i * 64 + lane) * 4;
            u32x2 w; w.x = cvt_pk_bf16(x[i][0] * rs * gg[i][0], x[i][1] * rs * gg[i][1]); w.y = cvt_pk_bf16(x[i][2] * rs * gg[i][2], x[i][3] * rs * gg[i][3]); *(u32x2*)(hr + c) = w; }
    }
}
__device__ __forceinline__ void final_norm_phase(const int TID, const int BID, const Params& p) {
    const float* z = (const float*)(p.ws + WS_Z); const float* g = p.in[29];
    const int lane = TID & 63, gw = BID * 8 + (TID >> 6), nw = gridDim.x * 8;
    f32x4 gg[8];
#pragma unroll
    for (int i = 0; i < 8; ++i) gg[i] = *(const f32x4*)(g + (i * 64 + lane) * 4);
    f32x4 xn[8];
    { const int r0 = gw < NTOK ? gw : NTOK - 1;
#pragma unroll
      for (int i = 0; i < 8; ++i) xn[i] = *(const f32x4*)(z + (size_t)r0 * D + (i * 64 + lane) * 4); }
    for (int r = gw; r < NTOK; r += nw) {
        f32x4 x[8];
#pragma unroll
        for (int i = 0; i < 8; ++i) x[i] = xn[i];
        { const int rn = (r + nw < NTOK) ? r + nw : NTOK - 1;
#pragma unroll
          for (int i = 0; i < 8; ++i) xn[i] = *(const f32x4*)(z + (size_t)rn * D + (i * 64 + lane) * 4); }
        int s, pos; if (r < 8224) { s = r / 4112; pos = r - s * 4112; } else { const int t = r - 8224; const int q = t / 2064; s = 2 + q; pos = t - q * 2064; }
        if (pos < 16) continue;
        float* dst = s < 2 ? p.out + ((size_t)s * 4096 + (pos - 16)) * D : p.out + (size_t)2 * 4096 * D + ((size_t)(s - 2) * 2048 + (pos - 16)) * D;
        float ss = 0.f;
#pragma unroll
        for (int i = 0; i < 8; ++i) ss += x[i][0] * x[i][0] + x[i][1] * x[i][1] + x[i][2] * x[i][2] + x[i][3] * x[i][3];
#pragma unroll
        for (int o = 32; o >= 1; o >>= 1) ss += __shfl_xor(ss, o);
        const float rs = rsqrtf(ss * (1.0f / D) + 1e-6f);
#pragma unroll
        for (int i = 0; i < 8; ++i) { const int c = (i * 64 + lane) * 4; f32x4 o; o[0] = x[i][0] * rs * gg[i][0]; o[1] = x[i][1] * rs * gg[i][1]; o[2] = x[i][2] * rs * gg[i][2]; o[3] = x[i][3] * rs * gg[i][3]; __builtin_nontemporal_store(o, (f32x4*)(dst + c)); }
    }
}
__device__ __forceinline__ void conv_tile(const int TID, const float* src, int ldn, int k0, int n0, int nvalid, bf16_t* dst, int ldd, int kofs, bool mapin, LAS float* tile) {
    const int tx = TID & 63, ty = TID >> 6;
    const int ncl = (n0 + tx < nvalid) ? n0 + tx : nvalid - 1;
#pragma unroll
    for (int i = 0; i < 8; ++i) { const int k = ty + 8 * i; tile[k * 65 + tx] = src[(size_t)(k0 + k) * ldn + ncl]; }
    __syncthreads();
#pragma unroll
    for (int i = 0; i < 8; ++i) { const int nn = ty + 8 * i; int n = n0 + nn;
        if (n < nvalid) { if (mapin) n = (n < 2560) ? n : (n < 2592 ? n + (C_GLR - 2560) : n - 32); dst[(size_t)n * ldd + kofs + k0 + tx] = f2bf(tile[tx * 65 + nn]); } }
    __syncthreads();
}
__device__ __forceinline__ void convert_weights(const int TID, const int BID, const Params& p, int l, LAS float* tile) {
    const int G = gridDim.x, b = BID;
    bf16_t* btin = (bf16_t*)(p.ws + WS_BTIN); bf16_t* btout = (bf16_t*)(p.ws + WS_BTOUT); bf16_t* bto = (bf16_t*)(p.ws + WS_BTO); bf16_t* btglu = (bf16_t*)(p.ws + WS_BTGLU); bf16_t* btlru = (bf16_t*)(p.ws + WS_BTLRU);
    { const float* src = p.in[4] + (size_t)l * D * NIN; const int tx = TID & 63, ty = TID >> 6; float v[8];
      { const int t = b < 32 * 169 ? b : 0; const int kt = t / 169, ntl = t - kt * 169; const int ncl = (ntl * 64 + tx < NIN) ? ntl * 64 + tx : NIN - 1;
#pragma unroll
        for (int i = 0; i < 8; ++i) v[i] = src[(size_t)(kt * 64 + ty + 8 * i) * NIN + ncl]; }
      for (int t = b; t < 32 * 169; t += G) { const int kt = t / 169, ntl = t - kt * 169, k0 = kt * 64, n0 = ntl * 64;
#pragma unroll
          for (int i = 0; i < 8; ++i) tile[(ty + 8 * i) * 65 + tx] = v[i];
          { const int tn = (t + G < 32 * 169) ? t + G : t; const int ktn = tn / 169, ntn = tn - ktn * 169; const int ncl = (ntn * 64 + tx < NIN) ? ntn * 64 + tx : NIN - 1;
#pragma unroll
            for (int i = 0; i < 8; ++i) v[i] = src[(size_t)(ktn * 64 + ty + 8 * i) * NIN + ncl]; }
          LBAR();
#pragma unroll
          for (int i = 0; i < 8; ++i) { const int nn = ty + 8 * i; int n = n0 + nn;
              if (n < NIN) { n = (n < 2560) ? n : (n < 2592 ? n + (C_GLR - 2560) : n - 32); btin[(size_t)n * D + k0 + tx] = f2bf(tile[tx * 65 + nn]); } }
          LBAR(); } }
    for (size_t i = (size_t)b * 512 + TID; i < (size_t)(NINP - NIN) * D / 8; i += (size_t)G * 512) *(u32x4*)(btin + (size_t)NIN * D + i * 8) = (u32x4){0u, 0u, 0u, 0u};
    { const float* src = p.in[25] + (size_t)l * 512 * D; for (int t = (b + 64) % G; t < 8 * 32; t += G) { const int kt = t / 32, ntl = t - kt * 32; conv_tile(TID, src, D, kt * 64, ntl * 64, D, btout, D, 0, false, tile); } }
    { const float* src = p.in[26] + (size_t)l * 512 * D; for (int t = (b + 128) % G; t < 8 * 32; t += G) { const int kt = t / 32, ntl = t - kt * 32; conv_tile(TID, src, D, kt * 64, ntl * 64, D, btout, D, 512, false, tile); } }
    { const float* src = p.in[27] + (size_t)l * 1024 * D; for (int t = b; t < 16 * 32; t += G) { const int kt = t / 32, ntl = t - kt * 32; conv_tile(TID, src, D, kt * 64, ntl * 64, D, btout, D, 1024, false, tile); } }
    { const float* src = p.in[28] + (size_t)l * D * D; for (int t = b; t < 32 * 32; t += G) { const int kt = t / 32, ntl = t - kt * 32; conv_tile(TID, src, D, kt * 64, ntl * 64, D, bto, D, 0, false, tile); } }
    { const float* src = p.in[13] + (size_t)l * 512 * 512; for (int t = (b + 192) % G; t < 8 * 8; t += G) { const int kt = t / 8, ntl = t - kt * 8; conv_tile(TID, src, 512, kt * 64, ntl * 64, 512, btglu, 512, 0, false, tile); } }
    for (int t = (b + 32) % G; t < 128; t += G) { const int mat = t >> 2, sub = t & 3;
        const int dk = mat >> 3, nb = mat & 7, d = dk >> 1, kind = dk & 1;
        const float* src = p.in[kind ? 22 : 20] + ((size_t)(l * 2 + d) * 8 + nb) * 128 * 128;
        conv_tile(TID, src, 128, (sub >> 1) * 64, (sub & 1) * 64, 128, btlru + (size_t)mat * 128 * 128, 128, 0, false, tile); }
}
__device__ __forceinline__ double exp_small(double x) { double s = 1.0, t = 1.0; for (int i = 1; i <= 14; ++i) { t *= x / (double)i; s += t; } return s; }
__device__ __forceinline__ double exp_neg(double x) { double e = exp_small(x * (1.0 / 64.0)); for (int i = 0; i < 6; ++i) e *= e; return e; }
__device__ __forceinline__ void s5_tables_all(const int TID, const int BID, const Params& p) {
    for (int vidx = (int)(gridDim.x - 1 - BID) * 512 + TID; vidx < 4 * 4096; vidx += gridDim.x * 512) {
        const int l = vidx >> 12, idx = vidx & 4095;
        f32x2* pw = (f32x2*)(p.ws + WS_PW) + l * PWL; f32x2* bbar = (f32x2*)(p.ws + WS_BBAR) + l * BBL;
        const int g = idx >> 7, d = (idx >> 6) & 1, n = idx & 63;
        const double dt = exp_neg((double)p.in[7][(l * 2 + d) * 32 + g]);
        const double lr = (double)p.in[5][((size_t)(l * 2 + d) * 32 + g) * 64 + n], li = (double)p.in[6][((size_t)(l * 2 + d) * 32 + g) * 64 + n];
        const double mag = exp_neg(lr * dt);
        double ang = li * dt; const double twopi = 6.283185307179586476925287; ang -= twopi * rint(ang / twopi);
        const double a8 = ang * 0.125, a2 = a8 * a8;
        double sn = a8, cs = 1.0, ts = a8, tc = 1.0;
        for (int i = 1; i <= 9; ++i) { tc *= -a2 / (double)((2 * i - 1) * (2 * i)); cs += tc; ts *= -a2 / (double)((2 * i) * (2 * i + 1)); sn += ts; }
        for (int i = 0; i < 3; ++i) { const double c2 = cs * cs - sn * sn, s2 = 2.0 * cs * sn; cs = c2; sn = s2; }
        const double abr = mag * cs, abi = mag * sn;
        double pr = 1.0, pi = 0.0;
        for (int j = 0; j <= 16; ++j) { pw[((size_t)(g * 2 + d) * 17 + j) * 64 + n] = (f32x2){(float)pr, (float)pi}; const double nr = pr * abr - pi * abi, ni = pr * abi + pi * abr; pr = nr; pi = ni; }
        const double den = lr * lr + li * li, fr = ((abr - 1.0) * lr + abi * li) / den, fi = (abi * lr - (abr - 1.0) * li) / den;
        float brf[16], bif[16];
#pragma unroll
        for (int c4 = 0; c4 < 4; ++c4) { const f32x4 t0 = *(const f32x4*)(p.in[8] + (((size_t)l * 32 + g) * 64 + n) * 16 + c4 * 4), t1 = *(const f32x4*)(p.in[9] + (((size_t)l * 32 + g) * 64 + n) * 16 + c4 * 4);
#pragma unroll
            for (int e = 0; e < 4; ++e) { brf[c4 * 4 + e] = t0[e]; bif[c4 * 4 + e] = t1[e]; } }
#pragma unroll
        for (int c = 0; c < 16; ++c) { const double br = (double)brf[c], bi = (double)bif[c];
            bbar[((size_t)(g * 2 + d) * 64 + n) * 16 + c] = (f32x2){(float)(fr * br - fi * bi), (float)(fr * bi + fi * br)}; }
    }
}
__device__ __forceinline__ float s5_kval(const float* cre, const float* cim, const f32x2* pw, const f32x2* bbar, int l, int g, int d, int j, int c, int cp) {
    const float* cr = cre + (((size_t)(l * 2 + d) * 32 + g) * 16 + c) * 64; const float* ci = cim + (((size_t)(l * 2 + d) * 32 + g) * 16 + c) * 64;
    const f32x2* pp = pw + ((size_t)(g * 2 + d) * 17 + j) * 64; const f32x2* bb = bbar + ((size_t)(g * 2 + d) * 64) * 16 + cp;
    float s = 0.f;
#pragma unroll 16
    for (int n = 0; n < 64; ++n) { const f32x2 pv = pp[n]; const f32x2 bv = bb[(size_t)n * 16]; const float er = cr[n] * pv.x - ci[n] * pv.y, ei = cr[n] * pv.y + ci[n] * pv.x; s += er * bv.x - ei * bv.y; }
    return s;
}
__device__ __forceinline__ void s5_assemble_a(const int TID, const int BID, const Params& p, int l) {
    const f32x2* pw = (const f32x2*)(p.ws + WS_PW) + l * PWL; const f32x2* bbar = (const f32x2*)(p.ws + WS_BBAR) + l * BBL;
    float* kmat = (float*)(p.ws + WS_KMAT); bf16_t* pmat = (bf16_t*)(p.ws + WS_PMAT);
    const float* cre = p.in[10]; const float* cim = p.in[11];
    const size_t stride = (size_t)gridDim.x * 512;
    for (size_t idx = (size_t)BID * 512 + TID; idx < (size_t)32 * 2 * 16 * 256; idx += stride) {
        const int g = (int)(idx >> 13), d = (int)(idx >> 12) & 1, j = (int)(idx >> 8) & 15, c = (int)(idx >> 4) & 15, cp = (int)idx & 15;
        kmat[idx] = s5_kval(cre, cim, pw, bbar, l, g, d, j, c, cp);
    }
    for (size_t idx = (size_t)BID * 512 + TID; idx < (size_t)32 * 256 * 256; idx += stride) {
        const int g = (int)(idx >> 16), nout = (int)(idx >> 8) & 255, k = (int)idx & 255, d = nout >> 7, ri = (nout >> 6) & 1, n = nout & 63, s = k >> 4, cp = k & 15, j = d == 0 ? 15 - s : s;
        const f32x2 pv = pw[((size_t)(g * 2 + d) * 17 + j) * 64 + n]; const f32x2 bv = bbar[((size_t)(g * 2 + d) * 64 + n) * 16 + cp];
        pmat[idx] = f2bf(ri == 0 ? pv.x * bv.x - pv.y * bv.y : pv.x * bv.y + pv.y * bv.x);
    }
}
__device__ __forceinline__ void s5_assemble_w(const int TID, const int BID, const Params& p, int l) {
    const f32x2* pw = (const f32x2*)(p.ws + WS_PW) + l * PWL; const float* kmat = (const float*)(p.ws + WS_KMAT);
    bf16_t* wmat = (bf16_t*)(p.ws + WS_WMAT);
    const float* cre = p.in[10]; const float* cim = p.in[11];
    const size_t stride = (size_t)gridDim.x * 512;
    for (size_t idx = (size_t)BID * 512 + TID; idx < (size_t)32 * 256 * 512; idx += stride) {
        const int g = (int)(idx >> 17), nout = (int)(idx >> 9) & 255, k = (int)idx & 511, t = nout >> 4, c = nout & 15;
        float val;
        if (k < 256) { const int s = k >> 4, cp = k & 15; val = 0.f;
            const int jf = s <= t ? t - s : 0, jb = s >= t ? s - t : 0;
            const float kf = kmat[((((size_t)g * 2 + 0) * 16 + jf) * 16 + c) * 16 + cp], kb = kmat[((((size_t)g * 2 + 1) * 16 + jb) * 16 + c) * 16 + cp], dsk = p.in[12][l * 512 + g * 16 + c];
            val = (s <= t ? kf : 0.f) + (s >= t ? kb : 0.f) + ((s == t && c == cp) ? dsk : 0.f);
        } else { const int kk = k - 256, d = kk >> 7, ri = (kk >> 6) & 1, n = kk & 63, j = d == 0 ? t + 1 : 16 - t;
            const float cr = cre[(((size_t)(l * 2 + d) * 32 + g) * 16 + c) * 64 + n], ci = cim[(((size_t)(l * 2 + d) * 32 + g) * 16 + c) * 64 + n];
            const f32x2 pv = pw[((size_t)(g * 2 + d) * 17 + j) * 64 + n];
            val = ri == 0 ? cr * pv.x - ci * pv.y : -(cr * pv.y + ci * pv.x); }
        wmat[idx] = f2bf(val);
    }
}

__device__ __forceinline__ void scans_phase(const int TID, const int BID, const Params& p, const int l, const bool do_gla) {
    const int G = gridDim.x;
    const bool split = (G == 256);
    {
        const f32x2* pw = (const f32x2*)(p.ws + WS_PW) + l * PWL; const bf16_t* st = (const bf16_t*)(p.ws + WS_ST); bf16_t* ub = (bf16_t*)(p.ws + WS_UBUF);
        for (int idx = BID * 512 + TID; idx < 40960; idx += G * 512) {
            const int seq = idx >> 12, rem = idx & 4095, g = rem >> 7, d = (rem >> 6) & 1, n = rem & 63;
            const int ch0 = seq < 2 ? seq * 257 : 514 + (seq - 2) * 129, nc = seq < 2 ? 257 : 129;
            const f32x2 a16 = pw[((size_t)(g * 2 + d) * 17 + 16) * 64 + n];
            float sr = 0.f, si = 0.f;
            for (int s0 = 0; s0 < nc; s0 += 32) {
                float lr[32], li[32];
#pragma unroll
                for (int i = 0; i < 32; ++i) { const int step = s0 + i; lr[i] = 0.f; li[i] = 0.f;
                    { const int sc = step < nc ? step : nc - 1; const int c = d == 0 ? sc : nc - 1 - sc; const size_t row = (size_t)g * CHP + ch0 + c; lr[i] = bf2f(st[row * 256 + d * 128 + n]); li[i] = bf2f(st[row * 256 + d * 128 + 64 + n]); } }
#pragma unroll
                for (int i = 0; i < 32; ++i) { const int step = s0 + i;
                    if (step < nc) { const int c = d == 0 ? step : nc - 1 - step; const size_t row = (size_t)g * CHP + ch0 + c;
                        ub[row * 512 + 256 + d * 128 + n] = f2bf(sr); ub[row * 512 + 256 + d * 128 + 64 + n] = f2bf(si);
                        const float nr = a16.x * sr - a16.y * si + lr[i], ni = a16.x * si + a16.y * sr + li[i]; sr = nr; si = ni; } }
            }
        }
    }
    {
        const float* la = (const float*)(p.ws + WS_LRUA); const float* lh = (const float*)(p.ws + WS_LRUH); float* lc = (float*)(p.ws + WS_LRUC);
        const int vb0 = split ? BID - 80 : BID, vstride = split ? 1 << 20 : G;
        for (int vb = vb0; vb >= 0 && vb < 40; vb += vstride) {
            const int idx = vb * 512 + TID;
            const int seq = idx >> 11, d = (idx >> 10) & 1, ch = idx & 1023;
            const int cb = seq < 2 ? seq * 65 : 130 + (seq - 2) * 33, nc = seq < 2 ? 65 : 33;
            float cin = 0.f;
            for (int s0 = 0; s0 < nc; s0 += 16) {
                float A[16], H[16];
#pragma unroll
                for (int i = 0; i < 16; ++i) { const int step = s0 + i; A[i] = 1.f; H[i] = 0.f;
                    { const int sc = step < nc ? step : nc - 1; const int ci = cb + (d == 0 ? sc : nc - 1 - sc); const size_t o = ((size_t)ci * 2 + d) * 1024 + ch; A[i] = la[o]; H[i] = lh[o]; } }
#pragma unroll
                for (int i = 0; i < 16; ++i) { const int step = s0 + i;
                    if (step < nc) { const int ci = cb + (d == 0 ? step : nc - 1 - step); const size_t o = ((size_t)ci * 2 + d) * 1024 + ch; lc[o] = cin; cin = A[i] * cin + H[i]; } }
            }
        }
    }
    if (do_gla) {
        float* ds = (float*)(p.ws + WS_DS); const float* dec = (const float*)(p.ws + WS_DECAY);
        for (int it = 0; ; ++it) {
            int vb;
            if (split) { if (BID >= 120) { if (it >= 8) break; vb = (BID - 120) + 136 * it; } else { vb = 1088 + BID + 120 * it; if (vb >= 1280) break; } }
            else { vb = BID + G * it; if (vb >= 1280) break; }
            const int e = vb * 512 + TID;
            const int seq = e >> 16, rem = e & 65535, head = rem >> 14, d = (rem >> 13) & 1, el = rem & 8191, kk = el & 63;
            const int cb = seq < 2 ? seq * 65 : 130 + (seq - 2) * 33, nc = seq < 2 ? 65 : 33;
            float S = 0.f;
            for (int s0 = 0; s0 < nc; s0 += 16) {
                float tm[16], dc[16];
#pragma unroll
                for (int i = 0; i < 16; ++i) { const int step = s0 + i; tm[i] = 0.f; dc[i] = 1.f;
                    { const int sc = step < nc ? step : nc - 1; const int ci = cb + (d == 0 ? sc : nc - 1 - sc); const size_t o = ((size_t)(ci * 4 + head) * 2 + d); tm[i] = ds[o * 8192 + el]; dc[i] = dec[o * 64 + kk]; } }
#pragma unroll
                for (int i = 0; i < 16; ++i) { const int step = s0 + i;
                    if (step < nc) { const int ci = cb + (d == 0 ? step : nc - 1 - step); const size_t o = ((size_t)(ci * 4 + head) * 2 + d); ds[o * 8192 + el] = S; S = dc[i] * S + tm[i]; } }
            }
        }
    }
}

__device__ __forceinline__ f32x4 mma_lds(f32x4 acc, const LAS bf16_t* A, const LAS bf16_t* B, int ld, int nks, int lane) {
    const LAS bf16_t* ap = A + (lane & 15) * ld + (lane >> 4) * 8; const LAS bf16_t* bp = B + (lane & 15) * ld + (lane >> 4) * 8;
    for (int ks = 0; ks < nks; ++ks) acc = __builtin_amdgcn_mfma_f32_16x16x32_bf16(*(const LAS bf16x8*)(ap + ks * 32), *(const LAS bf16x8*)(bp + ks * 32), acc, 0, 0, 0);
    return acc;
}
__device__ __forceinline__ f32x4 mma_lds_sw(f32x4 acc, const LAS bf16_t* A, int rowA0, const LAS bf16_t* B, int rowB0, int ld, int nks, int lane) {
    const int swa = rowA0 >= 0 ? (((rowA0 + (lane & 15)) >> 3) & 7) : 0, swb = rowB0 >= 0 ? (((rowB0 + (lane & 15)) >> 3) & 7) : 0;
    const LAS bf16_t* ap = A + (lane & 15) * ld; const LAS bf16_t* bp = B + (lane & 15) * ld;
    for (int ks = 0; ks < nks; ++ks) { const int cb = ks * 4 + (lane >> 4);
        acc = __builtin_amdgcn_mfma_f32_16x16x32_bf16(*(const LAS bf16x8*)(ap + ((cb ^ swa) << 3)), *(const LAS bf16x8*)(bp + ((cb ^ swb) << 3)), acc, 0, 0, 0); }
    return acc;
}
#define SWZ(row, col) (((((col) >> 3) ^ (((row) >> 3) & 7)) << 3) + ((col) & 7))
constexpr int GL_GLR = 0, GL_BF = 16384, GL_BB = 32768, GL_OS = 0, GL_QE0 = 49152, GL_QE1 = 58368, GL_KE0 = 67584, GL_KE1 = 76800, GL_VT = 86016, GL_ATT = 104448, GL_SP0 = 113664, GL_SP1 = 132096;
constexpr int GLD = 72;
template <int MODE>
__device__ __forceinline__ void gla_item(const int TID, const Params& p, int l, int ci, int head, LAS unsigned char* lds, const float (&wg)[2][16], const float (&bg)[2], const float (&ngv)[16]) {
    const int tid = TID, lane = tid & 63, wid = tid >> 6;
    const bf16_t* cols = (const bf16_t*)(p.ws + WS_COLS);
    int seq, c; chunk_info(ci, seq, c);
    const int tok0 = seq_start(seq) + (c == 0 ? -48 : 16 + 64 * (c - 1));
    const int rmin = (c == 0) ? 48 : 0;
    LAS float* glr_s = (LAS float*)(lds + GL_GLR); LAS float* bfs = (LAS float*)(lds + GL_BF); LAS float* bbs = (LAS float*)(lds + GL_BB);
    f32x4 gbv[4];
    if (MODE == 1) { const float* gb = (const float*)(p.ws + WS_GB) + (size_t)(ci * 4 + head) * 8192;
#pragma unroll
      for (int i = 0; i < 4; ++i) gbv[i] = *(const f32x4*)(gb + (i * 512 + tid) * 4); }
    u32x4 kw = (u32x4){0u, 0u, 0u, 0u}, qw = kw, vwp[2], gwp[2];
    { const int r = tid >> 3, k8 = (tid & 7) * 8; const int rc = r >= rmin ? r : rmin; const bf16_t* rowp = cols + (size_t)(tok0 + rc) * NINP;
      kw = *(const u32x4*)(rowp + C_K + head * 64 + k8); if (MODE == 1) qw = *(const u32x4*)(rowp + C_Q + head * 64 + k8);
#pragma unroll
      for (int hh = 0; hh < 2; ++hh) { vwp[hh] = *(const u32x4*)(rowp + C_V + head * 128 + ((tid & 7) + 8 * hh) * 8); if (MODE == 1) gwp[hh] = *(const u32x4*)(rowp + C_GB + head * 128 + (tid & 7) * 16 + hh * 8); } }
    if (MODE == 0) {
    { const int r = tid >> 3, j4 = (tid & 7) * 4; f32x4 v = (f32x4){0.f, 0.f, 0.f, 0.f};
      { const int rc = r >= rmin ? r : rmin; const u32x2 w = *(const u32x2*)(cols + (size_t)(tok0 + rc) * NINP + C_GLR + j4); if (r >= rmin) { v[0] = bflo(w.x); v[1] = bfhi(w.x); v[2] = bflo(w.y); v[3] = bfhi(w.y); } }
      *(LAS f32x4*)(glr_s + r * 32 + j4) = v; }
    __syncthreads();
    { const int kk = tid & 63, rb = tid >> 6;
#pragma unroll
      for (int i = 0; i < 8; ++i) { const int r = rb + 8 * i; float x0 = bg[0], x1 = bg[1]; f32x4 gr[8];
#pragma unroll
          for (int j4 = 0; j4 < 8; ++j4) gr[j4] = *(const LAS f32x4*)(glr_s + r * 32 + j4 * 4);
#pragma unroll
          for (int j = 0; j < 16; ++j) { x0 += gr[j >> 2][j & 3] * wg[0][j]; x1 += gr[4 + (j >> 2)][j & 3] * wg[1][j]; }
          const bool ok = r >= rmin; bfs[r * 64 + kk] = ok ? logsig(x0) * 0.0625f : 0.f; bbs[r * 64 + kk] = ok ? logsig(x1) * 0.0625f : 0.f; } }
    __syncthreads();
    { const int col = tid & 127, part = tid >> 7, d = col >> 6, kk = col & 63; LAS float* bs = d ? bbs : bfs; LAS float* tot = glr_s;
      float v[16];
#pragma unroll
      for (int i = 0; i < 16; ++i) v[i] = bs[(part * 16 + i) * 64 + kk];
      if (d == 0) {
#pragma unroll
          for (int i = 1; i < 16; ++i) v[i] += v[i - 1];
          tot[part * 128 + col] = v[15]; }
      else {
#pragma unroll
          for (int i = 14; i >= 0; --i) v[i] += v[i + 1];
          tot[part * 128 + col] = v[0]; }
      __syncthreads();
      float off = 0.f;
#pragma unroll
      for (int pp = 0; pp < 4; ++pp) { const float t = tot[pp * 128 + col]; if (d == 0 ? pp < part : pp > part) off += t; }
#pragma unroll
      for (int i = 0; i < 16; ++i) bs[(part * 16 + i) * 64 + kk] = v[i] + off; }
    __syncthreads();
    { float* gb = (float*)(p.ws + WS_GB) + (size_t)(ci * 4 + head) * 8192;
#pragma unroll
      for (int i = 0; i < 4; ++i) { const int e = (i * 512 + tid) * 4; *(f32x4*)(gb + e) = *(const LAS f32x4*)(bfs + e); } }
    } else {
      __syncthreads();
#pragma unroll
      for (int i = 0; i < 4; ++i) { const int e = (i * 512 + tid) * 4; *(LAS f32x4*)(bfs + e) = gbv[i]; }
      __syncthreads();
    }
    LAS bf16_t* vT = (LAS bf16_t*)(lds + GL_VT);
    { const int r = tid >> 3, k8 = (tid & 7) * 8; const bool ok = r >= rmin;
      if (!ok) { kw = (u32x4){0u, 0u, 0u, 0u}; qw = kw; }
      float qv[8], kv[8];
#pragma unroll
      for (int i = 0; i < 4; ++i) { qv[2 * i] = bflo(qw[i]); qv[2 * i + 1] = bfhi(qw[i]); kv[2 * i] = bflo(kw[i]); kv[2 * i + 1] = bfhi(kw[i]); }
      if (MODE == 0) { LAS bf16_t* kd0 = (LAS bf16_t*)(lds + GL_QE0); LAS bf16_t* kd1 = (LAS bf16_t*)(lds + GL_QE1);
#pragma unroll
          for (int i = 0; i < 8; ++i) { const int kk = k8 + i; kd0[kk * GLD + SWZ(kk, r)] = f2bf(kv[i] * __expf(bfs[63 * 64 + kk] - bfs[r * 64 + kk])); kd1[kk * GLD + SWZ(kk, r)] = f2bf(kv[i] * __expf(bbs[kk] - bbs[r * 64 + kk])); }
      } else { LAS bf16_t* qe0 = (LAS bf16_t*)(lds + GL_QE0); LAS bf16_t* qe1 = (LAS bf16_t*)(lds + GL_QE1); LAS bf16_t* ke0 = (LAS bf16_t*)(lds + GL_KE0); LAS bf16_t* ke1 = (LAS bf16_t*)(lds + GL_KE1);
          u32x4 a, b2, c2, d2;
#pragma unroll
          for (int i = 0; i < 4; ++i) { const int kk = k8 + 2 * i; const float f0 = bfs[r * 64 + kk], f1 = bfs[r * 64 + kk + 1], g0 = bbs[r * 64 + kk], g1 = bbs[r * 64 + kk + 1];
              a[i] = cvt_pk_bf16(qv[2 * i] * 0.125f * __expf(f0), qv[2 * i + 1] * 0.125f * __expf(f1)); b2[i] = cvt_pk_bf16(qv[2 * i] * 0.125f * __expf(g0), qv[2 * i + 1] * 0.125f * __expf(g1));
              c2[i] = cvt_pk_bf16(kv[2 * i] * __expf(-f0), kv[2 * i + 1] * __expf(-f1)); d2[i] = cvt_pk_bf16(kv[2 * i] * __expf(-g0), kv[2 * i + 1] * __expf(-g1)); }
          *(LAS u32x4*)(qe0 + r * GLD + k8) = a; *(LAS u32x4*)(qe1 + r * GLD + k8) = b2; *(LAS u32x4*)(ke0 + r * GLD + k8) = c2; *(LAS u32x4*)(ke1 + r * GLD + k8) = d2; }
#pragma unroll
      for (int hh = 0; hh < 2; ++hh) { const int v8 = ((tid & 7) + 8 * hh) * 8; u32x4 vw = (u32x4){0u, 0u, 0u, 0u};
          if (ok) vw = vwp[hh];
#pragma unroll
          for (int i = 0; i < 4; ++i) { vT[(v8 + 2 * i) * GLD + SWZ(v8, r)] = (bf16_t)(vw[i] & 0xffffu); vT[(v8 + 2 * i + 1) * GLD + SWZ(v8, r)] = (bf16_t)(vw[i] >> 16); } }
    }
    if (MODE == 1) {
        const float* ds = (const float*)(p.ws + WS_DS); f32x4 sv[2][4];
#pragma unroll
        for (int d = 0; d < 2; ++d) { const float* src = ds + ((size_t)(ci * 4 + head) * 2 + d) * 8192;
#pragma unroll
            for (int i = 0; i < 4; ++i) sv[d][i] = *(const f32x4*)(src + (i * 512 + tid) * 4); }
#pragma unroll
        for (int d = 0; d < 2; ++d) { LAS bf16_t* sp = (LAS bf16_t*)(lds + (d ? GL_SP1 : GL_SP0));
#pragma unroll
            for (int i = 0; i < 4; ++i) { const int e = (i * 512 + tid) * 4; const f32x4 v = sv[d][i]; u32x2 w; w.x = cvt_pk_bf16(v[0], v[1]); w.y = cvt_pk_bf16(v[2], v[3]); *(LAS u32x2*)(sp + (e >> 6) * GLD + (e & 63)) = w; } }
    }
    __syncthreads();
    if (MODE == 0) {
        float* ds = (float*)(p.ws + WS_DS); float* dec = (float*)(p.ws + WS_DECAY);
        if (tid < 128) { const int d = tid >> 6, kk = tid & 63; dec[((size_t)(ci * 4 + head) * 2 + d) * 64 + kk] = __expf(d == 0 ? bfs[63 * 64 + kk] : bbs[kk]); }
#pragma unroll
        for (int d = 0; d < 2; ++d) { const LAS bf16_t* kd = (const LAS bf16_t*)(lds + (d ? GL_QE1 : GL_QE0)); float* dst = ds + ((size_t)(ci * 4 + head) * 2 + d) * 8192;
            for (int kt = 0; kt < 4; ++kt) { f32x4 acc = (f32x4){0.f, 0.f, 0.f, 0.f}; acc = mma_lds_sw(acc, vT + wid * 16 * GLD, wid * 16, kd + kt * 16 * GLD, kt * 16, GLD, 2, lane);
#pragma unroll
                for (int j = 0; j < 4; ++j) dst[(wid * 16 + (lane >> 4) * 4 + j) * 64 + kt * 16 + (lane & 15)] = acc[j]; } }
        __syncthreads();
        return;
    }
    const LAS bf16_t* qe0 = (const LAS bf16_t*)(lds + GL_QE0); const LAS bf16_t* qe1 = (const LAS bf16_t*)(lds + GL_QE1); const LAS bf16_t* ke0 = (const LAS bf16_t*)(lds + GL_KE0); const LAS bf16_t* ke1 = (const LAS bf16_t*)(lds + GL_KE1);
    LAS bf16_t* att = (LAS bf16_t*)(lds + GL_ATT);
    { const int it = wid >> 1;
#pragma unroll
      for (int t2 = 0; t2 < 2; ++t2) { const int jt = (wid & 1) * 2 + t2; f32x4 af = (f32x4){0.f, 0.f, 0.f, 0.f}, ab = af;
          af = mma_lds(af, qe0 + it * 16 * GLD, ke0 + jt * 16 * GLD, GLD, 2, lane); ab = mma_lds(ab, qe1 + it * 16 * GLD, ke1 + jt * 16 * GLD, GLD, 2, lane);
#pragma unroll
          for (int j = 0; j < 4; ++j) { const int i_ = it * 16 + (lane >> 4) * 4 + j, j_ = jt * 16 + (lane & 15); att[i_ * GLD + j_] = f2bf((j_ <= i_ ? af[j] : 0.f) + (j_ >= i_ ? ab[j] : 0.f)); } } }
    __syncthreads();
    LAS float* os = (LAS float*)(lds + GL_OS);
    { const int it = wid >> 1; const LAS bf16_t* sp0 = (const LAS bf16_t*)(lds + GL_SP0); const LAS bf16_t* sp1 = (const LAS bf16_t*)(lds + GL_SP1);
#pragma unroll
      for (int t4 = 0; t4 < 4; ++t4) { const int vt = (wid & 1) * 4 + t4; f32x4 acc = (f32x4){0.f, 0.f, 0.f, 0.f};
          acc = mma_lds_sw(acc, att + it * 16 * GLD, -1, vT + vt * 16 * GLD, vt * 16, GLD, 2, lane); acc = mma_lds(acc, qe0 + it * 16 * GLD, sp0 + vt * 16 * GLD, GLD, 2, lane); acc = mma_lds(acc, qe1 + it * 16 * GLD, sp1 + vt * 16 * GLD, GLD, 2, lane);
#pragma unroll
          for (int j = 0; j < 4; ++j) os[(it * 16 + (lane >> 4) * 4 + j) * 132 + vt * 16 + (lane & 15)] = acc[j]; } }
    __syncthreads();
    { const int r = tid >> 3, v0 = (tid & 7) * 16; float o[16]; float ss = 0.f;
#pragma unroll
      for (int i = 0; i < 16; ++i) { o[i] = os[r * 132 + v0 + i]; ss += o[i] * o[i]; }
      ss += __shfl_xor(ss, 1); ss += __shfl_xor(ss, 2); ss += __shfl_xor(ss, 4);
      const float rs = rsqrtf(ss * (1.0f / 128.0f) + 1e-6f);
      if (r >= rmin) { const size_t tok = (size_t)(tok0 + r); bf16_t* yall = (bf16_t*)(p.ws + WS_YALL);
#pragma unroll
          for (int hh = 0; hh < 2; ++hh) { const u32x4 gw = gwp[hh]; u32x4 w;
#pragma unroll
              for (int i = 0; i < 4; ++i) { const int e = hh * 8 + 2 * i; w[i] = cvt_pk_bf16(o[e] * rs * ngv[e] * silu(bflo(gw[i])), o[e + 1] * rs * ngv[e + 1] * silu(bfhi(gw[i]))); }
              *(u32x4*)(yall + tok * D + 512 + head * 128 + v0 + hh * 8) = w; } } }
    __syncthreads();
}

__device__ __forceinline__ float softplus_neg(float lam) { const float e = __expf(-lam); return lam + 0.f < -8.f ? -lam : (e < 0.02f ? e * (1.0f - e * (0.5f - e * (1.0f / 3.0f))) : __logf(1.0f + e)); }
__device__ __forceinline__ float one_minus_exp(float x) {
    return x > -0.5f ? -x * (1.0f + x * 0.5f * (1.0f + x * (1.0f / 3.0f) * (1.0f + x * 0.25f * (1.0f + x * 0.2f * (1.0f + x * (1.0f / 6.0f) * (1.0f + x * (1.0f / 7.0f))))))) : 1.0f - __expf(x);
}
template <int MODE>
__device__ __forceinline__ void lru_phase(const int TID, const int b, const int G, const Params& p, int l, LAS unsigned char* lds) {
    const int tid = TID, lane = tid & 63, wid = tid >> 6, q = lane >> 4;
    const bf16_t* cols = (const bf16_t*)(p.ws + WS_COLS);
    int it = b; if (it >= NCK * 8) return;
    const int nb = b & 7;
    LAS bf16_t* xcA = (LAS bf16_t*)lds; LAS float* xcf = (LAS float*)(lds + 17408);
    const int ch = tid & 127, rb = tid >> 7, gchc = nb * 128 + ch;
    const float w0 = p.in[18][(l * 4 + 0) * 1024 + gchc], w1 = p.in[18][(l * 4 + 1) * 1024 + gchc], w2 = p.in[18][(l * 4 + 2) * 1024 + gchc], w3 = p.in[18][(l * 4 + 3) * 1024 + gchc], cb = p.in[19][l * 1024 + gchc];
    const int chl = wid * 16 + (lane & 15), gch = nb * 128 + chl;
    float ba[2], bx[2], sp8[2];
#pragma unroll
    for (int d = 0; d < 2; ++d) { ba[d] = p.in[21][(l * 2 + d) * 1024 + gch]; bx[d] = p.in[23][(l * 2 + d) * 1024 + gch]; sp8[d] = 8.0f * softplus_neg(p.in[24][(l * 2 + d) * 1024 + gch]); }
    bf16x8 bfr[4][4];
    { const bf16_t* bt = (const bf16_t*)(p.ws + WS_BTLRU);
#pragma unroll
      for (int mat = 0; mat < 4; ++mat)
#pragma unroll
          for (int ks = 0; ks < 4; ++ks) bfr[mat][ks] = *(const bf16x8*)(bt + ((size_t)(mat * 8 + nb) * 128 + wid * 16 + (lane & 15)) * 128 + ks * 32 + q * 8); }
    bf16_t xr[19];
    { int seq, c; chunk_info(it >> 3, seq, c); const int s0 = seq_start(seq), L = seq_len(seq), pos0 = (c == 0 ? -48 : 16 + 64 * (c - 1));
      const bf16_t* xb = cols + (size_t)s0 * NINP + C_XC + gchc;
#pragma unroll
      for (int i = 0; i < 19; ++i) { const int pos = pos0 + rb * 16 - 2 + i; const int pc = pos < 0 ? 0 : (pos < L ? pos : L - 1); xr[i] = xb[(size_t)pc * NINP]; } }
    for (; it < NCK * 8; it += G) {
        const int ci = it >> 3;
        int seq, c; chunk_info(ci, seq, c);
        const int s0 = seq_start(seq);
        const int pos0 = (c == 0 ? -48 : 16 + 64 * (c - 1));
        const int rmin = (c == 0) ? 48 : 0;
        float xv[19];
        { const int L = seq_len(seq);
#pragma unroll
          for (int i = 0; i < 19; ++i) { const int pos = pos0 + rb * 16 - 2 + i; xv[i] = (pos >= 0 && pos < L) ? bf2f(xr[i]) : 0.f; } }
#pragma unroll
        for (int i = 0; i < 16; ++i) { const int r = rb * 16 + i; const float xc = (r >= rmin) ? cb + xv[i] * w0 + xv[i + 1] * w1 + xv[i + 2] * w2 + xv[i + 3] * w3 : 0.f;
            xcf[r * 132 + ch] = xc; xcA[r * 136 + ch] = f2bf(xc); }
        u32x4 gq[2]; float cin[2];
        if (MODE == 1) {
#pragma unroll
            for (int d = 0; d < 2; ++d) cin[d] = ((const float*)(p.ws + WS_LRUC))[((size_t)ci * 2 + d) * 1024 + gch];
            { const int r = tid >> 3; const int rr = r >= rmin ? r : rmin; const bf16_t* gp = cols + (size_t)(s0 + pos0 + rr) * NINP + C_GC + nb * 128 + (tid & 7) * 16;
              gq[0] = *(const u32x4*)gp; gq[1] = *(const u32x4*)(gp + 8); }
        }
        { const int itn = it + G;
          if (itn < NCK * 8) { int seqn, cn; chunk_info(itn >> 3, seqn, cn); const int s0n = seq_start(seqn), Ln = seq_len(seqn), pos0n = (cn == 0 ? -48 : 16 + 64 * (cn - 1));
              const bf16_t* xb = cols + (size_t)s0n * NINP + C_XC + gchc;
#pragma unroll
              for (int i = 0; i < 19; ++i) { const int pos = pos0n + rb * 16 - 2 + i; const int pc = pos < 0 ? 0 : (pos < Ln ? pos : Ln - 1); xr[i] = xb[(size_t)pc * NINP]; } } }
        LBAR();
        LAS bf16_t* gts = (LAS bf16_t*)(lds + 51200); LAS float* hfs = (LAS float*)(lds + 68608);
        float hsum[4][4];
#pragma unroll
        for (int d = 0; d < 2; ++d) {
            __builtin_amdgcn_sched_barrier(0);
            f32x4 acc[2][4];
#pragma unroll
            for (int rt = 0; rt < 4; ++rt) { bf16x8 afr[4];
#pragma unroll
                for (int ks = 0; ks < 4; ++ks) afr[ks] = *(const LAS bf16x8*)(xcA + (rt * 16 + (lane & 15)) * 136 + ks * 32 + q * 8);
#pragma unroll
                for (int kind = 0; kind < 2; ++kind) { f32x4 a = (f32x4){0.f, 0.f, 0.f, 0.f};
#pragma unroll
                    for (int ks = 0; ks < 4; ++ks) a = __builtin_amdgcn_mfma_f32_16x16x32_bf16(afr[ks], bfr[d * 2 + kind][ks], a, 0, 0, 0);
                    acc[kind][rt] = a; } }
            float a[4][4], bb[4][4];
#pragma unroll
            for (int rt = 0; rt < 4; ++rt)
#pragma unroll
                for (int j = 0; j < 4; ++j) { const int r = rt * 16 + q * 4 + j; const float rg = sigm(acc[0][rt][j] + ba[d]), ig = sigm(acc[1][rt][j] + bx[d]), la = -sp8[d] * rg;
                    const bool ok = r >= rmin; const float av = __expf(la), x2 = 2.0f * la; const float om = x2 > -0.25f ? -x2 * (1.0f + x2 * 0.5f * (1.0f + x2 * (1.0f / 3.0f) * (1.0f + x2 * 0.25f * (1.0f + x2 * 0.2f)))) : 1.0f - av * av;
                    a[rt][j] = ok ? av : 1.0f; bb[rt][j] = ok ? __builtin_amdgcn_sqrtf(om) * ig * xcf[r * 132 + chl] : 0.f; }
            float LA[4], LB[4];
#pragma unroll
            for (int rt = 0; rt < 4; ++rt) { float A = 1.f, B = 0.f;
#pragma unroll
                for (int jj = 0; jj < 4; ++jj) { const int j = d == 0 ? jj : 3 - jj; B = a[rt][j] * B + bb[rt][j]; A *= a[rt][j]; }
                LA[rt] = A; LB[rt] = B; }
            const size_t co = ((size_t)ci * 2 + d) * 1024 + gch;
            float h = (MODE == 1) ? cin[d] : 0.f, Atot = 1.f; float hin[4];
#pragma unroll
            for (int rr = 0; rr < 4; ++rr) { const int rt = d == 0 ? rr : 3 - rr;
#pragma unroll
                for (int qi = 0; qi < 4; ++qi) { const int qq = d == 0 ? qi : 3 - qi;
                    const float Aq = __shfl(LA[rt], (lane & 15) + 16 * qq), Bq = __shfl(LB[rt], (lane & 15) + 16 * qq);
                    if (qq == q) hin[rt] = h;
                    h = Aq * h + Bq; Atot *= Aq; } }
            if (MODE == 0) { if (q == 0) { ((float*)(p.ws + WS_LRUA))[co] = Atot; ((float*)(p.ws + WS_LRUH))[co] = h; } }
            else {
#pragma unroll
                for (int rt = 0; rt < 4; ++rt) { float hh = hin[rt];
#pragma unroll
                    for (int jj = 0; jj < 4; ++jj) { const int j = d == 0 ? jj : 3 - jj; hh = a[rt][j] * hh + bb[rt][j];
                        if (d == 0) hfs[(rt * 16 + q * 4 + j) * 132 + chl] = hh; else hsum[rt][j] = hh; } }
                if (d == 0) { *(LAS u32x4*)(gts + (tid >> 3) * 136 + (tid & 7) * 16) = gq[0]; *(LAS u32x4*)(gts + (tid >> 3) * 136 + (tid & 7) * 16 + 8) = gq[1]; } }
        }
        if (MODE == 1) { bf16_t* yall = (bf16_t*)(p.ws + WS_YALL);
            LBAR();
#pragma unroll
            for (int rt = 0; rt < 4; ++rt)
#pragma unroll
                for (int j = 0; j < 4; ++j) { const int r = rt * 16 + q * 4 + j; xcA[r * 136 + chl] = f2bf((hsum[rt][j] + hfs[r * 132 + chl]) * silu(bf2f(gts[r * 136 + chl]))); }
            LBAR();
            { const int r = tid >> 3; if (r >= rmin) { const u32x4 y0 = *(const LAS u32x4*)(xcA + r * 136 + (tid & 7) * 16), y1 = *(const LAS u32x4*)(xcA + r * 136 + (tid & 7) * 16 + 8);
                bf16_t* yp = yall + (size_t)(s0 + pos0 + r) * D + 1024 + nb * 128 + (tid & 7) * 16; *(u32x4*)yp = y0; *(u32x4*)(yp + 8) = y1; } } }
        LBAR();
    }
}


template <int WHICH>
__device__ __forceinline__ void skinny_tail(const int TID, const int b0, const Params& p, const int first) {
    const int lane = TID & 63, wid = TID >> 6, q = lane >> 4;
    if (wid >= 5) return;
    for (int b = b0; b < 256; b += (int)gridDim.x) {
    const int ct = b & 127, rt = (b >> 7) * 5 + wid;
    const int row = 24576 + rt * 16 + (lane & 15);
    const int colb = ct * 16 + (lane & 15);
    const bf16_t* cols = (const bf16_t*)(p.ws + WS_COLS);
    if (WHICH == 0) {
        const bf16_t* A = (const bf16_t*)(p.ws + WS_YALL) + (size_t)row * D + q * 8; const bf16_t* B = (const bf16_t*)(p.ws + WS_BTOUT) + (size_t)colb * D + q * 8;
        bf16_t* mbf = (bf16_t*)(p.ws + WS_H);
        f32x4 msum = (f32x4){0.f, 0.f, 0.f, 0.f};
        unsigned char gt[3][4];
#pragma unroll
        for (int br = 0; br < 3; ++br)
#pragma unroll
            for (int j = 0; j < 4; ++j) { const int cc = colb & 255; gt[br][j] = ((const unsigned char*)(cols + (size_t)(24576 + rt * 16 + q * 4 + j) * NINP + C_MG))[(br * 8 + (colb >> 8)) * 256 + ((((cc & 127) >> 5) * 4 + ((cc & 31) >> 3)) * 2 + (cc >> 7)) * 8 + (cc & 7)]; }
        float gs[3][4];
#pragma unroll
        for (int br = 0; br < 3; ++br)
#pragma unroll
            for (int j = 0; j < 4; ++j) { gs[br][j] = (float)gt[br][j] * (1.0f / 255.0f); asm volatile("" : "+v"(gs[br][j])); }
#pragma unroll
        for (int br = 0; br < 3; ++br) { const int koff = br * 512, nks = br == 2 ? 32 : 16; f32x4 acc = (f32x4){0.f, 0.f, 0.f, 0.f};
            for (int k0 = 0; k0 < nks; k0 += 8) { bf16x8 av[8], bv[8];
#pragma unroll
                for (int i = 0; i < 8; ++i) { av[i] = *(const bf16x8*)(A + koff + (k0 + i) * 32); bv[i] = *(const bf16x8*)(B + koff + (k0 + i) * 32); }
#pragma unroll
                for (int i = 0; i < 8; ++i) acc = __builtin_amdgcn_mfma_f32_16x16x32_bf16(av[i], bv[i], acc, 0, 0, 0); }
#pragma unroll
            for (int j = 0; j < 4; ++j) msum[j] += gs[br][j] * acc[j]; }
#pragma unroll
        for (int j = 0; j < 4; ++j) { const int tok = 24576 + rt * 16 + q * 4 + j; mbf[(size_t)tok * D + colb] = f2bf(msum[j]); }
    } else {
        const bf16_t* A = (const bf16_t*)(p.ws + WS_H) + (size_t)row * D + q * 8; const bf16_t* B = (const bf16_t*)(p.ws + WS_BTO) + (size_t)colb * D + q * 8;
        float* z = (float*)(p.ws + WS_Z);
        f32x4 acc = (f32x4){0.f, 0.f, 0.f, 0.f};
        for (int k0 = 0; k0 < 64; k0 += 8) { bf16x8 av[8], bv[8];
#pragma unroll
            for (int i = 0; i < 8; ++i) { av[i] = *(const bf16x8*)(A + (k0 + i) * 32); bv[i] = *(const bf16x8*)(B + (k0 + i) * 32); }
#pragma unroll
            for (int i = 0; i < 8; ++i) acc = __builtin_amdgcn_mfma_f32_16x16x32_bf16(av[i], bv[i], acc, 0, 0, 0); }
#pragma unroll
        for (int j = 0; j < 4; ++j) { const int tok = 24576 + rt * 16 + q * 4 + j; const float res = first ? src_row(p, tok)[colb] : z[(size_t)tok * D + colb]; z[(size_t)tok * D + colb] = res + acc[j]; }
    }
    }
}

#define XB_TMO      128
#define XB_XCNT(j)  (256  + 64 * (j))
#define XB_XSUB(j)  (1280 + 64 * (j))
#define XB_XGEN(j)  (2304 + 64 * (j))
#define XB_TOP      3328
#define XB_TOPGEN   3392
#define XCD_BAR_WORDS 3456
#define XB_SPIN_CAP (1u << 18)
__device__ __forceinline__ unsigned xb_ld(unsigned* p)              { return __hip_atomic_load(p, __ATOMIC_RELAXED, __HIP_MEMORY_SCOPE_AGENT); }
__device__ __forceinline__ unsigned xb_add(unsigned* p, unsigned v) { return __hip_atomic_fetch_add(p, v, __ATOMIC_RELAXED, __HIP_MEMORY_SCOPE_AGENT); }
__device__ __forceinline__ unsigned xb_xcc_id() { return (unsigned)__builtin_amdgcn_s_getreg((3 << 11) | 20) & 0xFu; }
#define XB_SPIN(cond, bar) do { unsigned _sp = 0; while (cond) { __builtin_amdgcn_s_sleep(1); \
    if ((++_sp & 255u) == 0u) { if (xb_ld(&(bar)[XB_TMO])) break; if (_sp > XB_SPIN_CAP) { atomicAdd(&(bar)[XB_TMO], 1u); break; } } } } while (0)
struct XcdBarrier { unsigned* bar; unsigned x; volatile LAS unsigned* st; };
__device__ __forceinline__ XcdBarrier xcd_barrier_post(unsigned* bar, volatile LAS unsigned* st) {
    XcdBarrier b; b.bar = bar; b.x = xb_xcc_id(); b.st = st;
    if (threadIdx.x == 0) (void)xb_add(&bar[XB_XCNT(b.x)], 1u);
    return b;
}
__device__ __forceinline__ void xcd_barrier_complete(unsigned* bar, unsigned x, unsigned& nloc, unsigned& nx) {
    const unsigned G = gridDim.x * gridDim.y * gridDim.z;
    unsigned sum, cnt, mine, sp = 0u;
    for (;;) {
        sum = 0u; cnt = 0u; mine = 0u;
#pragma unroll
        for (unsigned j = 0; j < 16; ++j) { const unsigned c = xb_ld(&bar[XB_XCNT(j)]); sum += c; cnt += (c > 0u) ? 1u : 0u; mine = (j == x) ? c : mine; }
        if (sum == G) break;
        __builtin_amdgcn_s_sleep(1);
        if ((++sp & 255u) == 0u) { if (xb_ld(&bar[XB_TMO])) break; if (sp > XB_SPIN_CAP) { atomicAdd(&bar[XB_TMO], 1u); break; } }
    }
    nloc = mine > 0u ? mine : 1u; nx = cnt > 0u ? cnt : 1u;
}
__device__ __forceinline__ void xcd_barrier(const XcdBarrier& b) {
    asm volatile("s_waitcnt vmcnt(0)" ::: "memory");
    __syncthreads();
    if (threadIdx.x == 0) {
        unsigned* bar = b.bar;
        __builtin_amdgcn_s_waitcnt(0);
        unsigned nloc = b.st[0], nx = b.st[1];
        if (nloc == 0u) { xcd_barrier_complete(bar, b.x, nloc, nx); b.st[0] = nloc; b.st[1] = nx; }
        const unsigned old = xb_add(&bar[XB_XSUB(b.x)], 1u);
        const unsigned gen = old / nloc;
        if (old + 1u == (gen + 1u) * nloc) {
            __builtin_amdgcn_fence(__ATOMIC_RELEASE, "agent");
            asm volatile("s_waitcnt vmcnt(0)" ::: "memory");
            const unsigned og = xb_add(&bar[XB_TOP], 1u);
            const unsigned tg = og / nx;
            if (og + 1u == (tg + 1u) * nx) xb_add(&bar[XB_TOPGEN], 1u);
            else XB_SPIN(xb_ld(&bar[XB_TOPGEN]) == tg, bar);
            __builtin_amdgcn_fence(__ATOMIC_ACQUIRE, "agent");
            xb_add(&bar[XB_XGEN(b.x)], 1u);
            asm volatile("s_waitcnt vmcnt(0)" ::: "memory");
        } else {
            XB_SPIN(xb_ld(&bar[XB_XGEN(b.x)]) == gen, bar);
            __builtin_amdgcn_fence(__ATOMIC_ACQUIRE, "agent");
            asm volatile("s_waitcnt vmcnt(0)" ::: "memory");
        }
    }
    __syncthreads();
}

__global__ void __launch_bounds__(512) fwd_megakernel(Params p_in) {
    extern __shared__ __attribute__((aligned(16))) unsigned char smem[];
    LAS unsigned char* lds = (LAS unsigned char*)smem;
    cg::grid_group grid = cg::this_grid();
    const int G = gridDim.x;
    const Params& p0 = p_in;
    volatile LAS unsigned* stw = (volatile LAS unsigned*)(lds + 150528);
    if (threadIdx.x == 0) { stw[0] = 0u; stw[1] = 0u; }
    __syncthreads();
    const XcdBarrier xb = xcd_barrier_post((unsigned*)(p_in.ws + WS_BAR), stw);
    for (int ph = p0.ph_lo; ph < p0.ph_hi; ++ph) {
        const int reps_ = (ph < 32 && (ph & 7) == DUP) ? 2 : 1;
        for (int rep_ = 0; rep_ < reps_; ++rep_) {
        int TID = threadIdx.x; asm volatile("" : "+v"(TID));
        int b = blockIdx.x; asm volatile("" : "+s"(b));
        Params p = p0; { unsigned long long t_ = (unsigned long long)p.ws; asm volatile("" : "+s"(t_)); p.ws = (unsigned char*)t_; }
        const char* ws = (const char*)p.ws;
        if (ph == 32) { final_norm_phase(TID, b, p); }
        else {
            const int l = ph >> 3, k = ph & 7;
            if (k == 0 && (PHM & 1)) { rmsnorm_phase(TID, b, p, l); convert_weights(TID, b, p, l, (LAS float*)lds); if (l == 0) s5_tables_all(TID, b, p); }
            else if (k == 1 && (PHM & 2)) {
                TileOrder S; S.nM = MP / 256; S.nN = NINP / 256; S.nwg = S.nM * S.nN; S.G = G; S.c = b; S.mult = 1; S.nt0 = D / 64; S.A = ws + WS_H; S.B = ws + WS_BTIN; S.tA = (size_t)256 * D * 2; S.tB = (size_t)256 * D * 2;
                EpiIn E; E.cols = (bf16_t*)(p.ws + WS_COLS); E.ubuf = (bf16_t*)(p.ws + WS_UBUF);
                gemm_phase(TID, lds, D, D, S, E);
                s5_assemble_a(TID, b, p, l);
            } else if (k == 2 && (PHM & 4)) {
                GroupOrder S; S.G = G; S.c = b; S.nt0 = 4; S.A = ws + WS_UBUF; S.B = ws + WS_PMAT; S.gsA = (size_t)CHP * 512 * 2; S.gsB = (size_t)256 * 256 * 2; S.tA = (size_t)256 * 512 * 2;
                EpiS5State E; E.st = (float*)(p.ws + WS_ST);
                if (SUBM & 4) gemm_phase(TID, lds, 512, 256, S, E);
                __syncthreads();
                { const int head_ = ((b + 128) % G) & 3, kk_ = TID & 63; float wg_[2][16], bg_[2];
                  _Pragma("unroll") for (int d = 0; d < 2; ++d) { bg_[d] = p.in[16][(l * 2 + d) * 256 + head_ * 64 + kk_]; _Pragma("unroll") for (int j = 0; j < 16; ++j) wg_[d][j] = p.in[15][((size_t)(l * 2 + d) * 16 + j) * 256 + head_ * 64 + kk_]; }
                  float ng_[16]; _Pragma("unroll") for (int e = 0; e < 16; ++e) ng_[e] = p.in[17][l * 512 + head_ * 128 + (TID & 7) * 16 + e];
                  for (int it = (b + 128) % G; it < NCK * 4; it += G) gla_item<0>(TID, p, l, it >> 2, it & 3, lds, wg_, bg_, ng_); }
                lru_phase<0>(TID, b, G, p, l, lds);
                s5_assemble_w(TID, b, p, l);
            } else if (k == 3 && (PHM & 8)) { scans_phase(TID, b, p, l, rep_ == 0); }
            else if (k == 4 && (PHM & 16)) {
                GroupOrder S; S.G = G; S.c = b; S.nt0 = 8; S.A = ws + WS_UBUF; S.B = ws + WS_WMAT; S.gsA = (size_t)CHP * 512 * 2; S.gsB = (size_t)256 * 512 * 2; S.tA = (size_t)256 * 512 * 2;
                EpiS5Out E; E.zs5 = (bf16_t*)(p.ws + WS_ZS5);
                if (SUBM & 4) gemm_phase(TID, lds, 512, 512, S, E);
                __syncthreads();
                { const int head_ = ((b + 128) % G) & 3, kk_ = TID & 63; float wg_[2][16], bg_[2];
                  _Pragma("unroll") for (int d = 0; d < 2; ++d) { bg_[d] = p.in[16][(l * 2 + d) * 256 + head_ * 64 + kk_]; _Pragma("unroll") for (int j = 0; j < 16; ++j) wg_[d][j] = p.in[15][((size_t)(l * 2 + d) * 16 + j) * 256 + head_ * 64 + kk_]; }
                  float ng_[16]; _Pragma("unroll") for (int e = 0; e < 16; ++e) ng_[e] = p.in[17][l * 512 + head_ * 128 + (TID & 7) * 16 + e];
                  for (int it = (b + 128) % G; it < NCK * 4; it += G) gla_item<1>(TID, p, l, it >> 2, it & 3, lds, wg_, bg_, ng_); }
                lru_phase<1>(TID, b, G, p, l, lds);
            } else if (k == 5 && (PHM & 32)) {
                TileOrder S; S.nM = MP / 256; S.nN = 2; S.nwg = S.nM * S.nN; S.G = G; S.c = b; S.mult = 1; S.nt0 = 8; S.A = ws + WS_ZS5; S.B = ws + WS_BTGLU; S.tA = (size_t)256 * 512 * 2; S.tB = (size_t)256 * 512 * 2;
                EpiGlu E; E.zs5 = (const bf16_t*)(p.ws + WS_ZS5); E.cols = (const bf16_t*)(p.ws + WS_COLS); E.bglu = p.in[14] + l * 512; E.yall = (bf16_t*)(p.ws + WS_YALL);
                gemm_phase(TID, lds, 512, 512, S, E);
            } else if (k == 6 && (PHM & 64)) {
                TileOrder S; S.nM = 96; S.nN = 8; S.nwg = S.nM * S.nN; S.G = G; S.c = b; S.mult = 3; S.nt0 = 8; S.A = ws + WS_YALL; S.B = ws + WS_BTOUT; S.tA = (size_t)256 * D * 2; S.tB = (size_t)256 * D * 2;
                EpiOut E; E.cols = (const bf16_t*)(p.ws + WS_COLS); E.mbf = (bf16_t*)(p.ws + WS_H);
                gemm_phase(TID, lds, D, D, S, E);
                skinny_tail<0>(TID, b, p, 0);
            } else if (PHM & 128) {
                TileOrder S; S.nM = 96; S.nN = 8; S.nwg = S.nM * S.nN; S.G = G; S.c = b; S.mult = 1; S.nt0 = D / 64; S.A = ws + WS_H; S.B = ws + WS_BTO; S.tA = (size_t)256 * D * 2; S.tB = (size_t)256 * D * 2;
                EpiWo E; E.z = (float*)(p.ws + WS_Z); E.pp = &p; E.first = (l == 0);
                gemm_phase(TID, lds, D, D, S, E);
                skinny_tail<1>(TID, b, p, l == 0);
            }
        }
        }
        if (p0.use_sync && ph + 1 < p0.ph_hi) { if (ph == p0.ph_lo) grid.sync(); else xcd_barrier(xb); }
    }
}

extern "C" void kernel_launch(void* const* d_in, const int* in_sizes, int n_in, void* d_out, int out_size, void* d_ws, size_t ws_size, hipStream_t stream) {
    static int grid = 0, coop = 1;
    if (grid == 0) {
        if (n_in != 30 || ws_size < WS_END2) { fprintf(stderr, "kernel_launch: unexpected n_in %d or ws_size %zu (< %zu)\n", n_in, ws_size, (size_t)WS_END); grid = -1; return; }
        int dev = 0, cus = 0, per_cu = 0;
        (void)hipGetDevice(&dev); (void)hipDeviceGetAttribute(&cus, hipDeviceAttributeMultiprocessorCount, dev);
        if (hipFuncSetAttribute((const void*)fwd_megakernel, hipFuncAttributeMaxDynamicSharedMemorySize, LDS_BYTES) != hipSuccess) { fprintf(stderr, "kernel_launch: hipFuncSetAttribute failed\n"); grid = -1; return; }
        if (hipOccupancyMaxActiveBlocksPerMultiprocessor(&per_cu, (const void*)fwd_megakernel, 512, LDS_BYTES) != hipSuccess || per_cu < 1) { fprintf(stderr, "kernel_launch: occupancy query gave %d\n", per_cu); per_cu = 1; }
        (void)hipGetLastError();
        grid = cus * 1;
    }
    if (grid < 0) return;
    Params p{};
    for (int i = 0; i < 30; ++i) p.in[i] = (const float*)d_in[i];
    p.out = (float*)d_out; p.ws = (unsigned char*)d_ws; p.pad = 0;
    (void)hipMemsetAsync((char*)d_ws + WS_BAR, 0, 3456 * 4, stream);
    if (coop) {
        p.ph_lo = 0; p.ph_hi = 33; p.use_sync = 1;
        void* args[] = {&p};
        hipError_t e = hipLaunchCooperativeKernel((const void*)fwd_megakernel, dim3(grid), dim3(512), args, LDS_BYTES, stream);
        if (e == hipSuccess) return;
        fprintf(stderr, "kernel_launch: cooperative launch failed: %s (grid %d); falling back to one launch per phase\n", hipGetErrorString(e), grid);
        (void)hipGetLastError(); coop = 0;
    }
    for (int ph = 0; ph < 33; ++ph) { p.ph_lo = ph; p.ph_hi = ph + 1; p.use_sync = 0; hipLaunchKernelGGL(fwd_megakernel, dim3(grid), dim3(512), LDS_BYTES, stream, p); }
}
```

```cpp
#include <hip/hip_runtime.h>
#include <hip/hip_cooperative_groups.h>
#include <cstdio>
namespace cg = cooperative_groups;
#define LAS __attribute__((address_space(3)))
typedef unsigned short bf16_t;
typedef short bf16x8 __attribute__((ext_vector_type(8)));
typedef float f32x4 __attribute__((ext_vector_type(4)));
typedef float f32x2 __attribute__((ext_vector_type(2)));
typedef unsigned u32x2 __attribute__((ext_vector_type(2)));
typedef unsigned u32x4 __attribute__((ext_vector_type(4)));

constexpr int D = 2048, NTOK = 24736, MP = 24832, NINP = 11008, NIN = 10784;
constexpr int NCH16 = 1546, CHP = 1792, NCK = 394;
constexpr int C_GA = 512, C_Q = 1024, C_K = 1280, C_V = 1536, C_GB = 2048, C_XC = 2560, C_GC = 3584, C_MG = 4608, C_GLR = 10752;
constexpr int LDS_BYTES = 150528 + 16;
#ifndef SYNCREP
#define SYNCREP 1
#endif
#ifndef DUP
#define DUP -1
#endif
#ifndef SUBM
#define SUBM 7
#endif
#ifndef PHM
#define PHM 255
#endif

constexpr size_t al256(size_t x) { return (x + 255) & ~(size_t)255; }
constexpr size_t WS_Z = 0;
constexpr size_t WS_H = WS_Z + al256((size_t)MP * D * 4);
constexpr size_t WS_COLS = WS_H + al256((size_t)MP * D * 2);
constexpr size_t WS_YALL = WS_COLS + al256((size_t)MP * NINP * 2);
constexpr size_t WS_ZS5 = WS_YALL + al256((size_t)MP * D * 2);
constexpr size_t WS_UBUF = WS_ZS5 + al256((size_t)MP * 512 * 2);
constexpr size_t WS_ST = WS_UBUF + al256((size_t)32 * CHP * 512 * 2);
constexpr size_t WS_DS = WS_ST + al256((size_t)32 * CHP * 256 * 4);
constexpr size_t WS_M32 = WS_UBUF;
constexpr size_t WS_DECAY = WS_DS + al256((size_t)NCK * 4 * 2 * 8192 * 4);
constexpr size_t WS_LRUA = WS_DECAY + al256((size_t)NCK * 4 * 2 * 64 * 4);
constexpr size_t WS_LRUH = WS_LRUA + al256((size_t)NCK * 2 * 1024 * 4);
constexpr size_t WS_LRUC = WS_LRUH + al256((size_t)NCK * 2 * 1024 * 4);
constexpr size_t WS_PW = WS_LRUC + al256((size_t)NCK * 2 * 1024 * 4);
constexpr size_t WS_BBAR = WS_PW + al256((size_t)4 * 32 * 2 * 17 * 64 * 8);
constexpr size_t WS_WMAT = WS_BBAR + al256((size_t)4 * 32 * 2 * 64 * 16 * 8);
constexpr size_t WS_PMAT = WS_WMAT + al256((size_t)32 * 256 * 512 * 2);
constexpr size_t WS_BTIN = WS_PMAT + al256((size_t)32 * 256 * 256 * 2);
constexpr size_t WS_BTOUT = WS_BTIN + al256((size_t)NINP * D * 2);
constexpr size_t WS_BTO = WS_BTOUT + al256((size_t)D * D * 2);
constexpr size_t WS_BTGLU = WS_BTO + al256((size_t)D * D * 2);
constexpr size_t WS_BTLRU = WS_BTGLU + al256((size_t)512 * 512 * 2);
constexpr size_t WS_KMAT = WS_BTLRU + al256((size_t)32 * 128 * 128 * 2);
constexpr size_t WS_BAR = WS_KMAT + al256((size_t)32 * 2 * 16 * 256 * 4);
constexpr size_t WS_END = WS_BAR + al256((size_t)3456 * 4);
constexpr size_t WS_GB = WS_END;
constexpr size_t WS_END2 = WS_GB + al256((size_t)NCK * 4 * 8192 * 4);
constexpr size_t WS_SPB = WS_END2;
constexpr size_t WS_END3 = WS_SPB + al256((size_t)NCK * 4 * 2 * 8192 * 2);
constexpr size_t PWL = (size_t)32 * 2 * 17 * 64, BBL = (size_t)32 * 2 * 64 * 16;
static_assert(WS_END3 <= (size_t)1413480448, "workspace too large");
static_assert((size_t)MP * D * 4 <= WS_DECAY - WS_UBUF, "m32 alias too small");

struct Params { const float* in[30]; float* out; unsigned char* ws; int ph_lo, ph_hi, use_sync, pad; };

#define LBAR() do { asm volatile("s_waitcnt lgkmcnt(0)" ::: "memory"); __builtin_amdgcn_s_barrier(); asm volatile("" ::: "memory"); } while (0)
__device__ __forceinline__ unsigned cvt_pk_bf16(float lo, float hi) { unsigned r; asm volatile("v_cvt_pk_bf16_f32 %0, %1, %2" : "=v"(r) : "v"(lo), "v"(hi)); return r; }
__device__ __forceinline__ bf16_t f2bf(float f) { return (bf16_t)(cvt_pk_bf16(f, 0.f) & 0xffffu); }
__device__ __forceinline__ float bf2f(bf16_t b) { return __uint_as_float(((unsigned)b) << 16); }
__device__ __forceinline__ float bflo(unsigned w) { return __uint_as_float(w << 16); }
__device__ __forceinline__ float bfhi(unsigned w) { return __uint_as_float(w & 0xffff0000u); }
__device__ __forceinline__ float sigm(float x) { return __builtin_amdgcn_rcpf(1.0f + __expf(-x)); }
__device__ __forceinline__ float silu(float x) { return x * sigm(x); }
__device__ __forceinline__ float gelu_t(float x) { const float u = 0.7978845608028654f * (x + 0.044715f * x * x * x); return x * sigm(2.0f * u); }
__device__ __forceinline__ float logsig(float x) { return -(fmaxf(-x, 0.f) + __logf(1.0f + __expf(-fabsf(x)))); }

__device__ __forceinline__ int seq_start(int s) { return s < 2 ? s * 4112 : 8224 + (s - 2) * 2064; }
__device__ __forceinline__ int seq_len(int s) { return s < 2 ? 4112 : 2064; }
__device__ __forceinline__ void chunk_info(int ci, int& seq, int& c) { if (ci < 130) { seq = ci / 65; c = ci - seq * 65; } else { const int t = ci - 130; const int q = t / 33; seq = 2 + q; c = t - q * 33; } }

constexpr int BM = 256, BK = 64, HALF = 128, HTB = HALF * BK * 2, STAGE_BYTES = 8 * HTB, NXCD = 8, WGM = 8;
__device__ __forceinline__ int lds_byte(int r, int c) { const int st = (r >> 4) * 2 + (c >> 5), rr = r & 15, cc = c & 31, ob = rr * 64 + cc * 2; return st * 1024 + (ob ^ (((ob >> 9) & 1) << 5)); }
__device__ __forceinline__ void stage_rc(int b, int& R, int& C) { const int st = b / 1024, sb = b % 1024, swz = sb ^ (((sb >> 9) & 1) << 5); R = (st >> 1) * 16 + swz / 64; C = (st & 1) * 32 + (swz % 64) / 2; }

struct Unit { int pm, pn, sub, nt; const char* a; const char* b; };

struct TileOrder {
    int nM, nN, nwg, G, c, mult, nt0; const char* A; const char* B; size_t tA, tB;
    __device__ __forceinline__ bool next(int i, Unit& u) const {
        const int ti = i / mult, sub = i - ti * mult;
        const long L = (long)ti * G + c; if (L >= nwg) return false;
        int wgid = (int)L; { const int q = nwg / NXCD, r = nwg % NXCD, xcd = wgid % NXCD, off = wgid / NXCD; wgid = (xcd < r ? xcd * (q + 1) : r * (q + 1) + (xcd - r) * q) + off; }
        const int nig = WGM * nN, gid = wgid / nig, fm = gid * WGM, gsz = (nM - fm) < WGM ? (nM - fm) : WGM;
        u.pm = fm + ((wgid % nig) % gsz); u.pn = (wgid % nig) / gsz; u.sub = sub;
        const int koff = (mult == 3) ? sub * 512 : 0; u.nt = (mult == 3) ? (sub == 2 ? 16 : 8) : nt0;
        u.a = A + (size_t)u.pm * tA + (size_t)koff * 2; u.b = B + (size_t)u.pn * tB + (size_t)koff * 2; return true;
    }
};
struct GroupOrder {
    int G, c, nt0; const char* A; const char* B; size_t gsA, gsB, tA;
    __device__ __forceinline__ bool next(int i, Unit& u) const {
        const int L = i * G + c; if (L >= 224) return false;
        const int g = L / 7, pm = L - g * 7; u.pm = pm; u.pn = 0; u.sub = g; u.nt = nt0;
        u.a = A + (size_t)g * gsA + (size_t)pm * tA; u.b = B + (size_t)g * gsB; return true;
    }
};

__device__ __forceinline__ int perm32(int rho) { const int n = rho >> 4, i = rho & 15; return 8 * (i >> 2) + 4 * n + (i & 3); }
template <class Epi, class Sched>
__device__ __forceinline__ void gemm_phase(const int TID, LAS unsigned char* lds, const int lda, const int ldb, const Sched& S, const Epi& E) {
    const int tid = TID, wid = __builtin_amdgcn_readfirstlane(tid >> 6), lane = tid & 63, wr = wid >> 2, wc = wid & 3, fr = lane & 15, fq = lane >> 4;
    unsigned voffA[2], voffB[2];
#pragma unroll
    for (int i = 0; i < 2; ++i) { int R, C; stage_rc(tid * 16 + i * 8192, R, C); const int Rb = Epi::PERM ? ((R & ~31) + perm32(R & 31)) : R; voffA[i] = (unsigned)(R * lda + C) * 2u; voffB[i] = (unsigned)(Rb * ldb + C) * 2u; }
    const size_t kstep = (size_t)(BK * 2);
    const size_t hA = (size_t)HALF * lda * 2, hB = (size_t)HALF * ldb * 2;
    const unsigned ldsw = (unsigned)wid * 1024u;
    const int aoff = lds_byte(wr * 64 + fr, fq * 8), boff = lds_byte(wc * 32 + fr, fq * 8);
#define PG8_SA(b, h) (((b) * 2 + (h)) * HTB)
#define PG8_SB(b, h) ((4 + (b) * 2 + (h)) * HTB)
#define PG8_STAGE(bufoff, gbase, voff) do { _Pragma("unroll") for (int _i = 0; _i < 2; ++_i) \
        __builtin_amdgcn_global_load_lds((const unsigned*)((const char*)(gbase) + (voff)[_i]), (LAS unsigned*)(lds + (bufoff) + ldsw + _i * 8192), 16, 0, 0); } while (0)
#define PG8_LDA(dst, b, h) do { _Pragma("unroll") for (int m = 0; m < 4; ++m) _Pragma("unroll") for (int k = 0; k < 2; ++k) dst[m][k] = *(const LAS bf16x8*)(lds + PG8_SA(b, h) + aoff + m * 2048 + k * 1024); } while (0)
#define PG8_LDB(dst, b, h) do { _Pragma("unroll") for (int n = 0; n < 2; ++n) _Pragma("unroll") for (int k = 0; k < 2; ++k) dst[n][k] = *(const LAS bf16x8*)(lds + PG8_SB(b, h) + boff + n * 2048 + k * 1024); } while (0)
#define PG8_MMA(ai, bj, At, Bt) do { __builtin_amdgcn_s_setprio(1); _Pragma("unroll") for (int m = 0; m < 4; ++m) _Pragma("unroll") for (int n = 0; n < 2; ++n) _Pragma("unroll") for (int k = 0; k < 2; ++k) \
        acc[ai][bj][m][n] = __builtin_amdgcn_mfma_f32_16x16x32_bf16(Bt[n][k], At[m][k], acc[ai][bj][m][n], 0, 0, 0); __builtin_amdgcn_s_setprio(0); } while (0)
#define PG8_WAIT_V(n) asm volatile("s_waitcnt vmcnt(" #n ")" ::: "memory")
#define PG8_WAIT_L(n) asm volatile("s_waitcnt lgkmcnt(" #n ")" ::: "memory")
#define PG8_BAR __builtin_amdgcn_s_barrier()
#define PG8_SCHED __builtin_amdgcn_sched_barrier(0)
    Unit cur, nxt; int ui = 0;
    if (!S.next(0, cur)) return;
    f32x4 acc[2][2][4][2];
#pragma unroll
    for (int a = 0; a < 2; ++a)
#pragma unroll
        for (int b = 0; b < 2; ++b)
#pragma unroll
            for (int m = 0; m < 4; ++m)
#pragma unroll
                for (int n = 0; n < 2; ++n) acc[a][b][m][n] = (f32x4){0.f, 0.f, 0.f, 0.f};
    bf16x8 At[4][2], B0[2][2], B1[2][2];
    const char* cA = cur.a; const char* cB = cur.b;
    PG8_STAGE(PG8_SB(0, 0), cB, voffB); PG8_STAGE(PG8_SA(0, 0), cA, voffA); PG8_STAGE(PG8_SB(0, 1), cB + hB, voffB); PG8_STAGE(PG8_SA(0, 1), cA + hA, voffA);
    if (wr == 1) PG8_BAR;
    PG8_WAIT_V(4); PG8_BAR;
    PG8_STAGE(PG8_SB(1, 0), cB + kstep, voffB); PG8_STAGE(PG8_SA(1, 0), cA + kstep, voffA); PG8_STAGE(PG8_SB(1, 1), cB + hB + kstep, voffB);
    PG8_WAIT_V(6); PG8_BAR;
    for (;;) {
        const bool has_next = S.next(ui + 1, nxt);
        const char* nA = has_next ? nxt.a : cA; const char* nB = has_next ? nxt.b : cB;
        const int nt = cur.nt;
        for (int t = 0; t < nt; t += 2) {
            const bool last = (t == nt - 2);
            const char* a1 = cA + (size_t)(t + 1) * kstep;
            const char* a2 = last ? nA : cA + (size_t)(t + 2) * kstep; const char* b2 = last ? nB : cB + (size_t)(t + 2) * kstep;
            const char* a3 = a2 + kstep; const char* b3 = b2 + kstep;
            PG8_LDB(B0, 0, 0); PG8_SCHED; PG8_LDA(At, 0, 0); PG8_STAGE(PG8_SA(1, 1), a1 + hA, voffA);
            PG8_WAIT_L(8); PG8_BAR; PG8_WAIT_L(0); PG8_MMA(0, 0, At, B0); PG8_BAR; PG8_SCHED;
            PG8_LDB(B1, 0, 1); PG8_STAGE(PG8_SB(0, 0), b2, voffB);
            PG8_BAR; PG8_WAIT_L(0); PG8_MMA(0, 1, At, B1); PG8_BAR;
            PG8_LDA(At, 0, 1); PG8_STAGE(PG8_SA(0, 0), a2, voffA);
            PG8_BAR; PG8_WAIT_L(0); PG8_MMA(1, 0, At, B0); PG8_BAR; PG8_SCHED;
            PG8_STAGE(PG8_SB(0, 1), b2 + hB, voffB);
            PG8_WAIT_V(6); PG8_BAR; PG8_MMA(1, 1, At, B1); PG8_BAR;
            PG8_LDB(B0, 1, 0); PG8_SCHED; PG8_LDA(At, 1, 0); PG8_STAGE(PG8_SA(0, 1), a2 + hA, voffA);
            PG8_WAIT_L(8); PG8_BAR; PG8_WAIT_L(0); PG8_MMA(0, 0, At, B0); PG8_BAR; PG8_SCHED;
            PG8_LDB(B1, 1, 1); PG8_STAGE(PG8_SB(1, 0), b3, voffB);
            PG8_BAR; PG8_WAIT_L(0); PG8_MMA(0, 1, At, B1); PG8_BAR;
            PG8_LDA(At, 1, 1); PG8_STAGE(PG8_SA(1, 0), a3, voffA);
            PG8_BAR; PG8_WAIT_L(0); PG8_MMA(1, 0, At, B0); PG8_BAR; PG8_SCHED;
            PG8_STAGE(PG8_SB(1, 1), b3 + hB, voffB);
            PG8_WAIT_V(6); PG8_BAR; PG8_MMA(1, 1, At, B1); PG8_BAR;
        }
        E(acc, cur, wr, wc, fr, fq);
        if (!has_next) break;
#pragma unroll
        for (int a = 0; a < 2; ++a)
#pragma unroll
            for (int b = 0; b < 2; ++b)
#pragma unroll
                for (int m = 0; m < 4; ++m)
#pragma unroll
                    for (int n = 0; n < 2; ++n) acc[a][b][m][n] = (f32x4){0.f, 0.f, 0.f, 0.f};
        cur = nxt; cA = nA; cB = nB; ++ui;
    }
    PG8_WAIT_V(0);
    if (wr == 0) PG8_BAR;
    PG8_BAR;
#undef PG8_SA
#undef PG8_SB
#undef PG8_STAGE
#undef PG8_LDA
#undef PG8_LDB
#undef PG8_MMA
#undef PG8_WAIT_V
#undef PG8_WAIT_L
#undef PG8_BAR
#undef PG8_SCHED
}

#define EPI_LOOP(...) \
    const int row0 = u.pm * BM + wr * 64 + fr, col0 = u.pn * BM + wc * 32 + 4 * fq; \
    _Pragma("unroll") for (int ai = 0; ai < 2; ++ai) _Pragma("unroll") for (int m = 0; m < 4; ++m) { const int r = row0 + ai * HALF + m * 16; \
        _Pragma("unroll") for (int bj = 0; bj < 2; ++bj) _Pragma("unroll") for (int n = 0; n < 2; ++n) { const int c = col0 + bj * HALF + n * 16; const f32x4 v = acc[ai][bj][m][n]; __VA_ARGS__ } }

#define EPI_PROWS(...) \
    const int row0 = u.pm * BM + wr * 64 + fr, col0 = u.pn * BM + wc * 32 + 8 * fq; \
    _Pragma("unroll") for (int ai = 0; ai < 2; ++ai) _Pragma("unroll") for (int m = 0; m < 4; ++m) { const int r = row0 + ai * HALF + m * 16; __VA_ARGS__ }
__device__ __forceinline__ u32x4 pack8(const f32x4 a, const f32x4 b) { u32x4 w; w[0] = cvt_pk_bf16(a[0], a[1]); w[1] = cvt_pk_bf16(a[2], a[3]); w[2] = cvt_pk_bf16(b[0], b[1]); w[3] = cvt_pk_bf16(b[2], b[3]); return w; }
__device__ __forceinline__ unsigned q8(float x) { return (unsigned)__float2uint_rn(sigm(x) * 255.0f); }
__device__ __forceinline__ unsigned q8x4(const f32x4 v) { return q8(v[0]) | (q8(v[1]) << 8) | (q8(v[2]) << 16) | (q8(v[3]) << 24); }
struct EpiIn { static constexpr bool PERM = true; bf16_t* cols; bf16_t* ubuf;
    __device__ __forceinline__ void operator()(const f32x4 (&acc)[2][2][4][2], const Unit& u, int wr, int wc, int fr, int fq) const {
        if (u.pn >= 18 && u.pn < 42) {
            EPI_PROWS({ u32x4 w; w[0] = q8x4(acc[ai][0][m][0]); w[1] = q8x4(acc[ai][0][m][1]); w[2] = q8x4(acc[ai][1][m][0]); w[3] = q8x4(acc[ai][1][m][1]);
                *(u32x4*)((unsigned char*)(cols + (size_t)r * NINP + C_MG) + (u.pn - 18) * 256 + (wc * 4 + fq) * 16) = w; })
        } else {
            EPI_PROWS({ _Pragma("unroll") for (int bj = 0; bj < 2; ++bj) { const int c = col0 + bj * HALF;
                bf16_t* dst = (u.pn < 2) ? ubuf + ((size_t)((c >> 4) * CHP + (r >> 4)) * 512 + (r & 15) * 16 + (c & 15)) : cols + (size_t)r * NINP + c;
                *(u32x4*)dst = pack8(acc[ai][bj][m][0], acc[ai][bj][m][1]); } })
        }
    } };
struct EpiS5State { static constexpr bool PERM = false; float* st;
    __device__ __forceinline__ void operator()(const f32x4 (&acc)[2][2][4][2], const Unit& u, int wr, int wc, int fr, int fq) const {
        EPI_LOOP({ u32x2 w; w.x = cvt_pk_bf16(v[0], v[1]); w.y = cvt_pk_bf16(v[2], v[3]); *(u32x2*)((bf16_t*)st + ((size_t)(u.sub * CHP + r)) * 256 + c) = w; })
    } };
struct EpiS5Out { static constexpr bool PERM = true; bf16_t* zs5;
    __device__ __forceinline__ void operator()(const f32x4 (&acc)[2][2][4][2], const Unit& u, int wr, int wc, int fr, int fq) const {
        EPI_PROWS({ if (r < NCH16) { _Pragma("unroll") for (int bj = 0; bj < 2; ++bj) { const int c = col0 + bj * HALF; f32x4 a = acc[ai][bj][m][0], b2 = acc[ai][bj][m][1];
            _Pragma("unroll") for (int e = 0; e < 4; ++e) { a[e] = gelu_t(a[e]); b2[e] = gelu_t(b2[e]); }
            *(u32x4*)(zs5 + (size_t)(r * 16 + (c >> 4)) * 512 + u.sub * 16 + (c & 15)) = pack8(a, b2); } } })
    } };
#define EPI_ROWS(...) \
    const int row0 = u.pm * BM + wr * 64 + fr, col0 = u.pn * BM + wc * 32 + 4 * fq; \
    _Pragma("unroll") for (int ai = 0; ai < 2; ++ai) _Pragma("unroll") for (int m = 0; m < 4; ++m) { const int r = row0 + ai * HALF + m * 16; __VA_ARGS__ }
#define QOFF(q) (((q) >> 1) * HALF + ((q) & 1) * 16)
#define EPI_PIPE(LOADF, COMPF) \
    const int row0 = u.pm * BM + wr * 64 + fr, col0 = u.pn * BM + wc * 32 + 8 * fq; \
    LOADF(0, 0); \
    _Pragma("unroll") for (int gi = 0; gi < 8; ++gi) { if (gi + 1 < 8) { if ((gi & 1) == 0) { LOADF(gi + 1, 1); } else { LOADF(gi + 1, 0); } } if ((gi & 1) == 0) { COMPF(gi, 0); } else { COMPF(gi, 1); } }
#define GROW(gi) (row0 + ((gi) >> 2) * HALF + ((gi) & 3) * 16)
struct EpiGlu { static constexpr bool PERM = true; const bf16_t* zs5; const bf16_t* cols; const float* bglu; bf16_t* yall;
    __device__ __forceinline__ void operator()(const f32x4 (&acc)[2][2][4][2], const Unit& u, int wr, int wc, int fr, int fq) const {
        u32x4 zz[2][2], gg[2][2]; f32x4 bb[2][2];
        { const int c0 = u.pn * BM + wc * 32 + 8 * fq; _Pragma("unroll") for (int bj = 0; bj < 2; ++bj) { bb[bj][0] = *(const f32x4*)(bglu + c0 + bj * HALF); bb[bj][1] = *(const f32x4*)(bglu + c0 + bj * HALF + 4); } }
#define GLU_LOAD(gi, bf) do { const int r_ = GROW(gi); _Pragma("unroll") for (int bj = 0; bj < 2; ++bj) { const int c = col0 + bj * HALF; zz[bf][bj] = *(const u32x4*)(zs5 + (size_t)r_ * 512 + c); gg[bf][bj] = *(const u32x4*)(cols + (size_t)r_ * NINP + C_GA + c); } } while (0)
#define GLU_COMP(gi, bf) do { const int r_ = GROW(gi); _Pragma("unroll") for (int bj = 0; bj < 2; ++bj) { const int c = col0 + bj * HALF; f32x4 o[2]; \
            _Pragma("unroll") for (int hf = 0; hf < 2; ++hf) { const f32x4 v = acc[(gi) >> 2][bj][(gi) & 3][hf]; \
                o[hf][0] = bflo(zz[bf][bj][2 * hf]) * sigm(v[0] + bb[bj][hf][0]) * silu(bflo(gg[bf][bj][2 * hf])); o[hf][1] = bfhi(zz[bf][bj][2 * hf]) * sigm(v[1] + bb[bj][hf][1]) * silu(bfhi(gg[bf][bj][2 * hf])); \
                o[hf][2] = bflo(zz[bf][bj][2 * hf + 1]) * sigm(v[2] + bb[bj][hf][2]) * silu(bflo(gg[bf][bj][2 * hf + 1])); o[hf][3] = bfhi(zz[bf][bj][2 * hf + 1]) * sigm(v[3] + bb[bj][hf][3]) * silu(bfhi(gg[bf][bj][2 * hf + 1])); } \
            *(u32x4*)(yall + (size_t)r_ * D + c) = pack8(o[0], o[1]); } } while (0)
        EPI_PIPE(GLU_LOAD, GLU_COMP)
#undef GLU_LOAD
#undef GLU_COMP
    } };
__device__ __forceinline__ float ub(unsigned w, int k) { return (float)((w >> (8 * k)) & 255u) * (1.0f / 255.0f); }
struct EpiOut { static constexpr bool PERM = true; const bf16_t* cols; bf16_t* mbf;
    __device__ __forceinline__ void operator()(const f32x4 (&acc)[2][2][4][2], const Unit& u, int wr, int wc, int fr, int fq) const {
        u32x4 gg[8], mm[2][2];
        { const int row0g = u.pm * BM + wr * 64 + fr;
#pragma unroll
          for (int gi = 0; gi < 8; ++gi) gg[gi] = *(const u32x4*)((const unsigned char*)(cols + (size_t)(row0g + (gi >> 2) * HALF + (gi & 3) * 16) * NINP + C_MG) + (u.sub * 8 + u.pn) * 256 + (wc * 4 + fq) * 16); }
#define OUT_LOAD(gi, bf) do { const int r_ = GROW(gi); const bf16_t* mp = mbf + (size_t)r_ * D + col0; \
            _Pragma("unroll") for (int bj = 0; bj < 2; ++bj) { mm[bf][bj] = (u32x4){0u, 0u, 0u, 0u}; if (u.sub != 0) mm[bf][bj] = *(const u32x4*)(mp + bj * HALF); } } while (0)
#define OUT_COMP(gi, bf) do { const int r_ = GROW(gi); bf16_t* mp = mbf + (size_t)r_ * D + col0; _Pragma("unroll") for (int bj = 0; bj < 2; ++bj) { f32x4 o[2]; \
            _Pragma("unroll") for (int hf = 0; hf < 2; ++hf) { const f32x4 v = acc[(gi) >> 2][bj][(gi) & 3][hf]; const unsigned gw = gg[gi][bj * 2 + hf]; \
                o[hf][0] = bflo(mm[bf][bj][2 * hf]) + ub(gw, 0) * v[0]; o[hf][1] = bfhi(mm[bf][bj][2 * hf]) + ub(gw, 1) * v[1]; \
                o[hf][2] = bflo(mm[bf][bj][2 * hf + 1]) + ub(gw, 2) * v[2]; o[hf][3] = bfhi(mm[bf][bj][2 * hf + 1]) + ub(gw, 3) * v[3]; } \
            *(u32x4*)(mp + bj * HALF) = pack8(o[0], o[1]); } } while (0)
        EPI_PIPE(OUT_LOAD, OUT_COMP)
#undef OUT_LOAD
#undef OUT_COMP
    } };
__device__ __forceinline__ const float* src_row(const Params& p, int r);
struct EpiWo { static constexpr bool PERM = false; float* z; const Params* pp; int first;
    __device__ __forceinline__ void operator()(const f32x4 (&acc)[2][2][4][2], const Unit& u, int wr, int wc, int fr, int fq) const {
        EPI_ROWS({ if (r < NTOK) { float* zp = z + (size_t)r * D + col0; const float* rp = first ? src_row(*pp, r) + col0 : zp; f32x4 pv[4];
            _Pragma("unroll") for (int q = 0; q < 4; ++q) pv[q] = *(const f32x4*)(rp + QOFF(q));
            _Pragma("unroll") for (int q = 0; q < 4; ++q) *(f32x4*)(zp + QOFF(q)) = pv[q] + acc[ai][q >> 1][m][q & 1]; } })
    } };

__device__ __forceinline__ const float* src_row(const Params& p, int r) {
    int s, pos; if (r < 8224) { s = r / 4112; pos = r - s * 4112; } else { const int t = r - 8224; const int q = t / 2064; s = 2 + q; pos = t - q * 2064; }
    if (pos < 16) return p.in[2] + (size_t)pos * D;
    return s < 2 ? p.in[0] + ((size_t)s * 4096 + (pos - 16)) * D : p.in[1] + ((size_t)(s - 2) * 2048 + (pos - 16)) * D;
}
__device__ __forceinline__ void rmsnorm_phase(const int TID, const int BID, const Params& p, int l) {
    float* z = (float*)(p.ws + WS_Z); bf16_t* h = (bf16_t*)(p.ws + WS_H); const float* g = p.in[3] + (size_t)l * D;
    const int lane = TID & 63, gw = BID * 8 + (TID >> 6), nw = gridDim.x * 8;
    f32x4 gg[8];
#pragma unroll
    for (int i = 0; i < 8; ++i) gg[i] = *(const f32x4*)(g + (i * 64 + lane) * 4);
    f32x4 xn[8];
    { const int r0 = gw < NTOK ? gw : NTOK - 1; const float* src = (l == 0) ? src_row(p, r0) : z + (size_t)r0 * D;
#pragma unroll
      for (int i = 0; i < 8; ++i) xn[i] = *(const f32x4*)(src + (i * 64 + lane) * 4); }
    for (int r = gw; r < MP; r += nw) {
        bf16_t* hr = h + (size_t)r * D;
        f32x4 x[8];
#pragma unroll
        for (int i = 0; i < 8; ++i) x[i] = xn[i];
        { const int rn = (r + nw < NTOK) ? r + nw : NTOK - 1; const float* src = (l == 0) ? src_row(p, rn) : z + (size_t)rn * D;
#pragma unroll
          for (int i = 0; i < 8; ++i) xn[i] = *(const f32x4*)(src + (i * 64 + lane) * 4); }
        if (r >= NTOK) { for (int i = 0; i < 4; ++i) *(u32x4*)(hr + (i * 64 + lane) * 8) = (u32x4){0u, 0u, 0u, 0u}; continue; }
        float ss = 0.f;
#pragma unroll
        for (int i = 0; i < 8; ++i) ss += x[i][0] * x[i][0] + x[i][1] * x[i][1] + x[i][2] * x[i][2] + x[i][3] * x[i][3];
#pragma unroll
        for (int o = 32; o >= 1; o >>= 1) ss += __shfl_xor(ss, o);
        const float rs = rsqrtf(ss * (1.0f / D) + 1e-6f);
#pragma unroll
        for (int i = 0; i < 8; ++i) { const int c = (i * 64 + lane) * 4;
            u32x2 w; w.x = cvt_pk_bf16(x[i][0] * rs * gg[i][0], x[i][1] * rs * gg[i][1]); w.y = cvt_pk_bf16(x[i][2] * rs * gg[i][2], x[i][3] * rs * gg[i][3]); *(u32x2*)(hr + c) = w; }
    }
}
__device__ __forceinline__ void final_norm_phase(const int TID, const int BID, const Params& p) {
    const float* z = (const float*)(p.ws + WS_Z); const float* g = p.in[29];
    const int lane = TID & 63, gw = BID * 8 + (TID >> 6), nw = gridDim.x * 8;
    f32x4 gg[8];
#pragma unroll
    for (int i = 0; i < 8; ++i) gg[i] = *(const f32x4*)(g + (i * 64 + lane) * 4);
    f32x4 xn[8];
    { const int r0 = gw < NTOK ? gw : NTOK - 1;
#pragma unroll
      for (int i = 0; i < 8; ++i) xn[i] = *(const f32x4*)(z + (size_t)r0 * D + (i * 64 + lane) * 4); }
    for (int r = gw; r < NTOK; r += nw) {
        f32x4 x[8];
#pragma unroll
        for (int i = 0; i < 8; ++i) x[i] = xn[i];
        { const int rn = (r + nw < NTOK) ? r + nw : NTOK - 1;
#pragma unroll
          for (int i = 0; i < 8; ++i) xn[i] = *(const f32x4*)(z + (size_t)rn * D + (i * 64 + lane) * 4); }
        int s, pos; if (r < 8224) { s = r / 4112; pos = r - s * 4112; } else { const int t = r - 8224; const int q = t / 2064; s = 2 + q; pos = t - q * 2064; }
        if (pos < 16) continue;
        float* dst = s < 2 ? p.out + ((size_t)s * 4096 + (pos - 16)) * D : p.out + (size_t)2 * 4096 * D + ((size_t)(s - 2) * 2048 + (pos - 16)) * D;
        float ss = 0.f;
#pragma unroll
        for (int i = 0; i < 8; ++i) ss += x[i][0] * x[i][0] + x[i][1] * x[i][1] + x[i][2] * x[i][2] + x[i][3] * x[i][3];
#pragma unroll
        for (int o = 32; o >= 1; o >>= 1) ss += __shfl_xor(ss, o);
        const float rs = rsqrtf(ss * (1.0f / D) + 1e-6f);
#pragma unroll
        for (int i = 0; i < 8; ++i) { const int c = (i * 64 + lane) * 4; f32x4 o; o[0] = x[i][0] * rs * gg[i][0]; o[1] = x[i][1] * rs * gg[i][1]; o[2] = x[i][2] * rs * gg[i][2]; o[3] = x[i][3] * rs * gg[i][3]; __builtin_nontemporal_store(o, (f32x4*)(dst + c)); }
    }
}
__device__ __forceinline__ void conv_tile(const int TID, const float* src, int ldn, int k0, int n0, int nvalid, bf16_t* dst, int ldd, int kofs, bool mapin, LAS float* tile) {
    const int tx = TID & 63, ty = TID >> 6;
    const int ncl = (n0 + tx < nvalid) ? n0 + tx : nvalid - 1;
#pragma unroll
    for (int i = 0; i < 8; ++i) { const int k = ty + 8 * i; tile[k * 65 + tx] = src[(size_t)(k0 + k) * ldn + ncl]; }
    __syncthreads();
#pragma unroll
    for (int i = 0; i < 8; ++i) { const int nn = ty + 8 * i; int n = n0 + nn;
        if (n < nvalid) { if (mapin) n = (n < 2560) ? n : (n < 2592 ? n + (C_GLR - 2560) : n - 32); dst[(size_t)n * ldd + kofs + k0 + tx] = f2bf(tile[tx * 65 + nn]); } }
    __syncthreads();
}
__device__ __forceinline__ void convert_weights(const int TID, const int BID, const Params& p, int l, LAS float* tile) {
    const int G = gridDim.x, b = BID;
    bf16_t* btin = (bf16_t*)(p.ws + WS_BTIN); bf16_t* btout = (bf16_t*)(p.ws + WS_BTOUT); bf16_t* bto = (bf16_t*)(p.ws + WS_BTO); bf16_t* btglu = (bf16_t*)(p.ws + WS_BTGLU); bf16_t* btlru = (bf16_t*)(p.ws + WS_BTLRU);
    { const float* src = p.in[4] + (size_t)l * D * NIN; const int tx = TID & 63, ty = TID >> 6; float v[8];
      { const int t = b < 32 * 169 ? b : 0; const int kt = t / 169, ntl = t - kt * 169; const int ncl = (ntl * 64 + tx < NIN) ? ntl * 64 + tx : NIN - 1;
#pragma unroll
        for (int i = 0; i < 8; ++i) v[i] = src[(size_t)(kt * 64 + ty + 8 * i) * NIN + ncl]; }
      for (int t = b; t < 32 * 169; t += G) { const int kt = t / 169, ntl = t - kt * 169, k0 = kt * 64, n0 = ntl * 64;
#pragma unroll
          for (int i = 0; i < 8; ++i) tile[(ty + 8 * i) * 65 + tx] = v[i];
          { const int tn = (t + G < 32 * 169) ? t + G : t; const int ktn = tn / 169, ntn = tn - ktn * 169; const int ncl = (ntn * 64 + tx < NIN) ? ntn * 64 + tx : NIN - 1;
#pragma unroll
            for (int i = 0; i < 8; ++i) v[i] = src[(size_t)(ktn * 64 + ty + 8 * i) * NIN + ncl]; }
          LBAR();
#pragma unroll
          for (int i = 0; i < 8; ++i) { const int nn = ty + 8 * i; int n = n0 + nn;
              if (n < NIN) { n = (n < 2560) ? n : (n < 2592 ? n + (C_GLR - 2560) : n - 32); btin[(size_t)n * D + k0 + tx] = f2bf(tile[tx * 65 + nn]); } }
          LBAR(); } }
    for (size_t i = (size_t)b * 512 + TID; i < (size_t)(NINP - NIN) * D / 8; i += (size_t)G * 512) *(u32x4*)(btin + (size_t)NIN * D + i * 8) = (u32x4){0u, 0u, 0u, 0u};
    { const float* src = p.in[25] + (size_t)l * 512 * D; for (int t = (b + 64) % G; t < 8 * 32; t += G) { const int kt = t / 32, ntl = t - kt * 32; conv_tile(TID, src, D, kt * 64, ntl * 64, D, btout, D, 0, false, tile); } }
    { const float* src = p.in[26] + (size_t)l * 512 * D; for (int t = (b + 128) % G; t < 8 * 32; t += G) { const int kt = t / 32, ntl = t - kt * 32; conv_tile(TID, src, D, kt * 64, ntl * 64, D, btout, D, 512, false, tile); } }
    { const float* src = p.in[27] + (size_t)l * 1024 * D; for (int t = b; t < 16 * 32; t += G) { const int kt = t / 32, ntl = t - kt * 32; conv_tile(TID, src, D, kt * 64, ntl * 64, D, btout, D, 1024, false, tile); } }
    { const float* src = p.in[28] + (size_t)l * D * D; for (int t = b; t < 32 * 32; t += G) { const int kt = t / 32, ntl = t - kt * 32; conv_tile(TID, src, D, kt * 64, ntl * 64, D, bto, D, 0, false, tile); } }
    { const float* src = p.in[13] + (size_t)l * 512 * 512; for (int t = (b + 192) % G; t < 8 * 8; t += G) { const int kt = t / 8, ntl = t - kt * 8; conv_tile(TID, src, 512, kt * 64, ntl * 64, 512, btglu, 512, 0, false, tile); } }
    for (int t = (b + 32) % G; t < 128; t += G) { const int mat = t >> 2, sub = t & 3;
        const int dk = mat >> 3, nb = mat & 7, d = dk >> 1, kind = dk & 1;
        const float* src = p.in[kind ? 22 : 20] + ((size_t)(l * 2 + d) * 8 + nb) * 128 * 128;
        conv_tile(TID, src, 128, (sub >> 1) * 64, (sub & 1) * 64, 128, btlru + (size_t)mat * 128 * 128, 128, 0, false, tile); }
}
__device__ __forceinline__ double exp_small(double x) { double s = 1.0, t = 1.0; for (int i = 1; i <= 14; ++i) { t *= x / (double)i; s += t; } return s; }
__device__ __forceinline__ double exp_neg(double x) { double e = exp_small(x * (1.0 / 64.0)); for (int i = 0; i < 6; ++i) e *= e; return e; }
__device__ __forceinline__ void s5_tables_all(const int TID, const int BID, const Params& p) {
    for (int vidx = (int)(gridDim.x - 1 - BID) * 512 + TID; vidx < 4 * 4096; vidx += gridDim.x * 512) {
        const int l = vidx >> 12, idx = vidx & 4095;
        f32x2* pw = (f32x2*)(p.ws + WS_PW) + l * PWL; f32x2* bbar = (f32x2*)(p.ws + WS_BBAR) + l * BBL;
        const int g = idx >> 7, d = (idx >> 6) & 1, n = idx & 63;
        const double dt = exp_neg((double)p.in[7][(l * 2 + d) * 32 + g]);
        const double lr = (double)p.in[5][((size_t)(l * 2 + d) * 32 + g) * 64 + n], li = (double)p.in[6][((size_t)(l * 2 + d) * 32 + g) * 64 + n];
        const double mag = exp_neg(lr * dt);
        double ang = li * dt; const double twopi = 6.283185307179586476925287; ang -= twopi * rint(ang / twopi);
        const double a8 = ang * 0.125, a2 = a8 * a8;
        double sn = a8, cs = 1.0, ts = a8, tc = 1.0;
        for (int i = 1; i <= 9; ++i) { tc *= -a2 / (double)((2 * i - 1) * (2 * i)); cs += tc; ts *= -a2 / (double)((2 * i) * (2 * i + 1)); sn += ts; }
        for (int i = 0; i < 3; ++i) { const double c2 = cs * cs - sn * sn, s2 = 2.0 * cs * sn; cs = c2; sn = s2; }
        const double abr = mag * cs, abi = mag * sn;
        double pr = 1.0, pi = 0.0;
        for (int j = 0; j <= 16; ++j) { pw[((size_t)(g * 2 + d) * 17 + j) * 64 + n] = (f32x2){(float)pr, (float)pi}; const double nr = pr * abr - pi * abi, ni = pr * abi + pi * abr; pr = nr; pi = ni; }
        const double den = lr * lr + li * li, fr = ((abr - 1.0) * lr + abi * li) / den, fi = (abi * lr - (abr - 1.0) * li) / den;
        float brf[16], bif[16];
#pragma unroll
        for (int c4 = 0; c4 < 4; ++c4) { const f32x4 t0 = *(const f32x4*)(p.in[8] + (((size_t)l * 32 + g) * 64 + n) * 16 + c4 * 4), t1 = *(const f32x4*)(p.in[9] + (((size_t)l * 32 + g) * 64 + n) * 16 + c4 * 4);
#pragma unroll
            for (int e = 0; e < 4; ++e) { brf[c4 * 4 + e] = t0[e]; bif[c4 * 4 + e] = t1[e]; } }
#pragma unroll
        for (int c = 0; c < 16; ++c) { const double br = (double)brf[c], bi = (double)bif[c];
            bbar[((size_t)(g * 2 + d) * 64 + n) * 16 + c] = (f32x2){(float)(fr * br - fi * bi), (float)(fr * bi + fi * br)}; }
    }
}
__device__ __forceinline__ float s5_kval(const float* cre, const float* cim, const f32x2* pw, const f32x2* bbar, int l, int g, int d, int j, int c, int cp) {
    const float* cr = cre + (((size_t)(l * 2 + d) * 32 + g) * 16 + c) * 64; const float* ci = cim + (((size_t)(l * 2 + d) * 32 + g) * 16 + c) * 64;
    const f32x2* pp = pw + ((size_t)(g * 2 + d) * 17 + j) * 64; const f32x2* bb = bbar + ((size_t)(g * 2 + d) * 64) * 16 + cp;
    float s = 0.f;
#pragma unroll 16
    for (int n = 0; n < 64; ++n) { const f32x2 pv = pp[n]; const f32x2 bv = bb[(size_t)n * 16]; const float er = cr[n] * pv.x - ci[n] * pv.y, ei = cr[n] * pv.y + ci[n] * pv.x; s += er * bv.x - ei * bv.y; }
    return s;
}
__device__ __forceinline__ void s5_assemble_a(const int TID, const int BID, const Params& p, int l) {
    const f32x2* pw = (const f32x2*)(p.ws + WS_PW) + l * PWL; const f32x2* bbar = (const f32x2*)(p.ws + WS_BBAR) + l * BBL;
    float* kmat = (float*)(p.ws + WS_KMAT); bf16_t* pmat = (bf16_t*)(p.ws + WS_PMAT);
    const float* cre = p.in[10]; const float* cim = p.in[11];
    const size_t stride = (size_t)gridDim.x * 512;
    for (size_t idx = (size_t)BID * 512 + TID; idx < (size_t)32 * 2 * 16 * 256; idx += stride) {
        const int g = (int)(idx >> 13), d = (int)(idx >> 12) & 1, j = (int)(idx >> 8) & 15, c = (int)(idx >> 4) & 15, cp = (int)idx & 15;
        kmat[idx] = s5_kval(cre, cim, pw, bbar, l, g, d, j, c, cp);
    }
    for (size_t idx = (size_t)BID * 512 + TID; idx < (size_t)32 * 256 * 256; idx += stride) {
        const int g = (int)(idx >> 16), nout = (int)(idx >> 8) & 255, k = (int)idx & 255, d = nout >> 7, ri = (nout >> 6) & 1, n = nout & 63, s = k >> 4, cp = k & 15, j = d == 0 ? 15 - s : s;
        const f32x2 pv = pw[((size_t)(g * 2 + d) * 17 + j) * 64 + n]; const f32x2 bv = bbar[((size_t)(g * 2 + d) * 64 + n) * 16 + cp];
        pmat[idx] = f2bf(ri == 0 ? pv.x * bv.x - pv.y * bv.y : pv.x * bv.y + pv.y * bv.x);
    }
}
__device__ __forceinline__ void s5_assemble_w(const int TID, const int BID, const Params& p, int l) {
    const f32x2* pw = (const f32x2*)(p.ws + WS_PW) + l * PWL; const float* kmat = (const float*)(p.ws + WS_KMAT);
    bf16_t* wmat = (bf16_t*)(p.ws + WS_WMAT);
    const float* cre = p.in[10]; const float* cim = p.in[11];
    const size_t stride = (size_t)gridDim.x * 512;
    for (size_t idx = (size_t)BID * 512 + TID; idx < (size_t)32 * 256 * 512; idx += stride) {
        const int g = (int)(idx >> 17), nout = (int)(idx >> 9) & 255, k = (int)idx & 511, t = nout >> 4, c = nout & 15;
        float val;
        if (k < 256) { const int s = k >> 4, cp = k & 15; val = 0.f;
            const int jf = s <= t ? t - s : 0, jb = s >= t ? s - t : 0;
            const float kf = kmat[((((size_t)g * 2 + 0) * 16 + jf) * 16 + c) * 16 + cp], kb = kmat[((((size_t)g * 2 + 1) * 16 + jb) * 16 + c) * 16 + cp], dsk = p.in[12][l * 512 + g * 16 + c];
            val = (s <= t ? kf : 0.f) + (s >= t ? kb : 0.f) + ((s == t && c == cp) ? dsk : 0.f);
        } else { const int kk = k - 256, d = kk >> 7, ri = (kk >> 6) & 1, n = kk & 63, j = d == 0 ? t + 1 : 16 - t;
            const float cr = cre[(((size_t)(l * 2 + d) * 32 + g) * 16 + c) * 64 + n], ci = cim[(((size_t)(l * 2 + d) * 32 + g) * 16 + c) * 64 + n];
            const f32x2 pv = pw[((size_t)(g * 2 + d) * 17 + j) * 64 + n];
            val = ri == 0 ? cr * pv.x - ci * pv.y : -(cr * pv.y + ci * pv.x); }
        wmat[idx] = f2bf(val);
    }
}

__device__ __forceinline__ void scans_phase(const int TID, const int BID, const Params& p, const int l, const bool do_gla) {
    const int G = gridDim.x;
    const bool split = (G == 256);
    {
        const f32x2* pw = (const f32x2*)(p.ws + WS_PW) + l * PWL; const bf16_t* st = (const bf16_t*)(p.ws + WS_ST); bf16_t* ub = (bf16_t*)(p.ws + WS_UBUF);
        for (int idx = BID * 512 + TID; idx < 40960; idx += G * 512) {
            const int seq = idx >> 12, rem = idx & 4095, g = rem >> 7, d = (rem >> 6) & 1, n = rem & 63;
            const int ch0 = seq < 2 ? seq * 257 : 514 + (seq - 2) * 129, nc = seq < 2 ? 257 : 129;
            const f32x2 a16 = pw[((size_t)(g * 2 + d) * 17 + 16) * 64 + n];
            float sr = 0.f, si = 0.f;
            for (int s0 = 0; s0 < nc; s0 += 32) {
                float lr[32], li[32];
#pragma unroll
                for (int i = 0; i < 32; ++i) { const int step = s0 + i; lr[i] = 0.f; li[i] = 0.f;
                    { const int sc = step < nc ? step : nc - 1; const int c = d == 0 ? sc : nc - 1 - sc; const size_t row = (size_t)g * CHP + ch0 + c; lr[i] = bf2f(st[row * 256 + d * 128 + n]); li[i] = bf2f(st[row * 256 + d * 128 + 64 + n]); } }
#pragma unroll
                for (int i = 0; i < 32; ++i) { const int step = s0 + i;
                    if (step < nc) { const int c = d == 0 ? step : nc - 1 - step; const size_t row = (size_t)g * CHP + ch0 + c;
                        ub[row * 512 + 256 + d * 128 + n] = f2bf(sr); ub[row * 512 + 256 + d * 128 + 64 + n] = f2bf(si);
                        const float nr = a16.x * sr - a16.y * si + lr[i], ni = a16.x * si + a16.y * sr + li[i]; sr = nr; si = ni; } }
            }
        }
    }
    {
        const float* la = (const float*)(p.ws + WS_LRUA); const float* lh = (const float*)(p.ws + WS_LRUH); float* lc = (float*)(p.ws + WS_LRUC);
        const int vb0 = split ? BID - 80 : BID, vstride = split ? 1 << 20 : G;
        for (int vb = vb0; vb >= 0 && vb < 40; vb += vstride) {
            const int idx = vb * 512 + TID;
            const int seq = idx >> 11, d = (idx >> 10) & 1, ch = idx & 1023;
            const int cb = seq < 2 ? seq * 65 : 130 + (seq - 2) * 33, nc = seq < 2 ? 65 : 33;
            float cin = 0.f;
            for (int s0 = 0; s0 < nc; s0 += 16) {
                float A[16], H[16];
#pragma unroll
                for (int i = 0; i < 16; ++i) { const int step = s0 + i; A[i] = 1.f; H[i] = 0.f;
                    { const int sc = step < nc ? step : nc - 1; const int ci = cb + (d == 0 ? sc : nc - 1 - sc); const size_t o = ((size_t)ci * 2 + d) * 1024 + ch; A[i] = la[o]; H[i] = lh[o]; } }
#pragma unroll
                for (int i = 0; i < 16; ++i) { const int step = s0 + i;
                    if (step < nc) { const int ci = cb + (d == 0 ? step : nc - 1 - step); const size_t o = ((size_t)ci * 2 + d) * 1024 + ch; lc[o] = cin; cin = A[i] * cin + H[i]; } }
            }
        }
    }
    if (do_gla) {
        const float* ds = (const float*)(p.ws + WS_DS); const float* dec = (const float*)(p.ws + WS_DECAY); bf16_t* spb = (bf16_t*)(p.ws + WS_SPB);
        for (int it = 0; ; ++it) {
            int vb;
            if (split) { if (BID >= 120) { if (it >= 8) break; vb = (BID - 120) + 136 * it; } else { vb = 1088 + BID + 120 * it; if (vb >= 1280) break; } }
            else { vb = BID + G * it; if (vb >= 1280) break; }
            const int e = vb * 512 + TID;
            const int seq = e >> 16, rem = e & 65535, head = rem >> 14, d = (rem >> 13) & 1, el = rem & 8191, kk = el & 63;
            const int cb = seq < 2 ? seq * 65 : 130 + (seq - 2) * 33, nc = seq < 2 ? 65 : 33;
            float S = 0.f;
            for (int s0 = 0; s0 < nc; s0 += 16) {
                float tm[16], dc[16];
#pragma unroll
                for (int i = 0; i < 16; ++i) { const int step = s0 + i; tm[i] = 0.f; dc[i] = 1.f;
                    { const int sc = step < nc ? step : nc - 1; const int ci = cb + (d == 0 ? sc : nc - 1 - sc); const size_t o = ((size_t)(ci * 4 + head) * 2 + d); tm[i] = ds[o * 8192 + el]; dc[i] = dec[o * 64 + kk]; } }
#pragma unroll
                for (int i = 0; i < 16; ++i) { const int step = s0 + i;
                    if (step < nc) { const int ci = cb + (d == 0 ? step : nc - 1 - step); const size_t o = ((size_t)(ci * 4 + head) * 2 + d); spb[o * 8192 + el] = f2bf(S); S = dc[i] * S + tm[i]; } }
            }
        }
    }
}

__device__ __forceinline__ f32x4 mma_lds(f32x4 acc, const LAS bf16_t* A, const LAS bf16_t* B, int ld, int nks, int lane) {
    const LAS bf16_t* ap = A + (lane & 15) * ld + (lane >> 4) * 8; const LAS bf16_t* bp = B + (lane & 15) * ld + (lane >> 4) * 8;
    for (int ks = 0; ks < nks; ++ks) acc = __builtin_amdgcn_mfma_f32_16x16x32_bf16(*(const LAS bf16x8*)(ap + ks * 32), *(const LAS bf16x8*)(bp + ks * 32), acc, 0, 0, 0);
    return acc;
}
__device__ __forceinline__ f32x4 mma_lds_sw(f32x4 acc, const LAS bf16_t* A, int rowA0, const LAS bf16_t* B, int rowB0, int ld, int nks, int lane) {
    const int swa = rowA0 >= 0 ? (((rowA0 + (lane & 15)) >> 3) & 7) : 0, swb = rowB0 >= 0 ? (((rowB0 + (lane & 15)) >> 3) & 7) : 0;
    const LAS bf16_t* ap = A + (lane & 15) * ld; const LAS bf16_t* bp = B + (lane & 15) * ld;
    for (int ks = 0; ks < nks; ++ks) { const int cb = ks * 4 + (lane >> 4);
        acc = __builtin_amdgcn_mfma_f32_16x16x32_bf16(*(const LAS bf16x8*)(ap + ((cb ^ swa) << 3)), *(const LAS bf16x8*)(bp + ((cb ^ swb) << 3)), acc, 0, 0, 0); }
    return acc;
}
#define SWZ(row, col) (((((col) >> 3) ^ (((row) >> 3) & 7)) << 3) + ((col) & 7))
constexpr int GL_GLR = 0, GL_BF = 16384, GL_BB = 32768, GL_OS = 0, GL_QE0 = 49152, GL_QE1 = 58368, GL_KE0 = 67584, GL_KE1 = 76800, GL_VT = 86016, GL_ATT = 104448, GL_SP0 = 113664, GL_SP1 = 132096;
constexpr int GLD = 72;
template <int MODE>
__device__ __forceinline__ void gla_item(const int TID, const Params& p, int l, int ci, int head, LAS unsigned char* lds, const float (&wg)[2][16], const float (&bg)[2], const float (&ngv)[16]) {
    const int tid = TID, lane = tid & 63, wid = tid >> 6;
    const bf16_t* cols = (const bf16_t*)(p.ws + WS_COLS);
    int seq, c; chunk_info(ci, seq, c);
    const int tok0 = seq_start(seq) + (c == 0 ? -48 : 16 + 64 * (c - 1));
    const int rmin = (c == 0) ? 48 : 0;
    LAS float* glr_s = (LAS float*)(lds + GL_GLR); LAS float* bfs = (LAS float*)(lds + GL_BF); LAS float* bbs = (LAS float*)(lds + GL_BB);
    f32x4 gbv[4];
    if (MODE == 1) { const float* gb = (const float*)(p.ws + WS_GB) + (size_t)(ci * 4 + head) * 8192;
#pragma unroll
      for (int i = 0; i < 4; ++i) gbv[i] = *(const f32x4*)(gb + (i * 512 + tid) * 4); }
    u32x4 kw = (u32x4){0u, 0u, 0u, 0u}, qw = kw, vwp[2], gwp[2];
    { const int r = tid >> 3, k8 = (tid & 7) * 8; const int rc = r >= rmin ? r : rmin; const bf16_t* rowp = cols + (size_t)(tok0 + rc) * NINP;
      kw = *(const u32x4*)(rowp + C_K + head * 64 + k8); if (MODE == 1) qw = *(const u32x4*)(rowp + C_Q + head * 64 + k8);
#pragma unroll
      for (int hh = 0; hh < 2; ++hh) { vwp[hh] = *(const u32x4*)(rowp + C_V + head * 128 + ((tid & 7) + 8 * hh) * 8); if (MODE == 1) gwp[hh] = *(const u32x4*)(rowp + C_GB + head * 128 + (tid & 7) * 16 + hh * 8); } }
    if (MODE == 0) {
    { const int r = tid >> 3, j4 = (tid & 7) * 4; f32x4 v = (f32x4){0.f, 0.f, 0.f, 0.f};
      { const int rc = r >= rmin ? r : rmin; const u32x2 w = *(const u32x2*)(cols + (size_t)(tok0 + rc) * NINP + C_GLR + j4); if (r >= rmin) { v[0] = bflo(w.x); v[1] = bfhi(w.x); v[2] = bflo(w.y); v[3] = bfhi(w.y); } }
      *(LAS f32x4*)(glr_s + r * 32 + j4) = v; }
    __syncthreads();
    { const int kk = tid & 63, rb = tid >> 6;
#pragma unroll
      for (int i = 0; i < 8; ++i) { const int r = rb + 8 * i; float x0 = bg[0], x1 = bg[1]; f32x4 gr[8];
#pragma unroll
          for (int j4 = 0; j4 < 8; ++j4) gr[j4] = *(const LAS f32x4*)(glr_s + r * 32 + j4 * 4);
#pragma unroll
          for (int j = 0; j < 16; ++j) { x0 += gr[j >> 2][j & 3] * wg[0][j]; x1 += gr[4 + (j >> 2)][j & 3] * wg[1][j]; }
          const bool ok = r >= rmin; bfs[r * 64 + kk] = ok ? logsig(x0) * 0.0625f : 0.f; bbs[r * 64 + kk] = ok ? logsig(x1) * 0.0625f : 0.f; } }
    __syncthreads();
    { const int col = tid & 127, part = tid >> 7, d = col >> 6, kk = col & 63; LAS float* bs = d ? bbs : bfs; LAS float* tot = glr_s;
      float v[16];
#pragma unroll
      for (int i = 0; i < 16; ++i) v[i] = bs[(part * 16 + i) * 64 + kk];
      if (d == 0) {
#pragma unroll
          for (int i = 1; i < 16; ++i) v[i] += v[i - 1];
          tot[part * 128 + col] = v[15]; }
      else {
#pragma unroll
          for (int i = 14; i >= 0; --i) v[i] += v[i + 1];
          tot[part * 128 + col] = v[0]; }
      __syncthreads();
      float off = 0.f;
#pragma unroll
      for (int pp = 0; pp < 4; ++pp) { const float t = tot[pp * 128 + col]; if (d == 0 ? pp < part : pp > part) off += t; }
#pragma unroll
      for (int i = 0; i < 16; ++i) bs[(part * 16 + i) * 64 + kk] = v[i] + off; }
    __syncthreads();
    { float* gb = (float*)(p.ws + WS_GB) + (size_t)(ci * 4 + head) * 8192;
#pragma unroll
      for (int i = 0; i < 4; ++i) { const int e = (i * 512 + tid) * 4; *(f32x4*)(gb + e) = *(const LAS f32x4*)(bfs + e); } }
    } else {
      __syncthreads();
#pragma unroll
      for (int i = 0; i < 4; ++i) { const int e = (i * 512 + tid) * 4; *(LAS f32x4*)(bfs + e) = gbv[i]; }
      __syncthreads();
    }
    LAS bf16_t* vT = (LAS bf16_t*)(lds + GL_VT);
    { const int r = tid >> 3, k8 = (tid & 7) * 8; const bool ok = r >= rmin;
      if (!ok) { kw = (u32x4){0u, 0u, 0u, 0u}; qw = kw; }
      float qv[8], kv[8];
#pragma unroll
      for (int i = 0; i < 4; ++i) { qv[2 * i] = bflo(qw[i]); qv[2 * i + 1] = bfhi(qw[i]); kv[2 * i] = bflo(kw[i]); kv[2 * i + 1] = bfhi(kw[i]); }
      if (MODE == 0) { LAS bf16_t* kd0 = (LAS bf16_t*)(lds + GL_QE0); LAS bf16_t* kd1 = (LAS bf16_t*)(lds + GL_QE1);
#pragma unroll
          for (int i = 0; i < 8; ++i) { const int kk = k8 + i; kd0[kk * GLD + SWZ(kk, r)] = f2bf(kv[i] * __expf(bfs[63 * 64 + kk] - bfs[r * 64 + kk])); kd1[kk * GLD + SWZ(kk, r)] = f2bf(kv[i] * __expf(bbs[kk] - bbs[r * 64 + kk])); }
      } else { LAS bf16_t* qe0 = (LAS bf16_t*)(lds + GL_QE0); LAS bf16_t* qe1 = (LAS bf16_t*)(lds + GL_QE1); LAS bf16_t* ke0 = (LAS bf16_t*)(lds + GL_KE0); LAS bf16_t* ke1 = (LAS bf16_t*)(lds + GL_KE1);
          u32x4 a, b2, c2, d2;
#pragma unroll
          for (int i = 0; i < 4; ++i) { const int kk = k8 + 2 * i; const float f0 = bfs[r * 64 + kk], f1 = bfs[r * 64 + kk + 1], g0 = bbs[r * 64 + kk], g1 = bbs[r * 64 + kk + 1];
              a[i] = cvt_pk_bf16(qv[2 * i] * 0.125f * __expf(f0), qv[2 * i + 1] * 0.125f * __expf(f1)); b2[i] = cvt_pk_bf16(qv[2 * i] * 0.125f * __expf(g0), qv[2 * i + 1] * 0.125f * __expf(g1));
              c2[i] = cvt_pk_bf16(kv[2 * i] * __expf(-f0), kv[2 * i + 1] * __expf(-f1)); d2[i] = cvt_pk_bf16(kv[2 * i] * __expf(-g0), kv[2 * i + 1] * __expf(-g1)); }
          *(LAS u32x4*)(qe0 + r * GLD + k8) = a; *(LAS u32x4*)(qe1 + r * GLD + k8) = b2; *(LAS u32x4*)(ke0 + r * GLD + k8) = c2; *(LAS u32x4*)(ke1 + r * GLD + k8) = d2; }
#pragma unroll
      for (int hh = 0; hh < 2; ++hh) { const int v8 = ((tid & 7) + 8 * hh) * 8; u32x4 vw = (u32x4){0u, 0u, 0u, 0u};
          if (ok) vw = vwp[hh];
#pragma unroll
          for (int i = 0; i < 4; ++i) { vT[(v8 + 2 * i) * GLD + SWZ(v8, r)] = (bf16_t)(vw[i] & 0xffffu); vT[(v8 + 2 * i + 1) * GLD + SWZ(v8, r)] = (bf16_t)(vw[i] >> 16); } }
    }
    if (MODE == 1) {
        const bf16_t* spb = (const bf16_t*)(p.ws + WS_SPB); u32x4 sv[2][2];
#pragma unroll
        for (int d = 0; d < 2; ++d) { const bf16_t* src = spb + ((size_t)(ci * 4 + head) * 2 + d) * 8192;
#pragma unroll
            for (int i = 0; i < 2; ++i) sv[d][i] = *(const u32x4*)(src + (i * 512 + tid) * 8); }
#pragma unroll
        for (int d = 0; d < 2; ++d) { LAS bf16_t* sp = (LAS bf16_t*)(lds + (d ? GL_SP1 : GL_SP0));
#pragma unroll
            for (int i = 0; i < 2; ++i) { const int e = (i * 512 + tid) * 8; *(LAS u32x4*)(sp + (e >> 6) * GLD + (e & 63)) = sv[d][i]; } }
    }
    __syncthreads();
    if (MODE == 0) {
        float* ds = (float*)(p.ws + WS_DS); float* dec = (float*)(p.ws + WS_DECAY);
        if (tid < 128) { const int d = tid >> 6, kk = tid & 63; dec[((size_t)(ci * 4 + head) * 2 + d) * 64 + kk] = __expf(d == 0 ? bfs[63 * 64 + kk] : bbs[kk]); }
#pragma unroll
        for (int d = 0; d < 2; ++d) { const LAS bf16_t* kd = (const LAS bf16_t*)(lds + (d ? GL_QE1 : GL_QE0)); float* dst = ds + ((size_t)(ci * 4 + head) * 2 + d) * 8192;
            for (int kt = 0; kt < 4; ++kt) { f32x4 acc = (f32x4){0.f, 0.f, 0.f, 0.f}; acc = mma_lds_sw(acc, vT + wid * 16 * GLD, wid * 16, kd + kt * 16 * GLD, kt * 16, GLD, 2, lane);
#pragma unroll
                for (int j = 0; j < 4; ++j) dst[(wid * 16 + (lane >> 4) * 4 + j) * 64 + kt * 16 + (lane & 15)] = acc[j]; } }
        __syncthreads();
        return;
    }
    const LAS bf16_t* qe0 = (const LAS bf16_t*)(lds + GL_QE0); const LAS bf16_t* qe1 = (const LAS bf16_t*)(lds + GL_QE1); const LAS bf16_t* ke0 = (const LAS bf16_t*)(lds + GL_KE0); const LAS bf16_t* ke1 = (const LAS bf16_t*)(lds + GL_KE1);
    LAS bf16_t* att = (LAS bf16_t*)(lds + GL_ATT);
    { const int it = wid >> 1;
#pragma unroll
      for (int t2 = 0; t2 < 2; ++t2) { const int jt = (wid & 1) * 2 + t2; f32x4 af = (f32x4){0.f, 0.f, 0.f, 0.f}, ab = af;
          af = mma_lds(af, qe0 + it * 16 * GLD, ke0 + jt * 16 * GLD, GLD, 2, lane); ab = mma_lds(ab, qe1 + it * 16 * GLD, ke1 + jt * 16 * GLD, GLD, 2, lane);
#pragma unroll
          for (int j = 0; j < 4; ++j) { const int i_ = it * 16 + (lane >> 4) * 4 + j, j_ = jt * 16 + (lane & 15); att[i_ * GLD + j_] = f2bf((j_ <= i_ ? af[j] : 0.f) + (j_ >= i_ ? ab[j] : 0.f)); } } }
    __syncthreads();
    LAS float* os = (LAS float*)(lds + GL_OS);
    { const int it = wid >> 1; const LAS bf16_t* sp0 = (const LAS bf16_t*)(lds + GL_SP0); const LAS bf16_t* sp1 = (const LAS bf16_t*)(lds + GL_SP1);
#pragma unroll
      for (int t4 = 0; t4 < 4; ++t4) { const int vt = (wid & 1) * 4 + t4; f32x4 acc = (f32x4){0.f, 0.f, 0.f, 0.f};
          acc = mma_lds_sw(acc, att + it * 16 * GLD, -1, vT + vt * 16 * GLD, vt * 16, GLD, 2, lane); acc = mma_lds(acc, qe0 + it * 16 * GLD, sp0 + vt * 16 * GLD, GLD, 2, lane); acc = mma_lds(acc, qe1 + it * 16 * GLD, sp1 + vt * 16 * GLD, GLD, 2, lane);
#pragma unroll
          for (int j = 0; j < 4; ++j) os[(it * 16 + (lane >> 4) * 4 + j) * 132 + vt * 16 + (lane & 15)] = acc[j]; } }
    __syncthreads();
    { const int r = tid >> 3, v0 = (tid & 7) * 16; float o[16]; float ss = 0.f;
#pragma unroll
      for (int i = 0; i < 16; ++i) { o[i] = os[r * 132 + v0 + i]; ss += o[i] * o[i]; }
      ss += __shfl_xor(ss, 1); ss += __shfl_xor(ss, 2); ss += __shfl_xor(ss, 4);
      const float rs = rsqrtf(ss * (1.0f / 128.0f) + 1e-6f);
      if (r >= rmin) { const size_t tok = (size_t)(tok0 + r); bf16_t* yall = (bf16_t*)(p.ws + WS_YALL);
#pragma unroll
          for (int hh = 0; hh < 2; ++hh) { const u32x4 gw = gwp[hh]; u32x4 w;
#pragma unroll
              for (int i = 0; i < 4; ++i) { const int e = hh * 8 + 2 * i; w[i] = cvt_pk_bf16(o[e] * rs * ngv[e] * silu(bflo(gw[i])), o[e + 1] * rs * ngv[e + 1] * silu(bfhi(gw[i]))); }
              *(u32x4*)(yall + tok * D + 512 + head * 128 + v0 + hh * 8) = w; } } }
    __syncthreads();
}

__device__ __forceinline__ float softplus_neg(float lam) { const float e = __expf(-lam); return lam + 0.f < -8.f ? -lam : (e < 0.02f ? e * (1.0f - e * (0.5f - e * (1.0f / 3.0f))) : __logf(1.0f + e)); }
__device__ __forceinline__ float one_minus_exp(float x) {
    return x > -0.5f ? -x * (1.0f + x * 0.5f * (1.0f + x * (1.0f / 3.0f) * (1.0f + x * 0.25f * (1.0f + x * 0.2f * (1.0f + x * (1.0f / 6.0f) * (1.0f + x * (1.0f / 7.0f))))))) : 1.0f - __expf(x);
}
template <int MODE>
__device__ __forceinline__ void lru_phase(const int TID, const int b, const int G, const Params& p, int l, LAS unsigned char* lds) {
    const int tid = TID, lane = tid & 63, wid = tid >> 6, q = lane >> 4;
    const bf16_t* cols = (const bf16_t*)(p.ws + WS_COLS);
    int it = b; if (it >= NCK * 8) return;
    const int nb = b & 7;
    LAS bf16_t* xcA = (LAS bf16_t*)lds; LAS float* xcf = (LAS float*)(lds + 17408);
    const int ch = tid & 127, rb = tid >> 7, gchc = nb * 128 + ch;
    const float w0 = p.in[18][(l * 4 + 0) * 1024 + gchc], w1 = p.in[18][(l * 4 + 1) * 1024 + gchc], w2 = p.in[18][(l * 4 + 2) * 1024 + gchc], w3 = p.in[18][(l * 4 + 3) * 1024 + gchc], cb = p.in[19][l * 1024 + gchc];
    const int chl = wid * 16 + (lane & 15), gch = nb * 128 + chl;
    float ba[2], bx[2], sp8[2];
#pragma unroll
    for (int d = 0; d < 2; ++d) { ba[d] = p.in[21][(l * 2 + d) * 1024 + gch]; bx[d] = p.in[23][(l * 2 + d) * 1024 + gch]; sp8[d] = 8.0f * softplus_neg(p.in[24][(l * 2 + d) * 1024 + gch]); }
    bf16x8 bfr[4][4];
    { const bf16_t* bt = (const bf16_t*)(p.ws + WS_BTLRU);
#pragma unroll
      for (int mat = 0; mat < 4; ++mat)
#pragma unroll
          for (int ks = 0; ks < 4; ++ks) bfr[mat][ks] = *(const bf16x8*)(bt + ((size_t)(mat * 8 + nb) * 128 + wid * 16 + (lane & 15)) * 128 + ks * 32 + q * 8); }
    bf16_t xr[19];
    { int seq, c; chunk_info(it >> 3, seq, c); const int s0 = seq_start(seq), L = seq_len(seq), pos0 = (c == 0 ? -48 : 16 + 64 * (c - 1));
      const bf16_t* xb = cols + (size_t)s0 * NINP + C_XC + gchc;
#pragma unroll
      for (int i = 0; i < 19; ++i) { const int pos = pos0 + rb * 16 - 2 + i; const int pc = pos < 0 ? 0 : (pos < L ? pos : L - 1); xr[i] = xb[(size_t)pc * NINP]; } }
    for (; it < NCK * 8; it += G) {
        const int ci = it >> 3;
        int seq, c; chunk_info(ci, seq, c);
        const int s0 = seq_start(seq);
        const int pos0 = (c == 0 ? -48 : 16 + 64 * (c - 1));
        const int rmin = (c == 0) ? 48 : 0;
        float xv[19];
        { const int L = seq_len(seq);
#pragma unroll
          for (int i = 0; i < 19; ++i) { const int pos = pos0 + rb * 16 - 2 + i; xv[i] = (pos >= 0 && pos < L) ? bf2f(xr[i]) : 0.f; } }
#pragma unroll
        for (int i = 0; i < 16; ++i) { const int r = rb * 16 + i; const float xc = (r >= rmin) ? cb + xv[i] * w0 + xv[i + 1] * w1 + xv[i + 2] * w2 + xv[i + 3] * w3 : 0.f;
            xcf[r * 132 + ch] = xc; xcA[r * 136 + ch] = f2bf(xc); }
        u32x4 gq[2]; float cin[2];
        if (MODE == 1) {
#pragma unroll
            for (int d = 0; d < 2; ++d) cin[d] = ((const float*)(p.ws + WS_LRUC))[((size_t)ci * 2 + d) * 1024 + gch];
            { const int r = tid >> 3; const int rr = r >= rmin ? r : rmin; const bf16_t* gp = cols + (size_t)(s0 + pos0 + rr) * NINP + C_GC + nb * 128 + (tid & 7) * 16;
              gq[0] = *(const u32x4*)gp; gq[1] = *(const u32x4*)(gp + 8); }
        }
        { const int itn = it + G;
          if (itn < NCK * 8) { int seqn, cn; chunk_info(itn >> 3, seqn, cn); const int s0n = seq_start(seqn), Ln = seq_len(seqn), pos0n = (cn == 0 ? -48 : 16 + 64 * (cn - 1));
              const bf16_t* xb = cols + (size_t)s0n * NINP + C_XC + gchc;
#pragma unroll
              for (int i = 0; i < 19; ++i) { const int pos = pos0n + rb * 16 - 2 + i; const int pc = pos < 0 ? 0 : (pos < Ln ? pos : Ln - 1); xr[i] = xb[(size_t)pc * NINP]; } } }
        LBAR();
        LAS bf16_t* gts = (LAS bf16_t*)(lds + 51200); LAS float* hfs = (LAS float*)(lds + 68608);
        float hsum[4][4];
#pragma unroll
        for (int d = 0; d < 2; ++d) {
            __builtin_amdgcn_sched_barrier(0);
            f32x4 acc[2][4];
#pragma unroll
            for (int rt = 0; rt < 4; ++rt) { bf16x8 afr[4];
#pragma unroll
                for (int ks = 0; ks < 4; ++ks) afr[ks] = *(const LAS bf16x8*)(xcA + (rt * 16 + (lane & 15)) * 136 + ks * 32 + q * 8);
#pragma unroll
                for (int kind = 0; kind < 2; ++kind) { f32x4 a = (f32x4){0.f, 0.f, 0.f, 0.f};
#pragma unroll
                    for (int ks = 0; ks < 4; ++ks) a = __builtin_amdgcn_mfma_f32_16x16x32_bf16(afr[ks], bfr[d * 2 + kind][ks], a, 0, 0, 0);
                    acc[kind][rt] = a; } }
            float a[4][4], bb[4][4];
#pragma unroll
            for (int rt = 0; rt < 4; ++rt)
#pragma unroll
                for (int j = 0; j < 4; ++j) { const int r = rt * 16 + q * 4 + j; const float rg = sigm(acc[0][rt][j] + ba[d]), ig = sigm(acc[1][rt][j] + bx[d]), la = -sp8[d] * rg;
                    const bool ok = r >= rmin; const float av = __expf(la), x2 = 2.0f * la; const float om = x2 > -0.25f ? -x2 * (1.0f + x2 * 0.5f * (1.0f + x2 * (1.0f / 3.0f) * (1.0f + x2 * 0.25f * (1.0f + x2 * 0.2f)))) : 1.0f - av * av;
                    a[rt][j] = ok ? av : 1.0f; bb[rt][j] = ok ? __builtin_amdgcn_sqrtf(om) * ig * xcf[r * 132 + chl] : 0.f; }
            float LA[4], LB[4];
#pragma unroll
            for (int rt = 0; rt < 4; ++rt) { float A = 1.f, B = 0.f;
#pragma unroll
                for (int jj = 0; jj < 4; ++jj) { const int j = d == 0 ? jj : 3 - jj; B = a[rt][j] * B + bb[rt][j]; A *= a[rt][j]; }
                LA[rt] = A; LB[rt] = B; }
            const size_t co = ((size_t)ci * 2 + d) * 1024 + gch;
            float h = (MODE == 1) ? cin[d] : 0.f, Atot = 1.f; float hin[4];
#pragma unroll
            for (int rr = 0; rr < 4; ++rr) { const int rt = d == 0 ? rr : 3 - rr;
#pragma unroll
                for (int qi = 0; qi < 4; ++qi) { const int qq = d == 0 ? qi : 3 - qi;
                    const float Aq = __shfl(LA[rt], (lane & 15) + 16 * qq), Bq = __shfl(LB[rt], (lane & 15) + 16 * qq);
                    if (qq == q) hin[rt] = h;
                    h = Aq * h + Bq; Atot *= Aq; } }
            if (MODE == 0) { if (q == 0) { ((float*)(p.ws + WS_LRUA))[co] = Atot; ((float*)(p.ws + WS_LRUH))[co] = h; } }
            else {
#pragma unroll
                for (int rt = 0; rt < 4; ++rt) { float hh = hin[rt];
#pragma unroll
                    for (int jj = 0; jj < 4; ++jj) { const int j = d == 0 ? jj : 3 - jj; hh = a[rt][j] * hh + bb[rt][j];
                        if (d == 0) hfs[(rt * 16 + q * 4 + j) * 132 + chl] = hh; else hsum[rt][j] = hh; } }
                if (d == 0) { *(LAS u32x4*)(gts + (tid >> 3) * 136 + (tid & 7) * 16) = gq[0]; *(LAS u32x4*)(gts + (tid >> 3) * 136 + (tid & 7) * 16 + 8) = gq[1]; } }
        }
        if (MODE == 1) { bf16_t* yall = (bf16_t*)(p.ws + WS_YALL);
            LBAR();
#pragma unroll
            for (int rt = 0; rt < 4; ++rt)
#pragma unroll
                for (int j = 0; j < 4; ++j) { const int r = rt * 16 + q * 4 + j; xcA[r * 136 + chl] = f2bf((hsum[rt][j] + hfs[r * 132 + chl]) * silu(bf2f(gts[r * 136 + chl]))); }
            LBAR();
            { const int r = tid >> 3; if (r >= rmin) { const u32x4 y0 = *(const LAS u32x4*)(xcA + r * 136 + (tid & 7) * 16), y1 = *(const LAS u32x4*)(xcA + r * 136 + (tid & 7) * 16 + 8);
                bf16_t* yp = yall + (size_t)(s0 + pos0 + r) * D + 1024 + nb * 128 + (tid & 7) * 16; *(u32x4*)yp = y0; *(u32x4*)(yp + 8) = y1; } } }
        LBAR();
    }
}


template <int WHICH>
__device__ __forceinline__ void skinny_tail(const int TID, const int b0, const Params& p, const int first) {
    const int lane = TID & 63, wid = TID >> 6, q = lane >> 4;
    if (wid >= 5) return;
    for (int b = b0; b < 256; b += (int)gridDim.x) {
    const int ct = b & 127, rt = (b >> 7) * 5 + wid;
    const int row = 24576 + rt * 16 + (lane & 15);
    const int colb = ct * 16 + (lane & 15);
    const bf16_t* cols = (const bf16_t*)(p.ws + WS_COLS);
    if (WHICH == 0) {
        const bf16_t* A = (const bf16_t*)(p.ws + WS_YALL) + (size_t)row * D + q * 8; const bf16_t* B = (const bf16_t*)(p.ws + WS_BTOUT) + (size_t)colb * D + q * 8;
        bf16_t* mbf = (bf16_t*)(p.ws + WS_H);
        f32x4 msum = (f32x4){0.f, 0.f, 0.f, 0.f};
        unsigned char gt[3][4];
#pragma unroll
        for (int br = 0; br < 3; ++br)
#pragma unroll
            for (int j = 0; j < 4; ++j) { const int cc = colb & 255; gt[br][j] = ((const unsigned char*)(cols + (size_t)(24576 + rt * 16 + q * 4 + j) * NINP + C_MG))[(br * 8 + (colb >> 8)) * 256 + ((((cc & 127) >> 5) * 4 + ((cc & 31) >> 3)) * 2 + (cc >> 7)) * 8 + (cc & 7)]; }
        float gs[3][4];
#pragma unroll
        for (int br = 0; br < 3; ++br)
#pragma unroll
            for (int j = 0; j < 4; ++j) { gs[br][j] = (float)gt[br][j] * (1.0f / 255.0f); asm volatile("" : "+v"(gs[br][j])); }
#pragma unroll
        for (int br = 0; br < 3; ++br) { const int koff = br * 512, nks = br == 2 ? 32 : 16; f32x4 acc = (f32x4){0.f, 0.f, 0.f, 0.f};
            for (int k0 = 0; k0 < nks; k0 += 8) { bf16x8 av[8], bv[8];
#pragma unroll
                for (int i = 0; i < 8; ++i) { av[i] = *(const bf16x8*)(A + koff + (k0 + i) * 32); bv[i] = *(const bf16x8*)(B + koff + (k0 + i) * 32); }
#pragma unroll
                for (int i = 0; i < 8; ++i) acc = __builtin_amdgcn_mfma_f32_16x16x32_bf16(av[i], bv[i], acc, 0, 0, 0); }
#pragma unroll
            for (int j = 0; j < 4; ++j) msum[j] += gs[br][j] * acc[j]; }
#pragma unroll
        for (int j = 0; j < 4; ++j) { const int tok = 24576 + rt * 16 + q * 4 + j; mbf[(size_t)tok * D + colb] = f2bf(msum[j]); }
    } else {
        const bf16_t* A = (const bf16_t*)(p.ws + WS_H) + (size_t)row * D + q * 8; const bf16_t* B = (const bf16_t*)(p.ws + WS_BTO) + (size_t)colb * D + q * 8;
        float* z = (float*)(p.ws + WS_Z);
        f32x4 acc = (f32x4){0.f, 0.f, 0.f, 0.f};
        for (int k0 = 0; k0 < 64; k0 += 8) { bf16x8 av[8], bv[8];
#pragma unroll
            for (int i = 0; i < 8; ++i) { av[i] = *(const bf16x8*)(A + (k0 + i) * 32); bv[i] = *(const bf16x8*)(B + (k0 + i) * 32); }
#pragma unroll
            for (int i = 0; i < 8; ++i) acc = __builtin_amdgcn_mfma_f32_16x16x32_bf16(av[i], bv[i], acc, 0, 0, 0); }
#pragma unroll
        for (int j = 0; j < 4; ++j) { const int tok = 24576 + rt * 16 + q * 4 + j; const float res = first ? src_row(p, tok)[colb] : z[(size_t)tok * D + colb]; z[(size_t)tok * D + colb] = res + acc[j]; }
    }
    }
}

#define XB_TMO      128
#define XB_XCNT(j)  (256  + 64 * (j))
#define XB_XSUB(j)  (1280 + 64 * (j))
#define XB_XGEN(j)  (2304 + 64 * (j))
#define XB_TOP      3328
#define XB_TOPGEN   3392
#define XCD_BAR_WORDS 3456
#define XB_SPIN_CAP (1u << 18)
__device__ __forceinline__ unsigned xb_ld(unsigned* p)              { return __hip_atomic_load(p, __ATOMIC_RELAXED, __HIP_MEMORY_SCOPE_AGENT); }
__device__ __forceinline__ unsigned xb_add(unsigned* p, unsigned v) { return __hip_atomic_fetch_add(p, v, __ATOMIC_RELAXED, __HIP_MEMORY_SCOPE_AGENT); }
__device__ __forceinline__ unsigned xb_xcc_id() { return (unsigned)__builtin_amdgcn_s_getreg((3 << 11) | 20) & 0xFu; }
#define XB_SPIN(cond, bar) do { unsigned _sp = 0; while (cond) { __builtin_amdgcn_s_sleep(1); \
    if ((++_sp & 255u) == 0u) { if (xb_ld(&(bar)[XB_TMO])) break; if (_sp > XB_SPIN_CAP) { atomicAdd(&(bar)[XB_TMO], 1u); break; } } } } while (0)
struct XcdBarrier { unsigned* bar; unsigned x; volatile LAS unsigned* st; };
__device__ __forceinline__ XcdBarrier xcd_barrier_post(unsigned* bar, volatile LAS unsigned* st) {
    XcdBarrier b; b.bar = bar; b.x = xb_xcc_id(); b.st = st;
    if (threadIdx.x == 0) (void)xb_add(&bar[XB_XCNT(b.x)], 1u);
    return b;
}
__device__ __forceinline__ void xcd_barrier_complete(unsigned* bar, unsigned x, unsigned& nloc, unsigned& nx) {
    const unsigned G = gridDim.x * gridDim.y * gridDim.z;
    unsigned sum, cnt, mine, sp = 0u;
    for (;;) {
        sum = 0u; cnt = 0u; mine = 0u;
#pragma unroll
        for (unsigned j = 0; j < 16; ++j) { const unsigned c = xb_ld(&bar[XB_XCNT(j)]); sum += c; cnt += (c > 0u) ? 1u : 0u; mine = (j == x) ? c : mine; }
        if (sum == G) break;
        __builtin_amdgcn_s_sleep(1);
        if ((++sp & 255u) == 0u) { if (xb_ld(&bar[XB_TMO])) break; if (sp > XB_SPIN_CAP) { atomicAdd(&bar[XB_TMO], 1u); break; } }
    }
    nloc = mine > 0u ? mine : 1u; nx = cnt > 0u ? cnt : 1u;
}
__device__ __forceinline__ void xcd_barrier(const XcdBarrier& b) {
    asm volatile("s_waitcnt vmcnt(0)" ::: "memory");
    __syncthreads();
    if (threadIdx.x == 0) {
        unsigned* bar = b.bar;
        __builtin_amdgcn_s_waitcnt(0);
        unsigned nloc = b.st[0], nx = b.st[1];
        if (nloc == 0u) { xcd_barrier_complete(bar, b.x, nloc, nx); b.st[0] = nloc; b.st[1] = nx; }
        const unsigned old = xb_add(&bar[XB_XSUB(b.x)], 1u);
        const unsigned gen = old / nloc;
        if (old + 1u == (gen + 1u) * nloc) {
            __builtin_amdgcn_fence(__ATOMIC_RELEASE, "agent");
            asm volatile("s_waitcnt vmcnt(0)" ::: "memory");
            const unsigned og = xb_add(&bar[XB_TOP], 1u);
            const unsigned tg = og / nx;
            if (og + 1u == (tg + 1u) * nx) xb_add(&bar[XB_TOPGEN], 1u);
            else XB_SPIN(xb_ld(&bar[XB_TOPGEN]) == tg, bar);
            __builtin_amdgcn_fence(__ATOMIC_ACQUIRE, "agent");
            xb_add(&bar[XB_XGEN(b.x)], 1u);
            asm volatile("s_waitcnt vmcnt(0)" ::: "memory");
        } else {
            XB_SPIN(xb_ld(&bar[XB_XGEN(b.x)]) == gen, bar);
            __builtin_amdgcn_fence(__ATOMIC_ACQUIRE, "agent");
            asm volatile("s_waitcnt vmcnt(0)" ::: "memory");
        }
    }
    __syncthreads();
}

__global__ void __launch_bounds__(512) fwd_megakernel(Params p_in) {
    extern __shared__ __attribute__((aligned(16))) unsigned char smem[];
    LAS unsigned char* lds = (LAS unsigned char*)smem;
    cg::grid_group grid = cg::this_grid();
    const int G = gridDim.x;
    const Params& p0 = p_in;
    volatile LAS unsigned* stw = (volatile LAS unsigned*)(lds + 150528);
    if (threadIdx.x == 0) { stw[0] = 0u; stw[1] = 0u; }
    __syncthreads();
    const XcdBarrier xb = xcd_barrier_post((unsigned*)(p_in.ws + WS_BAR), stw);
    for (int ph = p0.ph_lo; ph < p0.ph_hi; ++ph) {
        const int reps_ = (ph < 32 && (ph & 7) == DUP) ? 2 : 1;
        for (int rep_ = 0; rep_ < reps_; ++rep_) {
        int TID = threadIdx.x; asm volatile("" : "+v"(TID));
        int b = blockIdx.x; asm volatile("" : "+s"(b));
        Params p = p0; { unsigned long long t_ = (unsigned long long)p.ws; asm volatile("" : "+s"(t_)); p.ws = (unsigned char*)t_; }
        const char* ws = (const char*)p.ws;
        if (ph == 32) { final_norm_phase(TID, b, p); }
        else {
            const int l = ph >> 3, k = ph & 7;
            if (k == 0 && (PHM & 1)) { rmsnorm_phase(TID, b, p, l); convert_weights(TID, b, p, l, (LAS float*)lds); if (l == 0) s5_tables_all(TID, b, p); }
            else if (k == 1 && (PHM & 2)) {
                TileOrder S; S.nM = MP / 256; S.nN = NINP / 256; S.nwg = S.nM * S.nN; S.G = G; S.c = b; S.mult = 1; S.nt0 = D / 64; S.A = ws + WS_H; S.B = ws + WS_BTIN; S.tA = (size_t)256 * D * 2; S.tB = (size_t)256 * D * 2;
                EpiIn E; E.cols = (bf16_t*)(p.ws + WS_COLS); E.ubuf = (bf16_t*)(p.ws + WS_UBUF);
                gemm_phase(TID, lds, D, D, S, E);
                s5_assemble_a(TID, b, p, l);
            } else if (k == 2 && (PHM & 4)) {
                GroupOrder S; S.G = G; S.c = b; S.nt0 = 4; S.A = ws + WS_UBUF; S.B = ws + WS_PMAT; S.gsA = (size_t)CHP * 512 * 2; S.gsB = (size_t)256 * 256 * 2; S.tA = (size_t)256 * 512 * 2;
                EpiS5State E; E.st = (float*)(p.ws + WS_ST);
                if (SUBM & 4) gemm_phase(TID, lds, 512, 256, S, E);
                __syncthreads();
                { const int head_ = ((b + 128) % G) & 3, kk_ = TID & 63; float wg_[2][16], bg_[2];
                  _Pragma("unroll") for (int d = 0; d < 2; ++d) { bg_[d] = p.in[16][(l * 2 + d) * 256 + head_ * 64 + kk_]; _Pragma("unroll") for (int j = 0; j < 16; ++j) wg_[d][j] = p.in[15][((size_t)(l * 2 + d) * 16 + j) * 256 + head_ * 64 + kk_]; }
                  float ng_[16]; _Pragma("unroll") for (int e = 0; e < 16; ++e) ng_[e] = p.in[17][l * 512 + head_ * 128 + (TID & 7) * 16 + e];
                  for (int it = (b + 128) % G; it < NCK * 4; it += G) gla_item<0>(TID, p, l, it >> 2, it & 3, lds, wg_, bg_, ng_); }
                lru_phase<0>(TID, b, G, p, l, lds);
                s5_assemble_w(TID, b, p, l);
            } else if (k == 3 && (PHM & 8)) { scans_phase(TID, b, p, l, rep_ == 0); }
            else if (k == 4 && (PHM & 16)) {
                GroupOrder S; S.G = G; S.c = b; S.nt0 = 8; S.A = ws + WS_UBUF; S.B = ws + WS_WMAT; S.gsA = (size_t)CHP * 512 * 2; S.gsB = (size_t)256 * 512 * 2; S.tA = (size_t)256 * 512 * 2;
                EpiS5Out E; E.zs5 = (bf16_t*)(p.ws + WS_ZS5);
                if (SUBM & 4) gemm_phase(TID, lds, 512, 512, S, E);
                __syncthreads();
                { const int head_ = ((b + 128) % G) & 3, kk_ = TID & 63; float wg_[2][16], bg_[2];
                  _Pragma("unroll") for (int d = 0; d < 2; ++d) { bg_[d] = p.in[16][(l * 2 + d) * 256 + head_ * 64 + kk_]; _Pragma("unroll") for (int j = 0; j < 16; ++j) wg_[d][j] = p.in[15][((size_t)(l * 2 + d) * 16 + j) * 256 + head_ * 64 + kk_]; }
                  float ng_[16]; _Pragma("unroll") for (int e = 0; e < 16; ++e) ng_[e] = p.in[17][l * 512 + head_ * 128 + (TID & 7) * 16 + e];
                  for (int it = (b + 128) % G; it < NCK * 4; it += G) gla_item<1>(TID, p, l, it >> 2, it & 3, lds, wg_, bg_, ng_); }
                lru_phase<1>(TID, b, G, p, l, lds);
            } else if (k == 5 && (PHM & 32)) {
                TileOrder S; S.nM = MP / 256; S.nN = 2; S.nwg = S.nM * S.nN; S.G = G; S.c = b; S.mult = 1; S.nt0 = 8; S.A = ws + WS_ZS5; S.B = ws + WS_BTGLU; S.tA = (size_t)256 * 512 * 2; S.tB = (size_t)256 * 512 * 2;
                EpiGlu E; E.zs5 = (const bf16_t*)(p.ws + WS_ZS5); E.cols = (const bf16_t*)(p.ws + WS_COLS); E.bglu = p.in[14] + l * 512; E.yall = (bf16_t*)(p.ws + WS_YALL);
                gemm_phase(TID, lds, 512, 512, S, E);
            } else if (k == 6 && (PHM & 64)) {
                TileOrder S; S.nM = 96; S.nN = 8; S.nwg = S.nM * S.nN; S.G = G; S.c = b; S.mult = 3; S.nt0 = 8; S.A = ws + WS_YALL; S.B = ws + WS_BTOUT; S.tA = (size_t)256 * D * 2; S.tB = (size_t)256 * D * 2;
                EpiOut E; E.cols = (const bf16_t*)(p.ws + WS_COLS); E.mbf = (bf16_t*)(p.ws + WS_H);
                gemm_phase(TID, lds, D, D, S, E);
                skinny_tail<0>(TID, b, p, 0);
            } else if (PHM & 128) {
                TileOrder S; S.nM = 96; S.nN = 8; S.nwg = S.nM * S.nN; S.G = G; S.c = b; S.mult = 1; S.nt0 = D / 64; S.A = ws + WS_H; S.B = ws + WS_BTO; S.tA = (size_t)256 * D * 2; S.tB = (size_t)256 * D * 2;
                EpiWo E; E.z = (float*)(p.ws + WS_Z); E.pp = &p; E.first = (l == 0);
                gemm_phase(TID, lds, D, D, S, E);
                skinny_tail<1>(TID, b, p, l == 0);
            }
        }
        }
        if (p0.use_sync && ph + 1 < p0.ph_hi) { if (ph == p0.ph_lo) grid.sync(); else xcd_barrier(xb); }
    }
}

extern "C" void kernel_launch(void* const* d_in, const int* in_sizes, int n_in, void* d_out, int out_size, void* d_ws, size_t ws_size, hipStream_t stream) {
    static int grid = 0, coop = 1;
    if (grid == 0) {
        if (n_in != 30 || ws_size < WS_END3) { fprintf(stderr, "kernel_launch: unexpected n_in %d or ws_size %zu (< %zu)\n", n_in, ws_size, (size_t)WS_END); grid = -1; return; }
        int dev = 0, cus = 0, per_cu = 0;
        (void)hipGetDevice(&dev); (void)hipDeviceGetAttribute(&cus, hipDeviceAttributeMultiprocessorCount, dev);
        if (hipFuncSetAttribute((const void*)fwd_megakernel, hipFuncAttributeMaxDynamicSharedMemorySize, LDS_BYTES) != hipSuccess) { fprintf(stderr, "kernel_launch: hipFuncSetAttribute failed\n"); grid = -1; return; }
        if (hipOccupancyMaxActiveBlocksPerMultiprocessor(&per_cu, (const void*)fwd_megakernel, 512, LDS_BYTES) != hipSuccess || per_cu < 1) { fprintf(stderr, "kernel_launch: occupancy query gave %d\n", per_cu); per_cu = 1; }
        (void)hipGetLastError();
        grid = cus * 1;
    }
    if (grid < 0) return;
    Params p{};
    for (int i = 0; i < 30; ++i) p.in[i] = (const float*)d_in[i];
    p.out = (float*)d_out; p.ws = (unsigned char*)d_ws; p.pad = 0;
    (void)hipMemsetAsync((char*)d_ws + WS_BAR, 0, 3456 * 4, stream);
    if (coop) {
        p.ph_lo = 0; p.ph_hi = 33; p.use_sync = 1;
        void* args[] = {&p};
        hipError_t e = hipLaunchCooperativeKernel((const void*)fwd_megakernel, dim3(grid), dim3(512), args, LDS_BYTES, stream);
        if (e == hipSuccess) return;
        fprintf(stderr, "kernel_launch: cooperative launch failed: %s (grid %d); falling back to one launch per phase\n", hipGetErrorString(e), grid);
        (void)hipGetLastError(); coop = 0;
    }
    for (int ph = 0; ph < 33; ++ph) { p.ph_lo = ph; p.ph_hi = ph + 1; p.use_sync = 0; hipLaunchKernelGGL(fwd_megakernel, dim3(grid), dim3(512), LDS_BYTES, stream, p); }
}
```

```cpp
#include <hip/hip_runtime.h>
#include <hip/hip_cooperative_groups.h>
#include <cstdio>
namespace cg = cooperative_groups;
#define LAS __attribute__((address_space(3)))
typedef unsigned short bf16_t;
typedef short bf16x8 __attribute__((ext_vector_type(8)));
typedef float f32x4 __attribute__((ext_vector_type(4)));
typedef float f32x2 __attribute__((ext_vector_type(2)));
typedef unsigned u32x2 __attribute__((ext_vector_type(2)));
typedef unsigned u32x4 __attribute__((ext_vector_type(4)));

constexpr int D = 2048, NTOK = 24736, MP = 24832, NINP = 11008, NIN = 10784;
constexpr int NCH16 = 1546, CHP = 1792, NCK = 394;
constexpr int C_GA = 512, C_Q = 1024, C_K = 1280, C_V = 1536, C_GB = 2048, C_XC = 2560, C_GC = 3584, C_MG = 4608, C_GLR = 10752;
constexpr int LDS_BYTES = 150528 + 16;
#ifndef SYNCREP
#define SYNCREP 1
#endif
#ifndef DUP
#define DUP -1
#endif
#ifndef SUBM
#define SUBM 7
#endif
#ifndef PHM
#define PHM 255
#endif

constexpr size_t al256(size_t x) { return (x + 255) & ~(size_t)255; }
constexpr size_t WS_Z = 0;
constexpr size_t WS_H = WS_Z + al256((size_t)MP * D * 4);
constexpr size_t WS_COLS = WS_H + al256((size_t)MP * D * 2);
constexpr size_t WS_YALL = WS_COLS + al256((size_t)MP * NINP * 2);
constexpr size_t WS_ZS5 = WS_YALL + al256((size_t)MP * D * 2);
constexpr size_t WS_UBUF = WS_ZS5 + al256((size_t)MP * 512 * 2);
constexpr size_t WS_ST = WS_UBUF + al256((size_t)32 * CHP * 512 * 2);
constexpr size_t WS_DS = WS_ST + al256((size_t)32 * CHP * 256 * 4);
constexpr size_t WS_M32 = WS_UBUF;
constexpr size_t WS_DECAY = WS_DS + al256((size_t)NCK * 4 * 2 * 8192 * 4);
constexpr size_t WS_LRUA = WS_DECAY + al256((size_t)NCK * 4 * 2 * 64 * 4);
constexpr size_t WS_LRUH = WS_LRUA + al256((size_t)NCK * 2 * 1024 * 4);
constexpr size_t WS_LRUC = WS_LRUH + al256((size_t)NCK * 2 * 1024 * 4);
constexpr size_t WS_PW = WS_LRUC + al256((size_t)NCK * 2 * 1024 * 4);
constexpr size_t WS_BBAR = WS_PW + al256((size_t)4 * 32 * 2 * 17 * 64 * 8);
constexpr size_t WS_WMAT = WS_BBAR + al256((size_t)4 * 32 * 2 * 64 * 16 * 8);
constexpr size_t WS_PMAT = WS_WMAT + al256((size_t)32 * 256 * 512 * 2);
constexpr size_t WS_BTIN = WS_PMAT + al256((size_t)32 * 256 * 256 * 2);
constexpr size_t WS_BTOUT = WS_BTIN + al256((size_t)NINP * D * 2);
constexpr size_t WS_BTO = WS_BTOUT + al256((size_t)D * D * 2);
constexpr size_t WS_BTGLU = WS_BTO + al256((size_t)D * D * 2);
constexpr size_t WS_BTLRU = WS_BTGLU + al256((size_t)512 * 512 * 2);
constexpr size_t WS_KMAT = WS_BTLRU + al256((size_t)32 * 128 * 128 * 2);
constexpr size_t WS_BAR = WS_KMAT + al256((size_t)32 * 2 * 16 * 256 * 4);
constexpr size_t WS_END = WS_BAR + al256((size_t)3456 * 4);
constexpr size_t WS_GB = WS_END;
constexpr size_t WS_END2 = WS_GB + al256((size_t)NCK * 4 * 8192 * 4);
constexpr size_t WS_SPB = WS_END2;
constexpr size_t WS_END3 = WS_SPB + al256((size_t)NCK * 4 * 2 * 8192 * 2);
constexpr size_t PWL = (size_t)32 * 2 * 17 * 64, BBL = (size_t)32 * 2 * 64 * 16;
static_assert(WS_END3 <= (size_t)1413480448, "workspace too large");
static_assert((size_t)MP * D * 4 <= WS_DECAY - WS_UBUF, "m32 alias too small");

struct Params { const float* in[30]; float* out; unsigned char* ws; int ph_lo, ph_hi, use_sync, pad; };

#define LBAR() do { asm volatile("s_waitcnt lgkmcnt(0)" ::: "memory"); __builtin_amdgcn_s_barrier(); asm volatile("" ::: "memory"); } while (0)
__device__ __forceinline__ unsigned cvt_pk_bf16(float lo, float hi) { unsigned r; asm volatile("v_cvt_pk_bf16_f32 %0, %1, %2" : "=v"(r) : "v"(lo), "v"(hi)); return r; }
__device__ __forceinline__ bf16_t f2bf(float f) { return (bf16_t)(cvt_pk_bf16(f, 0.f) & 0xffffu); }
__device__ __forceinline__ bf16_t f2bf_sw(float f) { unsigned u = __float_as_uint(f); u += 0x7FFFu + ((u >> 16) & 1u); return (bf16_t)(u >> 16); }
__device__ __forceinline__ float bf2f(bf16_t b) { return __uint_as_float(((unsigned)b) << 16); }
__device__ __forceinline__ float bflo(unsigned w) { return __uint_as_float(w << 16); }
__device__ __forceinline__ float bfhi(unsigned w) { return __uint_as_float(w & 0xffff0000u); }
__device__ __forceinline__ float sigm(float x) { return __builtin_amdgcn_rcpf(1.0f + __expf(-x)); }
__device__ __forceinline__ float silu(float x) { return x * sigm(x); }
__device__ __forceinline__ float gelu_t(float x) { const float u = 0.7978845608028654f * (x + 0.044715f * x * x * x); return x * sigm(2.0f * u); }
__device__ __forceinline__ float logsig(float x) { return -(fmaxf(-x, 0.f) + __logf(1.0f + __expf(-fabsf(x)))); }

__device__ __forceinline__ int seq_start(int s) { return s < 2 ? s * 4112 : 8224 + (s - 2) * 2064; }
__device__ __forceinline__ int seq_len(int s) { return s < 2 ? 4112 : 2064; }
__device__ __forceinline__ void chunk_info(int ci, int& seq, int& c) { if (ci < 130) { seq = ci / 65; c = ci - seq * 65; } else { const int t = ci - 130; const int q = t / 33; seq = 2 + q; c = t - q * 33; } }

constexpr int BM = 256, BK = 64, HALF = 128, HTB = HALF * BK * 2, STAGE_BYTES = 8 * HTB, NXCD = 8, WGM = 8;
__device__ __forceinline__ int lds_byte(int r, int c) { const int st = (r >> 4) * 2 + (c >> 5), rr = r & 15, cc = c & 31, ob = rr * 64 + cc * 2; return st * 1024 + (ob ^ (((ob >> 9) & 1) << 5)); }
__device__ __forceinline__ void stage_rc(int b, int& R, int& C) { const int st = b / 1024, sb = b % 1024, swz = sb ^ (((sb >> 9) & 1) << 5); R = (st >> 1) * 16 + swz / 64; C = (st & 1) * 32 + (swz % 64) / 2; }

struct Unit { int pm, pn, sub, nt; const char* a; const char* b; };

struct TileOrder {
    int nM, nN, nwg, G, c, mult, nt0; const char* A; const char* B; size_t tA, tB;
    __device__ __forceinline__ bool next(int i, Unit& u) const {
        const int ti = i / mult, sub = i - ti * mult;
        const long L = (long)ti * G + c; if (L >= nwg) return false;
        int wgid = (int)L; { const int q = nwg / NXCD, r = nwg % NXCD, xcd = wgid % NXCD, off = wgid / NXCD; wgid = (xcd < r ? xcd * (q + 1) : r * (q + 1) + (xcd - r) * q) + off; }
        const int nig = WGM * nN, gid = wgid / nig, fm = gid * WGM, gsz = (nM - fm) < WGM ? (nM - fm) : WGM;
        u.pm = fm + ((wgid % nig) % gsz); u.pn = (wgid % nig) / gsz; u.sub = sub;
        const int koff = (mult == 3) ? sub * 512 : 0; u.nt = (mult == 3) ? (sub == 2 ? 16 : 8) : nt0;
        u.a = A + (size_t)u.pm * tA + (size_t)koff * 2; u.b = B + (size_t)u.pn * tB + (size_t)koff * 2; return true;
    }
};
struct GroupOrder {
    int G, c, nt0; const char* A; const char* B; size_t gsA, gsB, tA;
    __device__ __forceinline__ bool next(int i, Unit& u) const {
        const int L = i * G + c; if (L >= 224) return false;
        const int g = L / 7, pm = L - g * 7; u.pm = pm; u.pn = 0; u.sub = g; u.nt = nt0;
        u.a = A + (size_t)g * gsA + (size_t)pm * tA; u.b = B + (size_t)g * gsB; return true;
    }
};

__device__ __forceinline__ int perm32(int rho) { const int n = rho >> 4, i = rho & 15; return 8 * (i >> 2) + 4 * n + (i & 3); }
template <class Epi, class Sched>
__device__ __forceinline__ void gemm_phase(const int TID, LAS unsigned char* lds, const int lda, const int ldb, const Sched& S, const Epi& E) {
    const int tid = TID, wid = __builtin_amdgcn_readfirstlane(tid >> 6), lane = tid & 63, wr = wid >> 2, wc = wid & 3, fr = lane & 15, fq = lane >> 4;
    unsigned voffA[2], voffB[2];
#pragma unroll
    for (int i = 0; i < 2; ++i) { int R, C; stage_rc(tid * 16 + i * 8192, R, C); const int Rb = Epi::PERM ? ((R & ~31) + perm32(R & 31)) : R; voffA[i] = (unsigned)(R * lda + C) * 2u; voffB[i] = (unsigned)(Rb * ldb + C) * 2u; }
    const size_t kstep = (size_t)(BK * 2);
    const size_t hA = (size_t)HALF * lda * 2, hB = (size_t)HALF * ldb * 2;
    const unsigned ldsw = (unsigned)wid * 1024u;
    const int aoff = lds_byte(wr * 64 + fr, fq * 8), boff = lds_byte(wc * 32 + fr, fq * 8);
#define PG8_SA(b, h) (((b) * 2 + (h)) * HTB)
#define PG8_SB(b, h) ((4 + (b) * 2 + (h)) * HTB)
#define PG8_STAGE(bufoff, gbase, voff) do { _Pragma("unroll") for (int _i = 0; _i < 2; ++_i) \
        __builtin_amdgcn_global_load_lds((const unsigned*)((const char*)(gbase) + (voff)[_i]), (LAS unsigned*)(lds + (bufoff) + ldsw + _i * 8192), 16, 0, 0); } while (0)
#define PG8_LDA(dst, b, h) do { _Pragma("unroll") for (int m = 0; m < 4; ++m) _Pragma("unroll") for (int k = 0; k < 2; ++k) dst[m][k] = *(const LAS bf16x8*)(lds + PG8_SA(b, h) + aoff + m * 2048 + k * 1024); } while (0)
#define PG8_LDB(dst, b, h) do { _Pragma("unroll") for (int n = 0; n < 2; ++n) _Pragma("unroll") for (int k = 0; k < 2; ++k) dst[n][k] = *(const LAS bf16x8*)(lds + PG8_SB(b, h) + boff + n * 2048 + k * 1024); } while (0)
#define PG8_MMA(ai, bj, At, Bt) do { __builtin_amdgcn_s_setprio(1); _Pragma("unroll") for (int m = 0; m < 4; ++m) _Pragma("unroll") for (int n = 0; n < 2; ++n) _Pragma("unroll") for (int k = 0; k < 2; ++k) \
        acc[ai][bj][m][n] = __builtin_amdgcn_mfma_f32_16x16x32_bf16(Bt[n][k], At[m][k], acc[ai][bj][m][n], 0, 0, 0); __builtin_amdgcn_s_setprio(0); } while (0)
#define PG8_WAIT_V(n) asm volatile("s_waitcnt vmcnt(" #n ")" ::: "memory")
#define PG8_WAIT_L(n) asm volatile("s_waitcnt lgkmcnt(" #n ")" ::: "memory")
#define PG8_BAR __builtin_amdgcn_s_barrier()
#define PG8_SCHED __builtin_amdgcn_sched_barrier(0)
    Unit cur, nxt; int ui = 0;
    if (!S.next(0, cur)) return;
    f32x4 acc[2][2][4][2];
#pragma unroll
    for (int a = 0; a < 2; ++a)
#pragma unroll
        for (int b = 0; b < 2; ++b)
#pragma unroll
            for (int m = 0; m < 4; ++m)
#pragma unroll
                for (int n = 0; n < 2; ++n) acc[a][b][m][n] = (f32x4){0.f, 0.f, 0.f, 0.f};
    bf16x8 At[4][2], B0[2][2], B1[2][2];
    const char* cA = cur.a; const char* cB = cur.b;
    PG8_STAGE(PG8_SB(0, 0), cB, voffB); PG8_STAGE(PG8_SA(0, 0), cA, voffA); PG8_STAGE(PG8_SB(0, 1), cB + hB, voffB); PG8_STAGE(PG8_SA(0, 1), cA + hA, voffA);
    if (wr == 1) PG8_BAR;
    PG8_WAIT_V(4); PG8_BAR;
    PG8_STAGE(PG8_SB(1, 0), cB + kstep, voffB); PG8_STAGE(PG8_SA(1, 0), cA + kstep, voffA); PG8_STAGE(PG8_SB(1, 1), cB + hB + kstep, voffB);
    PG8_WAIT_V(6); PG8_BAR;
    for (;;) {
        const bool has_next = S.next(ui + 1, nxt);
        const char* nA = has_next ? nxt.a : cA; const char* nB = has_next ? nxt.b : cB;
        const int nt = cur.nt;
        for (int t = 0; t < nt; t += 2) {
            const bool last = (t == nt - 2);
            const char* a1 = cA + (size_t)(t + 1) * kstep;
            const char* a2 = last ? nA : cA + (size_t)(t + 2) * kstep; const char* b2 = last ? nB : cB + (size_t)(t + 2) * kstep;
            const char* a3 = a2 + kstep; const char* b3 = b2 + kstep;
            PG8_LDB(B0, 0, 0); PG8_SCHED; PG8_LDA(At, 0, 0); PG8_STAGE(PG8_SA(1, 1), a1 + hA, voffA);
            PG8_WAIT_L(8); PG8_BAR; PG8_WAIT_L(0); PG8_MMA(0, 0, At, B0); PG8_BAR; PG8_SCHED;
            PG8_LDB(B1, 0, 1); PG8_STAGE(PG8_SB(0, 0), b2, voffB);
            PG8_BAR; PG8_WAIT_L(0); PG8_MMA(0, 1, At, B1); PG8_BAR;
            PG8_LDA(At, 0, 1); PG8_STAGE(PG8_SA(0, 0), a2, voffA);
            PG8_BAR; PG8_WAIT_L(0); PG8_MMA(1, 0, At, B0); PG8_BAR; PG8_SCHED;
            PG8_STAGE(PG8_SB(0, 1), b2 + hB, voffB);
            PG8_WAIT_V(6); PG8_BAR; PG8_MMA(1, 1, At, B1); PG8_BAR;
            PG8_LDB(B0, 1, 0); PG8_SCHED; PG8_LDA(At, 1, 0); PG8_STAGE(PG8_SA(0, 1), a2 + hA, voffA);
            PG8_WAIT_L(8); PG8_BAR; PG8_WAIT_L(0); PG8_MMA(0, 0, At, B0); PG8_BAR; PG8_SCHED;
            PG8_LDB(B1, 1, 1); PG8_STAGE(PG8_SB(1, 0), b3, voffB);
            PG8_BAR; PG8_WAIT_L(0); PG8_MMA(0, 1, At, B1); PG8_BAR;
            PG8_LDA(At, 1, 1); PG8_STAGE(PG8_SA(1, 0), a3, voffA);
            PG8_BAR; PG8_WAIT_L(0); PG8_MMA(1, 0, At, B0); PG8_BAR; PG8_SCHED;
            PG8_STAGE(PG8_SB(1, 1), b3 + hB, voffB);
            PG8_WAIT_V(6); PG8_BAR; PG8_MMA(1, 1, At, B1); PG8_BAR;
        }
        E(acc, cur, wr, wc, fr, fq);
        if (!has_next) break;
#pragma unroll
        for (int a = 0; a < 2; ++a)
#pragma unroll
            for (int b = 0; b < 2; ++b)
#pragma unroll
                for (int m = 0; m < 4; ++m)
#pragma unroll
                    for (int n = 0; n < 2; ++n) acc[a][b][m][n] = (f32x4){0.f, 0.f, 0.f, 0.f};
        cur = nxt; cA = nA; cB = nB; ++ui;
    }
    PG8_WAIT_V(0);
    if (wr == 0) PG8_BAR;
    PG8_BAR;
#undef PG8_SA
#undef PG8_SB
#undef PG8_STAGE
#undef PG8_LDA
#undef PG8_LDB
#undef PG8_MMA
#undef PG8_WAIT_V
#undef PG8_WAIT_L
#undef PG8_BAR
#undef PG8_SCHED
}

#define EPI_LOOP(...) \
    const int row0 = u.pm * BM + wr * 64 + fr, col0 = u.pn * BM + wc * 32 + 4 * fq; \
    _Pragma("unroll") for (int ai = 0; ai < 2; ++ai) _Pragma("unroll") for (int m = 0; m < 4; ++m) { const int r = row0 + ai * HALF + m * 16; \
        _Pragma("unroll") for (int bj = 0; bj < 2; ++bj) _Pragma("unroll") for (int n = 0; n < 2; ++n) { const int c = col0 + bj * HALF + n * 16; const f32x4 v = acc[ai][bj][m][n]; __VA_ARGS__ } }

#define EPI_PROWS(...) \
    const int row0 = u.pm * BM + wr * 64 + fr, col0 = u.pn * BM + wc * 32 + 8 * fq; \
    _Pragma("unroll") for (int ai = 0; ai < 2; ++ai) _Pragma("unroll") for (int m = 0; m < 4; ++m) { const int r = row0 + ai * HALF + m * 16; __VA_ARGS__ }
__device__ __forceinline__ u32x4 pack8(const f32x4 a, const f32x4 b) { u32x4 w; w[0] = cvt_pk_bf16(a[0], a[1]); w[1] = cvt_pk_bf16(a[2], a[3]); w[2] = cvt_pk_bf16(b[0], b[1]); w[3] = cvt_pk_bf16(b[2], b[3]); return w; }
__device__ __forceinline__ unsigned q8(float x) { return (unsigned)__float2uint_rn(sigm(x) * 255.0f); }
__device__ __forceinline__ unsigned q8x4(const f32x4 v) { return q8(v[0]) | (q8(v[1]) << 8) | (q8(v[2]) << 16) | (q8(v[3]) << 24); }
struct EpiIn { static constexpr bool PERM = true; bf16_t* cols; bf16_t* ubuf;
    __device__ __forceinline__ void operator()(const f32x4 (&acc)[2][2][4][2], const Unit& u, int wr, int wc, int fr, int fq) const {
        if (u.pn >= 18 && u.pn < 42) {
            EPI_PROWS({ u32x4 w; w[0] = q8x4(acc[ai][0][m][0]); w[1] = q8x4(acc[ai][0][m][1]); w[2] = q8x4(acc[ai][1][m][0]); w[3] = q8x4(acc[ai][1][m][1]);
                *(u32x4*)((unsigned char*)(cols + (size_t)r * NINP + C_MG) + (u.pn - 18) * 256 + (wc * 4 + fq) * 16) = w; })
        } else {
            EPI_PROWS({ _Pragma("unroll") for (int bj = 0; bj < 2; ++bj) { const int c = col0 + bj * HALF;
                bf16_t* dst = (u.pn < 2) ? ubuf + ((size_t)((c >> 4) * CHP + (r >> 4)) * 512 + (r & 15) * 16 + (c & 15)) : cols + (size_t)r * NINP + c;
                *(u32x4*)dst = pack8(acc[ai][bj][m][0], acc[ai][bj][m][1]); } })
        }
    } };
struct EpiS5State { static constexpr bool PERM = false; float* st;
    __device__ __forceinline__ void operator()(const f32x4 (&acc)[2][2][4][2], const Unit& u, int wr, int wc, int fr, int fq) const {
        EPI_LOOP({ u32x2 w; w.x = cvt_pk_bf16(v[0], v[1]); w.y = cvt_pk_bf16(v[2], v[3]); *(u32x2*)((bf16_t*)st + ((size_t)(u.sub * CHP + r)) * 256 + c) = w; })
    } };
struct EpiS5Out { static constexpr bool PERM = true; bf16_t* zs5;
    __device__ __forceinline__ void operator()(const f32x4 (&acc)[2][2][4][2], const Unit& u, int wr, int wc, int fr, int fq) const {
        EPI_PROWS({ if (r < NCH16) { _Pragma("unroll") for (int bj = 0; bj < 2; ++bj) { const int c = col0 + bj * HALF; f32x4 a = acc[ai][bj][m][0], b2 = acc[ai][bj][m][1];
            _Pragma("unroll") for (int e = 0; e < 4; ++e) { a[e] = gelu_t(a[e]); b2[e] = gelu_t(b2[e]); }
            *(u32x4*)(zs5 + (size_t)(r * 16 + (c >> 4)) * 512 + u.sub * 16 + (c & 15)) = pack8(a, b2); } } })
    } };
#define EPI_ROWS(...) \
    const int row0 = u.pm * BM + wr * 64 + fr, col0 = u.pn * BM + wc * 32 + 4 * fq; \
    _Pragma("unroll") for (int ai = 0; ai < 2; ++ai) _Pragma("unroll") for (int m = 0; m < 4; ++m) { const int r = row0 + ai * HALF + m * 16; __VA_ARGS__ }
#define QOFF(q) (((q) >> 1) * HALF + ((q) & 1) * 16)
#define EPI_PIPE(LOADF, COMPF) \
    const int row0 = u.pm * BM + wr * 64 + fr, col0 = u.pn * BM + wc * 32 + 8 * fq; \
    LOADF(0, 0); \
    _Pragma("unroll") for (int gi = 0; gi < 8; ++gi) { if (gi + 1 < 8) { if ((gi & 1) == 0) { LOADF(gi + 1, 1); } else { LOADF(gi + 1, 0); } } if ((gi & 1) == 0) { COMPF(gi, 0); } else { COMPF(gi, 1); } }
#define GROW(gi) (row0 + ((gi) >> 2) * HALF + ((gi) & 3) * 16)
struct EpiGlu { static constexpr bool PERM = true; const bf16_t* zs5; const bf16_t* cols; const float* bglu; bf16_t* yall;
    __device__ __forceinline__ void operator()(const f32x4 (&acc)[2][2][4][2], const Unit& u, int wr, int wc, int fr, int fq) const {
        u32x4 zz[2][2], gg[2][2]; f32x4 bb[2][2];
        { const int c0 = u.pn * BM + wc * 32 + 8 * fq; _Pragma("unroll") for (int bj = 0; bj < 2; ++bj) { bb[bj][0] = *(const f32x4*)(bglu + c0 + bj * HALF); bb[bj][1] = *(const f32x4*)(bglu + c0 + bj * HALF + 4); } }
#define GLU_LOAD(gi, bf) do { const int r_ = GROW(gi); _Pragma("unroll") for (int bj = 0; bj < 2; ++bj) { const int c = col0 + bj * HALF; zz[bf][bj] = *(const u32x4*)(zs5 + (size_t)r_ * 512 + c); gg[bf][bj] = *(const u32x4*)(cols + (size_t)r_ * NINP + C_GA + c); } } while (0)
#define GLU_COMP(gi, bf) do { const int r_ = GROW(gi); _Pragma("unroll") for (int bj = 0; bj < 2; ++bj) { const int c = col0 + bj * HALF; f32x4 o[2]; \
            _Pragma("unroll") for (int hf = 0; hf < 2; ++hf) { const f32x4 v = acc[(gi) >> 2][bj][(gi) & 3][hf]; \
                o[hf][0] = bflo(zz[bf][bj][2 * hf]) * sigm(v[0] + bb[bj][hf][0]) * silu(bflo(gg[bf][bj][2 * hf])); o[hf][1] = bfhi(zz[bf][bj][2 * hf]) * sigm(v[1] + bb[bj][hf][1]) * silu(bfhi(gg[bf][bj][2 * hf])); \
                o[hf][2] = bflo(zz[bf][bj][2 * hf + 1]) * sigm(v[2] + bb[bj][hf][2]) * silu(bflo(gg[bf][bj][2 * hf + 1])); o[hf][3] = bfhi(zz[bf][bj][2 * hf + 1]) * sigm(v[3] + bb[bj][hf][3]) * silu(bfhi(gg[bf][bj][2 * hf + 1])); } \
            *(u32x4*)(yall + (size_t)r_ * D + c) = pack8(o[0], o[1]); } } while (0)
        EPI_PIPE(GLU_LOAD, GLU_COMP)
#undef GLU_LOAD
#undef GLU_COMP
    } };
__device__ __forceinline__ float ub(unsigned w, int k) { return (float)((w >> (8 * k)) & 255u) * (1.0f / 255.0f); }
struct EpiOut { static constexpr bool PERM = true; const bf16_t* cols; bf16_t* mbf;
    __device__ __forceinline__ void operator()(const f32x4 (&acc)[2][2][4][2], const Unit& u, int wr, int wc, int fr, int fq) const {
        u32x4 gg[8], mm[2][2];
        { const int row0g = u.pm * BM + wr * 64 + fr;
#pragma unroll
          for (int gi = 0; gi < 8; ++gi) gg[gi] = *(const u32x4*)((const unsigned char*)(cols + (size_t)(row0g + (gi >> 2) * HALF + (gi & 3) * 16) * NINP + C_MG) + (u.sub * 8 + u.pn) * 256 + (wc * 4 + fq) * 16); }
#define OUT_LOAD(gi, bf) do { const int r_ = GROW(gi); const bf16_t* mp = mbf + (size_t)r_ * D + col0; \
            _Pragma("unroll") for (int bj = 0; bj < 2; ++bj) { mm[bf][bj] = (u32x4){0u, 0u, 0u, 0u}; if (u.sub != 0) mm[bf][bj] = *(const u32x4*)(mp + bj * HALF); } } while (0)
#define OUT_COMP(gi, bf) do { const int r_ = GROW(gi); bf16_t* mp = mbf + (size_t)r_ * D + col0; _Pragma("unroll") for (int bj = 0; bj < 2; ++bj) { f32x4 o[2]; \
            _Pragma("unroll") for (int hf = 0; hf < 2; ++hf) { const f32x4 v = acc[(gi) >> 2][bj][(gi) & 3][hf]; const unsigned gw = gg[gi][bj * 2 + hf]; \
                o[hf][0] = bflo(mm[bf][bj][2 * hf]) + ub(gw, 0) * v[0]; o[hf][1] = bfhi(mm[bf][bj][2 * hf]) + ub(gw, 1) * v[1]; \
                o[hf][2] = bflo(mm[bf][bj][2 * hf + 1]) + ub(gw, 2) * v[2]; o[hf][3] = bfhi(mm[bf][bj][2 * hf + 1]) + ub(gw, 3) * v[3]; } \
            *(u32x4*)(mp + bj * HALF) = pack8(o[0], o[1]); } } while (0)
        EPI_PIPE(OUT_LOAD, OUT_COMP)
#undef OUT_LOAD
#undef OUT_COMP
    } };
__device__ __forceinline__ const float* src_row(const Params& p, int r);
struct EpiWo { static constexpr bool PERM = false; float* z; const Params* pp; int first;
    __device__ __forceinline__ void operator()(const f32x4 (&acc)[2][2][4][2], const Unit& u, int wr, int wc, int fr, int fq) const {
        EPI_ROWS({ if (r < NTOK) { float* zp = z + (size_t)r * D + col0; const float* rp = first ? src_row(*pp, r) + col0 : zp; f32x4 pv[4];
            _Pragma("unroll") for (int q = 0; q < 4; ++q) pv[q] = *(const f32x4*)(rp + QOFF(q));
            _Pragma("unroll") for (int q = 0; q < 4; ++q) *(f32x4*)(zp + QOFF(q)) = pv[q] + acc[ai][q >> 1][m][q & 1]; } })
    } };

__device__ __forceinline__ const float* src_row(const Params& p, int r) {
    int s, pos; if (r < 8224) { s = r / 4112; pos = r - s * 4112; } else { const int t = r - 8224; const int q = t / 2064; s = 2 + q; pos = t - q * 2064; }
    if (pos < 16) return p.in[2] + (size_t)pos * D;
    return s < 2 ? p.in[0] + ((size_t)s * 4096 + (pos - 16)) * D : p.in[1] + ((size_t)(s - 2) * 2048 + (pos - 16)) * D;
}
__device__ __forceinline__ void rmsnorm_phase(const int TID, const int BID, const Params& p, int l) {
    float* z = (float*)(p.ws + WS_Z); bf16_t* h = (bf16_t*)(p.ws + WS_H); const float* g = p.in[3] + (size_t)l * D;
    const int lane = TID & 63, gw = BID * 8 + (TID >> 6), nw = gridDim.x * 8;
    f32x4 gg[8];
#pragma unroll
    for (int i = 0; i < 8; ++i) gg[i] = *(const f32x4*)(g + (i * 64 + lane) * 4);
    f32x4 xn[8];
    { const int r0 = gw < NTOK ? gw : NTOK - 1; const float* src = (l == 0) ? src_row(p, r0) : z + (size_t)r0 * D;
#pragma unroll
      for (int i = 0; i < 8; ++i) xn[i] = *(const f32x4*)(src + (i * 64 + lane) * 4); }
    for (int r = gw; r < MP; r += nw) {
        bf16_t* hr = h + (size_t)r * D;
        f32x4 x[8];
#pragma unroll
        for (int i = 0; i < 8; ++i) x[i] = xn[i];
        { const int rn = (r + nw < NTOK) ? r + nw : NTOK - 1; const float* src = (l == 0) ? src_row(p, rn) : z + (size_t)rn * D;
#pragma unroll
          for (int i = 0; i < 8; ++i) xn[i] = *(const f32x4*)(src + (i * 64 + lane) * 4); }
        if (r >= NTOK) { for (int i = 0; i < 4; ++i) *(u32x4*)(hr + (i * 64 + lane) * 8) = (u32x4){0u, 0u, 0u, 0u}; continue; }
        float ss = 0.f;
#pragma unroll
        for (int i = 0; i < 8; ++i) ss += x[i][0] * x[i][0] + x[i][1] * x[i][1] + x[i][2] * x[i][2] + x[i][3] * x[i][3];
#pragma unroll
        for (int o = 32; o >= 1; o >>= 1) ss += __shfl_xor(ss, o);
        const float rs = rsqrtf(ss * (1.0f / D) + 1e-6f);
#pragma unroll
        for (int i = 0; i < 8; ++i) { const int c = (i * 64 + lane) * 4;
            u32x2 w; w.x = cvt_pk_bf16(x[i][0] * rs * gg[i][0], x[i][1] * rs * gg[i][1]); w.y = cvt_pk_bf16(x[i][2] * rs * gg[i][2], x[i][3] * rs * gg[i][3]); *(u32x2*)(hr + c) = w; }
    }
}
__device__ __forceinline__ void final_norm_phase(const int TID, const int BID, const Params& p) {
    const float* z = (const float*)(p.ws + WS_Z); const float* g = p.in[29];
    const int lane = TID & 63, gw = BID * 8 + (TID >> 6), nw = gridDim.x * 8;
    f32x4 gg[8];
#pragma unroll
    for (int i = 0; i < 8; ++i) gg[i] = *(const f32x4*)(g + (i * 64 + lane) * 4);
    f32x4 xn[8];
    { const int r0 = gw < NTOK ? gw : NTOK - 1;
#pragma unroll
      for (int i = 0; i < 8; ++i) xn[i] = *(const f32x4*)(z + (size_t)r0 * D + (i * 64 + lane) * 4); }
    for (int r = gw; r < NTOK; r += nw) {
        f32x4 x[8];
#pragma unroll
        for (int i = 0; i < 8; ++i) x[i] = xn[i];
        { const int rn = (r + nw < NTOK) ? r + nw : NTOK - 1;
#pragma unroll
          for (int i = 0; i < 8; ++i) xn[i] = *(const f32x4*)(z + (size_t)rn * D + (i * 64 + lane) * 4); }
        int s, pos; if (r < 8224) { s = r / 4112; pos = r - s * 4112; } else { const int t = r - 8224; const int q = t / 2064; s = 2 + q; pos = t - q * 2064; }
        if (pos < 16) continue;
        float* dst = s < 2 ? p.out + ((size_t)s * 4096 + (pos - 16)) * D : p.out + (size_t)2 * 4096 * D + ((size_t)(s - 2) * 2048 + (pos - 16)) * D;
        float ss = 0.f;
#pragma unroll
        for (int i = 0; i < 8; ++i) ss += x[i][0] * x[i][0] + x[i][1] * x[i][1] + x[i][2] * x[i][2] + x[i][3] * x[i][3];
#pragma unroll
        for (int o = 32; o >= 1; o >>= 1) ss += __shfl_xor(ss, o);
        const float rs = rsqrtf(ss * (1.0f / D) + 1e-6f);
#pragma unroll
        for (int i = 0; i < 8; ++i) { const int c = (i * 64 + lane) * 4; f32x4 o; o[0] = x[i][0] * rs * gg[i][0]; o[1] = x[i][1] * rs * gg[i][1]; o[2] = x[i][2] * rs * gg[i][2]; o[3] = x[i][3] * rs * gg[i][3]; __builtin_nontemporal_store(o, (f32x4*)(dst + c)); }
    }
}
__device__ __forceinline__ void conv_tile(const int TID, const float* src, int ldn, int k0, int n0, int nvalid, bf16_t* dst, int ldd, int kofs, bool mapin, LAS float* tile) {
    const int tx = TID & 63, ty = TID >> 6;
    const int ncl = (n0 + tx < nvalid) ? n0 + tx : nvalid - 1;
#pragma unroll
    for (int i = 0; i < 8; ++i) { const int k = ty + 8 * i; tile[k * 65 + tx] = src[(size_t)(k0 + k) * ldn + ncl]; }
    __syncthreads();
#pragma unroll
    for (int i = 0; i < 8; ++i) { const int nn = ty + 8 * i; int n = n0 + nn;
        if (n < nvalid) { if (mapin) n = (n < 2560) ? n : (n < 2592 ? n + (C_GLR - 2560) : n - 32); dst[(size_t)n * ldd + kofs + k0 + tx] = f2bf(tile[tx * 65 + nn]); } }
    __syncthreads();
}
__device__ __forceinline__ void convert_weights(const int TID, const int BID, const Params& p, int l, LAS float* tile) {
    const int G = gridDim.x, b = BID;
    bf16_t* btin = (bf16_t*)(p.ws + WS_BTIN); bf16_t* btout = (bf16_t*)(p.ws + WS_BTOUT); bf16_t* bto = (bf16_t*)(p.ws + WS_BTO); bf16_t* btglu = (bf16_t*)(p.ws + WS_BTGLU); bf16_t* btlru = (bf16_t*)(p.ws + WS_BTLRU);
    { const float* src = p.in[4] + (size_t)l * D * NIN; const int tx = TID & 63, ty = TID >> 6; float v[8];
      { const int t = b < 32 * 169 ? b : 0; const int kt = t / 169, ntl = t - kt * 169; const int ncl = (ntl * 64 + tx < NIN) ? ntl * 64 + tx : NIN - 1;
#pragma unroll
        for (int i = 0; i < 8; ++i) v[i] = src[(size_t)(kt * 64 + ty + 8 * i) * NIN + ncl]; }
      for (int t = b; t < 32 * 169; t += G) { const int kt = t / 169, ntl = t - kt * 169, k0 = kt * 64, n0 = ntl * 64;
#pragma unroll
          for (int i = 0; i < 8; ++i) tile[(ty + 8 * i) * 65 + tx] = v[i];
          { const int tn = (t + G < 32 * 169) ? t + G : t; const int ktn = tn / 169, ntn = tn - ktn * 169; const int ncl = (ntn * 64 + tx < NIN) ? ntn * 64 + tx : NIN - 1;
#pragma unroll
            for (int i = 0; i < 8; ++i) v[i] = src[(size_t)(ktn * 64 + ty + 8 * i) * NIN + ncl]; }
          LBAR();
#pragma unroll
          for (int i = 0; i < 8; ++i) { const int nn = ty + 8 * i; int n = n0 + nn;
              if (n < NIN) { n = (n < 2560) ? n : (n < 2592 ? n + (C_GLR - 2560) : n - 32); btin[(size_t)n * D + k0 + tx] = f2bf(tile[tx * 65 + nn]); } }
          LBAR(); } }
    for (size_t i = (size_t)b * 512 + TID; i < (size_t)(NINP - NIN) * D / 8; i += (size_t)G * 512) *(u32x4*)(btin + (size_t)NIN * D + i * 8) = (u32x4){0u, 0u, 0u, 0u};
    { const float* src = p.in[25] + (size_t)l * 512 * D; for (int t = (b + 64) % G; t < 8 * 32; t += G) { const int kt = t / 32, ntl = t - kt * 32; conv_tile(TID, src, D, kt * 64, ntl * 64, D, btout, D, 0, false, tile); } }
    { const float* src = p.in[26] + (size_t)l * 512 * D; for (int t = (b + 128) % G; t < 8 * 32; t += G) { const int kt = t / 32, ntl = t - kt * 32; conv_tile(TID, src, D, kt * 64, ntl * 64, D, btout, D, 512, false, tile); } }
    { const float* src = p.in[27] + (size_t)l * 1024 * D; for (int t = b; t < 16 * 32; t += G) { const int kt = t / 32, ntl = t - kt * 32; conv_tile(TID, src, D, kt * 64, ntl * 64, D, btout, D, 1024, false, tile); } }
    { const float* src = p.in[28] + (size_t)l * D * D; for (int t = b; t < 32 * 32; t += G) { const int kt = t / 32, ntl = t - kt * 32; conv_tile(TID, src, D, kt * 64, ntl * 64, D, bto, D, 0, false, tile); } }
    { const float* src = p.in[13] + (size_t)l * 512 * 512; for (int t = (b + 192) % G; t < 8 * 8; t += G) { const int kt = t / 8, ntl = t - kt * 8; conv_tile(TID, src, 512, kt * 64, ntl * 64, 512, btglu, 512, 0, false, tile); } }
    for (int t = (b + 32) % G; t < 128; t += G) { const int mat = t >> 2, sub = t & 3;
        const int dk = mat >> 3, nb = mat & 7, d = dk >> 1, kind = dk & 1;
        const float* src = p.in[kind ? 22 : 20] + ((size_t)(l * 2 + d) * 8 + nb) * 128 * 128;
        conv_tile(TID, src, 128, (sub >> 1) * 64, (sub & 1) * 64, 128, btlru + (size_t)mat * 128 * 128, 128, 0, false, tile); }
}
__device__ __forceinline__ double exp_small(double x) { double s = 1.0, t = 1.0; for (int i = 1; i <= 14; ++i) { t *= x / (double)i; s += t; } return s; }
__device__ __forceinline__ double exp_neg(double x) { double e = exp_small(x * (1.0 / 64.0)); for (int i = 0; i < 6; ++i) e *= e; return e; }
__device__ __forceinline__ void s5_tables_all(const int TID, const int BID, const Params& p) {
    for (int vidx = (int)(gridDim.x - 1 - BID) * 512 + TID; vidx < 4 * 4096; vidx += gridDim.x * 512) {
        const int l = vidx >> 12, idx = vidx & 4095;
        f32x2* pw = (f32x2*)(p.ws + WS_PW) + l * PWL; f32x2* bbar = (f32x2*)(p.ws + WS_BBAR) + l * BBL;
        const int g = idx >> 7, d = (idx >> 6) & 1, n = idx & 63;
        const double dt = exp_neg((double)p.in[7][(l * 2 + d) * 32 + g]);
        const double lr = (double)p.in[5][((size_t)(l * 2 + d) * 32 + g) * 64 + n], li = (double)p.in[6][((size_t)(l * 2 + d) * 32 + g) * 64 + n];
        const double mag = exp_neg(lr * dt);
        double ang = li * dt; const double twopi = 6.283185307179586476925287; ang -= twopi * rint(ang / twopi);
        const double a8 = ang * 0.125, a2 = a8 * a8;
        double sn = a8, cs = 1.0, ts = a8, tc = 1.0;
        for (int i = 1; i <= 9; ++i) { tc *= -a2 / (double)((2 * i - 1) * (2 * i)); cs += tc; ts *= -a2 / (double)((2 * i) * (2 * i + 1)); sn += ts; }
        for (int i = 0; i < 3; ++i) { const double c2 = cs * cs - sn * sn, s2 = 2.0 * cs * sn; cs = c2; sn = s2; }
        const double abr = mag * cs, abi = mag * sn;
        double pr = 1.0, pi = 0.0;
        for (int j = 0; j <= 16; ++j) { pw[((size_t)(g * 2 + d) * 17 + j) * 64 + n] = (f32x2){(float)pr, (float)pi}; const double nr = pr * abr - pi * abi, ni = pr * abi + pi * abr; pr = nr; pi = ni; }
        const double den = lr * lr + li * li, fr = ((abr - 1.0) * lr + abi * li) / den, fi = (abi * lr - (abr - 1.0) * li) / den;
        float brf[16], bif[16];
#pragma unroll
        for (int c4 = 0; c4 < 4; ++c4) { const f32x4 t0 = *(const f32x4*)(p.in[8] + (((size_t)l * 32 + g) * 64 + n) * 16 + c4 * 4), t1 = *(const f32x4*)(p.in[9] + (((size_t)l * 32 + g) * 64 + n) * 16 + c4 * 4);
#pragma unroll
            for (int e = 0; e < 4; ++e) { brf[c4 * 4 + e] = t0[e]; bif[c4 * 4 + e] = t1[e]; } }
#pragma unroll
        for (int c = 0; c < 16; ++c) { const double br = (double)brf[c], bi = (double)bif[c];
            bbar[((size_t)(g * 2 + d) * 64 + n) * 16 + c] = (f32x2){(float)(fr * br - fi * bi), (float)(fr * bi + fi * br)}; }
    }
}
__device__ __forceinline__ float s5_kval(const float* cre, const float* cim, const f32x2* pw, const f32x2* bbar, int l, int g, int d, int j, int c, int cp) {
    const float* cr = cre + (((size_t)(l * 2 + d) * 32 + g) * 16 + c) * 64; const float* ci = cim + (((size_t)(l * 2 + d) * 32 + g) * 16 + c) * 64;
    const f32x2* pp = pw + ((size_t)(g * 2 + d) * 17 + j) * 64; const f32x2* bb = bbar + ((size_t)(g * 2 + d) * 64) * 16 + cp;
    float s = 0.f;
#pragma unroll 16
    for (int n = 0; n < 64; ++n) { const f32x2 pv = pp[n]; const f32x2 bv = bb[(size_t)n * 16]; const float er = cr[n] * pv.x - ci[n] * pv.y, ei = cr[n] * pv.y + ci[n] * pv.x; s += er * bv.x - ei * bv.y; }
    return s;
}
__device__ __forceinline__ void s5_assemble_a(const int TID, const int BID, const Params& p, int l) {
    const f32x2* pw = (const f32x2*)(p.ws + WS_PW) + l * PWL; const f32x2* bbar = (const f32x2*)(p.ws + WS_BBAR) + l * BBL;
    float* kmat = (float*)(p.ws + WS_KMAT); bf16_t* pmat = (bf16_t*)(p.ws + WS_PMAT);
    const float* cre = p.in[10]; const float* cim = p.in[11];
    const size_t stride = (size_t)gridDim.x * 512;
    for (size_t idx = (size_t)BID * 512 + TID; idx < (size_t)32 * 2 * 16 * 256; idx += stride) {
        const int g = (int)(idx >> 13), d = (int)(idx >> 12) & 1, j = (int)(idx >> 8) & 15, c = (int)(idx >> 4) & 15, cp = (int)idx & 15;
        kmat[idx] = s5_kval(cre, cim, pw, bbar, l, g, d, j, c, cp);
    }
    for (size_t idx = (size_t)BID * 512 + TID; idx < (size_t)32 * 256 * 256; idx += stride) {
        const int g = (int)(idx >> 16), nout = (int)(idx >> 8) & 255, k = (int)idx & 255, d = nout >> 7, ri = (nout >> 6) & 1, n = nout & 63, s = k >> 4, cp = k & 15, j = d == 0 ? 15 - s : s;
        const f32x2 pv = pw[((size_t)(g * 2 + d) * 17 + j) * 64 + n]; const f32x2 bv = bbar[((size_t)(g * 2 + d) * 64 + n) * 16 + cp];
        pmat[idx] = f2bf(ri == 0 ? pv.x * bv.x - pv.y * bv.y : pv.x * bv.y + pv.y * bv.x);
    }
}
__device__ __forceinline__ void s5_assemble_w(const int TID, const int BID, const Params& p, int l) {
    const f32x2* pw = (const f32x2*)(p.ws + WS_PW) + l * PWL; const float* kmat = (const float*)(p.ws + WS_KMAT);
    bf16_t* wmat = (bf16_t*)(p.ws + WS_WMAT);
    const float* cre = p.in[10]; const float* cim = p.in[11];
    const size_t stride = (size_t)gridDim.x * 512;
    for (size_t idx = (size_t)BID * 512 + TID; idx < (size_t)32 * 256 * 512; idx += stride) {
        const int g = (int)(idx >> 17), nout = (int)(idx >> 9) & 255, k = (int)idx & 511, t = nout >> 4, c = nout & 15;
        float val;
        if (k < 256) { const int s = k >> 4, cp = k & 15; val = 0.f;
            const int jf = s <= t ? t - s : 0, jb = s >= t ? s - t : 0;
            const float kf = kmat[((((size_t)g * 2 + 0) * 16 + jf) * 16 + c) * 16 + cp], kb = kmat[((((size_t)g * 2 + 1) * 16 + jb) * 16 + c) * 16 + cp], dsk = p.in[12][l * 512 + g * 16 + c];
            val = (s <= t ? kf : 0.f) + (s >= t ? kb : 0.f) + ((s == t && c == cp) ? dsk : 0.f);
        } else { const int kk = k - 256, d = kk >> 7, ri = (kk >> 6) & 1, n = kk & 63, j = d == 0 ? t + 1 : 16 - t;
            const float cr = cre[(((size_t)(l * 2 + d) * 32 + g) * 16 + c) * 64 + n], ci = cim[(((size_t)(l * 2 + d) * 32 + g) * 16 + c) * 64 + n];
            const f32x2 pv = pw[((size_t)(g * 2 + d) * 17 + j) * 64 + n];
            val = ri == 0 ? cr * pv.x - ci * pv.y : -(cr * pv.y + ci * pv.x); }
        wmat[idx] = f2bf(val);
    }
}

__device__ __forceinline__ void scans_phase(const int TID, const int BID, const Params& p, const int l, const bool do_gla) {
    const int G = gridDim.x;
    const bool split = (G == 256);
    {
        const f32x2* pw = (const f32x2*)(p.ws + WS_PW) + l * PWL; const bf16_t* st = (const bf16_t*)(p.ws + WS_ST); bf16_t* ub = (bf16_t*)(p.ws + WS_UBUF);
        for (int idx = BID * 512 + TID; idx < 40960; idx += G * 512) {
            const int seq = idx >> 12, rem = idx & 4095, g = rem >> 7, d = (rem >> 6) & 1, n = rem & 63;
            const int ch0 = seq < 2 ? seq * 257 : 514 + (seq - 2) * 129, nc = seq < 2 ? 257 : 129;
            const f32x2 a16 = pw[((size_t)(g * 2 + d) * 17 + 16) * 64 + n];
            float sr = 0.f, si = 0.f;
            for (int s0 = 0; s0 < nc; s0 += 32) {
                float lr[32], li[32];
#pragma unroll
                for (int i = 0; i < 32; ++i) { const int step = s0 + i; lr[i] = 0.f; li[i] = 0.f;
                    { const int sc = step < nc ? step : nc - 1; const int c = d == 0 ? sc : nc - 1 - sc; const size_t row = (size_t)g * CHP + ch0 + c; lr[i] = bf2f(st[row * 256 + d * 128 + n]); li[i] = bf2f(st[row * 256 + d * 128 + 64 + n]); } }
#pragma unroll
                for (int i = 0; i < 32; ++i) { const int step = s0 + i;
                    if (step < nc) { const int c = d == 0 ? step : nc - 1 - step; const size_t row = (size_t)g * CHP + ch0 + c;
                        ub[row * 512 + 256 + d * 128 + n] = f2bf(sr); ub[row * 512 + 256 + d * 128 + 64 + n] = f2bf(si);
                        const float nr = a16.x * sr - a16.y * si + lr[i], ni = a16.x * si + a16.y * sr + li[i]; sr = nr; si = ni; } }
            }
        }
    }
    {
        const float* la = (const float*)(p.ws + WS_LRUA); const float* lh = (const float*)(p.ws + WS_LRUH); float* lc = (float*)(p.ws + WS_LRUC);
        const int vb0 = split ? BID - 80 : BID, vstride = split ? 1 << 20 : G;
        for (int vb = vb0; vb >= 0 && vb < 40; vb += vstride) {
            const int idx = vb * 512 + TID;
            const int seq = idx >> 11, d = (idx >> 10) & 1, ch = idx & 1023;
            const int cb = seq < 2 ? seq * 65 : 130 + (seq - 2) * 33, nc = seq < 2 ? 65 : 33;
            float cin = 0.f;
            for (int s0 = 0; s0 < nc; s0 += 16) {
                float A[16], H[16];
#pragma unroll
                for (int i = 0; i < 16; ++i) { const int step = s0 + i; A[i] = 1.f; H[i] = 0.f;
                    { const int sc = step < nc ? step : nc - 1; const int ci = cb + (d == 0 ? sc : nc - 1 - sc); const size_t o = ((size_t)ci * 2 + d) * 1024 + ch; A[i] = la[o]; H[i] = lh[o]; } }
#pragma unroll
                for (int i = 0; i < 16; ++i) { const int step = s0 + i;
                    if (step < nc) { const int ci = cb + (d == 0 ? step : nc - 1 - step); const size_t o = ((size_t)ci * 2 + d) * 1024 + ch; lc[o] = cin; cin = A[i] * cin + H[i]; } }
            }
        }
    }
    if (do_gla) {
        const bf16_t* ds = (const bf16_t*)(p.ws + WS_DS); const float* dec = (const float*)(p.ws + WS_DECAY); bf16_t* spb = (bf16_t*)(p.ws + WS_SPB);
        for (int it = 0; ; ++it) {
            int vb;
            if (split) { if (BID >= 120) { if (it >= 8) break; vb = (BID - 120) + 136 * it; } else { vb = 1088 + BID + 120 * it; if (vb >= 1280) break; } }
            else { vb = BID + G * it; if (vb >= 1280) break; }
            const int e = vb * 512 + TID;
            const int seq = e >> 16, rem = e & 65535, head = rem >> 14, d = (rem >> 13) & 1, el = rem & 8191, kk = el & 63;
            const int cb = seq < 2 ? seq * 65 : 130 + (seq - 2) * 33, nc = seq < 2 ? 65 : 33;
            float S = 0.f;
            for (int s0 = 0; s0 < nc; s0 += 16) {
                float tm[16], dc[16];
#pragma unroll
                for (int i = 0; i < 16; ++i) { const int step = s0 + i; tm[i] = 0.f; dc[i] = 1.f;
                    { const int sc = step < nc ? step : nc - 1; const int ci = cb + (d == 0 ? sc : nc - 1 - sc); const size_t o = ((size_t)(ci * 4 + head) * 2 + d); tm[i] = bf2f(ds[o * 8192 + el]); dc[i] = dec[o * 64 + kk]; } }
#pragma unroll
                for (int i = 0; i < 16; ++i) { const int step = s0 + i;
                    if (step < nc) { const int ci = cb + (d == 0 ? step : nc - 1 - step); const size_t o = ((size_t)(ci * 4 + head) * 2 + d); spb[o * 8192 + el] = f2bf(S); S = dc[i] * S + tm[i]; } }
            }
        }
    }
}

__device__ __forceinline__ f32x4 mma_lds(f32x4 acc, const LAS bf16_t* A, const LAS bf16_t* B, int ld, int nks, int lane) {
    const LAS bf16_t* ap = A + (lane & 15) * ld + (lane >> 4) * 8; const LAS bf16_t* bp = B + (lane & 15) * ld + (lane >> 4) * 8;
    for (int ks = 0; ks < nks; ++ks) acc = __builtin_amdgcn_mfma_f32_16x16x32_bf16(*(const LAS bf16x8*)(ap + ks * 32), *(const LAS bf16x8*)(bp + ks * 32), acc, 0, 0, 0);
    return acc;
}
__device__ __forceinline__ f32x4 mma_lds_sw(f32x4 acc, const LAS bf16_t* A, int rowA0, const LAS bf16_t* B, int rowB0, int ld, int nks, int lane) {
    const int swa = rowA0 >= 0 ? (((rowA0 + (lane & 15)) >> 3) & 7) : 0, swb = rowB0 >= 0 ? (((rowB0 + (lane & 15)) >> 3) & 7) : 0;
    const LAS bf16_t* ap = A + (lane & 15) * ld; const LAS bf16_t* bp = B + (lane & 15) * ld;
    for (int ks = 0; ks < nks; ++ks) { const int cb = ks * 4 + (lane >> 4);
        acc = __builtin_amdgcn_mfma_f32_16x16x32_bf16(*(const LAS bf16x8*)(ap + ((cb ^ swa) << 3)), *(const LAS bf16x8*)(bp + ((cb ^ swb) << 3)), acc, 0, 0, 0); }
    return acc;
}
#define SWZ(row, col) (((((col) >> 3) ^ (((row) >> 3) & 7)) << 3) + ((col) & 7))
constexpr int GL_GLR = 0, GL_BF = 16384, GL_BB = 32768, GL_OS = 0, GL_QE0 = 49152, GL_QE1 = 58368, GL_KE0 = 67584, GL_KE1 = 76800, GL_VT = 86016, GL_ATT = 104448, GL_SP0 = 113664, GL_SP1 = 132096;
constexpr int GLD = 72;
template <int MODE>
__device__ __forceinline__ void gla_item(const int TID, const Params& p, int l, int ci, int head, LAS unsigned char* lds, const float (&wg)[2][16], const float (&bg)[2], const float (&ngv)[16]) {
    const int tid = TID, lane = tid & 63, wid = tid >> 6;
    const bf16_t* cols = (const bf16_t*)(p.ws + WS_COLS);
    int seq, c; chunk_info(ci, seq, c);
    const int tok0 = seq_start(seq) + (c == 0 ? -48 : 16 + 64 * (c - 1));
    const int rmin = (c == 0) ? 48 : 0;
    LAS float* glr_s = (LAS float*)(lds + GL_GLR); LAS float* bfs = (LAS float*)(lds + GL_BF); LAS float* bbs = (LAS float*)(lds + GL_BB);
    f32x4 gbv[4];
    if (MODE == 1) { const float* gb = (const float*)(p.ws + WS_GB) + (size_t)(ci * 4 + head) * 8192;
#pragma unroll
      for (int i = 0; i < 4; ++i) gbv[i] = *(const f32x4*)(gb + (i * 512 + tid) * 4); }
    u32x4 kw = (u32x4){0u, 0u, 0u, 0u}, qw = kw, vwp[2], gwp[2];
    { const int r = tid >> 3, k8 = (tid & 7) * 8; const int rc = r >= rmin ? r : rmin; const bf16_t* rowp = cols + (size_t)(tok0 + rc) * NINP;
      kw = *(const u32x4*)(rowp + C_K + head * 64 + k8); if (MODE == 1) qw = *(const u32x4*)(rowp + C_Q + head * 64 + k8);
#pragma unroll
      for (int hh = 0; hh < 2; ++hh) { vwp[hh] = *(const u32x4*)(rowp + C_V + head * 128 + ((tid & 7) + 8 * hh) * 8); if (MODE == 1) gwp[hh] = *(const u32x4*)(rowp + C_GB + head * 128 + (tid & 7) * 16 + hh * 8); } }
    if (MODE == 0) {
    { const int r = tid >> 3, j4 = (tid & 7) * 4; f32x4 v = (f32x4){0.f, 0.f, 0.f, 0.f};
      { const int rc = r >= rmin ? r : rmin; const u32x2 w = *(const u32x2*)(cols + (size_t)(tok0 + rc) * NINP + C_GLR + j4); if (r >= rmin) { v[0] = bflo(w.x); v[1] = bfhi(w.x); v[2] = bflo(w.y); v[3] = bfhi(w.y); } }
      *(LAS f32x4*)(glr_s + r * 32 + j4) = v; }
    __syncthreads();
    { const int kk = tid & 63, rb = tid >> 6;
#pragma unroll
      for (int i = 0; i < 8; ++i) { const int r = rb + 8 * i; float x0 = bg[0], x1 = bg[1]; f32x4 gr[8];
#pragma unroll
          for (int j4 = 0; j4 < 8; ++j4) gr[j4] = *(const LAS f32x4*)(glr_s + r * 32 + j4 * 4);
#pragma unroll
          for (int j = 0; j < 16; ++j) { x0 += gr[j >> 2][j & 3] * wg[0][j]; x1 += gr[4 + (j >> 2)][j & 3] * wg[1][j]; }
          const bool ok = r >= rmin; bfs[r * 64 + kk] = ok ? logsig(x0) * 0.0625f : 0.f; bbs[r * 64 + kk] = ok ? logsig(x1) * 0.0625f : 0.f; } }
    __syncthreads();
    { const int col = tid & 127, part = tid >> 7, d = col >> 6, kk = col & 63; LAS float* bs = d ? bbs : bfs; LAS float* tot = glr_s;
      float v[16];
#pragma unroll
      for (int i = 0; i < 16; ++i) v[i] = bs[(part * 16 + i) * 64 + kk];
      if (d == 0) {
#pragma unroll
          for (int i = 1; i < 16; ++i) v[i] += v[i - 1];
          tot[part * 128 + col] = v[15]; }
      else {
#pragma unroll
          for (int i = 14; i >= 0; --i) v[i] += v[i + 1];
          tot[part * 128 + col] = v[0]; }
      __syncthreads();
      float off = 0.f;
#pragma unroll
      for (int pp = 0; pp < 4; ++pp) { const float t = tot[pp * 128 + col]; if (d == 0 ? pp < part : pp > part) off += t; }
#pragma unroll
      for (int i = 0; i < 16; ++i) bs[(part * 16 + i) * 64 + kk] = v[i] + off; }
    __syncthreads();
    { float* gb = (float*)(p.ws + WS_GB) + (size_t)(ci * 4 + head) * 8192;
#pragma unroll
      for (int i = 0; i < 4; ++i) { const int e = (i * 512 + tid) * 4; *(f32x4*)(gb + e) = *(const LAS f32x4*)(bfs + e); } }
    } else {
      __syncthreads();
#pragma unroll
      for (int i = 0; i < 4; ++i) { const int e = (i * 512 + tid) * 4; *(LAS f32x4*)(bfs + e) = gbv[i]; }
      __syncthreads();
    }
    LAS bf16_t* vT = (LAS bf16_t*)(lds + GL_VT);
    { const int r = tid >> 3, k8 = (tid & 7) * 8; const bool ok = r >= rmin;
      if (!ok) { kw = (u32x4){0u, 0u, 0u, 0u}; qw = kw; }
      float qv[8], kv[8];
#pragma unroll
      for (int i = 0; i < 4; ++i) { qv[2 * i] = bflo(qw[i]); qv[2 * i + 1] = bfhi(qw[i]); kv[2 * i] = bflo(kw[i]); kv[2 * i + 1] = bfhi(kw[i]); }
      if (MODE == 0) { LAS bf16_t* kd0 = (LAS bf16_t*)(lds + GL_QE0); LAS bf16_t* kd1 = (LAS bf16_t*)(lds + GL_QE1);
#pragma unroll
          for (int i = 0; i < 8; ++i) { const int kk = k8 + i; kd0[kk * GLD + SWZ(kk, r)] = f2bf(kv[i] * __expf(bfs[63 * 64 + kk] - bfs[r * 64 + kk])); kd1[kk * GLD + SWZ(kk, r)] = f2bf(kv[i] * __expf(bbs[kk] - bbs[r * 64 + kk])); }
      } else { LAS bf16_t* qe0 = (LAS bf16_t*)(lds + GL_QE0); LAS bf16_t* qe1 = (LAS bf16_t*)(lds + GL_QE1); LAS bf16_t* ke0 = (LAS bf16_t*)(lds + GL_KE0); LAS bf16_t* ke1 = (LAS bf16_t*)(lds + GL_KE1);
          u32x4 a, b2, c2, d2;
#pragma unroll
          for (int i = 0; i < 4; ++i) { const int kk = k8 + 2 * i; const float f0 = bfs[r * 64 + kk], f1 = bfs[r * 64 + kk + 1], g0 = bbs[r * 64 + kk], g1 = bbs[r * 64 + kk + 1];
              a[i] = cvt_pk_bf16(qv[2 * i] * 0.125f * __expf(f0), qv[2 * i + 1] * 0.125f * __expf(f1)); b2[i] = cvt_pk_bf16(qv[2 * i] * 0.125f * __expf(g0), qv[2 * i + 1] * 0.125f * __expf(g1));
              c2[i] = cvt_pk_bf16(kv[2 * i] * __expf(-f0), kv[2 * i + 1] * __expf(-f1)); d2[i] = cvt_pk_bf16(kv[2 * i] * __expf(-g0), kv[2 * i + 1] * __expf(-g1)); }
          *(LAS u32x4*)(qe0 + r * GLD + k8) = a; *(LAS u32x4*)(qe1 + r * GLD + k8) = b2; *(LAS u32x4*)(ke0 + r * GLD + k8) = c2; *(LAS u32x4*)(ke1 + r * GLD + k8) = d2; }
#pragma unroll
      for (int hh = 0; hh < 2; ++hh) { const int v8 = ((tid & 7) + 8 * hh) * 8; u32x4 vw = (u32x4){0u, 0u, 0u, 0u};
          if (ok) vw = vwp[hh];
#pragma unroll
          for (int i = 0; i < 4; ++i) { vT[(v8 + 2 * i) * GLD + SWZ(v8, r)] = (bf16_t)(vw[i] & 0xffffu); vT[(v8 + 2 * i + 1) * GLD + SWZ(v8, r)] = (bf16_t)(vw[i] >> 16); } }
    }
    if (MODE == 1) {
        const bf16_t* spb = (const bf16_t*)(p.ws + WS_SPB); u32x4 sv[2][2];
#pragma unroll
        for (int d = 0; d < 2; ++d) { const bf16_t* src = spb + ((size_t)(ci * 4 + head) * 2 + d) * 8192;
#pragma unroll
            for (int i = 0; i < 2; ++i) sv[d][i] = *(const u32x4*)(src + (i * 512 + tid) * 8); }
#pragma unroll
        for (int d = 0; d < 2; ++d) { LAS bf16_t* sp = (LAS bf16_t*)(lds + (d ? GL_SP1 : GL_SP0));
#pragma unroll
            for (int i = 0; i < 2; ++i) { const int e = (i * 512 + tid) * 8; *(LAS u32x4*)(sp + (e >> 6) * GLD + (e & 63)) = sv[d][i]; } }
    }
    __syncthreads();
    if (MODE == 0) {
        float* ds = (float*)(p.ws + WS_DS); float* dec = (float*)(p.ws + WS_DECAY);
        if (tid < 128) { const int d = tid >> 6, kk = tid & 63; dec[((size_t)(ci * 4 + head) * 2 + d) * 64 + kk] = __expf(d == 0 ? bfs[63 * 64 + kk] : bbs[kk]); }
#pragma unroll
        for (int d = 0; d < 2; ++d) { const LAS bf16_t* kd = (const LAS bf16_t*)(lds + (d ? GL_QE1 : GL_QE0)); bf16_t* dst = (bf16_t*)ds + ((size_t)(ci * 4 + head) * 2 + d) * 8192;
            for (int kt = 0; kt < 4; ++kt) { f32x4 acc = (f32x4){0.f, 0.f, 0.f, 0.f}; acc = mma_lds_sw(acc, vT + wid * 16 * GLD, wid * 16, kd + kt * 16 * GLD, kt * 16, GLD, 2, lane);
#pragma unroll
                for (int j = 0; j < 4; ++j) dst[(wid * 16 + (lane >> 4) * 4 + j) * 64 + kt * 16 + (lane & 15)] = f2bf_sw(acc[j]); } }
        __syncthreads();
        return;
    }
    const LAS bf16_t* qe0 = (const LAS bf16_t*)(lds + GL_QE0); const LAS bf16_t* qe1 = (const LAS bf16_t*)(lds + GL_QE1); const LAS bf16_t* ke0 = (const LAS bf16_t*)(lds + GL_KE0); const LAS bf16_t* ke1 = (const LAS bf16_t*)(lds + GL_KE1);
    LAS bf16_t* att = (LAS bf16_t*)(lds + GL_ATT);
    { const int it = wid >> 1;
#pragma unroll
      for (int t2 = 0; t2 < 2; ++t2) { const int jt = (wid & 1) * 2 + t2; f32x4 af = (f32x4){0.f, 0.f, 0.f, 0.f}, ab = af;
          af = mma_lds(af, qe0 + it * 16 * GLD, ke0 + jt * 16 * GLD, GLD, 2, lane); ab = mma_lds(ab, qe1 + it * 16 * GLD, ke1 + jt * 16 * GLD, GLD, 2, lane);
#pragma unroll
          for (int j = 0; j < 4; ++j) { const int i_ = it * 16 + (lane >> 4) * 4 + j, j_ = jt * 16 + (lane & 15); att[i_ * GLD + j_] = f2bf((j_ <= i_ ? af[j] : 0.f) + (j_ >= i_ ? ab[j] : 0.f)); } } }
    __syncthreads();
    LAS float* os = (LAS float*)(lds + GL_OS);
    { const int it = wid >> 1; const LAS bf16_t* sp0 = (const LAS bf16_t*)(lds + GL_SP0); const LAS bf16_t* sp1 = (const LAS bf16_t*)(lds + GL_SP1);
#pragma unroll
      for (int t4 = 0; t4 < 4; ++t4) { const int vt = (wid & 1) * 4 + t4; f32x4 acc = (f32x4){0.f, 0.f, 0.f, 0.f};
          acc = mma_lds_sw(acc, att + it * 16 * GLD, -1, vT + vt * 16 * GLD, vt * 16, GLD, 2, lane); acc = mma_lds(acc, qe0 + it * 16 * GLD, sp0 + vt * 16 * GLD, GLD, 2, lane); acc = mma_lds(acc, qe1 + it * 16 * GLD, sp1 + vt * 16 * GLD, GLD, 2, lane);
#pragma unroll
          for (int j = 0; j < 4; ++j) os[(it * 16 + (lane >> 4) * 4 + j) * 132 + vt * 16 + (lane & 15)] = acc[j]; } }
    __syncthreads();
    { const int r = tid >> 3, v0 = (tid & 7) * 16; float o[16]; float ss = 0.f;
#pragma unroll
      for (int i = 0; i < 16; ++i) { o[i] = os[r * 132 + v0 + i]; ss += o[i] * o[i]; }
      ss += __shfl_xor(ss, 1); ss += __shfl_xor(ss, 2); ss += __shfl_xor(ss, 4);
      const float rs = rsqrtf(ss * (1.0f / 128.0f) + 1e-6f);
      if (r >= rmin) { const size_t tok = (size_t)(tok0 + r); bf16_t* yall = (bf16_t*)(p.ws + WS_YALL);
#pragma unroll
          for (int hh = 0; hh < 2; ++hh) { const u32x4 gw = gwp[hh]; u32x4 w;
#pragma unroll
              for (int i = 0; i < 4; ++i) { const int e = hh * 8 + 2 * i; w[i] = cvt_pk_bf16(o[e] * rs * ngv[e] * silu(bflo(gw[i])), o[e + 1] * rs * ngv[e + 1] * silu(bfhi(gw[i]))); }
              *(u32x4*)(yall + tok * D + 512 + head * 128 + v0 + hh * 8) = w; } } }
    __syncthreads();
}

__device__ __forceinline__ float softplus_neg(float lam) { const float e = __expf(-lam); return lam + 0.f < -8.f ? -lam : (e < 0.02f ? e * (1.0f - e * (0.5f - e * (1.0f / 3.0f))) : __logf(1.0f + e)); }
__device__ __forceinline__ float one_minus_exp(float x) {
    return x > -0.5f ? -x * (1.0f + x * 0.5f * (1.0f + x * (1.0f / 3.0f) * (1.0f + x * 0.25f * (1.0f + x * 0.2f * (1.0f + x * (1.0f / 6.0f) * (1.0f + x * (1.0f / 7.0f))))))) : 1.0f - __expf(x);
}
template <int MODE>
__device__ __forceinline__ void lru_phase(const int TID, const int b, const int G, const Params& p, int l, LAS unsigned char* lds) {
    const int tid = TID, lane = tid & 63, wid = tid >> 6, q = lane >> 4;
    const bf16_t* cols = (const bf16_t*)(p.ws + WS_COLS);
    int it = b; if (it >= NCK * 8) return;
    const int nb = b & 7;
    LAS bf16_t* xcA = (LAS bf16_t*)lds; LAS float* xcf = (LAS float*)(lds + 17408);
    const int ch = tid & 127, rb = tid >> 7, gchc = nb * 128 + ch;
    const float w0 = p.in[18][(l * 4 + 0) * 1024 + gchc], w1 = p.in[18][(l * 4 + 1) * 1024 + gchc], w2 = p.in[18][(l * 4 + 2) * 1024 + gchc], w3 = p.in[18][(l * 4 + 3) * 1024 + gchc], cb = p.in[19][l * 1024 + gchc];
    const int chl = wid * 16 + (lane & 15), gch = nb * 128 + chl;
    float ba[2], bx[2], sp8[2];
#pragma unroll
    for (int d = 0; d < 2; ++d) { ba[d] = p.in[21][(l * 2 + d) * 1024 + gch]; bx[d] = p.in[23][(l * 2 + d) * 1024 + gch]; sp8[d] = 8.0f * softplus_neg(p.in[24][(l * 2 + d) * 1024 + gch]); }
    bf16x8 bfr[4][4];
    { const bf16_t* bt = (const bf16_t*)(p.ws + WS_BTLRU);
#pragma unroll
      for (int mat = 0; mat < 4; ++mat)
#pragma unroll
          for (int ks = 0; ks < 4; ++ks) bfr[mat][ks] = *(const bf16x8*)(bt + ((size_t)(mat * 8 + nb) * 128 + wid * 16 + (lane & 15)) * 128 + ks * 32 + q * 8); }
    bf16_t xr[19];
    { int seq, c; chunk_info(it >> 3, seq, c); const int s0 = seq_start(seq), L = seq_len(seq), pos0 = (c == 0 ? -48 : 16 + 64 * (c - 1));
      const bf16_t* xb = cols + (size_t)s0 * NINP + C_XC + gchc;
#pragma unroll
      for (int i = 0; i < 19; ++i) { const int pos = pos0 + rb * 16 - 2 + i; const int pc = pos < 0 ? 0 : (pos < L ? pos : L - 1); xr[i] = xb[(size_t)pc * NINP]; } }
    for (; it < NCK * 8; it += G) {
        const int ci = it >> 3;
        int seq, c; chunk_info(ci, seq, c);
        const int s0 = seq_start(seq);
        const int pos0 = (c == 0 ? -48 : 16 + 64 * (c - 1));
        const int rmin = (c == 0) ? 48 : 0;
        float xv[19];
        { const int L = seq_len(seq);
#pragma unroll
          for (int i = 0; i < 19; ++i) { const int pos = pos0 + rb * 16 - 2 + i; xv[i] = (pos >= 0 && pos < L) ? bf2f(xr[i]) : 0.f; } }
#pragma unroll
        for (int i = 0; i < 16; ++i) { const int r = rb * 16 + i; const float xc = (r >= rmin) ? cb + xv[i] * w0 + xv[i + 1] * w1 + xv[i + 2] * w2 + xv[i + 3] * w3 : 0.f;
            xcf[r * 132 + ch] = xc; xcA[r * 136 + ch] = f2bf(xc); }
        u32x4 gq[2]; float cin[2];
        if (MODE == 1) {
#pragma unroll
            for (int d = 0; d < 2; ++d) cin[d] = ((const float*)(p.ws + WS_LRUC))[((size_t)ci * 2 + d) * 1024 + gch];
            { const int r = tid >> 3; const int rr = r >= rmin ? r : rmin; const bf16_t* gp = cols + (size_t)(s0 + pos0 + rr) * NINP + C_GC + nb * 128 + (tid & 7) * 16;
              gq[0] = *(const u32x4*)gp; gq[1] = *(const u32x4*)(gp + 8); }
        }
        { const int itn = it + G;
          if (itn < NCK * 8) { int seqn, cn; chunk_info(itn >> 3, seqn, cn); const int s0n = seq_start(seqn), Ln = seq_len(seqn), pos0n = (cn == 0 ? -48 : 16 + 64 * (cn - 1));
              const bf16_t* xb = cols + (size_t)s0n * NINP + C_XC + gchc;
#pragma unroll
              for (int i = 0; i < 19; ++i) { const int pos = pos0n + rb * 16 - 2 + i; const int pc = pos < 0 ? 0 : (pos < Ln ? pos : Ln - 1); xr[i] = xb[(size_t)pc * NINP]; } } }
        LBAR();
        LAS bf16_t* gts = (LAS bf16_t*)(lds + 51200); LAS float* hfs = (LAS float*)(lds + 68608);
        float hsum[4][4];
#pragma unroll
        for (int d = 0; d < 2; ++d) {
            __builtin_amdgcn_sched_barrier(0);
            f32x4 acc[2][4];
#pragma unroll
            for (int rt = 0; rt < 4; ++rt) { bf16x8 afr[4];
#pragma unroll
                for (int ks = 0; ks < 4; ++ks) afr[ks] = *(const LAS bf16x8*)(xcA + (rt * 16 + (lane & 15)) * 136 + ks * 32 + q * 8);
#pragma unroll
                for (int kind = 0; kind < 2; ++kind) { f32x4 a = (f32x4){0.f, 0.f, 0.f, 0.f};
#pragma unroll
                    for (int ks = 0; ks < 4; ++ks) a = __builtin_amdgcn_mfma_f32_16x16x32_bf16(afr[ks], bfr[d * 2 + kind][ks], a, 0, 0, 0);
                    acc[kind][rt] = a; } }
            float a[4][4], bb[4][4];
#pragma unroll
            for (int rt = 0; rt < 4; ++rt)
#pragma unroll
                for (int j = 0; j < 4; ++j) { const int r = rt * 16 + q * 4 + j; const float rg = sigm(acc[0][rt][j] + ba[d]), ig = sigm(acc[1][rt][j] + bx[d]), la = -sp8[d] * rg;
                    const bool ok = r >= rmin; const float av = __expf(la), x2 = 2.0f * la; const float om = x2 > -0.25f ? -x2 * (1.0f + x2 * 0.5f * (1.0f + x2 * (1.0f / 3.0f) * (1.0f + x2 * 0.25f * (1.0f + x2 * 0.2f)))) : 1.0f - av * av;
                    a[rt][j] = ok ? av : 1.0f; bb[rt][j] = ok ? __builtin_amdgcn_sqrtf(om) * ig * xcf[r * 132 + chl] : 0.f; }
            float LA[4], LB[4];
#pragma unroll
            for (int rt = 0; rt < 4; ++rt) { float A = 1.f, B = 0.f;
#pragma unroll
                for (int jj = 0; jj < 4; ++jj) { const int j = d == 0 ? jj : 3 - jj; B = a[rt][j] * B + bb[rt][j]; A *= a[rt][j]; }
                LA[rt] = A; LB[rt] = B; }
            const size_t co = ((size_t)ci * 2 + d) * 1024 + gch;
            float h = (MODE == 1) ? cin[d] : 0.f, Atot = 1.f; float hin[4];
#pragma unroll
            for (int rr = 0; rr < 4; ++rr) { const int rt = d == 0 ? rr : 3 - rr;
#pragma unroll
                for (int qi = 0; qi < 4; ++qi) { const int qq = d == 0 ? qi : 3 - qi;
                    const float Aq = __shfl(LA[rt], (lane & 15) + 16 * qq), Bq = __shfl(LB[rt], (lane & 15) + 16 * qq);
                    if (qq == q) hin[rt] = h;
                    h = Aq * h + Bq; Atot *= Aq; } }
            if (MODE == 0) { if (q == 0) { ((float*)(p.ws + WS_LRUA))[co] = Atot; ((float*)(p.ws + WS_LRUH))[co] = h; } }
            else {
#pragma unroll
                for (int rt = 0; rt < 4; ++rt) { float hh = hin[rt];
#pragma unroll
                    for (int jj = 0; jj < 4; ++jj) { const int j = d == 0 ? jj : 3 - jj; hh = a[rt][j] * hh + bb[rt][j];
                        if (d == 0) hfs[(rt * 16 + q * 4 + j) * 132 + chl] = hh; else hsum[rt][j] = hh; } }
                if (d == 0) { *(LAS u32x4*)(gts + (tid >> 3) * 136 + (tid & 7) * 16) = gq[0]; *(LAS u32x4*)(gts + (tid >> 3) * 136 + (tid & 7) * 16 + 8) = gq[1]; } }
        }
        if (MODE == 1) { bf16_t* yall = (bf16_t*)(p.ws + WS_YALL);
            LBAR();
#pragma unroll
            for (int rt = 0; rt < 4; ++rt)
#pragma unroll
                for (int j = 0; j < 4; ++j) { const int r = rt * 16 + q * 4 + j; xcA[r * 136 + chl] = f2bf((hsum[rt][j] + hfs[r * 132 + chl]) * silu(bf2f(gts[r * 136 + chl]))); }
            LBAR();
            { const int r = tid >> 3; if (r >= rmin) { const u32x4 y0 = *(const LAS u32x4*)(xcA + r * 136 + (tid & 7) * 16), y1 = *(const LAS u32x4*)(xcA + r * 136 + (tid & 7) * 16 + 8);
                bf16_t* yp = yall + (size_t)(s0 + pos0 + r) * D + 1024 + nb * 128 + (tid & 7) * 16; *(u32x4*)yp = y0; *(u32x4*)(yp + 8) = y1; } } }
        LBAR();
    }
}


template <int WHICH>
__device__ __forceinline__ void skinny_tail(const int TID, const int b0, const Params& p, const int first) {
    const int lane = TID & 63, wid = TID >> 6, q = lane >> 4;
    if (wid >= 5) return;
    for (int b = b0; b < 256; b += (int)gridDim.x) {
    const int ct = b & 127, rt = (b >> 7) * 5 + wid;
    const int row = 24576 + rt * 16 + (lane & 15);
    const int colb = ct * 16 + (lane & 15);
    const bf16_t* cols = (const bf16_t*)(p.ws + WS_COLS);
    if (WHICH == 0) {
        const bf16_t* A = (const bf16_t*)(p.ws + WS_YALL) + (size_t)row * D + q * 8; const bf16_t* B = (const bf16_t*)(p.ws + WS_BTOUT) + (size_t)colb * D + q * 8;
        bf16_t* mbf = (bf16_t*)(p.ws + WS_H);
        f32x4 msum = (f32x4){0.f, 0.f, 0.f, 0.f};
        unsigned char gt[3][4];
#pragma unroll
        for (int br = 0; br < 3; ++br)
#pragma unroll
            for (int j = 0; j < 4; ++j) { const int cc = colb & 255; gt[br][j] = ((const unsigned char*)(cols + (size_t)(24576 + rt * 16 + q * 4 + j) * NINP + C_MG))[(br * 8 + (colb >> 8)) * 256 + ((((cc & 127) >> 5) * 4 + ((cc & 31) >> 3)) * 2 + (cc >> 7)) * 8 + (cc & 7)]; }
        float gs[3][4];
#pragma unroll
        for (int br = 0; br < 3; ++br)
#pragma unroll
            for (int j = 0; j < 4; ++j) { gs[br][j] = (float)gt[br][j] * (1.0f / 255.0f); asm volatile("" : "+v"(gs[br][j])); }
#pragma unroll
        for (int br = 0; br < 3; ++br) { const int koff = br * 512, nks = br == 2 ? 32 : 16; f32x4 acc = (f32x4){0.f, 0.f, 0.f, 0.f};
            for (int k0 = 0; k0 < nks; k0 += 8) { bf16x8 av[8], bv[8];
#pragma unroll
                for (int i = 0; i < 8; ++i) { av[i] = *(const bf16x8*)(A + koff + (k0 + i) * 32); bv[i] = *(const bf16x8*)(B + koff + (k0 + i) * 32); }
#pragma unroll
                for (int i = 0; i < 8; ++i) acc = __builtin_amdgcn_mfma_f32_16x16x32_bf16(av[i], bv[i], acc, 0, 0, 0); }
#pragma unroll
            for (int j = 0; j < 4; ++j) msum[j] += gs[br][j] * acc[j]; }
#pragma unroll
        for (int j = 0; j < 4; ++j) { const int tok = 24576 + rt * 16 + q * 4 + j; mbf[(size_t)tok * D + colb] = f2bf(msum[j]); }
    } else {
        const bf16_t* A = (const bf16_t*)(p.ws + WS_H) + (size_t)row * D + q * 8; const bf16_t* B = (const bf16_t*)(p.ws + WS_BTO) + (size_t)colb * D + q * 8;
        float* z = (float*)(p.ws + WS_Z);
        f32x4 acc = (f32x4){0.f, 0.f, 0.f, 0.f};
        for (int k0 = 0; k0 < 64; k0 += 8) { bf16x8 av[8], bv[8];
#pragma unroll
            for (int i = 0; i < 8; ++i) { av[i] = *(const bf16x8*)(A + (k0 + i) * 32); bv[i] = *(const bf16x8*)(B + (k0 + i) * 32); }
#pragma unroll
            for (int i = 0; i < 8; ++i) acc = __builtin_amdgcn_mfma_f32_16x16x32_bf16(av[i], bv[i], acc, 0, 0, 0); }
#pragma unroll
        for (int j = 0; j < 4; ++j) { const int tok = 24576 + rt * 16 + q * 4 + j; const float res = first ? src_row(p, tok)[colb] : z[(size_t)tok * D + colb]; z[(size_t)tok * D + colb] = res + acc[j]; }
    }
    }
}

#define XB_TMO      128
#define XB_XCNT(j)  (256  + 64 * (j))
#define XB_XSUB(j)  (1280 + 64 * (j))
#define XB_XGEN(j)  (2304 + 64 * (j))
#define XB_TOP      3328
#define XB_TOPGEN   3392
#define XCD_BAR_WORDS 3456
#define XB_SPIN_CAP (1u << 18)
__device__ __forceinline__ unsigned xb_ld(unsigned* p)              { return __hip_atomic_load(p, __ATOMIC_RELAXED, __HIP_MEMORY_SCOPE_AGENT); }
__device__ __forceinline__ unsigned xb_add(unsigned* p, unsigned v) { return __hip_atomic_fetch_add(p, v, __ATOMIC_RELAXED, __HIP_MEMORY_SCOPE_AGENT); }
__device__ __forceinline__ unsigned xb_xcc_id() { return (unsigned)__builtin_amdgcn_s_getreg((3 << 11) | 20) & 0xFu; }
#define XB_SPIN(cond, bar) do { unsigned _sp = 0; while (cond) { __builtin_amdgcn_s_sleep(1); \
    if ((++_sp & 255u) == 0u) { if (xb_ld(&(bar)[XB_TMO])) break; if (_sp > XB_SPIN_CAP) { atomicAdd(&(bar)[XB_TMO], 1u); break; } } } } while (0)
struct XcdBarrier { unsigned* bar; unsigned x; volatile LAS unsigned* st; };
__device__ __forceinline__ XcdBarrier xcd_barrier_post(unsigned* bar, volatile LAS unsigned* st) {
    XcdBarrier b; b.bar = bar; b.x = xb_xcc_id(); b.st = st;
    if (threadIdx.x == 0) (void)xb_add(&bar[XB_XCNT(b.x)], 1u);
    return b;
}
__device__ __forceinline__ void xcd_barrier_complete(unsigned* bar, unsigned x, unsigned& nloc, unsigned& nx) {
    const unsigned G = gridDim.x * gridDim.y * gridDim.z;
    unsigned sum, cnt, mine, sp = 0u;
    for (;;) {
        sum = 0u; cnt = 0u; mine = 0u;
#pragma unroll
        for (unsigned j = 0; j < 16; ++j) { const unsigned c = xb_ld(&bar[XB_XCNT(j)]); sum += c; cnt += (c > 0u) ? 1u : 0u; mine = (j == x) ? c : mine; }
        if (sum == G) break;
        __builtin_amdgcn_s_sleep(1);
        if ((++sp & 255u) == 0u) { if (xb_ld(&bar[XB_TMO])) break; if (sp > XB_SPIN_CAP) { atomicAdd(&bar[XB_TMO], 1u); break; } }
    }
    nloc = mine > 0u ? mine : 1u; nx = cnt > 0u ? cnt : 1u;
}
__device__ __forceinline__ void xcd_barrier(const XcdBarrier& b) {
    asm volatile("s_waitcnt vmcnt(0)" ::: "memory");
    __syncthreads();
    if (threadIdx.x == 0) {
        unsigned* bar = b.bar;
        __builtin_amdgcn_s_waitcnt(0);
        unsigned nloc = b.st[0], nx = b.st[1];
        if (nloc == 0u) { xcd_barrier_complete(bar, b.x, nloc, nx); b.st[0] = nloc; b.st[1] = nx; }
        const unsigned old = xb_add(&bar[XB_XSUB(b.x)], 1u);
        const unsigned gen = old / nloc;
        if (old + 1u == (gen + 1u) * nloc) {
            __builtin_amdgcn_fence(__ATOMIC_RELEASE, "agent");
            asm volatile("s_waitcnt vmcnt(0)" ::: "memory");
            const unsigned og = xb_add(&bar[XB_TOP], 1u);
            const unsigned tg = og / nx;
            if (og + 1u == (tg + 1u) * nx) xb_add(&bar[XB_TOPGEN], 1u);
            else XB_SPIN(xb_ld(&bar[XB_TOPGEN]) == tg, bar);
            __builtin_amdgcn_fence(__ATOMIC_ACQUIRE, "agent");
            xb_add(&bar[XB_XGEN(b.x)], 1u);
            asm volatile("s_waitcnt vmcnt(0)" ::: "memory");
        } else {
            XB_SPIN(xb_ld(&bar[XB_XGEN(b.x)]) == gen, bar);
            __builtin_amdgcn_fence(__ATOMIC_ACQUIRE, "agent");
            asm volatile("s_waitcnt vmcnt(0)" ::: "memory");
        }
    }
    __syncthreads();
}

__global__ void __launch_bounds__(512) fwd_megakernel(Params p_in) {
    extern __shared__ __attribute__((aligned(16))) unsigned char smem[];
    LAS unsigned char* lds = (LAS unsigned char*)smem;
    cg::grid_group grid = cg::this_grid();
    const int G = gridDim.x;
    const Params& p0 = p_in;
    volatile LAS unsigned* stw = (volatile LAS unsigned*)(lds + 150528);
    if (threadIdx.x == 0) { stw[0] = 0u; stw[1] = 0u; }
    __syncthreads();
    const XcdBarrier xb = xcd_barrier_post((unsigned*)(p_in.ws + WS_BAR), stw);
    for (int ph = p0.ph_lo; ph < p0.ph_hi; ++ph) {
        const int reps_ = (ph < 32 && (ph & 7) == DUP) ? 2 : 1;
        for (int rep_ = 0; rep_ < reps_; ++rep_) {
        int TID = threadIdx.x; asm volatile("" : "+v"(TID));
        int b = blockIdx.x; asm volatile("" : "+s"(b));
        Params p = p0; { unsigned long long t_ = (unsigned long long)p.ws; asm volatile("" : "+s"(t_)); p.ws = (unsigned char*)t_; }
        const char* ws = (const char*)p.ws;
        if (ph == 32) { final_norm_phase(TID, b, p); }
        else {
            const int l = ph >> 3, k = ph & 7;
            if (k == 0 && (PHM & 1)) { rmsnorm_phase(TID, b, p, l); convert_weights(TID, b, p, l, (LAS float*)lds); if (l == 0) s5_tables_all(TID, b, p); }
            else if (k == 1 && (PHM & 2)) {
                TileOrder S; S.nM = MP / 256; S.nN = NINP / 256; S.nwg = S.nM * S.nN; S.G = G; S.c = b; S.mult = 1; S.nt0 = D / 64; S.A = ws + WS_H; S.B = ws + WS_BTIN; S.tA = (size_t)256 * D * 2; S.tB = (size_t)256 * D * 2;
                EpiIn E; E.cols = (bf16_t*)(p.ws + WS_COLS); E.ubuf = (bf16_t*)(p.ws + WS_UBUF);
                gemm_phase(TID, lds, D, D, S, E);
                s5_assemble_a(TID, b, p, l);
            } else if (k == 2 && (PHM & 4)) {
                GroupOrder S; S.G = G; S.c = b; S.nt0 = 4; S.A = ws + WS_UBUF; S.B = ws + WS_PMAT; S.gsA = (size_t)CHP * 512 * 2; S.gsB = (size_t)256 * 256 * 2; S.tA = (size_t)256 * 512 * 2;
                EpiS5State E; E.st = (float*)(p.ws + WS_ST);
                if (SUBM & 4) gemm_phase(TID, lds, 512, 256, S, E);
                __syncthreads();
                { const int head_ = ((b + 128) % G) & 3, kk_ = TID & 63; float wg_[2][16], bg_[2];
                  _Pragma("unroll") for (int d = 0; d < 2; ++d) { bg_[d] = p.in[16][(l * 2 + d) * 256 + head_ * 64 + kk_]; _Pragma("unroll") for (int j = 0; j < 16; ++j) wg_[d][j] = p.in[15][((size_t)(l * 2 + d) * 16 + j) * 256 + head_ * 64 + kk_]; }
                  float ng_[16]; _Pragma("unroll") for (int e = 0; e < 16; ++e) ng_[e] = p.in[17][l * 512 + head_ * 128 + (TID & 7) * 16 + e];
                  for (int it = (b + 128) % G; it < NCK * 4; it += G) gla_item<0>(TID, p, l, it >> 2, it & 3, lds, wg_, bg_, ng_); }
                lru_phase<0>(TID, b, G, p, l, lds);
                s5_assemble_w(TID, b, p, l);
            } else if (k == 3 && (PHM & 8)) { scans_phase(TID, b, p, l, rep_ == 0); }
            else if (k == 4 && (PHM & 16)) {
                GroupOrder S; S.G = G; S.c = b; S.nt0 = 8; S.A = ws + WS_UBUF; S.B = ws + WS_WMAT; S.gsA = (size_t)CHP * 512 * 2; S.gsB = (size_t)256 * 512 * 2; S.tA = (size_t)256 * 512 * 2;
                EpiS5Out E; E.zs5 = (bf16_t*)(p.ws + WS_ZS5);
                if (SUBM & 4) gemm_phase(TID, lds, 512, 512, S, E);
                __syncthreads();
                { const int head_ = ((b + 128) % G) & 3, kk_ = TID & 63; float wg_[2][16], bg_[2];
                  _Pragma("unroll") for (int d = 0; d < 2; ++d) { bg_[d] = p.in[16][(l * 2 + d) * 256 + head_ * 64 + kk_]; _Pragma("unroll") for (int j = 0; j < 16; ++j) wg_[d][j] = p.in[15][((size_t)(l * 2 + d) * 16 + j) * 256 + head_ * 64 + kk_]; }
                  float ng_[16]; _Pragma("unroll") for (int e = 0; e < 16; ++e) ng_[e] = p.in[17][l * 512 + head_ * 128 + (TID & 7) * 16 + e];
                  for (int it = (b + 128) % G; it < NCK * 4; it += G) gla_item<1>(TID, p, l, it >> 2, it & 3, lds, wg_, bg_, ng_); }
                lru_phase<1>(TID, b, G, p, l, lds);
            } else if (k == 5 && (PHM & 32)) {
                TileOrder S; S.nM = MP / 256; S.nN = 2; S.nwg = S.nM * S.nN; S.G = G; S.c = b; S.mult = 1; S.nt0 = 8; S.A = ws + WS_ZS5; S.B = ws + WS_BTGLU; S.tA = (size_t)256 * 512 * 2; S.tB = (size_t)256 * 512 * 2;
                EpiGlu E; E.zs5 = (const bf16_t*)(p.ws + WS_ZS5); E.cols = (const bf16_t*)(p.ws + WS_COLS); E.bglu = p.in[14] + l * 512; E.yall = (bf16_t*)(p.ws + WS_YALL);
                gemm_phase(TID, lds, 512, 512, S, E);
            } else if (k == 6 && (PHM & 64)) {
                TileOrder S; S.nM = 96; S.nN = 8; S.nwg = S.nM * S.nN; S.G = G; S.c = b; S.mult = 3; S.nt0 = 8; S.A = ws + WS_YALL; S.B = ws + WS_BTOUT; S.tA = (size_t)256 * D * 2; S.tB = (size_t)256 * D * 2;
                EpiOut E; E.cols = (const bf16_t*)(p.ws + WS_COLS); E.mbf = (bf16_t*)(p.ws + WS_H);
                gemm_phase(TID, lds, D, D, S, E);
                skinny_tail<0>(TID, b, p, 0);
            } else if (PHM & 128) {
                TileOrder S; S.nM = 96; S.nN = 8; S.nwg = S.nM * S.nN; S.G = G; S.c = b; S.mult = 1; S.nt0 = D / 64; S.A = ws + WS_H; S.B = ws + WS_BTO; S.tA = (size_t)256 * D * 2; S.tB = (size_t)256 * D * 2;
                EpiWo E; E.z = (float*)(p.ws + WS_Z); E.pp = &p; E.first = (l == 0);
                gemm_phase(TID, lds, D, D, S, E);
                skinny_tail<1>(TID, b, p, l == 0);
            }
        }
        }
        if (p0.use_sync && ph + 1 < p0.ph_hi) { if (ph == p0.ph_lo) grid.sync(); else xcd_barrier(xb); }
    }
}

extern "C" void kernel_launch(void* const* d_in, const int* in_sizes, int n_in, void* d_out, int out_size, void* d_ws, size_t ws_size, hipStream_t stream) {
    static int grid = 0, coop = 1;
    if (grid == 0) {
        if (n_in != 30 || ws_size < WS_END3) { fprintf(stderr, "kernel_launch: unexpected n_in %d or ws_size %zu (< %zu)\n", n_in, ws_size, (size_t)WS_END); grid = -1; return; }
        int dev = 0, cus = 0, per_cu = 0;
        (void)hipGetDevice(&dev); (void)hipDeviceGetAttribute(&cus, hipDeviceAttributeMultiprocessorCount, dev);
        if (hipFuncSetAttribute((const void*)fwd_megakernel, hipFuncAttributeMaxDynamicSharedMemorySize, LDS_BYTES) != hipSuccess) { fprintf(stderr, "kernel_launch: hipFuncSetAttribute failed\n"); grid = -1; return; }
        if (hipOccupancyMaxActiveBlocksPerMultiprocessor(&per_cu, (const void*)fwd_megakernel, 512, LDS_BYTES) != hipSuccess || per_cu < 1) { fprintf(stderr, "kernel_launch: occupancy query gave %d\n", per_cu); per_cu = 1; }
        (void)hipGetLastError();
        grid = cus * 1;
    }
    if (grid < 0) return;
    Params p{};
    for (int i = 0; i < 30; ++i) p.in[i] = (const float*)d_in[i];
    p.out = (float*)d_out; p.ws = (unsigned char*)d_ws; p.pad = 0;
    (void)hipMemsetAsync((char*)d_ws + WS_BAR, 0, 3456 * 4, stream);
    if (coop) {
        p.ph_lo = 0; p.ph_hi = 33; p.use_sync = 1;
        void* args[] = {&p};
        hipError_t e = hipLaunchCooperativeKernel((const void*)fwd_megakernel, dim3(grid), dim3(512), args, LDS_BYTES, stream);
        if (e == hipSuccess) return;
        fprintf(stderr, "kernel_launch: cooperative launch failed: %s (grid %d); falling back to one launch per phase\n", hipGetErrorString(e), grid);
        (void)hipGetLastError(); coop = 0;
    }
    for (int ph = 0; ph < 33; ++ph) { p.ph_lo = ph; p.ph_hi = ph + 1; p.use_sync = 0; hipLaunchKernelGGL(fwd_megakernel, dim3(grid), dim3(512), LDS_BYTES, stream, p); }
}
```

```cpp
#include <hip/hip_runtime.h>
#include <hip/hip_cooperative_groups.h>
#include <cstdio>
namespace cg = cooperative_groups;
#define LAS __attribute__((address_space(3)))
typedef unsigned short bf16_t;
typedef short bf16x8 __attribute__((ext_vector_type(8)));
typedef float f32x4 __attribute__((ext_vector_type(4)));
typedef float f32x2 __attribute__((ext_vector_type(2)));
typedef unsigned u32x2 __attribute__((ext_vector_type(2)));
typedef unsigned u32x4 __attribute__((ext_vector_type(4)));

constexpr int D = 2048, NTOK = 24736, MP = 24832, NINP = 11008, NIN = 10784;
constexpr int NCH16 = 1546, CHP = 1792, NCK = 394;
constexpr int C_GA = 512, C_Q = 1024, C_K = 1280, C_V = 1536, C_GB = 2048, C_XC = 2560, C_GC = 3584, C_MG = 4608, C_GLR = 10752;
constexpr int LDS_BYTES = 150528 + 16;
#ifndef SYNCREP
#define SYNCREP 1
#endif
#ifndef DUP
#define DUP -1
#endif
#ifndef SUBM
#define SUBM 7
#endif
#ifndef PHM
#define PHM 255
#endif

constexpr size_t al256(size_t x) { return (x + 255) & ~(size_t)255; }
constexpr size_t WS_Z = 0;
constexpr size_t WS_H = WS_Z + al256((size_t)MP * D * 4);
constexpr size_t WS_COLS = WS_H + al256((size_t)MP * D * 2);
constexpr size_t WS_YALL = WS_COLS + al256((size_t)MP * NINP * 2);
constexpr size_t WS_ZS5 = WS_YALL + al256((size_t)MP * D * 2);
constexpr size_t WS_UBUF = WS_ZS5 + al256((size_t)MP * 512 * 2);
constexpr size_t WS_ST = WS_UBUF + al256((size_t)32 * CHP * 512 * 2);
constexpr size_t WS_DS = WS_ST + al256((size_t)32 * CHP * 256 * 4);
constexpr size_t WS_M32 = WS_UBUF;
constexpr size_t WS_DECAY = WS_DS + al256((size_t)NCK * 4 * 2 * 8192 * 4);
constexpr size_t WS_LRUA = WS_DECAY + al256((size_t)NCK * 4 * 2 * 64 * 4);
constexpr size_t WS_LRUH = WS_LRUA + al256((size_t)NCK * 2 * 1024 * 4);
constexpr size_t WS_LRUC = WS_LRUH + al256((size_t)NCK * 2 * 1024 * 4);
constexpr size_t WS_PW = WS_LRUC + al256((size_t)NCK * 2 * 1024 * 4);
constexpr size_t WS_BBAR = WS_PW + al256((size_t)4 * 32 * 2 * 17 * 64 * 8);
constexpr size_t WS_WMAT = WS_BBAR + al256((size_t)4 * 32 * 2 * 64 * 16 * 8);
constexpr size_t WS_PMAT = WS_WMAT + al256((size_t)32 * 256 * 512 * 2);
constexpr size_t WS_BTIN = WS_PMAT + al256((size_t)32 * 256 * 256 * 2);
constexpr size_t WS_BTOUT = WS_BTIN + al256((size_t)NINP * D * 2);
constexpr size_t WS_BTO = WS_BTOUT + al256((size_t)D * D * 2);
constexpr size_t WS_BTGLU = WS_BTO + al256((size_t)D * D * 2);
constexpr size_t WS_BTLRU = WS_BTGLU + al256((size_t)512 * 512 * 2);
constexpr size_t WS_KMAT = WS_BTLRU + al256((size_t)32 * 128 * 128 * 2);
constexpr size_t WS_BAR = WS_KMAT + al256((size_t)32 * 2 * 16 * 256 * 4);
constexpr size_t WS_END = WS_BAR + al256((size_t)3456 * 4);
constexpr size_t WS_GB = WS_END;
constexpr size_t WS_END2 = WS_GB + al256((size_t)NCK * 4 * 8192 * 4);
constexpr size_t WS_SPB = WS_END2;
constexpr size_t WS_END3 = WS_SPB + al256((size_t)NCK * 4 * 2 * 8192 * 2);
constexpr size_t PWL = (size_t)32 * 2 * 17 * 64, BBL = (size_t)32 * 2 * 64 * 16;
static_assert(WS_END3 <= (size_t)1413480448, "workspace too large");
static_assert((size_t)MP * D * 4 <= WS_DECAY - WS_UBUF, "m32 alias too small");

struct Params { const float* in[30]; float* out; unsigned char* ws; int ph_lo, ph_hi, use_sync, pad; };

#define LBAR() do { asm volatile("s_waitcnt lgkmcnt(0)" ::: "memory"); __builtin_amdgcn_s_barrier(); asm volatile("" ::: "memory"); } while (0)
__device__ __forceinline__ unsigned cvt_pk_bf16(float lo, float hi) { unsigned r; asm volatile("v_cvt_pk_bf16_f32 %0, %1, %2" : "=v"(r) : "v"(lo), "v"(hi)); return r; }
__device__ __forceinline__ bf16_t f2bf(float f) { return (bf16_t)(cvt_pk_bf16(f, 0.f) & 0xffffu); }
__device__ __forceinline__ bf16_t f2bf_sw(float f) { unsigned u = __float_as_uint(f); u += 0x7FFFu + ((u >> 16) & 1u); return (bf16_t)(u >> 16); }
__device__ __forceinline__ float bf2f(bf16_t b) { return __uint_as_float(((unsigned)b) << 16); }
__device__ __forceinline__ float bflo(unsigned w) { return __uint_as_float(w << 16); }
__device__ __forceinline__ float bfhi(unsigned w) { return __uint_as_float(w & 0xffff0000u); }
__device__ __forceinline__ float sigm(float x) { return __builtin_amdgcn_rcpf(1.0f + __expf(-x)); }
__device__ __forceinline__ float silu(float x) { return x * sigm(x); }
__device__ __forceinline__ float gelu_t(float x) { const float u = 0.7978845608028654f * (x + 0.044715f * x * x * x); return x * sigm(2.0f * u); }
__device__ __forceinline__ float logsig(float x) { return -(fmaxf(-x, 0.f) + __logf(1.0f + __expf(-fabsf(x)))); }

__device__ __forceinline__ int seq_start(int s) { return s < 2 ? s * 4112 : 8224 + (s - 2) * 2064; }
__device__ __forceinline__ int seq_len(int s) { return s < 2 ? 4112 : 2064; }
__device__ __forceinline__ void chunk_info(int ci, int& seq, int& c) { if (ci < 130) { seq = ci / 65; c = ci - seq * 65; } else { const int t = ci - 130; const int q = t / 33; seq = 2 + q; c = t - q * 33; } }

constexpr int BM = 256, BK = 64, HALF = 128, HTB = HALF * BK * 2, STAGE_BYTES = 8 * HTB, NXCD = 8, WGM = 8;
__device__ __forceinline__ int lds_byte(int r, int c) { const int st = (r >> 4) * 2 + (c >> 5), rr = r & 15, cc = c & 31, ob = rr * 64 + cc * 2; return st * 1024 + (ob ^ (((ob >> 9) & 1) << 5)); }
__device__ __forceinline__ void stage_rc(int b, int& R, int& C) { const int st = b / 1024, sb = b % 1024, swz = sb ^ (((sb >> 9) & 1) << 5); R = (st >> 1) * 16 + swz / 64; C = (st & 1) * 32 + (swz % 64) / 2; }

struct Unit { int pm, pn, sub, nt; const char* a; const char* b; };

struct TileOrder {
    int nM, nN, nwg, G, c, mult, nt0; const char* A; const char* B; size_t tA, tB;
    __device__ __forceinline__ bool next(int i, Unit& u) const {
        const int ti = i / mult, sub = i - ti * mult;
        const long L = (long)ti * G + c; if (L >= nwg) return false;
        int wgid = (int)L; { const int q = nwg / NXCD, r = nwg % NXCD, xcd = wgid % NXCD, off = wgid / NXCD; wgid = (xcd < r ? xcd * (q + 1) : r * (q + 1) + (xcd - r) * q) + off; }
        const int nig = WGM * nN, gid = wgid / nig, fm = gid * WGM, gsz = (nM - fm) < WGM ? (nM - fm) : WGM;
        u.pm = fm + ((wgid % nig) % gsz); u.pn = (wgid % nig) / gsz; u.sub = sub;
        const int koff = (mult == 3) ? sub * 512 : 0; u.nt = (mult == 3) ? (sub == 2 ? 16 : 8) : nt0;
        u.a = A + (size_t)u.pm * tA + (size_t)koff * 2; u.b = B + (size_t)u.pn * tB + (size_t)koff * 2; return true;
    }
};
struct GroupOrder {
    int G, c, nt0; const char* A; const char* B; size_t gsA, gsB, tA;
    __device__ __forceinline__ bool next(int i, Unit& u) const {
        const int L = i * G + c; if (L >= 224) return false;
        const int g = L / 7, pm = L - g * 7; u.pm = pm; u.pn = 0; u.sub = g; u.nt = nt0;
        u.a = A + (size_t)g * gsA + (size_t)pm * tA; u.b = B + (size_t)g * gsB; return true;
    }
};

__device__ __forceinline__ int perm32(int rho) { const int n = rho >> 4, i = rho & 15; return 8 * (i >> 2) + 4 * n + (i & 3); }
template <class Epi, class Sched>
__device__ __forceinline__ void gemm_phase(const int TID, LAS unsigned char* lds, const int lda, const int ldb, const Sched& S, const Epi& E) {
    const int tid = TID, wid = __builtin_amdgcn_readfirstlane(tid >> 6), lane = tid & 63, wr = wid >> 2, wc = wid & 3, fr = lane & 15, fq = lane >> 4;
    unsigned voffA[2], voffB[2];
#pragma unroll
    for (int i = 0; i < 2; ++i) { int R, C; stage_rc(tid * 16 + i * 8192, R, C); const int Rb = Epi::PERM ? ((R & ~31) + perm32(R & 31)) : R; voffA[i] = (unsigned)(R * lda + C) * 2u; voffB[i] = (unsigned)(Rb * ldb + C) * 2u; }
    const size_t kstep = (size_t)(BK * 2);
    const size_t hA = (size_t)HALF * lda * 2, hB = (size_t)HALF * ldb * 2;
    const unsigned ldsw = (unsigned)wid * 1024u;
    const int aoff = lds_byte(wr * 64 + fr, fq * 8), boff = lds_byte(wc * 32 + fr, fq * 8);
#define PG8_SA(b, h) (((b) * 2 + (h)) * HTB)
#define PG8_SB(b, h) ((4 + (b) * 2 + (h)) * HTB)
#define PG8_STAGE(bufoff, gbase, voff) do { _Pragma("unroll") for (int _i = 0; _i < 2; ++_i) \
        __builtin_amdgcn_global_load_lds((const unsigned*)((const char*)(gbase) + (voff)[_i]), (LAS unsigned*)(lds + (bufoff) + ldsw + _i * 8192), 16, 0, 0); } while (0)
#define PG8_LDA(dst, b, h) do { _Pragma("unroll") for (int m = 0; m < 4; ++m) _Pragma("unroll") for (int k = 0; k < 2; ++k) dst[m][k] = *(const LAS bf16x8*)(lds + PG8_SA(b, h) + aoff + m * 2048 + k * 1024); } while (0)
#define PG8_LDB(dst, b, h) do { _Pragma("unroll") for (int n = 0; n < 2; ++n) _Pragma("unroll") for (int k = 0; k < 2; ++k) dst[n][k] = *(const LAS bf16x8*)(lds + PG8_SB(b, h) + boff + n * 2048 + k * 1024); } while (0)
#define PG8_MMA(ai, bj, At, Bt) do { __builtin_amdgcn_s_setprio(1); _Pragma("unroll") for (int m = 0; m < 4; ++m) _Pragma("unroll") for (int n = 0; n < 2; ++n) _Pragma("unroll") for (int k = 0; k < 2; ++k) \
        acc[ai][bj][m][n] = __builtin_amdgcn_mfma_f32_16x16x32_bf16(Bt[n][k], At[m][k], acc[ai][bj][m][n], 0, 0, 0); __builtin_amdgcn_s_setprio(0); } while (0)
#define PG8_WAIT_V(n) asm volatile("s_waitcnt vmcnt(" #n ")" ::: "memory")
#define PG8_WAIT_L(n) asm volatile("s_waitcnt lgkmcnt(" #n ")" ::: "memory")
#define PG8_BAR __builtin_amdgcn_s_barrier()
#define PG8_SCHED __builtin_amdgcn_sched_barrier(0)
    Unit cur, nxt; int ui = 0;
    if (!S.next(0, cur)) return;
    f32x4 acc[2][2][4][2];
#pragma unroll
    for (int a = 0; a < 2; ++a)
#pragma unroll
        for (int b = 0; b < 2; ++b)
#pragma unroll
            for (int m = 0; m < 4; ++m)
#pragma unroll
                for (int n = 0; n < 2; ++n) acc[a][b][m][n] = (f32x4){0.f, 0.f, 0.f, 0.f};
    bf16x8 At[4][2], B0[2][2], B1[2][2];
    const char* cA = cur.a; const char* cB = cur.b;
    PG8_STAGE(PG8_SB(0, 0), cB, voffB); PG8_STAGE(PG8_SA(0, 0), cA, voffA); PG8_STAGE(PG8_SB(0, 1), cB + hB, voffB); PG8_STAGE(PG8_SA(0, 1), cA + hA, voffA);
    if (wr == 1) PG8_BAR;
    PG8_WAIT_V(4); PG8_BAR;
    PG8_STAGE(PG8_SB(1, 0), cB + kstep, voffB); PG8_STAGE(PG8_SA(1, 0), cA + kstep, voffA); PG8_STAGE(PG8_SB(1, 1), cB + hB + kstep, voffB);
    PG8_WAIT_V(6); PG8_BAR;
    for (;;) {
        const bool has_next = S.next(ui + 1, nxt);
        const char* nA = has_next ? nxt.a : cA; const char* nB = has_next ? nxt.b : cB;
        const int nt = cur.nt;
        for (int t = 0; t < nt; t += 2) {
            const bool last = (t == nt - 2);
            const char* a1 = cA + (size_t)(t + 1) * kstep;
            const char* a2 = last ? nA : cA + (size_t)(t + 2) * kstep; const char* b2 = last ? nB : cB + (size_t)(t + 2) * kstep;
            const char* a3 = a2 + kstep; const char* b3 = b2 + kstep;
            PG8_LDB(B0, 0, 0); PG8_SCHED; PG8_LDA(At, 0, 0); PG8_STAGE(PG8_SA(1, 1), a1 + hA, voffA);
            PG8_WAIT_L(8); PG8_BAR; PG8_WAIT_L(0); PG8_MMA(0, 0, At, B0); PG8_BAR; PG8_SCHED;
            PG8_LDB(B1, 0, 1); PG8_STAGE(PG8_SB(0, 0), b2, voffB);
            PG8_BAR; PG8_WAIT_L(0); PG8_MMA(0, 1, At, B1); PG8_BAR;
            PG8_LDA(At, 0, 1); PG8_STAGE(PG8_SA(0, 0), a2, voffA);
            PG8_BAR; PG8_WAIT_L(0); PG8_MMA(1, 0, At, B0); PG8_BAR; PG8_SCHED;
            PG8_STAGE(PG8_SB(0, 1), b2 + hB, voffB);
            PG8_WAIT_V(6); PG8_BAR; PG8_MMA(1, 1, At, B1); PG8_BAR;
            PG8_LDB(B0, 1, 0); PG8_SCHED; PG8_LDA(At, 1, 0); PG8_STAGE(PG8_SA(0, 1), a2 + hA, voffA);
            PG8_WAIT_L(8); PG8_BAR; PG8_WAIT_L(0); PG8_MMA(0, 0, At, B0); PG8_BAR; PG8_SCHED;
            PG8_LDB(B1, 1, 1); PG8_STAGE(PG8_SB(1, 0), b3, voffB);
            PG8_BAR; PG8_WAIT_L(0); PG8_MMA(0, 1, At, B1); PG8_BAR;
            PG8_LDA(At, 1, 1); PG8_STAGE(PG8_SA(1, 0), a3, voffA);
            PG8_BAR; PG8_WAIT_L(0); PG8_MMA(1, 0, At, B0); PG8_BAR; PG8_SCHED;
            PG8_STAGE(PG8_SB(1, 1), b3 + hB, voffB);
            PG8_WAIT_V(6); PG8_BAR; PG8_MMA(1, 1, At, B1); PG8_BAR;
        }
        E(acc, cur, wr, wc, fr, fq);
        if (!has_next) break;
#pragma unroll
        for (int a = 0; a < 2; ++a)
#pragma unroll
            for (int b = 0; b < 2; ++b)
#pragma unroll
                for (int m = 0; m < 4; ++m)
#pragma unroll
                    for (int n = 0; n < 2; ++n) acc[a][b][m][n] = (f32x4){0.f, 0.f, 0.f, 0.f};
        cur = nxt; cA = nA; cB = nB; ++ui;
    }
    PG8_WAIT_V(0);
    if (wr == 0) PG8_BAR;
    PG8_BAR;
#undef PG8_SA
#undef PG8_SB
#undef PG8_STAGE
#undef PG8_LDA
#undef PG8_LDB
#undef PG8_MMA
#undef PG8_WAIT_V
#undef PG8_WAIT_L
#undef PG8_BAR
#undef PG8_SCHED
}

#define EPI_LOOP(...) \
    const int row0 = u.pm * BM + wr * 64 + fr, col0 = u.pn * BM + wc * 32 + 4 * fq; \
    _Pragma("unroll") for (int ai = 0; ai < 2; ++ai) _Pragma("unroll") for (int m = 0; m < 4; ++m) { const int r = row0 + ai * HALF + m * 16; \
        _Pragma("unroll") for (int bj = 0; bj < 2; ++bj) _Pragma("unroll") for (int n = 0; n < 2; ++n) { const int c = col0 + bj * HALF + n * 16; const f32x4 v = acc[ai][bj][m][n]; __VA_ARGS__ } }

#define EPI_PROWS(...) \
    const int row0 = u.pm * BM + wr * 64 + fr, col0 = u.pn * BM + wc * 32 + 8 * fq; \
    _Pragma("unroll") for (int ai = 0; ai < 2; ++ai) _Pragma("unroll") for (int m = 0; m < 4; ++m) { const int r = row0 + ai * HALF + m * 16; __VA_ARGS__ }
__device__ __forceinline__ u32x4 pack8(const f32x4 a, const f32x4 b) { u32x4 w; w[0] = cvt_pk_bf16(a[0], a[1]); w[1] = cvt_pk_bf16(a[2], a[3]); w[2] = cvt_pk_bf16(b[0], b[1]); w[3] = cvt_pk_bf16(b[2], b[3]); return w; }
__device__ __forceinline__ unsigned q8(float x) { return (unsigned)__float2uint_rn(__builtin_amdgcn_rcpf(fmaf(__expf(-x), 1.0f / 255.0f, 1.0f / 255.0f))); }
__device__ __forceinline__ unsigned q8x4(const f32x4 v) { return q8(v[0]) | (q8(v[1]) << 8) | (q8(v[2]) << 16) | (q8(v[3]) << 24); }
struct EpiIn { static constexpr bool PERM = true; bf16_t* cols; bf16_t* ubuf;
    __device__ __forceinline__ void operator()(const f32x4 (&acc)[2][2][4][2], const Unit& u, int wr, int wc, int fr, int fq) const {
        if (u.pn >= 18 && u.pn < 42) {
            EPI_PROWS({ u32x4 w; w[0] = q8x4(acc[ai][0][m][0]); w[1] = q8x4(acc[ai][0][m][1]); w[2] = q8x4(acc[ai][1][m][0]); w[3] = q8x4(acc[ai][1][m][1]);
                *(u32x4*)((unsigned char*)(cols + (size_t)r * NINP + C_MG) + (u.pn - 18) * 256 + (wc * 4 + fq) * 16) = w; })
        } else {
            EPI_PROWS({ _Pragma("unroll") for (int bj = 0; bj < 2; ++bj) { const int c = col0 + bj * HALF;
                bf16_t* dst = (u.pn < 2) ? ubuf + ((size_t)((c >> 4) * CHP + (r >> 4)) * 512 + (r & 15) * 16 + (c & 15)) : cols + (size_t)r * NINP + c;
                *(u32x4*)dst = pack8(acc[ai][bj][m][0], acc[ai][bj][m][1]); } })
        }
    } };
struct EpiS5State { static constexpr bool PERM = false; float* st;
    __device__ __forceinline__ void operator()(const f32x4 (&acc)[2][2][4][2], const Unit& u, int wr, int wc, int fr, int fq) const {
        EPI_LOOP({ u32x2 w; w.x = cvt_pk_bf16(v[0], v[1]); w.y = cvt_pk_bf16(v[2], v[3]); *(u32x2*)((bf16_t*)st + ((size_t)(u.sub * CHP + r)) * 256 + c) = w; })
    } };
struct EpiS5Out { static constexpr bool PERM = true; bf16_t* zs5;
    __device__ __forceinline__ void operator()(const f32x4 (&acc)[2][2][4][2], const Unit& u, int wr, int wc, int fr, int fq) const {
        EPI_PROWS({ if (r < NCH16) { _Pragma("unroll") for (int bj = 0; bj < 2; ++bj) { const int c = col0 + bj * HALF; f32x4 a = acc[ai][bj][m][0], b2 = acc[ai][bj][m][1];
            _Pragma("unroll") for (int e = 0; e < 4; ++e) { a[e] = gelu_t(a[e]); b2[e] = gelu_t(b2[e]); }
            *(u32x4*)(zs5 + (size_t)(r * 16 + (c >> 4)) * 512 + u.sub * 16 + (c & 15)) = pack8(a, b2); } } })
    } };
#define EPI_ROWS(...) \
    const int row0 = u.pm * BM + wr * 64 + fr, col0 = u.pn * BM + wc * 32 + 4 * fq; \
    _Pragma("unroll") for (int ai = 0; ai < 2; ++ai) _Pragma("unroll") for (int m = 0; m < 4; ++m) { const int r = row0 + ai * HALF + m * 16; __VA_ARGS__ }
#define QOFF(q) (((q) >> 1) * HALF + ((q) & 1) * 16)
#define EPI_PIPE(LOADF, COMPF) \
    const int row0 = u.pm * BM + wr * 64 + fr, col0 = u.pn * BM + wc * 32 + 8 * fq; \
    LOADF(0, 0); \
    _Pragma("unroll") for (int gi = 0; gi < 8; ++gi) { if (gi + 1 < 8) { if ((gi & 1) == 0) { LOADF(gi + 1, 1); } else { LOADF(gi + 1, 0); } } if ((gi & 1) == 0) { COMPF(gi, 0); } else { COMPF(gi, 1); } }
#define GROW(gi) (row0 + ((gi) >> 2) * HALF + ((gi) & 3) * 16)
struct EpiGlu { static constexpr bool PERM = true; const bf16_t* zs5; const bf16_t* cols; const float* bglu; bf16_t* yall;
    __device__ __forceinline__ void operator()(const f32x4 (&acc)[2][2][4][2], const Unit& u, int wr, int wc, int fr, int fq) const {
        u32x4 zz[2][2], gg[2][2]; f32x4 bb[2][2];
        { const int c0 = u.pn * BM + wc * 32 + 8 * fq; _Pragma("unroll") for (int bj = 0; bj < 2; ++bj) { bb[bj][0] = *(const f32x4*)(bglu + c0 + bj * HALF); bb[bj][1] = *(const f32x4*)(bglu + c0 + bj * HALF + 4); } }
#define GLU_LOAD(gi, bf) do { const int r_ = GROW(gi); _Pragma("unroll") for (int bj = 0; bj < 2; ++bj) { const int c = col0 + bj * HALF; zz[bf][bj] = *(const u32x4*)(zs5 + (size_t)r_ * 512 + c); gg[bf][bj] = *(const u32x4*)(cols + (size_t)r_ * NINP + C_GA + c); } } while (0)
#define GLU_COMP(gi, bf) do { const int r_ = GROW(gi); _Pragma("unroll") for (int bj = 0; bj < 2; ++bj) { const int c = col0 + bj * HALF; f32x4 o[2]; \
            _Pragma("unroll") for (int hf = 0; hf < 2; ++hf) { const f32x4 v = acc[(gi) >> 2][bj][(gi) & 3][hf]; \
                o[hf][0] = bflo(zz[bf][bj][2 * hf]) * sigm(v[0] + bb[bj][hf][0]) * silu(bflo(gg[bf][bj][2 * hf])); o[hf][1] = bfhi(zz[bf][bj][2 * hf]) * sigm(v[1] + bb[bj][hf][1]) * silu(bfhi(gg[bf][bj][2 * hf])); \
                o[hf][2] = bflo(zz[bf][bj][2 * hf + 1]) * sigm(v[2] + bb[bj][hf][2]) * silu(bflo(gg[bf][bj][2 * hf + 1])); o[hf][3] = bfhi(zz[bf][bj][2 * hf + 1]) * sigm(v[3] + bb[bj][hf][3]) * silu(bfhi(gg[bf][bj][2 * hf + 1])); } \
            *(u32x4*)(yall + (size_t)r_ * D + c) = pack8(o[0], o[1]); } } while (0)
        EPI_PIPE(GLU_LOAD, GLU_COMP)
#undef GLU_LOAD
#undef GLU_COMP
    } };
__device__ __forceinline__ float ub(unsigned w, int k) { return (float)((w >> (8 * k)) & 255u) * (1.0f / 255.0f); }
struct EpiOut { static constexpr bool PERM = true; const bf16_t* cols; bf16_t* mbf;
    __device__ __forceinline__ void operator()(const f32x4 (&acc)[2][2][4][2], const Unit& u, int wr, int wc, int fr, int fq) const {
        u32x4 gg[8], mm[2][2];
        { const int row0g = u.pm * BM + wr * 64 + fr;
#pragma unroll
          for (int gi = 0; gi < 8; ++gi) gg[gi] = *(const u32x4*)((const unsigned char*)(cols + (size_t)(row0g + (gi >> 2) * HALF + (gi & 3) * 16) * NINP + C_MG) + (u.sub * 8 + u.pn) * 256 + (wc * 4 + fq) * 16); }
#define OUT_LOAD(gi, bf) do { const int r_ = GROW(gi); const bf16_t* mp = mbf + (size_t)r_ * D + col0; \
            _Pragma("unroll") for (int bj = 0; bj < 2; ++bj) { mm[bf][bj] = (u32x4){0u, 0u, 0u, 0u}; if (u.sub != 0) mm[bf][bj] = *(const u32x4*)(mp + bj * HALF); } } while (0)
#define OUT_COMP(gi, bf) do { const int r_ = GROW(gi); bf16_t* mp = mbf + (size_t)r_ * D + col0; _Pragma("unroll") for (int bj = 0; bj < 2; ++bj) { f32x4 o[2]; \
            _Pragma("unroll") for (int hf = 0; hf < 2; ++hf) { const f32x4 v = acc[(gi) >> 2][bj][(gi) & 3][hf]; const unsigned gw = gg[gi][bj * 2 + hf]; \
                o[hf][0] = bflo(mm[bf][bj][2 * hf]) + ub(gw, 0) * v[0]; o[hf][1] = bfhi(mm[bf][bj][2 * hf]) + ub(gw, 1) * v[1]; \
                o[hf][2] = bflo(mm[bf][bj][2 * hf + 1]) + ub(gw, 2) * v[2]; o[hf][3] = bfhi(mm[bf][bj][2 * hf + 1]) + ub(gw, 3) * v[3]; } \
            *(u32x4*)(mp + bj * HALF) = pack8(o[0], o[1]); } } while (0)
        EPI_PIPE(OUT_LOAD, OUT_COMP)
#undef OUT_LOAD
#undef OUT_COMP
    } };
__device__ __forceinline__ const float* src_row(const Params& p, int r);
struct EpiWo { static constexpr bool PERM = false; float* z; const Params* pp; int first;
    __device__ __forceinline__ void operator()(const f32x4 (&acc)[2][2][4][2], const Unit& u, int wr, int wc, int fr, int fq) const {
        EPI_ROWS({ if (r < NTOK) { float* zp = z + (size_t)r * D + col0; const float* rp = first ? src_row(*pp, r) + col0 : zp; f32x4 pv[4];
            _Pragma("unroll") for (int q = 0; q < 4; ++q) pv[q] = *(const f32x4*)(rp + QOFF(q));
            _Pragma("unroll") for (int q = 0; q < 4; ++q) *(f32x4*)(zp + QOFF(q)) = pv[q] + acc[ai][q >> 1][m][q & 1]; } })
    } };

__device__ __forceinline__ const float* src_row(const Params& p, int r) {
    int s, pos; if (r < 8224) { s = r / 4112; pos = r - s * 4112; } else { const int t = r - 8224; const int q = t / 2064; s = 2 + q; pos = t - q * 2064; }
    if (pos < 16) return p.in[2] + (size_t)pos * D;
    return s < 2 ? p.in[0] + ((size_t)s * 4096 + (pos - 16)) * D : p.in[1] + ((size_t)(s - 2) * 2048 + (pos - 16)) * D;
}
__device__ __forceinline__ void rmsnorm_phase(const int TID, const int BID, const Params& p, int l) {
    float* z = (float*)(p.ws + WS_Z); bf16_t* h = (bf16_t*)(p.ws + WS_H); const float* g = p.in[3] + (size_t)l * D;
    const int lane = TID & 63, gw = BID * 8 + (TID >> 6), nw = gridDim.x * 8;
    f32x4 gg[8];
#pragma unroll
    for (int i = 0; i < 8; ++i) gg[i] = *(const f32x4*)(g + (i * 64 + lane) * 4);
    f32x4 xn[8];
    { const int r0 = gw < NTOK ? gw : NTOK - 1; const float* src = (l == 0) ? src_row(p, r0) : z + (size_t)r0 * D;
#pragma unroll
      for (int i = 0; i < 8; ++i) xn[i] = *(const f32x4*)(src + (i * 64 + lane) * 4); }
    for (int r = gw; r < MP; r += nw) {
        bf16_t* hr = h + (size_t)r * D;
        f32x4 x[8];
#pragma unroll
        for (int i = 0; i < 8; ++i) x[i] = xn[i];
        { const int rn = (r + nw < NTOK) ? r + nw : NTOK - 1; const float* src = (l == 0) ? src_row(p, rn) : z + (size_t)rn * D;
#pragma unroll
          for (int i = 0; i < 8; ++i) xn[i] = *(const f32x4*)(src + (i * 64 + lane) * 4); }
        if (r >= NTOK) { for (int i = 0; i < 4; ++i) *(u32x4*)(hr + (i * 64 + lane) * 8) = (u32x4){0u, 0u, 0u, 0u}; continue; }
        float ss = 0.f;
#pragma unroll
        for (int i = 0; i < 8; ++i) ss += x[i][0] * x[i][0] + x[i][1] * x[i][1] + x[i][2] * x[i][2] + x[i][3] * x[i][3];
#pragma unroll
        for (int o = 32; o >= 1; o >>= 1) ss += __shfl_xor(ss, o);
        const float rs = rsqrtf(ss * (1.0f / D) + 1e-6f);
#pragma unroll
        for (int i = 0; i < 8; ++i) { const int c = (i * 64 + lane) * 4;
            u32x2 w; w.x = cvt_pk_bf16(x[i][0] * rs * gg[i][0], x[i][1] * rs * gg[i][1]); w.y = cvt_pk_bf16(x[i][2] * rs * gg[i][2], x[i][3] * rs * gg[i][3]); *(u32x2*)(hr + c) = w; }
    }
}
__device__ __forceinline__ void final_norm_phase(const int TID, const int BID, const Params& p) {
    const float* z = (const float*)(p.ws + WS_Z); const float* g = p.in[29];
    const int lane = TID & 63, gw = BID * 8 + (TID >> 6), nw = gridDim.x * 8;
    f32x4 gg[8];
#pragma unroll
    for (int i = 0; i < 8; ++i) gg[i] = *(const f32x4*)(g + (i * 64 + lane) * 4);
    f32x4 xn[8];
    { const int r0 = gw < NTOK ? gw : NTOK - 1;
#pragma unroll
      for (int i = 0; i < 8; ++i) xn[i] = *(const f32x4*)(z + (size_t)r0 * D + (i * 64 + lane) * 4); }
    for (int r = gw; r < NTOK; r += nw) {
        f32x4 x[8];
#pragma unroll
        for (int i = 0; i < 8; ++i) x[i] = xn[i];
        { const int rn = (r + nw < NTOK) ? r + nw : NTOK - 1;
#pragma unroll
          for (int i = 0; i < 8; ++i) xn[i] = *(const f32x4*)(z + (size_t)rn * D + (i * 64 + lane) * 4); }
        int s, pos; if (r < 8224) { s = r / 4112; pos = r - s * 4112; } else { const int t = r - 8224; const int q = t / 2064; s = 2 + q; pos = t - q * 2064; }
        if (pos < 16) continue;
        float* dst = s < 2 ? p.out + ((size_t)s * 4096 + (pos - 16)) * D : p.out + (size_t)2 * 4096 * D + ((size_t)(s - 2) * 2048 + (pos - 16)) * D;
        float ss = 0.f;
#pragma unroll
        for (int i = 0; i < 8; ++i) ss += x[i][0] * x[i][0] + x[i][1] * x[i][1] + x[i][2] * x[i][2] + x[i][3] * x[i][3];
#pragma unroll
        for (int o = 32; o >= 1; o >>= 1) ss += __shfl_xor(ss, o);
        const float rs = rsqrtf(ss * (1.0f / D) + 1e-6f);
#pragma unroll
        for (int i = 0; i < 8; ++i) { const int c = (i * 64 + lane) * 4; f32x4 o; o[0] = x[i][0] * rs * gg[i][0]; o[1] = x[i][1] * rs * gg[i][1]; o[2] = x[i][2] * rs * gg[i][2]; o[3] = x[i][3] * rs * gg[i][3]; __builtin_nontemporal_store(o, (f32x4*)(dst + c)); }
    }
}
__device__ __forceinline__ void conv_tile(const int TID, const float* src, int ldn, int k0, int n0, int nvalid, bf16_t* dst, int ldd, int kofs, bool mapin, LAS float* tile) {
    const int tx = TID & 63, ty = TID >> 6;
    const int ncl = (n0 + tx < nvalid) ? n0 + tx : nvalid - 1;
#pragma unroll
    for (int i = 0; i < 8; ++i) { const int k = ty + 8 * i; tile[k * 65 + tx] = src[(size_t)(k0 + k) * ldn + ncl]; }
    __syncthreads();
#pragma unroll
    for (int i = 0; i < 8; ++i) { const int nn = ty + 8 * i; int n = n0 + nn;
        if (n < nvalid) { if (mapin) n = (n < 2560) ? n : (n < 2592 ? n + (C_GLR - 2560) : n - 32); dst[(size_t)n * ldd + kofs + k0 + tx] = f2bf(tile[tx * 65 + nn]); } }
    __syncthreads();
}
__device__ __forceinline__ void convert_weights(const int TID, const int BID, const Params& p, int l, LAS float* tile) {
    const int G = gridDim.x, b = BID;
    bf16_t* btin = (bf16_t*)(p.ws + WS_BTIN); bf16_t* btout = (bf16_t*)(p.ws + WS_BTOUT); bf16_t* bto = (bf16_t*)(p.ws + WS_BTO); bf16_t* btglu = (bf16_t*)(p.ws + WS_BTGLU); bf16_t* btlru = (bf16_t*)(p.ws + WS_BTLRU);
    { const float* src = p.in[4] + (size_t)l * D * NIN; const int tx = TID & 63, ty = TID >> 6; float v[8];
      { const int t = b < 32 * 169 ? b : 0; const int kt = t / 169, ntl = t - kt * 169; const int ncl = (ntl * 64 + tx < NIN) ? ntl * 64 + tx : NIN - 1;
#pragma unroll
        for (int i = 0; i < 8; ++i) v[i] = src[(size_t)(kt * 64 + ty + 8 * i) * NIN + ncl]; }
      for (int t = b; t < 32 * 169; t += G) { const int kt = t / 169, ntl = t - kt * 169, k0 = kt * 64, n0 = ntl * 64;
#pragma unroll
          for (int i = 0; i < 8; ++i) tile[(ty + 8 * i) * 65 + tx] = v[i];
          { const int tn = (t + G < 32 * 169) ? t + G : t; const int ktn = tn / 169, ntn = tn - ktn * 169; const int ncl = (ntn * 64 + tx < NIN) ? ntn * 64 + tx : NIN - 1;
#pragma unroll
            for (int i = 0; i < 8; ++i) v[i] = src[(size_t)(ktn * 64 + ty + 8 * i) * NIN + ncl]; }
          LBAR();
#pragma unroll
          for (int i = 0; i < 8; ++i) { const int nn = ty + 8 * i; int n = n0 + nn;
              if (n < NIN) { n = (n < 2560) ? n : (n < 2592 ? n + (C_GLR - 2560) : n - 32); btin[(size_t)n * D + k0 + tx] = f2bf(tile[tx * 65 + nn]); } }
          LBAR(); } }
    for (size_t i = (size_t)b * 512 + TID; i < (size_t)(NINP - NIN) * D / 8; i += (size_t)G * 512) *(u32x4*)(btin + (size_t)NIN * D + i * 8) = (u32x4){0u, 0u, 0u, 0u};
    { const float* src = p.in[25] + (size_t)l * 512 * D; for (int t = (b + 64) % G; t < 8 * 32; t += G) { const int kt = t / 32, ntl = t - kt * 32; conv_tile(TID, src, D, kt * 64, ntl * 64, D, btout, D, 0, false, tile); } }
    { const float* src = p.in[26] + (size_t)l * 512 * D; for (int t = (b + 128) % G; t < 8 * 32; t += G) { const int kt = t / 32, ntl = t - kt * 32; conv_tile(TID, src, D, kt * 64, ntl * 64, D, btout, D, 512, false, tile); } }
    { const float* src = p.in[27] + (size_t)l * 1024 * D; for (int t = b; t < 16 * 32; t += G) { const int kt = t / 32, ntl = t - kt * 32; conv_tile(TID, src, D, kt * 64, ntl * 64, D, btout, D, 1024, false, tile); } }
    { const float* src = p.in[28] + (size_t)l * D * D; for (int t = b; t < 32 * 32; t += G) { const int kt = t / 32, ntl = t - kt * 32; conv_tile(TID, src, D, kt * 64, ntl * 64, D, bto, D, 0, false, tile); } }
    { const float* src = p.in[13] + (size_t)l * 512 * 512; for (int t = (b + 192) % G; t < 8 * 8; t += G) { const int kt = t / 8, ntl = t - kt * 8; conv_tile(TID, src, 512, kt * 64, ntl * 64, 512, btglu, 512, 0, false, tile); } }
    for (int t = (b + 32) % G; t < 128; t += G) { const int mat = t >> 2, sub = t & 3;
        const int dk = mat >> 3, nb = mat & 7, d = dk >> 1, kind = dk & 1;
        const float* src = p.in[kind ? 22 : 20] + ((size_t)(l * 2 + d) * 8 + nb) * 128 * 128;
        conv_tile(TID, src, 128, (sub >> 1) * 64, (sub & 1) * 64, 128, btlru + (size_t)mat * 128 * 128, 128, 0, false, tile); }
}
__device__ __forceinline__ double exp_small(double x) { double s = 1.0, t = 1.0; for (int i = 1; i <= 14; ++i) { t *= x / (double)i; s += t; } return s; }
__device__ __forceinline__ double exp_neg(double x) { double e = exp_small(x * (1.0 / 64.0)); for (int i = 0; i < 6; ++i) e *= e; return e; }
__device__ __forceinline__ void s5_tables_all(const int TID, const int BID, const Params& p) {
    for (int vidx = (int)(gridDim.x - 1 - BID) * 512 + TID; vidx < 4 * 4096; vidx += gridDim.x * 512) {
        const int l = vidx >> 12, idx = vidx & 4095;
        f32x2* pw = (f32x2*)(p.ws + WS_PW) + l * PWL; f32x2* bbar = (f32x2*)(p.ws + WS_BBAR) + l * BBL;
        const int g = idx >> 7, d = (idx >> 6) & 1, n = idx & 63;
        const double dt = exp_neg((double)p.in[7][(l * 2 + d) * 32 + g]);
        const double lr = (double)p.in[5][((size_t)(l * 2 + d) * 32 + g) * 64 + n], li = (double)p.in[6][((size_t)(l * 2 + d) * 32 + g) * 64 + n];
        const double mag = exp_neg(lr * dt);
        double ang = li * dt; const double twopi = 6.283185307179586476925287; ang -= twopi * rint(ang / twopi);
        const double a8 = ang * 0.125, a2 = a8 * a8;
        double sn = a8, cs = 1.0, ts = a8, tc = 1.0;
        for (int i = 1; i <= 9; ++i) { tc *= -a2 / (double)((2 * i - 1) * (2 * i)); cs += tc; ts *= -a2 / (double)((2 * i) * (2 * i + 1)); sn += ts; }
        for (int i = 0; i < 3; ++i) { const double c2 = cs * cs - sn * sn, s2 = 2.0 * cs * sn; cs = c2; sn = s2; }
        const double abr = mag * cs, abi = mag * sn;
        double pr = 1.0, pi = 0.0;
        for (int j = 0; j <= 16; ++j) { pw[((size_t)(g * 2 + d) * 17 + j) * 64 + n] = (f32x2){(float)pr, (float)pi}; const double nr = pr * abr - pi * abi, ni = pr * abi + pi * abr; pr = nr; pi = ni; }
        const double den = lr * lr + li * li, fr = ((abr - 1.0) * lr + abi * li) / den, fi = (abi * lr - (abr - 1.0) * li) / den;
        float brf[16], bif[16];
#pragma unroll
        for (int c4 = 0; c4 < 4; ++c4) { const f32x4 t0 = *(const f32x4*)(p.in[8] + (((size_t)l * 32 + g) * 64 + n) * 16 + c4 * 4), t1 = *(const f32x4*)(p.in[9] + (((size_t)l * 32 + g) * 64 + n) * 16 + c4 * 4);
#pragma unroll
            for (int e = 0; e < 4; ++e) { brf[c4 * 4 + e] = t0[e]; bif[c4 * 4 + e] = t1[e]; } }
#pragma unroll
        for (int c = 0; c < 16; ++c) { const double br = (double)brf[c], bi = (double)bif[c];
            bbar[((size_t)(g * 2 + d) * 64 + n) * 16 + c] = (f32x2){(float)(fr * br - fi * bi), (float)(fr * bi + fi * br)}; }
    }
}
__device__ __forceinline__ float s5_kval(const float* cre, const float* cim, const f32x2* pw, const f32x2* bbar, int l, int g, int d, int j, int c, int cp) {
    const float* cr = cre + (((size_t)(l * 2 + d) * 32 + g) * 16 + c) * 64; const float* ci = cim + (((size_t)(l * 2 + d) * 32 + g) * 16 + c) * 64;
    const f32x2* pp = pw + ((size_t)(g * 2 + d) * 17 + j) * 64; const f32x2* bb = bbar + ((size_t)(g * 2 + d) * 64) * 16 + cp;
    float s = 0.f;
#pragma unroll 16
    for (int n = 0; n < 64; ++n) { const f32x2 pv = pp[n]; const f32x2 bv = bb[(size_t)n * 16]; const float er = cr[n] * pv.x - ci[n] * pv.y, ei = cr[n] * pv.y + ci[n] * pv.x; s += er * bv.x - ei * bv.y; }
    return s;
}
__device__ __forceinline__ void s5_assemble_a(const int TID, const int BID, const Params& p, int l) {
    const f32x2* pw = (const f32x2*)(p.ws + WS_PW) + l * PWL; const f32x2* bbar = (const f32x2*)(p.ws + WS_BBAR) + l * BBL;
    float* kmat = (float*)(p.ws + WS_KMAT); bf16_t* pmat = (bf16_t*)(p.ws + WS_PMAT);
    const float* cre = p.in[10]; const float* cim = p.in[11];
    const size_t stride = (size_t)gridDim.x * 512;
    for (size_t idx = (size_t)BID * 512 + TID; idx < (size_t)32 * 2 * 16 * 256; idx += stride) {
        const int g = (int)(idx >> 13), d = (int)(idx >> 12) & 1, j = (int)(idx >> 8) & 15, c = (int)(idx >> 4) & 15, cp = (int)idx & 15;
        kmat[idx] = s5_kval(cre, cim, pw, bbar, l, g, d, j, c, cp);
    }
    for (size_t idx = (size_t)BID * 512 + TID; idx < (size_t)32 * 256 * 256; idx += stride) {
        const int g = (int)(idx >> 16), nout = (int)(idx >> 8) & 255, k = (int)idx & 255, d = nout >> 7, ri = (nout >> 6) & 1, n = nout & 63, s = k >> 4, cp = k & 15, j = d == 0 ? 15 - s : s;
        const f32x2 pv = pw[((size_t)(g * 2 + d) * 17 + j) * 64 + n]; const f32x2 bv = bbar[((size_t)(g * 2 + d) * 64 + n) * 16 + cp];
        pmat[idx] = f2bf(ri == 0 ? pv.x * bv.x - pv.y * bv.y : pv.x * bv.y + pv.y * bv.x);
    }
}
__device__ __forceinline__ void s5_assemble_w(const int TID, const int BID, const Params& p, int l) {
    const f32x2* pw = (const f32x2*)(p.ws + WS_PW) + l * PWL; const float* kmat = (const float*)(p.ws + WS_KMAT);
    bf16_t* wmat = (bf16_t*)(p.ws + WS_WMAT);
    const float* cre = p.in[10]; const float* cim = p.in[11];
    const size_t stride = (size_t)gridDim.x * 512;
    for (size_t idx = (size_t)BID * 512 + TID; idx < (size_t)32 * 256 * 512; idx += stride) {
        const int g = (int)(idx >> 17), nout = (int)(idx >> 9) & 255, k = (int)idx & 511, t = nout >> 4, c = nout & 15;
        float val;
        if (k < 256) { const int s = k >> 4, cp = k & 15; val = 0.f;
            const int jf = s <= t ? t - s : 0, jb = s >= t ? s - t : 0;
            const float kf = kmat[((((size_t)g * 2 + 0) * 16 + jf) * 16 + c) * 16 + cp], kb = kmat[((((size_t)g * 2 + 1) * 16 + jb) * 16 + c) * 16 + cp], dsk = p.in[12][l * 512 + g * 16 + c];
            val = (s <= t ? kf : 0.f) + (s >= t ? kb : 0.f) + ((s == t && c == cp) ? dsk : 0.f);
        } else { const int kk = k - 256, d = kk >> 7, ri = (kk >> 6) & 1, n = kk & 63, j = d == 0 ? t + 1 : 16 - t;
            const float cr = cre[(((size_t)(l * 2 + d) * 32 + g) * 16 + c) * 64 + n], ci = cim[(((size_t)(l * 2 + d) * 32 + g) * 16 + c) * 64 + n];
            const f32x2 pv = pw[((size_t)(g * 2 + d) * 17 + j) * 64 + n];
            val = ri == 0 ? cr * pv.x - ci * pv.y : -(cr * pv.y + ci * pv.x); }
        wmat[idx] = f2bf(val);
    }
}

__device__ __forceinline__ void scans_phase(const int TID, const int BID, const Params& p, const int l, const bool do_gla) {
    const int G = gridDim.x;
    const bool split = (G == 256);
    {
        const f32x2* pw = (const f32x2*)(p.ws + WS_PW) + l * PWL; const bf16_t* st = (const bf16_t*)(p.ws + WS_ST); bf16_t* ub = (bf16_t*)(p.ws + WS_UBUF);
        for (int idx = BID * 512 + TID; idx < 40960; idx += G * 512) {
            const int seq = idx >> 12, rem = idx & 4095, g = rem >> 7, d = (rem >> 6) & 1, n = rem & 63;
            const int ch0 = seq < 2 ? seq * 257 : 514 + (seq - 2) * 129, nc = seq < 2 ? 257 : 129;
            const f32x2 a16 = pw[((size_t)(g * 2 + d) * 17 + 16) * 64 + n];
            float sr = 0.f, si = 0.f;
            for (int s0 = 0; s0 < nc; s0 += 32) {
                float lr[32], li[32];
#pragma unroll
                for (int i = 0; i < 32; ++i) { const int step = s0 + i; lr[i] = 0.f; li[i] = 0.f;
                    { const int sc = step < nc ? step : nc - 1; const int c = d == 0 ? sc : nc - 1 - sc; const size_t row = (size_t)g * CHP + ch0 + c; lr[i] = bf2f(st[row * 256 + d * 128 + n]); li[i] = bf2f(st[row * 256 + d * 128 + 64 + n]); } }
#pragma unroll
                for (int i = 0; i < 32; ++i) { const int step = s0 + i;
                    if (step < nc) { const int c = d == 0 ? step : nc - 1 - step; const size_t row = (size_t)g * CHP + ch0 + c;
                        ub[row * 512 + 256 + d * 128 + n] = f2bf(sr); ub[row * 512 + 256 + d * 128 + 64 + n] = f2bf(si);
                        const float nr = a16.x * sr - a16.y * si + lr[i], ni = a16.x * si + a16.y * sr + li[i]; sr = nr; si = ni; } }
            }
        }
    }
    {
        const float* la = (const float*)(p.ws + WS_LRUA); const float* lh = (const float*)(p.ws + WS_LRUH); float* lc = (float*)(p.ws + WS_LRUC);
        const int vb0 = split ? BID - 80 : BID, vstride = split ? 1 << 20 : G;
        for (int vb = vb0; vb >= 0 && vb < 40; vb += vstride) {
            const int idx = vb * 512 + TID;
            const int seq = idx >> 11, d = (idx >> 10) & 1, ch = idx & 1023;
            const int cb = seq < 2 ? seq * 65 : 130 + (seq - 2) * 33, nc = seq < 2 ? 65 : 33;
            float cin = 0.f;
            for (int s0 = 0; s0 < nc; s0 += 16) {
                float A[16], H[16];
#pragma unroll
                for (int i = 0; i < 16; ++i) { const int step = s0 + i; A[i] = 1.f; H[i] = 0.f;
                    { const int sc = step < nc ? step : nc - 1; const int ci = cb + (d == 0 ? sc : nc - 1 - sc); const size_t o = ((size_t)ci * 2 + d) * 1024 + ch; A[i] = la[o]; H[i] = lh[o]; } }
#pragma unroll
                for (int i = 0; i < 16; ++i) { const int step = s0 + i;
                    if (step < nc) { const int ci = cb + (d == 0 ? step : nc - 1 - step); const size_t o = ((size_t)ci * 2 + d) * 1024 + ch; lc[o] = cin; cin = A[i] * cin + H[i]; } }
            }
        }
    }
    if (do_gla) {
        const bf16_t* ds = (const bf16_t*)(p.ws + WS_DS); const float* dec = (const float*)(p.ws + WS_DECAY); bf16_t* spb = (bf16_t*)(p.ws + WS_SPB);
        for (int it = 0; ; ++it) {
            int vb;
            if (split) { if (BID >= 120) { if (it >= 8) break; vb = (BID - 120) + 136 * it; } else { vb = 1088 + BID + 120 * it; if (vb >= 1280) break; } }
            else { vb = BID + G * it; if (vb >= 1280) break; }
            const int e = vb * 512 + TID;
            const int seq = e >> 16, rem = e & 65535, head = rem >> 14, d = (rem >> 13) & 1, el = rem & 8191, kk = el & 63;
            const int cb = seq < 2 ? seq * 65 : 130 + (seq - 2) * 33, nc = seq < 2 ? 65 : 33;
            float S = 0.f;
            for (int s0 = 0; s0 < nc; s0 += 16) {
                float tm[16], dc[16];
#pragma unroll
                for (int i = 0; i < 16; ++i) { const int step = s0 + i; tm[i] = 0.f; dc[i] = 1.f;
                    { const int sc = step < nc ? step : nc - 1; const int ci = cb + (d == 0 ? sc : nc - 1 - sc); const size_t o = ((size_t)(ci * 4 + head) * 2 + d); tm[i] = bf2f(ds[o * 8192 + el]); dc[i] = dec[o * 64 + kk]; } }
#pragma unroll
                for (int i = 0; i < 16; ++i) { const int step = s0 + i;
                    if (step < nc) { const int ci = cb + (d == 0 ? step : nc - 1 - step); const size_t o = ((size_t)(ci * 4 + head) * 2 + d); spb[o * 8192 + el] = f2bf(S); S = dc[i] * S + tm[i]; } }
            }
        }
    }
}

__device__ __forceinline__ f32x4 mma_lds(f32x4 acc, const LAS bf16_t* A, const LAS bf16_t* B, int ld, int nks, int lane) {
    const LAS bf16_t* ap = A + (lane & 15) * ld + (lane >> 4) * 8; const LAS bf16_t* bp = B + (lane & 15) * ld + (lane >> 4) * 8;
    for (int ks = 0; ks < nks; ++ks) acc = __builtin_amdgcn_mfma_f32_16x16x32_bf16(*(const LAS bf16x8*)(ap + ks * 32), *(const LAS bf16x8*)(bp + ks * 32), acc, 0, 0, 0);
    return acc;
}
__device__ __forceinline__ f32x4 mma_lds_sw(f32x4 acc, const LAS bf16_t* A, int rowA0, const LAS bf16_t* B, int rowB0, int ld, int nks, int lane) {
    const int swa = rowA0 >= 0 ? (((rowA0 + (lane & 15)) >> 3) & 7) : 0, swb = rowB0 >= 0 ? (((rowB0 + (lane & 15)) >> 3) & 7) : 0;
    const LAS bf16_t* ap = A + (lane & 15) * ld; const LAS bf16_t* bp = B + (lane & 15) * ld;
    for (int ks = 0; ks < nks; ++ks) { const int cb = ks * 4 + (lane >> 4);
        acc = __builtin_amdgcn_mfma_f32_16x16x32_bf16(*(const LAS bf16x8*)(ap + ((cb ^ swa) << 3)), *(const LAS bf16x8*)(bp + ((cb ^ swb) << 3)), acc, 0, 0, 0); }
    return acc;
}
#define SWZ(row, col) (((((col) >> 3) ^ (((row) >> 3) & 7)) << 3) + ((col) & 7))
constexpr int GL_GLR = 0, GL_BF = 16384, GL_BB = 32768, GL_OS = 0, GL_QE0 = 49152, GL_QE1 = 58368, GL_KE0 = 67584, GL_KE1 = 76800, GL_VT = 86016, GL_ATT = 104448, GL_SP0 = 113664, GL_SP1 = 132096;
constexpr int GLD = 72;
template <int MODE>
__device__ __forceinline__ void gla_item(const int TID, const Params& p, int l, int ci, int head, LAS unsigned char* lds, const float (&wg)[2][16], const float (&bg)[2], const float (&ngv)[16]) {
    const int tid = TID, lane = tid & 63, wid = tid >> 6;
    const bf16_t* cols = (const bf16_t*)(p.ws + WS_COLS);
    int seq, c; chunk_info(ci, seq, c);
    const int tok0 = seq_start(seq) + (c == 0 ? -48 : 16 + 64 * (c - 1));
    const int rmin = (c == 0) ? 48 : 0;
    LAS float* glr_s = (LAS float*)(lds + GL_GLR); LAS float* bfs = (LAS float*)(lds + GL_BF); LAS float* bbs = (LAS float*)(lds + GL_BB);
    f32x4 gbv[4];
    if (MODE == 1) { const float* gb = (const float*)(p.ws + WS_GB) + (size_t)(ci * 4 + head) * 8192;
#pragma unroll
      for (int i = 0; i < 4; ++i) gbv[i] = *(const f32x4*)(gb + (i * 512 + tid) * 4); }
    u32x4 kw = (u32x4){0u, 0u, 0u, 0u}, qw = kw, vwp[2], gwp[2];
    { const int r = tid >> 3, k8 = (tid & 7) * 8; const int rc = r >= rmin ? r : rmin; const bf16_t* rowp = cols + (size_t)(tok0 + rc) * NINP;
      kw = *(const u32x4*)(rowp + C_K + head * 64 + k8); if (MODE == 1) qw = *(const u32x4*)(rowp + C_Q + head * 64 + k8);
#pragma unroll
      for (int hh = 0; hh < 2; ++hh) { vwp[hh] = *(const u32x4*)(rowp + C_V + head * 128 + ((tid & 7) + 8 * hh) * 8); if (MODE == 1) gwp[hh] = *(const u32x4*)(rowp + C_GB + head * 128 + (tid & 7) * 16 + hh * 8); } }
    if (MODE == 0) {
    { const int r = tid >> 3, j4 = (tid & 7) * 4; f32x4 v = (f32x4){0.f, 0.f, 0.f, 0.f};
      { const int rc = r >= rmin ? r : rmin; const u32x2 w = *(const u32x2*)(cols + (size_t)(tok0 + rc) * NINP + C_GLR + j4); if (r >= rmin) { v[0] = bflo(w.x); v[1] = bfhi(w.x); v[2] = bflo(w.y); v[3] = bfhi(w.y); } }
      *(LAS f32x4*)(glr_s + r * 32 + j4) = v; }
    __syncthreads();
    { const int kk = tid & 63, rb = tid >> 6;
#pragma unroll
      for (int i = 0; i < 8; ++i) { const int r = rb + 8 * i; float x0 = bg[0], x1 = bg[1]; f32x4 gr[8];
#pragma unroll
          for (int j4 = 0; j4 < 8; ++j4) gr[j4] = *(const LAS f32x4*)(glr_s + r * 32 + j4 * 4);
#pragma unroll
          for (int j = 0; j < 16; ++j) { x0 += gr[j >> 2][j & 3] * wg[0][j]; x1 += gr[4 + (j >> 2)][j & 3] * wg[1][j]; }
          const bool ok = r >= rmin; bfs[r * 64 + kk] = ok ? logsig(x0) * 0.0625f : 0.f; bbs[r * 64 + kk] = ok ? logsig(x1) * 0.0625f : 0.f; } }
    __syncthreads();
    { const int col = tid & 127, part = tid >> 7, d = col >> 6, kk = col & 63; LAS float* bs = d ? bbs : bfs; LAS float* tot = glr_s;
      float v[16];
#pragma unroll
      for (int i = 0; i < 16; ++i) v[i] = bs[(part * 16 + i) * 64 + kk];
      if (d == 0) {
#pragma unroll
          for (int i = 1; i < 16; ++i) v[i] += v[i - 1];
          tot[part * 128 + col] = v[15]; }
      else {
#pragma unroll
          for (int i = 14; i >= 0; --i) v[i] += v[i + 1];
          tot[part * 128 + col] = v[0]; }
      __syncthreads();
      float off = 0.f;
#pragma unroll
      for (int pp = 0; pp < 4; ++pp) { const float t = tot[pp * 128 + col]; if (d == 0 ? pp < part : pp > part) off += t; }
#pragma unroll
      for (int i = 0; i < 16; ++i) bs[(part * 16 + i) * 64 + kk] = v[i] + off; }
    __syncthreads();
    { float* gb = (float*)(p.ws + WS_GB) + (size_t)(ci * 4 + head) * 8192;
#pragma unroll
      for (int i = 0; i < 4; ++i) { const int e = (i * 512 + tid) * 4; *(f32x4*)(gb + e) = *(const LAS f32x4*)(bfs + e); } }
    } else {
      __syncthreads();
#pragma unroll
      for (int i = 0; i < 4; ++i) { const int e = (i * 512 + tid) * 4; *(LAS f32x4*)(bfs + e) = gbv[i]; }
      __syncthreads();
    }
    LAS bf16_t* vT = (LAS bf16_t*)(lds + GL_VT);
    { const int r = tid >> 3, k8 = (tid & 7) * 8; const bool ok = r >= rmin;
      if (!ok) { kw = (u32x4){0u, 0u, 0u, 0u}; qw = kw; }
      float qv[8], kv[8];
#pragma unroll
      for (int i = 0; i < 4; ++i) { qv[2 * i] = bflo(qw[i]); qv[2 * i + 1] = bfhi(qw[i]); kv[2 * i] = bflo(kw[i]); kv[2 * i + 1] = bfhi(kw[i]); }
      if (MODE == 0) { LAS bf16_t* kd0 = (LAS bf16_t*)(lds + GL_QE0); LAS bf16_t* kd1 = (LAS bf16_t*)(lds + GL_QE1);
#pragma unroll
          for (int i = 0; i < 8; ++i) { const int kk = k8 + i; kd0[kk * GLD + SWZ(kk, r)] = f2bf(kv[i] * __expf(bfs[63 * 64 + kk] - bfs[r * 64 + kk])); kd1[kk * GLD + SWZ(kk, r)] = f2bf(kv[i] * __expf(bbs[kk] - bbs[r * 64 + kk])); }
      } else { LAS bf16_t* qe0 = (LAS bf16_t*)(lds + GL_QE0); LAS bf16_t* qe1 = (LAS bf16_t*)(lds + GL_QE1); LAS bf16_t* ke0 = (LAS bf16_t*)(lds + GL_KE0); LAS bf16_t* ke1 = (LAS bf16_t*)(lds + GL_KE1);
          u32x4 a, b2, c2, d2;
#pragma unroll
          for (int i = 0; i < 4; ++i) { const int kk = k8 + 2 * i; const float f0 = bfs[r * 64 + kk], f1 = bfs[r * 64 + kk + 1], g0 = bbs[r * 64 + kk], g1 = bbs[r * 64 + kk + 1];
              a[i] = cvt_pk_bf16(qv[2 * i] * 0.125f * __expf(f0), qv[2 * i + 1] * 0.125f * __expf(f1)); b2[i] = cvt_pk_bf16(qv[2 * i] * 0.125f * __expf(g0), qv[2 * i + 1] * 0.125f * __expf(g1));
              c2[i] = cvt_pk_bf16(kv[2 * i] * __expf(-f0), kv[2 * i + 1] * __expf(-f1)); d2[i] = cvt_pk_bf16(kv[2 * i] * __expf(-g0), kv[2 * i + 1] * __expf(-g1)); }
          *(LAS u32x4*)(qe0 + r * GLD + k8) = a; *(LAS u32x4*)(qe1 + r * GLD + k8) = b2; *(LAS u32x4*)(ke0 + r * GLD + k8) = c2; *(LAS u32x4*)(ke1 + r * GLD + k8) = d2; }
#pragma unroll
      for (int hh = 0; hh < 2; ++hh) { const int v8 = ((tid & 7) + 8 * hh) * 8; u32x4 vw = (u32x4){0u, 0u, 0u, 0u};
          if (ok) vw = vwp[hh];
#pragma unroll
          for (int i = 0; i < 4; ++i) { vT[(v8 + 2 * i) * GLD + SWZ(v8, r)] = (bf16_t)(vw[i] & 0xffffu); vT[(v8 + 2 * i + 1) * GLD + SWZ(v8, r)] = (bf16_t)(vw[i] >> 16); } }
    }
    if (MODE == 1) {
        const bf16_t* spb = (const bf16_t*)(p.ws + WS_SPB); u32x4 sv[2][2];
#pragma unroll
        for (int d = 0; d < 2; ++d) { const bf16_t* src = spb + ((size_t)(ci * 4 + head) * 2 + d) * 8192;
#pragma unroll
            for (int i = 0; i < 2; ++i) sv[d][i] = *(const u32x4*)(src + (i * 512 + tid) * 8); }
#pragma unroll
        for (int d = 0; d < 2; ++d) { LAS bf16_t* sp = (LAS bf16_t*)(lds + (d ? GL_SP1 : GL_SP0));
#pragma unroll
            for (int i = 0; i < 2; ++i) { const int e = (i * 512 + tid) * 8; *(LAS u32x4*)(sp + (e >> 6) * GLD + (e & 63)) = sv[d][i]; } }
    }
    __syncthreads();
    if (MODE == 0) {
        float* ds = (float*)(p.ws + WS_DS); float* dec = (float*)(p.ws + WS_DECAY);
        if (tid < 128) { const int d = tid >> 6, kk = tid & 63; dec[((size_t)(ci * 4 + head) * 2 + d) * 64 + kk] = __expf(d == 0 ? bfs[63 * 64 + kk] : bbs[kk]); }
#pragma unroll
        for (int d = 0; d < 2; ++d) { const LAS bf16_t* kd = (const LAS bf16_t*)(lds + (d ? GL_QE1 : GL_QE0)); bf16_t* dst = (bf16_t*)ds + ((size_t)(ci * 4 + head) * 2 + d) * 8192;
            for (int kt = 0; kt < 4; ++kt) { f32x4 acc = (f32x4){0.f, 0.f, 0.f, 0.f}; acc = mma_lds_sw(acc, vT + wid * 16 * GLD, wid * 16, kd + kt * 16 * GLD, kt * 16, GLD, 2, lane);
#pragma unroll
                for (int j = 0; j < 4; ++j) dst[(wid * 16 + (lane >> 4) * 4 + j) * 64 + kt * 16 + (lane & 15)] = f2bf_sw(acc[j]); } }
        __syncthreads();
        return;
    }
    const LAS bf16_t* qe0 = (const LAS bf16_t*)(lds + GL_QE0); const LAS bf16_t* qe1 = (const LAS bf16_t*)(lds + GL_QE1); const LAS bf16_t* ke0 = (const LAS bf16_t*)(lds + GL_KE0); const LAS bf16_t* ke1 = (const LAS bf16_t*)(lds + GL_KE1);
    LAS bf16_t* att = (LAS bf16_t*)(lds + GL_ATT);
    { const int it = wid >> 1;
#pragma unroll
      for (int t2 = 0; t2 < 2; ++t2) { const int jt = (wid & 1) * 2 + t2; f32x4 af = (f32x4){0.f, 0.f, 0.f, 0.f}, ab = af;
          af = mma_lds(af, qe0 + it * 16 * GLD, ke0 + jt * 16 * GLD, GLD, 2, lane); ab = mma_lds(ab, qe1 + it * 16 * GLD, ke1 + jt * 16 * GLD, GLD, 2, lane);
#pragma unroll
          for (int j = 0; j < 4; ++j) { const int i_ = it * 16 + (lane >> 4) * 4 + j, j_ = jt * 16 + (lane & 15); att[i_ * GLD + j_] = f2bf((j_ <= i_ ? af[j] : 0.f) + (j_ >= i_ ? ab[j] : 0.f)); } } }
    __syncthreads();
    LAS float* os = (LAS float*)(lds + GL_OS);
    { const int it = wid >> 1; const LAS bf16_t* sp0 = (const LAS bf16_t*)(lds + GL_SP0); const LAS bf16_t* sp1 = (const LAS bf16_t*)(lds + GL_SP1);
#pragma unroll
      for (int t4 = 0; t4 < 4; ++t4) { const int vt = (wid & 1) * 4 + t4; f32x4 acc = (f32x4){0.f, 0.f, 0.f, 0.f};
          acc = mma_lds_sw(acc, att + it * 16 * GLD, -1, vT + vt * 16 * GLD, vt * 16, GLD, 2, lane); acc = mma_lds(acc, qe0 + it * 16 * GLD, sp0 + vt * 16 * GLD, GLD, 2, lane); acc = mma_lds(acc, qe1 + it * 16 * GLD, sp1 + vt * 16 * GLD, GLD, 2, lane);
#pragma unroll
          for (int j = 0; j < 4; ++j) os[(it * 16 + (lane >> 4) * 4 + j) * 132 + vt * 16 + (lane & 15)] = acc[j]; } }
    __syncthreads();
    { const int r = tid >> 3, v0 = (tid & 7) * 16; float o[16]; float ss = 0.f;
#pragma unroll
      for (int i = 0; i < 16; ++i) { o[i] = os[r * 132 + v0 + i]; ss += o[i] * o[i]; }
      ss += __shfl_xor(ss, 1); ss += __shfl_xor(ss, 2); ss += __shfl_xor(ss, 4);
      const float rs = rsqrtf(ss * (1.0f / 128.0f) + 1e-6f);
      if (r >= rmin) { const size_t tok = (size_t)(tok0 + r); bf16_t* yall = (bf16_t*)(p.ws + WS_YALL);
#pragma unroll
          for (int hh = 0; hh < 2; ++hh) { const u32x4 gw = gwp[hh]; u32x4 w;
#pragma unroll
              for (int i = 0; i < 4; ++i) { const int e = hh * 8 + 2 * i; w[i] = cvt_pk_bf16(o[e] * rs * ngv[e] * silu(bflo(gw[i])), o[e + 1] * rs * ngv[e + 1] * silu(bfhi(gw[i]))); }
              *(u32x4*)(yall + tok * D + 512 + head * 128 + v0 + hh * 8) = w; } } }
    __syncthreads();
}

__device__ __forceinline__ float softplus_neg(float lam) { const float e = __expf(-lam); return lam + 0.f < -8.f ? -lam : (e < 0.02f ? e * (1.0f - e * (0.5f - e * (1.0f / 3.0f))) : __logf(1.0f + e)); }
__device__ __forceinline__ float one_minus_exp(float x) {
    return x > -0.5f ? -x * (1.0f + x * 0.5f * (1.0f + x * (1.0f / 3.0f) * (1.0f + x * 0.25f * (1.0f + x * 0.2f * (1.0f + x * (1.0f / 6.0f) * (1.0f + x * (1.0f / 7.0f))))))) : 1.0f - __expf(x);
}
template <int MODE>
__device__ __forceinline__ void lru_phase(const int TID, const int b, const int G, const Params& p, int l, LAS unsigned char* lds) {
    const int tid = TID, lane = tid & 63, wid = tid >> 6, q = lane >> 4;
    const bf16_t* cols = (const bf16_t*)(p.ws + WS_COLS);
    int it = b; if (it >= NCK * 8) return;
    const int nb = b & 7;
    LAS bf16_t* xcA = (LAS bf16_t*)lds; LAS float* xcf = (LAS float*)(lds + 17408);
    const int ch = tid & 127, rb = tid >> 7, gchc = nb * 128 + ch;
    const float w0 = p.in[18][(l * 4 + 0) * 1024 + gchc], w1 = p.in[18][(l * 4 + 1) * 1024 + gchc], w2 = p.in[18][(l * 4 + 2) * 1024 + gchc], w3 = p.in[18][(l * 4 + 3) * 1024 + gchc], cb = p.in[19][l * 1024 + gchc];
    const int chl = wid * 16 + (lane & 15), gch = nb * 128 + chl;
    float ba[2], bx[2], sp8[2];
#pragma unroll
    for (int d = 0; d < 2; ++d) { ba[d] = p.in[21][(l * 2 + d) * 1024 + gch]; bx[d] = p.in[23][(l * 2 + d) * 1024 + gch]; sp8[d] = 8.0f * softplus_neg(p.in[24][(l * 2 + d) * 1024 + gch]); }
    bf16x8 bfr[4][4];
    { const bf16_t* bt = (const bf16_t*)(p.ws + WS_BTLRU);
#pragma unroll
      for (int mat = 0; mat < 4; ++mat)
#pragma unroll
          for (int ks = 0; ks < 4; ++ks) bfr[mat][ks] = *(const bf16x8*)(bt + ((size_t)(mat * 8 + nb) * 128 + wid * 16 + (lane & 15)) * 128 + ks * 32 + q * 8); }
    bf16_t xr[19];
    { int seq, c; chunk_info(it >> 3, seq, c); const int s0 = seq_start(seq), L = seq_len(seq), pos0 = (c == 0 ? -48 : 16 + 64 * (c - 1));
      const bf16_t* xb = cols + (size_t)s0 * NINP + C_XC + gchc;
#pragma unroll
      for (int i = 0; i < 19; ++i) { const int pos = pos0 + rb * 16 - 2 + i; const int pc = pos < 0 ? 0 : (pos < L ? pos : L - 1); xr[i] = xb[(size_t)pc * NINP]; } }
    for (; it < NCK * 8; it += G) {
        const int ci = it >> 3;
        int seq, c; chunk_info(ci, seq, c);
        const int s0 = seq_start(seq);
        const int pos0 = (c == 0 ? -48 : 16 + 64 * (c - 1));
        const int rmin = (c == 0) ? 48 : 0;
        float xv[19];
        { const int L = seq_len(seq);
#pragma unroll
          for (int i = 0; i < 19; ++i) { const int pos = pos0 + rb * 16 - 2 + i; xv[i] = (pos >= 0 && pos < L) ? bf2f(xr[i]) : 0.f; } }
#pragma unroll
        for (int i = 0; i < 16; ++i) { const int r = rb * 16 + i; const float xc = (r >= rmin) ? cb + xv[i] * w0 + xv[i + 1] * w1 + xv[i + 2] * w2 + xv[i + 3] * w3 : 0.f;
            xcf[r * 132 + ch] = xc; xcA[r * 136 + ch] = f2bf(xc); }
        u32x4 gq[2]; float cin[2];
        if (MODE == 1) {
#pragma unroll
            for (int d = 0; d < 2; ++d) cin[d] = ((const float*)(p.ws + WS_LRUC))[((size_t)ci * 2 + d) * 1024 + gch];
            { const int r = tid >> 3; const int rr = r >= rmin ? r : rmin; const bf16_t* gp = cols + (size_t)(s0 + pos0 + rr) * NINP + C_GC + nb * 128 + (tid & 7) * 16;
              gq[0] = *(const u32x4*)gp; gq[1] = *(const u32x4*)(gp + 8); }
        }
        { const int itn = it + G;
          if (itn < NCK * 8) { int seqn, cn; chunk_info(itn >> 3, seqn, cn); const int s0n = seq_start(seqn), Ln = seq_len(seqn), pos0n = (cn == 0 ? -48 : 16 + 64 * (cn - 1));
              const bf16_t* xb = cols + (size_t)s0n * NINP + C_XC + gchc;
#pragma unroll
              for (int i = 0; i < 19; ++i) { const int pos = pos0n + rb * 16 - 2 + i; const int pc = pos < 0 ? 0 : (pos < Ln ? pos : Ln - 1); xr[i] = xb[(size_t)pc * NINP]; } } }
        LBAR();
        LAS bf16_t* gts = (LAS bf16_t*)(lds + 51200); LAS float* hfs = (LAS float*)(lds + 68608);
        float hsum[4][4];
#pragma unroll
        for (int d = 0; d < 2; ++d) {
            __builtin_amdgcn_sched_barrier(0);
            f32x4 acc[2][4];
#pragma unroll
            for (int rt = 0; rt < 4; ++rt) { bf16x8 afr[4];
#pragma unroll
                for (int ks = 0; ks < 4; ++ks) afr[ks] = *(const LAS bf16x8*)(xcA + (rt * 16 + (lane & 15)) * 136 + ks * 32 + q * 8);
#pragma unroll
                for (int kind = 0; kind < 2; ++kind) { f32x4 a = (f32x4){0.f, 0.f, 0.f, 0.f};
#pragma unroll
                    for (int ks = 0; ks < 4; ++ks) a = __builtin_amdgcn_mfma_f32_16x16x32_bf16(afr[ks], bfr[d * 2 + kind][ks], a, 0, 0, 0);
                    acc[kind][rt] = a; } }
            float a[4][4], bb[4][4];
#pragma unroll
            for (int rt = 0; rt < 4; ++rt)
#pragma unroll
                for (int j = 0; j < 4; ++j) { const int r = rt * 16 + q * 4 + j; const float rg = sigm(acc[0][rt][j] + ba[d]), ig = sigm(acc[1][rt][j] + bx[d]), la = -sp8[d] * rg;
                    const bool ok = r >= rmin; const float av = __expf(la), x2 = 2.0f * la; const float om = x2 > -0.25f ? -x2 * (1.0f + x2 * 0.5f * (1.0f + x2 * (1.0f / 3.0f) * (1.0f + x2 * 0.25f * (1.0f + x2 * 0.2f)))) : 1.0f - av * av;
                    a[rt][j] = ok ? av : 1.0f; bb[rt][j] = ok ? __builtin_amdgcn_sqrtf(om) * ig * xcf[r * 132 + chl] : 0.f; }
            float LA[4], LB[4];
#pragma unroll
            for (int rt = 0; rt < 4; ++rt) { float A = 1.f, B = 0.f;
#pragma unroll
                for (int jj = 0; jj < 4; ++jj) { const int j = d == 0 ? jj : 3 - jj; B = a[rt][j] * B + bb[rt][j]; A *= a[rt][j]; }
                LA[rt] = A; LB[rt] = B; }
            const size_t co = ((size_t)ci * 2 + d) * 1024 + gch;
            float h = (MODE == 1) ? cin[d] : 0.f, Atot = 1.f; float hin[4];
#pragma unroll
            for (int rr = 0; rr < 4; ++rr) { const int rt = d == 0 ? rr : 3 - rr;
#pragma unroll
                for (int qi = 0; qi < 4; ++qi) { const int qq = d == 0 ? qi : 3 - qi;
                    const float Aq = __shfl(LA[rt], (lane & 15) + 16 * qq), Bq = __shfl(LB[rt], (lane & 15) + 16 * qq);
                    if (qq == q) hin[rt] = h;
                    h = Aq * h + Bq; Atot *= Aq; } }
            if (MODE == 0) { if (q == 0) { ((float*)(p.ws + WS_LRUA))[co] = Atot; ((float*)(p.ws + WS_LRUH))[co] = h; } }
            else {
#pragma unroll
                for (int rt = 0; rt < 4; ++rt) { float hh = hin[rt];
#pragma unroll
                    for (int jj = 0; jj < 4; ++jj) { const int j = d == 0 ? jj : 3 - jj; hh = a[rt][j] * hh + bb[rt][j];
                        if (d == 0) hfs[(rt * 16 + q * 4 + j) * 132 + chl] = hh; else hsum[rt][j] = hh; } }
                if (d == 0) { *(LAS u32x4*)(gts + (tid >> 3) * 136 + (tid & 7) * 16) = gq[0]; *(LAS u32x4*)(gts + (tid >> 3) * 136 + (tid & 7) * 16 + 8) = gq[1]; } }
        }
        if (MODE == 1) { bf16_t* yall = (bf16_t*)(p.ws + WS_YALL);
            LBAR();
#pragma unroll
            for (int rt = 0; rt < 4; ++rt)
#pragma unroll
                for (int j = 0; j < 4; ++j) { const int r = rt * 16 + q * 4 + j; xcA[r * 136 + chl] = f2bf((hsum[rt][j] + hfs[r * 132 + chl]) * silu(bf2f(gts[r * 136 + chl]))); }
            LBAR();
            { const int r = tid >> 3; if (r >= rmin) { const u32x4 y0 = *(const LAS u32x4*)(xcA + r * 136 + (tid & 7) * 16), y1 = *(const LAS u32x4*)(xcA + r * 136 + (tid & 7) * 16 + 8);
                bf16_t* yp = yall + (size_t)(s0 + pos0 + r) * D + 1024 + nb * 128 + (tid & 7) * 16; *(u32x4*)yp = y0; *(u32x4*)(yp + 8) = y1; } } }
        LBAR();
    }
}


template <int WHICH>
__device__ __forceinline__ void skinny_tail(const int TID, const int b0, const Params& p, const int first) {
    const int lane = TID & 63, wid = TID >> 6, q = lane >> 4;
    if (wid >= 5) return;
    for (int b = b0; b < 256; b += (int)gridDim.x) {
    const int ct = b & 127, rt = (b >> 7) * 5 + wid;
    const int row = 24576 + rt * 16 + (lane & 15);
    const int colb = ct * 16 + (lane & 15);
    const bf16_t* cols = (const bf16_t*)(p.ws + WS_COLS);
    if (WHICH == 0) {
        const bf16_t* A = (const bf16_t*)(p.ws + WS_YALL) + (size_t)row * D + q * 8; const bf16_t* B = (const bf16_t*)(p.ws + WS_BTOUT) + (size_t)colb * D + q * 8;
        bf16_t* mbf = (bf16_t*)(p.ws + WS_H);
        f32x4 msum = (f32x4){0.f, 0.f, 0.f, 0.f};
        unsigned char gt[3][4];
#pragma unroll
        for (int br = 0; br < 3; ++br)
#pragma unroll
            for (int j = 0; j < 4; ++j) { const int cc = colb & 255; gt[br][j] = ((const unsigned char*)(cols + (size_t)(24576 + rt * 16 + q * 4 + j) * NINP + C_MG))[(br * 8 + (colb >> 8)) * 256 + ((((cc & 127) >> 5) * 4 + ((cc & 31) >> 3)) * 2 + (cc >> 7)) * 8 + (cc & 7)]; }
        float gs[3][4];
#pragma unroll
        for (int br = 0; br < 3; ++br)
#pragma unroll
            for (int j = 0; j < 4; ++j) { gs[br][j] = (float)gt[br][j] * (1.0f / 255.0f); asm volatile("" : "+v"(gs[br][j])); }
#pragma unroll
        for (int br = 0; br < 3; ++br) { const int koff = br * 512, nks = br == 2 ? 32 : 16; f32x4 acc = (f32x4){0.f, 0.f, 0.f, 0.f};
            for (int k0 = 0; k0 < nks; k0 += 8) { bf16x8 av[8], bv[8];
#pragma unroll
                for (int i = 0; i < 8; ++i) { av[i] = *(const bf16x8*)(A + koff + (k0 + i) * 32); bv[i] = *(const bf16x8*)(B + koff + (k0 + i) * 32); }
#pragma unroll
                for (int i = 0; i < 8; ++i) acc = __builtin_amdgcn_mfma_f32_16x16x32_bf16(av[i], bv[i], acc, 0, 0, 0); }
#pragma unroll
            for (int j = 0; j < 4; ++j) msum[j] += gs[br][j] * acc[j]; }
#pragma unroll
        for (int j = 0; j < 4; ++j) { const int tok = 24576 + rt * 16 + q * 4 + j; mbf[(size_t)tok * D + colb] = f2bf(msum[j]); }
    } else {
        const bf16_t* A = (const bf16_t*)(p.ws + WS_H) + (size_t)row * D + q * 8; const bf16_t* B = (const bf16_t*)(p.ws + WS_BTO) + (size_t)colb * D + q * 8;
        float* z = (float*)(p.ws + WS_Z);
        f32x4 acc = (f32x4){0.f, 0.f, 0.f, 0.f};
        for (int k0 = 0; k0 < 64; k0 += 8) { bf16x8 av[8], bv[8];
#pragma unroll
            for (int i = 0; i < 8; ++i) { av[i] = *(const bf16x8*)(A + (k0 + i) * 32); bv[i] = *(const bf16x8*)(B + (k0 + i) * 32); }
#pragma unroll
            for (int i = 0; i < 8; ++i) acc = __builtin_amdgcn_mfma_f32_16x16x32_bf16(av[i], bv[i], acc, 0, 0, 0); }
#pragma unroll
        for (int j = 0; j < 4; ++j) { const int tok = 24576 + rt * 16 + q * 4 + j; const float res = first ? src_row(p, tok)[colb] : z[(size_t)tok * D + colb]; z[(size_t)tok * D + colb] = res + acc[j]; }
    }
    }
}

#define XB_TMO      128
#define XB_XCNT(j)  (256  + 64 * (j))
#define XB_XSUB(j)  (1280 + 64 * (j))
#define XB_XGEN(j)  (2304 + 64 * (j))
#define XB_TOP      3328
#define XB_TOPGEN   3392
#define XCD_BAR_WORDS 3456
#define XB_SPIN_CAP (1u << 18)
__device__ __forceinline__ unsigned xb_ld(unsigned* p)              { return __hip_atomic_load(p, __ATOMIC_RELAXED, __HIP_MEMORY_SCOPE_AGENT); }
__device__ __forceinline__ unsigned xb_add(unsigned* p, unsigned v) { return __hip_atomic_fetch_add(p, v, __ATOMIC_RELAXED, __HIP_MEMORY_SCOPE_AGENT); }
__device__ __forceinline__ unsigned xb_xcc_id() { return (unsigned)__builtin_amdgcn_s_getreg((3 << 11) | 20) & 0xFu; }
#define XB_SPIN(cond, bar) do { unsigned _sp = 0; while (cond) { __builtin_amdgcn_s_sleep(1); \
    if ((++_sp & 255u) == 0u) { if (xb_ld(&(bar)[XB_TMO])) break; if (_sp > XB_SPIN_CAP) { atomicAdd(&(bar)[XB_TMO], 1u); break; } } } } while (0)
struct XcdBarrier { unsigned* bar; unsigned x; volatile LAS unsigned* st; };
__device__ __forceinline__ XcdBarrier xcd_barrier_post(unsigned* bar, volatile LAS unsigned* st) {
    XcdBarrier b; b.bar = bar; b.x = xb_xcc_id(); b.st = st;
    if (threadIdx.x == 0) (void)xb_add(&bar[XB_XCNT(b.x)], 1u);
    return b;
}
__device__ __forceinline__ void xcd_barrier_complete(unsigned* bar, unsigned x, unsigned& nloc, unsigned& nx) {
    const unsigned G = gridDim.x * gridDim.y * gridDim.z;
    unsigned sum, cnt, mine, sp = 0u;
    for (;;) {
        sum = 0u; cnt = 0u; mine = 0u;
#pragma unroll
        for (unsigned j = 0; j < 16; ++j) { const unsigned c = xb_ld(&bar[XB_XCNT(j)]); sum += c; cnt += (c > 0u) ? 1u : 0u; mine = (j == x) ? c : mine; }
        if (sum == G) break;
        __builtin_amdgcn_s_sleep(1);
        if ((++sp & 255u) == 0u) { if (xb_ld(&bar[XB_TMO])) break; if (sp > XB_SPIN_CAP) { atomicAdd(&bar[XB_TMO], 1u); break; } }
    }
    nloc = mine > 0u ? mine : 1u; nx = cnt > 0u ? cnt : 1u;
}
__device__ __forceinline__ void xcd_barrier(const XcdBarrier& b) {
    asm volatile("s_waitcnt vmcnt(0)" ::: "memory");
    __syncthreads();
    if (threadIdx.x == 0) {
        unsigned* bar = b.bar;
        __builtin_amdgcn_s_waitcnt(0);
        unsigned nloc = b.st[0], nx = b.st[1];
        if (nloc == 0u) { xcd_barrier_complete(bar, b.x, nloc, nx); b.st[0] = nloc; b.st[1] = nx; }
        const unsigned old = xb_add(&bar[XB_XSUB(b.x)], 1u);
        const unsigned gen = old / nloc;
        if (old + 1u == (gen + 1u) * nloc) {
            __builtin_amdgcn_fence(__ATOMIC_RELEASE, "agent");
            asm volatile("s_waitcnt vmcnt(0)" ::: "memory");
            const unsigned og = xb_add(&bar[XB_TOP], 1u);
            const unsigned tg = og / nx;
            if (og + 1u == (tg + 1u) * nx) xb_add(&bar[XB_TOPGEN], 1u);
            else XB_SPIN(xb_ld(&bar[XB_TOPGEN]) == tg, bar);
            __builtin_amdgcn_fence(__ATOMIC_ACQUIRE, "agent");
            xb_add(&bar[XB_XGEN(b.x)], 1u);
            asm volatile("s_waitcnt vmcnt(0)" ::: "memory");
        } else {
            XB_SPIN(xb_ld(&bar[XB_XGEN(b.x)]) == gen, bar);
            __builtin_amdgcn_fence(__ATOMIC_ACQUIRE, "agent");
            asm volatile("s_waitcnt vmcnt(0)" ::: "memory");
        }
    }
    __syncthreads();
}

__global__ void __launch_bounds__(512) fwd_megakernel(Params p_in) {
    extern __shared__ __attribute__((aligned(16))) unsigned char smem[];
    LAS unsigned char* lds = (LAS unsigned char*)smem;
    cg::grid_group grid = cg::this_grid();
    const int G = gridDim.x;
    const Params& p0 = p_in;
    volatile LAS unsigned* stw = (volatile LAS unsigned*)(lds + 150528);
    if (threadIdx.x == 0) { stw[0] = 0u; stw[1] = 0u; }
    __syncthreads();
    const XcdBarrier xb = xcd_barrier_post((unsigned*)(p_in.ws + WS_BAR), stw);
    for (int ph = p0.ph_lo; ph < p0.ph_hi; ++ph) {
        const int reps_ = (ph < 32 && (ph & 7) == DUP) ? 2 : 1;
        for (int rep_ = 0; rep_ < reps_; ++rep_) {
        int TID = threadIdx.x; asm volatile("" : "+v"(TID));
        int b = blockIdx.x; asm volatile("" : "+s"(b));
        Params p = p0; { unsigned long long t_ = (unsigned long long)p.ws; asm volatile("" : "+s"(t_)); p.ws = (unsigned char*)t_; }
        const char* ws = (const char*)p.ws;
        if (ph == 32) { final_norm_phase(TID, b, p); }
        else {
            const int l = ph >> 3, k = ph & 7;
            if (k == 0 && (PHM & 1)) { rmsnorm_phase(TID, b, p, l); convert_weights(TID, b, p, l, (LAS float*)lds); if (l == 0) s5_tables_all(TID, b, p); }
            else if (k == 1 && (PHM & 2)) {
                TileOrder S; S.nM = MP / 256; S.nN = NINP / 256; S.nwg = S.nM * S.nN; S.G = G; S.c = b; S.mult = 1; S.nt0 = D / 64; S.A = ws + WS_H; S.B = ws + WS_BTIN; S.tA = (size_t)256 * D * 2; S.tB = (size_t)256 * D * 2;
                EpiIn E; E.cols = (bf16_t*)(p.ws + WS_COLS); E.ubuf = (bf16_t*)(p.ws + WS_UBUF);
                gemm_phase(TID, lds, D, D, S, E);
                s5_assemble_a(TID, b, p, l);
            } else if (k == 2 && (PHM & 4)) {
                GroupOrder S; S.G = G; S.c = b; S.nt0 = 4; S.A = ws + WS_UBUF; S.B = ws + WS_PMAT; S.gsA = (size_t)CHP * 512 * 2; S.gsB = (size_t)256 * 256 * 2; S.tA = (size_t)256 * 512 * 2;
                EpiS5State E; E.st = (float*)(p.ws + WS_ST);
                if (SUBM & 4) gemm_phase(TID, lds, 512, 256, S, E);
                __syncthreads();
                { const int head_ = ((b + 128) % G) & 3, kk_ = TID & 63; float wg_[2][16], bg_[2];
                  _Pragma("unroll") for (int d = 0; d < 2; ++d) { bg_[d] = p.in[16][(l * 2 + d) * 256 + head_ * 64 + kk_]; _Pragma("unroll") for (int j = 0; j < 16; ++j) wg_[d][j] = p.in[15][((size_t)(l * 2 + d) * 16 + j) * 256 + head_ * 64 + kk_]; }
                  float ng_[16]; _Pragma("unroll") for (int e = 0; e < 16; ++e) ng_[e] = p.in[17][l * 512 + head_ * 128 + (TID & 7) * 16 + e];
                  for (int it = (b + 128) % G; it < NCK * 4; it += G) gla_item<0>(TID, p, l, it >> 2, it & 3, lds, wg_, bg_, ng_); }
                lru_phase<0>(TID, b, G, p, l, lds);
                s5_assemble_w(TID, b, p, l);
            } else if (k == 3 && (PHM & 8)) { scans_phase(TID, b, p, l, rep_ == 0); }
            else if (k == 4 && (PHM & 16)) {
                GroupOrder S; S.G = G; S.c = b; S.nt0 = 8; S.A = ws + WS_UBUF; S.B = ws + WS_WMAT; S.gsA = (size_t)CHP * 512 * 2; S.gsB = (size_t)256 * 512 * 2; S.tA = (size_t)256 * 512 * 2;
                EpiS5Out E; E.zs5 = (bf16_t*)(p.ws + WS_ZS5);
                if (SUBM & 4) gemm_phase(TID, lds, 512, 512, S, E);
                __syncthreads();
                { const int head_ = ((b + 128) % G) & 3, kk_ = TID & 63; float wg_[2][16], bg_[2];
                  _Pragma("unroll") for (int d = 0; d < 2; ++d) { bg_[d] = p.in[16][(l * 2 + d) * 256 + head_ * 64 + kk_]; _Pragma("unroll") for (int j = 0; j < 16; ++j) wg_[d][j] = p.in[15][((size_t)(l * 2 + d) * 16 + j) * 256 + head_ * 64 + kk_]; }
                  float ng_[16]; _Pragma("unroll") for (int e = 0; e < 16; ++e) ng_[e] = p.in[17][l * 512 + head_ * 128 + (TID & 7) * 16 + e];
                  for (int it = (b + 128) % G; it < NCK * 4; it += G) gla_item<1>(TID, p, l, it >> 2, it & 3, lds, wg_, bg_, ng_); }
                lru_phase<1>(TID, b, G, p, l, lds);
            } else if (k == 5 && (PHM & 32)) {
                TileOrder S; S.nM = MP / 256; S.nN = 2; S.nwg = S.nM * S.nN; S.G = G; S.c = b; S.mult = 1; S.nt0 = 8; S.A = ws + WS_ZS5; S.B = ws + WS_BTGLU; S.tA = (size_t)256 * 512 * 2; S.tB = (size_t)256 * 512 * 2;
                EpiGlu E; E.zs5 = (const bf16_t*)(p.ws + WS_ZS5); E.cols = (const bf16_t*)(p.ws + WS_COLS); E.bglu = p.in[14] + l * 512; E.yall = (bf16_t*)(p.ws + WS_YALL);
                gemm_phase(TID, lds, 512, 512, S, E);
            } else if (k == 6 && (PHM & 64)) {
                TileOrder S; S.nM = 96; S.nN = 8; S.nwg = S.nM * S.nN; S.G = G; S.c = b; S.mult = 3; S.nt0 = 8; S.A = ws + WS_YALL; S.B = ws + WS_BTOUT; S.tA = (size_t)256 * D * 2; S.tB = (size_t)256 * D * 2;
                EpiOut E; E.cols = (const bf16_t*)(p.ws + WS_COLS); E.mbf = (bf16_t*)(p.ws + WS_H);
                gemm_phase(TID, lds, D, D, S, E);
                skinny_tail<0>(TID, b, p, 0);
            } else if (PHM & 128) {
                TileOrder S; S.nM = 96; S.nN = 8; S.nwg = S.nM * S.nN; S.G = G; S.c = b; S.mult = 1; S.nt0 = D / 64; S.A = ws + WS_H; S.B = ws + WS_BTO; S.tA = (size_t)256 * D * 2; S.tB = (size_t)256 * D * 2;
                EpiWo E; E.z = (float*)(p.ws + WS_Z); E.pp = &p; E.first = (l == 0);
                gemm_phase(TID, lds, D, D, S, E);
                skinny_tail<1>(TID, b, p, l == 0);
            }
        }
        }
        if (p0.use_sync && ph + 1 < p0.ph_hi) { if (ph == p0.ph_lo) grid.sync(); else xcd_barrier(xb); }
    }
}

extern "C" void kernel_launch(void* const* d_in, const int* in_sizes, int n_in, void* d_out, int out_size, void* d_ws, size_t ws_size, hipStream_t stream) {
    static int grid = 0, coop = 1;
    if (grid == 0) {
        if (n_in != 30 || ws_size < WS_END3) { fprintf(stderr, "kernel_launch: unexpected n_in %d or ws_size %zu (< %zu)\n", n_in, ws_size, (size_t)WS_END); grid = -1; return; }
        int dev = 0, cus = 0, per_cu = 0;
        (void)hipGetDevice(&dev); (void)hipDeviceGetAttribute(&cus, hipDeviceAttributeMultiprocessorCount, dev);
        if (hipFuncSetAttribute((const void*)fwd_megakernel, hipFuncAttributeMaxDynamicSharedMemorySize, LDS_BYTES) != hipSuccess) { fprintf(stderr, "kernel_launch: hipFuncSetAttribute failed\n"); grid = -1; return; }
        if (hipOccupancyMaxActiveBlocksPerMultiprocessor(&per_cu, (const void*)fwd_megakernel, 512, LDS_BYTES) != hipSuccess || per_cu < 1) { fprintf(stderr, "kernel_launch: occupancy query gave %d\n", per_cu); per_cu = 1; }
        (void)hipGetLastError();
        grid = cus * 1;
    }
    if (grid < 0) return;
    Params p{};
    for (int i = 0; i < 30; ++i) p.in[i] = (const float*)d_in[i];
    p.out = (float*)d_out; p.ws = (unsigned char*)d_ws; p.pad = 0;
    (void)hipMemsetAsync((char*)d_ws + WS_BAR, 0, 3456 * 4, stream);
    if (coop) {
        p.ph_lo = 0; p.ph_hi = 33; p.use_sync = 1;
        void* args[] = {&p};
        hipError_t e = hipLaunchCooperativeKernel((const void*)fwd_megakernel, dim3(grid), dim3(512), args, LDS_BYTES, stream);
        if (e == hipSuccess) return;
        fprintf(stderr, "kernel_launch: cooperative launch failed: %s (grid %d); falling back to one launch per phase\n", hipGetErrorString(e), grid);
        (void)hipGetLastError(); coop = 0;
    }
    for (int ph = 0; ph < 33; ++ph) { p.ph_lo = ph; p.ph_hi = ph + 1; p.use_sync = 0; hipLaunchKernelGGL(fwd_megakernel, dim3(grid), dim3(512), LDS_BYTES, stream, p); }
}
```

```cpp
#include <hip/hip_runtime.h>
#include <hip/hip_cooperative_groups.h>
#include <cstdio>
namespace cg = cooperative_groups;
#define LAS __attribute__((address_space(3)))
typedef unsigned short bf16_t;
typedef short bf16x8 __attribute__((ext_vector_type(8)));
typedef float f32x4 __attribute__((ext_vector_type(4)));
typedef float f32x2 __attribute__((ext_vector_type(2)));
typedef unsigned u32x2 __attribute__((ext_vector_type(2)));
typedef unsigned u32x4 __attribute__((ext_vector_type(4)));

constexpr int D = 2048, NTOK = 24736, MP = 24832, NINP = 11008, NIN = 10784;
constexpr int NCH16 = 1546, CHP = 1792, NCK = 394;
constexpr int C_GA = 512, C_Q = 1024, C_K = 1280, C_V = 1536, C_GB = 2048, C_XC = 2560, C_GC = 3584, C_MG = 4608, C_GLR = 10752;
constexpr int LDS_BYTES = 150528 + 16;
#ifndef SYNCREP
#define SYNCREP 1
#endif
#ifndef DUP
#define DUP -1
#endif
#ifndef SUBM
#define SUBM 7
#endif
#ifndef PHM
#define PHM 255
#endif

constexpr size_t al256(size_t x) { return (x + 255) & ~(size_t)255; }
constexpr size_t WS_Z = 0;
constexpr size_t WS_H = WS_Z + al256((size_t)MP * D * 4);
constexpr size_t WS_COLS = WS_H + al256((size_t)MP * D * 2);
constexpr size_t WS_YALL = WS_COLS + al256((size_t)MP * NINP * 2);
constexpr size_t WS_ZS5 = WS_YALL + al256((size_t)MP * D * 2);
constexpr size_t WS_UBUF = WS_ZS5 + al256((size_t)MP * 512 * 2);
constexpr size_t WS_ST = WS_UBUF + al256((size_t)32 * CHP * 512 * 2);
constexpr size_t WS_DS = WS_ST + al256((size_t)32 * CHP * 256 * 4);
constexpr size_t WS_M32 = WS_UBUF;
constexpr size_t WS_DECAY = WS_DS + al256((size_t)NCK * 4 * 2 * 8192 * 4);
constexpr size_t WS_LRUA = WS_DECAY + al256((size_t)NCK * 4 * 2 * 64 * 4);
constexpr size_t WS_LRUH = WS_LRUA + al256((size_t)NCK * 2 * 1024 * 4);
constexpr size_t WS_LRUC = WS_LRUH + al256((size_t)NCK * 2 * 1024 * 4);
constexpr size_t WS_PW = WS_LRUC + al256((size_t)NCK * 2 * 1024 * 4);
constexpr size_t WS_BBAR = WS_PW + al256((size_t)4 * 32 * 2 * 17 * 64 * 8);
constexpr size_t WS_WMAT = WS_BBAR + al256((size_t)4 * 32 * 2 * 64 * 16 * 8);
constexpr size_t WS_PMAT = WS_WMAT + al256((size_t)32 * 256 * 512 * 2);
constexpr size_t WS_BTIN = WS_PMAT + al256((size_t)32 * 256 * 256 * 2);
constexpr size_t WS_BTOUT = WS_BTIN + al256((size_t)NINP * D * 2);
constexpr size_t WS_BTO = WS_BTOUT + al256((size_t)D * D * 2);
constexpr size_t WS_BTGLU = WS_BTO + al256((size_t)D * D * 2);
constexpr size_t WS_BTLRU = WS_BTGLU + al256((size_t)512 * 512 * 2);
constexpr size_t WS_KMAT = WS_BTLRU + al256((size_t)32 * 128 * 128 * 2);
constexpr size_t WS_BAR = WS_KMAT + al256((size_t)32 * 2 * 16 * 256 * 4);
constexpr size_t WS_END = WS_BAR + al256((size_t)3456 * 4);
constexpr size_t WS_GB = WS_END;
constexpr size_t WS_END2 = WS_GB + al256((size_t)NCK * 4 * 8192 * 4);
constexpr size_t WS_SPB = WS_END2;
constexpr size_t WS_END3 = WS_SPB + al256((size_t)NCK * 4 * 2 * 8192 * 2);
constexpr size_t PWL = (size_t)32 * 2 * 17 * 64, BBL = (size_t)32 * 2 * 64 * 16;
static_assert(WS_END3 <= (size_t)1413480448, "workspace too large");
static_assert((size_t)MP * D * 4 <= WS_DECAY - WS_UBUF, "m32 alias too small");

struct Params { const float* in[30]; float* out; unsigned char* ws; int ph_lo, ph_hi, use_sync, pad; };

#define LBAR() do { asm volatile("s_waitcnt lgkmcnt(0)" ::: "memory"); __builtin_amdgcn_s_barrier(); asm volatile("" ::: "memory"); } while (0)
__device__ __forceinline__ unsigned cvt_pk_bf16(float lo, float hi) { unsigned r; asm volatile("v_cvt_pk_bf16_f32 %0, %1, %2" : "=v"(r) : "v"(lo), "v"(hi)); return r; }
__device__ __forceinline__ bf16_t f2bf(float f) { return (bf16_t)(cvt_pk_bf16(f, 0.f) & 0xffffu); }
__device__ __forceinline__ bf16_t f2bf_sw(float f) { unsigned u = __float_as_uint(f); u += 0x7FFFu + ((u >> 16) & 1u); return (bf16_t)(u >> 16); }
__device__ __forceinline__ float bf2f(bf16_t b) { return __uint_as_float(((unsigned)b) << 16); }
__device__ __forceinline__ float bflo(unsigned w) { return __uint_as_float(w << 16); }
__device__ __forceinline__ float bfhi(unsigned w) { return __uint_as_float(w & 0xffff0000u); }
__device__ __forceinline__ float sigm(float x) { return __builtin_amdgcn_rcpf(1.0f + __expf(-x)); }
__device__ __forceinline__ float silu(float x) { return x * sigm(x); }
__device__ __forceinline__ float glu2(float z, float a, float g) { return z * g * __builtin_amdgcn_rcpf((1.0f + __expf(-a)) * (1.0f + __expf(-g))); }
__device__ __forceinline__ float gelu_t(float x) { const float u = 0.7978845608028654f * (x + 0.044715f * x * x * x); return x * sigm(2.0f * u); }
__device__ __forceinline__ float logsig(float x) { return -(fmaxf(-x, 0.f) + __logf(1.0f + __expf(-fabsf(x)))); }

__device__ __forceinline__ int seq_start(int s) { return s < 2 ? s * 4112 : 8224 + (s - 2) * 2064; }
__device__ __forceinline__ int seq_len(int s) { return s < 2 ? 4112 : 2064; }
__device__ __forceinline__ void chunk_info(int ci, int& seq, int& c) { if (ci < 130) { seq = ci / 65; c = ci - seq * 65; } else { const int t = ci - 130; const int q = t / 33; seq = 2 + q; c = t - q * 33; } }

constexpr int BM = 256, BK = 64, HALF = 128, HTB = HALF * BK * 2, STAGE_BYTES = 8 * HTB, NXCD = 8, WGM = 8;
__device__ __forceinline__ int lds_byte(int r, int c) { const int st = (r >> 4) * 2 + (c >> 5), rr = r & 15, cc = c & 31, ob = rr * 64 + cc * 2; return st * 1024 + (ob ^ (((ob >> 9) & 1) << 5)); }
__device__ __forceinline__ void stage_rc(int b, int& R, int& C) { const int st = b / 1024, sb = b % 1024, swz = sb ^ (((sb >> 9) & 1) << 5); R = (st >> 1) * 16 + swz / 64; C = (st & 1) * 32 + (swz % 64) / 2; }

struct Unit { int pm, pn, sub, nt; const char* a; const char* b; };

struct TileOrder {
    int nM, nN, nwg, G, c, mult, nt0; const char* A; const char* B; size_t tA, tB;
    __device__ __forceinline__ bool next(int i, Unit& u) const {
        const int ti = i / mult, sub = i - ti * mult;
        const long L = (long)ti * G + c; if (L >= nwg) return false;
        int wgid = (int)L; { const int q = nwg / NXCD, r = nwg % NXCD, xcd = wgid % NXCD, off = wgid / NXCD; wgid = (xcd < r ? xcd * (q + 1) : r * (q + 1) + (xcd - r) * q) + off; }
        const int nig = WGM * nN, gid = wgid / nig, fm = gid * WGM, gsz = (nM - fm) < WGM ? (nM - fm) : WGM;
        u.pm = fm + ((wgid % nig) % gsz); u.pn = (wgid % nig) / gsz; u.sub = sub;
        const int koff = (mult == 3) ? sub * 512 : 0; u.nt = (mult == 3) ? (sub == 2 ? 16 : 8) : nt0;
        u.a = A + (size_t)u.pm * tA + (size_t)koff * 2; u.b = B + (size_t)u.pn * tB + (size_t)koff * 2; return true;
    }
};
struct GroupOrder {
    int G, c, nt0; const char* A; const char* B; size_t gsA, gsB, tA;
    __device__ __forceinline__ bool next(int i, Unit& u) const {
        const int L = i * G + c; if (L >= 224) return false;
        const int g = L / 7, pm = L - g * 7; u.pm = pm; u.pn = 0; u.sub = g; u.nt = nt0;
        u.a = A + (size_t)g * gsA + (size_t)pm * tA; u.b = B + (size_t)g * gsB; return true;
    }
};

__device__ __forceinline__ int perm32(int rho) { const int n = rho >> 4, i = rho & 15; return 8 * (i >> 2) + 4 * n + (i & 3); }
template <class Epi, class Sched>
__device__ __forceinline__ void gemm_phase(const int TID, LAS unsigned char* lds, const int lda, const int ldb, const Sched& S, const Epi& E) {
    const int tid = TID, wid = __builtin_amdgcn_readfirstlane(tid >> 6), lane = tid & 63, wr = wid >> 2, wc = wid & 3, fr = lane & 15, fq = lane >> 4;
    unsigned voffA[2], voffB[2];
#pragma unroll
    for (int i = 0; i < 2; ++i) { int R, C; stage_rc(tid * 16 + i * 8192, R, C); const int Rb = Epi::PERM ? ((R & ~31) + perm32(R & 31)) : R; voffA[i] = (unsigned)(R * lda + C) * 2u; voffB[i] = (unsigned)(Rb * ldb + C) * 2u; }
    const size_t kstep = (size_t)(BK * 2);
    const size_t hA = (size_t)HALF * lda * 2, hB = (size_t)HALF * ldb * 2;
    const unsigned ldsw = (unsigned)wid * 1024u;
    const int aoff = lds_byte(wr * 64 + fr, fq * 8), boff = lds_byte(wc * 32 + fr, fq * 8);
#define PG8_SA(b, h) (((b) * 2 + (h)) * HTB)
#define PG8_SB(b, h) ((4 + (b) * 2 + (h)) * HTB)
#define PG8_STAGE(bufoff, gbase, voff) do { _Pragma("unroll") for (int _i = 0; _i < 2; ++_i) \
        __builtin_amdgcn_global_load_lds((const unsigned*)((const char*)(gbase) + (voff)[_i]), (LAS unsigned*)(lds + (bufoff) + ldsw + _i * 8192), 16, 0, 0); } while (0)
#define PG8_LDA(dst, b, h) do { _Pragma("unroll") for (int m = 0; m < 4; ++m) _Pragma("unroll") for (int k = 0; k < 2; ++k) dst[m][k] = *(const LAS bf16x8*)(lds + PG8_SA(b, h) + aoff + m * 2048 + k * 1024); } while (0)
#define PG8_LDB(dst, b, h) do { _Pragma("unroll") for (int n = 0; n < 2; ++n) _Pragma("unroll") for (int k = 0; k < 2; ++k) dst[n][k] = *(const LAS bf16x8*)(lds + PG8_SB(b, h) + boff + n * 2048 + k * 1024); } while (0)
#define PG8_MMA(ai, bj, At, Bt) do { __builtin_amdgcn_s_setprio(1); _Pragma("unroll") for (int m = 0; m < 4; ++m) _Pragma("unroll") for (int n = 0; n < 2; ++n) _Pragma("unroll") for (int k = 0; k < 2; ++k) \
        acc[ai][bj][m][n] = __builtin_amdgcn_mfma_f32_16x16x32_bf16(Bt[n][k], At[m][k], acc[ai][bj][m][n], 0, 0, 0); __builtin_amdgcn_s_setprio(0); } while (0)
#define PG8_WAIT_V(n) asm volatile("s_waitcnt vmcnt(" #n ")" ::: "memory")
#define PG8_WAIT_L(n) asm volatile("s_waitcnt lgkmcnt(" #n ")" ::: "memory")
#define PG8_BAR __builtin_amdgcn_s_barrier()
#define PG8_SCHED __builtin_amdgcn_sched_barrier(0)
    Unit cur, nxt; int ui = 0;
    if (!S.next(0, cur)) return;
    f32x4 acc[2][2][4][2];
#pragma unroll
    for (int a = 0; a < 2; ++a)
#pragma unroll
        for (int b = 0; b < 2; ++b)
#pragma unroll
            for (int m = 0; m < 4; ++m)
#pragma unroll
                for (int n = 0; n < 2; ++n) acc[a][b][m][n] = (f32x4){0.f, 0.f, 0.f, 0.f};
    bf16x8 At[4][2], B0[2][2], B1[2][2];
    const char* cA = cur.a; const char* cB = cur.b;
    PG8_STAGE(PG8_SB(0, 0), cB, voffB); PG8_STAGE(PG8_SA(0, 0), cA, voffA); PG8_STAGE(PG8_SB(0, 1), cB + hB, voffB); PG8_STAGE(PG8_SA(0, 1), cA + hA, voffA);
    if (wr == 1) PG8_BAR;
    PG8_WAIT_V(4); PG8_BAR;
    PG8_STAGE(PG8_SB(1, 0), cB + kstep, voffB); PG8_STAGE(PG8_SA(1, 0), cA + kstep, voffA); PG8_STAGE(PG8_SB(1, 1), cB + hB + kstep, voffB);
    PG8_WAIT_V(6); PG8_BAR;
    for (;;) {
        const bool has_next = S.next(ui + 1, nxt);
        const char* nA = has_next ? nxt.a : cA; const char* nB = has_next ? nxt.b : cB;
        const int nt = cur.nt;
        for (int t = 0; t < nt; t += 2) {
            const bool last = (t == nt - 2);
            const char* a1 = cA + (size_t)(t + 1) * kstep;
            const char* a2 = last ? nA : cA + (size_t)(t + 2) * kstep; const char* b2 = last ? nB : cB + (size_t)(t + 2) * kstep;
            const char* a3 = a2 + kstep; const char* b3 = b2 + kstep;
            PG8_LDB(B0, 0, 0); PG8_SCHED; PG8_LDA(At, 0, 0); PG8_STAGE(PG8_SA(1, 1), a1 + hA, voffA);
            PG8_WAIT_L(8); PG8_BAR; PG8_WAIT_L(0); PG8_MMA(0, 0, At, B0); PG8_BAR; PG8_SCHED;
            PG8_LDB(B1, 0, 1); PG8_STAGE(PG8_SB(0, 0), b2, voffB);
            PG8_BAR; PG8_WAIT_L(0); PG8_MMA(0, 1, At, B1); PG8_BAR;
            PG8_LDA(At, 0, 1); PG8_STAGE(PG8_SA(0, 0), a2, voffA);
            PG8_BAR; PG8_WAIT_L(0); PG8_MMA(1, 0, At, B0); PG8_BAR; PG8_SCHED;
            PG8_STAGE(PG8_SB(0, 1), b2 + hB, voffB);
            PG8_WAIT_V(6); PG8_BAR; PG8_MMA(1, 1, At, B1); PG8_BAR;
            PG8_LDB(B0, 1, 0); PG8_SCHED; PG8_LDA(At, 1, 0); PG8_STAGE(PG8_SA(0, 1), a2 + hA, voffA);
            PG8_WAIT_L(8); PG8_BAR; PG8_WAIT_L(0); PG8_MMA(0, 0, At, B0); PG8_BAR; PG8_SCHED;
            PG8_LDB(B1, 1, 1); PG8_STAGE(PG8_SB(1, 0), b3, voffB);
            PG8_BAR; PG8_WAIT_L(0); PG8_MMA(0, 1, At, B1); PG8_BAR;
            PG8_LDA(At, 1, 1); PG8_STAGE(PG8_SA(1, 0), a3, voffA);
            PG8_BAR; PG8_WAIT_L(0); PG8_MMA(1, 0, At, B0); PG8_BAR; PG8_SCHED;
            PG8_STAGE(PG8_SB(1, 1), b3 + hB, voffB);
            PG8_WAIT_V(6); PG8_BAR; PG8_MMA(1, 1, At, B1); PG8_BAR;
        }
        E(acc, cur, wr, wc, fr, fq);
        if (!has_next) break;
#pragma unroll
        for (int a = 0; a < 2; ++a)
#pragma unroll
            for (int b = 0; b < 2; ++b)
#pragma unroll
                for (int m = 0; m < 4; ++m)
#pragma unroll
                    for (int n = 0; n < 2; ++n) acc[a][b][m][n] = (f32x4){0.f, 0.f, 0.f, 0.f};
        cur = nxt; cA = nA; cB = nB; ++ui;
    }
    PG8_WAIT_V(0);
    if (wr == 0) PG8_BAR;
    PG8_BAR;
#undef PG8_SA
#undef PG8_SB
#undef PG8_STAGE
#undef PG8_LDA
#undef PG8_LDB
#undef PG8_MMA
#undef PG8_WAIT_V
#undef PG8_WAIT_L
#undef PG8_BAR
#undef PG8_SCHED
}

#define EPI_LOOP(...) \
    const int row0 = u.pm * BM + wr * 64 + fr, col0 = u.pn * BM + wc * 32 + 4 * fq; \
    _Pragma("unroll") for (int ai = 0; ai < 2; ++ai) _Pragma("unroll") for (int m = 0; m < 4; ++m) { const int r = row0 + ai * HALF + m * 16; \
        _Pragma("unroll") for (int bj = 0; bj < 2; ++bj) _Pragma("unroll") for (int n = 0; n < 2; ++n) { const int c = col0 + bj * HALF + n * 16; const f32x4 v = acc[ai][bj][m][n]; __VA_ARGS__ } }

#define EPI_PROWS(...) \
    const int row0 = u.pm * BM + wr * 64 + fr, col0 = u.pn * BM + wc * 32 + 8 * fq; \
    _Pragma("unroll") for (int ai = 0; ai < 2; ++ai) _Pragma("unroll") for (int m = 0; m < 4; ++m) { const int r = row0 + ai * HALF + m * 16; __VA_ARGS__ }
__device__ __forceinline__ u32x4 pack8(const f32x4 a, const f32x4 b) { u32x4 w; w[0] = cvt_pk_bf16(a[0], a[1]); w[1] = cvt_pk_bf16(a[2], a[3]); w[2] = cvt_pk_bf16(b[0], b[1]); w[3] = cvt_pk_bf16(b[2], b[3]); return w; }
__device__ __forceinline__ unsigned q8(float x) { return (unsigned)__float2uint_rn(__builtin_amdgcn_rcpf(fmaf(__expf(-x), 1.0f / 255.0f, 1.0f / 255.0f))); }
__device__ __forceinline__ unsigned q8x4(const f32x4 v) { return q8(v[0]) | (q8(v[1]) << 8) | (q8(v[2]) << 16) | (q8(v[3]) << 24); }
struct EpiIn { static constexpr bool PERM = true; bf16_t* cols; bf16_t* ubuf;
    __device__ __forceinline__ void operator()(const f32x4 (&acc)[2][2][4][2], const Unit& u, int wr, int wc, int fr, int fq) const {
        if (u.pn >= 18 && u.pn < 42) {
            EPI_PROWS({ u32x4 w; w[0] = q8x4(acc[ai][0][m][0]); w[1] = q8x4(acc[ai][0][m][1]); w[2] = q8x4(acc[ai][1][m][0]); w[3] = q8x4(acc[ai][1][m][1]);
                *(u32x4*)((unsigned char*)(cols + (size_t)r * NINP + C_MG) + (u.pn - 18) * 256 + (wc * 4 + fq) * 16) = w; })
        } else {
            EPI_PROWS({ _Pragma("unroll") for (int bj = 0; bj < 2; ++bj) { const int c = col0 + bj * HALF;
                bf16_t* dst = (u.pn < 2) ? ubuf + ((size_t)((c >> 4) * CHP + (r >> 4)) * 512 + (r & 15) * 16 + (c & 15)) : cols + (size_t)r * NINP + c;
                *(u32x4*)dst = pack8(acc[ai][bj][m][0], acc[ai][bj][m][1]); } })
        }
    } };
struct EpiS5State { static constexpr bool PERM = false; float* st;
    __device__ __forceinline__ void operator()(const f32x4 (&acc)[2][2][4][2], const Unit& u, int wr, int wc, int fr, int fq) const {
        EPI_LOOP({ u32x2 w; w.x = cvt_pk_bf16(v[0], v[1]); w.y = cvt_pk_bf16(v[2], v[3]); *(u32x2*)((bf16_t*)st + ((size_t)(u.sub * CHP + r)) * 256 + c) = w; })
    } };
struct EpiS5Out { static constexpr bool PERM = true; bf16_t* zs5;
    __device__ __forceinline__ void operator()(const f32x4 (&acc)[2][2][4][2], const Unit& u, int wr, int wc, int fr, int fq) const {
        EPI_PROWS({ if (r < NCH16) { _Pragma("unroll") for (int bj = 0; bj < 2; ++bj) { const int c = col0 + bj * HALF; f32x4 a = acc[ai][bj][m][0], b2 = acc[ai][bj][m][1];
            _Pragma("unroll") for (int e = 0; e < 4; ++e) { a[e] = gelu_t(a[e]); b2[e] = gelu_t(b2[e]); }
            *(u32x4*)(zs5 + (size_t)(r * 16 + (c >> 4)) * 512 + u.sub * 16 + (c & 15)) = pack8(a, b2); } } })
    } };
#define EPI_ROWS(...) \
    const int row0 = u.pm * BM + wr * 64 + fr, col0 = u.pn * BM + wc * 32 + 4 * fq; \
    _Pragma("unroll") for (int ai = 0; ai < 2; ++ai) _Pragma("unroll") for (int m = 0; m < 4; ++m) { const int r = row0 + ai * HALF + m * 16; __VA_ARGS__ }
#define QOFF(q) (((q) >> 1) * HALF + ((q) & 1) * 16)
#define EPI_PIPE(LOADF, COMPF) \
    const int row0 = u.pm * BM + wr * 64 + fr, col0 = u.pn * BM + wc * 32 + 8 * fq; \
    LOADF(0, 0); \
    _Pragma("unroll") for (int gi = 0; gi < 8; ++gi) { if (gi + 1 < 8) { if ((gi & 1) == 0) { LOADF(gi + 1, 1); } else { LOADF(gi + 1, 0); } } if ((gi & 1) == 0) { COMPF(gi, 0); } else { COMPF(gi, 1); } }
#define GROW(gi) (row0 + ((gi) >> 2) * HALF + ((gi) & 3) * 16)
struct EpiGlu { static constexpr bool PERM = true; const bf16_t* zs5; const bf16_t* cols; const float* bglu; bf16_t* yall;
    __device__ __forceinline__ void operator()(const f32x4 (&acc)[2][2][4][2], const Unit& u, int wr, int wc, int fr, int fq) const {
        u32x4 zz[2][2], gg[2][2]; f32x4 bb[2][2];
        { const int c0 = u.pn * BM + wc * 32 + 8 * fq; _Pragma("unroll") for (int bj = 0; bj < 2; ++bj) { bb[bj][0] = *(const f32x4*)(bglu + c0 + bj * HALF); bb[bj][1] = *(const f32x4*)(bglu + c0 + bj * HALF + 4); } }
#define GLU_LOAD(gi, bf) do { const int r_ = GROW(gi); _Pragma("unroll") for (int bj = 0; bj < 2; ++bj) { const int c = col0 + bj * HALF; zz[bf][bj] = *(const u32x4*)(zs5 + (size_t)r_ * 512 + c); gg[bf][bj] = *(const u32x4*)(cols + (size_t)r_ * NINP + C_GA + c); } } while (0)
#define GLU_COMP(gi, bf) do { const int r_ = GROW(gi); _Pragma("unroll") for (int bj = 0; bj < 2; ++bj) { const int c = col0 + bj * HALF; f32x4 o[2]; \
            _Pragma("unroll") for (int hf = 0; hf < 2; ++hf) { const f32x4 v = acc[(gi) >> 2][bj][(gi) & 3][hf]; \
                o[hf][0] = glu2(bflo(zz[bf][bj][2 * hf]), v[0] + bb[bj][hf][0], bflo(gg[bf][bj][2 * hf])); o[hf][1] = glu2(bfhi(zz[bf][bj][2 * hf]), v[1] + bb[bj][hf][1], bfhi(gg[bf][bj][2 * hf])); \
                o[hf][2] = glu2(bflo(zz[bf][bj][2 * hf + 1]), v[2] + bb[bj][hf][2], bflo(gg[bf][bj][2 * hf + 1])); o[hf][3] = glu2(bfhi(zz[bf][bj][2 * hf + 1]), v[3] + bb[bj][hf][3], bfhi(gg[bf][bj][2 * hf + 1])); } \
            *(u32x4*)(yall + (size_t)r_ * D + c) = pack8(o[0], o[1]); } } while (0)
        EPI_PIPE(GLU_LOAD, GLU_COMP)
#undef GLU_LOAD
#undef GLU_COMP
    } };
__device__ __forceinline__ float ub(unsigned w, int k) { return (float)((w >> (8 * k)) & 255u) * (1.0f / 255.0f); }
struct EpiOut { static constexpr bool PERM = true; const bf16_t* cols; bf16_t* mbf;
    __device__ __forceinline__ void operator()(const f32x4 (&acc)[2][2][4][2], const Unit& u, int wr, int wc, int fr, int fq) const {
        u32x4 gg[8], mm[2][2];
        { const int row0g = u.pm * BM + wr * 64 + fr;
#pragma unroll
          for (int gi = 0; gi < 8; ++gi) gg[gi] = *(const u32x4*)((const unsigned char*)(cols + (size_t)(row0g + (gi >> 2) * HALF + (gi & 3) * 16) * NINP + C_MG) + (u.sub * 8 + u.pn) * 256 + (wc * 4 + fq) * 16); }
#define OUT_LOAD(gi, bf) do { const int r_ = GROW(gi); const bf16_t* mp = mbf + (size_t)r_ * D + col0; \
            _Pragma("unroll") for (int bj = 0; bj < 2; ++bj) { mm[bf][bj] = (u32x4){0u, 0u, 0u, 0u}; if (u.sub != 0) mm[bf][bj] = *(const u32x4*)(mp + bj * HALF); } } while (0)
#define OUT_COMP(gi, bf) do { const int r_ = GROW(gi); bf16_t* mp = mbf + (size_t)r_ * D + col0; _Pragma("unroll") for (int bj = 0; bj < 2; ++bj) { f32x4 o[2]; \
            _Pragma("unroll") for (int hf = 0; hf < 2; ++hf) { const f32x4 v = acc[(gi) >> 2][bj][(gi) & 3][hf]; const unsigned gw = gg[gi][bj * 2 + hf]; \
                o[hf][0] = bflo(mm[bf][bj][2 * hf]) + ub(gw, 0) * v[0]; o[hf][1] = bfhi(mm[bf][bj][2 * hf]) + ub(gw, 1) * v[1]; \
                o[hf][2] = bflo(mm[bf][bj][2 * hf + 1]) + ub(gw, 2) * v[2]; o[hf][3] = bfhi(mm[bf][bj][2 * hf + 1]) + ub(gw, 3) * v[3]; } \
            *(u32x4*)(mp + bj * HALF) = pack8(o[0], o[1]); } } while (0)
        EPI_PIPE(OUT_LOAD, OUT_COMP)
#undef OUT_LOAD
#undef OUT_COMP
    } };
__device__ __forceinline__ const float* src_row(const Params& p, int r);
struct EpiWo { static constexpr bool PERM = false; float* z; const Params* pp; int first;
    __device__ __forceinline__ void operator()(const f32x4 (&acc)[2][2][4][2], const Unit& u, int wr, int wc, int fr, int fq) const {
        EPI_ROWS({ if (r < NTOK) { float* zp = z + (size_t)r * D + col0; const float* rp = first ? src_row(*pp, r) + col0 : zp; f32x4 pv[4];
            _Pragma("unroll") for (int q = 0; q < 4; ++q) pv[q] = *(const f32x4*)(rp + QOFF(q));
            _Pragma("unroll") for (int q = 0; q < 4; ++q) *(f32x4*)(zp + QOFF(q)) = pv[q] + acc[ai][q >> 1][m][q & 1]; } })
    } };

__device__ __forceinline__ const float* src_row(const Params& p, int r) {
    int s, pos; if (r < 8224) { s = r / 4112; pos = r - s * 4112; } else { const int t = r - 8224; const int q = t / 2064; s = 2 + q; pos = t - q * 2064; }
    if (pos < 16) return p.in[2] + (size_t)pos * D;
    return s < 2 ? p.in[0] + ((size_t)s * 4096 + (pos - 16)) * D : p.in[1] + ((size_t)(s - 2) * 2048 + (pos - 16)) * D;
}
__device__ __forceinline__ void rmsnorm_phase(const int TID, const int BID, const Params& p, int l) {
    float* z = (float*)(p.ws + WS_Z); bf16_t* h = (bf16_t*)(p.ws + WS_H); const float* g = p.in[3] + (size_t)l * D;
    const int lane = TID & 63, gw = BID * 8 + (TID >> 6), nw = gridDim.x * 8;
    f32x4 gg[8];
#pragma unroll
    for (int i = 0; i < 8; ++i) gg[i] = *(const f32x4*)(g + (i * 64 + lane) * 4);
    f32x4 xn[8];
    { const int r0 = gw < NTOK ? gw : NTOK - 1; const float* src = (l == 0) ? src_row(p, r0) : z + (size_t)r0 * D;
#pragma unroll
      for (int i = 0; i < 8; ++i) xn[i] = *(const f32x4*)(src + (i * 64 + lane) * 4); }
    for (int r = gw; r < MP; r += nw) {
        bf16_t* hr = h + (size_t)r * D;
        f32x4 x[8];
#pragma unroll
        for (int i = 0; i < 8; ++i) x[i] = xn[i];
        { const int rn = (r + nw < NTOK) ? r + nw : NTOK - 1; const float* src = (l == 0) ? src_row(p, rn) : z + (size_t)rn * D;
#pragma unroll
          for (int i = 0; i < 8; ++i) xn[i] = *(const f32x4*)(src + (i * 64 + lane) * 4); }
        if (r >= NTOK) { for (int i = 0; i < 4; ++i) *(u32x4*)(hr + (i * 64 + lane) * 8) = (u32x4){0u, 0u, 0u, 0u}; continue; }
        float ss = 0.f;
#pragma unroll
        for (int i = 0; i < 8; ++i) ss += x[i][0] * x[i][0] + x[i][1] * x[i][1] + x[i][2] * x[i][2] + x[i][3] * x[i][3];
#pragma unroll
        for (int o = 32; o >= 1; o >>= 1) ss += __shfl_xor(ss, o);
        const float rs = rsqrtf(ss * (1.0f / D) + 1e-6f);
#pragma unroll
        for (int i = 0; i < 8; ++i) { const int c = (i * 64 + lane) * 4;
            u32x2 w; w.x = cvt_pk_bf16(x[i][0] * rs * gg[i][0], x[i][1] * rs * gg[i][1]); w.y = cvt_pk_bf16(x[i][2] * rs * gg[i][2], x[i][3] * rs * gg[i][3]); *(u32x2*)(hr + c) = w; }
    }
}
__device__ __forceinline__ void final_norm_phase(const int TID, const int BID, const Params& p) {
    const float* z = (const float*)(p.ws + WS_Z); const float* g = p.in[29];
    const int lane = TID & 63, gw = BID * 8 + (TID >> 6), nw = gridDim.x * 8;
    f32x4 gg[8];
#pragma unroll
    for (int i = 0; i < 8; ++i) gg[i] = *(const f32x4*)(g + (i * 64 + lane) * 4);
    f32x4 xn[8];
    { const int r0 = gw < NTOK ? gw : NTOK - 1;
#pragma unroll
      for (int i = 0; i < 8; ++i) xn[i] = *(const f32x4*)(z + (size_t)r0 * D + (i * 64 + lane) * 4); }
    for (int r = gw; r < NTOK; r += nw) {
        f32x4 x[8];
#pragma unroll
        for (int i = 0; i < 8; ++i) x[i] = xn[i];
        { const int rn = (r + nw < NTOK) ? r + nw : NTOK - 1;
#pragma unroll
          for (int i = 0; i < 8; ++i) xn[i] = *(const f32x4*)(z + (size_t)rn * D + (i * 64 + lane) * 4); }
        int s, pos; if (r < 8224) { s = r / 4112; pos = r - s * 4112; } else { const int t = r - 8224; const int q = t / 2064; s = 2 + q; pos = t - q * 2064; }
        if (pos < 16) continue;
        float* dst = s < 2 ? p.out + ((size_t)s * 4096 + (pos - 16)) * D : p.out + (size_t)2 * 4096 * D + ((size_t)(s - 2) * 2048 + (pos - 16)) * D;
        float ss = 0.f;
#pragma unroll
        for (int i = 0; i < 8; ++i) ss += x[i][0] * x[i][0] + x[i][1] * x[i][1] + x[i][2] * x[i][2] + x[i][3] * x[i][3];
#pragma unroll
        for (int o = 32; o >= 1; o >>= 1) ss += __shfl_xor(ss, o);
        const float rs = rsqrtf(ss * (1.0f / D) + 1e-6f);
#pragma unroll
        for (int i = 0; i < 8; ++i) { const int c = (i * 64 + lane) * 4; f32x4 o; o[0] = x[i][0] * rs * gg[i][0]; o[1] = x[i][1] * rs * gg[i][1]; o[2] = x[i][2] * rs * gg[i][2]; o[3] = x[i][3] * rs * gg[i][3]; __builtin_nontemporal_store(o, (f32x4*)(dst + c)); }
    }
}
__device__ __forceinline__ void conv_tile(const int TID, const float* src, int ldn, int k0, int n0, int nvalid, bf16_t* dst, int ldd, int kofs, bool mapin, LAS float* tile) {
    const int tx = TID & 63, ty = TID >> 6;
    const int ncl = (n0 + tx < nvalid) ? n0 + tx : nvalid - 1;
#pragma unroll
    for (int i = 0; i < 8; ++i) { const int k = ty + 8 * i; tile[k * 65 + tx] = src[(size_t)(k0 + k) * ldn + ncl]; }
    __syncthreads();
#pragma unroll
    for (int i = 0; i < 8; ++i) { const int nn = ty + 8 * i; int n = n0 + nn;
        if (n < nvalid) { if (mapin) n = (n < 2560) ? n : (n < 2592 ? n + (C_GLR - 2560) : n - 32); dst[(size_t)n * ldd + kofs + k0 + tx] = f2bf(tile[tx * 65 + nn]); } }
    __syncthreads();
}
__device__ __forceinline__ void convert_weights(const int TID, const int BID, const Params& p, int l, LAS float* tile) {
    const int G = gridDim.x, b = BID;
    bf16_t* btin = (bf16_t*)(p.ws + WS_BTIN); bf16_t* btout = (bf16_t*)(p.ws + WS_BTOUT); bf16_t* bto = (bf16_t*)(p.ws + WS_BTO); bf16_t* btglu = (bf16_t*)(p.ws + WS_BTGLU); bf16_t* btlru = (bf16_t*)(p.ws + WS_BTLRU);
    { const float* src = p.in[4] + (size_t)l * D * NIN; const int tx = TID & 63, ty = TID >> 6; float v[8];
      { const int t = b < 32 * 169 ? b : 0; const int kt = t / 169, ntl = t - kt * 169; const int ncl = (ntl * 64 + tx < NIN) ? ntl * 64 + tx : NIN - 1;
#pragma unroll
        for (int i = 0; i < 8; ++i) v[i] = src[(size_t)(kt * 64 + ty + 8 * i) * NIN + ncl]; }
      for (int t = b; t < 32 * 169; t += G) { const int kt = t / 169, ntl = t - kt * 169, k0 = kt * 64, n0 = ntl * 64;
#pragma unroll
          for (int i = 0; i < 8; ++i) tile[(ty + 8 * i) * 65 + tx] = v[i];
          { const int tn = (t + G < 32 * 169) ? t + G : t; const int ktn = tn / 169, ntn = tn - ktn * 169; const int ncl = (ntn * 64 + tx < NIN) ? ntn * 64 + tx : NIN - 1;
#pragma unroll
            for (int i = 0; i < 8; ++i) v[i] = src[(size_t)(ktn * 64 + ty + 8 * i) * NIN + ncl]; }
          LBAR();
#pragma unroll
          for (int i = 0; i < 8; ++i) { const int nn = ty + 8 * i; int n = n0 + nn;
              if (n < NIN) { n = (n < 2560) ? n : (n < 2592 ? n + (C_GLR - 2560) : n - 32); btin[(size_t)n * D + k0 + tx] = f2bf(tile[tx * 65 + nn]); } }
          LBAR(); } }
    for (size_t i = (size_t)b * 512 + TID; i < (size_t)(NINP - NIN) * D / 8; i += (size_t)G * 512) *(u32x4*)(btin + (size_t)NIN * D + i * 8) = (u32x4){0u, 0u, 0u, 0u};
    { const float* src = p.in[25] + (size_t)l * 512 * D; for (int t = (b + 64) % G; t < 8 * 32; t += G) { const int kt = t / 32, ntl = t - kt * 32; conv_tile(TID, src, D, kt * 64, ntl * 64, D, btout, D, 0, false, tile); } }
    { const float* src = p.in[26] + (size_t)l * 512 * D; for (int t = (b + 128) % G; t < 8 * 32; t += G) { const int kt = t / 32, ntl = t - kt * 32; conv_tile(TID, src, D, kt * 64, ntl * 64, D, btout, D, 512, false, tile); } }
    { const float* src = p.in[27] + (size_t)l * 1024 * D; for (int t = b; t < 16 * 32; t += G) { const int kt = t / 32, ntl = t - kt * 32; conv_tile(TID, src, D, kt * 64, ntl * 64, D, btout, D, 1024, false, tile); } }
    { const float* src = p.in[28] + (size_t)l * D * D; for (int t = b; t < 32 * 32; t += G) { const int kt = t / 32, ntl = t - kt * 32; conv_tile(TID, src, D, kt * 64, ntl * 64, D, bto, D, 0, false, tile); } }
    { const float* src = p.in[13] + (size_t)l * 512 * 512; for (int t = (b + 192) % G; t < 8 * 8; t += G) { const int kt = t / 8, ntl = t - kt * 8; conv_tile(TID, src, 512, kt * 64, ntl * 64, 512, btglu, 512, 0, false, tile); } }
    for (int t = (b + 32) % G; t < 128; t += G) { const int mat = t >> 2, sub = t & 3;
        const int dk = mat >> 3, nb = mat & 7, d = dk >> 1, kind = dk & 1;
        const float* src = p.in[kind ? 22 : 20] + ((size_t)(l * 2 + d) * 8 + nb) * 128 * 128;
        conv_tile(TID, src, 128, (sub >> 1) * 64, (sub & 1) * 64, 128, btlru + (size_t)mat * 128 * 128, 128, 0, false, tile); }
}
__device__ __forceinline__ double exp_small(double x) { double s = 1.0, t = 1.0; for (int i = 1; i <= 14; ++i) { t *= x / (double)i; s += t; } return s; }
__device__ __forceinline__ double exp_neg(double x) { double e = exp_small(x * (1.0 / 64.0)); for (int i = 0; i < 6; ++i) e *= e; return e; }
__device__ __forceinline__ void s5_tables_all(const int TID, const int BID, const Params& p) {
    for (int vidx = (int)(gridDim.x - 1 - BID) * 512 + TID; vidx < 4 * 4096; vidx += gridDim.x * 512) {
        const int l = vidx >> 12, idx = vidx & 4095;
        f32x2* pw = (f32x2*)(p.ws + WS_PW) + l * PWL; f32x2* bbar = (f32x2*)(p.ws + WS_BBAR) + l * BBL;
        const int g = idx >> 7, d = (idx >> 6) & 1, n = idx & 63;
        const double dt = exp_neg((double)p.in[7][(l * 2 + d) * 32 + g]);
        const double lr = (double)p.in[5][((size_t)(l * 2 + d) * 32 + g) * 64 + n], li = (double)p.in[6][((size_t)(l * 2 + d) * 32 + g) * 64 + n];
        const double mag = exp_neg(lr * dt);
        double ang = li * dt; const double twopi = 6.283185307179586476925287; ang -= twopi * rint(ang / twopi);
        const double a8 = ang * 0.125, a2 = a8 * a8;
        double sn = a8, cs = 1.0, ts = a8, tc = 1.0;
        for (int i = 1; i <= 9; ++i) { tc *= -a2 / (double)((2 * i - 1) * (2 * i)); cs += tc; ts *= -a2 / (double)((2 * i) * (2 * i + 1)); sn += ts; }
        for (int i = 0; i < 3; ++i) { const double c2 = cs * cs - sn * sn, s2 = 2.0 * cs * sn; cs = c2; sn = s2; }
        const double abr = mag * cs, abi = mag * sn;
        double pr = 1.0, pi = 0.0;
        for (int j = 0; j <= 16; ++j) { pw[((size_t)(g * 2 + d) * 17 + j) * 64 + n] = (f32x2){(float)pr, (float)pi}; const double nr = pr * abr - pi * abi, ni = pr * abi + pi * abr; pr = nr; pi = ni; }
        const double den = lr * lr + li * li, fr = ((abr - 1.0) * lr + abi * li) / den, fi = (abi * lr - (abr - 1.0) * li) / den;
        float brf[16], bif[16];
#pragma unroll
        for (int c4 = 0; c4 < 4; ++c4) { const f32x4 t0 = *(const f32x4*)(p.in[8] + (((size_t)l * 32 + g) * 64 + n) * 16 + c4 * 4), t1 = *(const f32x4*)(p.in[9] + (((size_t)l * 32 + g) * 64 + n) * 16 + c4 * 4);
#pragma unroll
            for (int e = 0; e < 4; ++e) { brf[c4 * 4 + e] = t0[e]; bif[c4 * 4 + e] = t1[e]; } }
#pragma unroll
        for (int c = 0; c < 16; ++c) { const double br = (double)brf[c], bi = (double)bif[c];
            bbar[((size_t)(g * 2 + d) * 64 + n) * 16 + c] = (f32x2){(float)(fr * br - fi * bi), (float)(fr * bi + fi * br)}; }
    }
}
__device__ __forceinline__ float s5_kval(const float* cre, const float* cim, const f32x2* pw, const f32x2* bbar, int l, int g, int d, int j, int c, int cp) {
    const float* cr = cre + (((size_t)(l * 2 + d) * 32 + g) * 16 + c) * 64; const float* ci = cim + (((size_t)(l * 2 + d) * 32 + g) * 16 + c) * 64;
    const f32x2* pp = pw + ((size_t)(g * 2 + d) * 17 + j) * 64; const f32x2* bb = bbar + ((size_t)(g * 2 + d) * 64) * 16 + cp;
    float s = 0.f;
#pragma unroll 16
    for (int n = 0; n < 64; ++n) { const f32x2 pv = pp[n]; const f32x2 bv = bb[(size_t)n * 16]; const float er = cr[n] * pv.x - ci[n] * pv.y, ei = cr[n] * pv.y + ci[n] * pv.x; s += er * bv.x - ei * bv.y; }
    return s;
}
__device__ __forceinline__ void s5_assemble_a(const int TID, const int BID, const Params& p, int l) {
    const f32x2* pw = (const f32x2*)(p.ws + WS_PW) + l * PWL; const f32x2* bbar = (const f32x2*)(p.ws + WS_BBAR) + l * BBL;
    float* kmat = (float*)(p.ws + WS_KMAT); bf16_t* pmat = (bf16_t*)(p.ws + WS_PMAT);
    const float* cre = p.in[10]; const float* cim = p.in[11];
    const size_t stride = (size_t)gridDim.x * 512;
    for (size_t idx = (size_t)BID * 512 + TID; idx < (size_t)32 * 2 * 16 * 256; idx += stride) {
        const int g = (int)(idx >> 13), d = (int)(idx >> 12) & 1, j = (int)(idx >> 8) & 15, c = (int)(idx >> 4) & 15, cp = (int)idx & 15;
        kmat[idx] = s5_kval(cre, cim, pw, bbar, l, g, d, j, c, cp);
    }
    for (size_t idx = (size_t)BID * 512 + TID; idx < (size_t)32 * 256 * 256; idx += stride) {
        const int g = (int)(idx >> 16), nout = (int)(idx >> 8) & 255, k = (int)idx & 255, d = nout >> 7, ri = (nout >> 6) & 1, n = nout & 63, s = k >> 4, cp = k & 15, j = d == 0 ? 15 - s : s;
        const f32x2 pv = pw[((size_t)(g * 2 + d) * 17 + j) * 64 + n]; const f32x2 bv = bbar[((size_t)(g * 2 + d) * 64 + n) * 16 + cp];
        pmat[idx] = f2bf(ri == 0 ? pv.x * bv.x - pv.y * bv.y : pv.x * bv.y + pv.y * bv.x);
    }
}
__device__ __forceinline__ void s5_assemble_w(const int TID, const int BID, const Params& p, int l) {
    const f32x2* pw = (const f32x2*)(p.ws + WS_PW) + l * PWL; const float* kmat = (const float*)(p.ws + WS_KMAT);
    bf16_t* wmat = (bf16_t*)(p.ws + WS_WMAT);
    const float* cre = p.in[10]; const float* cim = p.in[11];
    const size_t stride = (size_t)gridDim.x * 512;
    for (size_t idx = (size_t)BID * 512 + TID; idx < (size_t)32 * 256 * 512; idx += stride) {
        const int g = (int)(idx >> 17), nout = (int)(idx >> 9) & 255, k = (int)idx & 511, t = nout >> 4, c = nout & 15;
        float val;
        if (k < 256) { const int s = k >> 4, cp = k & 15; val = 0.f;
            const int jf = s <= t ? t - s : 0, jb = s >= t ? s - t : 0;
            const float kf = kmat[((((size_t)g * 2 + 0) * 16 + jf) * 16 + c) * 16 + cp], kb = kmat[((((size_t)g * 2 + 1) * 16 + jb) * 16 + c) * 16 + cp], dsk = p.in[12][l * 512 + g * 16 + c];
            val = (s <= t ? kf : 0.f) + (s >= t ? kb : 0.f) + ((s == t && c == cp) ? dsk : 0.f);
        } else { const int kk = k - 256, d = kk >> 7, ri = (kk >> 6) & 1, n = kk & 63, j = d == 0 ? t + 1 : 16 - t;
            const float cr = cre[(((size_t)(l * 2 + d) * 32 + g) * 16 + c) * 64 + n], ci = cim[(((size_t)(l * 2 + d) * 32 + g) * 16 + c) * 64 + n];
            const f32x2 pv = pw[((size_t)(g * 2 + d) * 17 + j) * 64 + n];
            val = ri == 0 ? cr * pv.x - ci * pv.y : -(cr * pv.y + ci * pv.x); }
        wmat[idx] = f2bf(val);
    }
}

__device__ __forceinline__ void scans_phase(const int TID, const int BID, const Params& p, const int l, const bool do_gla) {
    const int G = gridDim.x;
    const bool split = (G == 256);
    {
        const f32x2* pw = (const f32x2*)(p.ws + WS_PW) + l * PWL; const bf16_t* st = (const bf16_t*)(p.ws + WS_ST); bf16_t* ub = (bf16_t*)(p.ws + WS_UBUF);
        for (int idx = BID * 512 + TID; idx < 40960; idx += G * 512) {
            const int seq = idx >> 12, rem = idx & 4095, g = rem >> 7, d = (rem >> 6) & 1, n = rem & 63;
            const int ch0 = seq < 2 ? seq * 257 : 514 + (seq - 2) * 129, nc = seq < 2 ? 257 : 129;
            const f32x2 a16 = pw[((size_t)(g * 2 + d) * 17 + 16) * 64 + n];
            float sr = 0.f, si = 0.f;
            for (int s0 = 0; s0 < nc; s0 += 32) {
                float lr[32], li[32];
#pragma unroll
                for (int i = 0; i < 32; ++i) { const int step = s0 + i; lr[i] = 0.f; li[i] = 0.f;
                    { const int sc = step < nc ? step : nc - 1; const int c = d == 0 ? sc : nc - 1 - sc; const size_t row = (size_t)g * CHP + ch0 + c; lr[i] = bf2f(st[row * 256 + d * 128 + n]); li[i] = bf2f(st[row * 256 + d * 128 + 64 + n]); } }
#pragma unroll
                for (int i = 0; i < 32; ++i) { const int step = s0 + i;
                    if (step < nc) { const int c = d == 0 ? step : nc - 1 - step; const size_t row = (size_t)g * CHP + ch0 + c;
                        ub[row * 512 + 256 + d * 128 + n] = f2bf(sr); ub[row * 512 + 256 + d * 128 + 64 + n] = f2bf(si);
                        const float nr = a16.x * sr - a16.y * si + lr[i], ni = a16.x * si + a16.y * sr + li[i]; sr = nr; si = ni; } }
            }
        }
    }
    {
        const float* la = (const float*)(p.ws + WS_LRUA); const float* lh = (const float*)(p.ws + WS_LRUH); float* lc = (float*)(p.ws + WS_LRUC);
        const int vb0 = split ? BID - 80 : BID, vstride = split ? 1 << 20 : G;
        for (int vb = vb0; vb >= 0 && vb < 40; vb += vstride) {
            const int idx = vb * 512 + TID;
            const int seq = idx >> 11, d = (idx >> 10) & 1, ch = idx & 1023;
            const int cb = seq < 2 ? seq * 65 : 130 + (seq - 2) * 33, nc = seq < 2 ? 65 : 33;
            float cin = 0.f;
            for (int s0 = 0; s0 < nc; s0 += 16) {
                float A[16], H[16];
#pragma unroll
                for (int i = 0; i < 16; ++i) { const int step = s0 + i; A[i] = 1.f; H[i] = 0.f;
                    { const int sc = step < nc ? step : nc - 1; const int ci = cb + (d == 0 ? sc : nc - 1 - sc); const size_t o = ((size_t)ci * 2 + d) * 1024 + ch; A[i] = la[o]; H[i] = lh[o]; } }
#pragma unroll
                for (int i = 0; i < 16; ++i) { const int step = s0 + i;
                    if (step < nc) { const int ci = cb + (d == 0 ? step : nc - 1 - step); const size_t o = ((size_t)ci * 2 + d) * 1024 + ch; lc[o] = cin; cin = A[i] * cin + H[i]; } }
            }
        }
    }
    if (do_gla) {
        const bf16_t* ds = (const bf16_t*)(p.ws + WS_DS); const float* dec = (const float*)(p.ws + WS_DECAY); bf16_t* spb = (bf16_t*)(p.ws + WS_SPB);
        for (int it = 0; ; ++it) {
            int vb;
            if (split) { if (BID >= 120) { if (it >= 8) break; vb = (BID - 120) + 136 * it; } else { vb = 1088 + BID + 120 * it; if (vb >= 1280) break; } }
            else { vb = BID + G * it; if (vb >= 1280) break; }
            const int e = vb * 512 + TID;
            const int seq = e >> 16, rem = e & 65535, head = rem >> 14, d = (rem >> 13) & 1, el = rem & 8191, kk = el & 63;
            const int cb = seq < 2 ? seq * 65 : 130 + (seq - 2) * 33, nc = seq < 2 ? 65 : 33;
            float S = 0.f;
            for (int s0 = 0; s0 < nc; s0 += 16) {
                float tm[16], dc[16];
#pragma unroll
                for (int i = 0; i < 16; ++i) { const int step = s0 + i; tm[i] = 0.f; dc[i] = 1.f;
                    { const int sc = step < nc ? step : nc - 1; const int ci = cb + (d == 0 ? sc : nc - 1 - sc); const size_t o = ((size_t)(ci * 4 + head) * 2 + d); tm[i] = bf2f(ds[o * 8192 + el]); dc[i] = dec[o * 64 + kk]; } }
#pragma unroll
                for (int i = 0; i < 16; ++i) { const int step = s0 + i;
                    if (step < nc) { const int ci = cb + (d == 0 ? step : nc - 1 - step); const size_t o = ((size_t)(ci * 4 + head) * 2 + d); spb[o * 8192 + el] = f2bf(S); S = dc[i] * S + tm[i]; } }
            }
        }
    }
}

__device__ __forceinline__ f32x4 mma_lds(f32x4 acc, const LAS bf16_t* A, const LAS bf16_t* B, int ld, int nks, int lane) {
    const LAS bf16_t* ap = A + (lane & 15) * ld + (lane >> 4) * 8; const LAS bf16_t* bp = B + (lane & 15) * ld + (lane >> 4) * 8;
    for (int ks = 0; ks < nks; ++ks) acc = __builtin_amdgcn_mfma_f32_16x16x32_bf16(*(const LAS bf16x8*)(ap + ks * 32), *(const LAS bf16x8*)(bp + ks * 32), acc, 0, 0, 0);
    return acc;
}
__device__ __forceinline__ f32x4 mma_lds_sw(f32x4 acc, const LAS bf16_t* A, int rowA0, const LAS bf16_t* B, int rowB0, int ld, int nks, int lane) {
    const int swa = rowA0 >= 0 ? (((rowA0 + (lane & 15)) >> 3) & 7) : 0, swb = rowB0 >= 0 ? (((rowB0 + (lane & 15)) >> 3) & 7) : 0;
    const LAS bf16_t* ap = A + (lane & 15) * ld; const LAS bf16_t* bp = B + (lane & 15) * ld;
    for (int ks = 0; ks < nks; ++ks) { const int cb = ks * 4 + (lane >> 4);
        acc = __builtin_amdgcn_mfma_f32_16x16x32_bf16(*(const LAS bf16x8*)(ap + ((cb ^ swa) << 3)), *(const LAS bf16x8*)(bp + ((cb ^ swb) << 3)), acc, 0, 0, 0); }
    return acc;
}
#define SWZ(row, col) (((((col) >> 3) ^ (((row) >> 3) & 7)) << 3) + ((col) & 7))
constexpr int GL_GLR = 0, GL_BF = 16384, GL_BB = 32768, GL_OS = 0, GL_QE0 = 49152, GL_QE1 = 58368, GL_KE0 = 67584, GL_KE1 = 76800, GL_VT = 86016, GL_ATT = 104448, GL_SP0 = 113664, GL_SP1 = 132096;
constexpr int GLD = 72;
template <int MODE>
__device__ __forceinline__ void gla_item(const int TID, const Params& p, int l, int ci, int head, LAS unsigned char* lds, const float (&wg)[2][16], const float (&bg)[2], const float (&ngv)[16]) {
    const int tid = TID, lane = tid & 63, wid = tid >> 6;
    const bf16_t* cols = (const bf16_t*)(p.ws + WS_COLS);
    int seq, c; chunk_info(ci, seq, c);
    const int tok0 = seq_start(seq) + (c == 0 ? -48 : 16 + 64 * (c - 1));
    const int rmin = (c == 0) ? 48 : 0;
    LAS float* glr_s = (LAS float*)(lds + GL_GLR); LAS float* bfs = (LAS float*)(lds + GL_BF); LAS float* bbs = (LAS float*)(lds + GL_BB);
    f32x4 gbv[4];
    if (MODE == 1) { const float* gb = (const float*)(p.ws + WS_GB) + (size_t)(ci * 4 + head) * 8192;
#pragma unroll
      for (int i = 0; i < 4; ++i) gbv[i] = *(const f32x4*)(gb + (i * 512 + tid) * 4); }
    u32x4 kw = (u32x4){0u, 0u, 0u, 0u}, qw = kw, vwp[2], gwp[2];
    { const int r = tid >> 3, k8 = (tid & 7) * 8; const int rc = r >= rmin ? r : rmin; const bf16_t* rowp = cols + (size_t)(tok0 + rc) * NINP;
      kw = *(const u32x4*)(rowp + C_K + head * 64 + k8); if (MODE == 1) qw = *(const u32x4*)(rowp + C_Q + head * 64 + k8);
#pragma unroll
      for (int hh = 0; hh < 2; ++hh) { vwp[hh] = *(const u32x4*)(rowp + C_V + head * 128 + ((tid & 7) + 8 * hh) * 8); if (MODE == 1) gwp[hh] = *(const u32x4*)(rowp + C_GB + head * 128 + (tid & 7) * 16 + hh * 8); } }
    if (MODE == 0) {
    { const int r = tid >> 3, j4 = (tid & 7) * 4; f32x4 v = (f32x4){0.f, 0.f, 0.f, 0.f};
      { const int rc = r >= rmin ? r : rmin; const u32x2 w = *(const u32x2*)(cols + (size_t)(tok0 + rc) * NINP + C_GLR + j4); if (r >= rmin) { v[0] = bflo(w.x); v[1] = bfhi(w.x); v[2] = bflo(w.y); v[3] = bfhi(w.y); } }
      *(LAS f32x4*)(glr_s + r * 32 + j4) = v; }
    __syncthreads();
    { const int kk = tid & 63, rb = tid >> 6;
#pragma unroll
      for (int i = 0; i < 8; ++i) { const int r = rb + 8 * i; float x0 = bg[0], x1 = bg[1]; f32x4 gr[8];
#pragma unroll
          for (int j4 = 0; j4 < 8; ++j4) gr[j4] = *(const LAS f32x4*)(glr_s + r * 32 + j4 * 4);
#pragma unroll
          for (int j = 0; j < 16; ++j) { x0 += gr[j >> 2][j & 3] * wg[0][j]; x1 += gr[4 + (j >> 2)][j & 3] * wg[1][j]; }
          const bool ok = r >= rmin; bfs[r * 64 + kk] = ok ? logsig(x0) * 0.0625f : 0.f; bbs[r * 64 + kk] = ok ? logsig(x1) * 0.0625f : 0.f; } }
    __syncthreads();
    { const int col = tid & 127, part = tid >> 7, d = col >> 6, kk = col & 63; LAS float* bs = d ? bbs : bfs; LAS float* tot = glr_s;
      float v[16];
#pragma unroll
      for (int i = 0; i < 16; ++i) v[i] = bs[(part * 16 + i) * 64 + kk];
      if (d == 0) {
#pragma unroll
          for (int i = 1; i < 16; ++i) v[i] += v[i - 1];
          tot[part * 128 + col] = v[15]; }
      else {
#pragma unroll
          for (int i = 14; i >= 0; --i) v[i] += v[i + 1];
          tot[part * 128 + col] = v[0]; }
      __syncthreads();
      float off = 0.f;
#pragma unroll
      for (int pp = 0; pp < 4; ++pp) { const float t = tot[pp * 128 + col]; if (d == 0 ? pp < part : pp > part) off += t; }
#pragma unroll
      for (int i = 0; i < 16; ++i) bs[(part * 16 + i) * 64 + kk] = v[i] + off; }
    __syncthreads();
    { float* gb = (float*)(p.ws + WS_GB) + (size_t)(ci * 4 + head) * 8192;
#pragma unroll
      for (int i = 0; i < 4; ++i) { const int e = (i * 512 + tid) * 4; *(f32x4*)(gb + e) = *(const LAS f32x4*)(bfs + e); } }
    } else {
      __syncthreads();
#pragma unroll
      for (int i = 0; i < 4; ++i) { const int e = (i * 512 + tid) * 4; *(LAS f32x4*)(bfs + e) = gbv[i]; }
      __syncthreads();
    }
    LAS bf16_t* vT = (LAS bf16_t*)(lds + GL_VT);
    { const int r = tid >> 3, k8 = (tid & 7) * 8; const bool ok = r >= rmin;
      if (!ok) { kw = (u32x4){0u, 0u, 0u, 0u}; qw = kw; }
      float qv[8], kv[8];
#pragma unroll
      for (int i = 0; i < 4; ++i) { qv[2 * i] = bflo(qw[i]); qv[2 * i + 1] = bfhi(qw[i]); kv[2 * i] = bflo(kw[i]); kv[2 * i + 1] = bfhi(kw[i]); }
      if (MODE == 0) { LAS bf16_t* kd0 = (LAS bf16_t*)(lds + GL_QE0); LAS bf16_t* kd1 = (LAS bf16_t*)(lds + GL_QE1);
#pragma unroll
          for (int i = 0; i < 8; ++i) { const int kk = k8 + i; kd0[kk * GLD + SWZ(kk, r)] = f2bf(kv[i] * __expf(bfs[63 * 64 + kk] - bfs[r * 64 + kk])); kd1[kk * GLD + SWZ(kk, r)] = f2bf(kv[i] * __expf(bbs[kk] - bbs[r * 64 + kk])); }
      } else { LAS bf16_t* qe0 = (LAS bf16_t*)(lds + GL_QE0); LAS bf16_t* qe1 = (LAS bf16_t*)(lds + GL_QE1); LAS bf16_t* ke0 = (LAS bf16_t*)(lds + GL_KE0); LAS bf16_t* ke1 = (LAS bf16_t*)(lds + GL_KE1);
          u32x4 a, b2, c2, d2;
#pragma unroll
          for (int i = 0; i < 4; ++i) { const int kk = k8 + 2 * i; const float f0 = bfs[r * 64 + kk], f1 = bfs[r * 64 + kk + 1], g0 = bbs[r * 64 + kk], g1 = bbs[r * 64 + kk + 1];
              a[i] = cvt_pk_bf16(qv[2 * i] * 0.125f * __expf(f0), qv[2 * i + 1] * 0.125f * __expf(f1)); b2[i] = cvt_pk_bf16(qv[2 * i] * 0.125f * __expf(g0), qv[2 * i + 1] * 0.125f * __expf(g1));
              c2[i] = cvt_pk_bf16(kv[2 * i] * __expf(-f0), kv[2 * i + 1] * __expf(-f1)); d2[i] = cvt_pk_bf16(kv[2 * i] * __expf(-g0), kv[2 * i + 1] * __expf(-g1)); }
          *(LAS u32x4*)(qe0 + r * GLD + k8) = a; *(LAS u32x4*)(qe1 + r * GLD + k8) = b2; *(LAS u32x4*)(ke0 + r * GLD + k8) = c2; *(LAS u32x4*)(ke1 + r * GLD + k8) = d2; }
#pragma unroll
      for (int hh = 0; hh < 2; ++hh) { const int v8 = ((tid & 7) + 8 * hh) * 8; u32x4 vw = (u32x4){0u, 0u, 0u, 0u};
          if (ok) vw = vwp[hh];
#pragma unroll
          for (int i = 0; i < 4; ++i) { vT[(v8 + 2 * i) * GLD + SWZ(v8, r)] = (bf16_t)(vw[i] & 0xffffu); vT[(v8 + 2 * i + 1) * GLD + SWZ(v8, r)] = (bf16_t)(vw[i] >> 16); } }
    }
    if (MODE == 1) {
        const bf16_t* spb = (const bf16_t*)(p.ws + WS_SPB); u32x4 sv[2][2];
#pragma unroll
        for (int d = 0; d < 2; ++d) { const bf16_t* src = spb + ((size_t)(ci * 4 + head) * 2 + d) * 8192;
#pragma unroll
            for (int i = 0; i < 2; ++i) sv[d][i] = *(const u32x4*)(src + (i * 512 + tid) * 8); }
#pragma unroll
        for (int d = 0; d < 2; ++d) { LAS bf16_t* sp = (LAS bf16_t*)(lds + (d ? GL_SP1 : GL_SP0));
#pragma unroll
            for (int i = 0; i < 2; ++i) { const int e = (i * 512 + tid) * 8; *(LAS u32x4*)(sp + (e >> 6) * GLD + (e & 63)) = sv[d][i]; } }
    }
    __syncthreads();
    if (MODE == 0) {
        float* ds = (float*)(p.ws + WS_DS); float* dec = (float*)(p.ws + WS_DECAY);
        if (tid < 128) { const int d = tid >> 6, kk = tid & 63; dec[((size_t)(ci * 4 + head) * 2 + d) * 64 + kk] = __expf(d == 0 ? bfs[63 * 64 + kk] : bbs[kk]); }
#pragma unroll
        for (int d = 0; d < 2; ++d) { const LAS bf16_t* kd = (const LAS bf16_t*)(lds + (d ? GL_QE1 : GL_QE0)); bf16_t* dst = (bf16_t*)ds + ((size_t)(ci * 4 + head) * 2 + d) * 8192;
            for (int kt = 0; kt < 4; ++kt) { f32x4 acc = (f32x4){0.f, 0.f, 0.f, 0.f}; acc = mma_lds_sw(acc, vT + wid * 16 * GLD, wid * 16, kd + kt * 16 * GLD, kt * 16, GLD, 2, lane);
#pragma unroll
                for (int j = 0; j < 4; ++j) dst[(wid * 16 + (lane >> 4) * 4 + j) * 64 + kt * 16 + (lane & 15)] = f2bf_sw(acc[j]); } }
        __syncthreads();
        return;
    }
    const LAS bf16_t* qe0 = (const LAS bf16_t*)(lds + GL_QE0); const LAS bf16_t* qe1 = (const LAS bf16_t*)(lds + GL_QE1); const LAS bf16_t* ke0 = (const LAS bf16_t*)(lds + GL_KE0); const LAS bf16_t* ke1 = (const LAS bf16_t*)(lds + GL_KE1);
    LAS bf16_t* att = (LAS bf16_t*)(lds + GL_ATT);
    { const int it = wid >> 1;
#pragma unroll
      for (int t2 = 0; t2 < 2; ++t2) { const int jt = (wid & 1) * 2 + t2; f32x4 af = (f32x4){0.f, 0.f, 0.f, 0.f}, ab = af;
          af = mma_lds(af, qe0 + it * 16 * GLD, ke0 + jt * 16 * GLD, GLD, 2, lane); ab = mma_lds(ab, qe1 + it * 16 * GLD, ke1 + jt * 16 * GLD, GLD, 2, lane);
#pragma unroll
          for (int j = 0; j < 4; ++j) { const int i_ = it * 16 + (lane >> 4) * 4 + j, j_ = jt * 16 + (lane & 15); att[i_ * GLD + j_] = f2bf((j_ <= i_ ? af[j] : 0.f) + (j_ >= i_ ? ab[j] : 0.f)); } } }
    __syncthreads();
    LAS float* os = (LAS float*)(lds + GL_OS);
    { const int it = wid >> 1; const LAS bf16_t* sp0 = (const LAS bf16_t*)(lds + GL_SP0); const LAS bf16_t* sp1 = (const LAS bf16_t*)(lds + GL_SP1);
#pragma unroll
      for (int t4 = 0; t4 < 4; ++t4) { const int vt = (wid & 1) * 4 + t4; f32x4 acc = (f32x4){0.f, 0.f, 0.f, 0.f};
          acc = mma_lds_sw(acc, att + it * 16 * GLD, -1, vT + vt * 16 * GLD, vt * 16, GLD, 2, lane); acc = mma_lds(acc, qe0 + it * 16 * GLD, sp0 + vt * 16 * GLD, GLD, 2, lane); acc = mma_lds(acc, qe1 + it * 16 * GLD, sp1 + vt * 16 * GLD, GLD, 2, lane);
#pragma unroll
          for (int j = 0; j < 4; ++j) os[(it * 16 + (lane >> 4) * 4 + j) * 132 + vt * 16 + (lane & 15)] = acc[j]; } }
    __syncthreads();
    { const int r = tid >> 3, v0 = (tid & 7) * 16; float o[16]; float ss = 0.f;
#pragma unroll
      for (int i = 0; i < 16; ++i) { o[i] = os[r * 132 + v0 + i]; ss += o[i] * o[i]; }
      ss += __shfl_xor(ss, 1); ss += __shfl_xor(ss, 2); ss += __shfl_xor(ss, 4);
      const float rs = rsqrtf(ss * (1.0f / 128.0f) + 1e-6f);
      if (r >= rmin) { const size_t tok = (size_t)(tok0 + r); bf16_t* yall = (bf16_t*)(p.ws + WS_YALL);
#pragma unroll
          for (int hh = 0; hh < 2; ++hh) { const u32x4 gw = gwp[hh]; u32x4 w;
#pragma unroll
              for (int i = 0; i < 4; ++i) { const int e = hh * 8 + 2 * i; w[i] = cvt_pk_bf16(o[e] * rs * ngv[e] * silu(bflo(gw[i])), o[e + 1] * rs * ngv[e + 1] * silu(bfhi(gw[i]))); }
              *(u32x4*)(yall + tok * D + 512 + head * 128 + v0 + hh * 8) = w; } } }
    __syncthreads();
}

__device__ __forceinline__ float softplus_neg(float lam) { const float e = __expf(-lam); return lam + 0.f < -8.f ? -lam : (e < 0.02f ? e * (1.0f - e * (0.5f - e * (1.0f / 3.0f))) : __logf(1.0f + e)); }
__device__ __forceinline__ float one_minus_exp(float x) {
    return x > -0.5f ? -x * (1.0f + x * 0.5f * (1.0f + x * (1.0f / 3.0f) * (1.0f + x * 0.25f * (1.0f + x * 0.2f * (1.0f + x * (1.0f / 6.0f) * (1.0f + x * (1.0f / 7.0f))))))) : 1.0f - __expf(x);
}
template <int MODE>
__device__ __forceinline__ void lru_phase(const int TID, const int b, const int G, const Params& p, int l, LAS unsigned char* lds) {
    const int tid = TID, lane = tid & 63, wid = tid >> 6, q = lane >> 4;
    const bf16_t* cols = (const bf16_t*)(p.ws + WS_COLS);
    int it = b; if (it >= NCK * 8) return;
    const int nb = b & 7;
    LAS bf16_t* xcA = (LAS bf16_t*)lds; LAS float* xcf = (LAS float*)(lds + 17408);
    const int ch = tid & 127, rb = tid >> 7, gchc = nb * 128 + ch;
    const float w0 = p.in[18][(l * 4 + 0) * 1024 + gchc], w1 = p.in[18][(l * 4 + 1) * 1024 + gchc], w2 = p.in[18][(l * 4 + 2) * 1024 + gchc], w3 = p.in[18][(l * 4 + 3) * 1024 + gchc], cb = p.in[19][l * 1024 + gchc];
    const int chl = wid * 16 + (lane & 15), gch = nb * 128 + chl;
    float ba[2], bx[2], sp8[2];
#pragma unroll
    for (int d = 0; d < 2; ++d) { ba[d] = p.in[21][(l * 2 + d) * 1024 + gch]; bx[d] = p.in[23][(l * 2 + d) * 1024 + gch]; sp8[d] = 8.0f * softplus_neg(p.in[24][(l * 2 + d) * 1024 + gch]); }
    bf16x8 bfr[4][4];
    { const bf16_t* bt = (const bf16_t*)(p.ws + WS_BTLRU);
#pragma unroll
      for (int mat = 0; mat < 4; ++mat)
#pragma unroll
          for (int ks = 0; ks < 4; ++ks) bfr[mat][ks] = *(const bf16x8*)(bt + ((size_t)(mat * 8 + nb) * 128 + wid * 16 + (lane & 15)) * 128 + ks * 32 + q * 8); }
    bf16_t xr[19];
    { int seq, c; chunk_info(it >> 3, seq, c); const int s0 = seq_start(seq), L = seq_len(seq), pos0 = (c == 0 ? -48 : 16 + 64 * (c - 1));
      const bf16_t* xb = cols + (size_t)s0 * NINP + C_XC + gchc;
#pragma unroll
      for (int i = 0; i < 19; ++i) { const int pos = pos0 + rb * 16 - 2 + i; const int pc = pos < 0 ? 0 : (pos < L ? pos : L - 1); xr[i] = xb[(size_t)pc * NINP]; } }
    for (; it < NCK * 8; it += G) {
        const int ci = it >> 3;
        int seq, c; chunk_info(ci, seq, c);
        const int s0 = seq_start(seq);
        const int pos0 = (c == 0 ? -48 : 16 + 64 * (c - 1));
        const int rmin = (c == 0) ? 48 : 0;
        float xv[19];
        { const int L = seq_len(seq);
#pragma unroll
          for (int i = 0; i < 19; ++i) { const int pos = pos0 + rb * 16 - 2 + i; xv[i] = (pos >= 0 && pos < L) ? bf2f(xr[i]) : 0.f; } }
#pragma unroll
        for (int i = 0; i < 16; ++i) { const int r = rb * 16 + i; const float xc = (r >= rmin) ? cb + xv[i] * w0 + xv[i + 1] * w1 + xv[i + 2] * w2 + xv[i + 3] * w3 : 0.f;
            xcf[r * 132 + ch] = xc; xcA[r * 136 + ch] = f2bf(xc); }
        u32x4 gq[2]; float cin[2];
        if (MODE == 1) {
#pragma unroll
            for (int d = 0; d < 2; ++d) cin[d] = ((const float*)(p.ws + WS_LRUC))[((size_t)ci * 2 + d) * 1024 + gch];
            { const int r = tid >> 3; const int rr = r >= rmin ? r : rmin; const bf16_t* gp = cols + (size_t)(s0 + pos0 + rr) * NINP + C_GC + nb * 128 + (tid & 7) * 16;
              gq[0] = *(const u32x4*)gp; gq[1] = *(const u32x4*)(gp + 8); }
        }
        { const int itn = it + G;
          if (itn < NCK * 8) { int seqn, cn; chunk_info(itn >> 3, seqn, cn); const int s0n = seq_start(seqn), Ln = seq_len(seqn), pos0n = (cn == 0 ? -48 : 16 + 64 * (cn - 1));
              const bf16_t* xb = cols + (size_t)s0n * NINP + C_XC + gchc;
#pragma unroll
              for (int i = 0; i < 19; ++i) { const int pos = pos0n + rb * 16 - 2 + i; const int pc = pos < 0 ? 0 : (pos < Ln ? pos : Ln - 1); xr[i] = xb[(size_t)pc * NINP]; } } }
        LBAR();
        LAS bf16_t* gts = (LAS bf16_t*)(lds + 51200); LAS float* hfs = (LAS float*)(lds + 68608);
        float hsum[4][4];
#pragma unroll
        for (int d = 0; d < 2; ++d) {
            __builtin_amdgcn_sched_barrier(0);
            f32x4 acc[2][4];
#pragma unroll
            for (int rt = 0; rt < 4; ++rt) { bf16x8 afr[4];
#pragma unroll
                for (int ks = 0; ks < 4; ++ks) afr[ks] = *(const LAS bf16x8*)(xcA + (rt * 16 + (lane & 15)) * 136 + ks * 32 + q * 8);
#pragma unroll
                for (int kind = 0; kind < 2; ++kind) { f32x4 a = (f32x4){0.f, 0.f, 0.f, 0.f};
#pragma unroll
                    for (int ks = 0; ks < 4; ++ks) a = __builtin_amdgcn_mfma_f32_16x16x32_bf16(afr[ks], bfr[d * 2 + kind][ks], a, 0, 0, 0);
                    acc[kind][rt] = a; } }
            float a[4][4], bb[4][4];
#pragma unroll
            for (int rt = 0; rt < 4; ++rt)
#pragma unroll
                for (int j = 0; j < 4; ++j) { const int r = rt * 16 + q * 4 + j; const float rg = sigm(acc[0][rt][j] + ba[d]), ig = sigm(acc[1][rt][j] + bx[d]), la = -sp8[d] * rg;
                    const bool ok = r >= rmin; const float av = __expf(la), x2 = 2.0f * la; const float om = x2 > -0.25f ? -x2 * (1.0f + x2 * 0.5f * (1.0f + x2 * (1.0f / 3.0f) * (1.0f + x2 * 0.25f * (1.0f + x2 * 0.2f)))) : 1.0f - av * av;
                    a[rt][j] = ok ? av : 1.0f; bb[rt][j] = ok ? __builtin_amdgcn_sqrtf(om) * ig * xcf[r * 132 + chl] : 0.f; }
            float LA[4], LB[4];
#pragma unroll
            for (int rt = 0; rt < 4; ++rt) { float A = 1.f, B = 0.f;
#pragma unroll
                for (int jj = 0; jj < 4; ++jj) { const int j = d == 0 ? jj : 3 - jj; B = a[rt][j] * B + bb[rt][j]; A *= a[rt][j]; }
                LA[rt] = A; LB[rt] = B; }
            const size_t co = ((size_t)ci * 2 + d) * 1024 + gch;
            float h = (MODE == 1) ? cin[d] : 0.f, Atot = 1.f; float hin[4];
#pragma unroll
            for (int rr = 0; rr < 4; ++rr) { const int rt = d == 0 ? rr : 3 - rr;
#pragma unroll
                for (int qi = 0; qi < 4; ++qi) { const int qq = d == 0 ? qi : 3 - qi;
                    const float Aq = __shfl(LA[rt], (lane & 15) + 16 * qq), Bq = __shfl(LB[rt], (lane & 15) + 16 * qq);
                    if (qq == q) hin[rt] = h;
                    h = Aq * h + Bq; Atot *= Aq; } }
            if (MODE == 0) { if (q == 0) { ((float*)(p.ws + WS_LRUA))[co] = Atot; ((float*)(p.ws + WS_LRUH))[co] = h; } }
            else {
#pragma unroll
                for (int rt = 0; rt < 4; ++rt) { float hh = hin[rt];
#pragma unroll
                    for (int jj = 0; jj < 4; ++jj) { const int j = d == 0 ? jj : 3 - jj; hh = a[rt][j] * hh + bb[rt][j];
                        if (d == 0) hfs[(rt * 16 + q * 4 + j) * 132 + chl] = hh; else hsum[rt][j] = hh; } }
                if (d == 0) { *(LAS u32x4*)(gts + (tid >> 3) * 136 + (tid & 7) * 16) = gq[0]; *(LAS u32x4*)(gts + (tid >> 3) * 136 + (tid & 7) * 16 + 8) = gq[1]; } }
        }
        if (MODE == 1) { bf16_t* yall = (bf16_t*)(p.ws + WS_YALL);
            LBAR();
#pragma unroll
            for (int rt = 0; rt < 4; ++rt)
#pragma unroll
                for (int j = 0; j < 4; ++j) { const int r = rt * 16 + q * 4 + j; xcA[r * 136 + chl] = f2bf((hsum[rt][j] + hfs[r * 132 + chl]) * silu(bf2f(gts[r * 136 + chl]))); }
            LBAR();
            { const int r = tid >> 3; if (r >= rmin) { const u32x4 y0 = *(const LAS u32x4*)(xcA + r * 136 + (tid & 7) * 16), y1 = *(const LAS u32x4*)(xcA + r * 136 + (tid & 7) * 16 + 8);
                bf16_t* yp = yall + (size_t)(s0 + pos0 + r) * D + 1024 + nb * 128 + (tid & 7) * 16; *(u32x4*)yp = y0; *(u32x4*)(yp + 8) = y1; } } }
        LBAR();
    }
}


template <int WHICH>
__device__ __forceinline__ void skinny_tail(const int TID, const int b0, const Params& p, const int first) {
    const int lane = TID & 63, wid = TID >> 6, q = lane >> 4;
    if (wid >= 5) return;
    for (int b = b0; b < 256; b += (int)gridDim.x) {
    const int ct = b & 127, rt = (b >> 7) * 5 + wid;
    const int row = 24576 + rt * 16 + (lane & 15);
    const int colb = ct * 16 + (lane & 15);
    const bf16_t* cols = (const bf16_t*)(p.ws + WS_COLS);
    if (WHICH == 0) {
        const bf16_t* A = (const bf16_t*)(p.ws + WS_YALL) + (size_t)row * D + q * 8; const bf16_t* B = (const bf16_t*)(p.ws + WS_BTOUT) + (size_t)colb * D + q * 8;
        bf16_t* mbf = (bf16_t*)(p.ws + WS_H);
        f32x4 msum = (f32x4){0.f, 0.f, 0.f, 0.f};
        unsigned char gt[3][4];
#pragma unroll
        for (int br = 0; br < 3; ++br)
#pragma unroll
            for (int j = 0; j < 4; ++j) { const int cc = colb & 255; gt[br][j] = ((const unsigned char*)(cols + (size_t)(24576 + rt * 16 + q * 4 + j) * NINP + C_MG))[(br * 8 + (colb >> 8)) * 256 + ((((cc & 127) >> 5) * 4 + ((cc & 31) >> 3)) * 2 + (cc >> 7)) * 8 + (cc & 7)]; }
        float gs[3][4];
#pragma unroll
        for (int br = 0; br < 3; ++br)
#pragma unroll
            for (int j = 0; j < 4; ++j) { gs[br][j] = (float)gt[br][j] * (1.0f / 255.0f); asm volatile("" : "+v"(gs[br][j])); }
#pragma unroll
        for (int br = 0; br < 3; ++br) { const int koff = br * 512, nks = br == 2 ? 32 : 16; f32x4 acc = (f32x4){0.f, 0.f, 0.f, 0.f};
            for (int k0 = 0; k0 < nks; k0 += 8) { bf16x8 av[8], bv[8];
#pragma unroll
                for (int i = 0; i < 8; ++i) { av[i] = *(const bf16x8*)(A + koff + (k0 + i) * 32); bv[i] = *(const bf16x8*)(B + koff + (k0 + i) * 32); }
#pragma unroll
                for (int i = 0; i < 8; ++i) acc = __builtin_amdgcn_mfma_f32_16x16x32_bf16(av[i], bv[i], acc, 0, 0, 0); }
#pragma unroll
            for (int j = 0; j < 4; ++j) msum[j] += gs[br][j] * acc[j]; }
#pragma unroll
        for (int j = 0; j < 4; ++j) { const int tok = 24576 + rt * 16 + q * 4 + j; mbf[(size_t)tok * D + colb] = f2bf(msum[j]); }
    } else {
        const bf16_t* A = (const bf16_t*)(p.ws + WS_H) + (size_t)row * D + q * 8; const bf16_t* B = (const bf16_t*)(p.ws + WS_BTO) + (size_t)colb * D + q * 8;
        float* z = (float*)(p.ws + WS_Z);
        f32x4 acc = (f32x4){0.f, 0.f, 0.f, 0.f};
        for (int k0 = 0; k0 < 64; k0 += 8) { bf16x8 av[8], bv[8];
#pragma unroll
            for (int i = 0; i < 8; ++i) { av[i] = *(const bf16x8*)(A + (k0 + i) * 32); bv[i] = *(const bf16x8*)(B + (k0 + i) * 32); }
#pragma unroll
            for (int i = 0; i < 8; ++i) acc = __builtin_amdgcn_mfma_f32_16x16x32_bf16(av[i], bv[i], acc, 0, 0, 0); }
#pragma unroll
        for (int j = 0; j < 4; ++j) { const int tok = 24576 + rt * 16 + q * 4 + j; const float res = first ? src_row(p, tok)[colb] : z[(size_t)tok * D + colb]; z[(size_t)tok * D + colb] = res + acc[j]; }
    }
    }
}

#define XB_TMO      128
#define XB_XCNT(j)  (256  + 64 * (j))
#define XB_XSUB(j)  (1280 + 64 * (j))
#define XB_XGEN(j)  (2304 + 64 * (j))
#define XB_TOP      3328
#define XB_TOPGEN   3392
#define XCD_BAR_WORDS 3456
#define XB_SPIN_CAP (1u << 18)
__device__ __forceinline__ unsigned xb_ld(unsigned* p)              { return __hip_atomic_load(p, __ATOMIC_RELAXED, __HIP_MEMORY_SCOPE_AGENT); }
__device__ __forceinline__ unsigned xb_add(unsigned* p, unsigned v) { return __hip_atomic_fetch_add(p, v, __ATOMIC_RELAXED, __HIP_MEMORY_SCOPE_AGENT); }
__device__ __forceinline__ unsigned xb_xcc_id() { return (unsigned)__builtin_amdgcn_s_getreg((3 << 11) | 20) & 0xFu; }
#define XB_SPIN(cond, bar) do { unsigned _sp = 0; while (cond) { __builtin_amdgcn_s_sleep(1); \
    if ((++_sp & 255u) == 0u) { if (xb_ld(&(bar)[XB_TMO])) break; if (_sp > XB_SPIN_CAP) { atomicAdd(&(bar)[XB_TMO], 1u); break; } } } } while (0)
struct XcdBarrier { unsigned* bar; unsigned x; volatile LAS unsigned* st; };
__device__ __forceinline__ XcdBarrier xcd_barrier_post(unsigned* bar, volatile LAS unsigned* st) {
    XcdBarrier b; b.bar = bar; b.x = xb_xcc_id(); b.st = st;
    if (threadIdx.x == 0) (void)xb_add(&bar[XB_XCNT(b.x)], 1u);
    return b;
}
__device__ __forceinline__ void xcd_barrier_complete(unsigned* bar, unsigned x, unsigned& nloc, unsigned& nx) {
    const unsigned G = gridDim.x * gridDim.y * gridDim.z;
    unsigned sum, cnt, mine, sp = 0u;
    for (;;) {
        sum = 0u; cnt = 0u; mine = 0u;
#pragma unroll
        for (unsigned j = 0; j < 16; ++j) { const unsigned c = xb_ld(&bar[XB_XCNT(j)]); sum += c; cnt += (c > 0u) ? 1u : 0u; mine = (j == x) ? c : mine; }
        if (sum == G) break;
        __builtin_amdgcn_s_sleep(1);
        if ((++sp & 255u) == 0u) { if (xb_ld(&bar[XB_TMO])) break; if (sp > XB_SPIN_CAP) { atomicAdd(&bar[XB_TMO], 1u); break; } }
    }
    nloc = mine > 0u ? mine : 1u; nx = cnt > 0u ? cnt : 1u;
}
__device__ __forceinline__ void xcd_barrier(const XcdBarrier& b) {
    asm volatile("s_waitcnt vmcnt(0)" ::: "memory");
    __syncthreads();
    if (threadIdx.x == 0) {
        unsigned* bar = b.bar;
        __builtin_amdgcn_s_waitcnt(0);
        unsigned nloc = b.st[0], nx = b.st[1];
        if (nloc == 0u) { xcd_barrier_complete(bar, b.x, nloc, nx); b.st[0] = nloc; b.st[1] = nx; }
        const unsigned old = xb_add(&bar[XB_XSUB(b.x)], 1u);
        const unsigned gen = old / nloc;
        if (old + 1u == (gen + 1u) * nloc) {
            __builtin_amdgcn_fence(__ATOMIC_RELEASE, "agent");
            asm volatile("s_waitcnt vmcnt(0)" ::: "memory");
            const unsigned og = xb_add(&bar[XB_TOP], 1u);
            const unsigned tg = og / nx;
            if (og + 1u == (tg + 1u) * nx) xb_add(&bar[XB_TOPGEN], 1u);
            else XB_SPIN(xb_ld(&bar[XB_TOPGEN]) == tg, bar);
            __builtin_amdgcn_fence(__ATOMIC_ACQUIRE, "agent");
            xb_add(&bar[XB_XGEN(b.x)], 1u);
            asm volatile("s_waitcnt vmcnt(0)" ::: "memory");
        } else {
            XB_SPIN(xb_ld(&bar[XB_XGEN(b.x)]) == gen, bar);
            __builtin_amdgcn_fence(__ATOMIC_ACQUIRE, "agent");
            asm volatile("s_waitcnt vmcnt(0)" ::: "memory");
        }
    }
    __syncthreads();
}

__global__ void __launch_bounds__(512) fwd_megakernel(Params p_in) {
    extern __shared__ __attribute__((aligned(16))) unsigned char smem[];
    LAS unsigned char* lds = (LAS unsigned char*)smem;
    cg::grid_group grid = cg::this_grid();
    const int G = gridDim.x;
    const Params& p0 = p_in;
    volatile LAS unsigned* stw = (volatile LAS unsigned*)(lds + 150528);
    if (threadIdx.x == 0) { stw[0] = 0u; stw[1] = 0u; }
    __syncthreads();
    const XcdBarrier xb = xcd_barrier_post((unsigned*)(p_in.ws + WS_BAR), stw);
    for (int ph = p0.ph_lo; ph < p0.ph_hi; ++ph) {
        const int reps_ = (ph < 32 && (ph & 7) == DUP) ? 2 : 1;
        for (int rep_ = 0; rep_ < reps_; ++rep_) {
        int TID = threadIdx.x; asm volatile("" : "+v"(TID));
        int b = blockIdx.x; asm volatile("" : "+s"(b));
        Params p = p0; { unsigned long long t_ = (unsigned long long)p.ws; asm volatile("" : "+s"(t_)); p.ws = (unsigned char*)t_; }
        const char* ws = (const char*)p.ws;
        if (ph == 32) { final_norm_phase(TID, b, p); }
        else {
            const int l = ph >> 3, k = ph & 7;
            if (k == 0 && (PHM & 1)) { rmsnorm_phase(TID, b, p, l); convert_weights(TID, b, p, l, (LAS float*)lds); if (l == 0) s5_tables_all(TID, b, p); }
            else if (k == 1 && (PHM & 2)) {
                TileOrder S; S.nM = MP / 256; S.nN = NINP / 256; S.nwg = S.nM * S.nN; S.G = G; S.c = b; S.mult = 1; S.nt0 = D / 64; S.A = ws + WS_H; S.B = ws + WS_BTIN; S.tA = (size_t)256 * D * 2; S.tB = (size_t)256 * D * 2;
                EpiIn E; E.cols = (bf16_t*)(p.ws + WS_COLS); E.ubuf = (bf16_t*)(p.ws + WS_UBUF);
                gemm_phase(TID, lds, D, D, S, E);
                s5_assemble_a(TID, b, p, l);
            } else if (k == 2 && (PHM & 4)) {
                GroupOrder S; S.G = G; S.c = b; S.nt0 = 4; S.A = ws + WS_UBUF; S.B = ws + WS_PMAT; S.gsA = (size_t)CHP * 512 * 2; S.gsB = (size_t)256 * 256 * 2; S.tA = (size_t)256 * 512 * 2;
                EpiS5State E; E.st = (float*)(p.ws + WS_ST);
                if (SUBM & 4) gemm_phase(TID, lds, 512, 256, S, E);
                __syncthreads();
                { const int head_ = ((b + 128) % G) & 3, kk_ = TID & 63; float wg_[2][16], bg_[2];
                  _Pragma("unroll") for (int d = 0; d < 2; ++d) { bg_[d] = p.in[16][(l * 2 + d) * 256 + head_ * 64 + kk_]; _Pragma("unroll") for (int j = 0; j < 16; ++j) wg_[d][j] = p.in[15][((size_t)(l * 2 + d) * 16 + j) * 256 + head_ * 64 + kk_]; }
                  float ng_[16]; _Pragma("unroll") for (int e = 0; e < 16; ++e) ng_[e] = p.in[17][l * 512 + head_ * 128 + (TID & 7) * 16 + e];
                  for (int it = (b + 128) % G; it < NCK * 4; it += G) gla_item<0>(TID, p, l, it >> 2, it & 3, lds, wg_, bg_, ng_); }
                lru_phase<0>(TID, b, G, p, l, lds);
                s5_assemble_w(TID, b, p, l);
            } else if (k == 3 && (PHM & 8)) { scans_phase(TID, b, p, l, rep_ == 0); }
            else if (k == 4 && (PHM & 16)) {
                GroupOrder S; S.G = G; S.c = b; S.nt0 = 8; S.A = ws + WS_UBUF; S.B = ws + WS_WMAT; S.gsA = (size_t)CHP * 512 * 2; S.gsB = (size_t)256 * 512 * 2; S.tA = (size_t)256 * 512 * 2;
                EpiS5Out E; E.zs5 = (bf16_t*)(p.ws + WS_ZS5);
                if (SUBM & 4) gemm_phase(TID, lds, 512, 512, S, E);
                __syncthreads();
                { const int head_ = ((b + 128) % G) & 3, kk_ = TID & 63; float wg_[2][16], bg_[2];
                  _Pragma("unroll") for (int d = 0; d < 2; ++d) { bg_[d] = p.in[16][(l * 2 + d) * 256 + head_ * 64 + kk_]; _Pragma("unroll") for (int j = 0; j < 16; ++j) wg_[d][j] = p.in[15][((size_t)(l * 2 + d) * 16 + j) * 256 + head_ * 64 + kk_]; }
                  float ng_[16]; _Pragma("unroll") for (int e = 0; e < 16; ++e) ng_[e] = p.in[17][l * 512 + head_ * 128 + (TID & 7) * 16 + e];
                  for (int it = (b + 128) % G; it < NCK * 4; it += G) gla_item<1>(TID, p, l, it >> 2, it & 3, lds, wg_, bg_, ng_); }
                lru_phase<1>(TID, b, G, p, l, lds);
            } else if (k == 5 && (PHM & 32)) {
                TileOrder S; S.nM = MP / 256; S.nN = 2; S.nwg = S.nM * S.nN; S.G = G; S.c = b; S.mult = 1; S.nt0 = 8; S.A = ws + WS_ZS5; S.B = ws + WS_BTGLU; S.tA = (size_t)256 * 512 * 2; S.tB = (size_t)256 * 512 * 2;
                EpiGlu E; E.zs5 = (const bf16_t*)(p.ws + WS_ZS5); E.cols = (const bf16_t*)(p.ws + WS_COLS); E.bglu = p.in[14] + l * 512; E.yall = (bf16_t*)(p.ws + WS_YALL);
                gemm_phase(TID, lds, 512, 512, S, E);
            } else if (k == 6 && (PHM & 64)) {
                TileOrder S; S.nM = 96; S.nN = 8; S.nwg = S.nM * S.nN; S.G = G; S.c = b; S.mult = 3; S.nt0 = 8; S.A = ws + WS_YALL; S.B = ws + WS_BTOUT; S.tA = (size_t)256 * D * 2; S.tB = (size_t)256 * D * 2;
                EpiOut E; E.cols = (const bf16_t*)(p.ws + WS_COLS); E.mbf = (bf16_t*)(p.ws + WS_H);
                gemm_phase(TID, lds, D, D, S, E);
                skinny_tail<0>(TID, b, p, 0);
            } else if (PHM & 128) {
                TileOrder S; S.nM = 96; S.nN = 8; S.nwg = S.nM * S.nN; S.G = G; S.c = b; S.mult = 1; S.nt0 = D / 64; S.A = ws + WS_H; S.B = ws + WS_BTO; S.tA = (size_t)256 * D * 2; S.tB = (size_t)256 * D * 2;
                EpiWo E; E.z = (float*)(p.ws + WS_Z); E.pp = &p; E.first = (l == 0);
                gemm_phase(TID, lds, D, D, S, E);
                skinny_tail<1>(TID, b, p, l == 0);
            }
        }
        }
        if (p0.use_sync && ph + 1 < p0.ph_hi) { if (ph == p0.ph_lo) grid.sync(); else xcd_barrier(xb); }
    }
}

extern "C" void kernel_launch(void* const* d_in, const int* in_sizes, int n_in, void* d_out, int out_size, void* d_ws, size_t ws_size, hipStream_t stream) {
    static int grid = 0, coop = 1;
    if (grid == 0) {
        if (n_in != 30 || ws_size < WS_END3) { fprintf(stderr, "kernel_launch: unexpected n_in %d or ws_size %zu (< %zu)\n", n_in, ws_size, (size_t)WS_END); grid = -1; return; }
        int dev = 0, cus = 0, per_cu = 0;
        (void)hipGetDevice(&dev); (void)hipDeviceGetAttribute(&cus, hipDeviceAttributeMultiprocessorCount, dev);
        if (hipFuncSetAttribute((const void*)fwd_megakernel, hipFuncAttributeMaxDynamicSharedMemorySize, LDS_BYTES) != hipSuccess) { fprintf(stderr, "kernel_launch: hipFuncSetAttribute failed\n"); grid = -1; return; }
        if (hipOccupancyMaxActiveBlocksPerMultiprocessor(&per_cu, (const void*)fwd_megakernel, 512, LDS_BYTES) != hipSuccess || per_cu < 1) { fprintf(stderr, "kernel_launch: occupancy query gave %d\n", per_cu); per_cu = 1; }
        (void)hipGetLastError();
        grid = cus * 1;
    }
    if (grid < 0) return;
    Params p{};
    for (int i = 0; i < 30; ++i) p.in[i] = (const float*)d_in[i];
    p.out = (float*)d_out; p.ws = (unsigned char*)d_ws; p.pad = 0;
    (void)hipMemsetAsync((char*)d_ws + WS_BAR, 0, 3456 * 4, stream);
    if (coop) {
        p.ph_lo = 0; p.ph_hi = 33; p.use_sync = 1;
        void* args[] = {&p};
        hipError_t e = hipLaunchCooperativeKernel((const void*)fwd_megakernel, dim3(grid), dim3(512), args, LDS_BYTES, stream);
        if (e == hipSuccess) return;
        fprintf(stderr, "kernel_launch: cooperative launch failed: %s (grid %d); falling back to one launch per phase\n", hipGetErrorString(e), grid);
        (void)hipGetLastError(); coop = 0;
    }
    for (int ph = 0; ph < 33; ++ph) { p.ph_lo = ph; p.ph_hi = ph + 1; p.use_sync = 0; hipLaunchKernelGGL(fwd_megakernel, dim3(grid), dim3(512), LDS_BYTES, stream, p); }
}
```
